# Optimizing an MI355X kernel written in HIP

```python
import math
import jax
import jax.numpy as jnp
from jax import lax
import numpy as np

D_MODEL = 1024
BATCH = 8
SEQ = 2048
DEPTH = 2
DEC_BATCH = 128
DEC_SEQ = 4
PAST_LEN = 16384
PAGE_SIZE = 128

HEAD_DIM = 64
N_MIXERS = 4
HEADS = D_MODEL // (N_MIXERS * HEAD_DIM)
RET_DK = HEAD_DIM
RET_DV = HEAD_DIM
GLA_DK = HEAD_DIM // 2
GLA_DV = HEAD_DIM
GLA_GATE_RANK = 16
GLA_GATE_NORM = 16.0
HG_DK = HEAD_DIM
HG_DV = HEAD_DIM
GDN_DK = HEAD_DIM
GDN_DV = HEAD_DIM
CONV_W = 4
GDN_CONV_CH = HEADS * (2 * GDN_DK + GDN_DV)
MIX_WIDTH = HEADS * (RET_DV + GLA_DV + HG_DV + GDN_DV)
D_FF = ((8 * D_MODEL // 3 + 127) // 128) * 128
CHUNK = 64
ROPE_BASE = 10000.0
LN_EPS = 1e-5
RMS_EPS = 1e-6
ALPHA = (2.0 * DEPTH) ** 0.25
DEEPNORM_BETA = (8.0 * DEPTH) ** -0.25
N_MOD = 9
MIX_COLS = (
    HEADS * RET_DK, HEADS * RET_DK, HEADS * RET_DV, HEADS * RET_DV,
    HEADS * GLA_DK, HEADS * GLA_DK, HEADS * GLA_DV, GLA_GATE_RANK, HEADS * GLA_DV,
    HEADS * HG_DK, HEADS * HG_DK, HEADS * HG_DV, HEADS * HG_DV,
    GDN_CONV_CH, HEADS, HEADS, HEADS * GDN_DV,
)
IN_COLS = sum(MIX_COLS)

kernel_name = 'hybrid_ret_gla_hgrn2_gdn_decode_step'


def _layer_norm(x, g, b):
    xf = x.astype(jnp.float32)
    mu = jnp.mean(xf, axis=-1, keepdims=True)
    var = jnp.mean(jnp.square(xf - mu), axis=-1, keepdims=True)
    y = (xf - mu) * lax.rsqrt(var + LN_EPS)
    return (y * g.astype(jnp.float32) + b.astype(jnp.float32)).astype(x.dtype)


def _rms(x, g=None):
    xf = x.astype(jnp.float32)
    y = xf * lax.rsqrt(jnp.mean(jnp.square(xf), axis=-1, keepdims=True) + RMS_EPS)
    return y if g is None else y * g.astype(jnp.float32)


def _l2norm(x):
    xf = x.astype(jnp.float32)
    return xf * lax.rsqrt(jnp.sum(jnp.square(xf), axis=-1, keepdims=True) + RMS_EPS)


def _rotary(x, pos):
    half = x.shape[-1] // 2
    inv = ROPE_BASE ** (-jnp.arange(half, dtype=jnp.float32) / half)
    ang = pos[:, None] * inv[None, :]
    cos = jnp.cos(ang)[None, :, None, :]
    sin = jnp.sin(ang)[None, :, None, :]
    x1, x2 = x[..., :half], x[..., half:]
    return jnp.concatenate([x1 * cos - x2 * sin, x1 * sin + x2 * cos], axis=-1)


def _swiglu(h, wi, wo):
    a, b = jnp.split(h @ wi, 2, axis=-1)
    return (jax.nn.silu(a) * b) @ wo


def _split_cols(t):
    out, start = [], 0
    for w in MIX_COLS:
        out.append(t[..., start:start + w])
        start += w
    return out


def _chunking(T):
    c = min(CHUNK, T)
    return c, -(-T // c) * c


def _prep(t, tp, c):
    t = jnp.swapaxes(t, 1, 2).astype(jnp.float32)
    b, h, T, d = t.shape
    t = jnp.pad(t, ((0, 0), (0, 0), (0, tp - T), (0, 0)))
    return jnp.moveaxis(t.reshape(b, h, tp // c, c, d), 2, 0)


def _unchunk(o, T):
    nc, b, h, c, d = o.shape
    o = jnp.moveaxis(o, 0, 2).reshape(b, h, nc * c, d)[:, :, :T]
    return jnp.swapaxes(o, 1, 2)


def _gla_scan(q, k, v, g, s0):
    T = q.shape[1]
    c, tp = _chunking(T)
    xs = tuple(_prep(t, tp, c) for t in (q, k, v, g))
    causal = jnp.tril(jnp.ones((c, c), dtype=bool))[:, :, None]

    def step(S, inp):
        qc, kc, vc, gc = inp
        G = jnp.cumsum(gc, axis=2)
        diff = G[:, :, :, None, :] - G[:, :, None, :, :]
        decay = jnp.where(causal, jnp.exp(jnp.where(causal, diff, 0.0)), 0.0)
        att = jnp.einsum('bhtd,bhsd,bhtsd->bhts', qc, kc, decay)
        o = att @ vc + (qc * jnp.exp(G)) @ S
        gl = G[:, :, -1:, :]
        S = jnp.exp(gl[:, :, 0, :, None]) * S + jnp.einsum('bhsd,bhsv->bhdv', kc * jnp.exp(gl - G), vc)
        return S, o

    s, o = lax.scan(step, s0.astype(jnp.float32), xs)
    return _unchunk(o, T), s.astype(s0.dtype)


def _gdn_scan(q, k, v, beta, g, s0):
    T = q.shape[1]
    c, tp = _chunking(T)
    xs = tuple(_prep(t, tp, c) for t in (q, k, v, beta[..., None], g[..., None]))
    incl = jnp.tril(jnp.ones((c, c), dtype=bool))
    strict = jnp.tril(jnp.ones((c, c), dtype=bool), -1)
    eye = jnp.eye(c, dtype=jnp.float32)

    def step(S, inp):
        qc, kc, vc, bc, gc = inp
        G = jnp.cumsum(gc, axis=2)
        diff = G - jnp.swapaxes(G, -1, -2)
        L = jnp.where(incl, jnp.exp(jnp.where(incl, diff, 0.0)), 0.0)
        a = jnp.where(strict, bc * (kc @ jnp.swapaxes(kc, -1, -2)) * L, 0.0)
        tm = eye + a
        u = lax.linalg.triangular_solve(tm, bc * vc, left_side=True, lower=True, unit_diagonal=True)
        w = lax.linalg.triangular_solve(tm, bc * jnp.exp(G) * kc, left_side=True, lower=True, unit_diagonal=True)
        delta = u - w @ S
        o = ((qc @ jnp.swapaxes(kc, -1, -2)) * L) @ delta + (qc * jnp.exp(G)) @ S
        gl = G[:, :, -1:, :]
        S = jnp.exp(gl) * S + jnp.swapaxes(kc * jnp.exp(gl - G), -1, -2) @ delta
        return S, o

    s, o = lax.scan(step, s0.astype(jnp.float32), xs)
    return _unchunk(o, T), s.astype(s0.dtype)


def _causal_conv(u, buf, w):
    T = u.shape[1]
    up = jnp.concatenate([buf.astype(u.dtype), u], axis=1)
    out = sum(up[:, i:i + T] * w[i] for i in range(CONV_W))
    return out, up[:, -(CONV_W - 1):].astype(buf.dtype)


def _token_mixing(h, pos, lb_l, st, l, p):
    B, T, _ = h.shape
    f32 = jnp.float32
    ret_s, gla_s, hg_s, gdn_s, conv_s = st
    (rq, rk, rv, rg, aq, ak, av, alr, ag, hq, hf, hi, hg, dqkv, db, da, dg) = _split_cols(h @ p['w_in'][l])
    heads = lambda t: t.reshape(B, T, HEADS, -1)

    q = _rotary(heads(rq).astype(f32), pos)
    k = _rotary(heads(rk).astype(f32), pos) * RET_DK ** -0.5
    ret_decay = jnp.log(1.0 - 2.0 ** (-5.0 - jnp.arange(HEADS, dtype=f32)))
    g = jnp.broadcast_to(ret_decay[:, None], (B, T, HEADS, RET_DK))
    o_ret, ret_s = _gla_scan(q, k, heads(rv), g, ret_s)
    o_ret = _rms(o_ret) * jax.nn.silu(heads(rg).astype(f32))

    gk = jax.nn.log_sigmoid((alr @ p['gla_wg'][l] + p['gla_bg'][l]).astype(f32)) / GLA_GATE_NORM
    o_gla, gla_s = _gla_scan(heads(aq).astype(f32) * GLA_DK ** -0.5, heads(ak), heads(av), heads(gk), gla_s)
    o_gla = _rms(o_gla, p['gla_norm'][l]) * jax.nn.silu(heads(ag).astype(f32))

    zf = heads(hf.astype(f32))
    lbh = lb_l.reshape(HEADS, HG_DK)
    log_f = jnp.log(lbh + (1.0 - lbh) * jax.nn.sigmoid(zf))
    k_h = (1.0 - lbh) * jax.nn.sigmoid(-zf)
    q_h = jax.nn.silu(heads(hq).astype(f32)) * HG_DK ** -0.5
    o_hg, hg_s = _gla_scan(q_h, k_h, heads(hi), log_f, hg_s)
    o_hg = _rms(o_hg, p['hg_norm'][l]) * jax.nn.silu(heads(hg).astype(f32))

    u, conv_s = _causal_conv(dqkv, conv_s, p['gdn_conv'][l])
    u = jax.nn.silu(u)
    uq, uk, uv = jnp.split(u, [HEADS * GDN_DK, 2 * HEADS * GDN_DK], axis=-1)
    q_d = _l2norm(heads(uq)) * GDN_DK ** -0.5
    k_d = _l2norm(heads(uk))
    beta = jax.nn.sigmoid(db.astype(f32))
    g_d = -jnp.exp(p['gdn_a_log'][l].astype(f32)) * jax.nn.softplus(da.astype(f32) + p['gdn_dt_bias'][l].astype(f32))
    o_gdn, gdn_s = _gdn_scan(q_d, k_d, heads(uv), beta, g_d, gdn_s)
    o_gdn = _rms(o_gdn, p['gdn_norm'][l]) * jax.nn.silu(heads(dg).astype(f32))

    o = jnp.concatenate([t.reshape(B, T, -1) for t in (o_ret, o_gla, o_hg, o_gdn)], axis=-1).astype(h.dtype)
    return o @ p['w_out'][l], (ret_s, gla_s, hg_s, gdn_s, conv_s)


def _layer(x, c, pos, l, st, p, lb):
    mod = jax.nn.silu(c) @ p['ada_w'][l] + p['ada_b'][l]
    sh1, sc1, gt1, sh2, sc2, gt2, sh3, sc3, gt3 = jnp.split(mod[:, None, :], N_MOD, axis=-1)
    h = x * (1.0 + sc1) + sh1
    x = _layer_norm(ALPHA * x + 0.5 * (1.0 + gt1) * _swiglu(h, p['ffn1_wi'][l], p['ffn1_wo'][l]),
                    p['ln_g'][l, 0], p['ln_b'][l, 0])
    h = x * (1.0 + sc2) + sh2
    m, new_st = _token_mixing(h, pos, lb[l], st, l, p)
    x = _layer_norm(ALPHA * x + (1.0 + gt2) * m, p['ln_g'][l, 1], p['ln_b'][l, 1])
    h = x * (1.0 + sc3) + sh3
    x = _layer_norm(ALPHA * x + 0.5 * (1.0 + gt3) * _swiglu(h, p['ffn2_wi'][l], p['ffn2_wo'][l]),
                    p['ln_g'][l, 2], p['ln_b'][l, 2])
    return x, new_st


def _trunk(x, c, pos, states, p, lb):
    new = []
    for l in range(DEPTH):
        x, st = _layer(x, c, pos, l, tuple(s[l] for s in states), p, lb)
        new.append(st)
    return x, tuple(jnp.stack([n[i] for n in new]) for i in range(len(states)))


def setup_inputs(seed: int = 0) -> dict:
    key = jax.random.key(seed)
    ks = jax.random.split(key, 32)
    f32 = jnp.float32
    d = D_MODEL

    def nrm(k, shape, s):
        return jax.random.normal(k, shape, f32) * s

    u_a = jax.random.uniform(ks[26], (DEPTH, HEADS), f32, 1.0, 16.0)
    u_dt = jax.random.uniform(ks[27], (DEPTH, HEADS), f32)
    dt = jnp.exp(u_dt * (math.log(0.1) - math.log(0.001)) + math.log(0.001))
    return {
        'x_prompt': nrm(ks[0], (BATCH, SEQ, d), 1.0),
        'x_sample': nrm(ks[1], (DEC_BATCH, DEC_SEQ, d), 1.0),
        'state_ret': nrm(ks[2], (DEPTH, DEC_BATCH, HEADS, RET_DK, RET_DV), 0.5),
        'state_gla': nrm(ks[3], (DEPTH, DEC_BATCH, HEADS, GLA_DK, GLA_DV), 0.5),
        'state_hgrn': nrm(ks[4], (DEPTH, DEC_BATCH, HEADS, HG_DK, HG_DV), 0.5),
        'state_gdn': nrm(ks[5], (DEPTH, DEC_BATCH, HEADS, GDN_DK, GDN_DV), 0.5),
        'state_gdn_conv': nrm(ks[6], (DEPTH, DEC_BATCH, CONV_W - 1, GDN_CONV_CH), 1.0),
        'c_prompt': nrm(ks[7], (BATCH, d), 1.0),
        'c_sample': nrm(ks[8], (DEC_BATCH, d), 1.0),
        'ada_w': nrm(ks[9], (DEPTH, d, N_MOD * d), 0.1 * d ** -0.5),
        'ada_b': nrm(ks[10], (DEPTH, N_MOD * d), 0.02),
        'ln_g': 1.0 + nrm(ks[11], (DEPTH, 3, d), 0.02),
        'ln_b': nrm(ks[12], (DEPTH, 3, d), 0.02),
        'ffn1_wi': nrm(ks[13], (DEPTH, d, 2 * D_FF), d ** -0.5),
        'ffn1_wo': nrm(ks[14], (DEPTH, D_FF, d), D_FF ** -0.5 * DEEPNORM_BETA),
        'ffn2_wi': nrm(ks[15], (DEPTH, d, 2 * D_FF), d ** -0.5),
        'ffn2_wo': nrm(ks[16], (DEPTH, D_FF, d), D_FF ** -0.5 * DEEPNORM_BETA),
        'w_in': nrm(ks[17], (DEPTH, d, IN_COLS), d ** -0.5),
        'gla_wg': nrm(ks[18], (DEPTH, GLA_GATE_RANK, HEADS * GLA_DK), GLA_GATE_RANK ** -0.5),
        'gla_bg': nrm(ks[19], (DEPTH, HEADS * GLA_DK), 0.02),
        'hg_lb': nrm(ks[20], (DEPTH, HEADS * HG_DK), 0.5),
        'gdn_conv': nrm(ks[21], (DEPTH, CONV_W, GDN_CONV_CH), CONV_W ** -0.5),
        'gdn_a_log': jnp.log(u_a),
        'gdn_dt_bias': dt + jnp.log(-jnp.expm1(-dt)),
        'gla_norm': 1.0 + nrm(ks[22], (DEPTH, GLA_DV), 0.02),
        'hg_norm': 1.0 + nrm(ks[23], (DEPTH, HG_DV), 0.02),
        'gdn_norm': 1.0 + nrm(ks[24], (DEPTH, GDN_DV), 0.02),
        'w_out': nrm(ks[25], (DEPTH, MIX_WIDTH, d), MIX_WIDTH ** -0.5 * DEEPNORM_BETA),
    }


def reference(x_prompt, x_sample, state_ret, state_gla, state_hgrn, state_gdn, state_gdn_conv,
              c_prompt, c_sample, ada_w, ada_b, ln_g, ln_b, ffn1_wi, ffn1_wo, ffn2_wi, ffn2_wo,
              w_in, gla_wg, gla_bg, hg_lb, gdn_conv, gdn_a_log, gdn_dt_bias,
              gla_norm, hg_norm, gdn_norm, w_out):
    p = {'ada_w': ada_w, 'ada_b': ada_b, 'ln_g': ln_g, 'ln_b': ln_b,
         'ffn1_wi': ffn1_wi, 'ffn1_wo': ffn1_wo, 'ffn2_wi': ffn2_wi, 'ffn2_wo': ffn2_wo,
         'w_in': w_in, 'gla_wg': gla_wg, 'gla_bg': gla_bg, 'gdn_conv': gdn_conv,
         'gdn_a_log': gdn_a_log, 'gdn_dt_bias': gdn_dt_bias, 'gla_norm': gla_norm,
         'hg_norm': hg_norm, 'gdn_norm': gdn_norm, 'w_out': w_out}
    plb = jax.nn.softmax(hg_lb.astype(jnp.float32), axis=0)
    lb = jnp.cumsum(plb, axis=0) - plb[0]

    sample_states = (state_ret, state_gla, state_hgrn, state_gdn, state_gdn_conv)
    bp = x_prompt.shape[0]
    prompt_states = tuple(jnp.zeros((DEPTH, bp) + s.shape[2:], x_prompt.dtype) for s in sample_states)
    pos_p = jnp.arange(x_prompt.shape[1], dtype=jnp.float32)
    pos_s = PAST_LEN + jnp.arange(x_sample.shape[1], dtype=jnp.float32)

    y_prompt, (p_ret, p_gla, p_hg, p_gdn, p_conv) = _trunk(x_prompt, c_prompt, pos_p, prompt_states, p, lb)
    y_sample, (s_ret, s_gla, s_hg, s_gdn, s_conv) = _trunk(x_sample, c_sample, pos_s, sample_states, p, lb)
    return (y_prompt, y_sample, p_ret, p_gla, p_hg, p_gdn, p_conv, s_ret, s_gla, s_hg, s_gdn, s_conv)
```

```cpp
#include <hip/hip_runtime.h>
#include <hip/hip_cooperative_groups.h>
#include <cstdio>
#include <cstdint>
namespace cg = cooperative_groups;
namespace pg8 {
#define PG8_LAS __attribute__((address_space(3)))
typedef unsigned short bf16_t;
typedef short bf16x8 __attribute__((ext_vector_type(8)));
typedef float f32x4 __attribute__((ext_vector_type(4)));
typedef unsigned u32x4 __attribute__((ext_vector_type(4)));
constexpr int BM = 256, BK = 64, HALF = 128, HTB = HALF * BK * 2  , STAGE_BYTES = 8 * HTB, NXCD = 8, WGM = 8;

__host__ __device__ __forceinline__ int lds_byte(int r, int c) { const int st = (r >> 4) * 2 + (c >> 5), rr = r & 15, cc = c & 31, ob = rr * 64 + cc * 2; return st * 1024 + (ob ^ (((ob >> 9) & 1) << 5)); }
__host__ __device__ __forceinline__ void stage_rc(int b, int& R, int& C) { const int st = b / 1024, sb = b % 1024, swz = sb ^ (((sb >> 9) & 1) << 5); R = (st >> 1) * 16 + swz / 64; C = (st & 1) * 32 + (swz % 64) / 2; }
__host__ __device__ __forceinline__ int perm32(int rho) { const int n = rho >> 4, i = rho & 15; return 8 * (i >> 2) + 4 * n + (i & 3); }

struct Unit { int pm, pn; };
struct Gemm { const bf16_t* A; const bf16_t* Bt; int M, N, K; };

struct StaticOrder {
    int nM, nN, nwg, G, c;
    __host__ __device__ void init(int M, int N, int G_, int c_) { nM = M / BM; nN = N / BM; nwg = nM * nN; G = G_; c = c_; }
    __host__ __device__ bool next(int i, Unit& u) const {
        const long L = (long)i * G + c; if (L >= nwg) return false;
        int wgid = (int)L; { const int q = nwg / NXCD, r = nwg % NXCD, xcd = wgid % NXCD, off = wgid / NXCD; wgid = (xcd < r ? xcd * (q + 1) : r * (q + 1) + (xcd - r) * q) + off; }
        const int nig = WGM * nN, gid = wgid / nig, fm = gid * WGM, gsz = (nM - fm) < WGM ? (nM - fm) : WGM;
        u.pm = fm + ((wgid % nig) % gsz); u.pn = (wgid % nig) / gsz; return true;
    }
    __device__ __forceinline__ void a_ready(const Unit&) const {}
    __device__ __forceinline__ void done(const Unit&) const {}
};

__device__ __forceinline__ unsigned cvt_pk_bf16(float lo, float hi) { unsigned r; asm volatile("v_cvt_pk_bf16_f32 %0, %1, %2" : "=v"(r) : "v"(lo), "v"(hi)); return r; }
typedef float f32x2 __attribute__((ext_vector_type(2)));
__device__ __forceinline__ f32x2 gelu_pk(f32x2 v) {
    const f32x2 av = __builtin_elementwise_abs(v), d = av * 0.2316418882f + 1.0f;
    f32x2 t; t.x = __builtin_amdgcn_rcpf(d.x); t.y = __builtin_amdgcn_rcpf(d.y);
    f32x2 q = t * 0.5307027145f + (-0.7265760135f); q = q * t + 0.7107068705f; q = q * t + (-0.142248368f); q = q * t + 0.127414796f; q = q * t;
    const f32x2 s = (v * v) * (-0.72134752044f);
    f32x2 e; e.x = __builtin_amdgcn_exp2f(s.x); e.y = __builtin_amdgcn_exp2f(s.y);
    const f32x2 m = v * (q * e), r = v - m;
    f32x2 o; o.x = v.x < 0.f ? m.x : r.x; o.y = v.y < 0.f ? m.y : r.y; return o;
}

template <int ACT  > struct EpiBf16 {
    static constexpr bool PERM = true, AFTER_DRAIN = false; static_assert(ACT == 0 || ACT == 1, "EpiBf16: ACT is 0 (none) or 1 (gelu_pk)");
    bf16_t* O; int ldc; const float* bias; int split_cols; size_t split_stride; float scale0;
    __device__ __forceinline__ void operator()(const f32x4 (&acc)[2][2][4][2], const Unit& u, int wr, int wc, int fr, int fq) const {
        const int row0 = u.pm * BM + wr * 64 + fr; int colt = u.pn * BM; bf16_t* base = O;
        float sc = 1.f; if (split_cols) { const int t = colt / split_cols; base += (size_t)t * split_stride; colt -= t * split_cols; if (t == 0) sc = scale0; }
        const int col0 = colt + wc * 32 + 8 * fq, bcol0 = u.pn * BM + wc * 32 + 8 * fq;
        f32x4 bv[2][2];
#pragma unroll
        for (int bj = 0; bj < 2; ++bj)
#pragma unroll
            for (int n = 0; n < 2; ++n) bv[bj][n] = bias ? *(const f32x4*)(bias + bcol0 + bj * HALF + 4 * n) : (f32x4){0.f, 0.f, 0.f, 0.f};
#pragma unroll
        for (int ai = 0; ai < 2; ++ai)
#pragma unroll
            for (int m = 0; m < 4; ++m) { bf16_t* rowp = base + (size_t)(row0 + ai * HALF + m * 16) * ldc + col0;
#pragma unroll
                for (int bj = 0; bj < 2; ++bj) { f32x4 v0 = acc[ai][bj][m][0] + bv[bj][0], v1 = acc[ai][bj][m][1] + bv[bj][1];
                    if (ACT == 1) { f32x2 a = gelu_pk((f32x2){v0[0], v0[1]}), b = gelu_pk((f32x2){v0[2], v0[3]}), c = gelu_pk((f32x2){v1[0], v1[1]}), d = gelu_pk((f32x2){v1[2], v1[3]});
                        v0 = (f32x4){a.x, a.y, b.x, b.y}; v1 = (f32x4){c.x, c.y, d.x, d.y}; }
                    v0 = v0 * sc; v1 = v1 * sc; u32x4 w; w.x = cvt_pk_bf16(v0[0], v0[1]); w.y = cvt_pk_bf16(v0[2], v0[3]); w.z = cvt_pk_bf16(v1[0], v1[1]); w.w = cvt_pk_bf16(v1[2], v1[3]);
                    *(u32x4*)(rowp + bj * HALF) = w; } }
    }
};
template <class Epi, class Sched, bool ALIGN_EPI = false, bool SP2 = false>
__device__ __forceinline__ void gemm_phase(PG8_LAS unsigned char* lds, const Gemm g, const Sched& S, const Epi& E) {
    int tid_ = threadIdx.x; asm volatile("" : "+v"(tid_));
    const int tid = tid_, wid = __builtin_amdgcn_readfirstlane(tid >> 6), lane = tid & 63, wr = wid >> 2, wc = wid & 3, fr = lane & 15, fq = lane >> 4;
    const int K = g.K, nt = K / BK;
    unsigned voffA[2], voffB[2];
#pragma unroll
    for (int i = 0; i < 2; ++i) { int R, C; stage_rc(tid * 16 + i * 8192, R, C); const int Rb = Epi::PERM ? ((R & ~31) + perm32(R & 31)) : R;
        voffA[i] = (unsigned)(R * K + C) * 2u; voffB[i] = (unsigned)(Rb * K + C) * 2u; }
    const size_t kstep = (size_t)(BK * 2);
    const size_t hstep = (size_t)HALF * K * 2;
    const size_t tstep = 2 * hstep;
    const unsigned ldsw = (unsigned)wid * 1024u;
    const int aoff = lds_byte(wr * 64 + fr, fq * 8), boff = lds_byte(wc * 32 + fr, fq * 8);
#define PG8_SA(b, h) (((b) * 2 + (h)) * HTB)
#define PG8_SB(b, h) ((4 + (b) * 2 + (h)) * HTB)
#define PG8_STAGE(bufoff, gbase, voff) do { _Pragma("unroll") for (int _i = 0; _i < 2; ++_i) \
        __builtin_amdgcn_global_load_lds((const unsigned*)((const char*)(gbase) + (voff)[_i]), (PG8_LAS unsigned*)(lds + (bufoff) + ldsw + _i * 8192), 16, 0, 0); } while (0)
#define PG8_LDA(dst, b, h) do { _Pragma("unroll") for (int m = 0; m < 4; ++m) _Pragma("unroll") for (int k = 0; k < 2; ++k) dst[m][k] = *(const PG8_LAS bf16x8*)(lds + PG8_SA(b, h) + aoff + m * 2048 + k * 1024); } while (0)
#define PG8_LDB(dst, b, h) do { _Pragma("unroll") for (int n = 0; n < 2; ++n) _Pragma("unroll") for (int k = 0; k < 2; ++k) dst[n][k] = *(const PG8_LAS bf16x8*)(lds + PG8_SB(b, h) + boff + n * 2048 + k * 1024); } while (0)
#define PG8_MMA(ai, bj, At, Bt) do { __builtin_amdgcn_s_setprio(1); _Pragma("unroll") for (int m = 0; m < 4; ++m) _Pragma("unroll") for (int n = 0; n < 2; ++n) _Pragma("unroll") for (int k = 0; k < 2; ++k) \
        acc[ai][bj][m][n] = __builtin_amdgcn_mfma_f32_16x16x32_bf16(Bt[n][k], At[m][k], acc[ai][bj][m][n], 0, 0, 0); __builtin_amdgcn_s_setprio(0); } while (0)
#define PG8_WAIT_V(n) asm volatile("s_waitcnt vmcnt(" #n ")" ::: "memory")
#define PG8_WAIT_L(n) asm volatile("s_waitcnt lgkmcnt(" #n ")" ::: "memory")
#define PG8_BAR __builtin_amdgcn_s_barrier()
#define PG8_SCHED __builtin_amdgcn_sched_barrier(0)
    Unit cur, nxt; int ui = 0;
    if (!S.next(0, cur)) return;
    f32x4 acc[2][2][4][2];
#pragma unroll
    for (int a = 0; a < 2; ++a)
#pragma unroll
        for (int b = 0; b < 2; ++b)
#pragma unroll
            for (int m = 0; m < 4; ++m)
#pragma unroll
                for (int n = 0; n < 2; ++n) acc[a][b][m][n] = (f32x4){0.f, 0.f, 0.f, 0.f};
    bf16x8 At[4][2], B0[2][2], B1[2][2];
    const char* cA = (const char*)g.A + (size_t)cur.pm * tstep; const char* cB = (const char*)g.Bt + (size_t)cur.pn * tstep;
    S.a_ready(cur);
    if constexpr (SP2) {
        PG8_STAGE(PG8_SB(0, 0), cB, voffB); PG8_STAGE(PG8_SB(0, 1), cB + hstep, voffB); PG8_STAGE(PG8_SA(0, 0), cA, voffA); PG8_STAGE(PG8_SA(0, 1), cA + hstep, voffA);
        if (wr == 1) PG8_BAR;
        PG8_WAIT_V(2); PG8_BAR;
        PG8_STAGE(PG8_SB(1, 0), cB + kstep, voffB); PG8_STAGE(PG8_SA(1, 0), cA + kstep, voffA); PG8_STAGE(PG8_SB(1, 1), cB + hstep + kstep, voffB);
        PG8_WAIT_V(6); PG8_BAR;
    } else {
        PG8_STAGE(PG8_SB(0, 0), cB, voffB); PG8_STAGE(PG8_SA(0, 0), cA, voffA); PG8_STAGE(PG8_SB(0, 1), cB + hstep, voffB); PG8_STAGE(PG8_SA(0, 1), cA + hstep, voffA);
        if (wr == 1) PG8_BAR;
        PG8_WAIT_V(4); PG8_BAR;
        PG8_STAGE(PG8_SB(1, 0), cB + kstep, voffB); PG8_STAGE(PG8_SA(1, 0), cA + kstep, voffA); PG8_STAGE(PG8_SB(1, 1), cB + hstep + kstep, voffB);
        PG8_WAIT_V(6); PG8_BAR;
    }
    for (;;) {
        const bool has_next = S.next(ui + 1, nxt);
        const char* nA = has_next ? (const char*)g.A + (size_t)nxt.pm * tstep : cA; const char* nB = has_next ? (const char*)g.Bt + (size_t)nxt.pn * tstep : cB;
        for (int t = 0; t < nt; t += 2) {
            const bool last = (t == nt - 2);
            const char* a1 = cA + (size_t)(t + 1) * kstep;
            const char* a2 = last ? nA : cA + (size_t)(t + 2) * kstep; const char* b2 = last ? nB : cB + (size_t)(t + 2) * kstep;
            const char* a3 = a2 + kstep; const char* b3 = b2 + kstep;
            if (last && has_next) S.a_ready(nxt);
            if constexpr (SP2) {
            PG8_LDB(B0, 0, 0); PG8_LDB(B1, 0, 1); PG8_SCHED; PG8_LDA(At, 0, 0); PG8_STAGE(PG8_SA(1, 1), a1 + hstep, voffA);
            PG8_WAIT_V(8); PG8_WAIT_L(0); PG8_BAR; PG8_MMA(0, 0, At, B0); PG8_MMA(0, 1, At, B1); PG8_BAR; PG8_SCHED;
            PG8_LDA(At, 0, 1); PG8_STAGE(PG8_SB(0, 0), b2, voffB); PG8_STAGE(PG8_SB(0, 1), b2 + hstep, voffB); PG8_STAGE(PG8_SA(0, 0), a2, voffA);
            PG8_WAIT_V(8); PG8_WAIT_L(0); PG8_BAR; PG8_MMA(1, 0, At, B0); PG8_MMA(1, 1, At, B1); PG8_BAR; PG8_SCHED;
            PG8_LDB(B0, 1, 0); PG8_LDB(B1, 1, 1); PG8_SCHED; PG8_LDA(At, 1, 0); PG8_STAGE(PG8_SA(0, 1), a2 + hstep, voffA);
            PG8_WAIT_V(8); PG8_WAIT_L(0); PG8_BAR; PG8_MMA(0, 0, At, B0); PG8_MMA(0, 1, At, B1); PG8_BAR; PG8_SCHED;
            PG8_LDA(At, 1, 1); PG8_STAGE(PG8_SB(1, 0), b3, voffB); PG8_STAGE(PG8_SB(1, 1), b3 + hstep, voffB); PG8_STAGE(PG8_SA(1, 0), a3, voffA);
            PG8_WAIT_V(8); PG8_WAIT_L(0); PG8_BAR; PG8_MMA(1, 0, At, B0); PG8_MMA(1, 1, At, B1); PG8_BAR; PG8_SCHED;
            } else {
            PG8_LDB(B0, 0, 0); PG8_SCHED; PG8_LDA(At, 0, 0); PG8_STAGE(PG8_SA(1, 1), a1 + hstep, voffA);
            PG8_WAIT_L(8); PG8_BAR; PG8_WAIT_L(0); PG8_MMA(0, 0, At, B0); PG8_BAR; PG8_SCHED;
            PG8_LDB(B1, 0, 1); PG8_STAGE(PG8_SB(0, 0), b2, voffB);
            PG8_BAR; PG8_WAIT_L(0); PG8_MMA(0, 1, At, B1); PG8_BAR;
            PG8_LDA(At, 0, 1); PG8_STAGE(PG8_SA(0, 0), a2, voffA);
            PG8_BAR; PG8_WAIT_L(0); PG8_MMA(1, 0, At, B0); PG8_BAR; PG8_SCHED;
            PG8_STAGE(PG8_SB(0, 1), b2 + hstep, voffB);
            PG8_WAIT_V(6); PG8_BAR; PG8_MMA(1, 1, At, B1); PG8_BAR;
            PG8_LDB(B0, 1, 0); PG8_SCHED; PG8_LDA(At, 1, 0); PG8_STAGE(PG8_SA(0, 1), a2 + hstep, voffA);
            PG8_WAIT_L(8); PG8_BAR; PG8_WAIT_L(0); PG8_MMA(0, 0, At, B0); PG8_BAR; PG8_SCHED;
            PG8_LDB(B1, 1, 1); PG8_STAGE(PG8_SB(1, 0), b3, voffB);
            PG8_BAR; PG8_WAIT_L(0); PG8_MMA(0, 1, At, B1); PG8_BAR;
            PG8_LDA(At, 1, 1); PG8_STAGE(PG8_SA(1, 0), a3, voffA);
            PG8_BAR; PG8_WAIT_L(0); PG8_MMA(1, 0, At, B0); PG8_BAR; PG8_SCHED;
            PG8_STAGE(PG8_SB(1, 1), b3 + hstep, voffB);
            PG8_WAIT_V(6); PG8_BAR; PG8_MMA(1, 1, At, B1); PG8_BAR;
            }
        }
        if constexpr (ALIGN_EPI) { if (wr == 0) PG8_BAR; }
        if constexpr (!Epi::AFTER_DRAIN) { E(acc, cur, wr, wc, fr, fq); S.done(cur); }
        if (!has_next) break;
#pragma unroll
        for (int a = 0; a < 2; ++a)
#pragma unroll
            for (int b = 0; b < 2; ++b)
#pragma unroll
                for (int m = 0; m < 4; ++m)
#pragma unroll
                    for (int n = 0; n < 2; ++n) acc[a][b][m][n] = (f32x4){0.f, 0.f, 0.f, 0.f};
        cur = nxt; cA = nA; cB = nB; ++ui;
        if constexpr (ALIGN_EPI) { if (wr == 1) PG8_BAR; }
    }
    PG8_WAIT_V(0);
    if constexpr (!ALIGN_EPI) { if (wr == 0) PG8_BAR; }
    PG8_BAR;
    if constexpr (Epi::AFTER_DRAIN) { E.fused(acc, cur, wr, wc, fr, fq, lds, wid, lane); S.done(cur); }
#undef PG8_SA
#undef PG8_SB
#undef PG8_STAGE
#undef PG8_LDA
#undef PG8_LDB
#undef PG8_MMA
#undef PG8_WAIT_V
#undef PG8_WAIT_L
#undef PG8_BAR
#undef PG8_SCHED
}
}
#define PG8_SP2 true
#define PG8_ALIGN true

constexpr int D = 1024, TP = 2048, BP = 8, BS = 128, TS = 4;
constexpr int MP = BP * TP, MS = BS * TS, M = MP + MS;
constexpr int DFF = 2816, NWI = 2 * DFF, NIN = 3864, NINP = 4096, NMODC = 9216, NB = BP + BS;
constexpr int SBW = 1664, SFW = 392;
constexpr float LN_EPS = 1e-5f, RMS_EPS = 1e-6f;
constexpr float ALPHA = 1.41421356237f;
constexpr int C_RQ = 0, C_RK = 256, C_RV = 512, C_RG = 768, C_AQ = 1024, C_AK = 1152, C_AV = 1280, C_ALR = 1536, C_AG = 1552,
              C_HQ = 1808, C_HF = 2064, C_HI = 2320, C_HG = 2576, C_DQKV = 2832, C_DB = 3600, C_DA = 3604, C_DG = 3608;
constexpr int SB_RQ = 0, SB_RK = 256, SB_AQ = 512, SB_HQ = 640, SB_DQ = 896, SB_DK = 1152, SB_DV = 1408;
constexpr int SF_ADEC = 0, SF_HF = 128, SF_BETA = 384, SF_DDEC = 388;
constexpr size_t O_Y = 0;
constexpr size_t O_PRET = (size_t)M * D;
constexpr size_t O_PGLA = O_PRET + 2ull * BP * 4 * 64 * 64;
constexpr size_t O_PHG = O_PGLA + 2ull * BP * 4 * 32 * 64;
constexpr size_t O_PGDN = O_PHG + 2ull * BP * 4 * 64 * 64;
constexpr size_t O_PCONV = O_PGDN + 2ull * BP * 4 * 64 * 64;
constexpr size_t O_SRET = O_PCONV + 2ull * BP * 3 * 768;
constexpr size_t O_SGLA = O_SRET + 2ull * BS * 4 * 64 * 64;
constexpr size_t O_SHG = O_SGLA + 2ull * BS * 4 * 32 * 64;
constexpr size_t O_SGDN = O_SHG + 2ull * BS * 4 * 64 * 64;
constexpr size_t O_SCONV = O_SGDN + 2ull * BS * 4 * 64 * 64;
constexpr size_t O_END = O_SCONV + 2ull * BS * 3 * 768;

constexpr size_t MiB = 1u << 20;
constexpr size_t WS_ROPE = 1 * MiB;
constexpr size_t WS_AC = 2 * MiB;
constexpr size_t WS_MOD = 3 * MiB;
constexpr size_t WS_W = 13 * MiB;
constexpr size_t W_WI1 = 0, W_WO1 = 11 * MiB, W_WI2 = W_WO1 + 5 * MiB + MiB / 2, W_WO2 = W_WI2 + 11 * MiB, W_WIN = W_WO2 + 5 * MiB + MiB / 2, W_WOUT = W_WIN + 8 * MiB, W_LAYER = 43 * MiB;
constexpr size_t WS_H = WS_W + 2 * W_LAYER;
constexpr size_t WS_BIG = WS_H + 33 * MiB;
constexpr size_t WS_SB = WS_BIG + 132 * MiB;
constexpr size_t WS_SF = WS_SB + 54 * MiB;
constexpr size_t WS_END = WS_SF + 26 * MiB;
static_assert((size_t)M * SBW * 2 <= 54 * MiB && (size_t)M * SFW * 4 <= 26 * MiB && (size_t)M * 4096 * 2 <= 132 * MiB && (size_t)M * D * 2 <= 33 * MiB, "ws map");

constexpr int LDS_BYTES = 147456;
constexpr int NWAVES = 8;

#define GAS __attribute__((address_space(1)))
#define LAS __attribute__((address_space(3)))
typedef unsigned short bf16;
typedef unsigned v4u __attribute__((ext_vector_type(4)));
typedef unsigned v2u __attribute__((ext_vector_type(2)));
typedef float f32x4 __attribute__((ext_vector_type(4)));
typedef float f32x2 __attribute__((ext_vector_type(2)));
#define LDS_WAIT() asm volatile("s_waitcnt lgkmcnt(0)" ::: "memory")

__device__ __forceinline__ float bf2f(unsigned b) { return __uint_as_float(b << 16); }
__device__ __forceinline__ float bflo(unsigned w) { return __uint_as_float(w << 16); }
__device__ __forceinline__ float bfhi(unsigned w) { return __uint_as_float(w & 0xffff0000u); }
__device__ __forceinline__ unsigned pk2(float lo, float hi) { return pg8::cvt_pk_bf16(lo, hi); }
__device__ __forceinline__ float sigmoidf_(float x) { return 1.0f / (1.0f + __expf(-x)); }
__device__ __forceinline__ float siluf_(float x) { return x / (1.0f + __expf(-x)); }
__device__ __forceinline__ float wave_sum(float v) {
#pragma unroll
    for (int o = 1; o < 64; o <<= 1) v += __shfl_xor(v, o);
    return v;
}
template <int CTRL> __device__ __forceinline__ float dppmov(float v) { return __int_as_float(__builtin_amdgcn_update_dpp(0, __float_as_int(v), CTRL, 0xf, 0xf, true)); }
__device__ __forceinline__ float quad_sum(float v) { v += dppmov<0xB1>(v); v += dppmov<0x4E>(v); return v; }
__device__ __forceinline__ float row16_sum(float v) { v += dppmov<0xB1>(v); v += dppmov<0x4E>(v); v += dppmov<0x141>(v); v += dppmov<0x140>(v); return v; }

struct Args { const float* in[28]; float* out; unsigned char* ws; };

struct Ctx {
    int tid, lane, wave, gw, NGW;
    LAS unsigned char* lds;
    float* out; unsigned char* ws;
};
template <class T> __device__ __forceinline__ T* fresh_ptr(T* p) {
    unsigned lo = (unsigned)(uintptr_t)p, hi = (unsigned)((uintptr_t)p >> 32);
    asm volatile("" : "+v"(lo), "+v"(hi));
    lo = __builtin_amdgcn_readfirstlane(lo); hi = __builtin_amdgcn_readfirstlane(hi);
    return (T*)(((uintptr_t)hi << 32) | (uintptr_t)lo);
}
__device__ __forceinline__ Ctx make_ctx(const Args& args, LAS unsigned char* lds) {
    Ctx C; int t = threadIdx.x; asm volatile("" : "+v"(t));
    C.tid = t; C.lane = t & 63; C.wave = __builtin_amdgcn_readfirstlane(t >> 6);
    C.gw = (int)blockIdx.x * NWAVES + C.wave; C.NGW = (int)gridDim.x * NWAVES;
    float* op = fresh_ptr(args.out); unsigned char* wp = fresh_ptr(args.ws);
    C.lds = lds; C.out = op; C.ws = wp; return C;
}
__device__ __forceinline__ int batch_of_row(int r) { return r < MP ? (r >> 11) : BP + ((r - MP) >> 2); }

namespace pg8 {
struct EpiSwiglu {
    static constexpr bool PERM = true, AFTER_DRAIN = false;
    bf16_t* O; int ldc;
    __device__ __forceinline__ void operator()(const f32x4 (&acc)[2][2][4][2], const Unit& u, int wr, int wc, int fr, int fq) const {
        const int row0 = u.pm * BM + wr * 64 + fr, col0 = u.pn * 128 + wc * 32 + 8 * fq;
#pragma unroll
        for (int ai = 0; ai < 2; ++ai)
#pragma unroll
            for (int m = 0; m < 4; ++m) {
                bf16_t* rowp = O + (size_t)(row0 + ai * HALF + m * 16) * ldc + col0;
                float h[8];
#pragma unroll
                for (int n = 0; n < 2; ++n)
#pragma unroll
                    for (int j = 0; j < 4; ++j) {
                        const float a = acc[ai][0][m][n][j], b = acc[ai][1][m][n][j];
                        const float e = __builtin_amdgcn_exp2f(-1.44269504f * a);
                        h[n * 4 + j] = a * __builtin_amdgcn_rcpf(1.0f + e) * b;
                    }
                u32x4 w; w.x = cvt_pk_bf16(h[0], h[1]); w.y = cvt_pk_bf16(h[2], h[3]); w.z = cvt_pk_bf16(h[4], h[5]); w.w = cvt_pk_bf16(h[6], h[7]);
                *(u32x4*)rowp = w;
            }
    }
};
struct EpiPlain {
    static constexpr bool PERM = true, AFTER_DRAIN = false;
    bf16_t* O; int ldc;
    __device__ __forceinline__ void operator()(const f32x4 (&acc)[2][2][4][2], const Unit& u, int wr, int wc, int fr, int fq) const {
        const int row0 = u.pm * BM + wr * 64 + fr, col0 = u.pn * BM + wc * 32 + 8 * fq;
#pragma unroll
        for (int ai = 0; ai < 2; ++ai)
#pragma unroll
            for (int m = 0; m < 4; ++m) {
                bf16_t* rowp = O + (size_t)(row0 + ai * HALF + m * 16) * ldc + col0;
#pragma unroll
                for (int bj = 0; bj < 2; ++bj) { const f32x4 v0 = acc[ai][bj][m][0], v1 = acc[ai][bj][m][1];
                    u32x4 w; w.x = cvt_pk_bf16(v0[0], v0[1]); w.y = cvt_pk_bf16(v0[2], v0[3]); w.z = cvt_pk_bf16(v1[0], v1[1]); w.w = cvt_pk_bf16(v1[2], v1[3]);
                    *(u32x4*)(rowp + bj * HALF) = w; }
            }
    }
};
struct EpiRes {
    static constexpr bool PERM = false, AFTER_DRAIN = false;
    const float* resP; const float* resS; float* X; const float* gate; float alpha, scale;
    __device__ __forceinline__ void operator()(const f32x4 (&acc)[2][2][4][2], const Unit& u, int wr, int wc, int fr, int fq) const {
        const int col0 = u.pn * BM + wc * 32 + 4 * fq;
#pragma unroll
        for (int ai = 0; ai < 2; ++ai)
#pragma unroll
            for (int m = 0; m < 4; ++m) {
                const int r = u.pm * BM + ai * HALF + wr * 64 + m * 16 + fr;
                const int bi = r < 16384 ? (r >> 11) : 8 + ((r - 16384) >> 2);
                const float* rp = r < 16384 ? resP + (size_t)r * 1024 : resS + (size_t)(r - 16384) * 1024;
                const float* gp = gate + (size_t)bi * 9216;
                float* xo = X + (size_t)r * 1024;
#pragma unroll
                for (int bj = 0; bj < 2; ++bj)
#pragma unroll
                    for (int n = 0; n < 2; ++n) {
                        const int c = col0 + bj * HALF + n * 16;
                        const f32x4 rv = *(const f32x4*)(rp + c), gv = *(const f32x4*)(gp + c);
                        const f32x4 o = rv * alpha + (gv * scale + scale) * acc[ai][bj][m][n];
                        *(f32x4*)(xo + c) = o;
                    }
                asm volatile("" ::: "memory");
            }
    }
};
struct EpiMod {
    static constexpr bool PERM = false, AFTER_DRAIN = false;
    float* MODp; const float* ada_b;
    __device__ __forceinline__ void operator()(const f32x4 (&acc)[2][2][4][2], const Unit& u, int wr, int wc, int fr, int fq) const {
        const int col0 = u.pn * BM + wc * 32 + 4 * fq;
        const int l = (u.pn * BM) / 9216;
#pragma unroll
        for (int ai = 0; ai < 2; ++ai)
#pragma unroll
            for (int m = 0; m < 4; ++m) {
                const int r = u.pm * BM + ai * HALF + wr * 64 + m * 16 + fr;
                if (r < 136) {
#pragma unroll
                    for (int bj = 0; bj < 2; ++bj)
#pragma unroll
                        for (int n = 0; n < 2; ++n) {
                            const int c = col0 + bj * HALF + n * 16;
                            const f32x4 o = acc[ai][bj][m][n] + *(const f32x4*)(ada_b + c);
                            *(f32x4*)(MODp + (size_t)(l * 136 + r) * 9216 + (c - l * 9216)) = o;
                        }
                }
            }
    }
};
}

__device__ __forceinline__ void transpose_item(const float* W, int K, int N, bf16* WT, int dest_row0, LAS float* scr, int k0, int n0, int lane) {
    const int nn = n0 + (lane & 31); const bool ok = nn < N;
#pragma unroll 8
    for (int i = 0; i < 32; ++i) { const int kk = 2 * i + (lane >> 5); scr[kk * 33 + (lane & 31)] = ok ? W[(size_t)(k0 + kk) * N + nn] : 0.f; }
    LDS_WAIT();
    const int c = lane & 7;
#pragma unroll
    for (int j = 0; j < 4; ++j) { const int n = (lane >> 3) + 8 * j; const LAS float* s = scr + (8 * c) * 33 + n;
        v4u o; o.x = pk2(s[0 * 33], s[1 * 33]); o.y = pk2(s[2 * 33], s[3 * 33]); o.z = pk2(s[4 * 33], s[5 * 33]); o.w = pk2(s[6 * 33], s[7 * 33]);
        *(v4u*)(WT + (size_t)(dest_row0 + n) * K + k0 + 8 * c) = o; }
    LDS_WAIT();
}

__device__ __forceinline__ void p0_prologue(const Args& args, LAS unsigned char* lds_) {
    const Ctx C = make_ctx(args, lds_);
    LAS float* scr = (LAS float*)(C.lds + C.wave * 16384);
    constexpr int I_WI = 16 * 176, I_WO = 44 * 32, I_WIN = 16 * 121, I_WOUT = 16 * 32, I_ADA = 16 * 288;
    constexpr int I_LAYER = 2 * I_WI + 2 * I_WO + I_WIN + I_WOUT + I_ADA;
    for (int it = C.gw; it < 2 * I_LAYER; it += C.NGW) {
        const int l = it / I_LAYER; int r = it - l * I_LAYER;
        unsigned char* wl = C.ws + WS_W + (size_t)l * W_LAYER;
        if (r < 2 * (I_WI + I_WO)) {
            const int f = r / (I_WI + I_WO); r -= f * (I_WI + I_WO);
            if (r < I_WI) {
                const int kb = r / 176, nb = r % 176, n0 = nb * 32;
                const int half = n0 / DFF, j = n0 - half * DFF, t = j >> 7, jj = j & 127;
                transpose_item((f ? args.in[15] : args.in[13]) + (size_t)l * D * NWI, D, NWI, (bf16*)(wl + (f ? W_WI2 : W_WI1)), 256 * t + 128 * half + jj, scr, kb * 64, n0, C.lane);
            } else { r -= I_WI;
                const int kb = r / 32, nb = r % 32;
                transpose_item((f ? args.in[16] : args.in[14]) + (size_t)l * DFF * D, DFF, D, (bf16*)(wl + (f ? W_WO2 : W_WO1)), nb * 32, scr, kb * 64, nb * 32, C.lane);
            }
            continue;
        }
        r -= 2 * (I_WI + I_WO);
        if (r < I_WIN) { const int kb = r / 121, nb = r % 121;
            transpose_item(args.in[17] + (size_t)l * D * NIN, D, NIN, (bf16*)(wl + W_WIN), nb * 32, scr, kb * 64, nb * 32, C.lane); continue; }
        r -= I_WIN;
        if (r < I_WOUT) { const int kb = r / 32, nb = r % 32;
            transpose_item(args.in[27] + (size_t)l * D * D, D, D, (bf16*)(wl + W_WOUT), nb * 32, scr, kb * 64, nb * 32, C.lane); continue; }
        r -= I_WOUT;
        { const int kb = r / 288, nb = r % 288;
            transpose_item(args.in[9] + (size_t)l * D * NMODC, D, NMODC, (bf16*)(C.ws + WS_BIG), l * NMODC + nb * 32, scr, kb * 64, nb * 32, C.lane); }
    }
    const int gt = C.gw * 64 + C.lane, NGT = C.NGW * 64;
    for (int i = gt; i < 2 * 224 * 128; i += NGT) { const int l = i / (224 * 128), rr = (i / 128) % 224, ch = i & 127;
        *(v4u*)(C.ws + WS_W + (size_t)l * W_LAYER + W_WIN + ((size_t)(3872 + rr) * 1024 + ch * 8) * 2) = (v4u){0u, 0u, 0u, 0u}; }
    for (int i = gt; i < 256 * 256; i += NGT) { const int row = i >> 8, c4 = (i & 255) * 4;
        v2u o = (v2u){0u, 0u};
        if (row < NB) { const float* src = row < BP ? args.in[7] + (size_t)row * D : args.in[8] + (size_t)(row - BP) * D; const f32x4 v = *(const f32x4*)(src + c4);
            o.x = pk2(siluf_(v.x), siluf_(v.y)); o.y = pk2(siluf_(v.z), siluf_(v.w)); }
        *(v2u*)(C.ws + WS_AC + ((size_t)row * D + c4) * 2) = o; }
    for (int i = gt; i < 2052 * 32; i += NGT) { const int p = i >> 5, j = i & 31; const double pos = p < 2048 ? (double)p : (double)(16384 + (p - 2048));
        double inv = 1.0; for (int q = 0; q < j; ++q) inv *= 0.7498942093324559;
        const double ang = pos * inv; const double n = rint(ang * 0.15915494309189535);
        const float rr = (float)((ang - n * 6.283185307179586) - n * 2.4492935982947064e-16);
        ((f32x2*)(C.ws + WS_ROPE))[i] = (f32x2){__cosf(rr), __sinf(rr)}; }
}

__device__ __forceinline__ void p2_modulate0(const Args& args, LAS unsigned char* lds_) {
    const Ctx C = make_ctx(args, lds_);
    const float* MOD = (const float*)(C.ws + WS_MOD); bf16* H = (bf16*)(C.ws + WS_H);
    for (int r = C.gw; r < M; r += C.NGW) {
        const float* xr = r < MP ? args.in[0] + (size_t)r * D : args.in[1] + (size_t)(r - MP) * D;
        const float* modr = MOD + (size_t)batch_of_row(r) * NMODC;
#pragma unroll
        for (int j = 0; j < 4; ++j) { const int c = (C.lane + 64 * j) * 4;
            const f32x4 v = *(const f32x4*)(xr + c), sh = *(const f32x4*)(modr + c), sc = *(const f32x4*)(modr + 1024 + c);
            const f32x4 h = v * (sc + 1.0f) + sh;
            *(v2u*)(H + (size_t)r * D + c) = (v2u){pk2(h.x, h.y), pk2(h.z, h.w)}; }
    }
}

__device__ __forceinline__ void ln_phase(const Args& args, LAS unsigned char* lds_, int l, int which, bool write_h, int hl, int shc) {
    const Ctx C = make_ctx(args, lds_);
    const float* MOD = (const float*)(C.ws + WS_MOD); bf16* H = (bf16*)(C.ws + WS_H);
    const float* g = args.in[11] + (size_t)(l * 3 + which) * D; const float* b = args.in[12] + (size_t)(l * 3 + which) * D;
    for (int r = C.gw; r < M; r += C.NGW) {
        float* xr = C.out + (size_t)r * D;
        f32x4 v[4]; float s = 0.f;
#pragma unroll
        for (int j = 0; j < 4; ++j) { v[j] = *(const f32x4*)(xr + (C.lane + 64 * j) * 4); s += (v[j].x + v[j].y) + (v[j].z + v[j].w); }
        const float mean = wave_sum(s) * (1.f / D); float s2 = 0.f;
#pragma unroll
        for (int j = 0; j < 4; ++j) { v[j] = v[j] - mean; s2 += (v[j].x * v[j].x + v[j].y * v[j].y) + (v[j].z * v[j].z + v[j].w * v[j].w); }
        const float rstd = 1.f / sqrtf(wave_sum(s2) * (1.f / D) + LN_EPS);
        const float* modr = MOD + (size_t)(hl * NB + batch_of_row(r)) * NMODC + shc * 1024;
#pragma unroll
        for (int j = 0; j < 4; ++j) { const int c = (C.lane + 64 * j) * 4;
            const f32x4 xn = v[j] * rstd * *(const f32x4*)(g + c) + *(const f32x4*)(b + c);
            *(f32x4*)(xr + c) = xn;
            if (write_h) { const f32x4 sh = *(const f32x4*)(modr + c), sc = *(const f32x4*)(modr + 1024 + c); const f32x4 h = xn * (sc + 1.0f) + sh;
                *(v2u*)(H + (size_t)r * D + c) = (v2u){pk2(h.x, h.y), pk2(h.z, h.w)}; }
        }
    }
}

__device__ __forceinline__ void prep_phase(const Args& args, LAS unsigned char* lds_, int l) {
    const Ctx C = make_ctx(args, lds_);
    const bf16* PROJ = (const bf16*)(C.ws + WS_BIG); bf16* SB = (bf16*)(C.ws + WS_SB); float* SF = (float*)(C.ws + WS_SF);
    const f32x2* ROPE = (const f32x2*)(C.ws + WS_ROPE);
    const int lane = C.lane;
    const float* wg = args.in[18] + (size_t)l * 16 * 128; const float* bg = args.in[19] + (size_t)l * 128;
    const float* cw = args.in[21] + (size_t)l * 4 * 768;
    for (int r = C.gw; r < M; r += C.NGW) {
        const bool isp = r < MP; const int rs = r - MP;
        const int b = isp ? (r >> 11) : (rs >> 2), t = isp ? (r & 2047) : (rs & 3);
        const int ridx = isp ? t : 2048 + t;
        const bf16* P = PROJ + (size_t)r * NINP; bf16* sb = SB + (size_t)r * SBW; float* sf = SF + (size_t)r * SFW;
        { const int j = lane & 31; const bool hi = lane >= 32; const f32x2 cs = ROPE[ridx * 32 + j];
#pragma unroll
          for (int h = 0; h < 4; ++h) {
              const float q1 = bf2f(P[C_RQ + h * 64 + j]), q2 = bf2f(P[C_RQ + h * 64 + 32 + j]);
              const float k1 = bf2f(P[C_RK + h * 64 + j]), k2 = bf2f(P[C_RK + h * 64 + 32 + j]);
              const float qo = hi ? (q1 * cs.y + q2 * cs.x) : (q1 * cs.x - q2 * cs.y);
              const float ko = hi ? (k1 * cs.y + k2 * cs.x) : (k1 * cs.x - k2 * cs.y);
              sb[SB_RQ + h * 64 + lane] = (bf16)(pk2(qo, 0.f) & 0xffffu);
              sb[SB_RK + h * 64 + lane] = (bf16)(pk2(ko * 0.125f, 0.f) & 0xffffu);
          } }
        asm volatile("" ::: "memory");
        { float alr[16];
#pragma unroll
          for (int i = 0; i < 16; ++i) alr[i] = bf2f(P[C_ALR + i]);
#pragma unroll
          for (int hh = 0; hh < 2; ++hh) { const int c = lane + 64 * hh; float x = bg[c];
#pragma unroll
              for (int i = 0; i < 16; ++i) x += alr[i] * wg[i * 128 + c];
              const float sp = fmaxf(-x, 0.f) + log1pf(expf(-fabsf(x)));
              sf[SF_ADEC + c] = expf(-sp * (1.0f / 16.0f));
              sb[SB_AQ + c] = (bf16)(pk2(bf2f(P[C_AQ + c]) * 0.17677669529663687f, 0.f) & 0xffffu); } }
        asm volatile("" ::: "memory");
        {
#pragma unroll
          for (int i = 0; i < 4; ++i) { const int c = lane + 64 * i;
              float lbv = 0.f; if (l == 1) lbv = 1.0f / (1.0f + expf(args.in[20][c] - args.in[20][256 + c]));
              const float z = bf2f(P[C_HF + c]);
              sf[SF_HF + c] = lbv + (1.0f - lbv) * sigmoidf_(z);
              sb[SB_HQ + c] = (bf16)(pk2(siluf_(bf2f(P[C_HQ + c])) * 0.125f, 0.f) & 0xffffu); } }
        asm volatile("" ::: "memory");
        { const float* cst = args.in[6] + ((size_t)(l * BS + b) * 3) * 768;
          float* cso = isp ? C.out + O_PCONV + ((size_t)(l * BP + b) * 3) * 768 : C.out + O_SCONV + ((size_t)(l * BS + b) * 3) * 768;
          const int so = isp ? t - (TP - 3) : t - 1;
#pragma unroll 1
          for (int i = 0; i < 12; ++i) { const int ch = lane + 64 * i;
              const float x0 = bf2f(P[C_DQKV + ch]);
              float acc = x0 * cw[3 * 768 + ch];
#pragma unroll
              for (int k = 1; k < 4; ++k) { const int tt = t - k; float xv;
                  if (tt >= 0) xv = bf2f(P[C_DQKV + ch - k * NINP]); else xv = isp ? 0.f : cst[(3 + tt) * 768 + ch];
                  acc += xv * cw[(3 - k) * 768 + ch]; }
              const float uu = siluf_(acc);
              if (so >= 0) cso[so * 768 + ch] = x0;
              float sc = 1.0f;
              if (i < 8) { const float nn = wave_sum(uu * uu); sc = rsqrtf(nn + RMS_EPS) * (i < 4 ? 0.125f : 1.0f); }
              sb[SB_DQ + i * 64 + lane] = (bf16)(pk2(uu * sc, 0.f) & 0xffffu); }
          if (lane < 4) { const float db = bf2f(P[C_DB + lane]), da = bf2f(P[C_DA + lane]);
              sf[SF_BETA + lane] = sigmoidf_(db);
              const float xx = da + args.in[23][l * 4 + lane]; const float sp = fmaxf(xx, 0.f) + log1pf(expf(-fabsf(xx)));
              sf[SF_DDEC + lane] = expf(-expf(args.in[22][l * 4 + lane]) * sp); } }
    }
}

template <int KIND, int DH, int R> struct Raw { unsigned q[DH / 2]; unsigned k[DH / 2]; unsigned v[(R + 1) / 2]; float f[DH]; float be, de; };

template <int KIND, int DH, int R>
__device__ __forceinline__ void load_tok(Raw<KIND, DH, R>& x, const bf16* qp, const bf16* kp, const bf16* vp, const float* fp) {
    if constexpr (DH == 4) { const v2u w = *(const v2u*)qp; x.q[0] = w.x; x.q[1] = w.y; } else { x.q[0] = *(const unsigned*)qp; }
    if constexpr (KIND != 2) { if constexpr (DH == 4) { const v2u w = *(const v2u*)kp; x.k[0] = w.x; x.k[1] = w.y; } else { x.k[0] = *(const unsigned*)kp; } }
    if constexpr (R == 1) x.v[0] = *vp; else if constexpr (R == 2) x.v[0] = *(const unsigned*)vp; else { const v2u w = *(const v2u*)vp; x.v[0] = w.x; x.v[1] = w.y; }
    if constexpr (KIND == 1) { const f32x2 w = *(const f32x2*)fp; x.f[0] = w.x; x.f[1] = w.y; }
    if constexpr (KIND == 2) { const f32x4 w = *(const f32x4*)fp; x.f[0] = w.x; x.f[1] = w.y; x.f[2] = w.z; x.f[3] = w.w; }
    if constexpr (KIND == 3) { x.be = fp[0]; x.de = fp[4]; }
}

template <int KIND, int DH, int R>
__device__ __forceinline__ void scan_task(const Ctx& C, int row0, int T, int h, int slice, const float* sin, float* sout) {
    const bf16* PROJ = (const bf16*)(C.ws + WS_BIG); const bf16* SB = (const bf16*)(C.ws + WS_SB); const float* SF = (const float*)(C.ws + WS_SF);
    bf16* H = (bf16*)(C.ws + WS_H);
    const int lane = C.lane, dl = lane & 15, rw = lane >> 4;
    const int d0 = dl * DH, v0 = slice * (4 * R) + rw * R;
    constexpr int DK = 16 * DH;
    const bf16 *qp, *kp, *vp; const float* fp; int ks, vs;
    const bf16* sbr = SB + (size_t)row0 * SBW; const bf16* pr = PROJ + (size_t)row0 * NINP; const float* sfr = SF + (size_t)row0 * SFW;
    if constexpr (KIND == 0) { qp = sbr + SB_RQ + h * 64 + d0; kp = sbr + SB_RK + h * 64 + d0; ks = SBW; vp = pr + C_RV + h * 64 + v0; vs = NINP; fp = sfr; }
    if constexpr (KIND == 1) { qp = sbr + SB_AQ + h * 32 + d0; kp = pr + C_AK + h * 32 + d0; ks = NINP; vp = pr + C_AV + h * 64 + v0; vs = NINP; fp = sfr + SF_ADEC + h * 32 + d0; }
    if constexpr (KIND == 2) { qp = sbr + SB_HQ + h * 64 + d0; kp = sbr; ks = SBW; vp = pr + C_HI + h * 64 + v0; vs = NINP; fp = sfr + SF_HF + h * 64 + d0; }
    if constexpr (KIND == 3) { qp = sbr + SB_DQ + h * 64 + d0; kp = sbr + SB_DK + h * 64 + d0; ks = SBW; vp = sbr + SB_DV + h * 64 + v0; vs = SBW; fp = sfr + SF_BETA + h; }
    bf16* op = H + (size_t)row0 * D + KIND * 256 + h * 64 + v0;
    const float rdec = 1.0f - exp2f(-5.0f - (float)h);

    float S[DH][R];
#pragma unroll
    for (int dh = 0; dh < DH; ++dh)
#pragma unroll
        for (int vv = 0; vv < R; ++vv) S[dh][vv] = sin ? sin[(size_t)(d0 + dh) * 64 + v0 + vv] : 0.f;

    typedef Raw<KIND, DH, R> RawT;
    RawT A[4];
#pragma unroll
    for (int u = 0; u < 4; ++u) load_tok<KIND, DH, R>(A[u], qp + (size_t)u * SBW, kp + (size_t)u * ks, vp + (size_t)u * vs, fp + (size_t)u * SFW);
    for (int t0 = 0; t0 < T; t0 += 4) {
        RawT B[4];
        const bool more = t0 + 4 < T;
#pragma unroll
        for (int u = 0; u < 4; ++u) { B[u] = A[u]; }
        if (more) {
#pragma unroll
            for (int u = 0; u < 4; ++u) load_tok<KIND, DH, R>(B[u], qp + (size_t)(t0 + 4 + u) * SBW, kp + (size_t)(t0 + 4 + u) * ks, vp + (size_t)(t0 + 4 + u) * vs, fp + (size_t)(t0 + 4 + u) * SFW);
        }
#pragma unroll
        for (int u = 0; u < 4; ++u) {
            const RawT& x = A[u];
            float q[DH], k[DH], v[R];
            q[0] = bflo(x.q[0]); q[1] = bfhi(x.q[0]); if constexpr (DH == 4) { q[2] = bflo(x.q[1]); q[3] = bfhi(x.q[1]); }
            if constexpr (KIND != 2) { k[0] = bflo(x.k[0]); k[1] = bfhi(x.k[0]); if constexpr (DH == 4) { k[2] = bflo(x.k[1]); k[3] = bfhi(x.k[1]); } }
            if constexpr (R == 1) v[0] = bflo(x.v[0]);
            if constexpr (R >= 2) { v[0] = bflo(x.v[0]); v[1] = bfhi(x.v[0]); }
            if constexpr (R == 4) { v[2] = bflo(x.v[1]); v[3] = bfhi(x.v[1]); }
            float o[R];
            if constexpr (KIND == 3) {
                float ks_[R];
#pragma unroll
                for (int vv = 0; vv < R; ++vv) { float p = 0.f;
#pragma unroll
                    for (int dh = 0; dh < DH; ++dh) { S[dh][vv] *= x.de; p += k[dh] * S[dh][vv]; }
                    ks_[vv] = row16_sum(p); }
#pragma unroll
                for (int vv = 0; vv < R; ++vv) { const float uu = x.be * (v[vv] - ks_[vv]); float p = 0.f;
#pragma unroll
                    for (int dh = 0; dh < DH; ++dh) { S[dh][vv] += k[dh] * uu; p += q[dh] * S[dh][vv]; }
                    o[vv] = row16_sum(p); }
            } else {
#pragma unroll
                for (int dh = 0; dh < DH; ++dh) {
                    float dec, kk;
                    if constexpr (KIND == 0) { dec = rdec; kk = k[dh]; }
                    if constexpr (KIND == 1) { dec = x.f[dh]; kk = k[dh]; }
                    if constexpr (KIND == 2) { dec = x.f[dh]; kk = 1.0f - x.f[dh]; }
#pragma unroll
                    for (int vv = 0; vv < R; ++vv) S[dh][vv] = dec * S[dh][vv] + kk * v[vv];
                }
#pragma unroll
                for (int vv = 0; vv < R; ++vv) { float p = 0.f;
#pragma unroll
                    for (int dh = 0; dh < DH; ++dh) p += q[dh] * S[dh][vv];
                    o[vv] = row16_sum(p); }
            }
            if (dl == 0) {
                bf16* o_ = op + (size_t)(t0 + u) * D;
                if constexpr (R == 1) *o_ = (bf16)(pk2(o[0], 0.f) & 0xffffu);
                if constexpr (R == 2) *(unsigned*)o_ = pk2(o[0], o[1]);
                if constexpr (R == 4) *(v2u*)o_ = (v2u){pk2(o[0], o[1]), pk2(o[2], o[3])};
            }
        }
#pragma unroll
        for (int u = 0; u < 4; ++u) A[u] = B[u];
    }
#pragma unroll
    for (int dh = 0; dh < DH; ++dh)
#pragma unroll
        for (int vv = 0; vv < R; ++vv) sout[(size_t)(d0 + dh) * 64 + v0 + vv] = S[dh][vv];
    (void)DK;
}

__device__ __forceinline__ void scan_phase(const Args& args, LAS unsigned char* lds_, int l) {
    const Ctx C = make_ctx(args, lds_);
    constexpr int NLONG = 1152, NSHORT = BS * 144;
    const int slot = C.wave * 256 + (int)blockIdx.x;
    const int nidle = C.NGW - NLONG;
    for (int it = 0;; ++it) {
        int kind, b, h, slice, row0, T; bool isp;
        if (slot < NLONG) { if (it > 0) break; isp = true; T = TP;
            int i = slot;
            if (i < 512) { kind = 3; b = i >> 6; h = (i >> 4) & 3; slice = i & 15; }
            else if (i < 768) { i -= 512; kind = 0; b = i >> 5; h = (i >> 3) & 3; slice = i & 7; }
            else if (i < 1024) { i -= 768; kind = 2; b = i >> 5; h = (i >> 3) & 3; slice = i & 7; }
            else { i -= 1024; kind = 1; b = i >> 4; h = (i >> 2) & 3; slice = i & 3; }
            row0 = b * TP;
        } else { const int st = (slot - NLONG) + it * nidle; if (st >= NSHORT) break; isp = false; T = TS;
            b = st / 144; int i = st - b * 144;
            if (i < 64) { kind = 3; h = i >> 4; slice = i & 15; }
            else if (i < 96) { i -= 64; kind = 0; h = i >> 3; slice = i & 7; }
            else if (i < 128) { i -= 96; kind = 2; h = i >> 3; slice = i & 7; }
            else { i -= 128; kind = 1; h = i >> 2; slice = i & 3; }
            row0 = MP + b * TS;
        }
        const int nbat = isp ? BP : BS;
        const size_t sidx = (size_t)((l * nbat + b) * 4 + h);
        if (kind == 0) { scan_task<0, 4, 2>(C, row0, T, h, slice, isp ? nullptr : args.in[2] + sidx * 4096, C.out + (isp ? O_PRET : O_SRET) + sidx * 4096); }
        else if (kind == 1) { scan_task<1, 2, 4>(C, row0, T, h, slice, isp ? nullptr : args.in[3] + sidx * 2048, C.out + (isp ? O_PGLA : O_SGLA) + sidx * 2048); }
        else if (kind == 2) { scan_task<2, 4, 2>(C, row0, T, h, slice, isp ? nullptr : args.in[4] + sidx * 4096, C.out + (isp ? O_PHG : O_SHG) + sidx * 4096); }
        else { scan_task<3, 4, 1>(C, row0, T, h, slice, isp ? nullptr : args.in[5] + sidx * 4096, C.out + (isp ? O_PGDN : O_SGDN) + sidx * 4096); }
    }
}

__device__ __forceinline__ void post_phase(const Args& args, LAS unsigned char* lds_, int l) {
    const Ctx C = make_ctx(args, lds_);
    const bf16* PROJ = (const bf16*)(C.ws + WS_BIG); bf16* H = (bf16*)(C.ws + WS_H);
    const int lane = C.lane, mixer = lane >> 4, cc = (lane & 15) * 16;
    const int gbase = mixer == 0 ? C_RG : mixer == 1 ? C_AG : mixer == 2 ? C_HG : C_DG;
    const float* nw = mixer == 1 ? args.in[24] + l * 64 : mixer == 2 ? args.in[25] + l * 64 : args.in[26] + l * 64;
    float w[16];
#pragma unroll
    for (int i = 0; i < 16; ++i) w[i] = mixer == 0 ? 1.0f : nw[(cc + i) & 63];
    for (int r = C.gw; r < M; r += C.NGW) {
        bf16* hp = H + (size_t)r * D + lane * 16; const bf16* gp = PROJ + (size_t)r * NINP + gbase + cc;
        const v4u a0 = *(const v4u*)hp, a1 = *(const v4u*)(hp + 8);
        const v4u g0 = *(const v4u*)gp, g1 = *(const v4u*)(gp + 8);
        float y[16], g[16];
        const unsigned aw[8] = {a0.x, a0.y, a0.z, a0.w, a1.x, a1.y, a1.z, a1.w}, gw_[8] = {g0.x, g0.y, g0.z, g0.w, g1.x, g1.y, g1.z, g1.w};
        float ss = 0.f;
#pragma unroll
        for (int i = 0; i < 8; ++i) { y[2 * i] = bflo(aw[i]); y[2 * i + 1] = bfhi(aw[i]); g[2 * i] = bflo(gw_[i]); g[2 * i + 1] = bfhi(gw_[i]); ss += y[2 * i] * y[2 * i] + y[2 * i + 1] * y[2 * i + 1]; }
        ss = quad_sum(ss);
        const float rs = rsqrtf(ss * (1.0f / 64.0f) + RMS_EPS);
        unsigned ow[8];
#pragma unroll
        for (int i = 0; i < 8; ++i) ow[i] = pk2(y[2 * i] * rs * w[2 * i] * siluf_(g[2 * i]), y[2 * i + 1] * rs * w[2 * i + 1] * siluf_(g[2 * i + 1]));
        *(v4u*)hp = (v4u){ow[0], ow[1], ow[2], ow[3]}; *(v4u*)(hp + 8) = (v4u){ow[4], ow[5], ow[6], ow[7]};
    }
}

__global__ void __launch_bounds__(NWAVES * 64, 2) mega_fwd(Args args) {
    extern __shared__ __attribute__((aligned(16))) unsigned char lds[];
    cg::grid_group grid = cg::this_grid();
    LAS unsigned char* const LDSP = (LAS unsigned char*)lds;
    const int G = (int)gridDim.x, bx = (int)blockIdx.x;
#define FRESH() float* out_ = fresh_ptr(args.out); unsigned char* ws = fresh_ptr(args.ws); \
    float* MOD = (float*)(ws + WS_MOD); bf16* H = (bf16*)(ws + WS_H); bf16* BIG = (bf16*)(ws + WS_BIG); (void)MOD; (void)H; (void)BIG; (void)out_;

    p0_prologue(args, LDSP);
    grid.sync();
    {
        FRESH();
        pg8::Gemm g{(const bf16*)(ws + WS_AC), BIG, 256, 2 * NMODC, D}; pg8::StaticOrder S; S.init(256, 2 * NMODC, G, bx);
        pg8::EpiMod E{MOD, args.in[10]};
        pg8::gemm_phase<pg8::EpiMod, pg8::StaticOrder, PG8_ALIGN, PG8_SP2>(LDSP, g, S, E);
    }
    grid.sync();
    p2_modulate0(args, LDSP);
    grid.sync();
#pragma unroll 1
    for (int l = 0; l < 2; ++l) {
#pragma unroll 1
        for (int f = 0; f < 2; ++f) {
            if (f == 1) {
                {
                    FRESH();
                    pg8::Gemm g{H, (const bf16*)(ws + WS_W + (size_t)l * W_LAYER + W_WIN), M, NINP, D}; pg8::StaticOrder S; S.init(M, NINP, G, bx);
                    pg8::EpiPlain E{BIG, NINP};
                    pg8::gemm_phase<pg8::EpiPlain, pg8::StaticOrder, PG8_ALIGN, PG8_SP2>(LDSP, g, S, E);
                }
                grid.sync();
                prep_phase(args, LDSP, l);
                grid.sync();
                scan_phase(args, LDSP, l);
                grid.sync();
                post_phase(args, LDSP, l);
                grid.sync();
                {
                    FRESH();
                    pg8::Gemm g{H, (const bf16*)(ws + WS_W + (size_t)l * W_LAYER + W_WOUT), M, D, D}; pg8::StaticOrder S; S.init(M, D, G, bx);
                    pg8::EpiRes E{out_, out_ + (size_t)MP * D, out_, MOD + (size_t)l * NB * NMODC + 5 * 1024, ALPHA, 1.0f};
                    pg8::gemm_phase<pg8::EpiRes, pg8::StaticOrder, PG8_ALIGN, PG8_SP2>(LDSP, g, S, E);
                }
                grid.sync();
                ln_phase(args, LDSP, l, 1, true, l, 6);
                grid.sync();
            }
            {
                FRESH();
                pg8::Gemm g{H, (const bf16*)(ws + WS_W + (size_t)l * W_LAYER + (f ? W_WI2 : W_WI1)), M, NWI, D}; pg8::StaticOrder S; S.init(M, NWI, G, bx);
                pg8::EpiSwiglu E{BIG, DFF};
                pg8::gemm_phase<pg8::EpiSwiglu, pg8::StaticOrder, PG8_ALIGN, PG8_SP2>(LDSP, g, S, E);
            }
            grid.sync();
            {
                FRESH();
                const bool first = (l == 0 && f == 0);
                pg8::Gemm g{BIG, (const bf16*)(ws + WS_W + (size_t)l * W_LAYER + (f ? W_WO2 : W_WO1)), M, D, DFF}; pg8::StaticOrder S; S.init(M, D, G, bx);
                pg8::EpiRes E{first ? args.in[0] : out_, first ? args.in[1] : out_ + (size_t)MP * D, out_, MOD + (size_t)l * NB * NMODC + (f ? 8 : 2) * 1024, ALPHA, 0.5f};
                pg8::gemm_phase<pg8::EpiRes, pg8::StaticOrder, PG8_ALIGN, PG8_SP2>(LDSP, g, S, E);
            }
            grid.sync();
            if (f == 0) ln_phase(args, LDSP, l, 0, true, l, 3);
            else ln_phase(args, LDSP, l, 2, l == 0, 1, 0);
            if (!(l == 1 && f == 1)) grid.sync();
        }
    }
}

extern "C" void kernel_launch(void* const* d_in, const int* in_sizes, int n_in, void* d_out, int out_size, void* d_ws, size_t ws_size, hipStream_t stream) {
    static int grid = 0;
    if (grid == 0) {
        if (n_in != 28 || (size_t)out_size != O_END || ws_size < WS_END) { fprintf(stderr, "kernel_launch: unexpected sizes n_in %d out %d ws %zu (need %zu)\n", n_in, out_size, ws_size, (size_t)WS_END); grid = -1; return; }
        int dev = 0, cus = 0, per_cu = 0;
        hipGetDevice(&dev); hipDeviceGetAttribute(&cus, hipDeviceAttributeMultiprocessorCount, dev);
        hipFuncSetAttribute((const void*)mega_fwd, hipFuncAttributeMaxDynamicSharedMemorySize, LDS_BYTES);
        hipOccupancyMaxActiveBlocksPerMultiprocessor(&per_cu, (const void*)mega_fwd, NWAVES * 64, LDS_BYTES);
        (void)hipGetLastError();
        if (per_cu < 1 || cus < 256) { fprintf(stderr, "kernel_launch: occupancy %d cus %d\n", per_cu, cus); grid = -1; return; }
        grid = 256;
    }
    if (grid < 0) return;
    Args a{};
    for (int i = 0; i < 28; ++i) a.in[i] = (const float*)d_in[i];
    a.out = (float*)d_out; a.ws = (unsigned char*)d_ws;
    void* kargs[] = {&a};
    hipError_t e = hipLaunchCooperativeKernel((const void*)mega_fwd, dim3(grid), dim3(NWAVES * 64), kargs, LDS_BYTES, stream);
    if (e != hipSuccess) fprintf(stderr, "cooperative launch failed: %s\n", hipGetErrorString(e));
}
```

```cpp
#include <hip/hip_runtime.h>
#include <hip/hip_cooperative_groups.h>
#include <cstdio>
#include <cstdint>
namespace cg = cooperative_groups;
namespace pg8 {
#define PG8_LAS __attribute__((address_space(3)))
typedef unsigned short bf16_t;
typedef short bf16x8 __attribute__((ext_vector_type(8)));
typedef float f32x4 __attribute__((ext_vector_type(4)));
typedef unsigned u32x4 __attribute__((ext_vector_type(4)));
constexpr int BM = 256, BK = 64, HALF = 128, HTB = HALF * BK * 2  , STAGE_BYTES = 8 * HTB, NXCD = 8, WGM = 8;

__host__ __device__ __forceinline__ int lds_byte(int r, int c) { const int st = (r >> 4) * 2 + (c >> 5), rr = r & 15, cc = c & 31, ob = rr * 64 + cc * 2; return st * 1024 + (ob ^ (((ob >> 9) & 1) << 5)); }
__host__ __device__ __forceinline__ void stage_rc(int b, int& R, int& C) { const int st = b / 1024, sb = b % 1024, swz = sb ^ (((sb >> 9) & 1) << 5); R = (st >> 1) * 16 + swz / 64; C = (st & 1) * 32 + (swz % 64) / 2; }
__host__ __device__ __forceinline__ int perm32(int rho) { const int n = rho >> 4, i = rho & 15; return 8 * (i >> 2) + 4 * n + (i & 3); }

struct Unit { int pm, pn; };
struct Gemm { const bf16_t* A; const bf16_t* Bt; int M, N, K; };

struct StaticOrder {
    int nM, nN, nwg, G, c;
    __host__ __device__ void init(int M, int N, int G_, int c_) { nM = M / BM; nN = N / BM; nwg = nM * nN; G = G_; c = c_; }
    __host__ __device__ bool next(int i, Unit& u) const {
        const long L = (long)i * G + c; if (L >= nwg) return false;
        int wgid = (int)L; { const int q = nwg / NXCD, r = nwg % NXCD, xcd = wgid % NXCD, off = wgid / NXCD; wgid = (xcd < r ? xcd * (q + 1) : r * (q + 1) + (xcd - r) * q) + off; }
        const int nig = WGM * nN, gid = wgid / nig, fm = gid * WGM, gsz = (nM - fm) < WGM ? (nM - fm) : WGM;
        u.pm = fm + ((wgid % nig) % gsz); u.pn = (wgid % nig) / gsz; return true;
    }
    __device__ __forceinline__ void a_ready(const Unit&) const {}
    __device__ __forceinline__ void done(const Unit&) const {}
};

__device__ __forceinline__ unsigned cvt_pk_bf16(float lo, float hi) { unsigned r; asm volatile("v_cvt_pk_bf16_f32 %0, %1, %2" : "=v"(r) : "v"(lo), "v"(hi)); return r; }
typedef float f32x2 __attribute__((ext_vector_type(2)));
__device__ __forceinline__ f32x2 gelu_pk(f32x2 v) {
    const f32x2 av = __builtin_elementwise_abs(v), d = av * 0.2316418882f + 1.0f;
    f32x2 t; t.x = __builtin_amdgcn_rcpf(d.x); t.y = __builtin_amdgcn_rcpf(d.y);
    f32x2 q = t * 0.5307027145f + (-0.7265760135f); q = q * t + 0.7107068705f; q = q * t + (-0.142248368f); q = q * t + 0.127414796f; q = q * t;
    const f32x2 s = (v * v) * (-0.72134752044f);
    f32x2 e; e.x = __builtin_amdgcn_exp2f(s.x); e.y = __builtin_amdgcn_exp2f(s.y);
    const f32x2 m = v * (q * e), r = v - m;
    f32x2 o; o.x = v.x < 0.f ? m.x : r.x; o.y = v.y < 0.f ? m.y : r.y; return o;
}

template <int ACT  > struct EpiBf16 {
    static constexpr bool PERM = true, AFTER_DRAIN = false; static_assert(ACT == 0 || ACT == 1, "EpiBf16: ACT is 0 (none) or 1 (gelu_pk)");
    bf16_t* O; int ldc; const float* bias; int split_cols; size_t split_stride; float scale0;
    __device__ __forceinline__ void operator()(const f32x4 (&acc)[2][2][4][2], const Unit& u, int wr, int wc, int fr, int fq) const {
        const int row0 = u.pm * BM + wr * 64 + fr; int colt = u.pn * BM; bf16_t* base = O;
        float sc = 1.f; if (split_cols) { const int t = colt / split_cols; base += (size_t)t * split_stride; colt -= t * split_cols; if (t == 0) sc = scale0; }
        const int col0 = colt + wc * 32 + 8 * fq, bcol0 = u.pn * BM + wc * 32 + 8 * fq;
        f32x4 bv[2][2];
#pragma unroll
        for (int bj = 0; bj < 2; ++bj)
#pragma unroll
            for (int n = 0; n < 2; ++n) bv[bj][n] = bias ? *(const f32x4*)(bias + bcol0 + bj * HALF + 4 * n) : (f32x4){0.f, 0.f, 0.f, 0.f};
#pragma unroll
        for (int ai = 0; ai < 2; ++ai)
#pragma unroll
            for (int m = 0; m < 4; ++m) { bf16_t* rowp = base + (size_t)(row0 + ai * HALF + m * 16) * ldc + col0;
#pragma unroll
                for (int bj = 0; bj < 2; ++bj) { f32x4 v0 = acc[ai][bj][m][0] + bv[bj][0], v1 = acc[ai][bj][m][1] + bv[bj][1];
                    if (ACT == 1) { f32x2 a = gelu_pk((f32x2){v0[0], v0[1]}), b = gelu_pk((f32x2){v0[2], v0[3]}), c = gelu_pk((f32x2){v1[0], v1[1]}), d = gelu_pk((f32x2){v1[2], v1[3]});
                        v0 = (f32x4){a.x, a.y, b.x, b.y}; v1 = (f32x4){c.x, c.y, d.x, d.y}; }
                    v0 = v0 * sc; v1 = v1 * sc; u32x4 w; w.x = cvt_pk_bf16(v0[0], v0[1]); w.y = cvt_pk_bf16(v0[2], v0[3]); w.z = cvt_pk_bf16(v1[0], v1[1]); w.w = cvt_pk_bf16(v1[2], v1[3]);
                    *(u32x4*)(rowp + bj * HALF) = w; } }
    }
};
template <class Epi, class Sched, bool ALIGN_EPI = false, bool SP2 = false>
__device__ __forceinline__ void gemm_phase(PG8_LAS unsigned char* lds, const Gemm g, const Sched& S, const Epi& E) {
    int tid_ = threadIdx.x; asm volatile("" : "+v"(tid_));
    const int tid = tid_, wid = __builtin_amdgcn_readfirstlane(tid >> 6), lane = tid & 63, wr = wid >> 2, wc = wid & 3, fr = lane & 15, fq = lane >> 4;
    const int K = g.K, nt = K / BK;
    unsigned voffA[2], voffB[2];
#pragma unroll
    for (int i = 0; i < 2; ++i) { int R, C; stage_rc(tid * 16 + i * 8192, R, C); const int Rb = Epi::PERM ? ((R & ~31) + perm32(R & 31)) : R;
        voffA[i] = (unsigned)(R * K + C) * 2u; voffB[i] = (unsigned)(Rb * K + C) * 2u; }
    const size_t kstep = (size_t)(BK * 2);
    const size_t hstep = (size_t)HALF * K * 2;
    const size_t tstep = 2 * hstep;
    const unsigned ldsw = (unsigned)wid * 1024u;
    const int aoff = lds_byte(wr * 64 + fr, fq * 8), boff = lds_byte(wc * 32 + fr, fq * 8);
#define PG8_SA(b, h) (((b) * 2 + (h)) * HTB)
#define PG8_SB(b, h) ((4 + (b) * 2 + (h)) * HTB)
#define PG8_STAGE(bufoff, gbase, voff) do { _Pragma("unroll") for (int _i = 0; _i < 2; ++_i) \
        __builtin_amdgcn_global_load_lds((const unsigned*)((const char*)(gbase) + (voff)[_i]), (PG8_LAS unsigned*)(lds + (bufoff) + ldsw + _i * 8192), 16, 0, 0); } while (0)
#define PG8_LDA(dst, b, h) do { _Pragma("unroll") for (int m = 0; m < 4; ++m) _Pragma("unroll") for (int k = 0; k < 2; ++k) dst[m][k] = *(const PG8_LAS bf16x8*)(lds + PG8_SA(b, h) + aoff + m * 2048 + k * 1024); } while (0)
#define PG8_LDB(dst, b, h) do { _Pragma("unroll") for (int n = 0; n < 2; ++n) _Pragma("unroll") for (int k = 0; k < 2; ++k) dst[n][k] = *(const PG8_LAS bf16x8*)(lds + PG8_SB(b, h) + boff + n * 2048 + k * 1024); } while (0)
#define PG8_MMA(ai, bj, At, Bt) do { __builtin_amdgcn_s_setprio(1); _Pragma("unroll") for (int m = 0; m < 4; ++m) _Pragma("unroll") for (int n = 0; n < 2; ++n) _Pragma("unroll") for (int k = 0; k < 2; ++k) \
        acc[ai][bj][m][n] = __builtin_amdgcn_mfma_f32_16x16x32_bf16(Bt[n][k], At[m][k], acc[ai][bj][m][n], 0, 0, 0); __builtin_amdgcn_s_setprio(0); } while (0)
#define PG8_WAIT_V(n) asm volatile("s_waitcnt vmcnt(" #n ")" ::: "memory")
#define PG8_WAIT_L(n) asm volatile("s_waitcnt lgkmcnt(" #n ")" ::: "memory")
#define PG8_BAR __builtin_amdgcn_s_barrier()
#define PG8_SCHED __builtin_amdgcn_sched_barrier(0)
    Unit cur, nxt; int ui = 0;
    if (!S.next(0, cur)) return;
    f32x4 acc[2][2][4][2];
#pragma unroll
    for (int a = 0; a < 2; ++a)
#pragma unroll
        for (int b = 0; b < 2; ++b)
#pragma unroll
            for (int m = 0; m < 4; ++m)
#pragma unroll
                for (int n = 0; n < 2; ++n) acc[a][b][m][n] = (f32x4){0.f, 0.f, 0.f, 0.f};
    bf16x8 At[4][2], B0[2][2], B1[2][2];
    const char* cA = (const char*)g.A + (size_t)cur.pm * tstep; const char* cB = (const char*)g.Bt + (size_t)cur.pn * tstep;
    S.a_ready(cur);
    if constexpr (SP2) {
        PG8_STAGE(PG8_SB(0, 0), cB, voffB); PG8_STAGE(PG8_SB(0, 1), cB + hstep, voffB); PG8_STAGE(PG8_SA(0, 0), cA, voffA); PG8_STAGE(PG8_SA(0, 1), cA + hstep, voffA);
        if (wr == 1) PG8_BAR;
        PG8_WAIT_V(2); PG8_BAR;
        PG8_STAGE(PG8_SB(1, 0), cB + kstep, voffB); PG8_STAGE(PG8_SA(1, 0), cA + kstep, voffA); PG8_STAGE(PG8_SB(1, 1), cB + hstep + kstep, voffB);
        PG8_WAIT_V(6); PG8_BAR;
    } else {
        PG8_STAGE(PG8_SB(0, 0), cB, voffB); PG8_STAGE(PG8_SA(0, 0), cA, voffA); PG8_STAGE(PG8_SB(0, 1), cB + hstep, voffB); PG8_STAGE(PG8_SA(0, 1), cA + hstep, voffA);
        if (wr == 1) PG8_BAR;
        PG8_WAIT_V(4); PG8_BAR;
        PG8_STAGE(PG8_SB(1, 0), cB + kstep, voffB); PG8_STAGE(PG8_SA(1, 0), cA + kstep, voffA); PG8_STAGE(PG8_SB(1, 1), cB + hstep + kstep, voffB);
        PG8_WAIT_V(6); PG8_BAR;
    }
    for (;;) {
        const bool has_next = S.next(ui + 1, nxt);
        const char* nA = has_next ? (const char*)g.A + (size_t)nxt.pm * tstep : cA; const char* nB = has_next ? (const char*)g.Bt + (size_t)nxt.pn * tstep : cB;
        for (int t = 0; t < nt; t += 2) {
            const bool last = (t == nt - 2);
            const char* a1 = cA + (size_t)(t + 1) * kstep;
            const char* a2 = last ? nA : cA + (size_t)(t + 2) * kstep; const char* b2 = last ? nB : cB + (size_t)(t + 2) * kstep;
            const char* a3 = a2 + kstep; const char* b3 = b2 + kstep;
            if (last && has_next) S.a_ready(nxt);
            if constexpr (SP2) {
            PG8_LDB(B0, 0, 0); PG8_LDB(B1, 0, 1); PG8_SCHED; PG8_LDA(At, 0, 0); PG8_STAGE(PG8_SA(1, 1), a1 + hstep, voffA);
            PG8_WAIT_V(8); PG8_WAIT_L(0); PG8_BAR; PG8_MMA(0, 0, At, B0); PG8_MMA(0, 1, At, B1); PG8_BAR; PG8_SCHED;
            PG8_LDA(At, 0, 1); PG8_STAGE(PG8_SB(0, 0), b2, voffB); PG8_STAGE(PG8_SB(0, 1), b2 + hstep, voffB); PG8_STAGE(PG8_SA(0, 0), a2, voffA);
            PG8_WAIT_V(8); PG8_WAIT_L(0); PG8_BAR; PG8_MMA(1, 0, At, B0); PG8_MMA(1, 1, At, B1); PG8_BAR; PG8_SCHED;
            PG8_LDB(B0, 1, 0); PG8_LDB(B1, 1, 1); PG8_SCHED; PG8_LDA(At, 1, 0); PG8_STAGE(PG8_SA(0, 1), a2 + hstep, voffA);
            PG8_WAIT_V(8); PG8_WAIT_L(0); PG8_BAR; PG8_MMA(0, 0, At, B0); PG8_MMA(0, 1, At, B1); PG8_BAR; PG8_SCHED;
            PG8_LDA(At, 1, 1); PG8_STAGE(PG8_SB(1, 0), b3, voffB); PG8_STAGE(PG8_SB(1, 1), b3 + hstep, voffB); PG8_STAGE(PG8_SA(1, 0), a3, voffA);
            PG8_WAIT_V(8); PG8_WAIT_L(0); PG8_BAR; PG8_MMA(1, 0, At, B0); PG8_MMA(1, 1, At, B1); PG8_BAR; PG8_SCHED;
            } else {
            PG8_LDB(B0, 0, 0); PG8_SCHED; PG8_LDA(At, 0, 0); PG8_STAGE(PG8_SA(1, 1), a1 + hstep, voffA);
            PG8_WAIT_L(8); PG8_BAR; PG8_WAIT_L(0); PG8_MMA(0, 0, At, B0); PG8_BAR; PG8_SCHED;
            PG8_LDB(B1, 0, 1); PG8_STAGE(PG8_SB(0, 0), b2, voffB);
            PG8_BAR; PG8_WAIT_L(0); PG8_MMA(0, 1, At, B1); PG8_BAR;
            PG8_LDA(At, 0, 1); PG8_STAGE(PG8_SA(0, 0), a2, voffA);
            PG8_BAR; PG8_WAIT_L(0); PG8_MMA(1, 0, At, B0); PG8_BAR; PG8_SCHED;
            PG8_STAGE(PG8_SB(0, 1), b2 + hstep, voffB);
            PG8_WAIT_V(6); PG8_BAR; PG8_MMA(1, 1, At, B1); PG8_BAR;
            PG8_LDB(B0, 1, 0); PG8_SCHED; PG8_LDA(At, 1, 0); PG8_STAGE(PG8_SA(0, 1), a2 + hstep, voffA);
            PG8_WAIT_L(8); PG8_BAR; PG8_WAIT_L(0); PG8_MMA(0, 0, At, B0); PG8_BAR; PG8_SCHED;
            PG8_LDB(B1, 1, 1); PG8_STAGE(PG8_SB(1, 0), b3, voffB);
            PG8_BAR; PG8_WAIT_L(0); PG8_MMA(0, 1, At, B1); PG8_BAR;
            PG8_LDA(At, 1, 1); PG8_STAGE(PG8_SA(1, 0), a3, voffA);
            PG8_BAR; PG8_WAIT_L(0); PG8_MMA(1, 0, At, B0); PG8_BAR; PG8_SCHED;
            PG8_STAGE(PG8_SB(1, 1), b3 + hstep, voffB);
            PG8_WAIT_V(6); PG8_BAR; PG8_MMA(1, 1, At, B1); PG8_BAR;
            }
        }
        if constexpr (ALIGN_EPI) { if (wr == 0) PG8_BAR; }
        if constexpr (!Epi::AFTER_DRAIN) { E(acc, cur, wr, wc, fr, fq); S.done(cur); }
        if (!has_next) break;
#pragma unroll
        for (int a = 0; a < 2; ++a)
#pragma unroll
            for (int b = 0; b < 2; ++b)
#pragma unroll
                for (int m = 0; m < 4; ++m)
#pragma unroll
                    for (int n = 0; n < 2; ++n) acc[a][b][m][n] = (f32x4){0.f, 0.f, 0.f, 0.f};
        cur = nxt; cA = nA; cB = nB; ++ui;
        if constexpr (ALIGN_EPI) { if (wr == 1) PG8_BAR; }
    }
    PG8_WAIT_V(0);
    if constexpr (!ALIGN_EPI) { if (wr == 0) PG8_BAR; }
    PG8_BAR;
    if constexpr (Epi::AFTER_DRAIN) { E.fused(acc, cur, wr, wc, fr, fq, lds, wid, lane); S.done(cur); }
#undef PG8_SA
#undef PG8_SB
#undef PG8_STAGE
#undef PG8_LDA
#undef PG8_LDB
#undef PG8_MMA
#undef PG8_WAIT_V
#undef PG8_WAIT_L
#undef PG8_BAR
#undef PG8_SCHED
}
}
#define PG8_SP2 true
#define PG8_ALIGN true

constexpr int D = 1024, TP = 2048, BP = 8, BS = 128, TS = 4;
constexpr int MP = BP * TP, MS = BS * TS, M = MP + MS;
constexpr int DFF = 2816, NWI = 2 * DFF, NIN = 3864, NINP = 4096, NMODC = 9216, NB = BP + BS;
constexpr int SBW = 1664, SFW = 392;
constexpr float LN_EPS = 1e-5f, RMS_EPS = 1e-6f;
constexpr float ALPHA = 1.41421356237f;
constexpr int C_RQ = 0, C_RK = 256, C_RV = 512, C_RG = 768, C_AQ = 1024, C_AK = 1152, C_AV = 1280, C_ALR = 1536, C_AG = 1552,
              C_HQ = 1808, C_HF = 2064, C_HI = 2320, C_HG = 2576, C_DQKV = 2832, C_DB = 3600, C_DA = 3604, C_DG = 3608;
constexpr int SB_RQ = 0, SB_RK = 256, SB_AQ = 512, SB_HQ = 640, SB_DQ = 896, SB_DK = 1152, SB_DV = 1408;
constexpr int SF_ADEC = 0, SF_HF = 128, SF_BETA = 384, SF_DDEC = 388;
constexpr size_t O_Y = 0;
constexpr size_t O_PRET = (size_t)M * D;
constexpr size_t O_PGLA = O_PRET + 2ull * BP * 4 * 64 * 64;
constexpr size_t O_PHG = O_PGLA + 2ull * BP * 4 * 32 * 64;
constexpr size_t O_PGDN = O_PHG + 2ull * BP * 4 * 64 * 64;
constexpr size_t O_PCONV = O_PGDN + 2ull * BP * 4 * 64 * 64;
constexpr size_t O_SRET = O_PCONV + 2ull * BP * 3 * 768;
constexpr size_t O_SGLA = O_SRET + 2ull * BS * 4 * 64 * 64;
constexpr size_t O_SHG = O_SGLA + 2ull * BS * 4 * 32 * 64;
constexpr size_t O_SGDN = O_SHG + 2ull * BS * 4 * 64 * 64;
constexpr size_t O_SCONV = O_SGDN + 2ull * BS * 4 * 64 * 64;
constexpr size_t O_END = O_SCONV + 2ull * BS * 3 * 768;

constexpr size_t MiB = 1u << 20;
constexpr size_t WS_ROPE = 1 * MiB;
constexpr size_t WS_AC = 2 * MiB;
constexpr size_t WS_MOD = 3 * MiB;
constexpr size_t WS_W = 13 * MiB;
constexpr size_t W_WI1 = 0, W_WO1 = 11 * MiB, W_WI2 = W_WO1 + 5 * MiB + MiB / 2, W_WO2 = W_WI2 + 11 * MiB, W_WIN = W_WO2 + 5 * MiB + MiB / 2, W_WOUT = W_WIN + 8 * MiB, W_LAYER = 43 * MiB;
constexpr size_t WS_H = WS_W + 2 * W_LAYER;
constexpr size_t WS_BIG = WS_H + 33 * MiB;
constexpr size_t WS_SB = WS_BIG + 132 * MiB;
constexpr size_t WS_SF = WS_SB + 54 * MiB;
constexpr size_t WS_END = WS_SF + 26 * MiB;
static_assert((size_t)M * SBW * 2 <= 54 * MiB && (size_t)M * SFW * 4 <= 26 * MiB && (size_t)M * 4096 * 2 <= 132 * MiB && (size_t)M * D * 2 <= 33 * MiB, "ws map");

constexpr int LDS_BYTES = 147456;
constexpr int NWAVES = 8;

#define GAS __attribute__((address_space(1)))
#define LAS __attribute__((address_space(3)))
typedef unsigned short bf16;
typedef unsigned v4u __attribute__((ext_vector_type(4)));
typedef unsigned v2u __attribute__((ext_vector_type(2)));
typedef float f32x4 __attribute__((ext_vector_type(4)));
typedef float f32x2 __attribute__((ext_vector_type(2)));
#define LDS_WAIT() asm volatile("s_waitcnt lgkmcnt(0)" ::: "memory")

__device__ __forceinline__ float bf2f(unsigned b) { return __uint_as_float(b << 16); }
__device__ __forceinline__ float bflo(unsigned w) { return __uint_as_float(w << 16); }
__device__ __forceinline__ float bfhi(unsigned w) { return __uint_as_float(w & 0xffff0000u); }
__device__ __forceinline__ unsigned pk2(float lo, float hi) { return pg8::cvt_pk_bf16(lo, hi); }
__device__ __forceinline__ float sigmoidf_(float x) { return 1.0f / (1.0f + __expf(-x)); }
__device__ __forceinline__ float siluf_(float x) { return x / (1.0f + __expf(-x)); }
__device__ __forceinline__ float wave_sum(float v) {
#pragma unroll
    for (int o = 1; o < 64; o <<= 1) v += __shfl_xor(v, o);
    return v;
}
template <int CTRL> __device__ __forceinline__ float dppmov(float v) { return __int_as_float(__builtin_amdgcn_update_dpp(0, __float_as_int(v), CTRL, 0xf, 0xf, true)); }
__device__ __forceinline__ float quad_sum(float v) { v += dppmov<0xB1>(v); v += dppmov<0x4E>(v); return v; }
__device__ __forceinline__ float row16_sum(float v) { v += dppmov<0xB1>(v); v += dppmov<0x4E>(v); v += dppmov<0x141>(v); v += dppmov<0x140>(v); return v; }

struct Args { const float* in[28]; float* out; unsigned char* ws; };

struct Ctx {
    int tid, lane, wave, gw, NGW;
    LAS unsigned char* lds;
    float* out; unsigned char* ws;
};
template <class T> __device__ __forceinline__ T* fresh_ptr(T* p) {
    unsigned lo = (unsigned)(uintptr_t)p, hi = (unsigned)((uintptr_t)p >> 32);
    asm volatile("" : "+v"(lo), "+v"(hi));
    lo = __builtin_amdgcn_readfirstlane(lo); hi = __builtin_amdgcn_readfirstlane(hi);
    return (T*)(((uintptr_t)hi << 32) | (uintptr_t)lo);
}
__device__ __forceinline__ Ctx make_ctx(const Args& args, LAS unsigned char* lds) {
    Ctx C; int t = threadIdx.x; asm volatile("" : "+v"(t));
    C.tid = t; C.lane = t & 63; C.wave = __builtin_amdgcn_readfirstlane(t >> 6);
    C.gw = (int)blockIdx.x * NWAVES + C.wave; C.NGW = (int)gridDim.x * NWAVES;
    float* op = fresh_ptr(args.out); unsigned char* wp = fresh_ptr(args.ws);
    C.lds = lds; C.out = op; C.ws = wp; return C;
}
__device__ __forceinline__ int batch_of_row(int r) { return r < MP ? (r >> 11) : BP + ((r - MP) >> 2); }


typedef GAS unsigned gu32;
#define RLX_AGENT __ATOMIC_RELAXED, __HIP_MEMORY_SCOPE_AGENT
#define XB_TMO      128
#define XB_XCNT(j)  (256  + 64 * (j))
#define XB_XSUB(j)  (1280 + 64 * (j))
#define XB_XGEN(j)  (2304 + 64 * (j))
#define XB_TOP      3328
#define XB_TOPGEN   3392
#define XCD_BAR_WORDS 3456
#define XB_SPIN_CAP (1u << 18)

__device__ __forceinline__ unsigned xb_ld(unsigned* p)              { return __hip_atomic_load(p, __ATOMIC_RELAXED, __HIP_MEMORY_SCOPE_AGENT); }
__device__ __forceinline__ unsigned xb_add(unsigned* p, unsigned v) { return __hip_atomic_fetch_add(p, v, __ATOMIC_RELAXED, __HIP_MEMORY_SCOPE_AGENT); }
__device__ __forceinline__ unsigned xb_xcc_id() { return (unsigned)__builtin_amdgcn_s_getreg((3 << 11) | 20) & 0xFu; }
#define XB_SPIN(cond, bar) do { unsigned _sp = 0; while (cond) { __builtin_amdgcn_s_sleep(1); \
    if ((++_sp & 255u) == 0u) { if (xb_ld(&(bar)[XB_TMO])) break; if (_sp > XB_SPIN_CAP) { atomicAdd(&(bar)[XB_TMO], 1u); break; } } } } while (0)

struct XcdBarrier {
    unsigned* bar; unsigned x;
    volatile LAS unsigned* st;
};

__device__ __forceinline__ XcdBarrier xcd_barrier_post(unsigned* bar, volatile LAS unsigned* st) {
    XcdBarrier b; b.bar = bar; b.x = xb_xcc_id(); b.st = st;
    if (threadIdx.x == 0) (void)xb_add(&bar[XB_XCNT(b.x)], 1u);
    return b;
}
__device__ __forceinline__ void xcd_barrier_complete(unsigned* bar, unsigned x, unsigned& nloc, unsigned& nx) {
    const unsigned G = gridDim.x * gridDim.y * gridDim.z;
    unsigned sum, cnt, mine, sp = 0u;
    for (;;) {
        sum = 0u; cnt = 0u; mine = 0u;
#pragma unroll
        for (unsigned j = 0; j < 16; ++j) { const unsigned c = xb_ld(&bar[XB_XCNT(j)]); sum += c; cnt += (c > 0u) ? 1u : 0u; mine = (j == x) ? c : mine; }
        if (sum == G) break;
        __builtin_amdgcn_s_sleep(1);
        if ((++sp & 255u) == 0u) { if (xb_ld(&bar[XB_TMO])) break; if (sp > XB_SPIN_CAP) { atomicAdd(&bar[XB_TMO], 1u); break; } }
    }
    nloc = mine > 0u ? mine : 1u; nx = cnt > 0u ? cnt : 1u;
}

__device__ __forceinline__ void xcd_barrier(const XcdBarrier& b) {
    asm volatile("s_waitcnt vmcnt(0)" ::: "memory");
    __syncthreads();
    if (threadIdx.x == 0) {
        unsigned* bar = b.bar;
        __builtin_amdgcn_s_waitcnt(0);
        unsigned nloc = b.st[0], nx = b.st[1];
        if (nloc == 0u) { xcd_barrier_complete(bar, b.x, nloc, nx); b.st[0] = nloc; b.st[1] = nx; }
        const unsigned old = xb_add(&bar[XB_XSUB(b.x)], 1u);
        const unsigned gen = old / nloc;
        if (old + 1u == (gen + 1u) * nloc) {
            __builtin_amdgcn_fence(__ATOMIC_RELEASE, "agent");
            asm volatile("s_waitcnt vmcnt(0)" ::: "memory");
            const unsigned og = xb_add(&bar[XB_TOP], 1u);
            const unsigned tg = og / nx;
            if (og + 1u == (tg + 1u) * nx) xb_add(&bar[XB_TOPGEN], 1u);
            else XB_SPIN(xb_ld(&bar[XB_TOPGEN]) == tg, bar);
            __builtin_amdgcn_fence(__ATOMIC_ACQUIRE, "agent");
            xb_add(&bar[XB_XGEN(b.x)], 1u);
            asm volatile("s_waitcnt vmcnt(0)" ::: "memory");
        } else {
            XB_SPIN(xb_ld(&bar[XB_XGEN(b.x)]) == gen, bar);
            __builtin_amdgcn_fence(__ATOMIC_ACQUIRE, "agent");
            asm volatile("s_waitcnt vmcnt(0)" ::: "memory");
        }
    }
    __syncthreads();
}

constexpr int MISC_OFF = LDS_BYTES - 256;
__device__ __forceinline__ void grid_bar(const Args& args, LAS unsigned char* lds) {
    XcdBarrier b; b.bar = (unsigned*)fresh_ptr(args.ws); b.x = xb_xcc_id(); b.st = (volatile LAS unsigned*)(lds + MISC_OFF);
    xcd_barrier(b);
}

namespace pg8 {
struct EpiSwiglu {
    static constexpr bool PERM = true, AFTER_DRAIN = false;
    bf16_t* O; int ldc;
    __device__ __forceinline__ void operator()(const f32x4 (&acc)[2][2][4][2], const Unit& u, int wr, int wc, int fr, int fq) const {
        const int row0 = u.pm * BM + wr * 64 + fr, col0 = u.pn * 128 + wc * 32 + 8 * fq;
#pragma unroll
        for (int ai = 0; ai < 2; ++ai)
#pragma unroll
            for (int m = 0; m < 4; ++m) {
                bf16_t* rowp = O + (size_t)(row0 + ai * HALF + m * 16) * ldc + col0;
                float h[8];
#pragma unroll
                for (int n = 0; n < 2; ++n)
#pragma unroll
                    for (int j = 0; j < 4; ++j) {
                        const float a = acc[ai][0][m][n][j], b = acc[ai][1][m][n][j];
                        const float e = __builtin_amdgcn_exp2f(-1.44269504f * a);
                        h[n * 4 + j] = a * __builtin_amdgcn_rcpf(1.0f + e) * b;
                    }
                u32x4 w; w.x = cvt_pk_bf16(h[0], h[1]); w.y = cvt_pk_bf16(h[2], h[3]); w.z = cvt_pk_bf16(h[4], h[5]); w.w = cvt_pk_bf16(h[6], h[7]);
                *(u32x4*)rowp = w;
            }
    }
};
struct EpiPlain {
    static constexpr bool PERM = true, AFTER_DRAIN = false;
    bf16_t* O; int ldc;
    __device__ __forceinline__ void operator()(const f32x4 (&acc)[2][2][4][2], const Unit& u, int wr, int wc, int fr, int fq) const {
        const int row0 = u.pm * BM + wr * 64 + fr, col0 = u.pn * BM + wc * 32 + 8 * fq;
#pragma unroll
        for (int ai = 0; ai < 2; ++ai)
#pragma unroll
            for (int m = 0; m < 4; ++m) {
                bf16_t* rowp = O + (size_t)(row0 + ai * HALF + m * 16) * ldc + col0;
#pragma unroll
                for (int bj = 0; bj < 2; ++bj) { const f32x4 v0 = acc[ai][bj][m][0], v1 = acc[ai][bj][m][1];
                    u32x4 w; w.x = cvt_pk_bf16(v0[0], v0[1]); w.y = cvt_pk_bf16(v0[2], v0[3]); w.z = cvt_pk_bf16(v1[0], v1[1]); w.w = cvt_pk_bf16(v1[2], v1[3]);
                    *(u32x4*)(rowp + bj * HALF) = w; }
            }
    }
};
struct EpiRes {
    static constexpr bool PERM = false, AFTER_DRAIN = false;
    const float* resP; const float* resS; float* X; const float* gate; float alpha, scale;
    __device__ __forceinline__ void operator()(const f32x4 (&acc)[2][2][4][2], const Unit& u, int wr, int wc, int fr, int fq) const {
        const int col0 = u.pn * BM + wc * 32 + 4 * fq;
#pragma unroll
        for (int ai = 0; ai < 2; ++ai)
#pragma unroll
            for (int m = 0; m < 4; ++m) {
                const int r = u.pm * BM + ai * HALF + wr * 64 + m * 16 + fr;
                const int bi = r < 16384 ? (r >> 11) : 8 + ((r - 16384) >> 2);
                const float* rp = r < 16384 ? resP + (size_t)r * 1024 : resS + (size_t)(r - 16384) * 1024;
                const float* gp = gate + (size_t)bi * 9216;
                float* xo = X + (size_t)r * 1024;
#pragma unroll
                for (int bj = 0; bj < 2; ++bj)
#pragma unroll
                    for (int n = 0; n < 2; ++n) {
                        const int c = col0 + bj * HALF + n * 16;
                        const f32x4 rv = *(const f32x4*)(rp + c), gv = *(const f32x4*)(gp + c);
                        const f32x4 o = rv * alpha + (gv * scale + scale) * acc[ai][bj][m][n];
                        *(f32x4*)(xo + c) = o;
                    }
                asm volatile("" ::: "memory");
            }
    }
};
struct EpiMod {
    static constexpr bool PERM = false, AFTER_DRAIN = false;
    float* MODp; const float* ada_b;
    __device__ __forceinline__ void operator()(const f32x4 (&acc)[2][2][4][2], const Unit& u, int wr, int wc, int fr, int fq) const {
        const int col0 = u.pn * BM + wc * 32 + 4 * fq;
        const int l = (u.pn * BM) / 9216;
#pragma unroll
        for (int ai = 0; ai < 2; ++ai)
#pragma unroll
            for (int m = 0; m < 4; ++m) {
                const int r = u.pm * BM + ai * HALF + wr * 64 + m * 16 + fr;
                if (r < 136) {
#pragma unroll
                    for (int bj = 0; bj < 2; ++bj)
#pragma unroll
                        for (int n = 0; n < 2; ++n) {
                            const int c = col0 + bj * HALF + n * 16;
                            const f32x4 o = acc[ai][bj][m][n] + *(const f32x4*)(ada_b + c);
                            *(f32x4*)(MODp + (size_t)(l * 136 + r) * 9216 + (c - l * 9216)) = o;
                        }
                }
            }
    }
};
}

__device__ __forceinline__ void transpose_item(const float* W, int K, int N, bf16* WT, int dest_row0, LAS float* scr, int k0, int n0, int lane) {
    const int nn = n0 + (lane & 31); const bool ok = nn < N;
#pragma unroll 8
    for (int i = 0; i < 32; ++i) { const int kk = 2 * i + (lane >> 5); scr[kk * 33 + (lane & 31)] = ok ? W[(size_t)(k0 + kk) * N + nn] : 0.f; }
    LDS_WAIT();
    const int c = lane & 7;
#pragma unroll
    for (int j = 0; j < 4; ++j) { const int n = (lane >> 3) + 8 * j; const LAS float* s = scr + (8 * c) * 33 + n;
        v4u o; o.x = pk2(s[0 * 33], s[1 * 33]); o.y = pk2(s[2 * 33], s[3 * 33]); o.z = pk2(s[4 * 33], s[5 * 33]); o.w = pk2(s[6 * 33], s[7 * 33]);
        *(v4u*)(WT + (size_t)(dest_row0 + n) * K + k0 + 8 * c) = o; }
    LDS_WAIT();
}

__device__ __forceinline__ void p0_prologue(const Args& args, LAS unsigned char* lds_) {
    const Ctx C = make_ctx(args, lds_);
    LAS float* scr = (LAS float*)(C.lds + C.wave * 16384);
    constexpr int I_WI = 16 * 176, I_WO = 44 * 32, I_WIN = 16 * 121, I_WOUT = 16 * 32, I_ADA = 16 * 288;
    constexpr int I_LAYER = 2 * I_WI + 2 * I_WO + I_WIN + I_WOUT + I_ADA;
    for (int it = C.gw; it < 2 * I_LAYER; it += C.NGW) {
        const int l = it / I_LAYER; int r = it - l * I_LAYER;
        unsigned char* wl = C.ws + WS_W + (size_t)l * W_LAYER;
        if (r < 2 * (I_WI + I_WO)) {
            const int f = r / (I_WI + I_WO); r -= f * (I_WI + I_WO);
            if (r < I_WI) {
                const int kb = r / 176, nb = r % 176, n0 = nb * 32;
                const int half = n0 / DFF, j = n0 - half * DFF, t = j >> 7, jj = j & 127;
                transpose_item((f ? args.in[15] : args.in[13]) + (size_t)l * D * NWI, D, NWI, (bf16*)(wl + (f ? W_WI2 : W_WI1)), 256 * t + 128 * half + jj, scr, kb * 64, n0, C.lane);
            } else { r -= I_WI;
                const int kb = r / 32, nb = r % 32;
                transpose_item((f ? args.in[16] : args.in[14]) + (size_t)l * DFF * D, DFF, D, (bf16*)(wl + (f ? W_WO2 : W_WO1)), nb * 32, scr, kb * 64, nb * 32, C.lane);
            }
            continue;
        }
        r -= 2 * (I_WI + I_WO);
        if (r < I_WIN) { const int kb = r / 121, nb = r % 121;
            transpose_item(args.in[17] + (size_t)l * D * NIN, D, NIN, (bf16*)(wl + W_WIN), nb * 32, scr, kb * 64, nb * 32, C.lane); continue; }
        r -= I_WIN;
        if (r < I_WOUT) { const int kb = r / 32, nb = r % 32;
            transpose_item(args.in[27] + (size_t)l * D * D, D, D, (bf16*)(wl + W_WOUT), nb * 32, scr, kb * 64, nb * 32, C.lane); continue; }
        r -= I_WOUT;
        { const int kb = r / 288, nb = r % 288;
            transpose_item(args.in[9] + (size_t)l * D * NMODC, D, NMODC, (bf16*)(C.ws + WS_BIG), l * NMODC + nb * 32, scr, kb * 64, nb * 32, C.lane); }
    }
    const int gt = C.gw * 64 + C.lane, NGT = C.NGW * 64;
    for (int i = gt; i < 2 * 224 * 128; i += NGT) { const int l = i / (224 * 128), rr = (i / 128) % 224, ch = i & 127;
        *(v4u*)(C.ws + WS_W + (size_t)l * W_LAYER + W_WIN + ((size_t)(3872 + rr) * 1024 + ch * 8) * 2) = (v4u){0u, 0u, 0u, 0u}; }
    for (int i = gt; i < 256 * 256; i += NGT) { const int row = i >> 8, c4 = (i & 255) * 4;
        v2u o = (v2u){0u, 0u};
        if (row < NB) { const float* src = row < BP ? args.in[7] + (size_t)row * D : args.in[8] + (size_t)(row - BP) * D; const f32x4 v = *(const f32x4*)(src + c4);
            o.x = pk2(siluf_(v.x), siluf_(v.y)); o.y = pk2(siluf_(v.z), siluf_(v.w)); }
        *(v2u*)(C.ws + WS_AC + ((size_t)row * D + c4) * 2) = o; }
    for (int i = gt; i < 2052 * 32; i += NGT) { const int p = i >> 5, j = i & 31; const double pos = p < 2048 ? (double)p : (double)(16384 + (p - 2048));
        double inv = 1.0; for (int q = 0; q < j; ++q) inv *= 0.7498942093324559;
        const double ang = pos * inv; const double n = rint(ang * 0.15915494309189535);
        const float rr = (float)((ang - n * 6.283185307179586) - n * 2.4492935982947064e-16);
        ((f32x2*)(C.ws + WS_ROPE))[i] = (f32x2){__cosf(rr), __sinf(rr)}; }
}

__device__ __forceinline__ void p2_modulate0(const Args& args, LAS unsigned char* lds_) {
    const Ctx C = make_ctx(args, lds_);
    const float* MOD = (const float*)(C.ws + WS_MOD); bf16* H = (bf16*)(C.ws + WS_H);
    for (int r = C.gw; r < M; r += C.NGW) {
        const float* xr = r < MP ? args.in[0] + (size_t)r * D : args.in[1] + (size_t)(r - MP) * D;
        const float* modr = MOD + (size_t)batch_of_row(r) * NMODC;
#pragma unroll
        for (int j = 0; j < 4; ++j) { const int c = (C.lane + 64 * j) * 4;
            const f32x4 v = *(const f32x4*)(xr + c), sh = *(const f32x4*)(modr + c), sc = *(const f32x4*)(modr + 1024 + c);
            const f32x4 h = v * (sc + 1.0f) + sh;
            *(v2u*)(H + (size_t)r * D + c) = (v2u){pk2(h.x, h.y), pk2(h.z, h.w)}; }
    }
}

__device__ __forceinline__ void ln_phase(const Args& args, LAS unsigned char* lds_, int l, int which, bool write_h, int hl, int shc) {
    const Ctx C = make_ctx(args, lds_);
    const float* MOD = (const float*)(C.ws + WS_MOD); bf16* H = (bf16*)(C.ws + WS_H);
    const float* g = args.in[11] + (size_t)(l * 3 + which) * D; const float* b = args.in[12] + (size_t)(l * 3 + which) * D;
    for (int r = C.gw; r < M; r += C.NGW) {
        float* xr = C.out + (size_t)r * D;
        f32x4 v[4]; float s = 0.f;
#pragma unroll
        for (int j = 0; j < 4; ++j) { v[j] = *(const f32x4*)(xr + (C.lane + 64 * j) * 4); s += (v[j].x + v[j].y) + (v[j].z + v[j].w); }
        const float mean = wave_sum(s) * (1.f / D); float s2 = 0.f;
#pragma unroll
        for (int j = 0; j < 4; ++j) { v[j] = v[j] - mean; s2 += (v[j].x * v[j].x + v[j].y * v[j].y) + (v[j].z * v[j].z + v[j].w * v[j].w); }
        const float rstd = 1.f / sqrtf(wave_sum(s2) * (1.f / D) + LN_EPS);
        const float* modr = MOD + (size_t)(hl * NB + batch_of_row(r)) * NMODC + shc * 1024;
#pragma unroll
        for (int j = 0; j < 4; ++j) { const int c = (C.lane + 64 * j) * 4;
            const f32x4 xn = v[j] * rstd * *(const f32x4*)(g + c) + *(const f32x4*)(b + c);
            *(f32x4*)(xr + c) = xn;
            if (write_h) { const f32x4 sh = *(const f32x4*)(modr + c), sc = *(const f32x4*)(modr + 1024 + c); const f32x4 h = xn * (sc + 1.0f) + sh;
                *(v2u*)(H + (size_t)r * D + c) = (v2u){pk2(h.x, h.y), pk2(h.z, h.w)}; }
        }
    }
}

__device__ __forceinline__ void prep_phase(const Args& args, LAS unsigned char* lds_, int l) {
    const Ctx C = make_ctx(args, lds_);
    const bf16* PROJ = (const bf16*)(C.ws + WS_BIG); bf16* SB = (bf16*)(C.ws + WS_SB); float* SF = (float*)(C.ws + WS_SF);
    const f32x2* ROPE = (const f32x2*)(C.ws + WS_ROPE);
    const int lane = C.lane;
    const float* wg = args.in[18] + (size_t)l * 16 * 128; const float* bg = args.in[19] + (size_t)l * 128;
    const float* cw = args.in[21] + (size_t)l * 4 * 768;
    for (int r = C.gw; r < M; r += C.NGW) {
        const bool isp = r < MP; const int rs = r - MP;
        const int b = isp ? (r >> 11) : (rs >> 2), t = isp ? (r & 2047) : (rs & 3);
        const int ridx = isp ? t : 2048 + t;
        const bf16* P = PROJ + (size_t)r * NINP; bf16* sb = SB + (size_t)r * SBW; float* sf = SF + (size_t)r * SFW;
        { const int j = lane & 31; const bool hi = lane >= 32; const f32x2 cs = ROPE[ridx * 32 + j];
#pragma unroll
          for (int h = 0; h < 4; ++h) {
              const float q1 = bf2f(P[C_RQ + h * 64 + j]), q2 = bf2f(P[C_RQ + h * 64 + 32 + j]);
              const float k1 = bf2f(P[C_RK + h * 64 + j]), k2 = bf2f(P[C_RK + h * 64 + 32 + j]);
              const float qo = hi ? (q1 * cs.y + q2 * cs.x) : (q1 * cs.x - q2 * cs.y);
              const float ko = hi ? (k1 * cs.y + k2 * cs.x) : (k1 * cs.x - k2 * cs.y);
              sb[SB_RQ + h * 64 + lane] = (bf16)(pk2(qo, 0.f) & 0xffffu);
              sb[SB_RK + h * 64 + lane] = (bf16)(pk2(ko * 0.125f, 0.f) & 0xffffu);
          } }
        asm volatile("" ::: "memory");
        { float alr[16];
#pragma unroll
          for (int i = 0; i < 16; ++i) alr[i] = bf2f(P[C_ALR + i]);
#pragma unroll
          for (int hh = 0; hh < 2; ++hh) { const int c = lane + 64 * hh; float x = bg[c];
#pragma unroll
              for (int i = 0; i < 16; ++i) x += alr[i] * wg[i * 128 + c];
              const float sp = fmaxf(-x, 0.f) + log1pf(expf(-fabsf(x)));
              sf[SF_ADEC + c] = expf(-sp * (1.0f / 16.0f));
              sb[SB_AQ + c] = (bf16)(pk2(bf2f(P[C_AQ + c]) * 0.17677669529663687f, 0.f) & 0xffffu); } }
        asm volatile("" ::: "memory");
        {
#pragma unroll
          for (int i = 0; i < 4; ++i) { const int c = lane + 64 * i;
              float lbv = 0.f; if (l == 1) lbv = 1.0f / (1.0f + expf(args.in[20][c] - args.in[20][256 + c]));
              const float z = bf2f(P[C_HF + c]);
              sf[SF_HF + c] = lbv + (1.0f - lbv) * sigmoidf_(z);
              sb[SB_HQ + c] = (bf16)(pk2(siluf_(bf2f(P[C_HQ + c])) * 0.125f, 0.f) & 0xffffu); } }
        asm volatile("" ::: "memory");
        { const float* cst = args.in[6] + ((size_t)(l * BS + b) * 3) * 768;
          float* cso = isp ? C.out + O_PCONV + ((size_t)(l * BP + b) * 3) * 768 : C.out + O_SCONV + ((size_t)(l * BS + b) * 3) * 768;
          const int so = isp ? t - (TP - 3) : t - 1;
#pragma unroll 1
          for (int i = 0; i < 12; ++i) { const int ch = lane + 64 * i;
              const float x0 = bf2f(P[C_DQKV + ch]);
              float acc = x0 * cw[3 * 768 + ch];
#pragma unroll
              for (int k = 1; k < 4; ++k) { const int tt = t - k; float xv;
                  if (tt >= 0) xv = bf2f(P[C_DQKV + ch - k * NINP]); else xv = isp ? 0.f : cst[(3 + tt) * 768 + ch];
                  acc += xv * cw[(3 - k) * 768 + ch]; }
              const float uu = siluf_(acc);
              if (so >= 0) cso[so * 768 + ch] = x0;
              float sc = 1.0f;
              if (i < 8) { const float nn = wave_sum(uu * uu); sc = rsqrtf(nn + RMS_EPS) * (i < 4 ? 0.125f : 1.0f); }
              sb[SB_DQ + i * 64 + lane] = (bf16)(pk2(uu * sc, 0.f) & 0xffffu); }
          if (lane < 4) { const float db = bf2f(P[C_DB + lane]), da = bf2f(P[C_DA + lane]);
              sf[SF_BETA + lane] = sigmoidf_(db);
              const float xx = da + args.in[23][l * 4 + lane]; const float sp = fmaxf(xx, 0.f) + log1pf(expf(-fabsf(xx)));
              sf[SF_DDEC + lane] = expf(-expf(args.in[22][l * 4 + lane]) * sp); } }
    }
}

template <int KIND, int DH, int R> struct Raw { unsigned q[DH / 2]; unsigned k[DH / 2]; unsigned v[(R + 1) / 2]; float f[DH]; float be, de; };

template <int KIND, int DH, int R>
__device__ __forceinline__ void load_tok(Raw<KIND, DH, R>& x, const bf16* qp, const bf16* kp, const bf16* vp, const float* fp) {
    if constexpr (DH == 4) { const v2u w = *(const v2u*)qp; x.q[0] = w.x; x.q[1] = w.y; } else { x.q[0] = *(const unsigned*)qp; }
    if constexpr (KIND != 2) { if constexpr (DH == 4) { const v2u w = *(const v2u*)kp; x.k[0] = w.x; x.k[1] = w.y; } else { x.k[0] = *(const unsigned*)kp; } }
    if constexpr (R == 1) x.v[0] = *vp; else if constexpr (R == 2) x.v[0] = *(const unsigned*)vp; else { const v2u w = *(const v2u*)vp; x.v[0] = w.x; x.v[1] = w.y; }
    if constexpr (KIND == 1) { const f32x2 w = *(const f32x2*)fp; x.f[0] = w.x; x.f[1] = w.y; }
    if constexpr (KIND == 2) { const f32x4 w = *(const f32x4*)fp; x.f[0] = w.x; x.f[1] = w.y; x.f[2] = w.z; x.f[3] = w.w; }
    if constexpr (KIND == 3) { x.be = fp[0]; x.de = fp[4]; }
}

template <int KIND, int DH, int R>
__device__ __forceinline__ void scan_task(const Ctx& C, int row0, int T, int h, int slice, const float* sin, float* sout) {
    const bf16* PROJ = (const bf16*)(C.ws + WS_BIG); const bf16* SB = (const bf16*)(C.ws + WS_SB); const float* SF = (const float*)(C.ws + WS_SF);
    bf16* H = (bf16*)(C.ws + WS_H);
    const int lane = C.lane, dl = lane & 15, rw = lane >> 4;
    const int d0 = dl * DH, v0 = slice * (4 * R) + rw * R;
    constexpr int DK = 16 * DH;
    const bf16 *qp, *kp, *vp; const float* fp; int ks, vs;
    const bf16* sbr = SB + (size_t)row0 * SBW; const bf16* pr = PROJ + (size_t)row0 * NINP; const float* sfr = SF + (size_t)row0 * SFW;
    if constexpr (KIND == 0) { qp = sbr + SB_RQ + h * 64 + d0; kp = sbr + SB_RK + h * 64 + d0; ks = SBW; vp = pr + C_RV + h * 64 + v0; vs = NINP; fp = sfr; }
    if constexpr (KIND == 1) { qp = sbr + SB_AQ + h * 32 + d0; kp = pr + C_AK + h * 32 + d0; ks = NINP; vp = pr + C_AV + h * 64 + v0; vs = NINP; fp = sfr + SF_ADEC + h * 32 + d0; }
    if constexpr (KIND == 2) { qp = sbr + SB_HQ + h * 64 + d0; kp = sbr; ks = SBW; vp = pr + C_HI + h * 64 + v0; vs = NINP; fp = sfr + SF_HF + h * 64 + d0; }
    if constexpr (KIND == 3) { qp = sbr + SB_DQ + h * 64 + d0; kp = sbr + SB_DK + h * 64 + d0; ks = SBW; vp = sbr + SB_DV + h * 64 + v0; vs = SBW; fp = sfr + SF_BETA + h; }
    bf16* op = H + (size_t)row0 * D + KIND * 256 + h * 64 + v0;
    const float rdec = 1.0f - exp2f(-5.0f - (float)h);

    float S[DH][R];
#pragma unroll
    for (int dh = 0; dh < DH; ++dh)
#pragma unroll
        for (int vv = 0; vv < R; ++vv) S[dh][vv] = sin ? sin[(size_t)(d0 + dh) * 64 + v0 + vv] : 0.f;

    typedef Raw<KIND, DH, R> RawT;
    RawT A[4];
#pragma unroll
    for (int u = 0; u < 4; ++u) load_tok<KIND, DH, R>(A[u], qp + (size_t)u * SBW, kp + (size_t)u * ks, vp + (size_t)u * vs, fp + (size_t)u * SFW);
    for (int t0 = 0; t0 < T; t0 += 4) {
        RawT B[4];
        const bool more = t0 + 4 < T;
#pragma unroll
        for (int u = 0; u < 4; ++u) { B[u] = A[u]; }
        if (more) {
#pragma unroll
            for (int u = 0; u < 4; ++u) load_tok<KIND, DH, R>(B[u], qp + (size_t)(t0 + 4 + u) * SBW, kp + (size_t)(t0 + 4 + u) * ks, vp + (size_t)(t0 + 4 + u) * vs, fp + (size_t)(t0 + 4 + u) * SFW);
        }
#pragma unroll
        for (int u = 0; u < 4; ++u) {
            const RawT& x = A[u];
            float q[DH], k[DH], v[R];
            q[0] = bflo(x.q[0]); q[1] = bfhi(x.q[0]); if constexpr (DH == 4) { q[2] = bflo(x.q[1]); q[3] = bfhi(x.q[1]); }
            if constexpr (KIND != 2) { k[0] = bflo(x.k[0]); k[1] = bfhi(x.k[0]); if constexpr (DH == 4) { k[2] = bflo(x.k[1]); k[3] = bfhi(x.k[1]); } }
            if constexpr (R == 1) v[0] = bflo(x.v[0]);
            if constexpr (R >= 2) { v[0] = bflo(x.v[0]); v[1] = bfhi(x.v[0]); }
            if constexpr (R == 4) { v[2] = bflo(x.v[1]); v[3] = bfhi(x.v[1]); }
            float o[R];
            if constexpr (KIND == 3) {
                float ks_[R];
#pragma unroll
                for (int vv = 0; vv < R; ++vv) { float p = 0.f;
#pragma unroll
                    for (int dh = 0; dh < DH; ++dh) { S[dh][vv] *= x.de; p += k[dh] * S[dh][vv]; }
                    ks_[vv] = row16_sum(p); }
#pragma unroll
                for (int vv = 0; vv < R; ++vv) { const float uu = x.be * (v[vv] - ks_[vv]); float p = 0.f;
#pragma unroll
                    for (int dh = 0; dh < DH; ++dh) { S[dh][vv] += k[dh] * uu; p += q[dh] * S[dh][vv]; }
                    o[vv] = row16_sum(p); }
            } else {
#pragma unroll
                for (int dh = 0; dh < DH; ++dh) {
                    float dec, kk;
                    if constexpr (KIND == 0) { dec = rdec; kk = k[dh]; }
                    if constexpr (KIND == 1) { dec = x.f[dh]; kk = k[dh]; }
                    if constexpr (KIND == 2) { dec = x.f[dh]; kk = 1.0f - x.f[dh]; }
#pragma unroll
                    for (int vv = 0; vv < R; ++vv) S[dh][vv] = dec * S[dh][vv] + kk * v[vv];
                }
#pragma unroll
                for (int vv = 0; vv < R; ++vv) { float p = 0.f;
#pragma unroll
                    for (int dh = 0; dh < DH; ++dh) p += q[dh] * S[dh][vv];
                    o[vv] = row16_sum(p); }
            }
            if (dl == 0) {
                bf16* o_ = op + (size_t)(t0 + u) * D;
                if constexpr (R == 1) *o_ = (bf16)(pk2(o[0], 0.f) & 0xffffu);
                if constexpr (R == 2) *(unsigned*)o_ = pk2(o[0], o[1]);
                if constexpr (R == 4) *(v2u*)o_ = (v2u){pk2(o[0], o[1]), pk2(o[2], o[3])};
            }
        }
#pragma unroll
        for (int u = 0; u < 4; ++u) A[u] = B[u];
    }
#pragma unroll
    for (int dh = 0; dh < DH; ++dh)
#pragma unroll
        for (int vv = 0; vv < R; ++vv) sout[(size_t)(d0 + dh) * 64 + v0 + vv] = S[dh][vv];
    (void)DK;
}

template <int KIND, int DH, int R>
__device__ __forceinline__ void scan_long(const Ctx& C, LAS float* wl, int row0, int T, int h, int slice, float* sout) {
    constexpr int CT = 16, DK = 16 * DH, NV = 4 * R;
    constexpr bool HASK = true, GK = (KIND != 2), HASF = (KIND == 1 || KIND == 2), HASB = (KIND == 3);
    constexpr int OQ = 0, OK_ = OQ + CT * DK, OF = OK_ + (HASK ? CT * DK : 0), OV = OF + (HASF ? CT * DK : 0), OB = OV + CT * NV, BUF = OB + (HASB ? CT * 2 : 0);
    const bf16* PROJ = (const bf16*)(C.ws + WS_BIG); const bf16* SB = (const bf16*)(C.ws + WS_SB); const float* SF = (const float*)(C.ws + WS_SF);
    bf16* H = (bf16*)(C.ws + WS_H);
    const int lane = C.lane, dl = lane & 15, rw = lane >> 4;
    const int d0 = dl * DH;
    const int stok = lane >> 2, spart = lane & 3;
    const bf16 *qg, *kg, *vg; const float *fg, *bg; int ks, vs;
    {
        const bf16* sbr = SB + (size_t)row0 * SBW; const bf16* pr = PROJ + (size_t)row0 * NINP; const float* sfr = SF + (size_t)row0 * SFW;
        const int vcol = slice * NV;
        if constexpr (KIND == 0) { qg = sbr + SB_RQ + h * 64; kg = sbr + SB_RK + h * 64; ks = SBW; vg = pr + C_RV + h * 64 + vcol; vs = NINP; fg = sfr; bg = sfr; }
        if constexpr (KIND == 1) { qg = sbr + SB_AQ + h * 32; kg = pr + C_AK + h * 32; ks = NINP; vg = pr + C_AV + h * 64 + vcol; vs = NINP; fg = sfr + SF_ADEC + h * 32; bg = sfr; }
        if constexpr (KIND == 2) { qg = sbr + SB_HQ + h * 64; kg = sbr; ks = SBW; vg = pr + C_HI + h * 64 + vcol; vs = NINP; fg = sfr + SF_HF + h * 64; bg = sfr; }
        if constexpr (KIND == 3) { qg = sbr + SB_DQ + h * 64; kg = sbr + SB_DK + h * 64; ks = SBW; vg = sbr + SB_DV + h * 64 + vcol; vs = SBW; fg = sfr; bg = sfr + SF_BETA + h; }
    }
    constexpr int QP = DK / 4;
    qg += (size_t)stok * SBW + spart * QP; kg += (size_t)stok * ks + spart * QP; fg += (size_t)stok * SFW + spart * QP;
    vg += (size_t)(lane & 15) * vs; bg += (size_t)(lane & 15) * SFW;
    bf16* op = H + (size_t)row0 * D + KIND * 256 + h * 64 + slice * NV + rw * R;
    const float rdec = 1.0f - exp2f(-5.0f - (float)h);

    float S[DH][R];
#pragma unroll
    for (int dh = 0; dh < DH; ++dh)
#pragma unroll
        for (int vv = 0; vv < R; ++vv) S[dh][vv] = 0.f;

    v4u rq[QP / 8], rk[QP / 8]; f32x4 rf[QP / 4]; unsigned rv[NV / 2]; float rb0 = 0.f, rb1 = 0.f;
    auto stage_load = [&](int c) {
        const size_t t = (size_t)c * CT;
#pragma unroll
        for (int i = 0; i < QP / 8; ++i) { rq[i] = *(const v4u*)(qg + t * SBW + i * 8); if constexpr (GK) rk[i] = *(const v4u*)(kg + t * ks + i * 8); }
        if constexpr (HASF) {
#pragma unroll
            for (int i = 0; i < QP / 4; ++i) rf[i] = *(const f32x4*)(fg + t * SFW + i * 4); }
        if (lane < 16) {
            if constexpr (NV == 4) { const v2u w = *(const v2u*)(vg + t * vs); rv[0] = w.x; rv[1] = w.y; }
            if constexpr (NV == 8) { const v4u w = *(const v4u*)(vg + t * vs); rv[0] = w.x; rv[1] = w.y; rv[2] = w.z; rv[3] = w.w; }
            if constexpr (NV == 16) { const v4u w = *(const v4u*)(vg + t * vs), w2 = *(const v4u*)(vg + t * vs + 8); rv[0] = w.x; rv[1] = w.y; rv[2] = w.z; rv[3] = w.w; rv[4] = w2.x; rv[5] = w2.y; rv[6] = w2.z; rv[7] = w2.w; }
            if constexpr (HASB) { rb0 = bg[t * SFW]; rb1 = bg[t * SFW + 4]; }
        }
    };
    auto stage_write = [&](int b) {
        LAS float* base = wl + b * BUF;
#pragma unroll
        for (int i = 0; i < QP / 8; ++i) {
            LAS float* qd = base + OQ + stok * DK + spart * QP + i * 8;
            *(LAS f32x4*)qd = (f32x4){bflo(rq[i].x), bfhi(rq[i].x), bflo(rq[i].y), bfhi(rq[i].y)}; *(LAS f32x4*)(qd + 4) = (f32x4){bflo(rq[i].z), bfhi(rq[i].z), bflo(rq[i].w), bfhi(rq[i].w)};
            if constexpr (GK) { LAS float* kd = base + OK_ + stok * DK + spart * QP + i * 8;
                *(LAS f32x4*)kd = (f32x4){bflo(rk[i].x), bfhi(rk[i].x), bflo(rk[i].y), bfhi(rk[i].y)}; *(LAS f32x4*)(kd + 4) = (f32x4){bflo(rk[i].z), bfhi(rk[i].z), bflo(rk[i].w), bfhi(rk[i].w)}; }
        }
        if constexpr (HASF) {
#pragma unroll
            for (int i = 0; i < QP / 4; ++i) { *(LAS f32x4*)(base + OF + stok * DK + spart * QP + i * 4) = rf[i];
                if constexpr (KIND == 2) *(LAS f32x4*)(base + OK_ + stok * DK + spart * QP + i * 4) = 1.0f - rf[i]; } }
        if (lane < 16) {
#pragma unroll
            for (int i = 0; i < NV / 2; ++i) { base[OV + lane * NV + 2 * i] = bflo(rv[i]); base[OV + lane * NV + 2 * i + 1] = bfhi(rv[i]); }
            if constexpr (HASB) { base[OB + lane * 2] = rb0; base[OB + lane * 2 + 1] = rb1; }
        }
    };
    static_assert(2 * BUF * 4 <= 26624, "per-wave LDS");
    const int nch = T / CT;
    stage_load(0); stage_write(0);
#pragma unroll 1
    for (int c = 0; c < nch; ++c) {
        const bool more = c + 1 < nch;
        if (more) stage_load(c + 1);
        const LAS float* base = wl + (c & 1) * BUF;
float okeep[R];
#pragma unroll
        for (int vv = 0; vv < R; ++vv) okeep[vv] = 0.f;
#pragma unroll
        for (int u = 0; u < CT; ++u) {
            float q[DH], k[DH], f[DH], v[R];
            if constexpr (DH == 4) { const f32x4 w = *(const LAS f32x4*)(base + OQ + u * DK + d0); q[0] = w.x; q[1] = w.y; q[2] = w.z; q[3] = w.w; }
            else { const f32x2 w = *(const LAS f32x2*)(base + OQ + u * DK + d0); q[0] = w.x; q[1] = w.y; }
            if constexpr (HASK) {
                if constexpr (DH == 4) { const f32x4 w = *(const LAS f32x4*)(base + OK_ + u * DK + d0); k[0] = w.x; k[1] = w.y; k[2] = w.z; k[3] = w.w; }
                else { const f32x2 w = *(const LAS f32x2*)(base + OK_ + u * DK + d0); k[0] = w.x; k[1] = w.y; } }
            if constexpr (HASF) {
                if constexpr (DH == 4) { const f32x4 w = *(const LAS f32x4*)(base + OF + u * DK + d0); f[0] = w.x; f[1] = w.y; f[2] = w.z; f[3] = w.w; }
                else { const f32x2 w = *(const LAS f32x2*)(base + OF + u * DK + d0); f[0] = w.x; f[1] = w.y; } }
            if constexpr (R == 1) v[0] = base[OV + u * NV + rw];
            if constexpr (R == 2) { const f32x2 w = *(const LAS f32x2*)(base + OV + u * NV + rw * 2); v[0] = w.x; v[1] = w.y; }
            if constexpr (R == 4) { const f32x4 w = *(const LAS f32x4*)(base + OV + u * NV + rw * 4); v[0] = w.x; v[1] = w.y; v[2] = w.z; v[3] = w.w; }
            float o[R];
            if constexpr (KIND == 3) {
                const f32x2 bd = *(const LAS f32x2*)(base + OB + u * 2);
                float ks_[R];
#pragma unroll
                for (int vv = 0; vv < R; ++vv) { float p = 0.f;
#pragma unroll
                    for (int dh = 0; dh < DH; ++dh) { S[dh][vv] *= bd.y; p += k[dh] * S[dh][vv]; }
                    ks_[vv] = row16_sum(p); }
#pragma unroll
                for (int vv = 0; vv < R; ++vv) { const float uu = bd.x * (v[vv] - ks_[vv]); float p = 0.f;
#pragma unroll
                    for (int dh = 0; dh < DH; ++dh) { S[dh][vv] += k[dh] * uu; p += q[dh] * S[dh][vv]; }
                    o[vv] = row16_sum(p); }
            } else {
#pragma unroll
                for (int dh = 0; dh < DH; ++dh) {
                    float dec, kk;
                    if constexpr (KIND == 0) { dec = rdec; kk = k[dh]; }
                    if constexpr (KIND == 1) { dec = f[dh]; kk = k[dh]; }
                    if constexpr (KIND == 2) { dec = f[dh]; kk = k[dh]; }
#pragma unroll
                    for (int vv = 0; vv < R; ++vv) S[dh][vv] = dec * S[dh][vv] + kk * v[vv];
                }
#pragma unroll
                for (int vv = 0; vv < R; ++vv) { float p = 0.f;
#pragma unroll
                    for (int dh = 0; dh < DH; ++dh) p += q[dh] * S[dh][vv];
                    o[vv] = row16_sum(p); }
            }
#pragma unroll
            for (int vv = 0; vv < R; ++vv) okeep[vv] = (dl == u) ? o[vv] : okeep[vv];
        }
        {
            bf16* o_ = op + (size_t)(c * CT + dl) * D;
            if constexpr (R == 1) *o_ = (bf16)(pk2(okeep[0], 0.f) & 0xffffu);
            if constexpr (R == 2) *(unsigned*)o_ = pk2(okeep[0], okeep[1]);
            if constexpr (R == 4) *(v2u*)o_ = (v2u){pk2(okeep[0], okeep[1]), pk2(okeep[2], okeep[3])};
        }
        if (more) stage_write((c + 1) & 1);
    }
    const int v0 = slice * NV + rw * R;
#pragma unroll
    for (int dh = 0; dh < DH; ++dh)
#pragma unroll
        for (int vv = 0; vv < R; ++vv) sout[(size_t)(d0 + dh) * 64 + v0 + vv] = S[dh][vv];
}

__device__ __forceinline__ void scan_phase(const Args& args, LAS unsigned char* lds_, int l) {
    const Ctx C = make_ctx(args, lds_);
    constexpr int NLONG = 1152, NSHORT = BS * 144;
    const int slot = C.wave * 256 + (int)blockIdx.x;
    const int nidle = C.NGW - NLONG;
    for (int it = 0;; ++it) {
        int kind, b, h, slice, row0, T; bool isp;
        if (slot < NLONG) { if (it > 0) break; isp = true; T = TP;
            int i = slot;
            if (i < 512) { kind = 3; b = i >> 6; h = (i >> 4) & 3; slice = i & 15; }
            else if (i < 768) { i -= 512; kind = 0; b = i >> 5; h = (i >> 3) & 3; slice = i & 7; }
            else if (i < 1024) { i -= 768; kind = 2; b = i >> 5; h = (i >> 3) & 3; slice = i & 7; }
            else { i -= 1024; kind = 1; b = i >> 4; h = (i >> 2) & 3; slice = i & 3; }
            row0 = b * TP;
        } else { const int st = (slot - NLONG) + it * nidle; if (st >= NSHORT) break; isp = false; T = TS;
            b = st / 144; int i = st - b * 144;
            if (i < 64) { kind = 3; h = i >> 4; slice = i & 15; }
            else if (i < 96) { i -= 64; kind = 0; h = i >> 3; slice = i & 7; }
            else if (i < 128) { i -= 96; kind = 2; h = i >> 3; slice = i & 7; }
            else { i -= 128; kind = 1; h = i >> 2; slice = i & 3; }
            row0 = MP + b * TS;
        }
        const int nbat = isp ? BP : BS;
        const size_t sidx = (size_t)((l * nbat + b) * 4 + h);
        if (isp) {
            LAS float* wl = (LAS float*)(C.lds + C.wave * 26624);
            if (kind == 0) scan_long<0, 4, 2>(C, wl, row0, T, h, slice, C.out + O_PRET + sidx * 4096);
            else if (kind == 1) scan_long<1, 2, 4>(C, wl, row0, T, h, slice, C.out + O_PGLA + sidx * 2048);
            else if (kind == 2) scan_long<2, 4, 2>(C, wl, row0, T, h, slice, C.out + O_PHG + sidx * 4096);
            else scan_long<3, 4, 1>(C, wl, row0, T, h, slice, C.out + O_PGDN + sidx * 4096);
        } else {
            if (kind == 0) { scan_task<0, 4, 2>(C, row0, T, h, slice, args.in[2] + sidx * 4096, C.out + O_SRET + sidx * 4096); }
            else if (kind == 1) { scan_task<1, 2, 4>(C, row0, T, h, slice, args.in[3] + sidx * 2048, C.out + O_SGLA + sidx * 2048); }
            else if (kind == 2) { scan_task<2, 4, 2>(C, row0, T, h, slice, args.in[4] + sidx * 4096, C.out + O_SHG + sidx * 4096); }
            else { scan_task<3, 4, 1>(C, row0, T, h, slice, args.in[5] + sidx * 4096, C.out + O_SGDN + sidx * 4096); }
        }
    }
}

__device__ __forceinline__ void post_phase(const Args& args, LAS unsigned char* lds_, int l) {
    const Ctx C = make_ctx(args, lds_);
    const bf16* PROJ = (const bf16*)(C.ws + WS_BIG); bf16* H = (bf16*)(C.ws + WS_H);
    const int lane = C.lane, mixer = lane >> 4, cc = (lane & 15) * 16;
    const int gbase = mixer == 0 ? C_RG : mixer == 1 ? C_AG : mixer == 2 ? C_HG : C_DG;
    const float* nw = mixer == 1 ? args.in[24] + l * 64 : mixer == 2 ? args.in[25] + l * 64 : args.in[26] + l * 64;
    float w[16];
#pragma unroll
    for (int i = 0; i < 16; ++i) w[i] = mixer == 0 ? 1.0f : nw[(cc + i) & 63];
    for (int r = C.gw; r < M; r += C.NGW) {
        bf16* hp = H + (size_t)r * D + lane * 16; const bf16* gp = PROJ + (size_t)r * NINP + gbase + cc;
        const v4u a0 = *(const v4u*)hp, a1 = *(const v4u*)(hp + 8);
        const v4u g0 = *(const v4u*)gp, g1 = *(const v4u*)(gp + 8);
        float y[16], g[16];
        const unsigned aw[8] = {a0.x, a0.y, a0.z, a0.w, a1.x, a1.y, a1.z, a1.w}, gw_[8] = {g0.x, g0.y, g0.z, g0.w, g1.x, g1.y, g1.z, g1.w};
        float ss = 0.f;
#pragma unroll
        for (int i = 0; i < 8; ++i) { y[2 * i] = bflo(aw[i]); y[2 * i + 1] = bfhi(aw[i]); g[2 * i] = bflo(gw_[i]); g[2 * i + 1] = bfhi(gw_[i]); ss += y[2 * i] * y[2 * i] + y[2 * i + 1] * y[2 * i + 1]; }
        ss = quad_sum(ss);
        const float rs = rsqrtf(ss * (1.0f / 64.0f) + RMS_EPS);
        unsigned ow[8];
#pragma unroll
        for (int i = 0; i < 8; ++i) ow[i] = pk2(y[2 * i] * rs * w[2 * i] * siluf_(g[2 * i]), y[2 * i + 1] * rs * w[2 * i + 1] * siluf_(g[2 * i + 1]));
        *(v4u*)hp = (v4u){ow[0], ow[1], ow[2], ow[3]}; *(v4u*)(hp + 8) = (v4u){ow[4], ow[5], ow[6], ow[7]};
    }
}

__global__ void __launch_bounds__(NWAVES * 64, 2) mega_fwd(Args args) {
    extern __shared__ __attribute__((aligned(16))) unsigned char lds[];
    cg::grid_group grid = cg::this_grid();
    LAS unsigned char* const LDSP = (LAS unsigned char*)lds;
    const int G = (int)gridDim.x, bx = (int)blockIdx.x;
    if (threadIdx.x < 64) ((LAS unsigned*)(LDSP + MISC_OFF))[threadIdx.x] = 0u;
    __syncthreads();
    (void)xcd_barrier_post((unsigned*)args.ws, (volatile LAS unsigned*)(LDSP + MISC_OFF));
#define FRESH() float* out_ = fresh_ptr(args.out); unsigned char* ws = fresh_ptr(args.ws); \
    float* MOD = (float*)(ws + WS_MOD); bf16* H = (bf16*)(ws + WS_H); bf16* BIG = (bf16*)(ws + WS_BIG); (void)MOD; (void)H; (void)BIG; (void)out_;

    p0_prologue(args, LDSP);
    grid.sync();
    {
        FRESH();
        pg8::Gemm g{(const bf16*)(ws + WS_AC), BIG, 256, 2 * NMODC, D}; pg8::StaticOrder S; S.init(256, 2 * NMODC, G, bx);
        pg8::EpiMod E{MOD, args.in[10]};
        pg8::gemm_phase<pg8::EpiMod, pg8::StaticOrder, PG8_ALIGN, PG8_SP2>(LDSP, g, S, E);
    }
    grid_bar(args, LDSP);
    p2_modulate0(args, LDSP);
    grid_bar(args, LDSP);
#pragma unroll 1
    for (int l = 0; l < 2; ++l) {
#pragma unroll 1
        for (int f = 0; f < 2; ++f) {
            if (f == 1) {
                {
                    FRESH();
                    pg8::Gemm g{H, (const bf16*)(ws + WS_W + (size_t)l * W_LAYER + W_WIN), M, NINP, D}; pg8::StaticOrder S; S.init(M, NINP, G, bx);
                    pg8::EpiPlain E{BIG, NINP};
                    pg8::gemm_phase<pg8::EpiPlain, pg8::StaticOrder, PG8_ALIGN, PG8_SP2>(LDSP, g, S, E);
                }
                grid_bar(args, LDSP);
                prep_phase(args, LDSP, l);
                grid_bar(args, LDSP);
                scan_phase(args, LDSP, l);
                grid_bar(args, LDSP);
                post_phase(args, LDSP, l);
                grid_bar(args, LDSP);
                {
                    FRESH();
                    pg8::Gemm g{H, (const bf16*)(ws + WS_W + (size_t)l * W_LAYER + W_WOUT), M, D, D}; pg8::StaticOrder S; S.init(M, D, G, bx);
                    pg8::EpiRes E{out_, out_ + (size_t)MP * D, out_, MOD + (size_t)l * NB * NMODC + 5 * 1024, ALPHA, 1.0f};
                    pg8::gemm_phase<pg8::EpiRes, pg8::StaticOrder, PG8_ALIGN, PG8_SP2>(LDSP, g, S, E);
                }
                grid_bar(args, LDSP);
                ln_phase(args, LDSP, l, 1, true, l, 6);
                grid_bar(args, LDSP);
            }
            {
                FRESH();
                pg8::Gemm g{H, (const bf16*)(ws + WS_W + (size_t)l * W_LAYER + (f ? W_WI2 : W_WI1)), M, NWI, D}; pg8::StaticOrder S; S.init(M, NWI, G, bx);
                pg8::EpiSwiglu E{BIG, DFF};
                pg8::gemm_phase<pg8::EpiSwiglu, pg8::StaticOrder, PG8_ALIGN, PG8_SP2>(LDSP, g, S, E);
            }
            grid_bar(args, LDSP);
            {
                FRESH();
                const bool first = (l == 0 && f == 0);
                pg8::Gemm g{BIG, (const bf16*)(ws + WS_W + (size_t)l * W_LAYER + (f ? W_WO2 : W_WO1)), M, D, DFF}; pg8::StaticOrder S; S.init(M, D, G, bx);
                pg8::EpiRes E{first ? args.in[0] : out_, first ? args.in[1] : out_ + (size_t)MP * D, out_, MOD + (size_t)l * NB * NMODC + (f ? 8 : 2) * 1024, ALPHA, 0.5f};
                pg8::gemm_phase<pg8::EpiRes, pg8::StaticOrder, PG8_ALIGN, PG8_SP2>(LDSP, g, S, E);
            }
            grid_bar(args, LDSP);
            if (f == 0) ln_phase(args, LDSP, l, 0, true, l, 3);
            else ln_phase(args, LDSP, l, 2, l == 0, 1, 0);
            if (!(l == 1 && f == 1)) grid_bar(args, LDSP);
        }
    }
}

extern "C" void kernel_launch(void* const* d_in, const int* in_sizes, int n_in, void* d_out, int out_size, void* d_ws, size_t ws_size, hipStream_t stream) {
    static int grid = 0;
    if (grid == 0) {
        if (n_in != 28 || (size_t)out_size != O_END || ws_size < WS_END) { fprintf(stderr, "kernel_launch: unexpected sizes n_in %d out %d ws %zu (need %zu)\n", n_in, out_size, ws_size, (size_t)WS_END); grid = -1; return; }
        int dev = 0, cus = 0, per_cu = 0;
        hipGetDevice(&dev); hipDeviceGetAttribute(&cus, hipDeviceAttributeMultiprocessorCount, dev);
        hipFuncSetAttribute((const void*)mega_fwd, hipFuncAttributeMaxDynamicSharedMemorySize, LDS_BYTES);
        hipOccupancyMaxActiveBlocksPerMultiprocessor(&per_cu, (const void*)mega_fwd, NWAVES * 64, LDS_BYTES);
        (void)hipGetLastError();
        if (per_cu < 1 || cus < 256) { fprintf(stderr, "kernel_launch: occupancy %d cus %d\n", per_cu, cus); grid = -1; return; }
        grid = 256;
    }
    if (grid < 0) return;
    if (hipMemsetAsync(d_ws, 0, 65536, stream) != hipSuccess) { fprintf(stderr, "memset failed\n"); return; }
    Args a{};
    for (int i = 0; i < 28; ++i) a.in[i] = (const float*)d_in[i];
    a.out = (float*)d_out; a.ws = (unsigned char*)d_ws;
    void* kargs[] = {&a};
    hipError_t e = hipLaunchCooperativeKernel((const void*)mega_fwd, dim3(grid), dim3(NWAVES * 64), kargs, LDS_BYTES, stream);
    if (e != hipSuccess) fprintf(stderr, "cooperative launch failed: %s\n", hipGetErrorString(e));
}
```

```cpp
#include <hip/hip_runtime.h>
#include <hip/hip_cooperative_groups.h>
#include <cstdio>
#include <cstdint>
namespace cg = cooperative_groups;
namespace pg8 {
#define PG8_LAS __attribute__((address_space(3)))
typedef unsigned short bf16_t;
typedef short bf16x8 __attribute__((ext_vector_type(8)));
typedef float f32x4 __attribute__((ext_vector_type(4)));
typedef unsigned u32x4 __attribute__((ext_vector_type(4)));
constexpr int BM = 256, BK = 64, HALF = 128, HTB = HALF * BK * 2  , STAGE_BYTES = 8 * HTB, NXCD = 8, WGM = 8;

__host__ __device__ __forceinline__ int lds_byte(int r, int c) { const int st = (r >> 4) * 2 + (c >> 5), rr = r & 15, cc = c & 31, ob = rr * 64 + cc * 2; return st * 1024 + (ob ^ (((ob >> 9) & 1) << 5)); }
__host__ __device__ __forceinline__ void stage_rc(int b, int& R, int& C) { const int st = b / 1024, sb = b % 1024, swz = sb ^ (((sb >> 9) & 1) << 5); R = (st >> 1) * 16 + swz / 64; C = (st & 1) * 32 + (swz % 64) / 2; }
__host__ __device__ __forceinline__ int perm32(int rho) { const int n = rho >> 4, i = rho & 15; return 8 * (i >> 2) + 4 * n + (i & 3); }

struct Unit { int pm, pn; };
struct Gemm { const bf16_t* A; const bf16_t* Bt; int M, N, K; };

struct StaticOrder {
    int nM, nN, nwg, G, c;
    __host__ __device__ void init(int M, int N, int G_, int c_) { nM = M / BM; nN = N / BM; nwg = nM * nN; G = G_; c = c_; }
    __host__ __device__ bool next(int i, Unit& u) const {
        const long L = (long)i * G + c; if (L >= nwg) return false;
        int wgid = (int)L; { const int q = nwg / NXCD, r = nwg % NXCD, xcd = wgid % NXCD, off = wgid / NXCD; wgid = (xcd < r ? xcd * (q + 1) : r * (q + 1) + (xcd - r) * q) + off; }
        const int nig = WGM * nN, gid = wgid / nig, fm = gid * WGM, gsz = (nM - fm) < WGM ? (nM - fm) : WGM;
        u.pm = fm + ((wgid % nig) % gsz); u.pn = (wgid % nig) / gsz; return true;
    }
    __device__ __forceinline__ void a_ready(const Unit&) const {}
    __device__ __forceinline__ void done(const Unit&) const {}
};

__device__ __forceinline__ unsigned cvt_pk_bf16(float lo, float hi) { unsigned r; asm volatile("v_cvt_pk_bf16_f32 %0, %1, %2" : "=v"(r) : "v"(lo), "v"(hi)); return r; }
typedef float f32x2 __attribute__((ext_vector_type(2)));
__device__ __forceinline__ f32x2 gelu_pk(f32x2 v) {
    const f32x2 av = __builtin_elementwise_abs(v), d = av * 0.2316418882f + 1.0f;
    f32x2 t; t.x = __builtin_amdgcn_rcpf(d.x); t.y = __builtin_amdgcn_rcpf(d.y);
    f32x2 q = t * 0.5307027145f + (-0.7265760135f); q = q * t + 0.7107068705f; q = q * t + (-0.142248368f); q = q * t + 0.127414796f; q = q * t;
    const f32x2 s = (v * v) * (-0.72134752044f);
    f32x2 e; e.x = __builtin_amdgcn_exp2f(s.x); e.y = __builtin_amdgcn_exp2f(s.y);
    const f32x2 m = v * (q * e), r = v - m;
    f32x2 o; o.x = v.x < 0.f ? m.x : r.x; o.y = v.y < 0.f ? m.y : r.y; return o;
}

template <int ACT  > struct EpiBf16 {
    static constexpr bool PERM = true, AFTER_DRAIN = false; static_assert(ACT == 0 || ACT == 1, "EpiBf16: ACT is 0 (none) or 1 (gelu_pk)");
    bf16_t* O; int ldc; const float* bias; int split_cols; size_t split_stride; float scale0;
    __device__ __forceinline__ void operator()(const f32x4 (&acc)[2][2][4][2], const Unit& u, int wr, int wc, int fr, int fq) const {
        const int row0 = u.pm * BM + wr * 64 + fr; int colt = u.pn * BM; bf16_t* base = O;
        float sc = 1.f; if (split_cols) { const int t = colt / split_cols; base += (size_t)t * split_stride; colt -= t * split_cols; if (t == 0) sc = scale0; }
        const int col0 = colt + wc * 32 + 8 * fq, bcol0 = u.pn * BM + wc * 32 + 8 * fq;
        f32x4 bv[2][2];
#pragma unroll
        for (int bj = 0; bj < 2; ++bj)
#pragma unroll
            for (int n = 0; n < 2; ++n) bv[bj][n] = bias ? *(const f32x4*)(bias + bcol0 + bj * HALF + 4 * n) : (f32x4){0.f, 0.f, 0.f, 0.f};
#pragma unroll
        for (int ai = 0; ai < 2; ++ai)
#pragma unroll
            for (int m = 0; m < 4; ++m) { bf16_t* rowp = base + (size_t)(row0 + ai * HALF + m * 16) * ldc + col0;
#pragma unroll
                for (int bj = 0; bj < 2; ++bj) { f32x4 v0 = acc[ai][bj][m][0] + bv[bj][0], v1 = acc[ai][bj][m][1] + bv[bj][1];
                    if (ACT == 1) { f32x2 a = gelu_pk((f32x2){v0[0], v0[1]}), b = gelu_pk((f32x2){v0[2], v0[3]}), c = gelu_pk((f32x2){v1[0], v1[1]}), d = gelu_pk((f32x2){v1[2], v1[3]});
                        v0 = (f32x4){a.x, a.y, b.x, b.y}; v1 = (f32x4){c.x, c.y, d.x, d.y}; }
                    v0 = v0 * sc; v1 = v1 * sc; u32x4 w; w.x = cvt_pk_bf16(v0[0], v0[1]); w.y = cvt_pk_bf16(v0[2], v0[3]); w.z = cvt_pk_bf16(v1[0], v1[1]); w.w = cvt_pk_bf16(v1[2], v1[3]);
                    *(u32x4*)(rowp + bj * HALF) = w; } }
    }
};
template <class Epi, class Sched, bool ALIGN_EPI = false, bool SP2 = false>
__device__ __forceinline__ void gemm_phase(PG8_LAS unsigned char* lds, const Gemm g, const Sched& S, const Epi& E) {
    int tid_ = threadIdx.x; asm volatile("" : "+v"(tid_));
    const int tid = tid_, wid = __builtin_amdgcn_readfirstlane(tid >> 6), lane = tid & 63, wr = wid >> 2, wc = wid & 3, fr = lane & 15, fq = lane >> 4;
    const int K = g.K, nt = K / BK;
    unsigned voffA[2], voffB[2];
#pragma unroll
    for (int i = 0; i < 2; ++i) { int R, C; stage_rc(tid * 16 + i * 8192, R, C); const int Rb = Epi::PERM ? ((R & ~31) + perm32(R & 31)) : R;
        voffA[i] = (unsigned)(R * K + C) * 2u; voffB[i] = (unsigned)(Rb * K + C) * 2u; }
    const size_t kstep = (size_t)(BK * 2);
    const size_t hstep = (size_t)HALF * K * 2;
    const size_t tstep = 2 * hstep;
    const unsigned ldsw = (unsigned)wid * 1024u;
    const int aoff = lds_byte(wr * 64 + fr, fq * 8), boff = lds_byte(wc * 32 + fr, fq * 8);
#define PG8_SA(b, h) (((b) * 2 + (h)) * HTB)
#define PG8_SB(b, h) ((4 + (b) * 2 + (h)) * HTB)
#define PG8_STAGE(bufoff, gbase, voff) do { _Pragma("unroll") for (int _i = 0; _i < 2; ++_i) \
        __builtin_amdgcn_global_load_lds((const unsigned*)((const char*)(gbase) + (voff)[_i]), (PG8_LAS unsigned*)(lds + (bufoff) + ldsw + _i * 8192), 16, 0, 0); } while (0)
#define PG8_LDA(dst, b, h) do { _Pragma("unroll") for (int m = 0; m < 4; ++m) _Pragma("unroll") for (int k = 0; k < 2; ++k) dst[m][k] = *(const PG8_LAS bf16x8*)(lds + PG8_SA(b, h) + aoff + m * 2048 + k * 1024); } while (0)
#define PG8_LDB(dst, b, h) do { _Pragma("unroll") for (int n = 0; n < 2; ++n) _Pragma("unroll") for (int k = 0; k < 2; ++k) dst[n][k] = *(const PG8_LAS bf16x8*)(lds + PG8_SB(b, h) + boff + n * 2048 + k * 1024); } while (0)
#define PG8_MMA(ai, bj, At, Bt) do { __builtin_amdgcn_s_setprio(1); _Pragma("unroll") for (int m = 0; m < 4; ++m) _Pragma("unroll") for (int n = 0; n < 2; ++n) _Pragma("unroll") for (int k = 0; k < 2; ++k) \
        acc[ai][bj][m][n] = __builtin_amdgcn_mfma_f32_16x16x32_bf16(Bt[n][k], At[m][k], acc[ai][bj][m][n], 0, 0, 0); __builtin_amdgcn_s_setprio(0); } while (0)
#define PG8_WAIT_V(n) asm volatile("s_waitcnt vmcnt(" #n ")" ::: "memory")
#define PG8_WAIT_L(n) asm volatile("s_waitcnt lgkmcnt(" #n ")" ::: "memory")
#define PG8_BAR __builtin_amdgcn_s_barrier()
#define PG8_SCHED __builtin_amdgcn_sched_barrier(0)
    Unit cur, nxt; int ui = 0;
    if (!S.next(0, cur)) return;
    f32x4 acc[2][2][4][2];
#pragma unroll
    for (int a = 0; a < 2; ++a)
#pragma unroll
        for (int b = 0; b < 2; ++b)
#pragma unroll
            for (int m = 0; m < 4; ++m)
#pragma unroll
                for (int n = 0; n < 2; ++n) acc[a][b][m][n] = (f32x4){0.f, 0.f, 0.f, 0.f};
    bf16x8 At[4][2], B0[2][2], B1[2][2];
    const char* cA = (const char*)g.A + (size_t)cur.pm * tstep; const char* cB = (const char*)g.Bt + (size_t)cur.pn * tstep;
    S.a_ready(cur);
    if constexpr (SP2) {
        PG8_STAGE(PG8_SB(0, 0), cB, voffB); PG8_STAGE(PG8_SB(0, 1), cB + hstep, voffB); PG8_STAGE(PG8_SA(0, 0), cA, voffA); PG8_STAGE(PG8_SA(0, 1), cA + hstep, voffA);
        if (wr == 1) PG8_BAR;
        PG8_WAIT_V(2); PG8_BAR;
        PG8_STAGE(PG8_SB(1, 0), cB + kstep, voffB); PG8_STAGE(PG8_SA(1, 0), cA + kstep, voffA); PG8_STAGE(PG8_SB(1, 1), cB + hstep + kstep, voffB);
        PG8_WAIT_V(6); PG8_BAR;
    } else {
        PG8_STAGE(PG8_SB(0, 0), cB, voffB); PG8_STAGE(PG8_SA(0, 0), cA, voffA); PG8_STAGE(PG8_SB(0, 1), cB + hstep, voffB); PG8_STAGE(PG8_SA(0, 1), cA + hstep, voffA);
        if (wr == 1) PG8_BAR;
        PG8_WAIT_V(4); PG8_BAR;
        PG8_STAGE(PG8_SB(1, 0), cB + kstep, voffB); PG8_STAGE(PG8_SA(1, 0), cA + kstep, voffA); PG8_STAGE(PG8_SB(1, 1), cB + hstep + kstep, voffB);
        PG8_WAIT_V(6); PG8_BAR;
    }
    for (;;) {
        const bool has_next = S.next(ui + 1, nxt);
        const char* nA = has_next ? (const char*)g.A + (size_t)nxt.pm * tstep : cA; const char* nB = has_next ? (const char*)g.Bt + (size_t)nxt.pn * tstep : cB;
        for (int t = 0; t < nt; t += 2) {
            const bool last = (t == nt - 2);
            const char* a1 = cA + (size_t)(t + 1) * kstep;
            const char* a2 = last ? nA : cA + (size_t)(t + 2) * kstep; const char* b2 = last ? nB : cB + (size_t)(t + 2) * kstep;
            const char* a3 = a2 + kstep; const char* b3 = b2 + kstep;
            if (last && has_next) S.a_ready(nxt);
            if constexpr (SP2) {
            PG8_LDB(B0, 0, 0); PG8_LDB(B1, 0, 1); PG8_SCHED; PG8_LDA(At, 0, 0); PG8_STAGE(PG8_SA(1, 1), a1 + hstep, voffA);
            PG8_WAIT_V(8); PG8_WAIT_L(0); PG8_BAR; PG8_MMA(0, 0, At, B0); PG8_MMA(0, 1, At, B1); PG8_BAR; PG8_SCHED;
            PG8_LDA(At, 0, 1); PG8_STAGE(PG8_SB(0, 0), b2, voffB); PG8_STAGE(PG8_SB(0, 1), b2 + hstep, voffB); PG8_STAGE(PG8_SA(0, 0), a2, voffA);
            PG8_WAIT_V(8); PG8_WAIT_L(0); PG8_BAR; PG8_MMA(1, 0, At, B0); PG8_MMA(1, 1, At, B1); PG8_BAR; PG8_SCHED;
            PG8_LDB(B0, 1, 0); PG8_LDB(B1, 1, 1); PG8_SCHED; PG8_LDA(At, 1, 0); PG8_STAGE(PG8_SA(0, 1), a2 + hstep, voffA);
            PG8_WAIT_V(8); PG8_WAIT_L(0); PG8_BAR; PG8_MMA(0, 0, At, B0); PG8_MMA(0, 1, At, B1); PG8_BAR; PG8_SCHED;
            PG8_LDA(At, 1, 1); PG8_STAGE(PG8_SB(1, 0), b3, voffB); PG8_STAGE(PG8_SB(1, 1), b3 + hstep, voffB); PG8_STAGE(PG8_SA(1, 0), a3, voffA);
            PG8_WAIT_V(8); PG8_WAIT_L(0); PG8_BAR; PG8_MMA(1, 0, At, B0); PG8_MMA(1, 1, At, B1); PG8_BAR; PG8_SCHED;
            } else {
            PG8_LDB(B0, 0, 0); PG8_SCHED; PG8_LDA(At, 0, 0); PG8_STAGE(PG8_SA(1, 1), a1 + hstep, voffA);
            PG8_WAIT_L(8); PG8_BAR; PG8_WAIT_L(0); PG8_MMA(0, 0, At, B0); PG8_BAR; PG8_SCHED;
            PG8_LDB(B1, 0, 1); PG8_STAGE(PG8_SB(0, 0), b2, voffB);
            PG8_BAR; PG8_WAIT_L(0); PG8_MMA(0, 1, At, B1); PG8_BAR;
            PG8_LDA(At, 0, 1); PG8_STAGE(PG8_SA(0, 0), a2, voffA);
            PG8_BAR; PG8_WAIT_L(0); PG8_MMA(1, 0, At, B0); PG8_BAR; PG8_SCHED;
            PG8_STAGE(PG8_SB(0, 1), b2 + hstep, voffB);
            PG8_WAIT_V(6); PG8_BAR; PG8_MMA(1, 1, At, B1); PG8_BAR;
            PG8_LDB(B0, 1, 0); PG8_SCHED; PG8_LDA(At, 1, 0); PG8_STAGE(PG8_SA(0, 1), a2 + hstep, voffA);
            PG8_WAIT_L(8); PG8_BAR; PG8_WAIT_L(0); PG8_MMA(0, 0, At, B0); PG8_BAR; PG8_SCHED;
            PG8_LDB(B1, 1, 1); PG8_STAGE(PG8_SB(1, 0), b3, voffB);
            PG8_BAR; PG8_WAIT_L(0); PG8_MMA(0, 1, At, B1); PG8_BAR;
            PG8_LDA(At, 1, 1); PG8_STAGE(PG8_SA(1, 0), a3, voffA);
            PG8_BAR; PG8_WAIT_L(0); PG8_MMA(1, 0, At, B0); PG8_BAR; PG8_SCHED;
            PG8_STAGE(PG8_SB(1, 1), b3 + hstep, voffB);
            PG8_WAIT_V(6); PG8_BAR; PG8_MMA(1, 1, At, B1); PG8_BAR;
            }
        }
        if constexpr (ALIGN_EPI) { if (wr == 0) PG8_BAR; }
        if constexpr (!Epi::AFTER_DRAIN) { E(acc, cur, wr, wc, fr, fq); S.done(cur); }
        if (!has_next) break;
#pragma unroll
        for (int a = 0; a < 2; ++a)
#pragma unroll
            for (int b = 0; b < 2; ++b)
#pragma unroll
                for (int m = 0; m < 4; ++m)
#pragma unroll
                    for (int n = 0; n < 2; ++n) acc[a][b][m][n] = (f32x4){0.f, 0.f, 0.f, 0.f};
        cur = nxt; cA = nA; cB = nB; ++ui;
        if constexpr (ALIGN_EPI) { if (wr == 1) PG8_BAR; }
    }
    PG8_WAIT_V(0);
    if constexpr (!ALIGN_EPI) { if (wr == 0) PG8_BAR; }
    PG8_BAR;
    if constexpr (Epi::AFTER_DRAIN) { E.fused(acc, cur, wr, wc, fr, fq, lds, wid, lane); S.done(cur); }
#undef PG8_SA
#undef PG8_SB
#undef PG8_STAGE
#undef PG8_LDA
#undef PG8_LDB
#undef PG8_MMA
#undef PG8_WAIT_V
#undef PG8_WAIT_L
#undef PG8_BAR
#undef PG8_SCHED
}
}
#define PG8_SP2 true
#define PG8_ALIGN true

constexpr int D = 1024, TP = 2048, BP = 8, BS = 128, TS = 4;
constexpr int MP = BP * TP, MS = BS * TS, M = MP + MS;
constexpr int DFF = 2816, NWI = 2 * DFF, NIN = 3864, NINP = 4096, NMODC = 9216, NB = BP + BS;
constexpr int SBW = 1664, SFW = 392;
constexpr float LN_EPS = 1e-5f, RMS_EPS = 1e-6f;
constexpr float ALPHA = 1.41421356237f;
constexpr int C_RQ = 0, C_RK = 256, C_RV = 512, C_RG = 768, C_AQ = 1024, C_AK = 1152, C_AV = 1280, C_ALR = 1536, C_AG = 1552,
              C_HQ = 1808, C_HF = 2064, C_HI = 2320, C_HG = 2576, C_DQKV = 2832, C_DB = 3600, C_DA = 3604, C_DG = 3608;
constexpr int SB_RQ = 0, SB_RK = 256, SB_AQ = 512, SB_HQ = 640, SB_DQ = 896, SB_DK = 1152, SB_DV = 1408;
constexpr int SF_ADEC = 0, SF_HF = 128, SF_BETA = 384, SF_DDEC = 388;
constexpr size_t O_Y = 0;
constexpr size_t O_PRET = (size_t)M * D;
constexpr size_t O_PGLA = O_PRET + 2ull * BP * 4 * 64 * 64;
constexpr size_t O_PHG = O_PGLA + 2ull * BP * 4 * 32 * 64;
constexpr size_t O_PGDN = O_PHG + 2ull * BP * 4 * 64 * 64;
constexpr size_t O_PCONV = O_PGDN + 2ull * BP * 4 * 64 * 64;
constexpr size_t O_SRET = O_PCONV + 2ull * BP * 3 * 768;
constexpr size_t O_SGLA = O_SRET + 2ull * BS * 4 * 64 * 64;
constexpr size_t O_SHG = O_SGLA + 2ull * BS * 4 * 32 * 64;
constexpr size_t O_SGDN = O_SHG + 2ull * BS * 4 * 64 * 64;
constexpr size_t O_SCONV = O_SGDN + 2ull * BS * 4 * 64 * 64;
constexpr size_t O_END = O_SCONV + 2ull * BS * 3 * 768;

constexpr size_t MiB = 1u << 20;
constexpr size_t WS_ROPE = 1 * MiB;
constexpr size_t WS_AC = 2 * MiB;
constexpr size_t WS_MOD = 3 * MiB;
constexpr size_t WS_W = 13 * MiB;
constexpr size_t W_WI1 = 0, W_WO1 = 11 * MiB, W_WI2 = W_WO1 + 5 * MiB + MiB / 2, W_WO2 = W_WI2 + 11 * MiB, W_WIN = W_WO2 + 5 * MiB + MiB / 2, W_WOUT = W_WIN + 8 * MiB, W_LAYER = 43 * MiB;
constexpr size_t WS_H = WS_W + 2 * W_LAYER;
constexpr size_t WS_BIG = WS_H + 33 * MiB;
constexpr size_t WS_SB = WS_BIG + 132 * MiB;
constexpr size_t WS_SF = WS_SB + 54 * MiB;
constexpr size_t WS_END = WS_SF + 26 * MiB;
static_assert((size_t)M * SBW * 2 <= 54 * MiB && (size_t)M * SFW * 4 <= 26 * MiB && (size_t)M * 4096 * 2 <= 132 * MiB && (size_t)M * D * 2 <= 33 * MiB, "ws map");

constexpr int LDS_BYTES = 147456;
constexpr int NWAVES = 8;

#define GAS __attribute__((address_space(1)))
#define LAS __attribute__((address_space(3)))
typedef unsigned short bf16;
typedef unsigned v4u __attribute__((ext_vector_type(4)));
typedef unsigned v2u __attribute__((ext_vector_type(2)));
typedef float f32x4 __attribute__((ext_vector_type(4)));
typedef float f32x2 __attribute__((ext_vector_type(2)));
#define LDS_WAIT() asm volatile("s_waitcnt lgkmcnt(0)" ::: "memory")

__device__ __forceinline__ float bf2f(unsigned b) { return __uint_as_float(b << 16); }
__device__ __forceinline__ float bflo(unsigned w) { return __uint_as_float(w << 16); }
__device__ __forceinline__ float bfhi(unsigned w) { return __uint_as_float(w & 0xffff0000u); }
__device__ __forceinline__ unsigned pk2(float lo, float hi) { return pg8::cvt_pk_bf16(lo, hi); }
__device__ __forceinline__ float sigmoidf_(float x) { return 1.0f / (1.0f + __expf(-x)); }
__device__ __forceinline__ float siluf_(float x) { return x / (1.0f + __expf(-x)); }
__device__ __forceinline__ float wave_sum(float v) {
#pragma unroll
    for (int o = 1; o < 64; o <<= 1) v += __shfl_xor(v, o);
    return v;
}
template <int CTRL> __device__ __forceinline__ float dppmov(float v) { return __int_as_float(__builtin_amdgcn_update_dpp(0, __float_as_int(v), CTRL, 0xf, 0xf, true)); }
__device__ __forceinline__ float quad_sum(float v) { v += dppmov<0xB1>(v); v += dppmov<0x4E>(v); return v; }
__device__ __forceinline__ float row16_sum(float v) { v += dppmov<0xB1>(v); v += dppmov<0x4E>(v); v += dppmov<0x141>(v); v += dppmov<0x140>(v); return v; }

struct Args { const float* in[28]; float* out; unsigned char* ws; };

struct Ctx {
    int tid, lane, wave, gw, NGW;
    LAS unsigned char* lds;
    float* out; unsigned char* ws;
};
template <class T> __device__ __forceinline__ T* fresh_ptr(T* p) {
    unsigned lo = (unsigned)(uintptr_t)p, hi = (unsigned)((uintptr_t)p >> 32);
    asm volatile("" : "+v"(lo), "+v"(hi));
    lo = __builtin_amdgcn_readfirstlane(lo); hi = __builtin_amdgcn_readfirstlane(hi);
    return (T*)(__attribute__((address_space(1))) T*)(((uintptr_t)hi << 32) | (uintptr_t)lo);
}
__device__ __forceinline__ Ctx make_ctx(const Args& args, LAS unsigned char* lds) {
    Ctx C; int t = threadIdx.x; asm volatile("" : "+v"(t));
    C.tid = t; C.lane = t & 63; C.wave = __builtin_amdgcn_readfirstlane(t >> 6);
    C.gw = (int)blockIdx.x * NWAVES + C.wave; C.NGW = (int)gridDim.x * NWAVES;
    float* op = fresh_ptr(args.out); unsigned char* wp = fresh_ptr(args.ws);
    C.lds = lds; C.out = op; C.ws = wp; return C;
}
__device__ __forceinline__ int batch_of_row(int r) { return r < MP ? (r >> 11) : BP + ((r - MP) >> 2); }


typedef GAS unsigned gu32;
#define RLX_AGENT __ATOMIC_RELAXED, __HIP_MEMORY_SCOPE_AGENT
#define XB_TMO      128
#define XB_XCNT(j)  (256  + 64 * (j))
#define XB_XSUB(j)  (1280 + 64 * (j))
#define XB_XGEN(j)  (2304 + 64 * (j))
#define XB_TOP      3328
#define XB_TOPGEN   3392
#define XCD_BAR_WORDS 3456
#define XB_SPIN_CAP (1u << 18)

__device__ __forceinline__ unsigned xb_ld(unsigned* p)              { return __hip_atomic_load(p, __ATOMIC_RELAXED, __HIP_MEMORY_SCOPE_AGENT); }
__device__ __forceinline__ unsigned xb_add(unsigned* p, unsigned v) { return __hip_atomic_fetch_add(p, v, __ATOMIC_RELAXED, __HIP_MEMORY_SCOPE_AGENT); }
__device__ __forceinline__ unsigned xb_xcc_id() { return (unsigned)__builtin_amdgcn_s_getreg((3 << 11) | 20) & 0xFu; }
#define XB_SPIN(cond, bar) do { unsigned _sp = 0; while (cond) { __builtin_amdgcn_s_sleep(1); \
    if ((++_sp & 255u) == 0u) { if (xb_ld(&(bar)[XB_TMO])) break; if (_sp > XB_SPIN_CAP) { atomicAdd(&(bar)[XB_TMO], 1u); break; } } } } while (0)

struct XcdBarrier {
    unsigned* bar; unsigned x;
    volatile LAS unsigned* st;
};

__device__ __forceinline__ XcdBarrier xcd_barrier_post(unsigned* bar, volatile LAS unsigned* st) {
    XcdBarrier b; b.bar = bar; b.x = xb_xcc_id(); b.st = st;
    if (threadIdx.x == 0) (void)xb_add(&bar[XB_XCNT(b.x)], 1u);
    return b;
}
__device__ __forceinline__ void xcd_barrier_complete(unsigned* bar, unsigned x, unsigned& nloc, unsigned& nx) {
    const unsigned G = gridDim.x * gridDim.y * gridDim.z;
    unsigned sum, cnt, mine, sp = 0u;
    for (;;) {
        sum = 0u; cnt = 0u; mine = 0u;
#pragma unroll
        for (unsigned j = 0; j < 16; ++j) { const unsigned c = xb_ld(&bar[XB_XCNT(j)]); sum += c; cnt += (c > 0u) ? 1u : 0u; mine = (j == x) ? c : mine; }
        if (sum == G) break;
        __builtin_amdgcn_s_sleep(1);
        if ((++sp & 255u) == 0u) { if (xb_ld(&bar[XB_TMO])) break; if (sp > XB_SPIN_CAP) { atomicAdd(&bar[XB_TMO], 1u); break; } }
    }
    nloc = mine > 0u ? mine : 1u; nx = cnt > 0u ? cnt : 1u;
}

__device__ __forceinline__ void xcd_barrier(const XcdBarrier& b) {
    asm volatile("s_waitcnt vmcnt(0)" ::: "memory");
    __syncthreads();
    if (threadIdx.x == 0) {
        unsigned* bar = b.bar;
        __builtin_amdgcn_s_waitcnt(0);
        unsigned nloc = b.st[0], nx = b.st[1];
        if (nloc == 0u) { xcd_barrier_complete(bar, b.x, nloc, nx); b.st[0] = nloc; b.st[1] = nx; }
        const unsigned old = xb_add(&bar[XB_XSUB(b.x)], 1u);
        const unsigned gen = old / nloc;
        if (old + 1u == (gen + 1u) * nloc) {
            __builtin_amdgcn_fence(__ATOMIC_RELEASE, "agent");
            asm volatile("s_waitcnt vmcnt(0)" ::: "memory");
            const unsigned og = xb_add(&bar[XB_TOP], 1u);
            const unsigned tg = og / nx;
            if (og + 1u == (tg + 1u) * nx) xb_add(&bar[XB_TOPGEN], 1u);
            else XB_SPIN(xb_ld(&bar[XB_TOPGEN]) == tg, bar);
            __builtin_amdgcn_fence(__ATOMIC_ACQUIRE, "agent");
            xb_add(&bar[XB_XGEN(b.x)], 1u);
            asm volatile("s_waitcnt vmcnt(0)" ::: "memory");
        } else {
            XB_SPIN(xb_ld(&bar[XB_XGEN(b.x)]) == gen, bar);
            __builtin_amdgcn_fence(__ATOMIC_ACQUIRE, "agent");
            asm volatile("s_waitcnt vmcnt(0)" ::: "memory");
        }
    }
    __syncthreads();
}

constexpr int MISC_OFF = LDS_BYTES - 256;
__device__ __forceinline__ void grid_bar(const Args& args, LAS unsigned char* lds) {
    XcdBarrier b; b.bar = (unsigned*)fresh_ptr(args.ws); b.x = xb_xcc_id(); b.st = (volatile LAS unsigned*)(lds + MISC_OFF);
    xcd_barrier(b);
}

namespace pg8 {
struct EpiSwiglu {
    static constexpr bool PERM = true, AFTER_DRAIN = false;
    bf16_t* O; int ldc;
    __device__ __forceinline__ void operator()(const f32x4 (&acc)[2][2][4][2], const Unit& u, int wr, int wc, int fr, int fq) const {
        const int row0 = u.pm * BM + wr * 64 + fr, col0 = u.pn * 128 + wc * 32 + 8 * fq;
#pragma unroll
        for (int ai = 0; ai < 2; ++ai)
#pragma unroll
            for (int m = 0; m < 4; ++m) {
                bf16_t* rowp = O + (size_t)(row0 + ai * HALF + m * 16) * ldc + col0;
                float h[8];
#pragma unroll
                for (int n = 0; n < 2; ++n)
#pragma unroll
                    for (int j = 0; j < 4; ++j) {
                        const float a = acc[ai][0][m][n][j], b = acc[ai][1][m][n][j];
                        const float e = __builtin_amdgcn_exp2f(-1.44269504f * a);
                        h[n * 4 + j] = a * __builtin_amdgcn_rcpf(1.0f + e) * b;
                    }
                u32x4 w; w.x = cvt_pk_bf16(h[0], h[1]); w.y = cvt_pk_bf16(h[2], h[3]); w.z = cvt_pk_bf16(h[4], h[5]); w.w = cvt_pk_bf16(h[6], h[7]);
                *(u32x4*)rowp = w;
            }
    }
};
struct EpiPlain {
    static constexpr bool PERM = true, AFTER_DRAIN = false;
    bf16_t* O; int ldc;
    __device__ __forceinline__ void operator()(const f32x4 (&acc)[2][2][4][2], const Unit& u, int wr, int wc, int fr, int fq) const {
        const int row0 = u.pm * BM + wr * 64 + fr, col0 = u.pn * BM + wc * 32 + 8 * fq;
#pragma unroll
        for (int ai = 0; ai < 2; ++ai)
#pragma unroll
            for (int m = 0; m < 4; ++m) {
                bf16_t* rowp = O + (size_t)(row0 + ai * HALF + m * 16) * ldc + col0;
#pragma unroll
                for (int bj = 0; bj < 2; ++bj) { const f32x4 v0 = acc[ai][bj][m][0], v1 = acc[ai][bj][m][1];
                    u32x4 w; w.x = cvt_pk_bf16(v0[0], v0[1]); w.y = cvt_pk_bf16(v0[2], v0[3]); w.z = cvt_pk_bf16(v1[0], v1[1]); w.w = cvt_pk_bf16(v1[2], v1[3]);
                    *(u32x4*)(rowp + bj * HALF) = w; }
            }
    }
};
struct EpiRes {
    static constexpr bool PERM = false, AFTER_DRAIN = false;
    const float* resP; const float* resS; float* X; const float* gate; float alpha, scale;
    __device__ __forceinline__ void operator()(const f32x4 (&acc)[2][2][4][2], const Unit& u, int wr, int wc, int fr, int fq) const {
        const int col0 = u.pn * BM + wc * 32 + 4 * fq;
#pragma unroll
        for (int ai = 0; ai < 2; ++ai)
#pragma unroll
            for (int m = 0; m < 4; ++m) {
                const int r = u.pm * BM + ai * HALF + wr * 64 + m * 16 + fr;
                const int bi = r < 16384 ? (r >> 11) : 8 + ((r - 16384) >> 2);
                const float* rp = r < 16384 ? resP + (size_t)r * 1024 : resS + (size_t)(r - 16384) * 1024;
                const float* gp = gate + (size_t)bi * 9216;
                float* xo = X + (size_t)r * 1024;
#pragma unroll
                for (int bj = 0; bj < 2; ++bj)
#pragma unroll
                    for (int n = 0; n < 2; ++n) {
                        const int c = col0 + bj * HALF + n * 16;
                        const f32x4 rv = *(const f32x4*)(rp + c), gv = *(const f32x4*)(gp + c);
                        const f32x4 o = rv * alpha + (gv * scale + scale) * acc[ai][bj][m][n];
                        *(f32x4*)(xo + c) = o;
                    }
                asm volatile("" ::: "memory");
            }
    }
};
struct EpiMod {
    static constexpr bool PERM = false, AFTER_DRAIN = false;
    float* MODp; const float* ada_b;
    __device__ __forceinline__ void operator()(const f32x4 (&acc)[2][2][4][2], const Unit& u, int wr, int wc, int fr, int fq) const {
        const int col0 = u.pn * BM + wc * 32 + 4 * fq;
        const int l = (u.pn * BM) / 9216;
#pragma unroll
        for (int ai = 0; ai < 2; ++ai)
#pragma unroll
            for (int m = 0; m < 4; ++m) {
                const int r = u.pm * BM + ai * HALF + wr * 64 + m * 16 + fr;
                if (r < 136) {
#pragma unroll
                    for (int bj = 0; bj < 2; ++bj)
#pragma unroll
                        for (int n = 0; n < 2; ++n) {
                            const int c = col0 + bj * HALF + n * 16;
                            const f32x4 o = acc[ai][bj][m][n] + *(const f32x4*)(ada_b + c);
                            *(f32x4*)(MODp + (size_t)(l * 136 + r) * 9216 + (c - l * 9216)) = o;
                        }
                }
            }
    }
};
}

__device__ __forceinline__ void transpose_item(const float* W, int K, int N, bf16* WT, int dest_row0, LAS float* scr, int k0, int n0, int lane) {
    const int nn = n0 + (lane & 31); const bool ok = nn < N;
#pragma unroll 8
    for (int i = 0; i < 32; ++i) { const int kk = 2 * i + (lane >> 5); scr[kk * 33 + (lane & 31)] = ok ? W[(size_t)(k0 + kk) * N + nn] : 0.f; }
    LDS_WAIT();
    const int c = lane & 7;
#pragma unroll
    for (int j = 0; j < 4; ++j) { const int n = (lane >> 3) + 8 * j; const LAS float* s = scr + (8 * c) * 33 + n;
        v4u o; o.x = pk2(s[0 * 33], s[1 * 33]); o.y = pk2(s[2 * 33], s[3 * 33]); o.z = pk2(s[4 * 33], s[5 * 33]); o.w = pk2(s[6 * 33], s[7 * 33]);
        *(v4u*)(WT + (size_t)(dest_row0 + n) * K + k0 + 8 * c) = o; }
    LDS_WAIT();
}

__device__ __forceinline__ void p0_prologue(const Args& args, LAS unsigned char* lds_) {
    const Ctx C = make_ctx(args, lds_);
    LAS float* scr = (LAS float*)(C.lds + C.wave * 16384);
    constexpr int I_WI = 16 * 176, I_WO = 44 * 32, I_WIN = 16 * 121, I_WOUT = 16 * 32, I_ADA = 16 * 288;
    constexpr int I_LAYER = 2 * I_WI + 2 * I_WO + I_WIN + I_WOUT + I_ADA;
    for (int it = C.gw; it < 2 * I_LAYER; it += C.NGW) {
        const int l = it / I_LAYER; int r = it - l * I_LAYER;
        unsigned char* wl = C.ws + WS_W + (size_t)l * W_LAYER;
        if (r < 2 * (I_WI + I_WO)) {
            const int f = r / (I_WI + I_WO); r -= f * (I_WI + I_WO);
            if (r < I_WI) {
                const int kb = r / 176, nb = r % 176, n0 = nb * 32;
                const int half = n0 / DFF, j = n0 - half * DFF, t = j >> 7, jj = j & 127;
                transpose_item((f ? args.in[15] : args.in[13]) + (size_t)l * D * NWI, D, NWI, (bf16*)(wl + (f ? W_WI2 : W_WI1)), 256 * t + 128 * half + jj, scr, kb * 64, n0, C.lane);
            } else { r -= I_WI;
                const int kb = r / 32, nb = r % 32;
                transpose_item((f ? args.in[16] : args.in[14]) + (size_t)l * DFF * D, DFF, D, (bf16*)(wl + (f ? W_WO2 : W_WO1)), nb * 32, scr, kb * 64, nb * 32, C.lane);
            }
            continue;
        }
        r -= 2 * (I_WI + I_WO);
        if (r < I_WIN) { const int kb = r / 121, nb = r % 121;
            transpose_item(args.in[17] + (size_t)l * D * NIN, D, NIN, (bf16*)(wl + W_WIN), nb * 32, scr, kb * 64, nb * 32, C.lane); continue; }
        r -= I_WIN;
        if (r < I_WOUT) { const int kb = r / 32, nb = r % 32;
            transpose_item(args.in[27] + (size_t)l * D * D, D, D, (bf16*)(wl + W_WOUT), nb * 32, scr, kb * 64, nb * 32, C.lane); continue; }
        r -= I_WOUT;
        { const int kb = r / 288, nb = r % 288;
            transpose_item(args.in[9] + (size_t)l * D * NMODC, D, NMODC, (bf16*)(C.ws + WS_BIG), l * NMODC + nb * 32, scr, kb * 64, nb * 32, C.lane); }
    }
    const int gt = C.gw * 64 + C.lane, NGT = C.NGW * 64;
    for (int i = gt; i < 2 * 224 * 128; i += NGT) { const int l = i / (224 * 128), rr = (i / 128) % 224, ch = i & 127;
        *(v4u*)(C.ws + WS_W + (size_t)l * W_LAYER + W_WIN + ((size_t)(3872 + rr) * 1024 + ch * 8) * 2) = (v4u){0u, 0u, 0u, 0u}; }
    for (int i = gt; i < 256 * 256; i += NGT) { const int row = i >> 8, c4 = (i & 255) * 4;
        v2u o = (v2u){0u, 0u};
        if (row < NB) { const float* src = row < BP ? args.in[7] + (size_t)row * D : args.in[8] + (size_t)(row - BP) * D; const f32x4 v = *(const f32x4*)(src + c4);
            o.x = pk2(siluf_(v.x), siluf_(v.y)); o.y = pk2(siluf_(v.z), siluf_(v.w)); }
        *(v2u*)(C.ws + WS_AC + ((size_t)row * D + c4) * 2) = o; }
    for (int i = gt; i < 2052 * 32; i += NGT) { const int p = i >> 5, j = i & 31; const double pos = p < 2048 ? (double)p : (double)(16384 + (p - 2048));
        double inv = 1.0; for (int q = 0; q < j; ++q) inv *= 0.7498942093324559;
        const double ang = pos * inv; const double n = rint(ang * 0.15915494309189535);
        const float rr = (float)((ang - n * 6.283185307179586) - n * 2.4492935982947064e-16);
        ((f32x2*)(C.ws + WS_ROPE))[i] = (f32x2){__cosf(rr), __sinf(rr)}; }
}

__device__ __forceinline__ void p2_modulate0(const Args& args, LAS unsigned char* lds_) {
    const Ctx C = make_ctx(args, lds_);
    const float* MOD = (const float*)(C.ws + WS_MOD); bf16* H = (bf16*)(C.ws + WS_H);
    for (int r = C.gw; r < M; r += C.NGW) {
        const float* xr = r < MP ? args.in[0] + (size_t)r * D : args.in[1] + (size_t)(r - MP) * D;
        const float* modr = MOD + (size_t)batch_of_row(r) * NMODC;
#pragma unroll
        for (int j = 0; j < 4; ++j) { const int c = (C.lane + 64 * j) * 4;
            const f32x4 v = *(const f32x4*)(xr + c), sh = *(const f32x4*)(modr + c), sc = *(const f32x4*)(modr + 1024 + c);
            const f32x4 h = v * (sc + 1.0f) + sh;
            *(v2u*)(H + (size_t)r * D + c) = (v2u){pk2(h.x, h.y), pk2(h.z, h.w)}; }
    }
}

__device__ __forceinline__ void ln_phase(const Args& args, LAS unsigned char* lds_, int l, int which, bool write_h, int hl, int shc) {
    const Ctx C = make_ctx(args, lds_);
    const float* MOD = (const float*)(C.ws + WS_MOD); bf16* H = (bf16*)(C.ws + WS_H);
    const float* g = args.in[11] + (size_t)(l * 3 + which) * D; const float* b = args.in[12] + (size_t)(l * 3 + which) * D;
    for (int r = C.gw; r < M; r += C.NGW) {
        float* xr = C.out + (size_t)r * D;
        f32x4 v[4]; float s = 0.f;
#pragma unroll
        for (int j = 0; j < 4; ++j) { v[j] = *(const f32x4*)(xr + (C.lane + 64 * j) * 4); s += (v[j].x + v[j].y) + (v[j].z + v[j].w); }
        const float mean = wave_sum(s) * (1.f / D); float s2 = 0.f;
#pragma unroll
        for (int j = 0; j < 4; ++j) { v[j] = v[j] - mean; s2 += (v[j].x * v[j].x + v[j].y * v[j].y) + (v[j].z * v[j].z + v[j].w * v[j].w); }
        const float rstd = 1.f / sqrtf(wave_sum(s2) * (1.f / D) + LN_EPS);
        const float* modr = MOD + (size_t)(hl * NB + batch_of_row(r)) * NMODC + shc * 1024;
#pragma unroll
        for (int j = 0; j < 4; ++j) { const int c = (C.lane + 64 * j) * 4;
            const f32x4 xn = v[j] * rstd * *(const f32x4*)(g + c) + *(const f32x4*)(b + c);
            *(f32x4*)(xr + c) = xn;
            if (write_h) { const f32x4 sh = *(const f32x4*)(modr + c), sc = *(const f32x4*)(modr + 1024 + c); const f32x4 h = xn * (sc + 1.0f) + sh;
                *(v2u*)(H + (size_t)r * D + c) = (v2u){pk2(h.x, h.y), pk2(h.z, h.w)}; }
        }
    }
}

__device__ __forceinline__ void prep_phase(const Args& args, LAS unsigned char* lds_, int l) {
    const Ctx C = make_ctx(args, lds_);
    const bf16* PROJ = (const bf16*)(C.ws + WS_BIG); bf16* SB = (bf16*)(C.ws + WS_SB); float* SF = (float*)(C.ws + WS_SF);
    const f32x2* ROPE = (const f32x2*)(C.ws + WS_ROPE);
    const int lane = C.lane;
    const float* wg = args.in[18] + (size_t)l * 16 * 128; const float* bg = args.in[19] + (size_t)l * 128;
    const float* cw = args.in[21] + (size_t)l * 4 * 768;
    for (int r = C.gw; r < M; r += C.NGW) {
        const bool isp = r < MP; const int rs = r - MP;
        const int b = isp ? (r >> 11) : (rs >> 2), t = isp ? (r & 2047) : (rs & 3);
        const int ridx = isp ? t : 2048 + t;
        const bf16* P = PROJ + (size_t)r * NINP; bf16* sb = SB + (size_t)r * SBW; float* sf = SF + (size_t)r * SFW;
        { const int j = lane & 31; const bool hi = lane >= 32; const f32x2 cs = ROPE[ridx * 32 + j];
#pragma unroll
          for (int h = 0; h < 4; ++h) {
              const float q1 = bf2f(P[C_RQ + h * 64 + j]), q2 = bf2f(P[C_RQ + h * 64 + 32 + j]);
              const float k1 = bf2f(P[C_RK + h * 64 + j]), k2 = bf2f(P[C_RK + h * 64 + 32 + j]);
              const float qo = hi ? (q1 * cs.y + q2 * cs.x) : (q1 * cs.x - q2 * cs.y);
              const float ko = hi ? (k1 * cs.y + k2 * cs.x) : (k1 * cs.x - k2 * cs.y);
              sb[SB_RQ + h * 64 + lane] = (bf16)(pk2(qo, 0.f) & 0xffffu);
              sb[SB_RK + h * 64 + lane] = (bf16)(pk2(ko * 0.125f, 0.f) & 0xffffu);
          } }
        asm volatile("" ::: "memory");
        { float alr[16];
#pragma unroll
          for (int i = 0; i < 16; ++i) alr[i] = bf2f(P[C_ALR + i]);
#pragma unroll
          for (int hh = 0; hh < 2; ++hh) { const int c = lane + 64 * hh; float x = bg[c];
#pragma unroll
              for (int i = 0; i < 16; ++i) x += alr[i] * wg[i * 128 + c];
              const float sp = fmaxf(-x, 0.f) + log1pf(expf(-fabsf(x)));
              sf[SF_ADEC + c] = expf(-sp * (1.0f / 16.0f));
              sb[SB_AQ + c] = (bf16)(pk2(bf2f(P[C_AQ + c]) * 0.17677669529663687f, 0.f) & 0xffffu); } }
        asm volatile("" ::: "memory");
        {
#pragma unroll
          for (int i = 0; i < 4; ++i) { const int c = lane + 64 * i;
              float lbv = 0.f; if (l == 1) lbv = 1.0f / (1.0f + expf(args.in[20][c] - args.in[20][256 + c]));
              const float z = bf2f(P[C_HF + c]);
              sf[SF_HF + c] = lbv + (1.0f - lbv) * sigmoidf_(z);
              sb[SB_HQ + c] = (bf16)(pk2(siluf_(bf2f(P[C_HQ + c])) * 0.125f, 0.f) & 0xffffu); } }
        asm volatile("" ::: "memory");
        { const float* cst = args.in[6] + ((size_t)(l * BS + b) * 3) * 768;
          float* cso = isp ? C.out + O_PCONV + ((size_t)(l * BP + b) * 3) * 768 : C.out + O_SCONV + ((size_t)(l * BS + b) * 3) * 768;
          const int so = isp ? t - (TP - 3) : t - 1;
#pragma unroll 1
          for (int i = 0; i < 12; ++i) { const int ch = lane + 64 * i;
              const float x0 = bf2f(P[C_DQKV + ch]);
              float acc = x0 * cw[3 * 768 + ch];
#pragma unroll
              for (int k = 1; k < 4; ++k) { const int tt = t - k; float xv;
                  if (tt >= 0) xv = bf2f(P[C_DQKV + ch - k * NINP]); else xv = isp ? 0.f : cst[(3 + tt) * 768 + ch];
                  acc += xv * cw[(3 - k) * 768 + ch]; }
              const float uu = siluf_(acc);
              if (so >= 0) cso[so * 768 + ch] = x0;
              float sc = 1.0f;
              if (i < 8) { const float nn = wave_sum(uu * uu); sc = rsqrtf(nn + RMS_EPS) * (i < 4 ? 0.125f : 1.0f); }
              sb[SB_DQ + i * 64 + lane] = (bf16)(pk2(uu * sc, 0.f) & 0xffffu); }
          if (lane < 4) { const float db = bf2f(P[C_DB + lane]), da = bf2f(P[C_DA + lane]);
              sf[SF_BETA + lane] = sigmoidf_(db);
              const float xx = da + args.in[23][l * 4 + lane]; const float sp = fmaxf(xx, 0.f) + log1pf(expf(-fabsf(xx)));
              sf[SF_DDEC + lane] = expf(-expf(args.in[22][l * 4 + lane]) * sp); } }
    }
}

template <int KIND, int DH, int R> struct Raw { unsigned q[DH / 2]; unsigned k[DH / 2]; unsigned v[(R + 1) / 2]; float f[DH]; float be, de; };

template <int KIND, int DH, int R>
__device__ __forceinline__ void load_tok(Raw<KIND, DH, R>& x, const bf16* qp, const bf16* kp, const bf16* vp, const float* fp) {
    if constexpr (DH == 4) { const v2u w = *(const v2u*)qp; x.q[0] = w.x; x.q[1] = w.y; } else { x.q[0] = *(const unsigned*)qp; }
    if constexpr (KIND != 2) { if constexpr (DH == 4) { const v2u w = *(const v2u*)kp; x.k[0] = w.x; x.k[1] = w.y; } else { x.k[0] = *(const unsigned*)kp; } }
    if constexpr (R == 1) x.v[0] = *vp; else if constexpr (R == 2) x.v[0] = *(const unsigned*)vp; else { const v2u w = *(const v2u*)vp; x.v[0] = w.x; x.v[1] = w.y; }
    if constexpr (KIND == 1) { const f32x2 w = *(const f32x2*)fp; x.f[0] = w.x; x.f[1] = w.y; }
    if constexpr (KIND == 2) { const f32x4 w = *(const f32x4*)fp; x.f[0] = w.x; x.f[1] = w.y; x.f[2] = w.z; x.f[3] = w.w; }
    if constexpr (KIND == 3) { x.be = fp[0]; x.de = fp[4]; }
}

template <int KIND, int DH, int R>
__device__ __forceinline__ void scan_task(const Ctx& C, int row0, int T, int h, int slice, const float* sin, float* sout) {
    const bf16* PROJ = (const bf16*)(C.ws + WS_BIG); const bf16* SB = (const bf16*)(C.ws + WS_SB); const float* SF = (const float*)(C.ws + WS_SF);
    bf16* H = (bf16*)(C.ws + WS_H);
    const int lane = C.lane, dl = lane & 15, rw = lane >> 4;
    const int d0 = dl * DH, v0 = slice * (4 * R) + rw * R;
    constexpr int DK = 16 * DH;
    const bf16 *qp, *kp, *vp; const float* fp; int ks, vs;
    const bf16* sbr = SB + (size_t)row0 * SBW; const bf16* pr = PROJ + (size_t)row0 * NINP; const float* sfr = SF + (size_t)row0 * SFW;
    if constexpr (KIND == 0) { qp = sbr + SB_RQ + h * 64 + d0; kp = sbr + SB_RK + h * 64 + d0; ks = SBW; vp = pr + C_RV + h * 64 + v0; vs = NINP; fp = sfr; }
    if constexpr (KIND == 1) { qp = sbr + SB_AQ + h * 32 + d0; kp = pr + C_AK + h * 32 + d0; ks = NINP; vp = pr + C_AV + h * 64 + v0; vs = NINP; fp = sfr + SF_ADEC + h * 32 + d0; }
    if constexpr (KIND == 2) { qp = sbr + SB_HQ + h * 64 + d0; kp = sbr; ks = SBW; vp = pr + C_HI + h * 64 + v0; vs = NINP; fp = sfr + SF_HF + h * 64 + d0; }
    if constexpr (KIND == 3) { qp = sbr + SB_DQ + h * 64 + d0; kp = sbr + SB_DK + h * 64 + d0; ks = SBW; vp = sbr + SB_DV + h * 64 + v0; vs = SBW; fp = sfr + SF_BETA + h; }
    bf16* op = H + (size_t)row0 * D + KIND * 256 + h * 64 + v0;
    const float rdec = 1.0f - exp2f(-5.0f - (float)h);

    float S[DH][R];
#pragma unroll
    for (int dh = 0; dh < DH; ++dh)
#pragma unroll
        for (int vv = 0; vv < R; ++vv) S[dh][vv] = sin ? sin[(size_t)(d0 + dh) * 64 + v0 + vv] : 0.f;

    typedef Raw<KIND, DH, R> RawT;
    RawT A[4];
#pragma unroll
    for (int u = 0; u < 4; ++u) load_tok<KIND, DH, R>(A[u], qp + (size_t)u * SBW, kp + (size_t)u * ks, vp + (size_t)u * vs, fp + (size_t)u * SFW);
    for (int t0 = 0; t0 < T; t0 += 4) {
        RawT B[4];
        const bool more = t0 + 4 < T;
#pragma unroll
        for (int u = 0; u < 4; ++u) { B[u] = A[u]; }
        if (more) {
#pragma unroll
            for (int u = 0; u < 4; ++u) load_tok<KIND, DH, R>(B[u], qp + (size_t)(t0 + 4 + u) * SBW, kp + (size_t)(t0 + 4 + u) * ks, vp + (size_t)(t0 + 4 + u) * vs, fp + (size_t)(t0 + 4 + u) * SFW);
        }
#pragma unroll
        for (int u = 0; u < 4; ++u) {
            const RawT& x = A[u];
            float q[DH], k[DH], v[R];
            q[0] = bflo(x.q[0]); q[1] = bfhi(x.q[0]); if constexpr (DH == 4) { q[2] = bflo(x.q[1]); q[3] = bfhi(x.q[1]); }
            if constexpr (KIND != 2) { k[0] = bflo(x.k[0]); k[1] = bfhi(x.k[0]); if constexpr (DH == 4) { k[2] = bflo(x.k[1]); k[3] = bfhi(x.k[1]); } }
            if constexpr (R == 1) v[0] = bflo(x.v[0]);
            if constexpr (R >= 2) { v[0] = bflo(x.v[0]); v[1] = bfhi(x.v[0]); }
            if constexpr (R == 4) { v[2] = bflo(x.v[1]); v[3] = bfhi(x.v[1]); }
            float o[R];
            if constexpr (KIND == 3) {
                float ks_[R];
#pragma unroll
                for (int vv = 0; vv < R; ++vv) { float p = 0.f;
#pragma unroll
                    for (int dh = 0; dh < DH; ++dh) { S[dh][vv] *= x.de; p += k[dh] * S[dh][vv]; }
                    ks_[vv] = row16_sum(p); }
#pragma unroll
                for (int vv = 0; vv < R; ++vv) { const float uu = x.be * (v[vv] - ks_[vv]); float p = 0.f;
#pragma unroll
                    for (int dh = 0; dh < DH; ++dh) { S[dh][vv] += k[dh] * uu; p += q[dh] * S[dh][vv]; }
                    o[vv] = row16_sum(p); }
            } else {
#pragma unroll
                for (int dh = 0; dh < DH; ++dh) {
                    float dec, kk;
                    if constexpr (KIND == 0) { dec = rdec; kk = k[dh]; }
                    if constexpr (KIND == 1) { dec = x.f[dh]; kk = k[dh]; }
                    if constexpr (KIND == 2) { dec = x.f[dh]; kk = 1.0f - x.f[dh]; }
#pragma unroll
                    for (int vv = 0; vv < R; ++vv) S[dh][vv] = dec * S[dh][vv] + kk * v[vv];
                }
#pragma unroll
                for (int vv = 0; vv < R; ++vv) { float p = 0.f;
#pragma unroll
                    for (int dh = 0; dh < DH; ++dh) p += q[dh] * S[dh][vv];
                    o[vv] = row16_sum(p); }
            }
            if (dl == 0) {
                bf16* o_ = op + (size_t)(t0 + u) * D;
                if constexpr (R == 1) *o_ = (bf16)(pk2(o[0], 0.f) & 0xffffu);
                if constexpr (R == 2) *(unsigned*)o_ = pk2(o[0], o[1]);
                if constexpr (R == 4) *(v2u*)o_ = (v2u){pk2(o[0], o[1]), pk2(o[2], o[3])};
            }
        }
#pragma unroll
        for (int u = 0; u < 4; ++u) A[u] = B[u];
    }
#pragma unroll
    for (int dh = 0; dh < DH; ++dh)
#pragma unroll
        for (int vv = 0; vv < R; ++vv) sout[(size_t)(d0 + dh) * 64 + v0 + vv] = S[dh][vv];
    (void)DK;
}

template <int KIND, int DH, int R>
__device__ __forceinline__ void scan_long(const Ctx& C, LAS float* wl, int row0, int T, int h, int slice, float* sout) {
    constexpr int CT = 16, DK = 16 * DH, NV = 4 * R, UNR = 4;
    constexpr bool HASK = true, GK = (KIND != 2), HASF = (KIND == 1 || KIND == 2), HASB = (KIND == 3);
    constexpr int OQ = 0, OK_ = OQ + CT * DK, OF = OK_ + (HASK ? CT * DK : 0), OV = OF + (HASF ? CT * DK : 0), OB = OV + CT * NV, BUF = OB + (HASB ? CT * 2 : 0);
    const bf16* PROJ = (const bf16*)(C.ws + WS_BIG); const bf16* SB = (const bf16*)(C.ws + WS_SB); const float* SF = (const float*)(C.ws + WS_SF);
    bf16* H = (bf16*)(C.ws + WS_H);
    const int lane = C.lane, dl = lane & 15, rw = lane >> 4;
    const int d0 = dl * DH;
    const int stok = lane >> 2, spart = lane & 3;
    const GAS bf16 *qg, *kg, *vg; const GAS float *fg, *bg; int ks, vs;
    {
        const GAS bf16* sbr = (const GAS bf16*)(SB + (size_t)row0 * SBW); const GAS bf16* pr = (const GAS bf16*)(PROJ + (size_t)row0 * NINP); const GAS float* sfr = (const GAS float*)(SF + (size_t)row0 * SFW);
        const int vcol = slice * NV;
        if constexpr (KIND == 0) { qg = sbr + SB_RQ + h * 64; kg = sbr + SB_RK + h * 64; ks = SBW; vg = pr + C_RV + h * 64 + vcol; vs = NINP; fg = sfr; bg = sfr; }
        if constexpr (KIND == 1) { qg = sbr + SB_AQ + h * 32; kg = pr + C_AK + h * 32; ks = NINP; vg = pr + C_AV + h * 64 + vcol; vs = NINP; fg = sfr + SF_ADEC + h * 32; bg = sfr; }
        if constexpr (KIND == 2) { qg = sbr + SB_HQ + h * 64; kg = sbr; ks = SBW; vg = pr + C_HI + h * 64 + vcol; vs = NINP; fg = sfr + SF_HF + h * 64; bg = sfr; }
        if constexpr (KIND == 3) { qg = sbr + SB_DQ + h * 64; kg = sbr + SB_DK + h * 64; ks = SBW; vg = sbr + SB_DV + h * 64 + vcol; vs = SBW; fg = sfr; bg = sfr + SF_BETA + h; }
    }
    constexpr int QP = DK / 4;
    qg += (size_t)stok * SBW + spart * QP; kg += (size_t)stok * ks + spart * QP; fg += (size_t)stok * SFW + spart * QP;
    vg += (size_t)(lane & 15) * vs; bg += (size_t)(lane & 15) * SFW;
    GAS bf16* op = (GAS bf16*)(H + (size_t)row0 * D + KIND * 256 + h * 64 + slice * NV + rw * R);
    const float rdec = 1.0f - exp2f(-5.0f - (float)h);

    float S[DH][R];
#pragma unroll
    for (int dh = 0; dh < DH; ++dh)
#pragma unroll
        for (int vv = 0; vv < R; ++vv) S[dh][vv] = 0.f;

    struct SR { v4u rq[QP / 8], rk[QP / 8]; f32x4 rf[QP / 4]; unsigned rv[NV / 2]; float rb0, rb1; };
    SR s0, s1; s0.rb0 = s0.rb1 = s1.rb0 = s1.rb1 = 0.f;
    auto stage_load = [&](SR& sr, int c) {
        const size_t t = (size_t)c * CT;
#pragma unroll
        for (int i = 0; i < QP / 8; ++i) { sr.rq[i] = *(const GAS v4u*)(qg + t * SBW + i * 8); if constexpr (GK) sr.rk[i] = *(const GAS v4u*)(kg + t * ks + i * 8); }
        if constexpr (HASF) {
#pragma unroll
            for (int i = 0; i < QP / 4; ++i) sr.rf[i] = *(const GAS f32x4*)(fg + t * SFW + i * 4); }
        if (lane < 16) {
            if constexpr (NV == 4) { const v2u w = *(const GAS v2u*)(vg + t * vs); sr.rv[0] = w.x; sr.rv[1] = w.y; }
            if constexpr (NV == 8) { const v4u w = *(const GAS v4u*)(vg + t * vs); sr.rv[0] = w.x; sr.rv[1] = w.y; sr.rv[2] = w.z; sr.rv[3] = w.w; }
            if constexpr (NV == 16) { const v4u w = *(const GAS v4u*)(vg + t * vs), w2 = *(const GAS v4u*)(vg + t * vs + 8); sr.rv[0] = w.x; sr.rv[1] = w.y; sr.rv[2] = w.z; sr.rv[3] = w.w; sr.rv[4] = w2.x; sr.rv[5] = w2.y; sr.rv[6] = w2.z; sr.rv[7] = w2.w; }
            if constexpr (HASB) { sr.rb0 = bg[t * SFW]; sr.rb1 = bg[t * SFW + 4]; }
        }
    };
    auto stage_write = [&](SR& sr, int b) {
        LAS float* base = wl + b * BUF;
#pragma unroll
        for (int i = 0; i < QP / 8; ++i) {
            LAS float* qd = base + OQ + stok * DK + spart * QP + i * 8;
            *(LAS f32x4*)qd = (f32x4){bflo(sr.rq[i].x), bfhi(sr.rq[i].x), bflo(sr.rq[i].y), bfhi(sr.rq[i].y)}; *(LAS f32x4*)(qd + 4) = (f32x4){bflo(sr.rq[i].z), bfhi(sr.rq[i].z), bflo(sr.rq[i].w), bfhi(sr.rq[i].w)};
            if constexpr (GK) { LAS float* kd = base + OK_ + stok * DK + spart * QP + i * 8;
                *(LAS f32x4*)kd = (f32x4){bflo(sr.rk[i].x), bfhi(sr.rk[i].x), bflo(sr.rk[i].y), bfhi(sr.rk[i].y)}; *(LAS f32x4*)(kd + 4) = (f32x4){bflo(sr.rk[i].z), bfhi(sr.rk[i].z), bflo(sr.rk[i].w), bfhi(sr.rk[i].w)}; }
        }
        if constexpr (HASF) {
#pragma unroll
            for (int i = 0; i < QP / 4; ++i) { *(LAS f32x4*)(base + OF + stok * DK + spart * QP + i * 4) = sr.rf[i];
                if constexpr (KIND == 2) *(LAS f32x4*)(base + OK_ + stok * DK + spart * QP + i * 4) = 1.0f - sr.rf[i]; } }
        if (lane < 16) {
#pragma unroll
            for (int i = 0; i < NV / 2; ++i) { base[OV + lane * NV + 2 * i] = bflo(sr.rv[i]); base[OV + lane * NV + 2 * i + 1] = bfhi(sr.rv[i]); }
            if constexpr (HASB) { base[OB + lane * 2] = sr.rb0; base[OB + lane * 2 + 1] = sr.rb1; }
        }
    };
    static_assert(2 * BUF * 4 <= 32768, "per-wave LDS");
    const int nch = T / CT;
    auto compute = [&](int c, const LAS float* base) {
float okeep[R];
#pragma unroll
        for (int vv = 0; vv < R; ++vv) okeep[vv] = 0.f;
#pragma unroll 1
        for (int ub = 0; ub < CT; ub += UNR)
#pragma unroll
        for (int uu_ = 0; uu_ < UNR; ++uu_) { const int u = ub + uu_;
            float q[DH], k[DH], f[DH], v[R];
            if constexpr (DH == 4) { const f32x4 w = *(const LAS f32x4*)(base + OQ + u * DK + d0); q[0] = w.x; q[1] = w.y; q[2] = w.z; q[3] = w.w; }
            else { const f32x2 w = *(const LAS f32x2*)(base + OQ + u * DK + d0); q[0] = w.x; q[1] = w.y; }
            if constexpr (HASK) {
                if constexpr (DH == 4) { const f32x4 w = *(const LAS f32x4*)(base + OK_ + u * DK + d0); k[0] = w.x; k[1] = w.y; k[2] = w.z; k[3] = w.w; }
                else { const f32x2 w = *(const LAS f32x2*)(base + OK_ + u * DK + d0); k[0] = w.x; k[1] = w.y; } }
            if constexpr (HASF) {
                if constexpr (DH == 4) { const f32x4 w = *(const LAS f32x4*)(base + OF + u * DK + d0); f[0] = w.x; f[1] = w.y; f[2] = w.z; f[3] = w.w; }
                else { const f32x2 w = *(const LAS f32x2*)(base + OF + u * DK + d0); f[0] = w.x; f[1] = w.y; } }
            if constexpr (R == 1) v[0] = base[OV + u * NV + rw];
            if constexpr (R == 2) { const f32x2 w = *(const LAS f32x2*)(base + OV + u * NV + rw * 2); v[0] = w.x; v[1] = w.y; }
            if constexpr (R == 4) { const f32x4 w = *(const LAS f32x4*)(base + OV + u * NV + rw * 4); v[0] = w.x; v[1] = w.y; v[2] = w.z; v[3] = w.w; }
            float o[R];
            if constexpr (KIND == 3) {
                const f32x2 bd = *(const LAS f32x2*)(base + OB + u * 2);
                float ks_[R];
#pragma unroll
                for (int vv = 0; vv < R; ++vv) { float p = 0.f;
#pragma unroll
                    for (int dh = 0; dh < DH; ++dh) { S[dh][vv] *= bd.y; p += k[dh] * S[dh][vv]; }
                    ks_[vv] = row16_sum(p); }
#pragma unroll
                for (int vv = 0; vv < R; ++vv) { const float uu = bd.x * (v[vv] - ks_[vv]); float p = 0.f;
#pragma unroll
                    for (int dh = 0; dh < DH; ++dh) { S[dh][vv] += k[dh] * uu; p += q[dh] * S[dh][vv]; }
                    o[vv] = row16_sum(p); }
            } else {
#pragma unroll
                for (int dh = 0; dh < DH; ++dh) {
                    float dec, kk;
                    if constexpr (KIND == 0) { dec = rdec; kk = k[dh]; }
                    if constexpr (KIND == 1) { dec = f[dh]; kk = k[dh]; }
                    if constexpr (KIND == 2) { dec = f[dh]; kk = k[dh]; }
#pragma unroll
                    for (int vv = 0; vv < R; ++vv) S[dh][vv] = dec * S[dh][vv] + kk * v[vv];
                }
#pragma unroll
                for (int vv = 0; vv < R; ++vv) { float p = 0.f;
#pragma unroll
                    for (int dh = 0; dh < DH; ++dh) p += q[dh] * S[dh][vv];
                    o[vv] = row16_sum(p); }
            }
#pragma unroll
            for (int vv = 0; vv < R; ++vv) okeep[vv] = (dl == u) ? o[vv] : okeep[vv];
        }
        {
            GAS bf16* o_ = op + (size_t)(c * CT + dl) * D;
            if constexpr (R == 1) *o_ = (bf16)(pk2(okeep[0], 0.f) & 0xffffu);
            if constexpr (R == 2) *(GAS unsigned*)o_ = pk2(okeep[0], okeep[1]);
            if constexpr (R == 4) *(GAS v2u*)o_ = (v2u){pk2(okeep[0], okeep[1]), pk2(okeep[2], okeep[3])};
        }
    };
    stage_load(s0, 0); stage_write(s0, 0); stage_load(s1, 1);
#pragma unroll 1
    for (int c = 0; c < nch; c += 2) {
        stage_load(s0, min(c + 2, nch - 1));
        compute(c, wl);
        stage_write(s1, 1);
        stage_load(s1, min(c + 3, nch - 1));
        compute(c + 1, wl + BUF);
        stage_write(s0, 0);
    }
    const int v0 = slice * NV + rw * R;
#pragma unroll
    for (int dh = 0; dh < DH; ++dh)
#pragma unroll
        for (int vv = 0; vv < R; ++vv) sout[(size_t)(d0 + dh) * 64 + v0 + vv] = S[dh][vv];
}

__device__ __forceinline__ void scan_phase(const Args& args, LAS unsigned char* lds_, int l, int mode = 0) {
    const Ctx C = make_ctx(args, lds_);
    constexpr int NLONG = 1024, NSHORT = BS * 144;
    const int slot = C.wave * 256 + (int)blockIdx.x;
    const int nidle = C.NGW - NLONG;
    for (int it = 0;; ++it) {
        int kind, b, h, slice, row0, T; bool isp;
        if (slot < NLONG) { if (it > 0 || mode == 2) break; isp = true; T = TP;
            const int kk_ = slot >> 8, i = slot & 255; kind = kk_ == 0 ? 3 : (kk_ == 1 ? 0 : (kk_ == 2 ? 2 : 1));
            { const int stream = (i & 7) | ((i >> 6) << 3); slice = (i >> 3) & 7; b = stream >> 2; h = stream & 3; }
            row0 = b * TP;
        } else { const int st = (slot - NLONG) + it * nidle; if (st >= NSHORT || mode == 1) break; isp = false; T = TS;
            b = st / 144; int i = st - b * 144;
            if (i < 64) { kind = 3; h = i >> 4; slice = i & 15; }
            else if (i < 96) { i -= 64; kind = 0; h = i >> 3; slice = i & 7; }
            else if (i < 128) { i -= 96; kind = 2; h = i >> 3; slice = i & 7; }
            else { i -= 128; kind = 1; h = i >> 2; slice = i & 3; }
            row0 = MP + b * TS;
        }
        const int nbat = isp ? BP : BS;
        const size_t sidx = (size_t)((l * nbat + b) * 4 + h);
        if (isp) {
            LAS float* wl = (LAS float*)(C.lds + C.wave * 32768);
            if (kind == 0) scan_long<0, 4, 2>(C, wl, row0, T, h, slice, C.out + O_PRET + sidx * 4096);
            else if (kind == 1) scan_long<1, 2, 2>(C, wl, row0, T, h, slice, C.out + O_PGLA + sidx * 2048);
            else if (kind == 2) scan_long<2, 4, 2>(C, wl, row0, T, h, slice, C.out + O_PHG + sidx * 4096);
            else scan_long<3, 4, 2>(C, wl, row0, T, h, slice, C.out + O_PGDN + sidx * 4096);
        } else {
            if (kind == 0) { scan_task<0, 4, 2>(C, row0, T, h, slice, args.in[2] + sidx * 4096, C.out + O_SRET + sidx * 4096); }
            else if (kind == 1) { scan_task<1, 2, 4>(C, row0, T, h, slice, args.in[3] + sidx * 2048, C.out + O_SGLA + sidx * 2048); }
            else if (kind == 2) { scan_task<2, 4, 2>(C, row0, T, h, slice, args.in[4] + sidx * 4096, C.out + O_SHG + sidx * 4096); }
            else { scan_task<3, 4, 1>(C, row0, T, h, slice, args.in[5] + sidx * 4096, C.out + O_SGDN + sidx * 4096); }
        }
    }
}

__device__ __forceinline__ void post_phase(const Args& args, LAS unsigned char* lds_, int l) {
    const Ctx C = make_ctx(args, lds_);
    const bf16* PROJ = (const bf16*)(C.ws + WS_BIG); bf16* H = (bf16*)(C.ws + WS_H);
    const int lane = C.lane, mixer = lane >> 4, cc = (lane & 15) * 16;
    const int gbase = mixer == 0 ? C_RG : mixer == 1 ? C_AG : mixer == 2 ? C_HG : C_DG;
    const float* nw = mixer == 1 ? args.in[24] + l * 64 : mixer == 2 ? args.in[25] + l * 64 : args.in[26] + l * 64;
    float w[16];
#pragma unroll
    for (int i = 0; i < 16; ++i) w[i] = mixer == 0 ? 1.0f : nw[(cc + i) & 63];
    for (int r = C.gw; r < M; r += C.NGW) {
        bf16* hp = H + (size_t)r * D + lane * 16; const bf16* gp = PROJ + (size_t)r * NINP + gbase + cc;
        const v4u a0 = *(const v4u*)hp, a1 = *(const v4u*)(hp + 8);
        const v4u g0 = *(const v4u*)gp, g1 = *(const v4u*)(gp + 8);
        float y[16], g[16];
        const unsigned aw[8] = {a0.x, a0.y, a0.z, a0.w, a1.x, a1.y, a1.z, a1.w}, gw_[8] = {g0.x, g0.y, g0.z, g0.w, g1.x, g1.y, g1.z, g1.w};
        float ss = 0.f;
#pragma unroll
        for (int i = 0; i < 8; ++i) { y[2 * i] = bflo(aw[i]); y[2 * i + 1] = bfhi(aw[i]); g[2 * i] = bflo(gw_[i]); g[2 * i + 1] = bfhi(gw_[i]); ss += y[2 * i] * y[2 * i] + y[2 * i + 1] * y[2 * i + 1]; }
        ss = quad_sum(ss);
        const float rs = rsqrtf(ss * (1.0f / 64.0f) + RMS_EPS);
        unsigned ow[8];
#pragma unroll
        for (int i = 0; i < 8; ++i) ow[i] = pk2(y[2 * i] * rs * w[2 * i] * siluf_(g[2 * i]), y[2 * i + 1] * rs * w[2 * i + 1] * siluf_(g[2 * i + 1]));
        *(v4u*)hp = (v4u){ow[0], ow[1], ow[2], ow[3]}; *(v4u*)(hp + 8) = (v4u){ow[4], ow[5], ow[6], ow[7]};
    }
}

__global__ void __launch_bounds__(NWAVES * 64, 2) mega_fwd(Args args) {
    extern __shared__ __attribute__((aligned(16))) unsigned char lds[];
    cg::grid_group grid = cg::this_grid();
    LAS unsigned char* const LDSP = (LAS unsigned char*)lds;
    const int G = (int)gridDim.x, bx = (int)blockIdx.x;
    if (threadIdx.x < 64) ((LAS unsigned*)(LDSP + MISC_OFF))[threadIdx.x] = 0u;
    __syncthreads();
    (void)xcd_barrier_post((unsigned*)args.ws, (volatile LAS unsigned*)(LDSP + MISC_OFF));
#define FRESH() float* out_ = fresh_ptr(args.out); unsigned char* ws = fresh_ptr(args.ws); \
    float* MOD = (float*)(ws + WS_MOD); bf16* H = (bf16*)(ws + WS_H); bf16* BIG = (bf16*)(ws + WS_BIG); (void)MOD; (void)H; (void)BIG; (void)out_;

    p0_prologue(args, LDSP);
    grid.sync();
    {
        FRESH();
        pg8::Gemm g{(const bf16*)(ws + WS_AC), BIG, 256, 2 * NMODC, D}; pg8::StaticOrder S; S.init(256, 2 * NMODC, G, bx);
        pg8::EpiMod E{MOD, args.in[10]};
        pg8::gemm_phase<pg8::EpiMod, pg8::StaticOrder, PG8_ALIGN, PG8_SP2>(LDSP, g, S, E);
    }
    grid_bar(args, LDSP);
    p2_modulate0(args, LDSP);
    grid_bar(args, LDSP);
#pragma unroll 1
    for (int l = 0; l < 2; ++l) {
#pragma unroll 1
        for (int f = 0; f < 2; ++f) {
            if (f == 1) {
                {
                    FRESH();
                    pg8::Gemm g{H, (const bf16*)(ws + WS_W + (size_t)l * W_LAYER + W_WIN), M, NINP, D}; pg8::StaticOrder S; S.init(M, NINP, G, bx);
                    pg8::EpiPlain E{BIG, NINP};
                    pg8::gemm_phase<pg8::EpiPlain, pg8::StaticOrder, PG8_ALIGN, PG8_SP2>(LDSP, g, S, E);
                }
                grid_bar(args, LDSP);
                prep_phase(args, LDSP, l);
                grid_bar(args, LDSP);
                scan_phase(args, LDSP, l);
#ifdef PROBE_SCANMODE
                grid_bar(args, LDSP); scan_phase(args, LDSP, l, PROBE_SCANMODE);
#endif
                grid_bar(args, LDSP);
                post_phase(args, LDSP, l);
                grid_bar(args, LDSP);
                {
                    FRESH();
                    pg8::Gemm g{H, (const bf16*)(ws + WS_W + (size_t)l * W_LAYER + W_WOUT), M, D, D}; pg8::StaticOrder S; S.init(M, D, G, bx);
                    pg8::EpiRes E{out_, out_ + (size_t)MP * D, out_, MOD + (size_t)l * NB * NMODC + 5 * 1024, ALPHA, 1.0f};
                    pg8::gemm_phase<pg8::EpiRes, pg8::StaticOrder, PG8_ALIGN, PG8_SP2>(LDSP, g, S, E);
                }
                grid_bar(args, LDSP);
                ln_phase(args, LDSP, l, 1, true, l, 6);
                grid_bar(args, LDSP);
            }
            {
                FRESH();
                pg8::Gemm g{H, (const bf16*)(ws + WS_W + (size_t)l * W_LAYER + (f ? W_WI2 : W_WI1)), M, NWI, D}; pg8::StaticOrder S; S.init(M, NWI, G, bx);
                pg8::EpiSwiglu E{BIG, DFF};
                pg8::gemm_phase<pg8::EpiSwiglu, pg8::StaticOrder, PG8_ALIGN, PG8_SP2>(LDSP, g, S, E);
            }
            grid_bar(args, LDSP);
            {
                FRESH();
                const bool first = (l == 0 && f == 0);
                pg8::Gemm g{BIG, (const bf16*)(ws + WS_W + (size_t)l * W_LAYER + (f ? W_WO2 : W_WO1)), M, D, DFF}; pg8::StaticOrder S; S.init(M, D, G, bx);
                pg8::EpiRes E{first ? args.in[0] : out_, first ? args.in[1] : out_ + (size_t)MP * D, out_, MOD + (size_t)l * NB * NMODC + (f ? 8 : 2) * 1024, ALPHA, 0.5f};
                pg8::gemm_phase<pg8::EpiRes, pg8::StaticOrder, PG8_ALIGN, PG8_SP2>(LDSP, g, S, E);
            }
            grid_bar(args, LDSP);
            if (f == 0) ln_phase(args, LDSP, l, 0, true, l, 3);
            else ln_phase(args, LDSP, l, 2, l == 0, 1, 0);
            if (!(l == 1 && f == 1)) grid_bar(args, LDSP);
        }
    }
}

extern "C" void kernel_launch(void* const* d_in, const int* in_sizes, int n_in, void* d_out, int out_size, void* d_ws, size_t ws_size, hipStream_t stream) {
    static int grid = 0;
    if (grid == 0) {
        if (n_in != 28 || (size_t)out_size != O_END || ws_size < WS_END) { fprintf(stderr, "kernel_launch: unexpected sizes n_in %d out %d ws %zu (need %zu)\n", n_in, out_size, ws_size, (size_t)WS_END); grid = -1; return; }
        int dev = 0, cus = 0, per_cu = 0;
        hipGetDevice(&dev); hipDeviceGetAttribute(&cus, hipDeviceAttributeMultiprocessorCount, dev);
        hipFuncSetAttribute((const void*)mega_fwd, hipFuncAttributeMaxDynamicSharedMemorySize, LDS_BYTES);
        hipOccupancyMaxActiveBlocksPerMultiprocessor(&per_cu, (const void*)mega_fwd, NWAVES * 64, LDS_BYTES);
        (void)hipGetLastError();
        if (per_cu < 1 || cus < 256) { fprintf(stderr, "kernel_launch: occupancy %d cus %d\n", per_cu, cus); grid = -1; return; }
        grid = 256;
    }
    if (grid < 0) return;
    if (hipMemsetAsync(d_ws, 0, 65536, stream) != hipSuccess) { fprintf(stderr, "memset failed\n"); return; }
    Args a{};
    for (int i = 0; i < 28; ++i) a.in[i] = (const float*)d_in[i];
    a.out = (float*)d_out; a.ws = (unsigned char*)d_ws;
    void* kargs[] = {&a};
    hipError_t e = hipLaunchCooperativeKernel((const void*)mega_fwd, dim3(grid), dim3(NWAVES * 64), kargs, LDS_BYTES, stream);
    if (e != hipSuccess) fprintf(stderr, "cooperative launch failed: %s\n", hipGetErrorString(e));
}
```

```cpp
#include <hip/hip_runtime.h>
#include <hip/hip_cooperative_groups.h>
#include <cstdio>
#include <cstdint>
namespace cg = cooperative_groups;
namespace pg8 {
#define PG8_LAS __attribute__((address_space(3)))
typedef unsigned short bf16_t;
typedef short bf16x8 __attribute__((ext_vector_type(8)));
typedef float f32x4 __attribute__((ext_vector_type(4)));
typedef unsigned u32x4 __attribute__((ext_vector_type(4)));
constexpr int BM = 256, BK = 64, HALF = 128, HTB = HALF * BK * 2  , STAGE_BYTES = 8 * HTB, NXCD = 8, WGM = 8;

__host__ __device__ __forceinline__ int lds_byte(int r, int c) { const int st = (r >> 4) * 2 + (c >> 5), rr = r & 15, cc = c & 31, ob = rr * 64 + cc * 2; return st * 1024 + (ob ^ (((ob >> 9) & 1) << 5)); }
__host__ __device__ __forceinline__ void stage_rc(int b, int& R, int& C) { const int st = b / 1024, sb = b % 1024, swz = sb ^ (((sb >> 9) & 1) << 5); R = (st >> 1) * 16 + swz / 64; C = (st & 1) * 32 + (swz % 64) / 2; }
__host__ __device__ __forceinline__ int perm32(int rho) { const int n = rho >> 4, i = rho & 15; return 8 * (i >> 2) + 4 * n + (i & 3); }

struct Unit { int pm, pn, k0, nt; };
struct Gemm { const bf16_t* A; const bf16_t* Bt; int M, N, K; };

struct StaticOrder {
    int nM, nN, nwg, G, c, ntf;
    __host__ __device__ void init(int M, int N, int G_, int c_, int K_ = 1024) { nM = M / BM; nN = N / BM; nwg = nM * nN; G = G_; c = c_; ntf = K_ / BK; }
    __host__ __device__ bool next(int i, Unit& u) const {
        const long L = (long)i * G + c; if (L >= nwg) return false;
        int wgid = (int)L; { const int q = nwg / NXCD, r = nwg % NXCD, xcd = wgid % NXCD, off = wgid / NXCD; wgid = (xcd < r ? xcd * (q + 1) : r * (q + 1) + (xcd - r) * q) + off; }
        const int nig = WGM * nN, gid = wgid / nig, fm = gid * WGM, gsz = (nM - fm) < WGM ? (nM - fm) : WGM;
        u.pm = fm + ((wgid % nig) % gsz); u.pn = (wgid % nig) / gsz; u.k0 = 0; u.nt = ntf; return true;
    }
    __device__ __forceinline__ void a_ready(const Unit&) const {}
    __device__ __forceinline__ void done(const Unit&) const {}
};

struct SplitOrder {
    StaticOrder base; int ppu, c;
    static constexpr int PK = 4;
    __host__ __device__ void init(int K_, int G_, int c_) { base.init(16384, 1024, G_, c_, K_); ppu = (K_ / BK) / PK; c = c_; }
    __host__ __device__ bool next(int i, Unit& u) const {
        if (i == 0) return base.next(0, u);
        if (i == 1 && c < 8 * ppu) { const int j = c / ppu, p = c - j * ppu; u.pm = 64 + (j >> 2); u.pn = j & 3; u.k0 = p * PK; u.nt = PK; return true; }
        return false;
    }
    __device__ __forceinline__ void a_ready(const Unit&) const {}
    __device__ __forceinline__ void done(const Unit&) const {}
};

__device__ __forceinline__ unsigned cvt_pk_bf16(float lo, float hi) { unsigned r; asm volatile("v_cvt_pk_bf16_f32 %0, %1, %2" : "=v"(r) : "v"(lo), "v"(hi)); return r; }
typedef float f32x2 __attribute__((ext_vector_type(2)));
__device__ __forceinline__ f32x2 gelu_pk(f32x2 v) {
    const f32x2 av = __builtin_elementwise_abs(v), d = av * 0.2316418882f + 1.0f;
    f32x2 t; t.x = __builtin_amdgcn_rcpf(d.x); t.y = __builtin_amdgcn_rcpf(d.y);
    f32x2 q = t * 0.5307027145f + (-0.7265760135f); q = q * t + 0.7107068705f; q = q * t + (-0.142248368f); q = q * t + 0.127414796f; q = q * t;
    const f32x2 s = (v * v) * (-0.72134752044f);
    f32x2 e; e.x = __builtin_amdgcn_exp2f(s.x); e.y = __builtin_amdgcn_exp2f(s.y);
    const f32x2 m = v * (q * e), r = v - m;
    f32x2 o; o.x = v.x < 0.f ? m.x : r.x; o.y = v.y < 0.f ? m.y : r.y; return o;
}

template <int ACT  > struct EpiBf16 {
    static constexpr bool PERM = true, AFTER_DRAIN = false; static_assert(ACT == 0 || ACT == 1, "EpiBf16: ACT is 0 (none) or 1 (gelu_pk)");
    bf16_t* O; int ldc; const float* bias; int split_cols; size_t split_stride; float scale0;
    __device__ __forceinline__ void operator()(const f32x4 (&acc)[2][2][4][2], const Unit& u, int wr, int wc, int fr, int fq) const {
        const int row0 = u.pm * BM + wr * 64 + fr; int colt = u.pn * BM; bf16_t* base = O;
        float sc = 1.f; if (split_cols) { const int t = colt / split_cols; base += (size_t)t * split_stride; colt -= t * split_cols; if (t == 0) sc = scale0; }
        const int col0 = colt + wc * 32 + 8 * fq, bcol0 = u.pn * BM + wc * 32 + 8 * fq;
        f32x4 bv[2][2];
#pragma unroll
        for (int bj = 0; bj < 2; ++bj)
#pragma unroll
            for (int n = 0; n < 2; ++n) bv[bj][n] = bias ? *(const f32x4*)(bias + bcol0 + bj * HALF + 4 * n) : (f32x4){0.f, 0.f, 0.f, 0.f};
#pragma unroll
        for (int ai = 0; ai < 2; ++ai)
#pragma unroll
            for (int m = 0; m < 4; ++m) { bf16_t* rowp = base + (size_t)(row0 + ai * HALF + m * 16) * ldc + col0;
#pragma unroll
                for (int bj = 0; bj < 2; ++bj) { f32x4 v0 = acc[ai][bj][m][0] + bv[bj][0], v1 = acc[ai][bj][m][1] + bv[bj][1];
                    if (ACT == 1) { f32x2 a = gelu_pk((f32x2){v0[0], v0[1]}), b = gelu_pk((f32x2){v0[2], v0[3]}), c = gelu_pk((f32x2){v1[0], v1[1]}), d = gelu_pk((f32x2){v1[2], v1[3]});
                        v0 = (f32x4){a.x, a.y, b.x, b.y}; v1 = (f32x4){c.x, c.y, d.x, d.y}; }
                    v0 = v0 * sc; v1 = v1 * sc; u32x4 w; w.x = cvt_pk_bf16(v0[0], v0[1]); w.y = cvt_pk_bf16(v0[2], v0[3]); w.z = cvt_pk_bf16(v1[0], v1[1]); w.w = cvt_pk_bf16(v1[2], v1[3]);
                    *(u32x4*)(rowp + bj * HALF) = w; } }
    }
};
template <class Epi, class Sched, bool ALIGN_EPI = false, bool SP2 = false>
__device__ __forceinline__ void gemm_phase(PG8_LAS unsigned char* lds, const Gemm g, const Sched& S, const Epi& E) {
    int tid_ = threadIdx.x; asm volatile("" : "+v"(tid_));
    const int tid = tid_, wid = __builtin_amdgcn_readfirstlane(tid >> 6), lane = tid & 63, wr = wid >> 2, wc = wid & 3, fr = lane & 15, fq = lane >> 4;
    const int K = g.K;
    unsigned voffA[2], voffB[2];
#pragma unroll
    for (int i = 0; i < 2; ++i) { int R, C; stage_rc(tid * 16 + i * 8192, R, C); const int Rb = Epi::PERM ? ((R & ~31) + perm32(R & 31)) : R;
        voffA[i] = (unsigned)(R * K + C) * 2u; voffB[i] = (unsigned)(Rb * K + C) * 2u; }
    const size_t kstep = (size_t)(BK * 2);
    const size_t hstep = (size_t)HALF * K * 2;
    const size_t tstep = 2 * hstep;
    const unsigned ldsw = (unsigned)wid * 1024u;
    const int aoff = lds_byte(wr * 64 + fr, fq * 8), boff = lds_byte(wc * 32 + fr, fq * 8);
#define PG8_SA(b, h) (((b) * 2 + (h)) * HTB)
#define PG8_SB(b, h) ((4 + (b) * 2 + (h)) * HTB)
#define PG8_STAGE(bufoff, gbase, voff) do { _Pragma("unroll") for (int _i = 0; _i < 2; ++_i) \
        __builtin_amdgcn_global_load_lds((const unsigned*)((const char*)(gbase) + (voff)[_i]), (PG8_LAS unsigned*)(lds + (bufoff) + ldsw + _i * 8192), 16, 0, 0); } while (0)
#define PG8_LDA(dst, b, h) do { _Pragma("unroll") for (int m = 0; m < 4; ++m) _Pragma("unroll") for (int k = 0; k < 2; ++k) dst[m][k] = *(const PG8_LAS bf16x8*)(lds + PG8_SA(b, h) + aoff + m * 2048 + k * 1024); } while (0)
#define PG8_LDB(dst, b, h) do { _Pragma("unroll") for (int n = 0; n < 2; ++n) _Pragma("unroll") for (int k = 0; k < 2; ++k) dst[n][k] = *(const PG8_LAS bf16x8*)(lds + PG8_SB(b, h) + boff + n * 2048 + k * 1024); } while (0)
#define PG8_MMA(ai, bj, At, Bt) do { __builtin_amdgcn_s_setprio(1); _Pragma("unroll") for (int m = 0; m < 4; ++m) _Pragma("unroll") for (int n = 0; n < 2; ++n) _Pragma("unroll") for (int k = 0; k < 2; ++k) \
        acc[ai][bj][m][n] = __builtin_amdgcn_mfma_f32_16x16x32_bf16(Bt[n][k], At[m][k], acc[ai][bj][m][n], 0, 0, 0); __builtin_amdgcn_s_setprio(0); } while (0)
#define PG8_WAIT_V(n) asm volatile("s_waitcnt vmcnt(" #n ")" ::: "memory")
#define PG8_WAIT_L(n) asm volatile("s_waitcnt lgkmcnt(" #n ")" ::: "memory")
#define PG8_BAR __builtin_amdgcn_s_barrier()
#define PG8_SCHED __builtin_amdgcn_sched_barrier(0)
    Unit cur, nxt; int ui = 0;
    if (!S.next(0, cur)) return;
    f32x4 acc[2][2][4][2];
#pragma unroll
    for (int a = 0; a < 2; ++a)
#pragma unroll
        for (int b = 0; b < 2; ++b)
#pragma unroll
            for (int m = 0; m < 4; ++m)
#pragma unroll
                for (int n = 0; n < 2; ++n) acc[a][b][m][n] = (f32x4){0.f, 0.f, 0.f, 0.f};
    bf16x8 At[4][2], B0[2][2], B1[2][2];
    const char* cA = (const char*)g.A + (size_t)cur.pm * tstep + (size_t)cur.k0 * kstep; const char* cB = (const char*)g.Bt + (size_t)cur.pn * tstep + (size_t)cur.k0 * kstep;
    S.a_ready(cur);
    if constexpr (SP2) {
        PG8_STAGE(PG8_SB(0, 0), cB, voffB); PG8_STAGE(PG8_SB(0, 1), cB + hstep, voffB); PG8_STAGE(PG8_SA(0, 0), cA, voffA); PG8_STAGE(PG8_SA(0, 1), cA + hstep, voffA);
        if (wr == 1) PG8_BAR;
        PG8_WAIT_V(2); PG8_BAR;
        PG8_STAGE(PG8_SB(1, 0), cB + kstep, voffB); PG8_STAGE(PG8_SA(1, 0), cA + kstep, voffA); PG8_STAGE(PG8_SB(1, 1), cB + hstep + kstep, voffB);
        PG8_WAIT_V(6); PG8_BAR;
    } else {
        PG8_STAGE(PG8_SB(0, 0), cB, voffB); PG8_STAGE(PG8_SA(0, 0), cA, voffA); PG8_STAGE(PG8_SB(0, 1), cB + hstep, voffB); PG8_STAGE(PG8_SA(0, 1), cA + hstep, voffA);
        if (wr == 1) PG8_BAR;
        PG8_WAIT_V(4); PG8_BAR;
        PG8_STAGE(PG8_SB(1, 0), cB + kstep, voffB); PG8_STAGE(PG8_SA(1, 0), cA + kstep, voffA); PG8_STAGE(PG8_SB(1, 1), cB + hstep + kstep, voffB);
        PG8_WAIT_V(6); PG8_BAR;
    }
    for (;;) {
        const bool has_next = S.next(ui + 1, nxt);
        const char* nA = has_next ? (const char*)g.A + (size_t)nxt.pm * tstep + (size_t)nxt.k0 * kstep : cA; const char* nB = has_next ? (const char*)g.Bt + (size_t)nxt.pn * tstep + (size_t)nxt.k0 * kstep : cB;
        const int nt = cur.nt;
        for (int t = 0; t < nt; t += 2) {
            const bool last = (t == nt - 2);
            const char* a1 = cA + (size_t)(t + 1) * kstep;
            const char* a2 = last ? nA : cA + (size_t)(t + 2) * kstep; const char* b2 = last ? nB : cB + (size_t)(t + 2) * kstep;
            const char* a3 = a2 + kstep; const char* b3 = b2 + kstep;
            if (last && has_next) S.a_ready(nxt);
            if constexpr (SP2) {
            PG8_LDB(B0, 0, 0); PG8_LDB(B1, 0, 1); PG8_SCHED; PG8_LDA(At, 0, 0); PG8_STAGE(PG8_SA(1, 1), a1 + hstep, voffA);
            PG8_WAIT_V(8); PG8_WAIT_L(0); PG8_BAR; PG8_MMA(0, 0, At, B0); PG8_MMA(0, 1, At, B1); PG8_BAR; PG8_SCHED;
            PG8_LDA(At, 0, 1); PG8_STAGE(PG8_SB(0, 0), b2, voffB); PG8_STAGE(PG8_SB(0, 1), b2 + hstep, voffB); PG8_STAGE(PG8_SA(0, 0), a2, voffA);
            PG8_WAIT_V(8); PG8_WAIT_L(0); PG8_BAR; PG8_MMA(1, 0, At, B0); PG8_MMA(1, 1, At, B1); PG8_BAR; PG8_SCHED;
            PG8_LDB(B0, 1, 0); PG8_LDB(B1, 1, 1); PG8_SCHED; PG8_LDA(At, 1, 0); PG8_STAGE(PG8_SA(0, 1), a2 + hstep, voffA);
            PG8_WAIT_V(8); PG8_WAIT_L(0); PG8_BAR; PG8_MMA(0, 0, At, B0); PG8_MMA(0, 1, At, B1); PG8_BAR; PG8_SCHED;
            PG8_LDA(At, 1, 1); PG8_STAGE(PG8_SB(1, 0), b3, voffB); PG8_STAGE(PG8_SB(1, 1), b3 + hstep, voffB); PG8_STAGE(PG8_SA(1, 0), a3, voffA);
            PG8_WAIT_V(8); PG8_WAIT_L(0); PG8_BAR; PG8_MMA(1, 0, At, B0); PG8_MMA(1, 1, At, B1); PG8_BAR; PG8_SCHED;
            } else {
            PG8_LDB(B0, 0, 0); PG8_SCHED; PG8_LDA(At, 0, 0); PG8_STAGE(PG8_SA(1, 1), a1 + hstep, voffA);
            PG8_WAIT_L(8); PG8_BAR; PG8_WAIT_L(0); PG8_MMA(0, 0, At, B0); PG8_BAR; PG8_SCHED;
            PG8_LDB(B1, 0, 1); PG8_STAGE(PG8_SB(0, 0), b2, voffB);
            PG8_BAR; PG8_WAIT_L(0); PG8_MMA(0, 1, At, B1); PG8_BAR;
            PG8_LDA(At, 0, 1); PG8_STAGE(PG8_SA(0, 0), a2, voffA);
            PG8_BAR; PG8_WAIT_L(0); PG8_MMA(1, 0, At, B0); PG8_BAR; PG8_SCHED;
            PG8_STAGE(PG8_SB(0, 1), b2 + hstep, voffB);
            PG8_WAIT_V(6); PG8_BAR; PG8_MMA(1, 1, At, B1); PG8_BAR;
            PG8_LDB(B0, 1, 0); PG8_SCHED; PG8_LDA(At, 1, 0); PG8_STAGE(PG8_SA(0, 1), a2 + hstep, voffA);
            PG8_WAIT_L(8); PG8_BAR; PG8_WAIT_L(0); PG8_MMA(0, 0, At, B0); PG8_BAR; PG8_SCHED;
            PG8_LDB(B1, 1, 1); PG8_STAGE(PG8_SB(1, 0), b3, voffB);
            PG8_BAR; PG8_WAIT_L(0); PG8_MMA(0, 1, At, B1); PG8_BAR;
            PG8_LDA(At, 1, 1); PG8_STAGE(PG8_SA(1, 0), a3, voffA);
            PG8_BAR; PG8_WAIT_L(0); PG8_MMA(1, 0, At, B0); PG8_BAR; PG8_SCHED;
            PG8_STAGE(PG8_SB(1, 1), b3 + hstep, voffB);
            PG8_WAIT_V(6); PG8_BAR; PG8_MMA(1, 1, At, B1); PG8_BAR;
            }
        }
        if constexpr (ALIGN_EPI) { if (wr == 0) PG8_BAR; }
        if constexpr (!Epi::AFTER_DRAIN) { E(acc, cur, wr, wc, fr, fq); S.done(cur); }
        if (!has_next) break;
#pragma unroll
        for (int a = 0; a < 2; ++a)
#pragma unroll
            for (int b = 0; b < 2; ++b)
#pragma unroll
                for (int m = 0; m < 4; ++m)
#pragma unroll
                    for (int n = 0; n < 2; ++n) acc[a][b][m][n] = (f32x4){0.f, 0.f, 0.f, 0.f};
        cur = nxt; cA = nA; cB = nB; ++ui;
        if constexpr (ALIGN_EPI) { if (wr == 1) PG8_BAR; }
    }
    PG8_WAIT_V(0);
    if constexpr (!ALIGN_EPI) { if (wr == 0) PG8_BAR; }
    PG8_BAR;
    if constexpr (Epi::AFTER_DRAIN) { E.fused(acc, cur, wr, wc, fr, fq, lds, wid, lane); S.done(cur); }
#undef PG8_SA
#undef PG8_SB
#undef PG8_STAGE
#undef PG8_LDA
#undef PG8_LDB
#undef PG8_MMA
#undef PG8_WAIT_V
#undef PG8_WAIT_L
#undef PG8_BAR
#undef PG8_SCHED
}
}
#define PG8_SP2 true
#define PG8_ALIGN true

constexpr int D = 1024, TP = 2048, BP = 8, BS = 128, TS = 4;
constexpr int MP = BP * TP, MS = BS * TS, M = MP + MS;
constexpr int DFF = 2816, NWI = 2 * DFF, NIN = 3864, NINP = 4096, NMODC = 9216, NB = BP + BS;
constexpr int SBW = 1664, SFW = 392;
constexpr float LN_EPS = 1e-5f, RMS_EPS = 1e-6f;
constexpr float ALPHA = 1.41421356237f;
constexpr int C_RQ = 0, C_RK = 256, C_RV = 512, C_RG = 768, C_AQ = 1024, C_AK = 1152, C_AV = 1280, C_ALR = 1536, C_AG = 1552,
              C_HQ = 1808, C_HF = 2064, C_HI = 2320, C_HG = 2576, C_DQKV = 2832, C_DB = 3600, C_DA = 3604, C_DG = 3608;
constexpr int SB_RQ = 0, SB_RK = 256, SB_AQ = 512, SB_HQ = 640, SB_DQ = 896, SB_DK = 1152, SB_DV = 1408;
constexpr int SF_ADEC = 0, SF_HF = 128, SF_BETA = 384, SF_DDEC = 388;
constexpr size_t O_Y = 0;
constexpr size_t O_PRET = (size_t)M * D;
constexpr size_t O_PGLA = O_PRET + 2ull * BP * 4 * 64 * 64;
constexpr size_t O_PHG = O_PGLA + 2ull * BP * 4 * 32 * 64;
constexpr size_t O_PGDN = O_PHG + 2ull * BP * 4 * 64 * 64;
constexpr size_t O_PCONV = O_PGDN + 2ull * BP * 4 * 64 * 64;
constexpr size_t O_SRET = O_PCONV + 2ull * BP * 3 * 768;
constexpr size_t O_SGLA = O_SRET + 2ull * BS * 4 * 64 * 64;
constexpr size_t O_SHG = O_SGLA + 2ull * BS * 4 * 32 * 64;
constexpr size_t O_SGDN = O_SHG + 2ull * BS * 4 * 64 * 64;
constexpr size_t O_SCONV = O_SGDN + 2ull * BS * 4 * 64 * 64;
constexpr size_t O_END = O_SCONV + 2ull * BS * 3 * 768;

constexpr size_t MiB = 1u << 20;
constexpr size_t WS_ROPE = 1 * MiB;
constexpr size_t WS_AC = 2 * MiB;
constexpr size_t WS_MOD = 3 * MiB;
constexpr size_t WS_W = 13 * MiB;
constexpr size_t W_WI1 = 0, W_WO1 = 11 * MiB, W_WI2 = W_WO1 + 5 * MiB + MiB / 2, W_WO2 = W_WI2 + 11 * MiB, W_WIN = W_WO2 + 5 * MiB + MiB / 2, W_WOUT = W_WIN + 8 * MiB, W_LAYER = 43 * MiB;
constexpr size_t WS_H = WS_W + 2 * W_LAYER;
constexpr size_t WS_BIG = WS_H + 33 * MiB;
constexpr size_t WS_SB = WS_BIG + 132 * MiB;
constexpr size_t WS_SF = WS_SB + 54 * MiB;
constexpr size_t WS_END = WS_SF + 26 * MiB;
static_assert((size_t)M * SBW * 2 <= 54 * MiB && (size_t)M * SFW * 4 <= 26 * MiB && (size_t)M * 4096 * 2 <= 132 * MiB && (size_t)M * D * 2 <= 33 * MiB, "ws map");

constexpr int LDS_BYTES = 147456;
constexpr int NWAVES = 8;

#define GAS __attribute__((address_space(1)))
#define LAS __attribute__((address_space(3)))
typedef unsigned short bf16;
typedef unsigned v4u __attribute__((ext_vector_type(4)));
typedef unsigned v2u __attribute__((ext_vector_type(2)));
typedef float f32x4 __attribute__((ext_vector_type(4)));
typedef float f32x2 __attribute__((ext_vector_type(2)));
#define LDS_WAIT() asm volatile("s_waitcnt lgkmcnt(0)" ::: "memory")

__device__ __forceinline__ float bf2f(unsigned b) { return __uint_as_float(b << 16); }
__device__ __forceinline__ float bflo(unsigned w) { return __uint_as_float(w << 16); }
__device__ __forceinline__ float bfhi(unsigned w) { return __uint_as_float(w & 0xffff0000u); }
__device__ __forceinline__ unsigned pk2(float lo, float hi) { return pg8::cvt_pk_bf16(lo, hi); }
__device__ __forceinline__ float sigmoidf_(float x) { return 1.0f / (1.0f + __expf(-x)); }
__device__ __forceinline__ float siluf_(float x) { return x / (1.0f + __expf(-x)); }
__device__ __forceinline__ float wave_sum(float v) {
#pragma unroll
    for (int o = 1; o < 64; o <<= 1) v += __shfl_xor(v, o);
    return v;
}
template <int CTRL> __device__ __forceinline__ float dppmov(float v) { return __int_as_float(__builtin_amdgcn_update_dpp(0, __float_as_int(v), CTRL, 0xf, 0xf, true)); }
__device__ __forceinline__ float quad_sum(float v) { v += dppmov<0xB1>(v); v += dppmov<0x4E>(v); return v; }
__device__ __forceinline__ float row16_sum(float v) { v += dppmov<0xB1>(v); v += dppmov<0x4E>(v); v += dppmov<0x141>(v); v += dppmov<0x140>(v); return v; }

struct Args { const float* in[28]; float* out; unsigned char* ws; };

struct Ctx {
    int tid, lane, wave, gw, NGW;
    LAS unsigned char* lds;
    float* out; unsigned char* ws;
};
template <class T> __device__ __forceinline__ T* fresh_ptr(T* p) {
    unsigned lo = (unsigned)(uintptr_t)p, hi = (unsigned)((uintptr_t)p >> 32);
    asm volatile("" : "+v"(lo), "+v"(hi));
    lo = __builtin_amdgcn_readfirstlane(lo); hi = __builtin_amdgcn_readfirstlane(hi);
    return (T*)(__attribute__((address_space(1))) T*)(((uintptr_t)hi << 32) | (uintptr_t)lo);
}
__device__ __forceinline__ Ctx make_ctx(const Args& args, LAS unsigned char* lds) {
    Ctx C; int t = threadIdx.x; asm volatile("" : "+v"(t));
    C.tid = t; C.lane = t & 63; C.wave = __builtin_amdgcn_readfirstlane(t >> 6);
    C.gw = (int)blockIdx.x * NWAVES + C.wave; C.NGW = (int)gridDim.x * NWAVES;
    float* op = fresh_ptr(args.out); unsigned char* wp = fresh_ptr(args.ws);
    C.lds = lds; C.out = op; C.ws = wp; return C;
}
__device__ __forceinline__ int batch_of_row(int r) { return r < MP ? (r >> 11) : BP + ((r - MP) >> 2); }


typedef GAS unsigned gu32;
#define RLX_AGENT __ATOMIC_RELAXED, __HIP_MEMORY_SCOPE_AGENT
#define XB_TMO      128
#define XB_XCNT(j)  (256  + 64 * (j))
#define XB_XSUB(j)  (1280 + 64 * (j))
#define XB_XGEN(j)  (2304 + 64 * (j))
#define XB_TOP      3328
#define XB_TOPGEN   3392
#define XCD_BAR_WORDS 3456
#define XB_SPIN_CAP (1u << 18)

__device__ __forceinline__ unsigned xb_ld(unsigned* p)              { return __hip_atomic_load(p, __ATOMIC_RELAXED, __HIP_MEMORY_SCOPE_AGENT); }
__device__ __forceinline__ unsigned xb_add(unsigned* p, unsigned v) { return __hip_atomic_fetch_add(p, v, __ATOMIC_RELAXED, __HIP_MEMORY_SCOPE_AGENT); }
__device__ __forceinline__ unsigned xb_xcc_id() { return (unsigned)__builtin_amdgcn_s_getreg((3 << 11) | 20) & 0xFu; }
#define XB_SPIN(cond, bar) do { unsigned _sp = 0; while (cond) { __builtin_amdgcn_s_sleep(1); \
    if ((++_sp & 255u) == 0u) { if (xb_ld(&(bar)[XB_TMO])) break; if (_sp > XB_SPIN_CAP) { atomicAdd(&(bar)[XB_TMO], 1u); break; } } } } while (0)

struct XcdBarrier {
    unsigned* bar; unsigned x;
    volatile LAS unsigned* st;
};

__device__ __forceinline__ XcdBarrier xcd_barrier_post(unsigned* bar, volatile LAS unsigned* st) {
    XcdBarrier b; b.bar = bar; b.x = xb_xcc_id(); b.st = st;
    if (threadIdx.x == 0) (void)xb_add(&bar[XB_XCNT(b.x)], 1u);
    return b;
}
__device__ __forceinline__ void xcd_barrier_complete(unsigned* bar, unsigned x, unsigned& nloc, unsigned& nx) {
    const unsigned G = gridDim.x * gridDim.y * gridDim.z;
    unsigned sum, cnt, mine, sp = 0u;
    for (;;) {
        sum = 0u; cnt = 0u; mine = 0u;
#pragma unroll
        for (unsigned j = 0; j < 16; ++j) { const unsigned c = xb_ld(&bar[XB_XCNT(j)]); sum += c; cnt += (c > 0u) ? 1u : 0u; mine = (j == x) ? c : mine; }
        if (sum == G) break;
        __builtin_amdgcn_s_sleep(1);
        if ((++sp & 255u) == 0u) { if (xb_ld(&bar[XB_TMO])) break; if (sp > XB_SPIN_CAP) { atomicAdd(&bar[XB_TMO], 1u); break; } }
    }
    nloc = mine > 0u ? mine : 1u; nx = cnt > 0u ? cnt : 1u;
}

__device__ __forceinline__ void xcd_barrier(const XcdBarrier& b) {
    asm volatile("s_waitcnt vmcnt(0)" ::: "memory");
    __syncthreads();
    if (threadIdx.x == 0) {
        unsigned* bar = b.bar;
        __builtin_amdgcn_s_waitcnt(0);
        unsigned nloc = b.st[0], nx = b.st[1];
        if (nloc == 0u) { xcd_barrier_complete(bar, b.x, nloc, nx); b.st[0] = nloc; b.st[1] = nx; }
        const unsigned old = xb_add(&bar[XB_XSUB(b.x)], 1u);
        const unsigned gen = old / nloc;
        if (old + 1u == (gen + 1u) * nloc) {
            __builtin_amdgcn_fence(__ATOMIC_RELEASE, "agent");
            asm volatile("s_waitcnt vmcnt(0)" ::: "memory");
            const unsigned og = xb_add(&bar[XB_TOP], 1u);
            const unsigned tg = og / nx;
            if (og + 1u == (tg + 1u) * nx) xb_add(&bar[XB_TOPGEN], 1u);
            else XB_SPIN(xb_ld(&bar[XB_TOPGEN]) == tg, bar);
            __builtin_amdgcn_fence(__ATOMIC_ACQUIRE, "agent");
            xb_add(&bar[XB_XGEN(b.x)], 1u);
            asm volatile("s_waitcnt vmcnt(0)" ::: "memory");
        } else {
            XB_SPIN(xb_ld(&bar[XB_XGEN(b.x)]) == gen, bar);
            __builtin_amdgcn_fence(__ATOMIC_ACQUIRE, "agent");
            asm volatile("s_waitcnt vmcnt(0)" ::: "memory");
        }
    }
    __syncthreads();
}

constexpr int MISC_OFF = LDS_BYTES - 256;
__device__ __forceinline__ void grid_bar(const Args& args, LAS unsigned char* lds) {
    XcdBarrier b; b.bar = (unsigned*)fresh_ptr(args.ws); b.x = xb_xcc_id(); b.st = (volatile LAS unsigned*)(lds + MISC_OFF);
    xcd_barrier(b);
}

namespace pg8 {
struct EpiSwiglu {
    static constexpr bool PERM = true, AFTER_DRAIN = false;
    bf16_t* O; int ldc;
    __device__ __forceinline__ void operator()(const f32x4 (&acc)[2][2][4][2], const Unit& u, int wr, int wc, int fr, int fq) const {
        const int row0 = u.pm * BM + wr * 64 + fr, col0 = u.pn * 128 + wc * 32 + 8 * fq;
#pragma unroll
        for (int ai = 0; ai < 2; ++ai)
#pragma unroll
            for (int m = 0; m < 4; ++m) {
                bf16_t* rowp = O + (size_t)(row0 + ai * HALF + m * 16) * ldc + col0;
                float h[8];
#pragma unroll
                for (int n = 0; n < 2; ++n)
#pragma unroll
                    for (int j = 0; j < 4; ++j) {
                        const float a = acc[ai][0][m][n][j], b = acc[ai][1][m][n][j];
                        const float e = __builtin_amdgcn_exp2f(-1.44269504f * a);
                        h[n * 4 + j] = a * __builtin_amdgcn_rcpf(1.0f + e) * b;
                    }
                u32x4 w; w.x = cvt_pk_bf16(h[0], h[1]); w.y = cvt_pk_bf16(h[2], h[3]); w.z = cvt_pk_bf16(h[4], h[5]); w.w = cvt_pk_bf16(h[6], h[7]);
                *(u32x4*)rowp = w;
            }
    }
};
struct EpiPlain {
    static constexpr bool PERM = true, AFTER_DRAIN = false;
    bf16_t* O; int ldc;
    __device__ __forceinline__ void operator()(const f32x4 (&acc)[2][2][4][2], const Unit& u, int wr, int wc, int fr, int fq) const {
        const int row0 = u.pm * BM + wr * 64 + fr, col0 = u.pn * BM + wc * 32 + 8 * fq;
#pragma unroll
        for (int ai = 0; ai < 2; ++ai)
#pragma unroll
            for (int m = 0; m < 4; ++m) {
                bf16_t* rowp = O + (size_t)(row0 + ai * HALF + m * 16) * ldc + col0;
#pragma unroll
                for (int bj = 0; bj < 2; ++bj) { const f32x4 v0 = acc[ai][bj][m][0], v1 = acc[ai][bj][m][1];
                    u32x4 w; w.x = cvt_pk_bf16(v0[0], v0[1]); w.y = cvt_pk_bf16(v0[2], v0[3]); w.z = cvt_pk_bf16(v1[0], v1[1]); w.w = cvt_pk_bf16(v1[2], v1[3]);
                    *(u32x4*)(rowp + bj * HALF) = w; }
            }
    }
};
struct EpiRes {
    static constexpr bool PERM = false, AFTER_DRAIN = false;
    float* X; float* PART; const float* gate; float scale; int ntf;
    __device__ __forceinline__ void operator()(const f32x4 (&acc)[2][2][4][2], const Unit& u, int wr, int wc, int fr, int fq) const {
        const int col0 = u.pn * BM + wc * 32 + 4 * fq;
        const bool full = (u.nt == ntf);
        float* pbase = PART + (size_t)(u.k0 / SplitOrder::PK) * (512 * 1024);
#pragma unroll
        for (int ai = 0; ai < 2; ++ai)
#pragma unroll
            for (int m = 0; m < 4; ++m) {
                const int r = u.pm * BM + ai * HALF + wr * 64 + m * 16 + fr;
                const int bi = r < 16384 ? (r >> 11) : 8 + ((r - 16384) >> 2);
                const float* gp = gate + (size_t)bi * 9216;
                float* xo = full ? X + (size_t)r * 1024 : pbase + (size_t)(r - 16384) * 1024;
#pragma unroll
                for (int bj = 0; bj < 2; ++bj)
#pragma unroll
                    for (int n = 0; n < 2; ++n) {
                        const int c = col0 + bj * HALF + n * 16;
                        const f32x4 gv = *(const f32x4*)(gp + c);
                        f32x4 o = (gv * scale + scale) * acc[ai][bj][m][n];
                        if (full) o += *(const f32x4*)(xo + c);
                        *(f32x4*)(xo + c) = o;
                    }
                asm volatile("" ::: "memory");
            }
    }
};
struct EpiMod {
    static constexpr bool PERM = false, AFTER_DRAIN = false;
    float* MODp; const float* ada_b;
    __device__ __forceinline__ void operator()(const f32x4 (&acc)[2][2][4][2], const Unit& u, int wr, int wc, int fr, int fq) const {
        const int col0 = u.pn * BM + wc * 32 + 4 * fq;
        const int l = (u.pn * BM) / 9216;
#pragma unroll
        for (int ai = 0; ai < 2; ++ai)
#pragma unroll
            for (int m = 0; m < 4; ++m) {
                const int r = u.pm * BM + ai * HALF + wr * 64 + m * 16 + fr;
                if (r < 136) {
#pragma unroll
                    for (int bj = 0; bj < 2; ++bj)
#pragma unroll
                        for (int n = 0; n < 2; ++n) {
                            const int c = col0 + bj * HALF + n * 16;
                            const f32x4 o = acc[ai][bj][m][n] + *(const f32x4*)(ada_b + c);
                            *(f32x4*)(MODp + (size_t)(l * 136 + r) * 9216 + (c - l * 9216)) = o;
                        }
                }
            }
    }
};
}

__device__ __forceinline__ void transpose_item(const float* W, int K, int N, bf16* WT, int dest_row0, LAS float* scr, int k0, int n0, int lane) {
    const int nn = n0 + (lane & 31); const bool ok = nn < N;
#pragma unroll 8
    for (int i = 0; i < 32; ++i) { const int kk = 2 * i + (lane >> 5); scr[kk * 33 + (lane & 31)] = ok ? W[(size_t)(k0 + kk) * N + nn] : 0.f; }
    LDS_WAIT();
    const int c = lane & 7;
#pragma unroll
    for (int j = 0; j < 4; ++j) { const int n = (lane >> 3) + 8 * j; const LAS float* s = scr + (8 * c) * 33 + n;
        v4u o; o.x = pk2(s[0 * 33], s[1 * 33]); o.y = pk2(s[2 * 33], s[3 * 33]); o.z = pk2(s[4 * 33], s[5 * 33]); o.w = pk2(s[6 * 33], s[7 * 33]);
        *(v4u*)(WT + (size_t)(dest_row0 + n) * K + k0 + 8 * c) = o; }
    LDS_WAIT();
}

__device__ __forceinline__ void p0_prologue(const Args& args, LAS unsigned char* lds_) {
    const Ctx C = make_ctx(args, lds_);
    LAS float* scr = (LAS float*)(C.lds + C.wave * 16384);
    constexpr int I_WI = 16 * 176, I_WO = 44 * 32, I_WIN = 16 * 121, I_WOUT = 16 * 32, I_ADA = 16 * 288;
    constexpr int I_LAYER = 2 * I_WI + 2 * I_WO + I_WIN + I_WOUT + I_ADA;
    for (int it = C.gw; it < 2 * I_LAYER; it += C.NGW) {
        const int l = it / I_LAYER; int r = it - l * I_LAYER;
        unsigned char* wl = C.ws + WS_W + (size_t)l * W_LAYER;
        if (r < 2 * (I_WI + I_WO)) {
            const int f = r / (I_WI + I_WO); r -= f * (I_WI + I_WO);
            if (r < I_WI) {
                const int kb = r / 176, nb = r % 176, n0 = nb * 32;
                const int half = n0 / DFF, j = n0 - half * DFF, t = j >> 7, jj = j & 127;
                transpose_item((f ? args.in[15] : args.in[13]) + (size_t)l * D * NWI, D, NWI, (bf16*)(wl + (f ? W_WI2 : W_WI1)), 256 * t + 128 * half + jj, scr, kb * 64, n0, C.lane);
            } else { r -= I_WI;
                const int kb = r / 32, nb = r % 32;
                transpose_item((f ? args.in[16] : args.in[14]) + (size_t)l * DFF * D, DFF, D, (bf16*)(wl + (f ? W_WO2 : W_WO1)), nb * 32, scr, kb * 64, nb * 32, C.lane);
            }
            continue;
        }
        r -= 2 * (I_WI + I_WO);
        if (r < I_WIN) { const int kb = r / 121, nb = r % 121;
            transpose_item(args.in[17] + (size_t)l * D * NIN, D, NIN, (bf16*)(wl + W_WIN), nb * 32, scr, kb * 64, nb * 32, C.lane); continue; }
        r -= I_WIN;
        if (r < I_WOUT) { const int kb = r / 32, nb = r % 32;
            transpose_item(args.in[27] + (size_t)l * D * D, D, D, (bf16*)(wl + W_WOUT), nb * 32, scr, kb * 64, nb * 32, C.lane); continue; }
        r -= I_WOUT;
        { const int kb = r / 288, nb = r % 288;
            transpose_item(args.in[9] + (size_t)l * D * NMODC, D, NMODC, (bf16*)(C.ws + WS_BIG), l * NMODC + nb * 32, scr, kb * 64, nb * 32, C.lane); }
    }
    const int gt = C.gw * 64 + C.lane, NGT = C.NGW * 64;
    for (int i = gt; i < 2 * 224 * 128; i += NGT) { const int l = i / (224 * 128), rr = (i / 128) % 224, ch = i & 127;
        *(v4u*)(C.ws + WS_W + (size_t)l * W_LAYER + W_WIN + ((size_t)(3872 + rr) * 1024 + ch * 8) * 2) = (v4u){0u, 0u, 0u, 0u}; }
    for (int i = gt; i < 256 * 256; i += NGT) { const int row = i >> 8, c4 = (i & 255) * 4;
        v2u o = (v2u){0u, 0u};
        if (row < NB) { const float* src = row < BP ? args.in[7] + (size_t)row * D : args.in[8] + (size_t)(row - BP) * D; const f32x4 v = *(const f32x4*)(src + c4);
            o.x = pk2(siluf_(v.x), siluf_(v.y)); o.y = pk2(siluf_(v.z), siluf_(v.w)); }
        *(v2u*)(C.ws + WS_AC + ((size_t)row * D + c4) * 2) = o; }
    for (int i = gt; i < 2052 * 32; i += NGT) { const int p = i >> 5, j = i & 31; const double pos = p < 2048 ? (double)p : (double)(16384 + (p - 2048));
        double inv = 1.0; for (int q = 0; q < j; ++q) inv *= 0.7498942093324559;
        const double ang = pos * inv; const double n = rint(ang * 0.15915494309189535);
        const float rr = (float)((ang - n * 6.283185307179586) - n * 2.4492935982947064e-16);
        ((f32x2*)(C.ws + WS_ROPE))[i] = (f32x2){__cosf(rr), __sinf(rr)}; }
}

__device__ __forceinline__ void p2_modulate0(const Args& args, LAS unsigned char* lds_) {
    const Ctx C = make_ctx(args, lds_);
    const float* MOD = (const float*)(C.ws + WS_MOD); bf16* H = (bf16*)(C.ws + WS_H);
    for (int r = C.gw; r < M; r += C.NGW) {
        const float* xr = r < MP ? args.in[0] + (size_t)r * D : args.in[1] + (size_t)(r - MP) * D;
        const float* modr = MOD + (size_t)batch_of_row(r) * NMODC;
#pragma unroll
        for (int j = 0; j < 4; ++j) { const int c = (C.lane + 64 * j) * 4;
            const f32x4 v = *(const f32x4*)(xr + c), sh = *(const f32x4*)(modr + c), sc = *(const f32x4*)(modr + 1024 + c);
            const f32x4 h = v * (sc + 1.0f) + sh;
            *(f32x4*)(C.out + (size_t)r * D + c) = v * ALPHA;
            *(v2u*)(H + (size_t)r * D + c) = (v2u){pk2(h.x, h.y), pk2(h.z, h.w)}; }
    }
}

__device__ __forceinline__ void ln_phase(const Args& args, LAS unsigned char* lds_, int l, int which, bool write_h, int hl, int shc, int npart, float xscale) {
    const Ctx C = make_ctx(args, lds_);
    const float* MOD = (const float*)(C.ws + WS_MOD); bf16* H = (bf16*)(C.ws + WS_H);
    const float* g = args.in[11] + (size_t)(l * 3 + which) * D; const float* b = args.in[12] + (size_t)(l * 3 + which) * D;
    for (int r = C.gw; r < M; r += C.NGW) {
        float* xr = C.out + (size_t)r * D;
        f32x4 v[4]; float s = 0.f;
#pragma unroll
        for (int j = 0; j < 4; ++j) v[j] = *(const f32x4*)(xr + (C.lane + 64 * j) * 4);
        if (r >= MP) { const float* pp = (const float*)(C.ws + WS_SB) + (size_t)(r - MP) * D;
#pragma unroll 1
            for (int p = 0; p < npart; ++p, pp += 512 * 1024) {
#pragma unroll
                for (int j = 0; j < 4; ++j) v[j] += *(const f32x4*)(pp + (C.lane + 64 * j) * 4); } }
#pragma unroll
        for (int j = 0; j < 4; ++j) s += (v[j].x + v[j].y) + (v[j].z + v[j].w);
        const float mean = wave_sum(s) * (1.f / D); float s2 = 0.f;
#pragma unroll
        for (int j = 0; j < 4; ++j) { v[j] = v[j] - mean; s2 += (v[j].x * v[j].x + v[j].y * v[j].y) + (v[j].z * v[j].z + v[j].w * v[j].w); }
        const float rstd = 1.f / sqrtf(wave_sum(s2) * (1.f / D) + LN_EPS);
        const float* modr = MOD + (size_t)(hl * NB + batch_of_row(r)) * NMODC + shc * 1024;
#pragma unroll
        for (int j = 0; j < 4; ++j) { const int c = (C.lane + 64 * j) * 4;
            const f32x4 xn = v[j] * rstd * *(const f32x4*)(g + c) + *(const f32x4*)(b + c);
            *(f32x4*)(xr + c) = xn * xscale;
            if (write_h) { const f32x4 sh = *(const f32x4*)(modr + c), sc = *(const f32x4*)(modr + 1024 + c); const f32x4 h = xn * (sc + 1.0f) + sh;
                *(v2u*)(H + (size_t)r * D + c) = (v2u){pk2(h.x, h.y), pk2(h.z, h.w)}; }
        }
    }
}

struct PrepRaw { unsigned short rq1[4], rq2[4], rk1[4], rk2[4], aq[2], hf[4], hq[4], dx[12], db, da; v4u alr0, alr1; };
__device__ __forceinline__ void prep_load(PrepRaw& x, const bf16* P, int lane) {
    const int j = lane & 31;
#pragma unroll
    for (int h = 0; h < 4; ++h) { x.rq1[h] = P[C_RQ + h * 64 + j]; x.rq2[h] = P[C_RQ + h * 64 + 32 + j]; x.rk1[h] = P[C_RK + h * 64 + j]; x.rk2[h] = P[C_RK + h * 64 + 32 + j]; }
    x.alr0 = *(const v4u*)(P + C_ALR); x.alr1 = *(const v4u*)(P + C_ALR + 8);
#pragma unroll
    for (int i = 0; i < 2; ++i) x.aq[i] = P[C_AQ + lane + 64 * i];
#pragma unroll
    for (int i = 0; i < 4; ++i) { x.hf[i] = P[C_HF + lane + 64 * i]; x.hq[i] = P[C_HQ + lane + 64 * i]; }
#pragma unroll
    for (int i = 0; i < 12; ++i) x.dx[i] = P[C_DQKV + lane + 64 * i];
    x.db = P[C_DB + (lane & 3)]; x.da = P[C_DA + (lane & 3)];
}
__device__ __forceinline__ float wave_sum2(float v) { v = row16_sum(v); v += __shfl_xor(v, 16); v += __shfl_xor(v, 32); return v; }

__device__ __forceinline__ void prep_phase(const Args& args, LAS unsigned char* lds_, int l) {
    const Ctx C = make_ctx(args, lds_);
    const bf16* PROJ = (const bf16*)(C.ws + WS_BIG); bf16* SB = (bf16*)(C.ws + WS_SB); float* SF = (float*)(C.ws + WS_SF);
    const f32x2* ROPE = (const f32x2*)(C.ws + WS_ROPE);
    const int lane = C.lane;
    const float* wg = args.in[18] + (size_t)l * 16 * 128; const float* bg = args.in[19] + (size_t)l * 128;
    const float* cw = args.in[21] + (size_t)l * 4 * 768;
    constexpr int CH = 9;
    const int r0 = C.gw * CH, r1 = min(r0 + CH, M);
    if (r0 >= M) return;
    float lbv[4];
#pragma unroll
    for (int i = 0; i < 4; ++i) { lbv[i] = 0.f; if (l == 1) lbv[i] = 1.0f / (1.0f + expf(args.in[20][lane + 64 * i] - args.in[20][256 + lane + 64 * i])); }
    const float a_neg = -expf(args.in[22][l * 4 + (lane & 3)]), dtb = args.in[23][l * 4 + (lane & 3)];
    const float bg0 = bg[lane], bg1 = bg[lane + 64];
    float w1[12], w2[12], w3[12];
    auto load_window = [&](int r) {
        const bool isp = r < MP; const int rs = r - MP; const int b = isp ? (r >> 11) : (rs >> 2), t = isp ? (r & 2047) : (rs & 3);
        const float* cst = args.in[6] + ((size_t)(l * BS + b) * 3) * 768;
#pragma unroll
        for (int i = 0; i < 12; ++i) { const int ch = lane + 64 * i; const bf16* Pc = PROJ + (size_t)r * NINP + C_DQKV + ch;
            w1[i] = t >= 1 ? bf2f(Pc[-1 * NINP]) : (isp ? 0.f : cst[2 * 768 + ch]);
            w2[i] = t >= 2 ? bf2f(Pc[-2 * NINP]) : (isp ? 0.f : cst[(1 + t) * 768 + ch]);
            w3[i] = t >= 3 ? bf2f(Pc[-3 * NINP]) : (isp ? 0.f : cst[t * 768 + ch]); }
    };
    PrepRaw A; prep_load(A, PROJ + (size_t)r0 * NINP, lane);
    load_window(r0);
#pragma unroll 1
    for (int r = r0; r < r1; ++r) {
        PrepRaw B = A;
        if (r + 1 < r1) prep_load(B, PROJ + (size_t)(r + 1) * NINP, lane);
        int zo = 0; asm volatile("" : "+v"(zo));
        const bool isp = r < MP; const int rs = r - MP;
        const int b = isp ? (r >> 11) : (rs >> 2), t = isp ? (r & 2047) : (rs & 3);
        const int ridx = isp ? t : 2048 + t;
        bf16* sb = SB + (size_t)r * SBW; float* sf = SF + (size_t)r * SFW;
        { const int j = lane & 31; const bool hi = lane >= 32; const f32x2 cs = ROPE[ridx * 32 + j];
#pragma unroll
          for (int h = 0; h < 4; ++h) {
              const float q1 = bf2f(A.rq1[h]), q2 = bf2f(A.rq2[h]), k1 = bf2f(A.rk1[h]), k2 = bf2f(A.rk2[h]);
              const float qo = hi ? (q1 * cs.y + q2 * cs.x) : (q1 * cs.x - q2 * cs.y);
              const float ko = hi ? (k1 * cs.y + k2 * cs.x) : (k1 * cs.x - k2 * cs.y);
              sb[SB_RQ + h * 64 + lane] = (bf16)(pk2(qo, 0.f) & 0xffffu);
              sb[SB_RK + h * 64 + lane] = (bf16)(pk2(ko * 0.125f, 0.f) & 0xffffu);
          } }
        { const unsigned aw[8] = {A.alr0.x, A.alr0.y, A.alr0.z, A.alr0.w, A.alr1.x, A.alr1.y, A.alr1.z, A.alr1.w};
          float x0 = bg0, x1 = bg1;
#pragma unroll
          for (int i = 0; i < 8; ++i) { const float a0 = bflo(aw[i]), a1 = bfhi(aw[i]);
              x0 += a0 * wg[(2 * i) * 128 + lane + zo] + a1 * wg[(2 * i + 1) * 128 + lane + zo];
              x1 += a0 * wg[(2 * i) * 128 + lane + 64 + zo] + a1 * wg[(2 * i + 1) * 128 + lane + 64 + zo]; }
          const float sp0 = fmaxf(-x0, 0.f) + log1pf(expf(-fabsf(x0))), sp1 = fmaxf(-x1, 0.f) + log1pf(expf(-fabsf(x1)));
          sf[SF_ADEC + lane] = expf(-sp0 * (1.0f / 16.0f)); sf[SF_ADEC + lane + 64] = expf(-sp1 * (1.0f / 16.0f));
          sb[SB_AQ + lane] = (bf16)(pk2(bf2f(A.aq[0]) * 0.17677669529663687f, 0.f) & 0xffffu);
          sb[SB_AQ + lane + 64] = (bf16)(pk2(bf2f(A.aq[1]) * 0.17677669529663687f, 0.f) & 0xffffu); }
#pragma unroll
        for (int i = 0; i < 4; ++i) { const int c = lane + 64 * i;
            sf[SF_HF + c] = lbv[i] + (1.0f - lbv[i]) * sigmoidf_(bf2f(A.hf[i]));
            sb[SB_HQ + c] = (bf16)(pk2(siluf_(bf2f(A.hq[i])) * 0.125f, 0.f) & 0xffffu); }
        { float* cso = isp ? C.out + O_PCONV + ((size_t)(l * BP + b) * 3) * 768 : C.out + O_SCONV + ((size_t)(l * BS + b) * 3) * 768;
          const int so = isp ? t - (TP - 3) : t - 1;
          float uu[12];
#pragma unroll
          for (int i = 0; i < 12; ++i) { const float x0 = bf2f(A.dx[i]);
              const float* cwc = cw + lane + 64 * i + zo;
              uu[i] = siluf_(x0 * cwc[3 * 768] + w1[i] * cwc[2 * 768] + w2[i] * cwc[768] + w3[i] * cwc[0]);
              if (so >= 0) cso[so * 768 + lane + 64 * i] = x0;
              w3[i] = w2[i]; w2[i] = w1[i]; w1[i] = x0; }
#pragma unroll
          for (int i = 0; i < 12; ++i) { float sc = 1.0f;
              if (i < 8) { const float nn = wave_sum2(uu[i] * uu[i]); sc = rsqrtf(nn + RMS_EPS) * (i < 4 ? 0.125f : 1.0f); }
              sb[SB_DQ + i * 64 + lane] = (bf16)(pk2(uu[i] * sc, 0.f) & 0xffffu); }
          if (lane < 4) { sf[SF_BETA + lane] = sigmoidf_(bf2f(A.db));
              const float xx = bf2f(A.da) + dtb; const float sp = fmaxf(xx, 0.f) + log1pf(expf(-fabsf(xx)));
              sf[SF_DDEC + lane] = expf(a_neg * sp); } }
        A = B;
        if (r + 1 < r1) { const int rn = r + 1; const bool ns = rn < MP ? ((rn & 2047) == 0) : (((rn - MP) & 3) == 0); if (ns) load_window(rn); }
    }
}

template <int KIND, int DH, int R> struct Raw { unsigned q[DH / 2]; unsigned k[DH / 2]; unsigned v[(R + 1) / 2]; float f[DH]; float be, de; };

template <int KIND, int DH, int R>
__device__ __forceinline__ void load_tok(Raw<KIND, DH, R>& x, const bf16* qp, const bf16* kp, const bf16* vp, const float* fp) {
    if constexpr (DH == 4) { const v2u w = *(const v2u*)qp; x.q[0] = w.x; x.q[1] = w.y; } else { x.q[0] = *(const unsigned*)qp; }
    if constexpr (KIND != 2) { if constexpr (DH == 4) { const v2u w = *(const v2u*)kp; x.k[0] = w.x; x.k[1] = w.y; } else { x.k[0] = *(const unsigned*)kp; } }
    if constexpr (R == 1) x.v[0] = *vp; else if constexpr (R == 2) x.v[0] = *(const unsigned*)vp; else { const v2u w = *(const v2u*)vp; x.v[0] = w.x; x.v[1] = w.y; }
    if constexpr (KIND == 1) { const f32x2 w = *(const f32x2*)fp; x.f[0] = w.x; x.f[1] = w.y; }
    if constexpr (KIND == 2) { const f32x4 w = *(const f32x4*)fp; x.f[0] = w.x; x.f[1] = w.y; x.f[2] = w.z; x.f[3] = w.w; }
    if constexpr (KIND == 3) { x.be = fp[0]; x.de = fp[4]; }
}

template <int KIND, int DH, int R>
__device__ __forceinline__ void scan_task(const Ctx& C, int row0, int T, int h, int slice, const float* sin, float* sout) {
    const bf16* PROJ = (const bf16*)(C.ws + WS_BIG); const bf16* SB = (const bf16*)(C.ws + WS_SB); const float* SF = (const float*)(C.ws + WS_SF);
    bf16* H = (bf16*)(C.ws + WS_H);
    const int lane = C.lane, dl = lane & 15, rw = lane >> 4;
    const int d0 = dl * DH, v0 = slice * (4 * R) + rw * R;
    constexpr int DK = 16 * DH;
    const bf16 *qp, *kp, *vp; const float* fp; int ks, vs;
    const bf16* sbr = SB + (size_t)row0 * SBW; const bf16* pr = PROJ + (size_t)row0 * NINP; const float* sfr = SF + (size_t)row0 * SFW;
    if constexpr (KIND == 0) { qp = sbr + SB_RQ + h * 64 + d0; kp = sbr + SB_RK + h * 64 + d0; ks = SBW; vp = pr + C_RV + h * 64 + v0; vs = NINP; fp = sfr; }
    if constexpr (KIND == 1) { qp = sbr + SB_AQ + h * 32 + d0; kp = pr + C_AK + h * 32 + d0; ks = NINP; vp = pr + C_AV + h * 64 + v0; vs = NINP; fp = sfr + SF_ADEC + h * 32 + d0; }
    if constexpr (KIND == 2) { qp = sbr + SB_HQ + h * 64 + d0; kp = sbr; ks = SBW; vp = pr + C_HI + h * 64 + v0; vs = NINP; fp = sfr + SF_HF + h * 64 + d0; }
    if constexpr (KIND == 3) { qp = sbr + SB_DQ + h * 64 + d0; kp = sbr + SB_DK + h * 64 + d0; ks = SBW; vp = sbr + SB_DV + h * 64 + v0; vs = SBW; fp = sfr + SF_BETA + h; }
    bf16* op = H + (size_t)row0 * D + KIND * 256 + h * 64 + v0;
    const float rdec = 1.0f - exp2f(-5.0f - (float)h);

    float S[DH][R];
#pragma unroll
    for (int dh = 0; dh < DH; ++dh)
#pragma unroll
        for (int vv = 0; vv < R; ++vv) S[dh][vv] = sin ? sin[(size_t)(d0 + dh) * 64 + v0 + vv] : 0.f;

    typedef Raw<KIND, DH, R> RawT;
    RawT A[4];
#pragma unroll
    for (int u = 0; u < 4; ++u) load_tok<KIND, DH, R>(A[u], qp + (size_t)u * SBW, kp + (size_t)u * ks, vp + (size_t)u * vs, fp + (size_t)u * SFW);
    for (int t0 = 0; t0 < T; t0 += 4) {
        RawT B[4];
        const bool more = t0 + 4 < T;
#pragma unroll
        for (int u = 0; u < 4; ++u) { B[u] = A[u]; }
        if (more) {
#pragma unroll
            for (int u = 0; u < 4; ++u) load_tok<KIND, DH, R>(B[u], qp + (size_t)(t0 + 4 + u) * SBW, kp + (size_t)(t0 + 4 + u) * ks, vp + (size_t)(t0 + 4 + u) * vs, fp + (size_t)(t0 + 4 + u) * SFW);
        }
#pragma unroll
        for (int u = 0; u < 4; ++u) {
            const RawT& x = A[u];
            float q[DH], k[DH], v[R];
            q[0] = bflo(x.q[0]); q[1] = bfhi(x.q[0]); if constexpr (DH == 4) { q[2] = bflo(x.q[1]); q[3] = bfhi(x.q[1]); }
            if constexpr (KIND != 2) { k[0] = bflo(x.k[0]); k[1] = bfhi(x.k[0]); if constexpr (DH == 4) { k[2] = bflo(x.k[1]); k[3] = bfhi(x.k[1]); } }
            if constexpr (R == 1) v[0] = bflo(x.v[0]);
            if constexpr (R >= 2) { v[0] = bflo(x.v[0]); v[1] = bfhi(x.v[0]); }
            if constexpr (R == 4) { v[2] = bflo(x.v[1]); v[3] = bfhi(x.v[1]); }
            float o[R];
            if constexpr (KIND == 3) {
                float ks_[R];
#pragma unroll
                for (int vv = 0; vv < R; ++vv) { float p = 0.f;
#pragma unroll
                    for (int dh = 0; dh < DH; ++dh) { S[dh][vv] *= x.de; p += k[dh] * S[dh][vv]; }
                    ks_[vv] = row16_sum(p); }
#pragma unroll
                for (int vv = 0; vv < R; ++vv) { const float uu = x.be * (v[vv] - ks_[vv]); float p = 0.f;
#pragma unroll
                    for (int dh = 0; dh < DH; ++dh) { S[dh][vv] += k[dh] * uu; p += q[dh] * S[dh][vv]; }
                    o[vv] = row16_sum(p); }
            } else {
#pragma unroll
                for (int dh = 0; dh < DH; ++dh) {
                    float dec, kk;
                    if constexpr (KIND == 0) { dec = rdec; kk = k[dh]; }
                    if constexpr (KIND == 1) { dec = x.f[dh]; kk = k[dh]; }
                    if constexpr (KIND == 2) { dec = x.f[dh]; kk = 1.0f - x.f[dh]; }
#pragma unroll
                    for (int vv = 0; vv < R; ++vv) S[dh][vv] = dec * S[dh][vv] + kk * v[vv];
                }
#pragma unroll
                for (int vv = 0; vv < R; ++vv) { float p = 0.f;
#pragma unroll
                    for (int dh = 0; dh < DH; ++dh) p += q[dh] * S[dh][vv];
                    o[vv] = row16_sum(p); }
            }
            if (dl == 0) {
                bf16* o_ = op + (size_t)(t0 + u) * D;
                if constexpr (R == 1) *o_ = (bf16)(pk2(o[0], 0.f) & 0xffffu);
                if constexpr (R == 2) *(unsigned*)o_ = pk2(o[0], o[1]);
                if constexpr (R == 4) *(v2u*)o_ = (v2u){pk2(o[0], o[1]), pk2(o[2], o[3])};
            }
        }
#pragma unroll
        for (int u = 0; u < 4; ++u) A[u] = B[u];
    }
#pragma unroll
    for (int dh = 0; dh < DH; ++dh)
#pragma unroll
        for (int vv = 0; vv < R; ++vv) sout[(size_t)(d0 + dh) * 64 + v0 + vv] = S[dh][vv];
    (void)DK;
}

template <int KIND, int DH, int R>
__device__ __forceinline__ void scan_long(const Ctx& C, LAS float* wl, int row0, int T, int h, int slice, float* sout) {
    constexpr int CT = 16, DK = 16 * DH, NV = 4 * R, UNR = 4;
    constexpr bool HASK = true, GK = (KIND != 2), HASF = (KIND == 1 || KIND == 2), HASB = (KIND == 3);
    constexpr int OQ = 0, OK_ = OQ + CT * DK, OF = OK_ + (HASK ? CT * DK : 0), OV = OF + (HASF ? CT * DK : 0), OB = OV + CT * NV, BUF = OB + (HASB ? CT * 2 : 0);
    const bf16* PROJ = (const bf16*)(C.ws + WS_BIG); const bf16* SB = (const bf16*)(C.ws + WS_SB); const float* SF = (const float*)(C.ws + WS_SF);
    bf16* H = (bf16*)(C.ws + WS_H);
    const int lane = C.lane, dl = lane & 15, rw = lane >> 4;
    const int d0 = dl * DH;
    const int stok = lane >> 2, spart = lane & 3;
    const GAS bf16 *qg, *kg, *vg; const GAS float *fg, *bg; int ks, vs;
    {
        const GAS bf16* sbr = (const GAS bf16*)(SB + (size_t)row0 * SBW); const GAS bf16* pr = (const GAS bf16*)(PROJ + (size_t)row0 * NINP); const GAS float* sfr = (const GAS float*)(SF + (size_t)row0 * SFW);
        const int vcol = slice * NV;
        if constexpr (KIND == 0) { qg = sbr + SB_RQ + h * 64; kg = sbr + SB_RK + h * 64; ks = SBW; vg = pr + C_RV + h * 64 + vcol; vs = NINP; fg = sfr; bg = sfr; }
        if constexpr (KIND == 1) { qg = sbr + SB_AQ + h * 32; kg = pr + C_AK + h * 32; ks = NINP; vg = pr + C_AV + h * 64 + vcol; vs = NINP; fg = sfr + SF_ADEC + h * 32; bg = sfr; }
        if constexpr (KIND == 2) { qg = sbr + SB_HQ + h * 64; kg = sbr; ks = SBW; vg = pr + C_HI + h * 64 + vcol; vs = NINP; fg = sfr + SF_HF + h * 64; bg = sfr; }
        if constexpr (KIND == 3) { qg = sbr + SB_DQ + h * 64; kg = sbr + SB_DK + h * 64; ks = SBW; vg = sbr + SB_DV + h * 64 + vcol; vs = SBW; fg = sfr; bg = sfr + SF_BETA + h; }
    }
    constexpr int QP = DK / 4;
    qg += (size_t)stok * SBW + spart * QP; kg += (size_t)stok * ks + spart * QP; fg += (size_t)stok * SFW + spart * QP;
    vg += (size_t)(lane & 15) * vs; bg += (size_t)(lane & 15) * SFW;
    GAS bf16* op = (GAS bf16*)(H + (size_t)row0 * D + KIND * 256 + h * 64 + slice * NV + rw * R);
    const float rdec = 1.0f - exp2f(-5.0f - (float)h);

    float S[DH][R];
#pragma unroll
    for (int dh = 0; dh < DH; ++dh)
#pragma unroll
        for (int vv = 0; vv < R; ++vv) S[dh][vv] = 0.f;

    struct SR { v4u rq[QP / 8], rk[QP / 8]; f32x4 rf[QP / 4]; unsigned rv[NV / 2]; float rb0, rb1; };
    SR s0, s1; s0.rb0 = s0.rb1 = s1.rb0 = s1.rb1 = 0.f;
    auto stage_load = [&](SR& sr, int c) {
        const size_t t = (size_t)c * CT;
#pragma unroll
        for (int i = 0; i < QP / 8; ++i) { sr.rq[i] = *(const GAS v4u*)(qg + t * SBW + i * 8); if constexpr (GK) sr.rk[i] = *(const GAS v4u*)(kg + t * ks + i * 8); }
        if constexpr (HASF) {
#pragma unroll
            for (int i = 0; i < QP / 4; ++i) sr.rf[i] = *(const GAS f32x4*)(fg + t * SFW + i * 4); }
        if (lane < 16) {
            if constexpr (NV == 4) { const v2u w = *(const GAS v2u*)(vg + t * vs); sr.rv[0] = w.x; sr.rv[1] = w.y; }
            if constexpr (NV == 8) { const v4u w = *(const GAS v4u*)(vg + t * vs); sr.rv[0] = w.x; sr.rv[1] = w.y; sr.rv[2] = w.z; sr.rv[3] = w.w; }
            if constexpr (NV == 16) { const v4u w = *(const GAS v4u*)(vg + t * vs), w2 = *(const GAS v4u*)(vg + t * vs + 8); sr.rv[0] = w.x; sr.rv[1] = w.y; sr.rv[2] = w.z; sr.rv[3] = w.w; sr.rv[4] = w2.x; sr.rv[5] = w2.y; sr.rv[6] = w2.z; sr.rv[7] = w2.w; }
            if constexpr (HASB) { sr.rb0 = bg[t * SFW]; sr.rb1 = bg[t * SFW + 4]; }
        }
    };
    auto stage_write = [&](SR& sr, int b) {
        LAS float* base = wl + b * BUF;
#pragma unroll
        for (int i = 0; i < QP / 8; ++i) {
            LAS float* qd = base + OQ + stok * DK + spart * QP + i * 8;
            *(LAS f32x4*)qd = (f32x4){bflo(sr.rq[i].x), bfhi(sr.rq[i].x), bflo(sr.rq[i].y), bfhi(sr.rq[i].y)}; *(LAS f32x4*)(qd + 4) = (f32x4){bflo(sr.rq[i].z), bfhi(sr.rq[i].z), bflo(sr.rq[i].w), bfhi(sr.rq[i].w)};
            if constexpr (GK) { LAS float* kd = base + OK_ + stok * DK + spart * QP + i * 8;
                *(LAS f32x4*)kd = (f32x4){bflo(sr.rk[i].x), bfhi(sr.rk[i].x), bflo(sr.rk[i].y), bfhi(sr.rk[i].y)}; *(LAS f32x4*)(kd + 4) = (f32x4){bflo(sr.rk[i].z), bfhi(sr.rk[i].z), bflo(sr.rk[i].w), bfhi(sr.rk[i].w)}; }
        }
        if constexpr (HASF) {
#pragma unroll
            for (int i = 0; i < QP / 4; ++i) { *(LAS f32x4*)(base + OF + stok * DK + spart * QP + i * 4) = sr.rf[i];
                if constexpr (KIND == 2) *(LAS f32x4*)(base + OK_ + stok * DK + spart * QP + i * 4) = 1.0f - sr.rf[i]; } }
        if (lane < 16) {
#pragma unroll
            for (int i = 0; i < NV / 2; ++i) { base[OV + lane * NV + 2 * i] = bflo(sr.rv[i]); base[OV + lane * NV + 2 * i + 1] = bfhi(sr.rv[i]); }
            if constexpr (HASB) { base[OB + lane * 2] = sr.rb0; base[OB + lane * 2 + 1] = sr.rb1; }
        }
    };
    static_assert(2 * BUF * 4 <= 32768, "per-wave LDS");
    const int nch = T / CT;
    auto compute = [&](int c, const LAS float* base) {
float okeep[R];
#pragma unroll
        for (int vv = 0; vv < R; ++vv) okeep[vv] = 0.f;
#pragma unroll 1
        for (int ub = 0; ub < CT; ub += UNR)
#pragma unroll
        for (int uu_ = 0; uu_ < UNR; ++uu_) { const int u = ub + uu_;
            float q[DH], k[DH], f[DH], v[R];
            if constexpr (DH == 4) { const f32x4 w = *(const LAS f32x4*)(base + OQ + u * DK + d0); q[0] = w.x; q[1] = w.y; q[2] = w.z; q[3] = w.w; }
            else { const f32x2 w = *(const LAS f32x2*)(base + OQ + u * DK + d0); q[0] = w.x; q[1] = w.y; }
            if constexpr (HASK) {
                if constexpr (DH == 4) { const f32x4 w = *(const LAS f32x4*)(base + OK_ + u * DK + d0); k[0] = w.x; k[1] = w.y; k[2] = w.z; k[3] = w.w; }
                else { const f32x2 w = *(const LAS f32x2*)(base + OK_ + u * DK + d0); k[0] = w.x; k[1] = w.y; } }
            if constexpr (HASF) {
                if constexpr (DH == 4) { const f32x4 w = *(const LAS f32x4*)(base + OF + u * DK + d0); f[0] = w.x; f[1] = w.y; f[2] = w.z; f[3] = w.w; }
                else { const f32x2 w = *(const LAS f32x2*)(base + OF + u * DK + d0); f[0] = w.x; f[1] = w.y; } }
            if constexpr (R == 1) v[0] = base[OV + u * NV + rw];
            if constexpr (R == 2) { const f32x2 w = *(const LAS f32x2*)(base + OV + u * NV + rw * 2); v[0] = w.x; v[1] = w.y; }
            if constexpr (R == 4) { const f32x4 w = *(const LAS f32x4*)(base + OV + u * NV + rw * 4); v[0] = w.x; v[1] = w.y; v[2] = w.z; v[3] = w.w; }
            float o[R];
            if constexpr (KIND == 3) {
                const f32x2 bd = *(const LAS f32x2*)(base + OB + u * 2);
                float ks_[R];
#pragma unroll
                for (int vv = 0; vv < R; ++vv) { float p = 0.f;
#pragma unroll
                    for (int dh = 0; dh < DH; ++dh) { S[dh][vv] *= bd.y; p += k[dh] * S[dh][vv]; }
                    ks_[vv] = row16_sum(p); }
#pragma unroll
                for (int vv = 0; vv < R; ++vv) { const float uu = bd.x * (v[vv] - ks_[vv]); float p = 0.f;
#pragma unroll
                    for (int dh = 0; dh < DH; ++dh) { S[dh][vv] += k[dh] * uu; p += q[dh] * S[dh][vv]; }
                    o[vv] = row16_sum(p); }
            } else {
#pragma unroll
                for (int dh = 0; dh < DH; ++dh) {
                    float dec, kk;
                    if constexpr (KIND == 0) { dec = rdec; kk = k[dh]; }
                    if constexpr (KIND == 1) { dec = f[dh]; kk = k[dh]; }
                    if constexpr (KIND == 2) { dec = f[dh]; kk = k[dh]; }
#pragma unroll
                    for (int vv = 0; vv < R; ++vv) S[dh][vv] = dec * S[dh][vv] + kk * v[vv];
                }
#pragma unroll
                for (int vv = 0; vv < R; ++vv) { float p = 0.f;
#pragma unroll
                    for (int dh = 0; dh < DH; ++dh) p += q[dh] * S[dh][vv];
                    o[vv] = row16_sum(p); }
            }
#pragma unroll
            for (int vv = 0; vv < R; ++vv) okeep[vv] = (dl == u) ? o[vv] : okeep[vv];
        }
        {
            GAS bf16* o_ = op + (size_t)(c * CT + dl) * D;
            if constexpr (R == 1) *o_ = (bf16)(pk2(okeep[0], 0.f) & 0xffffu);
            if constexpr (R == 2) *(GAS unsigned*)o_ = pk2(okeep[0], okeep[1]);
            if constexpr (R == 4) *(GAS v2u*)o_ = (v2u){pk2(okeep[0], okeep[1]), pk2(okeep[2], okeep[3])};
        }
    };
    stage_load(s0, 0); stage_write(s0, 0); stage_load(s1, 1);
#pragma unroll 1
    for (int c = 0; c < nch; c += 2) {
        stage_load(s0, min(c + 2, nch - 1));
        compute(c, wl);
        stage_write(s1, 1);
        stage_load(s1, min(c + 3, nch - 1));
        compute(c + 1, wl + BUF);
        stage_write(s0, 0);
    }
    const int v0 = slice * NV + rw * R;
#pragma unroll
    for (int dh = 0; dh < DH; ++dh)
#pragma unroll
        for (int vv = 0; vv < R; ++vv) sout[(size_t)(d0 + dh) * 64 + v0 + vv] = S[dh][vv];
}

__device__ __forceinline__ void scan_phase(const Args& args, LAS unsigned char* lds_, int l, int mode = 0) {
    const Ctx C = make_ctx(args, lds_);
    constexpr int NLONG = 1024, NSHORT = BS * 144;
    const int slot = C.wave * 256 + (int)blockIdx.x;
    const int nidle = C.NGW - NLONG;
    for (int it = 0;; ++it) {
        int kind, b, h, slice, row0, T; bool isp;
        if (slot < NLONG) { if (it > 0 || mode == 2) break; isp = true; T = TP;
            const int kk_ = slot >> 8, i = slot & 255; kind = kk_ == 0 ? 3 : (kk_ == 1 ? 0 : (kk_ == 2 ? 2 : 1));
            { const int stream = (i & 7) | ((i >> 6) << 3); slice = (i >> 3) & 7; b = stream >> 2; h = stream & 3; }
            row0 = b * TP;
        } else { const int st = (slot - NLONG) + it * nidle; if (st >= NSHORT || mode == 1) break; isp = false; T = TS;
            b = st / 144; int i = st - b * 144;
            if (i < 64) { kind = 3; h = i >> 4; slice = i & 15; }
            else if (i < 96) { i -= 64; kind = 0; h = i >> 3; slice = i & 7; }
            else if (i < 128) { i -= 96; kind = 2; h = i >> 3; slice = i & 7; }
            else { i -= 128; kind = 1; h = i >> 2; slice = i & 3; }
            row0 = MP + b * TS;
        }
        const int nbat = isp ? BP : BS;
        const size_t sidx = (size_t)((l * nbat + b) * 4 + h);
        if (isp) {
            LAS float* wl = (LAS float*)(C.lds + C.wave * 32768);
            if (kind == 0) scan_long<0, 4, 2>(C, wl, row0, T, h, slice, C.out + O_PRET + sidx * 4096);
            else if (kind == 1) scan_long<1, 2, 2>(C, wl, row0, T, h, slice, C.out + O_PGLA + sidx * 2048);
            else if (kind == 2) scan_long<2, 4, 2>(C, wl, row0, T, h, slice, C.out + O_PHG + sidx * 4096);
            else scan_long<3, 4, 2>(C, wl, row0, T, h, slice, C.out + O_PGDN + sidx * 4096);
        } else {
            if (kind == 0) { scan_task<0, 4, 2>(C, row0, T, h, slice, args.in[2] + sidx * 4096, C.out + O_SRET + sidx * 4096); }
            else if (kind == 1) { scan_task<1, 2, 4>(C, row0, T, h, slice, args.in[3] + sidx * 2048, C.out + O_SGLA + sidx * 2048); }
            else if (kind == 2) { scan_task<2, 4, 2>(C, row0, T, h, slice, args.in[4] + sidx * 4096, C.out + O_SHG + sidx * 4096); }
            else { scan_task<3, 4, 1>(C, row0, T, h, slice, args.in[5] + sidx * 4096, C.out + O_SGDN + sidx * 4096); }
        }
    }
}

__device__ __forceinline__ void post_phase(const Args& args, LAS unsigned char* lds_, int l) {
    const Ctx C = make_ctx(args, lds_);
    const bf16* PROJ = (const bf16*)(C.ws + WS_BIG); bf16* H = (bf16*)(C.ws + WS_H);
    const int lane = C.lane, mixer = lane >> 4, cc = (lane & 15) * 16;
    const int gbase = mixer == 0 ? C_RG : mixer == 1 ? C_AG : mixer == 2 ? C_HG : C_DG;
    const float* nw = mixer == 1 ? args.in[24] + l * 64 : mixer == 2 ? args.in[25] + l * 64 : args.in[26] + l * 64;
    float w[16];
#pragma unroll
    for (int i = 0; i < 16; ++i) w[i] = mixer == 0 ? 1.0f : nw[(cc + i) & 63];
    for (int r = C.gw; r < M; r += C.NGW) {
        bf16* hp = H + (size_t)r * D + lane * 16; const bf16* gp = PROJ + (size_t)r * NINP + gbase + cc;
        const v4u a0 = *(const v4u*)hp, a1 = *(const v4u*)(hp + 8);
        const v4u g0 = *(const v4u*)gp, g1 = *(const v4u*)(gp + 8);
        float y[16], g[16];
        const unsigned aw[8] = {a0.x, a0.y, a0.z, a0.w, a1.x, a1.y, a1.z, a1.w}, gw_[8] = {g0.x, g0.y, g0.z, g0.w, g1.x, g1.y, g1.z, g1.w};
        float ss = 0.f;
#pragma unroll
        for (int i = 0; i < 8; ++i) { y[2 * i] = bflo(aw[i]); y[2 * i + 1] = bfhi(aw[i]); g[2 * i] = bflo(gw_[i]); g[2 * i + 1] = bfhi(gw_[i]); ss += y[2 * i] * y[2 * i] + y[2 * i + 1] * y[2 * i + 1]; }
        ss = quad_sum(ss);
        const float rs = rsqrtf(ss * (1.0f / 64.0f) + RMS_EPS);
        unsigned ow[8];
#pragma unroll
        for (int i = 0; i < 8; ++i) ow[i] = pk2(y[2 * i] * rs * w[2 * i] * siluf_(g[2 * i]), y[2 * i + 1] * rs * w[2 * i + 1] * siluf_(g[2 * i + 1]));
        *(v4u*)hp = (v4u){ow[0], ow[1], ow[2], ow[3]}; *(v4u*)(hp + 8) = (v4u){ow[4], ow[5], ow[6], ow[7]};
    }
}

__global__ void __launch_bounds__(NWAVES * 64, 2) mega_fwd(Args args) {
    extern __shared__ __attribute__((aligned(16))) unsigned char lds[];
    cg::grid_group grid = cg::this_grid();
    LAS unsigned char* const LDSP = (LAS unsigned char*)lds;
    const int G = (int)gridDim.x, bx = (int)blockIdx.x;
    if (threadIdx.x < 64) ((LAS unsigned*)(LDSP + MISC_OFF))[threadIdx.x] = 0u;
    __syncthreads();
    (void)xcd_barrier_post((unsigned*)args.ws, (volatile LAS unsigned*)(LDSP + MISC_OFF));
#define FRESH() float* out_ = fresh_ptr(args.out); unsigned char* ws = fresh_ptr(args.ws); \
    float* MOD = (float*)(ws + WS_MOD); bf16* H = (bf16*)(ws + WS_H); bf16* BIG = (bf16*)(ws + WS_BIG); (void)MOD; (void)H; (void)BIG; (void)out_;

    p0_prologue(args, LDSP);
    grid.sync();
    {
        FRESH();
        pg8::Gemm g{(const bf16*)(ws + WS_AC), BIG, 256, 2 * NMODC, D}; pg8::StaticOrder S; S.init(256, 2 * NMODC, G, bx, D);
        pg8::EpiMod E{MOD, args.in[10]};
        pg8::gemm_phase<pg8::EpiMod, pg8::StaticOrder, PG8_ALIGN, PG8_SP2>(LDSP, g, S, E);
    }
    grid_bar(args, LDSP);
    p2_modulate0(args, LDSP);
    grid_bar(args, LDSP);
#pragma unroll 1
    for (int l = 0; l < 2; ++l) {
#pragma unroll 1
        for (int f = 0; f < 2; ++f) {
            if (f == 1) {
                {
                    FRESH();
                    pg8::Gemm g{H, (const bf16*)(ws + WS_W + (size_t)l * W_LAYER + W_WIN), M, NINP, D}; pg8::StaticOrder S; S.init(M, NINP, G, bx, D);
                    pg8::EpiPlain E{BIG, NINP};
                    pg8::gemm_phase<pg8::EpiPlain, pg8::StaticOrder, PG8_ALIGN, PG8_SP2>(LDSP, g, S, E);
                }
                grid_bar(args, LDSP);
                prep_phase(args, LDSP, l);
                grid_bar(args, LDSP);
                scan_phase(args, LDSP, l);
#ifdef PROBE_SCANMODE
                grid_bar(args, LDSP); scan_phase(args, LDSP, l, PROBE_SCANMODE);
#endif
                grid_bar(args, LDSP);
                post_phase(args, LDSP, l);
                grid_bar(args, LDSP);
                {
                    FRESH();
                    pg8::Gemm g{H, (const bf16*)(ws + WS_W + (size_t)l * W_LAYER + W_WOUT), M, D, D}; pg8::SplitOrder S; S.init(D, G, bx);
                    pg8::EpiRes E{out_, (float*)(ws + WS_SB), MOD + (size_t)l * NB * NMODC + 5 * 1024, 1.0f, D / 64};
                    pg8::gemm_phase<pg8::EpiRes, pg8::SplitOrder, PG8_ALIGN, PG8_SP2>(LDSP, g, S, E);
                }
                grid_bar(args, LDSP);
                ln_phase(args, LDSP, l, 1, true, l, 6, 4, ALPHA);
                grid_bar(args, LDSP);
            }
            {
                FRESH();
                pg8::Gemm g{H, (const bf16*)(ws + WS_W + (size_t)l * W_LAYER + (f ? W_WI2 : W_WI1)), M, NWI, D}; pg8::StaticOrder S; S.init(M, NWI, G, bx, D);
                pg8::EpiSwiglu E{BIG, DFF};
                pg8::gemm_phase<pg8::EpiSwiglu, pg8::StaticOrder, PG8_ALIGN, PG8_SP2>(LDSP, g, S, E);
            }
            grid_bar(args, LDSP);
            {
                FRESH();
                pg8::Gemm g{BIG, (const bf16*)(ws + WS_W + (size_t)l * W_LAYER + (f ? W_WO2 : W_WO1)), M, D, DFF}; pg8::SplitOrder S; S.init(DFF, G, bx);
                pg8::EpiRes E{out_, (float*)(ws + WS_SB), MOD + (size_t)l * NB * NMODC + (f ? 8 : 2) * 1024, 0.5f, DFF / 64};
                pg8::gemm_phase<pg8::EpiRes, pg8::SplitOrder, PG8_ALIGN, PG8_SP2>(LDSP, g, S, E);
            }
            grid_bar(args, LDSP);
            if (f == 0) ln_phase(args, LDSP, l, 0, true, l, 3, 11, ALPHA);
            else ln_phase(args, LDSP, l, 2, l == 0, 1, 0, 11, l == 0 ? ALPHA : 1.0f);
            if (!(l == 1 && f == 1)) grid_bar(args, LDSP);
        }
    }
}

extern "C" void kernel_launch(void* const* d_in, const int* in_sizes, int n_in, void* d_out, int out_size, void* d_ws, size_t ws_size, hipStream_t stream) {
    static int grid = 0;
    if (grid == 0) {
        if (n_in != 28 || (size_t)out_size != O_END || ws_size < WS_END) { fprintf(stderr, "kernel_launch: unexpected sizes n_in %d out %d ws %zu (need %zu)\n", n_in, out_size, ws_size, (size_t)WS_END); grid = -1; return; }
        int dev = 0, cus = 0, per_cu = 0;
        hipGetDevice(&dev); hipDeviceGetAttribute(&cus, hipDeviceAttributeMultiprocessorCount, dev);
        hipFuncSetAttribute((const void*)mega_fwd, hipFuncAttributeMaxDynamicSharedMemorySize, LDS_BYTES);
        hipOccupancyMaxActiveBlocksPerMultiprocessor(&per_cu, (const void*)mega_fwd, NWAVES * 64, LDS_BYTES);
        (void)hipGetLastError();
        if (per_cu < 1 || cus < 256) { fprintf(stderr, "kernel_launch: occupancy %d cus %d\n", per_cu, cus); grid = -1; return; }
        grid = 256;
    }
    if (grid < 0) return;
    if (hipMemsetAsync(d_ws, 0, 65536, stream) != hipSuccess) { fprintf(stderr, "memset failed\n"); return; }
    Args a{};
    for (int i = 0; i < 28; ++i) a.in[i] = (const float*)d_in[i];
    a.out = (float*)d_out; a.ws = (unsigned char*)d_ws;
    void* kargs[] = {&a};
    hipError_t e = hipLaunchCooperativeKernel((const void*)mega_fwd, dim3(grid), dim3(NWAVES * 64), kargs, LDS_BYTES, stream);
    if (e != hipSuccess) fprintf(stderr, "cooperative launch failed: %s\n", hipGetErrorString(e));
}
```

```cpp
#include <hip/hip_runtime.h>
#include <hip/hip_cooperative_groups.h>
#include <cstdio>
#include <cstdint>
namespace cg = cooperative_groups;
namespace pg8 {
#define PG8_LAS __attribute__((address_space(3)))
typedef unsigned short bf16_t;
typedef short bf16x8 __attribute__((ext_vector_type(8)));
typedef float f32x4 __attribute__((ext_vector_type(4)));
typedef unsigned u32x4 __attribute__((ext_vector_type(4)));
constexpr int BM = 256, BK = 64, HALF = 128, HTB = HALF * BK * 2  , STAGE_BYTES = 8 * HTB, NXCD = 8, WGM = 8;

__host__ __device__ __forceinline__ int lds_byte(int r, int c) { const int st = (r >> 4) * 2 + (c >> 5), rr = r & 15, cc = c & 31, ob = rr * 64 + cc * 2; return st * 1024 + (ob ^ (((ob >> 9) & 1) << 5)); }
__host__ __device__ __forceinline__ void stage_rc(int b, int& R, int& C) { const int st = b / 1024, sb = b % 1024, swz = sb ^ (((sb >> 9) & 1) << 5); R = (st >> 1) * 16 + swz / 64; C = (st & 1) * 32 + (swz % 64) / 2; }
__host__ __device__ __forceinline__ int perm32(int rho) { const int n = rho >> 4, i = rho & 15; return 8 * (i >> 2) + 4 * n + (i & 3); }

struct Unit { int pm, pn, k0, nt; };
struct Gemm { const bf16_t* A; const bf16_t* Bt; int M, N, K; };

struct StaticOrder {
    int nM, nN, nwg, G, c, ntf;
    __host__ __device__ void init(int M, int N, int G_, int c_, int K_ = 1024) { nM = M / BM; nN = N / BM; nwg = nM * nN; G = G_; c = c_; ntf = K_ / BK; }
    __host__ __device__ bool next(int i, Unit& u) const {
        const long L = (long)i * G + c; if (L >= nwg) return false;
        int wgid = (int)L; { const int q = nwg / NXCD, r = nwg % NXCD, xcd = wgid % NXCD, off = wgid / NXCD; wgid = (xcd < r ? xcd * (q + 1) : r * (q + 1) + (xcd - r) * q) + off; }
        const int nig = WGM * nN, gid = wgid / nig, fm = gid * WGM, gsz = (nM - fm) < WGM ? (nM - fm) : WGM;
        u.pm = fm + ((wgid % nig) % gsz); u.pn = (wgid % nig) / gsz; u.k0 = 0; u.nt = ntf; return true;
    }
    __device__ __forceinline__ void a_ready(const Unit&) const {}
    __device__ __forceinline__ void done(const Unit&) const {}
};

struct SplitOrder {
    StaticOrder base; int ppu, c;
    static constexpr int PK = 4;
    __host__ __device__ void init(int K_, int G_, int c_) { base.init(16384, 1024, G_, c_, K_); ppu = (K_ / BK) / PK; c = c_; }
    __host__ __device__ bool next(int i, Unit& u) const {
        if (i == 0) return base.next(0, u);
        if (i == 1 && c < 8 * ppu) { const int j = c / ppu, p = c - j * ppu; u.pm = 64 + (j >> 2); u.pn = j & 3; u.k0 = p * PK; u.nt = PK; return true; }
        return false;
    }
    __device__ __forceinline__ void a_ready(const Unit&) const {}
    __device__ __forceinline__ void done(const Unit&) const {}
};

__device__ __forceinline__ unsigned cvt_pk_bf16(float lo, float hi) { unsigned r; asm volatile("v_cvt_pk_bf16_f32 %0, %1, %2" : "=v"(r) : "v"(lo), "v"(hi)); return r; }
typedef float f32x2 __attribute__((ext_vector_type(2)));
__device__ __forceinline__ f32x2 gelu_pk(f32x2 v) {
    const f32x2 av = __builtin_elementwise_abs(v), d = av * 0.2316418882f + 1.0f;
    f32x2 t; t.x = __builtin_amdgcn_rcpf(d.x); t.y = __builtin_amdgcn_rcpf(d.y);
    f32x2 q = t * 0.5307027145f + (-0.7265760135f); q = q * t + 0.7107068705f; q = q * t + (-0.142248368f); q = q * t + 0.127414796f; q = q * t;
    const f32x2 s = (v * v) * (-0.72134752044f);
    f32x2 e; e.x = __builtin_amdgcn_exp2f(s.x); e.y = __builtin_amdgcn_exp2f(s.y);
    const f32x2 m = v * (q * e), r = v - m;
    f32x2 o; o.x = v.x < 0.f ? m.x : r.x; o.y = v.y < 0.f ? m.y : r.y; return o;
}

template <int ACT  > struct EpiBf16 {
    static constexpr bool PERM = true, AFTER_DRAIN = false; static_assert(ACT == 0 || ACT == 1, "EpiBf16: ACT is 0 (none) or 1 (gelu_pk)");
    bf16_t* O; int ldc; const float* bias; int split_cols; size_t split_stride; float scale0;
    __device__ __forceinline__ void operator()(const f32x4 (&acc)[2][2][4][2], const Unit& u, int wr, int wc, int fr, int fq) const {
        const int row0 = u.pm * BM + wr * 64 + fr; int colt = u.pn * BM; bf16_t* base = O;
        float sc = 1.f; if (split_cols) { const int t = colt / split_cols; base += (size_t)t * split_stride; colt -= t * split_cols; if (t == 0) sc = scale0; }
        const int col0 = colt + wc * 32 + 8 * fq, bcol0 = u.pn * BM + wc * 32 + 8 * fq;
        f32x4 bv[2][2];
#pragma unroll
        for (int bj = 0; bj < 2; ++bj)
#pragma unroll
            for (int n = 0; n < 2; ++n) bv[bj][n] = bias ? *(const f32x4*)(bias + bcol0 + bj * HALF + 4 * n) : (f32x4){0.f, 0.f, 0.f, 0.f};
#pragma unroll
        for (int ai = 0; ai < 2; ++ai)
#pragma unroll
            for (int m = 0; m < 4; ++m) { bf16_t* rowp = base + (size_t)(row0 + ai * HALF + m * 16) * ldc + col0;
#pragma unroll
                for (int bj = 0; bj < 2; ++bj) { f32x4 v0 = acc[ai][bj][m][0] + bv[bj][0], v1 = acc[ai][bj][m][1] + bv[bj][1];
                    if (ACT == 1) { f32x2 a = gelu_pk((f32x2){v0[0], v0[1]}), b = gelu_pk((f32x2){v0[2], v0[3]}), c = gelu_pk((f32x2){v1[0], v1[1]}), d = gelu_pk((f32x2){v1[2], v1[3]});
                        v0 = (f32x4){a.x, a.y, b.x, b.y}; v1 = (f32x4){c.x, c.y, d.x, d.y}; }
                    v0 = v0 * sc; v1 = v1 * sc; u32x4 w; w.x = cvt_pk_bf16(v0[0], v0[1]); w.y = cvt_pk_bf16(v0[2], v0[3]); w.z = cvt_pk_bf16(v1[0], v1[1]); w.w = cvt_pk_bf16(v1[2], v1[3]);
                    *(u32x4*)(rowp + bj * HALF) = w; } }
    }
};
template <class Epi, class Sched, bool ALIGN_EPI = false, bool SP2 = false>
__device__ __forceinline__ void gemm_phase(PG8_LAS unsigned char* lds, const Gemm g, const Sched& S, const Epi& E) {
    int tid_ = threadIdx.x; asm volatile("" : "+v"(tid_));
    const int tid = tid_, wid = __builtin_amdgcn_readfirstlane(tid >> 6), lane = tid & 63, wr = wid >> 2, wc = wid & 3, fr = lane & 15, fq = lane >> 4;
    const int K = g.K;
    unsigned voffA[2], voffB[2];
#pragma unroll
    for (int i = 0; i < 2; ++i) { int R, C; stage_rc(tid * 16 + i * 8192, R, C); const int Rb = Epi::PERM ? ((R & ~31) + perm32(R & 31)) : R;
        voffA[i] = (unsigned)(R * K + C) * 2u; voffB[i] = (unsigned)(Rb * K + C) * 2u; }
    const size_t kstep = (size_t)(BK * 2);
    const size_t hstep = (size_t)HALF * K * 2;
    const size_t tstep = 2 * hstep;
    const unsigned ldsw = (unsigned)wid * 1024u;
    const int aoff = lds_byte(wr * 64 + fr, fq * 8), boff = lds_byte(wc * 32 + fr, fq * 8);
#define PG8_SA(b, h) (((b) * 2 + (h)) * HTB)
#define PG8_SB(b, h) ((4 + (b) * 2 + (h)) * HTB)
#define PG8_STAGE(bufoff, gbase, voff) do { _Pragma("unroll") for (int _i = 0; _i < 2; ++_i) \
        __builtin_amdgcn_global_load_lds((const unsigned*)((const char*)(gbase) + (voff)[_i]), (PG8_LAS unsigned*)(lds + (bufoff) + ldsw + _i * 8192), 16, 0, 0); } while (0)
#define PG8_LDA(dst, b, h) do { _Pragma("unroll") for (int m = 0; m < 4; ++m) _Pragma("unroll") for (int k = 0; k < 2; ++k) dst[m][k] = *(const PG8_LAS bf16x8*)(lds + PG8_SA(b, h) + aoff + m * 2048 + k * 1024); } while (0)
#define PG8_LDB(dst, b, h) do { _Pragma("unroll") for (int n = 0; n < 2; ++n) _Pragma("unroll") for (int k = 0; k < 2; ++k) dst[n][k] = *(const PG8_LAS bf16x8*)(lds + PG8_SB(b, h) + boff + n * 2048 + k * 1024); } while (0)
#define PG8_MMA(ai, bj, At, Bt) do { __builtin_amdgcn_s_setprio(1); _Pragma("unroll") for (int m = 0; m < 4; ++m) _Pragma("unroll") for (int n = 0; n < 2; ++n) _Pragma("unroll") for (int k = 0; k < 2; ++k) \
        acc[ai][bj][m][n] = __builtin_amdgcn_mfma_f32_16x16x32_bf16(Bt[n][k], At[m][k], acc[ai][bj][m][n], 0, 0, 0); __builtin_amdgcn_s_setprio(0); } while (0)
#define PG8_WAIT_V(n) asm volatile("s_waitcnt vmcnt(" #n ")" ::: "memory")
#define PG8_WAIT_L(n) asm volatile("s_waitcnt lgkmcnt(" #n ")" ::: "memory")
#define PG8_BAR __builtin_amdgcn_s_barrier()
#define PG8_SCHED __builtin_amdgcn_sched_barrier(0)
    Unit cur, nxt; int ui = 0;
    if (!S.next(0, cur)) return;
    f32x4 acc[2][2][4][2];
#pragma unroll
    for (int a = 0; a < 2; ++a)
#pragma unroll
        for (int b = 0; b < 2; ++b)
#pragma unroll
            for (int m = 0; m < 4; ++m)
#pragma unroll
                for (int n = 0; n < 2; ++n) acc[a][b][m][n] = (f32x4){0.f, 0.f, 0.f, 0.f};
    bf16x8 At[4][2], B0[2][2], B1[2][2];
    const char* cA = (const char*)g.A + (size_t)cur.pm * tstep + (size_t)cur.k0 * kstep; const char* cB = (const char*)g.Bt + (size_t)cur.pn * tstep + (size_t)cur.k0 * kstep;
    S.a_ready(cur);
    if constexpr (SP2) {
        PG8_STAGE(PG8_SB(0, 0), cB, voffB); PG8_STAGE(PG8_SB(0, 1), cB + hstep, voffB); PG8_STAGE(PG8_SA(0, 0), cA, voffA); PG8_STAGE(PG8_SA(0, 1), cA + hstep, voffA);
        if (wr == 1) PG8_BAR;
        PG8_WAIT_V(2); PG8_BAR;
        PG8_STAGE(PG8_SB(1, 0), cB + kstep, voffB); PG8_STAGE(PG8_SA(1, 0), cA + kstep, voffA); PG8_STAGE(PG8_SB(1, 1), cB + hstep + kstep, voffB);
        PG8_WAIT_V(6); PG8_BAR;
    } else {
        PG8_STAGE(PG8_SB(0, 0), cB, voffB); PG8_STAGE(PG8_SA(0, 0), cA, voffA); PG8_STAGE(PG8_SB(0, 1), cB + hstep, voffB); PG8_STAGE(PG8_SA(0, 1), cA + hstep, voffA);
        if (wr == 1) PG8_BAR;
        PG8_WAIT_V(4); PG8_BAR;
        PG8_STAGE(PG8_SB(1, 0), cB + kstep, voffB); PG8_STAGE(PG8_SA(1, 0), cA + kstep, voffA); PG8_STAGE(PG8_SB(1, 1), cB + hstep + kstep, voffB);
        PG8_WAIT_V(6); PG8_BAR;
    }
    for (;;) {
        const bool has_next = S.next(ui + 1, nxt);
        const char* nA = has_next ? (const char*)g.A + (size_t)nxt.pm * tstep + (size_t)nxt.k0 * kstep : cA; const char* nB = has_next ? (const char*)g.Bt + (size_t)nxt.pn * tstep + (size_t)nxt.k0 * kstep : cB;
        const int nt = cur.nt;
        for (int t = 0; t < nt; t += 2) {
            const bool last = (t == nt - 2);
            const char* a1 = cA + (size_t)(t + 1) * kstep;
            const char* a2 = last ? nA : cA + (size_t)(t + 2) * kstep; const char* b2 = last ? nB : cB + (size_t)(t + 2) * kstep;
            const char* a3 = a2 + kstep; const char* b3 = b2 + kstep;
            if (last && has_next) S.a_ready(nxt);
            if constexpr (SP2) {
            PG8_LDB(B0, 0, 0); PG8_LDB(B1, 0, 1); PG8_SCHED; PG8_LDA(At, 0, 0); PG8_STAGE(PG8_SA(1, 1), a1 + hstep, voffA);
            PG8_WAIT_V(8); PG8_WAIT_L(0); PG8_BAR; PG8_MMA(0, 0, At, B0); PG8_MMA(0, 1, At, B1); PG8_BAR; PG8_SCHED;
            PG8_LDA(At, 0, 1); PG8_STAGE(PG8_SB(0, 0), b2, voffB); PG8_STAGE(PG8_SB(0, 1), b2 + hstep, voffB); PG8_STAGE(PG8_SA(0, 0), a2, voffA);
            PG8_WAIT_V(8); PG8_WAIT_L(0); PG8_BAR; PG8_MMA(1, 0, At, B0); PG8_MMA(1, 1, At, B1); PG8_BAR; PG8_SCHED;
            PG8_LDB(B0, 1, 0); PG8_LDB(B1, 1, 1); PG8_SCHED; PG8_LDA(At, 1, 0); PG8_STAGE(PG8_SA(0, 1), a2 + hstep, voffA);
            PG8_WAIT_V(8); PG8_WAIT_L(0); PG8_BAR; PG8_MMA(0, 0, At, B0); PG8_MMA(0, 1, At, B1); PG8_BAR; PG8_SCHED;
            PG8_LDA(At, 1, 1); PG8_STAGE(PG8_SB(1, 0), b3, voffB); PG8_STAGE(PG8_SB(1, 1), b3 + hstep, voffB); PG8_STAGE(PG8_SA(1, 0), a3, voffA);
            PG8_WAIT_V(8); PG8_WAIT_L(0); PG8_BAR; PG8_MMA(1, 0, At, B0); PG8_MMA(1, 1, At, B1); PG8_BAR; PG8_SCHED;
            } else {
            PG8_LDB(B0, 0, 0); PG8_SCHED; PG8_LDA(At, 0, 0); PG8_STAGE(PG8_SA(1, 1), a1 + hstep, voffA);
            PG8_WAIT_L(8); PG8_BAR; PG8_WAIT_L(0); PG8_MMA(0, 0, At, B0); PG8_BAR; PG8_SCHED;
            PG8_LDB(B1, 0, 1); PG8_STAGE(PG8_SB(0, 0), b2, voffB);
            PG8_BAR; PG8_WAIT_L(0); PG8_MMA(0, 1, At, B1); PG8_BAR;
            PG8_LDA(At, 0, 1); PG8_STAGE(PG8_SA(0, 0), a2, voffA);
            PG8_BAR; PG8_WAIT_L(0); PG8_MMA(1, 0, At, B0); PG8_BAR; PG8_SCHED;
            PG8_STAGE(PG8_SB(0, 1), b2 + hstep, voffB);
            PG8_WAIT_V(6); PG8_BAR; PG8_MMA(1, 1, At, B1); PG8_BAR;
            PG8_LDB(B0, 1, 0); PG8_SCHED; PG8_LDA(At, 1, 0); PG8_STAGE(PG8_SA(0, 1), a2 + hstep, voffA);
            PG8_WAIT_L(8); PG8_BAR; PG8_WAIT_L(0); PG8_MMA(0, 0, At, B0); PG8_BAR; PG8_SCHED;
            PG8_LDB(B1, 1, 1); PG8_STAGE(PG8_SB(1, 0), b3, voffB);
            PG8_BAR; PG8_WAIT_L(0); PG8_MMA(0, 1, At, B1); PG8_BAR;
            PG8_LDA(At, 1, 1); PG8_STAGE(PG8_SA(1, 0), a3, voffA);
            PG8_BAR; PG8_WAIT_L(0); PG8_MMA(1, 0, At, B0); PG8_BAR; PG8_SCHED;
            PG8_STAGE(PG8_SB(1, 1), b3 + hstep, voffB);
            PG8_WAIT_V(6); PG8_BAR; PG8_MMA(1, 1, At, B1); PG8_BAR;
            }
        }
        if constexpr (ALIGN_EPI) { if (wr == 0) PG8_BAR; }
        if constexpr (!Epi::AFTER_DRAIN) { E(acc, cur, wr, wc, fr, fq); S.done(cur); }
        if (!has_next) break;
#pragma unroll
        for (int a = 0; a < 2; ++a)
#pragma unroll
            for (int b = 0; b < 2; ++b)
#pragma unroll
                for (int m = 0; m < 4; ++m)
#pragma unroll
                    for (int n = 0; n < 2; ++n) acc[a][b][m][n] = (f32x4){0.f, 0.f, 0.f, 0.f};
        cur = nxt; cA = nA; cB = nB; ++ui;
        if constexpr (ALIGN_EPI) { if (wr == 1) PG8_BAR; }
    }
    PG8_WAIT_V(0);
    if constexpr (!ALIGN_EPI) { if (wr == 0) PG8_BAR; }
    PG8_BAR;
    if constexpr (Epi::AFTER_DRAIN) { E.fused(acc, cur, wr, wc, fr, fq, lds, wid, lane); S.done(cur); }
#undef PG8_SA
#undef PG8_SB
#undef PG8_STAGE
#undef PG8_LDA
#undef PG8_LDB
#undef PG8_MMA
#undef PG8_WAIT_V
#undef PG8_WAIT_L
#undef PG8_BAR
#undef PG8_SCHED
}
}
#define PG8_SP2 true
#define PG8_ALIGN true

constexpr int D = 1024, TP = 2048, BP = 8, BS = 128, TS = 4;
constexpr int MP = BP * TP, MS = BS * TS, M = MP + MS;
constexpr int DFF = 2816, NWI = 2 * DFF, NIN = 3864, NINP = 4096, NMODC = 9216, NB = BP + BS;
constexpr int SBW = 1664, SFW = 392;
constexpr float LN_EPS = 1e-5f, RMS_EPS = 1e-6f;
constexpr float ALPHA = 1.41421356237f;
constexpr int C_RQ = 0, C_RK = 256, C_RV = 512, C_RG = 768, C_AQ = 1024, C_AK = 1152, C_AV = 1280, C_ALR = 1536, C_AG = 1552,
              C_HQ = 1808, C_HF = 2064, C_HI = 2320, C_HG = 2576, C_DQKV = 2832, C_DB = 3600, C_DA = 3604, C_DG = 3608;
constexpr int SB_RQ = 0, SB_RK = 256, SB_AQ = 512, SB_HQ = 640, SB_DQ = 896, SB_DK = 1152, SB_DV = 1408;
constexpr int SF_ADEC = 0, SF_HF = 128, SF_BETA = 384, SF_DDEC = 388;
constexpr size_t O_Y = 0;
constexpr size_t O_PRET = (size_t)M * D;
constexpr size_t O_PGLA = O_PRET + 2ull * BP * 4 * 64 * 64;
constexpr size_t O_PHG = O_PGLA + 2ull * BP * 4 * 32 * 64;
constexpr size_t O_PGDN = O_PHG + 2ull * BP * 4 * 64 * 64;
constexpr size_t O_PCONV = O_PGDN + 2ull * BP * 4 * 64 * 64;
constexpr size_t O_SRET = O_PCONV + 2ull * BP * 3 * 768;
constexpr size_t O_SGLA = O_SRET + 2ull * BS * 4 * 64 * 64;
constexpr size_t O_SHG = O_SGLA + 2ull * BS * 4 * 32 * 64;
constexpr size_t O_SGDN = O_SHG + 2ull * BS * 4 * 64 * 64;
constexpr size_t O_SCONV = O_SGDN + 2ull * BS * 4 * 64 * 64;
constexpr size_t O_END = O_SCONV + 2ull * BS * 3 * 768;

constexpr size_t MiB = 1u << 20;
constexpr size_t WS_ROPE = 1 * MiB;
constexpr size_t WS_AC = 2 * MiB;
constexpr size_t WS_MOD = 3 * MiB;
constexpr size_t WS_W = 13 * MiB;
constexpr size_t W_WI1 = 0, W_WO1 = 11 * MiB, W_WI2 = W_WO1 + 5 * MiB + MiB / 2, W_WO2 = W_WI2 + 11 * MiB, W_WIN = W_WO2 + 5 * MiB + MiB / 2, W_WOUT = W_WIN + 8 * MiB, W_LAYER = 43 * MiB;
constexpr size_t WS_H = WS_W + 2 * W_LAYER;
constexpr size_t WS_BIG = WS_H + 33 * MiB;
constexpr size_t WS_SB = WS_BIG + 132 * MiB;
constexpr size_t WS_SF = WS_SB + 54 * MiB;
constexpr size_t WS_END = WS_SF + 26 * MiB;
static_assert((size_t)M * SBW * 2 <= 54 * MiB && (size_t)M * SFW * 4 <= 26 * MiB && (size_t)M * 4096 * 2 <= 132 * MiB && (size_t)M * D * 2 <= 33 * MiB, "ws map");

constexpr int LDS_BYTES = 147456;
constexpr int NWAVES = 8;

#define GAS __attribute__((address_space(1)))
#define LAS __attribute__((address_space(3)))
typedef unsigned short bf16;
typedef unsigned v4u __attribute__((ext_vector_type(4)));
typedef unsigned v2u __attribute__((ext_vector_type(2)));
typedef float f32x4 __attribute__((ext_vector_type(4)));
typedef float f32x2 __attribute__((ext_vector_type(2)));
#define LDS_WAIT() asm volatile("s_waitcnt lgkmcnt(0)" ::: "memory")

__device__ __forceinline__ float bf2f(unsigned b) { return __uint_as_float(b << 16); }
__device__ __forceinline__ float bflo(unsigned w) { return __uint_as_float(w << 16); }
__device__ __forceinline__ float bfhi(unsigned w) { return __uint_as_float(w & 0xffff0000u); }
__device__ __forceinline__ unsigned pk2(float lo, float hi) { return pg8::cvt_pk_bf16(lo, hi); }
__device__ __forceinline__ float sigmoidf_(float x) { return 1.0f / (1.0f + __expf(-x)); }
__device__ __forceinline__ float siluf_(float x) { return x / (1.0f + __expf(-x)); }
__device__ __forceinline__ float wave_sum(float v) {
#pragma unroll
    for (int o = 1; o < 64; o <<= 1) v += __shfl_xor(v, o);
    return v;
}
template <int CTRL> __device__ __forceinline__ float dppmov(float v) { return __int_as_float(__builtin_amdgcn_update_dpp(0, __float_as_int(v), CTRL, 0xf, 0xf, true)); }
__device__ __forceinline__ float quad_sum(float v) { v += dppmov<0xB1>(v); v += dppmov<0x4E>(v); return v; }
__device__ __forceinline__ float row8_sum(float v) { v += dppmov<0xB1>(v); v += dppmov<0x4E>(v); v += dppmov<0x141>(v); return v; }
__device__ __forceinline__ float row16_sum(float v) { v += dppmov<0xB1>(v); v += dppmov<0x4E>(v); v += dppmov<0x141>(v); v += dppmov<0x140>(v); return v; }

struct Args { const float* in[28]; float* out; unsigned char* ws; };

struct Ctx {
    int tid, lane, wave, gw, NGW;
    LAS unsigned char* lds;
    float* out; unsigned char* ws;
};
template <class T> __device__ __forceinline__ T* fresh_ptr(T* p) {
    unsigned lo = (unsigned)(uintptr_t)p, hi = (unsigned)((uintptr_t)p >> 32);
    asm volatile("" : "+v"(lo), "+v"(hi));
    lo = __builtin_amdgcn_readfirstlane(lo); hi = __builtin_amdgcn_readfirstlane(hi);
    return (T*)(__attribute__((address_space(1))) T*)(((uintptr_t)hi << 32) | (uintptr_t)lo);
}
__device__ __forceinline__ Ctx make_ctx(const Args& args, LAS unsigned char* lds) {
    Ctx C; int t = threadIdx.x; asm volatile("" : "+v"(t));
    C.tid = t; C.lane = t & 63; C.wave = __builtin_amdgcn_readfirstlane(t >> 6);
    C.gw = (int)blockIdx.x * NWAVES + C.wave; C.NGW = (int)gridDim.x * NWAVES;
    float* op = fresh_ptr(args.out); unsigned char* wp = fresh_ptr(args.ws);
    C.lds = lds; C.out = op; C.ws = wp; return C;
}
__device__ __forceinline__ int batch_of_row(int r) { return r < MP ? (r >> 11) : BP + ((r - MP) >> 2); }


typedef GAS unsigned gu32;
#define RLX_AGENT __ATOMIC_RELAXED, __HIP_MEMORY_SCOPE_AGENT
#define XB_TMO      128
#define XB_XCNT(j)  (256  + 64 * (j))
#define XB_XSUB(j)  (1280 + 64 * (j))
#define XB_XGEN(j)  (2304 + 64 * (j))
#define XB_TOP      3328
#define XB_TOPGEN   3392
#define XCD_BAR_WORDS 3456
#define XB_SPIN_CAP (1u << 18)

__device__ __forceinline__ unsigned xb_ld(unsigned* p)              { return __hip_atomic_load(p, __ATOMIC_RELAXED, __HIP_MEMORY_SCOPE_AGENT); }
__device__ __forceinline__ unsigned xb_add(unsigned* p, unsigned v) { return __hip_atomic_fetch_add(p, v, __ATOMIC_RELAXED, __HIP_MEMORY_SCOPE_AGENT); }
__device__ __forceinline__ unsigned xb_xcc_id() { return (unsigned)__builtin_amdgcn_s_getreg((3 << 11) | 20) & 0xFu; }
#define XB_SPIN(cond, bar) do { unsigned _sp = 0; while (cond) { __builtin_amdgcn_s_sleep(1); \
    if ((++_sp & 255u) == 0u) { if (xb_ld(&(bar)[XB_TMO])) break; if (_sp > XB_SPIN_CAP) { atomicAdd(&(bar)[XB_TMO], 1u); break; } } } } while (0)

struct XcdBarrier {
    unsigned* bar; unsigned x;
    volatile LAS unsigned* st;
};

__device__ __forceinline__ XcdBarrier xcd_barrier_post(unsigned* bar, volatile LAS unsigned* st) {
    XcdBarrier b; b.bar = bar; b.x = xb_xcc_id(); b.st = st;
    if (threadIdx.x == 0) (void)xb_add(&bar[XB_XCNT(b.x)], 1u);
    return b;
}
__device__ __forceinline__ void xcd_barrier_complete(unsigned* bar, unsigned x, unsigned& nloc, unsigned& nx) {
    const unsigned G = gridDim.x * gridDim.y * gridDim.z;
    unsigned sum, cnt, mine, sp = 0u;
    for (;;) {
        sum = 0u; cnt = 0u; mine = 0u;
#pragma unroll
        for (unsigned j = 0; j < 16; ++j) { const unsigned c = xb_ld(&bar[XB_XCNT(j)]); sum += c; cnt += (c > 0u) ? 1u : 0u; mine = (j == x) ? c : mine; }
        if (sum == G) break;
        __builtin_amdgcn_s_sleep(1);
        if ((++sp & 255u) == 0u) { if (xb_ld(&bar[XB_TMO])) break; if (sp > XB_SPIN_CAP) { atomicAdd(&bar[XB_TMO], 1u); break; } }
    }
    nloc = mine > 0u ? mine : 1u; nx = cnt > 0u ? cnt : 1u;
}

__device__ __forceinline__ void xcd_barrier(const XcdBarrier& b) {
    asm volatile("s_waitcnt vmcnt(0)" ::: "memory");
    __syncthreads();
    if (threadIdx.x == 0) {
        unsigned* bar = b.bar;
        __builtin_amdgcn_s_waitcnt(0);
        unsigned nloc = b.st[0], nx = b.st[1];
        if (nloc == 0u) { xcd_barrier_complete(bar, b.x, nloc, nx); b.st[0] = nloc; b.st[1] = nx; }
        const unsigned old = xb_add(&bar[XB_XSUB(b.x)], 1u);
        const unsigned gen = old / nloc;
        if (old + 1u == (gen + 1u) * nloc) {
            __builtin_amdgcn_fence(__ATOMIC_RELEASE, "agent");
            asm volatile("s_waitcnt vmcnt(0)" ::: "memory");
            const unsigned og = xb_add(&bar[XB_TOP], 1u);
            const unsigned tg = og / nx;
            if (og + 1u == (tg + 1u) * nx) xb_add(&bar[XB_TOPGEN], 1u);
            else XB_SPIN(xb_ld(&bar[XB_TOPGEN]) == tg, bar);
            __builtin_amdgcn_fence(__ATOMIC_ACQUIRE, "agent");
            xb_add(&bar[XB_XGEN(b.x)], 1u);
            asm volatile("s_waitcnt vmcnt(0)" ::: "memory");
        } else {
            XB_SPIN(xb_ld(&bar[XB_XGEN(b.x)]) == gen, bar);
            __builtin_amdgcn_fence(__ATOMIC_ACQUIRE, "agent");
            asm volatile("s_waitcnt vmcnt(0)" ::: "memory");
        }
    }
    __syncthreads();
}

constexpr int MISC_OFF = LDS_BYTES - 256;
__device__ __forceinline__ void grid_bar(const Args& args, LAS unsigned char* lds) {
    XcdBarrier b; b.bar = (unsigned*)fresh_ptr(args.ws); b.x = xb_xcc_id(); b.st = (volatile LAS unsigned*)(lds + MISC_OFF);
    xcd_barrier(b);
}

namespace pg8 {
struct EpiSwiglu {
    static constexpr bool PERM = true, AFTER_DRAIN = false;
    bf16_t* O; int ldc;
    __device__ __forceinline__ void operator()(const f32x4 (&acc)[2][2][4][2], const Unit& u, int wr, int wc, int fr, int fq) const {
        const int row0 = u.pm * BM + wr * 64 + fr, col0 = u.pn * 128 + wc * 32 + 8 * fq;
#pragma unroll
        for (int ai = 0; ai < 2; ++ai)
#pragma unroll
            for (int m = 0; m < 4; ++m) {
                bf16_t* rowp = O + (size_t)(row0 + ai * HALF + m * 16) * ldc + col0;
                float h[8];
#pragma unroll
                for (int n = 0; n < 2; ++n)
#pragma unroll
                    for (int j = 0; j < 4; ++j) {
                        const float a = acc[ai][0][m][n][j], b = acc[ai][1][m][n][j];
                        const float e = __builtin_amdgcn_exp2f(-1.44269504f * a);
                        h[n * 4 + j] = a * __builtin_amdgcn_rcpf(1.0f + e) * b;
                    }
                u32x4 w; w.x = cvt_pk_bf16(h[0], h[1]); w.y = cvt_pk_bf16(h[2], h[3]); w.z = cvt_pk_bf16(h[4], h[5]); w.w = cvt_pk_bf16(h[6], h[7]);
                *(u32x4*)rowp = w;
            }
    }
};
struct EpiPlain {
    static constexpr bool PERM = true, AFTER_DRAIN = false;
    bf16_t* O; int ldc;
    __device__ __forceinline__ void operator()(const f32x4 (&acc)[2][2][4][2], const Unit& u, int wr, int wc, int fr, int fq) const {
        const int row0 = u.pm * BM + wr * 64 + fr, col0 = u.pn * BM + wc * 32 + 8 * fq;
#pragma unroll
        for (int ai = 0; ai < 2; ++ai)
#pragma unroll
            for (int m = 0; m < 4; ++m) {
                bf16_t* rowp = O + (size_t)(row0 + ai * HALF + m * 16) * ldc + col0;
#pragma unroll
                for (int bj = 0; bj < 2; ++bj) { const f32x4 v0 = acc[ai][bj][m][0], v1 = acc[ai][bj][m][1];
                    u32x4 w; w.x = cvt_pk_bf16(v0[0], v0[1]); w.y = cvt_pk_bf16(v0[2], v0[3]); w.z = cvt_pk_bf16(v1[0], v1[1]); w.w = cvt_pk_bf16(v1[2], v1[3]);
                    *(u32x4*)(rowp + bj * HALF) = w; }
            }
    }
};
struct EpiRes {
    static constexpr bool PERM = false, AFTER_DRAIN = false;
    float* X; float* PART; const float* gate; float scale; int ntf;
    __device__ __forceinline__ void operator()(const f32x4 (&acc)[2][2][4][2], const Unit& u, int wr, int wc, int fr, int fq) const {
        const int col0 = u.pn * BM + wc * 32 + 4 * fq;
        const bool full = (u.nt == ntf);
        float* pbase = PART + (size_t)(u.k0 / SplitOrder::PK) * (512 * 1024);
#pragma unroll
        for (int ai = 0; ai < 2; ++ai)
#pragma unroll
            for (int m = 0; m < 4; ++m) {
                const int r = u.pm * BM + ai * HALF + wr * 64 + m * 16 + fr;
                const int bi = r < 16384 ? (r >> 11) : 8 + ((r - 16384) >> 2);
                const float* gp = gate + (size_t)bi * 9216;
                float* xo = full ? X + (size_t)r * 1024 : pbase + (size_t)(r - 16384) * 1024;
#pragma unroll
                for (int bj = 0; bj < 2; ++bj)
#pragma unroll
                    for (int n = 0; n < 2; ++n) {
                        const int c = col0 + bj * HALF + n * 16;
                        const f32x4 gv = *(const f32x4*)(gp + c);
                        f32x4 o = (gv * scale + scale) * acc[ai][bj][m][n];
                        if (full) o += *(const f32x4*)(xo + c);
                        *(f32x4*)(xo + c) = o;
                    }
                asm volatile("" ::: "memory");
            }
    }
};
struct EpiMod {
    static constexpr bool PERM = false, AFTER_DRAIN = false;
    float* MODp; const float* ada_b;
    __device__ __forceinline__ void operator()(const f32x4 (&acc)[2][2][4][2], const Unit& u, int wr, int wc, int fr, int fq) const {
        const int col0 = u.pn * BM + wc * 32 + 4 * fq;
        const int l = (u.pn * BM) / 9216;
#pragma unroll
        for (int ai = 0; ai < 2; ++ai)
#pragma unroll
            for (int m = 0; m < 4; ++m) {
                const int r = u.pm * BM + ai * HALF + wr * 64 + m * 16 + fr;
                if (r < 136) {
#pragma unroll
                    for (int bj = 0; bj < 2; ++bj)
#pragma unroll
                        for (int n = 0; n < 2; ++n) {
                            const int c = col0 + bj * HALF + n * 16;
                            const f32x4 o = acc[ai][bj][m][n] + *(const f32x4*)(ada_b + c);
                            *(f32x4*)(MODp + (size_t)(l * 136 + r) * 9216 + (c - l * 9216)) = o;
                        }
                }
            }
    }
};
}

__device__ __forceinline__ void transpose_item(const float* W, int K, int N, bf16* WT, int dest_row0, LAS float* scr, int k0, int n0, int lane) {
    const int nn = n0 + (lane & 31); const bool ok = nn < N;
#pragma unroll 8
    for (int i = 0; i < 32; ++i) { const int kk = 2 * i + (lane >> 5); scr[kk * 33 + (lane & 31)] = ok ? W[(size_t)(k0 + kk) * N + nn] : 0.f; }
    LDS_WAIT();
    const int c = lane & 7;
#pragma unroll
    for (int j = 0; j < 4; ++j) { const int n = (lane >> 3) + 8 * j; const LAS float* s = scr + (8 * c) * 33 + n;
        v4u o; o.x = pk2(s[0 * 33], s[1 * 33]); o.y = pk2(s[2 * 33], s[3 * 33]); o.z = pk2(s[4 * 33], s[5 * 33]); o.w = pk2(s[6 * 33], s[7 * 33]);
        *(v4u*)(WT + (size_t)(dest_row0 + n) * K + k0 + 8 * c) = o; }
    LDS_WAIT();
}

__device__ __forceinline__ void p0_prologue(const Args& args, LAS unsigned char* lds_) {
    const Ctx C = make_ctx(args, lds_);
    LAS float* scr = (LAS float*)(C.lds + C.wave * 16384);
    constexpr int I_WI = 16 * 176, I_WO = 44 * 32, I_WIN = 16 * 121, I_WOUT = 16 * 32, I_ADA = 16 * 288;
    constexpr int I_LAYER = 2 * I_WI + 2 * I_WO + I_WIN + I_WOUT + I_ADA;
    for (int it = C.gw; it < 2 * I_LAYER; it += C.NGW) {
        const int l = it / I_LAYER; int r = it - l * I_LAYER;
        unsigned char* wl = C.ws + WS_W + (size_t)l * W_LAYER;
        if (r < 2 * (I_WI + I_WO)) {
            const int f = r / (I_WI + I_WO); r -= f * (I_WI + I_WO);
            if (r < I_WI) {
                const int kb = r / 176, nb = r % 176, n0 = nb * 32;
                const int half = n0 / DFF, j = n0 - half * DFF, t = j >> 7, jj = j & 127;
                transpose_item((f ? args.in[15] : args.in[13]) + (size_t)l * D * NWI, D, NWI, (bf16*)(wl + (f ? W_WI2 : W_WI1)), 256 * t + 128 * half + jj, scr, kb * 64, n0, C.lane);
            } else { r -= I_WI;
                const int kb = r / 32, nb = r % 32;
                transpose_item((f ? args.in[16] : args.in[14]) + (size_t)l * DFF * D, DFF, D, (bf16*)(wl + (f ? W_WO2 : W_WO1)), nb * 32, scr, kb * 64, nb * 32, C.lane);
            }
            continue;
        }
        r -= 2 * (I_WI + I_WO);
        if (r < I_WIN) { const int kb = r / 121, nb = r % 121;
            transpose_item(args.in[17] + (size_t)l * D * NIN, D, NIN, (bf16*)(wl + W_WIN), nb * 32, scr, kb * 64, nb * 32, C.lane); continue; }
        r -= I_WIN;
        if (r < I_WOUT) { const int kb = r / 32, nb = r % 32;
            transpose_item(args.in[27] + (size_t)l * D * D, D, D, (bf16*)(wl + W_WOUT), nb * 32, scr, kb * 64, nb * 32, C.lane); continue; }
        r -= I_WOUT;
        { const int kb = r / 288, nb = r % 288;
            transpose_item(args.in[9] + (size_t)l * D * NMODC, D, NMODC, (bf16*)(C.ws + WS_BIG), l * NMODC + nb * 32, scr, kb * 64, nb * 32, C.lane); }
    }
    const int gt = C.gw * 64 + C.lane, NGT = C.NGW * 64;
    for (int i = gt; i < 2 * 224 * 128; i += NGT) { const int l = i / (224 * 128), rr = (i / 128) % 224, ch = i & 127;
        *(v4u*)(C.ws + WS_W + (size_t)l * W_LAYER + W_WIN + ((size_t)(3872 + rr) * 1024 + ch * 8) * 2) = (v4u){0u, 0u, 0u, 0u}; }
    for (int i = gt; i < 256 * 256; i += NGT) { const int row = i >> 8, c4 = (i & 255) * 4;
        v2u o = (v2u){0u, 0u};
        if (row < NB) { const float* src = row < BP ? args.in[7] + (size_t)row * D : args.in[8] + (size_t)(row - BP) * D; const f32x4 v = *(const f32x4*)(src + c4);
            o.x = pk2(siluf_(v.x), siluf_(v.y)); o.y = pk2(siluf_(v.z), siluf_(v.w)); }
        *(v2u*)(C.ws + WS_AC + ((size_t)row * D + c4) * 2) = o; }
    for (int i = gt; i < 2052 * 32; i += NGT) { const int p = i >> 5, j = i & 31; const double pos = p < 2048 ? (double)p : (double)(16384 + (p - 2048));
        double inv = 1.0; for (int q = 0; q < j; ++q) inv *= 0.7498942093324559;
        const double ang = pos * inv; const double n = rint(ang * 0.15915494309189535);
        const float rr = (float)((ang - n * 6.283185307179586) - n * 2.4492935982947064e-16);
        ((f32x2*)(C.ws + WS_ROPE))[i] = (f32x2){__cosf(rr), __sinf(rr)}; }
}

__device__ __forceinline__ void p2_modulate0(const Args& args, LAS unsigned char* lds_) {
    const Ctx C = make_ctx(args, lds_);
    const float* MOD = (const float*)(C.ws + WS_MOD); bf16* H = (bf16*)(C.ws + WS_H);
    for (int r = C.gw; r < M; r += C.NGW) {
        const float* xr = r < MP ? args.in[0] + (size_t)r * D : args.in[1] + (size_t)(r - MP) * D;
        const float* modr = MOD + (size_t)batch_of_row(r) * NMODC;
#pragma unroll
        for (int j = 0; j < 4; ++j) { const int c = (C.lane + 64 * j) * 4;
            const f32x4 v = *(const f32x4*)(xr + c), sh = *(const f32x4*)(modr + c), sc = *(const f32x4*)(modr + 1024 + c);
            const f32x4 h = v * (sc + 1.0f) + sh;
            *(f32x4*)(C.out + (size_t)r * D + c) = v * ALPHA;
            *(v2u*)(H + (size_t)r * D + c) = (v2u){pk2(h.x, h.y), pk2(h.z, h.w)}; }
    }
}

__device__ __forceinline__ void ln_phase(const Args& args, LAS unsigned char* lds_, int l, int which, bool write_h, int hl, int shc, int npart, float xscale) {
    const Ctx C = make_ctx(args, lds_);
    const float* MOD = (const float*)(C.ws + WS_MOD); bf16* H = (bf16*)(C.ws + WS_H);
    const float* g = args.in[11] + (size_t)(l * 3 + which) * D; const float* b = args.in[12] + (size_t)(l * 3 + which) * D;
    for (int r = C.gw; r < M; r += C.NGW) {
        float* xr = C.out + (size_t)r * D;
        f32x4 v[4]; float s = 0.f;
#pragma unroll
        for (int j = 0; j < 4; ++j) v[j] = *(const f32x4*)(xr + (C.lane + 64 * j) * 4);
        if (r >= MP) { const float* pp = (const float*)(C.ws + WS_SB) + (size_t)(r - MP) * D;
#pragma unroll 1
            for (int p = 0; p < npart; ++p, pp += 512 * 1024) {
#pragma unroll
                for (int j = 0; j < 4; ++j) v[j] += *(const f32x4*)(pp + (C.lane + 64 * j) * 4); } }
#pragma unroll
        for (int j = 0; j < 4; ++j) s += (v[j].x + v[j].y) + (v[j].z + v[j].w);
        const float mean = wave_sum(s) * (1.f / D); float s2 = 0.f;
#pragma unroll
        for (int j = 0; j < 4; ++j) { v[j] = v[j] - mean; s2 += (v[j].x * v[j].x + v[j].y * v[j].y) + (v[j].z * v[j].z + v[j].w * v[j].w); }
        const float rstd = 1.f / sqrtf(wave_sum(s2) * (1.f / D) + LN_EPS);
        const float* modr = MOD + (size_t)(hl * NB + batch_of_row(r)) * NMODC + shc * 1024;
#pragma unroll
        for (int j = 0; j < 4; ++j) { const int c = (C.lane + 64 * j) * 4;
            const f32x4 xn = v[j] * rstd * *(const f32x4*)(g + c) + *(const f32x4*)(b + c);
            *(f32x4*)(xr + c) = xn * xscale;
            if (write_h) { const f32x4 sh = *(const f32x4*)(modr + c), sc = *(const f32x4*)(modr + 1024 + c); const f32x4 h = xn * (sc + 1.0f) + sh;
                *(v2u*)(H + (size_t)r * D + c) = (v2u){pk2(h.x, h.y), pk2(h.z, h.w)}; }
        }
    }
}

struct PrepRaw { unsigned short rq1[4], rq2[4], rk1[4], rk2[4], aq[2], hf[4], hq[4], dx[12], db, da; v4u alr0, alr1; };
__device__ __forceinline__ void prep_load(PrepRaw& x, const bf16* P, int lane) {
    const int j = lane & 31;
#pragma unroll
    for (int h = 0; h < 4; ++h) { x.rq1[h] = P[C_RQ + h * 64 + j]; x.rq2[h] = P[C_RQ + h * 64 + 32 + j]; x.rk1[h] = P[C_RK + h * 64 + j]; x.rk2[h] = P[C_RK + h * 64 + 32 + j]; }
    x.alr0 = *(const v4u*)(P + C_ALR); x.alr1 = *(const v4u*)(P + C_ALR + 8);
#pragma unroll
    for (int i = 0; i < 2; ++i) x.aq[i] = P[C_AQ + lane + 64 * i];
#pragma unroll
    for (int i = 0; i < 4; ++i) { x.hf[i] = P[C_HF + lane + 64 * i]; x.hq[i] = P[C_HQ + lane + 64 * i]; }
#pragma unroll
    for (int i = 0; i < 12; ++i) x.dx[i] = P[C_DQKV + lane + 64 * i];
    x.db = P[C_DB + (lane & 3)]; x.da = P[C_DA + (lane & 3)];
}
__device__ __forceinline__ float wave_sum2(float v) { v = row16_sum(v); v += __shfl_xor(v, 16); v += __shfl_xor(v, 32); return v; }

__device__ __forceinline__ void prep_phase(const Args& args, LAS unsigned char* lds_, int l) {
    const Ctx C = make_ctx(args, lds_);
    const bf16* PROJ = (const bf16*)(C.ws + WS_BIG); bf16* SB = (bf16*)(C.ws + WS_SB); float* SF = (float*)(C.ws + WS_SF);
    const f32x2* ROPE = (const f32x2*)(C.ws + WS_ROPE);
    const int lane = C.lane;
    const float* wg = args.in[18] + (size_t)l * 16 * 128; const float* bg = args.in[19] + (size_t)l * 128;
    const float* cw = args.in[21] + (size_t)l * 4 * 768;
    constexpr int CH = 9;
    const int r0 = C.gw * CH, r1 = min(r0 + CH, M);
    if (r0 >= M) return;
    float lbv[4];
#pragma unroll
    for (int i = 0; i < 4; ++i) { lbv[i] = 0.f; if (l == 1) lbv[i] = 1.0f / (1.0f + expf(args.in[20][lane + 64 * i] - args.in[20][256 + lane + 64 * i])); }
    const float a_neg = -expf(args.in[22][l * 4 + (lane & 3)]), dtb = args.in[23][l * 4 + (lane & 3)];
    const float bg0 = bg[lane], bg1 = bg[lane + 64];
    float w1[12], w2[12], w3[12];
    auto load_window = [&](int r) {
        const bool isp = r < MP; const int rs = r - MP; const int b = isp ? (r >> 11) : (rs >> 2), t = isp ? (r & 2047) : (rs & 3);
        const float* cst = args.in[6] + ((size_t)(l * BS + b) * 3) * 768;
#pragma unroll
        for (int i = 0; i < 12; ++i) { const int ch = lane + 64 * i; const bf16* Pc = PROJ + (size_t)r * NINP + C_DQKV + ch;
            w1[i] = t >= 1 ? bf2f(Pc[-1 * NINP]) : (isp ? 0.f : cst[2 * 768 + ch]);
            w2[i] = t >= 2 ? bf2f(Pc[-2 * NINP]) : (isp ? 0.f : cst[(1 + t) * 768 + ch]);
            w3[i] = t >= 3 ? bf2f(Pc[-3 * NINP]) : (isp ? 0.f : cst[t * 768 + ch]); }
    };
    PrepRaw A; prep_load(A, PROJ + (size_t)r0 * NINP, lane);
    load_window(r0);
#pragma unroll 1
    for (int r = r0; r < r1; ++r) {
        PrepRaw B = A;
        if (r + 1 < r1) prep_load(B, PROJ + (size_t)(r + 1) * NINP, lane);
        int zo = 0; asm volatile("" : "+v"(zo));
        const bool isp = r < MP; const int rs = r - MP;
        const int b = isp ? (r >> 11) : (rs >> 2), t = isp ? (r & 2047) : (rs & 3);
        const int ridx = isp ? t : 2048 + t;
        bf16* sb = SB + (size_t)r * SBW; float* sf = SF + (size_t)r * SFW;
        { const int j = lane & 31; const bool hi = lane >= 32; const f32x2 cs = ROPE[ridx * 32 + j];
#pragma unroll
          for (int h = 0; h < 4; ++h) {
              const float q1 = bf2f(A.rq1[h]), q2 = bf2f(A.rq2[h]), k1 = bf2f(A.rk1[h]), k2 = bf2f(A.rk2[h]);
              const float qo = hi ? (q1 * cs.y + q2 * cs.x) : (q1 * cs.x - q2 * cs.y);
              const float ko = hi ? (k1 * cs.y + k2 * cs.x) : (k1 * cs.x - k2 * cs.y);
              sb[SB_RQ + h * 64 + lane] = (bf16)(pk2(qo, 0.f) & 0xffffu);
              sb[SB_RK + h * 64 + lane] = (bf16)(pk2(ko * 0.125f, 0.f) & 0xffffu);
          } }
        { const unsigned aw[8] = {A.alr0.x, A.alr0.y, A.alr0.z, A.alr0.w, A.alr1.x, A.alr1.y, A.alr1.z, A.alr1.w};
          float x0 = bg0, x1 = bg1;
#pragma unroll
          for (int i = 0; i < 8; ++i) { const float a0 = bflo(aw[i]), a1 = bfhi(aw[i]);
              x0 += a0 * wg[(2 * i) * 128 + lane + zo] + a1 * wg[(2 * i + 1) * 128 + lane + zo];
              x1 += a0 * wg[(2 * i) * 128 + lane + 64 + zo] + a1 * wg[(2 * i + 1) * 128 + lane + 64 + zo]; }
          const float sp0 = fmaxf(-x0, 0.f) + log1pf(expf(-fabsf(x0))), sp1 = fmaxf(-x1, 0.f) + log1pf(expf(-fabsf(x1)));
          sf[SF_ADEC + lane] = expf(-sp0 * (1.0f / 16.0f)); sf[SF_ADEC + lane + 64] = expf(-sp1 * (1.0f / 16.0f));
          sb[SB_AQ + lane] = (bf16)(pk2(bf2f(A.aq[0]) * 0.17677669529663687f, 0.f) & 0xffffu);
          sb[SB_AQ + lane + 64] = (bf16)(pk2(bf2f(A.aq[1]) * 0.17677669529663687f, 0.f) & 0xffffu); }
#pragma unroll
        for (int i = 0; i < 4; ++i) { const int c = lane + 64 * i;
            sf[SF_HF + c] = lbv[i] + (1.0f - lbv[i]) * sigmoidf_(bf2f(A.hf[i]));
            sb[SB_HQ + c] = (bf16)(pk2(siluf_(bf2f(A.hq[i])) * 0.125f, 0.f) & 0xffffu); }
        { float* cso = isp ? C.out + O_PCONV + ((size_t)(l * BP + b) * 3) * 768 : C.out + O_SCONV + ((size_t)(l * BS + b) * 3) * 768;
          const int so = isp ? t - (TP - 3) : t - 1;
          float uu[12];
#pragma unroll
          for (int i = 0; i < 12; ++i) { const float x0 = bf2f(A.dx[i]);
              const float* cwc = cw + lane + 64 * i + zo;
              uu[i] = siluf_(x0 * cwc[3 * 768] + w1[i] * cwc[2 * 768] + w2[i] * cwc[768] + w3[i] * cwc[0]);
              if (so >= 0) cso[so * 768 + lane + 64 * i] = x0;
              w3[i] = w2[i]; w2[i] = w1[i]; w1[i] = x0; }
#pragma unroll
          for (int i = 0; i < 12; ++i) { float sc = 1.0f;
              if (i < 8) { const float nn = wave_sum2(uu[i] * uu[i]); sc = rsqrtf(nn + RMS_EPS) * (i < 4 ? 0.125f : 1.0f); }
              sb[SB_DQ + i * 64 + lane] = (bf16)(pk2(uu[i] * sc, 0.f) & 0xffffu); }
          if (lane < 4) { sf[SF_BETA + lane] = sigmoidf_(bf2f(A.db));
              const float xx = bf2f(A.da) + dtb; const float sp = fmaxf(xx, 0.f) + log1pf(expf(-fabsf(xx)));
              sf[SF_DDEC + lane] = expf(a_neg * sp); } }
        A = B;
        if (r + 1 < r1) { const int rn = r + 1; const bool ns = rn < MP ? ((rn & 2047) == 0) : (((rn - MP) & 3) == 0); if (ns) load_window(rn); }
    }
}

template <int KIND, int DH, int R> struct Raw { unsigned q[DH / 2]; unsigned k[DH / 2]; unsigned v[(R + 1) / 2]; float f[DH]; float be, de; };

template <int KIND, int DH, int R>
__device__ __forceinline__ void load_tok(Raw<KIND, DH, R>& x, const bf16* qp, const bf16* kp, const bf16* vp, const float* fp) {
    if constexpr (DH == 4) { const v2u w = *(const v2u*)qp; x.q[0] = w.x; x.q[1] = w.y; } else { x.q[0] = *(const unsigned*)qp; }
    if constexpr (KIND != 2) { if constexpr (DH == 4) { const v2u w = *(const v2u*)kp; x.k[0] = w.x; x.k[1] = w.y; } else { x.k[0] = *(const unsigned*)kp; } }
    if constexpr (R == 1) x.v[0] = *vp; else if constexpr (R == 2) x.v[0] = *(const unsigned*)vp; else { const v2u w = *(const v2u*)vp; x.v[0] = w.x; x.v[1] = w.y; }
    if constexpr (KIND == 1) { const f32x2 w = *(const f32x2*)fp; x.f[0] = w.x; x.f[1] = w.y; }
    if constexpr (KIND == 2) { const f32x4 w = *(const f32x4*)fp; x.f[0] = w.x; x.f[1] = w.y; x.f[2] = w.z; x.f[3] = w.w; }
    if constexpr (KIND == 3) { x.be = fp[0]; x.de = fp[4]; }
}

template <int KIND, int DH, int R>
__device__ __forceinline__ void scan_task(const Ctx& C, int row0, int T, int h, int slice, const float* sin, float* sout) {
    const bf16* PROJ = (const bf16*)(C.ws + WS_BIG); const bf16* SB = (const bf16*)(C.ws + WS_SB); const float* SF = (const float*)(C.ws + WS_SF);
    bf16* H = (bf16*)(C.ws + WS_H);
    const int lane = C.lane, dl = lane & 15, rw = lane >> 4;
    const int d0 = dl * DH, v0 = slice * (4 * R) + rw * R;
    constexpr int DK = 16 * DH;
    const bf16 *qp, *kp, *vp; const float* fp; int ks, vs;
    const bf16* sbr = SB + (size_t)row0 * SBW; const bf16* pr = PROJ + (size_t)row0 * NINP; const float* sfr = SF + (size_t)row0 * SFW;
    if constexpr (KIND == 0) { qp = sbr + SB_RQ + h * 64 + d0; kp = sbr + SB_RK + h * 64 + d0; ks = SBW; vp = pr + C_RV + h * 64 + v0; vs = NINP; fp = sfr; }
    if constexpr (KIND == 1) { qp = sbr + SB_AQ + h * 32 + d0; kp = pr + C_AK + h * 32 + d0; ks = NINP; vp = pr + C_AV + h * 64 + v0; vs = NINP; fp = sfr + SF_ADEC + h * 32 + d0; }
    if constexpr (KIND == 2) { qp = sbr + SB_HQ + h * 64 + d0; kp = sbr; ks = SBW; vp = pr + C_HI + h * 64 + v0; vs = NINP; fp = sfr + SF_HF + h * 64 + d0; }
    if constexpr (KIND == 3) { qp = sbr + SB_DQ + h * 64 + d0; kp = sbr + SB_DK + h * 64 + d0; ks = SBW; vp = sbr + SB_DV + h * 64 + v0; vs = SBW; fp = sfr + SF_BETA + h; }
    bf16* op = H + (size_t)row0 * D + KIND * 256 + h * 64 + v0;
    const float rdec = 1.0f - exp2f(-5.0f - (float)h);

    float S[DH][R];
#pragma unroll
    for (int dh = 0; dh < DH; ++dh)
#pragma unroll
        for (int vv = 0; vv < R; ++vv) S[dh][vv] = sin ? sin[(size_t)(d0 + dh) * 64 + v0 + vv] : 0.f;

    typedef Raw<KIND, DH, R> RawT;
    RawT A[4];
#pragma unroll
    for (int u = 0; u < 4; ++u) load_tok<KIND, DH, R>(A[u], qp + (size_t)u * SBW, kp + (size_t)u * ks, vp + (size_t)u * vs, fp + (size_t)u * SFW);
    for (int t0 = 0; t0 < T; t0 += 4) {
        RawT B[4];
        const bool more = t0 + 4 < T;
#pragma unroll
        for (int u = 0; u < 4; ++u) { B[u] = A[u]; }
        if (more) {
#pragma unroll
            for (int u = 0; u < 4; ++u) load_tok<KIND, DH, R>(B[u], qp + (size_t)(t0 + 4 + u) * SBW, kp + (size_t)(t0 + 4 + u) * ks, vp + (size_t)(t0 + 4 + u) * vs, fp + (size_t)(t0 + 4 + u) * SFW);
        }
#pragma unroll
        for (int u = 0; u < 4; ++u) {
            const RawT& x = A[u];
            float q[DH], k[DH], v[R];
            q[0] = bflo(x.q[0]); q[1] = bfhi(x.q[0]); if constexpr (DH == 4) { q[2] = bflo(x.q[1]); q[3] = bfhi(x.q[1]); }
            if constexpr (KIND != 2) { k[0] = bflo(x.k[0]); k[1] = bfhi(x.k[0]); if constexpr (DH == 4) { k[2] = bflo(x.k[1]); k[3] = bfhi(x.k[1]); } }
            if constexpr (R == 1) v[0] = bflo(x.v[0]);
            if constexpr (R >= 2) { v[0] = bflo(x.v[0]); v[1] = bfhi(x.v[0]); }
            if constexpr (R == 4) { v[2] = bflo(x.v[1]); v[3] = bfhi(x.v[1]); }
            float o[R];
            if constexpr (KIND == 3) {
                float ks_[R];
#pragma unroll
                for (int vv = 0; vv < R; ++vv) { float p = 0.f;
#pragma unroll
                    for (int dh = 0; dh < DH; ++dh) { S[dh][vv] *= x.de; p += k[dh] * S[dh][vv]; }
                    ks_[vv] = row16_sum(p); }
#pragma unroll
                for (int vv = 0; vv < R; ++vv) { const float uu = x.be * (v[vv] - ks_[vv]); float p = 0.f;
#pragma unroll
                    for (int dh = 0; dh < DH; ++dh) { S[dh][vv] += k[dh] * uu; p += q[dh] * S[dh][vv]; }
                    o[vv] = row16_sum(p); }
            } else {
#pragma unroll
                for (int dh = 0; dh < DH; ++dh) {
                    float dec, kk;
                    if constexpr (KIND == 0) { dec = rdec; kk = k[dh]; }
                    if constexpr (KIND == 1) { dec = x.f[dh]; kk = k[dh]; }
                    if constexpr (KIND == 2) { dec = x.f[dh]; kk = 1.0f - x.f[dh]; }
#pragma unroll
                    for (int vv = 0; vv < R; ++vv) S[dh][vv] = dec * S[dh][vv] + kk * v[vv];
                }
#pragma unroll
                for (int vv = 0; vv < R; ++vv) { float p = 0.f;
#pragma unroll
                    for (int dh = 0; dh < DH; ++dh) p += q[dh] * S[dh][vv];
                    o[vv] = row16_sum(p); }
            }
            if (dl == 0) {
                bf16* o_ = op + (size_t)(t0 + u) * D;
                if constexpr (R == 1) *o_ = (bf16)(pk2(o[0], 0.f) & 0xffffu);
                if constexpr (R == 2) *(unsigned*)o_ = pk2(o[0], o[1]);
                if constexpr (R == 4) *(v2u*)o_ = (v2u){pk2(o[0], o[1]), pk2(o[2], o[3])};
            }
        }
#pragma unroll
        for (int u = 0; u < 4; ++u) A[u] = B[u];
    }
#pragma unroll
    for (int dh = 0; dh < DH; ++dh)
#pragma unroll
        for (int vv = 0; vv < R; ++vv) sout[(size_t)(d0 + dh) * 64 + v0 + vv] = S[dh][vv];
    (void)DK;
}

template <int KIND, int DH, int R>
__device__ __forceinline__ void scan_long(const Ctx& C, LAS float* wl, int row0, int T, int h, int slice, float* sout) {
    constexpr int CT = 16, LR = 8, DK = LR * DH, NV = (64 / LR) * R, UNR = 8;
    constexpr bool HASK = true, GK = (KIND != 2), HASF = (KIND == 1 || KIND == 2), HASB = (KIND == 3);
    constexpr int OQ = 0, OK_ = OQ + CT * DK, OF = OK_ + (HASK ? CT * DK : 0), OV = OF + (HASF ? CT * DK : 0), OB = OV + CT * NV, BUF = OB + (HASB ? CT * 2 : 0);
    const bf16* PROJ = (const bf16*)(C.ws + WS_BIG); const bf16* SB = (const bf16*)(C.ws + WS_SB); const float* SF = (const float*)(C.ws + WS_SF);
    bf16* H = (bf16*)(C.ws + WS_H);
    const int lane = C.lane, dl = lane & (LR - 1), rw = lane / LR;
    const int d0 = dl * DH;
    const int stok = lane >> 2, spart = lane & 3;
    const GAS bf16 *qg, *kg, *vg; const GAS float *fg, *bg; int ks, vs;
    {
        const GAS bf16* sbr = (const GAS bf16*)(SB + (size_t)row0 * SBW); const GAS bf16* pr = (const GAS bf16*)(PROJ + (size_t)row0 * NINP); const GAS float* sfr = (const GAS float*)(SF + (size_t)row0 * SFW);
        const int vcol = slice * NV;
        if constexpr (KIND == 0) { qg = sbr + SB_RQ + h * 64; kg = sbr + SB_RK + h * 64; ks = SBW; vg = pr + C_RV + h * 64 + vcol; vs = NINP; fg = sfr; bg = sfr; }
        if constexpr (KIND == 1) { qg = sbr + SB_AQ + h * 32; kg = pr + C_AK + h * 32; ks = NINP; vg = pr + C_AV + h * 64 + vcol; vs = NINP; fg = sfr + SF_ADEC + h * 32; bg = sfr; }
        if constexpr (KIND == 2) { qg = sbr + SB_HQ + h * 64; kg = sbr; ks = SBW; vg = pr + C_HI + h * 64 + vcol; vs = NINP; fg = sfr + SF_HF + h * 64; bg = sfr; }
        if constexpr (KIND == 3) { qg = sbr + SB_DQ + h * 64; kg = sbr + SB_DK + h * 64; ks = SBW; vg = sbr + SB_DV + h * 64 + vcol; vs = SBW; fg = sfr; bg = sfr + SF_BETA + h; }
    }
    constexpr int QP = DK / 4;
    qg += (size_t)stok * SBW + spart * QP; kg += (size_t)stok * ks + spart * QP; fg += (size_t)stok * SFW + spart * QP;
    vg += (size_t)(lane & 15) * vs; bg += (size_t)(lane & 15) * SFW;
    GAS bf16* op = (GAS bf16*)(H + (size_t)row0 * D + KIND * 256 + h * 64 + slice * NV + rw * R);
    const float rdec = 1.0f - exp2f(-5.0f - (float)h);

    static_assert(R == 1, "scan_long: one column per lane row");
    f32x2 S2[DH / 2];
#pragma unroll
    for (int i = 0; i < DH / 2; ++i) S2[i] = (f32x2){0.f, 0.f};

    struct SR { v4u rq[QP / 8], rk[QP / 8]; f32x4 rf[QP / 4]; unsigned rv[NV / 2]; float rb0, rb1; };
    SR s0; s0.rb0 = s0.rb1 = 0.f;
    auto stage_load = [&](SR& sr, int c) {
        const size_t t = (size_t)c * CT;
#pragma unroll
        for (int i = 0; i < QP / 8; ++i) { sr.rq[i] = *(const GAS v4u*)(qg + t * SBW + i * 8); if constexpr (GK) sr.rk[i] = *(const GAS v4u*)(kg + t * ks + i * 8); }
        if constexpr (HASF) {
#pragma unroll
            for (int i = 0; i < QP / 4; ++i) sr.rf[i] = *(const GAS f32x4*)(fg + t * SFW + i * 4); }
        if (lane < 16) {
            if constexpr (NV == 4) { const v2u w = *(const GAS v2u*)(vg + t * vs); sr.rv[0] = w.x; sr.rv[1] = w.y; }
            if constexpr (NV == 8) { const v4u w = *(const GAS v4u*)(vg + t * vs); sr.rv[0] = w.x; sr.rv[1] = w.y; sr.rv[2] = w.z; sr.rv[3] = w.w; }
            if constexpr (NV == 16) { const v4u w = *(const GAS v4u*)(vg + t * vs), w2 = *(const GAS v4u*)(vg + t * vs + 8); sr.rv[0] = w.x; sr.rv[1] = w.y; sr.rv[2] = w.z; sr.rv[3] = w.w; sr.rv[4] = w2.x; sr.rv[5] = w2.y; sr.rv[6] = w2.z; sr.rv[7] = w2.w; }
            if constexpr (HASB) { sr.rb0 = bg[t * SFW]; sr.rb1 = bg[t * SFW + 4]; }
        }
    };
    auto stage_write = [&](SR& sr, int b) {
        LAS float* base = wl + b * BUF;
#pragma unroll
        for (int i = 0; i < QP / 8; ++i) {
            LAS float* qd = base + OQ + stok * DK + spart * QP + i * 8;
            *(LAS f32x4*)qd = (f32x4){bflo(sr.rq[i].x), bfhi(sr.rq[i].x), bflo(sr.rq[i].y), bfhi(sr.rq[i].y)}; *(LAS f32x4*)(qd + 4) = (f32x4){bflo(sr.rq[i].z), bfhi(sr.rq[i].z), bflo(sr.rq[i].w), bfhi(sr.rq[i].w)};
            if constexpr (GK) { LAS float* kd = base + OK_ + stok * DK + spart * QP + i * 8;
                *(LAS f32x4*)kd = (f32x4){bflo(sr.rk[i].x), bfhi(sr.rk[i].x), bflo(sr.rk[i].y), bfhi(sr.rk[i].y)}; *(LAS f32x4*)(kd + 4) = (f32x4){bflo(sr.rk[i].z), bfhi(sr.rk[i].z), bflo(sr.rk[i].w), bfhi(sr.rk[i].w)}; }
        }
        if constexpr (HASF) {
#pragma unroll
            for (int i = 0; i < QP / 4; ++i) { *(LAS f32x4*)(base + OF + stok * DK + spart * QP + i * 4) = sr.rf[i];
                if constexpr (KIND == 2) *(LAS f32x4*)(base + OK_ + stok * DK + spart * QP + i * 4) = 1.0f - sr.rf[i]; } }
        if (lane < 16) {
#pragma unroll
            for (int i = 0; i < NV / 2; ++i) { base[OV + lane * NV + 2 * i] = bflo(sr.rv[i]); base[OV + lane * NV + 2 * i + 1] = bfhi(sr.rv[i]); }
            if constexpr (HASB) { base[OB + lane * 2] = sr.rb0; base[OB + lane * 2 + 1] = sr.rb1; }
        }
    };
    static_assert(2 * BUF * 4 <= 32768, "per-wave LDS");
    const int nch = T / CT;
    struct Opnd { f32x2 q2[DH / 2], k2[DH / 2], f2[DH / 2]; float v; f32x2 bd; };
    auto ldop = [&](Opnd& x, const LAS float* base, int u) {
#pragma unroll
        for (int i = 0; i < DH / 4; ++i) { const f32x4 w = *(const LAS f32x4*)(base + OQ + u * DK + d0 + 4 * i); x.q2[2 * i] = (f32x2){w.x, w.y}; x.q2[2 * i + 1] = (f32x2){w.z, w.w}; }
#pragma unroll
        for (int i = 0; i < DH / 4; ++i) { const f32x4 w = *(const LAS f32x4*)(base + OK_ + u * DK + d0 + 4 * i); x.k2[2 * i] = (f32x2){w.x, w.y}; x.k2[2 * i + 1] = (f32x2){w.z, w.w}; }
        if constexpr (HASF) {
#pragma unroll
            for (int i = 0; i < DH / 4; ++i) { const f32x4 w = *(const LAS f32x4*)(base + OF + u * DK + d0 + 4 * i); x.f2[2 * i] = (f32x2){w.x, w.y}; x.f2[2 * i + 1] = (f32x2){w.z, w.w}; } }
        x.v = base[OV + u * NV + rw];
        if constexpr (HASB) x.bd = *(const LAS f32x2*)(base + OB + u * 2);
    };
    auto compute = [&](int c, const LAS float* base) {
#pragma unroll 1
        for (int ub = 0; ub < CT; ub += UNR) {
        float okeep[R];
#pragma unroll
        for (int vv = 0; vv < R; ++vv) okeep[vv] = 0.f;
        Opnd X; X.bd = (f32x2){0.f, 0.f};
#pragma unroll
        for (int i = 0; i < DH / 2; ++i) X.f2[i] = (f32x2){0.f, 0.f};
        ldop(X, base, ub);
#pragma unroll
        for (int uu_ = 0; uu_ < UNR; ++uu_) { const int u = ub + uu_;
            Opnd Y = X;
            if (uu_ + 1 < UNR) ldop(Y, base, u + 1);
            f32x2 (&q2)[DH / 2] = X.q2; f32x2 (&k2)[DH / 2] = X.k2; f32x2 (&f2)[DH / 2] = X.f2; const float vv_ = X.v; const f32x2 bd = X.bd;
            float o[1];
            if constexpr (KIND == 3) {
                f32x2 a = k2[0] * S2[0];
#pragma unroll
                for (int i = 1; i < DH / 2; ++i) a = __builtin_elementwise_fma(k2[i], S2[i], a);
                const float ks_ = row8_sum(a.x + a.y) * bd.y;
                const float uu = bd.x * (vv_ - ks_);
                const f32x2 de2 = (f32x2){bd.y, bd.y}, uu2 = (f32x2){uu, uu};
#pragma unroll
                for (int i = 0; i < DH / 2; ++i) S2[i] = __builtin_elementwise_fma(S2[i], de2, k2[i] * uu2);
            } else {
                const f32x2 v2 = (f32x2){vv_, vv_};
#pragma unroll
                for (int i = 0; i < DH / 2; ++i) {
                    f32x2 dec2;
                    if constexpr (KIND == 0) dec2 = (f32x2){rdec, rdec}; else dec2 = f2[i];
                    S2[i] = __builtin_elementwise_fma(S2[i], dec2, k2[i] * v2);
                }
            }
            { f32x2 a = q2[0] * S2[0];
#pragma unroll
              for (int i = 1; i < DH / 2; ++i) a = __builtin_elementwise_fma(q2[i], S2[i], a);
              o[0] = row8_sum(a.x + a.y); }
#pragma unroll
            for (int vv = 0; vv < R; ++vv) okeep[vv] = (dl == uu_) ? o[vv] : okeep[vv];
            X = Y;
        }
        {
            GAS bf16* o_ = op + (size_t)(c * CT + ub + dl) * D;
            if constexpr (R == 1) *o_ = (bf16)(pk2(okeep[0], 0.f) & 0xffffu);
            if constexpr (R == 2) *(GAS unsigned*)o_ = pk2(okeep[0], okeep[1]);
            if constexpr (R == 4) *(GAS v2u*)o_ = (v2u){pk2(okeep[0], okeep[1]), pk2(okeep[2], okeep[3])};
        }
        }
    };
    stage_load(s0, 0); stage_write(s0, 0);
#pragma unroll 1
    for (int c = 0; c < nch; c += 2) {
        stage_load(s0, min(c + 1, nch - 1));
        compute(c, wl);
        stage_write(s0, 1);
        stage_load(s0, min(c + 2, nch - 1));
        compute(c + 1, wl + BUF);
        stage_write(s0, 0);
    }
    const int v0 = slice * NV + rw * R;
#pragma unroll
    for (int i = 0; i < DH / 2; ++i) { sout[(size_t)(d0 + 2 * i) * 64 + v0] = S2[i].x; sout[(size_t)(d0 + 2 * i + 1) * 64 + v0] = S2[i].y; }
}

__device__ __forceinline__ void scan_phase(const Args& args, LAS unsigned char* lds_, int l, int mode = 0) {
    const Ctx C = make_ctx(args, lds_);
    constexpr int NLONG = 1024, NSHORT = BS * 144;
    const int slot = C.wave * 256 + (int)blockIdx.x;
    const int nidle = C.NGW - NLONG;
    for (int it = 0;; ++it) {
        int kind, b, h, slice, row0, T; bool isp;
        if (slot < NLONG) { if (it > 0 || mode == 2) break; isp = true; T = TP;
            const int kk_ = slot >> 8, i = slot & 255; kind = kk_ == 0 ? 3 : (kk_ == 1 ? 0 : (kk_ == 2 ? 2 : 1));
            { const int stream = (i & 7) | ((i >> 6) << 3); slice = (i >> 3) & 7; b = stream >> 2; h = stream & 3; }
            row0 = b * TP;
        } else { const int st = (slot - NLONG) + it * nidle; if (st >= NSHORT || mode == 1) break; isp = false; T = TS;
            b = st / 144; int i = st - b * 144;
            if (i < 64) { kind = 3; h = i >> 4; slice = i & 15; }
            else if (i < 96) { i -= 64; kind = 0; h = i >> 3; slice = i & 7; }
            else if (i < 128) { i -= 96; kind = 2; h = i >> 3; slice = i & 7; }
            else { i -= 128; kind = 1; h = i >> 2; slice = i & 3; }
            row0 = MP + b * TS;
        }
        const int nbat = isp ? BP : BS;
        const size_t sidx = (size_t)((l * nbat + b) * 4 + h);
        if (isp) {
            LAS float* wl = (LAS float*)(C.lds + C.wave * 32768);
            if (kind == 0) scan_long<0, 8, 1>(C, wl, row0, T, h, slice, C.out + O_PRET + sidx * 4096);
            else if (kind == 1) scan_long<1, 4, 1>(C, wl, row0, T, h, slice, C.out + O_PGLA + sidx * 2048);
            else if (kind == 2) scan_long<2, 8, 1>(C, wl, row0, T, h, slice, C.out + O_PHG + sidx * 4096);
            else scan_long<3, 8, 1>(C, wl, row0, T, h, slice, C.out + O_PGDN + sidx * 4096);
        } else {
            if (kind == 0) { scan_task<0, 4, 2>(C, row0, T, h, slice, args.in[2] + sidx * 4096, C.out + O_SRET + sidx * 4096); }
            else if (kind == 1) { scan_task<1, 2, 4>(C, row0, T, h, slice, args.in[3] + sidx * 2048, C.out + O_SGLA + sidx * 2048); }
            else if (kind == 2) { scan_task<2, 4, 2>(C, row0, T, h, slice, args.in[4] + sidx * 4096, C.out + O_SHG + sidx * 4096); }
            else { scan_task<3, 4, 1>(C, row0, T, h, slice, args.in[5] + sidx * 4096, C.out + O_SGDN + sidx * 4096); }
        }
    }
}

__device__ __forceinline__ void post_phase(const Args& args, LAS unsigned char* lds_, int l) {
    const Ctx C = make_ctx(args, lds_);
    const bf16* PROJ = (const bf16*)(C.ws + WS_BIG); bf16* H = (bf16*)(C.ws + WS_H);
    const int lane = C.lane, mixer = lane >> 4, cc = (lane & 15) * 16;
    const int gbase = mixer == 0 ? C_RG : mixer == 1 ? C_AG : mixer == 2 ? C_HG : C_DG;
    const float* nw = mixer == 1 ? args.in[24] + l * 64 : mixer == 2 ? args.in[25] + l * 64 : args.in[26] + l * 64;
    float w[16];
#pragma unroll
    for (int i = 0; i < 16; ++i) w[i] = mixer == 0 ? 1.0f : nw[(cc + i) & 63];
    for (int r = C.gw; r < M; r += C.NGW) {
        bf16* hp = H + (size_t)r * D + lane * 16; const bf16* gp = PROJ + (size_t)r * NINP + gbase + cc;
        const v4u a0 = *(const v4u*)hp, a1 = *(const v4u*)(hp + 8);
        const v4u g0 = *(const v4u*)gp, g1 = *(const v4u*)(gp + 8);
        float y[16], g[16];
        const unsigned aw[8] = {a0.x, a0.y, a0.z, a0.w, a1.x, a1.y, a1.z, a1.w}, gw_[8] = {g0.x, g0.y, g0.z, g0.w, g1.x, g1.y, g1.z, g1.w};
        float ss = 0.f;
#pragma unroll
        for (int i = 0; i < 8; ++i) { y[2 * i] = bflo(aw[i]); y[2 * i + 1] = bfhi(aw[i]); g[2 * i] = bflo(gw_[i]); g[2 * i + 1] = bfhi(gw_[i]); ss += y[2 * i] * y[2 * i] + y[2 * i + 1] * y[2 * i + 1]; }
        ss = quad_sum(ss);
        const float rs = rsqrtf(ss * (1.0f / 64.0f) + RMS_EPS);
        unsigned ow[8];
#pragma unroll
        for (int i = 0; i < 8; ++i) ow[i] = pk2(y[2 * i] * rs * w[2 * i] * siluf_(g[2 * i]), y[2 * i + 1] * rs * w[2 * i + 1] * siluf_(g[2 * i + 1]));
        *(v4u*)hp = (v4u){ow[0], ow[1], ow[2], ow[3]}; *(v4u*)(hp + 8) = (v4u){ow[4], ow[5], ow[6], ow[7]};
    }
}

__global__ void __launch_bounds__(NWAVES * 64, 2) mega_fwd(Args args) {
    extern __shared__ __attribute__((aligned(16))) unsigned char lds[];
    cg::grid_group grid = cg::this_grid();
    LAS unsigned char* const LDSP = (LAS unsigned char*)lds;
    const int G = (int)gridDim.x, bx = (int)blockIdx.x;
    if (threadIdx.x < 64) ((LAS unsigned*)(LDSP + MISC_OFF))[threadIdx.x] = 0u;
    __syncthreads();
    (void)xcd_barrier_post((unsigned*)args.ws, (volatile LAS unsigned*)(LDSP + MISC_OFF));
#define FRESH() float* out_ = fresh_ptr(args.out); unsigned char* ws = fresh_ptr(args.ws); \
    float* MOD = (float*)(ws + WS_MOD); bf16* H = (bf16*)(ws + WS_H); bf16* BIG = (bf16*)(ws + WS_BIG); (void)MOD; (void)H; (void)BIG; (void)out_;

    p0_prologue(args, LDSP);
    grid.sync();
    {
        FRESH();
        pg8::Gemm g{(const bf16*)(ws + WS_AC), BIG, 256, 2 * NMODC, D}; pg8::StaticOrder S; S.init(256, 2 * NMODC, G, bx, D);
        pg8::EpiMod E{MOD, args.in[10]};
        pg8::gemm_phase<pg8::EpiMod, pg8::StaticOrder, PG8_ALIGN, PG8_SP2>(LDSP, g, S, E);
    }
    grid_bar(args, LDSP);
    p2_modulate0(args, LDSP);
    grid_bar(args, LDSP);
#pragma unroll 1
    for (int l = 0; l < 2; ++l) {
#pragma unroll 1
        for (int f = 0; f < 2; ++f) {
            if (f == 1) {
                {
                    FRESH();
                    pg8::Gemm g{H, (const bf16*)(ws + WS_W + (size_t)l * W_LAYER + W_WIN), M, NINP, D}; pg8::StaticOrder S; S.init(M, NINP, G, bx, D);
                    pg8::EpiPlain E{BIG, NINP};
                    pg8::gemm_phase<pg8::EpiPlain, pg8::StaticOrder, PG8_ALIGN, PG8_SP2>(LDSP, g, S, E);
                }
                grid_bar(args, LDSP);
                prep_phase(args, LDSP, l);
                grid_bar(args, LDSP);
                scan_phase(args, LDSP, l);
#ifdef PROBE_SCANMODE
                grid_bar(args, LDSP); scan_phase(args, LDSP, l, PROBE_SCANMODE);
#endif
                grid_bar(args, LDSP);
                post_phase(args, LDSP, l);
                grid_bar(args, LDSP);
                {
                    FRESH();
                    pg8::Gemm g{H, (const bf16*)(ws + WS_W + (size_t)l * W_LAYER + W_WOUT), M, D, D}; pg8::SplitOrder S; S.init(D, G, bx);
                    pg8::EpiRes E{out_, (float*)(ws + WS_SB), MOD + (size_t)l * NB * NMODC + 5 * 1024, 1.0f, D / 64};
                    pg8::gemm_phase<pg8::EpiRes, pg8::SplitOrder, PG8_ALIGN, PG8_SP2>(LDSP, g, S, E);
                }
                grid_bar(args, LDSP);
                ln_phase(args, LDSP, l, 1, true, l, 6, 4, ALPHA);
                grid_bar(args, LDSP);
            }
            {
                FRESH();
                pg8::Gemm g{H, (const bf16*)(ws + WS_W + (size_t)l * W_LAYER + (f ? W_WI2 : W_WI1)), M, NWI, D}; pg8::StaticOrder S; S.init(M, NWI, G, bx, D);
                pg8::EpiSwiglu E{BIG, DFF};
                pg8::gemm_phase<pg8::EpiSwiglu, pg8::StaticOrder, PG8_ALIGN, PG8_SP2>(LDSP, g, S, E);
            }
            grid_bar(args, LDSP);
            {
                FRESH();
                pg8::Gemm g{BIG, (const bf16*)(ws + WS_W + (size_t)l * W_LAYER + (f ? W_WO2 : W_WO1)), M, D, DFF}; pg8::SplitOrder S; S.init(DFF, G, bx);
                pg8::EpiRes E{out_, (float*)(ws + WS_SB), MOD + (size_t)l * NB * NMODC + (f ? 8 : 2) * 1024, 0.5f, DFF / 64};
                pg8::gemm_phase<pg8::EpiRes, pg8::SplitOrder, PG8_ALIGN, PG8_SP2>(LDSP, g, S, E);
            }
            grid_bar(args, LDSP);
            if (f == 0) ln_phase(args, LDSP, l, 0, true, l, 3, 11, ALPHA);
            else ln_phase(args, LDSP, l, 2, l == 0, 1, 0, 11, l == 0 ? ALPHA : 1.0f);
            if (!(l == 1 && f == 1)) grid_bar(args, LDSP);
        }
    }
}

extern "C" void kernel_launch(void* const* d_in, const int* in_sizes, int n_in, void* d_out, int out_size, void* d_ws, size_t ws_size, hipStream_t stream) {
    static int grid = 0;
    if (grid == 0) {
        if (n_in != 28 || (size_t)out_size != O_END || ws_size < WS_END) { fprintf(stderr, "kernel_launch: unexpected sizes n_in %d out %d ws %zu (need %zu)\n", n_in, out_size, ws_size, (size_t)WS_END); grid = -1; return; }
        int dev = 0, cus = 0, per_cu = 0;
        hipGetDevice(&dev); hipDeviceGetAttribute(&cus, hipDeviceAttributeMultiprocessorCount, dev);
        hipFuncSetAttribute((const void*)mega_fwd, hipFuncAttributeMaxDynamicSharedMemorySize, LDS_BYTES);
        hipOccupancyMaxActiveBlocksPerMultiprocessor(&per_cu, (const void*)mega_fwd, NWAVES * 64, LDS_BYTES);
        (void)hipGetLastError();
        if (per_cu < 1 || cus < 256) { fprintf(stderr, "kernel_launch: occupancy %d cus %d\n", per_cu, cus); grid = -1; return; }
        grid = 256;
    }
    if (grid < 0) return;
    if (hipMemsetAsync(d_ws, 0, 65536, stream) != hipSuccess) { fprintf(stderr, "memset failed\n"); return; }
    Args a{};
    for (int i = 0; i < 28; ++i) a.in[i] = (const float*)d_in[i];
    a.out = (float*)d_out; a.ws = (unsigned char*)d_ws;
    void* kargs[] = {&a};
    hipError_t e = hipLaunchCooperativeKernel((const void*)mega_fwd, dim3(grid), dim3(NWAVES * 64), kargs, LDS_BYTES, stream);
    if (e != hipSuccess) fprintf(stderr, "cooperative launch failed: %s\n", hipGetErrorString(e));
}
```

```cpp
#include <hip/hip_runtime.h>
#include <hip/hip_cooperative_groups.h>
#include <cstdio>
#include <cstdint>
namespace cg = cooperative_groups;
namespace pg8 {
#define PG8_LAS __attribute__((address_space(3)))
typedef unsigned short bf16_t;
typedef short bf16x8 __attribute__((ext_vector_type(8)));
typedef float f32x4 __attribute__((ext_vector_type(4)));
typedef unsigned u32x4 __attribute__((ext_vector_type(4)));
constexpr int BM = 256, BK = 64, HALF = 128, HTB = HALF * BK * 2  , STAGE_BYTES = 8 * HTB, NXCD = 8, WGM = 8;

__host__ __device__ __forceinline__ int lds_byte(int r, int c) { const int st = (r >> 4) * 2 + (c >> 5), rr = r & 15, cc = c & 31, ob = rr * 64 + cc * 2; return st * 1024 + (ob ^ (((ob >> 9) & 1) << 5)); }
__host__ __device__ __forceinline__ void stage_rc(int b, int& R, int& C) { const int st = b / 1024, sb = b % 1024, swz = sb ^ (((sb >> 9) & 1) << 5); R = (st >> 1) * 16 + swz / 64; C = (st & 1) * 32 + (swz % 64) / 2; }
__host__ __device__ __forceinline__ int perm32(int rho) { const int n = rho >> 4, i = rho & 15; return 8 * (i >> 2) + 4 * n + (i & 3); }

struct Unit { int pm, pn, k0, nt; };
struct Gemm { const bf16_t* A; const bf16_t* Bt; int M, N, K; };

struct StaticOrder {
    int nM, nN, nwg, G, c, ntf;
    __host__ __device__ void init(int M, int N, int G_, int c_, int K_ = 1024) { nM = M / BM; nN = N / BM; nwg = nM * nN; G = G_; c = c_; ntf = K_ / BK; }
    __host__ __device__ bool next(int i, Unit& u) const {
        const long L = (long)i * G + c; if (L >= nwg) return false;
        int wgid = (int)L; { const int q = nwg / NXCD, r = nwg % NXCD, xcd = wgid % NXCD, off = wgid / NXCD; wgid = (xcd < r ? xcd * (q + 1) : r * (q + 1) + (xcd - r) * q) + off; }
        const int nig = WGM * nN, gid = wgid / nig, fm = gid * WGM, gsz = (nM - fm) < WGM ? (nM - fm) : WGM;
        u.pm = fm + ((wgid % nig) % gsz); u.pn = (wgid % nig) / gsz; u.k0 = 0; u.nt = ntf; return true;
    }
    __device__ __forceinline__ void a_ready(const Unit&) const {}
    __device__ __forceinline__ void done(const Unit&) const {}
};

struct SplitOrder {
    StaticOrder base; int ppu, c;
    static constexpr int PK = 4;
    __host__ __device__ void init(int K_, int G_, int c_) { base.init(16384, 1024, G_, c_, K_); ppu = (K_ / BK) / PK; c = c_; }
    __host__ __device__ bool next(int i, Unit& u) const {
        if (i == 0) return base.next(0, u);
        if (i == 1 && c < 8 * ppu) { const int j = c / ppu, p = c - j * ppu; u.pm = 64 + (j >> 2); u.pn = j & 3; u.k0 = p * PK; u.nt = PK; return true; }
        return false;
    }
    __device__ __forceinline__ void a_ready(const Unit&) const {}
    __device__ __forceinline__ void done(const Unit&) const {}
};

__device__ __forceinline__ unsigned cvt_pk_bf16(float lo, float hi) { unsigned r; asm volatile("v_cvt_pk_bf16_f32 %0, %1, %2" : "=v"(r) : "v"(lo), "v"(hi)); return r; }
typedef float f32x2 __attribute__((ext_vector_type(2)));
__device__ __forceinline__ f32x2 gelu_pk(f32x2 v) {
    const f32x2 av = __builtin_elementwise_abs(v), d = av * 0.2316418882f + 1.0f;
    f32x2 t; t.x = __builtin_amdgcn_rcpf(d.x); t.y = __builtin_amdgcn_rcpf(d.y);
    f32x2 q = t * 0.5307027145f + (-0.7265760135f); q = q * t + 0.7107068705f; q = q * t + (-0.142248368f); q = q * t + 0.127414796f; q = q * t;
    const f32x2 s = (v * v) * (-0.72134752044f);
    f32x2 e; e.x = __builtin_amdgcn_exp2f(s.x); e.y = __builtin_amdgcn_exp2f(s.y);
    const f32x2 m = v * (q * e), r = v - m;
    f32x2 o; o.x = v.x < 0.f ? m.x : r.x; o.y = v.y < 0.f ? m.y : r.y; return o;
}

template <int ACT  > struct EpiBf16 {
    static constexpr bool PERM = true, AFTER_DRAIN = false; static_assert(ACT == 0 || ACT == 1, "EpiBf16: ACT is 0 (none) or 1 (gelu_pk)");
    bf16_t* O; int ldc; const float* bias; int split_cols; size_t split_stride; float scale0;
    __device__ __forceinline__ void operator()(const f32x4 (&acc)[2][2][4][2], const Unit& u, int wr, int wc, int fr, int fq) const {
        const int row0 = u.pm * BM + wr * 64 + fr; int colt = u.pn * BM; bf16_t* base = O;
        float sc = 1.f; if (split_cols) { const int t = colt / split_cols; base += (size_t)t * split_stride; colt -= t * split_cols; if (t == 0) sc = scale0; }
        const int col0 = colt + wc * 32 + 8 * fq, bcol0 = u.pn * BM + wc * 32 + 8 * fq;
        f32x4 bv[2][2];
#pragma unroll
        for (int bj = 0; bj < 2; ++bj)
#pragma unroll
            for (int n = 0; n < 2; ++n) bv[bj][n] = bias ? *(const f32x4*)(bias + bcol0 + bj * HALF + 4 * n) : (f32x4){0.f, 0.f, 0.f, 0.f};
#pragma unroll
        for (int ai = 0; ai < 2; ++ai)
#pragma unroll
            for (int m = 0; m < 4; ++m) { bf16_t* rowp = base + (size_t)(row0 + ai * HALF + m * 16) * ldc + col0;
#pragma unroll
                for (int bj = 0; bj < 2; ++bj) { f32x4 v0 = acc[ai][bj][m][0] + bv[bj][0], v1 = acc[ai][bj][m][1] + bv[bj][1];
                    if (ACT == 1) { f32x2 a = gelu_pk((f32x2){v0[0], v0[1]}), b = gelu_pk((f32x2){v0[2], v0[3]}), c = gelu_pk((f32x2){v1[0], v1[1]}), d = gelu_pk((f32x2){v1[2], v1[3]});
                        v0 = (f32x4){a.x, a.y, b.x, b.y}; v1 = (f32x4){c.x, c.y, d.x, d.y}; }
                    v0 = v0 * sc; v1 = v1 * sc; u32x4 w; w.x = cvt_pk_bf16(v0[0], v0[1]); w.y = cvt_pk_bf16(v0[2], v0[3]); w.z = cvt_pk_bf16(v1[0], v1[1]); w.w = cvt_pk_bf16(v1[2], v1[3]);
                    *(u32x4*)(rowp + bj * HALF) = w; } }
    }
};
template <class Epi, class Sched, bool ALIGN_EPI = false, bool SP2 = false>
__device__ __forceinline__ void gemm_phase(PG8_LAS unsigned char* lds, const Gemm g, const Sched& S, const Epi& E) {
    int tid_ = threadIdx.x; asm volatile("" : "+v"(tid_));
    const int tid = tid_, wid = __builtin_amdgcn_readfirstlane(tid >> 6), lane = tid & 63, wr = wid >> 2, wc = wid & 3, fr = lane & 15, fq = lane >> 4;
    const int K = g.K;
    unsigned voffA[2], voffB[2];
#pragma unroll
    for (int i = 0; i < 2; ++i) { int R, C; stage_rc(tid * 16 + i * 8192, R, C); const int Rb = Epi::PERM ? ((R & ~31) + perm32(R & 31)) : R;
        voffA[i] = (unsigned)(R * K + C) * 2u; voffB[i] = (unsigned)(Rb * K + C) * 2u; }
    const size_t kstep = (size_t)(BK * 2);
    const size_t hstep = (size_t)HALF * K * 2;
    const size_t tstep = 2 * hstep;
    const unsigned ldsw = (unsigned)wid * 1024u;
    const int aoff = lds_byte(wr * 64 + fr, fq * 8), boff = lds_byte(wc * 32 + fr, fq * 8);
#define PG8_SA(b, h) (((b) * 2 + (h)) * HTB)
#define PG8_SB(b, h) ((4 + (b) * 2 + (h)) * HTB)
#define PG8_STAGE(bufoff, gbase, voff) do { _Pragma("unroll") for (int _i = 0; _i < 2; ++_i) \
        __builtin_amdgcn_global_load_lds((const unsigned*)((const char*)(gbase) + (voff)[_i]), (PG8_LAS unsigned*)(lds + (bufoff) + ldsw + _i * 8192), 16, 0, 0); } while (0)
#define PG8_LDA(dst, b, h) do { _Pragma("unroll") for (int m = 0; m < 4; ++m) _Pragma("unroll") for (int k = 0; k < 2; ++k) dst[m][k] = *(const PG8_LAS bf16x8*)(lds + PG8_SA(b, h) + aoff + m * 2048 + k * 1024); } while (0)
#define PG8_LDB(dst, b, h) do { _Pragma("unroll") for (int n = 0; n < 2; ++n) _Pragma("unroll") for (int k = 0; k < 2; ++k) dst[n][k] = *(const PG8_LAS bf16x8*)(lds + PG8_SB(b, h) + boff + n * 2048 + k * 1024); } while (0)
#define PG8_MMA(ai, bj, At, Bt) do { __builtin_amdgcn_s_setprio(1); _Pragma("unroll") for (int m = 0; m < 4; ++m) _Pragma("unroll") for (int n = 0; n < 2; ++n) _Pragma("unroll") for (int k = 0; k < 2; ++k) \
        acc[ai][bj][m][n] = __builtin_amdgcn_mfma_f32_16x16x32_bf16(Bt[n][k], At[m][k], acc[ai][bj][m][n], 0, 0, 0); __builtin_amdgcn_s_setprio(0); } while (0)
#define PG8_WAIT_V(n) asm volatile("s_waitcnt vmcnt(" #n ")" ::: "memory")
#define PG8_WAIT_L(n) asm volatile("s_waitcnt lgkmcnt(" #n ")" ::: "memory")
#define PG8_BAR __builtin_amdgcn_s_barrier()
#define PG8_SCHED __builtin_amdgcn_sched_barrier(0)
    Unit cur, nxt; int ui = 0;
    if (!S.next(0, cur)) return;
    f32x4 acc[2][2][4][2];
#pragma unroll
    for (int a = 0; a < 2; ++a)
#pragma unroll
        for (int b = 0; b < 2; ++b)
#pragma unroll
            for (int m = 0; m < 4; ++m)
#pragma unroll
                for (int n = 0; n < 2; ++n) acc[a][b][m][n] = (f32x4){0.f, 0.f, 0.f, 0.f};
    bf16x8 At[4][2], B0[2][2], B1[2][2];
    const char* cA = (const char*)g.A + (size_t)cur.pm * tstep + (size_t)cur.k0 * kstep; const char* cB = (const char*)g.Bt + (size_t)cur.pn * tstep + (size_t)cur.k0 * kstep;
    S.a_ready(cur);
    if constexpr (SP2) {
        PG8_STAGE(PG8_SB(0, 0), cB, voffB); PG8_STAGE(PG8_SB(0, 1), cB + hstep, voffB); PG8_STAGE(PG8_SA(0, 0), cA, voffA); PG8_STAGE(PG8_SA(0, 1), cA + hstep, voffA);
        if (wr == 1) PG8_BAR;
        PG8_WAIT_V(2); PG8_BAR;
        PG8_STAGE(PG8_SB(1, 0), cB + kstep, voffB); PG8_STAGE(PG8_SA(1, 0), cA + kstep, voffA); PG8_STAGE(PG8_SB(1, 1), cB + hstep + kstep, voffB);
        PG8_WAIT_V(6); PG8_BAR;
    } else {
        PG8_STAGE(PG8_SB(0, 0), cB, voffB); PG8_STAGE(PG8_SA(0, 0), cA, voffA); PG8_STAGE(PG8_SB(0, 1), cB + hstep, voffB); PG8_STAGE(PG8_SA(0, 1), cA + hstep, voffA);
        if (wr == 1) PG8_BAR;
        PG8_WAIT_V(4); PG8_BAR;
        PG8_STAGE(PG8_SB(1, 0), cB + kstep, voffB); PG8_STAGE(PG8_SA(1, 0), cA + kstep, voffA); PG8_STAGE(PG8_SB(1, 1), cB + hstep + kstep, voffB);
        PG8_WAIT_V(6); PG8_BAR;
    }
    for (;;) {
        const bool has_next = S.next(ui + 1, nxt);
        const char* nA = has_next ? (const char*)g.A + (size_t)nxt.pm * tstep + (size_t)nxt.k0 * kstep : cA; const char* nB = has_next ? (const char*)g.Bt + (size_t)nxt.pn * tstep + (size_t)nxt.k0 * kstep : cB;
        const int nt = cur.nt;
        for (int t = 0; t < nt; t += 2) {
            const bool last = (t == nt - 2);
            const char* a1 = cA + (size_t)(t + 1) * kstep;
            const char* a2 = last ? nA : cA + (size_t)(t + 2) * kstep; const char* b2 = last ? nB : cB + (size_t)(t + 2) * kstep;
            const char* a3 = a2 + kstep; const char* b3 = b2 + kstep;
            if (last && has_next) S.a_ready(nxt);
            if constexpr (SP2) {
            PG8_LDB(B0, 0, 0); PG8_LDB(B1, 0, 1); PG8_SCHED; PG8_LDA(At, 0, 0); PG8_STAGE(PG8_SA(1, 1), a1 + hstep, voffA);
            PG8_WAIT_V(8); PG8_WAIT_L(0); PG8_BAR; PG8_MMA(0, 0, At, B0); PG8_MMA(0, 1, At, B1); PG8_BAR; PG8_SCHED;
            PG8_LDA(At, 0, 1); PG8_STAGE(PG8_SB(0, 0), b2, voffB); PG8_STAGE(PG8_SB(0, 1), b2 + hstep, voffB); PG8_STAGE(PG8_SA(0, 0), a2, voffA);
            PG8_WAIT_V(8); PG8_WAIT_L(0); PG8_BAR; PG8_MMA(1, 0, At, B0); PG8_MMA(1, 1, At, B1); PG8_BAR; PG8_SCHED;
            PG8_LDB(B0, 1, 0); PG8_LDB(B1, 1, 1); PG8_SCHED; PG8_LDA(At, 1, 0); PG8_STAGE(PG8_SA(0, 1), a2 + hstep, voffA);
            PG8_WAIT_V(8); PG8_WAIT_L(0); PG8_BAR; PG8_MMA(0, 0, At, B0); PG8_MMA(0, 1, At, B1); PG8_BAR; PG8_SCHED;
            PG8_LDA(At, 1, 1); PG8_STAGE(PG8_SB(1, 0), b3, voffB); PG8_STAGE(PG8_SB(1, 1), b3 + hstep, voffB); PG8_STAGE(PG8_SA(1, 0), a3, voffA);
            PG8_WAIT_V(8); PG8_WAIT_L(0); PG8_BAR; PG8_MMA(1, 0, At, B0); PG8_MMA(1, 1, At, B1); PG8_BAR; PG8_SCHED;
            } else {
            PG8_LDB(B0, 0, 0); PG8_SCHED; PG8_LDA(At, 0, 0); PG8_STAGE(PG8_SA(1, 1), a1 + hstep, voffA);
            PG8_WAIT_L(8); PG8_BAR; PG8_WAIT_L(0); PG8_MMA(0, 0, At, B0); PG8_BAR; PG8_SCHED;
            PG8_LDB(B1, 0, 1); PG8_STAGE(PG8_SB(0, 0), b2, voffB);
            PG8_BAR; PG8_WAIT_L(0); PG8_MMA(0, 1, At, B1); PG8_BAR;
            PG8_LDA(At, 0, 1); PG8_STAGE(PG8_SA(0, 0), a2, voffA);
            PG8_BAR; PG8_WAIT_L(0); PG8_MMA(1, 0, At, B0); PG8_BAR; PG8_SCHED;
            PG8_STAGE(PG8_SB(0, 1), b2 + hstep, voffB);
            PG8_WAIT_V(6); PG8_BAR; PG8_MMA(1, 1, At, B1); PG8_BAR;
            PG8_LDB(B0, 1, 0); PG8_SCHED; PG8_LDA(At, 1, 0); PG8_STAGE(PG8_SA(0, 1), a2 + hstep, voffA);
            PG8_WAIT_L(8); PG8_BAR; PG8_WAIT_L(0); PG8_MMA(0, 0, At, B0); PG8_BAR; PG8_SCHED;
            PG8_LDB(B1, 1, 1); PG8_STAGE(PG8_SB(1, 0), b3, voffB);
            PG8_BAR; PG8_WAIT_L(0); PG8_MMA(0, 1, At, B1); PG8_BAR;
            PG8_LDA(At, 1, 1); PG8_STAGE(PG8_SA(1, 0), a3, voffA);
            PG8_BAR; PG8_WAIT_L(0); PG8_MMA(1, 0, At, B0); PG8_BAR; PG8_SCHED;
            PG8_STAGE(PG8_SB(1, 1), b3 + hstep, voffB);
            PG8_WAIT_V(6); PG8_BAR; PG8_MMA(1, 1, At, B1); PG8_BAR;
            }
        }
        if constexpr (ALIGN_EPI) { if (wr == 0) PG8_BAR; }
        if constexpr (!Epi::AFTER_DRAIN) { E(acc, cur, wr, wc, fr, fq); S.done(cur); }
        if (!has_next) break;
#pragma unroll
        for (int a = 0; a < 2; ++a)
#pragma unroll
            for (int b = 0; b < 2; ++b)
#pragma unroll
                for (int m = 0; m < 4; ++m)
#pragma unroll
                    for (int n = 0; n < 2; ++n) acc[a][b][m][n] = (f32x4){0.f, 0.f, 0.f, 0.f};
        cur = nxt; cA = nA; cB = nB; ++ui;
        if constexpr (ALIGN_EPI) { if (wr == 1) PG8_BAR; }
    }
    PG8_WAIT_V(0);
    if constexpr (!ALIGN_EPI) { if (wr == 0) PG8_BAR; }
    PG8_BAR;
    if constexpr (Epi::AFTER_DRAIN) { E.fused(acc, cur, wr, wc, fr, fq, lds, wid, lane); S.done(cur); }
#undef PG8_SA
#undef PG8_SB
#undef PG8_STAGE
#undef PG8_LDA
#undef PG8_LDB
#undef PG8_MMA
#undef PG8_WAIT_V
#undef PG8_WAIT_L
#undef PG8_BAR
#undef PG8_SCHED
}
}
#define PG8_SP2 true
#define PG8_ALIGN true

constexpr int D = 1024, TP = 2048, BP = 8, BS = 128, TS = 4;
constexpr int MP = BP * TP, MS = BS * TS, M = MP + MS;
constexpr int DFF = 2816, NWI = 2 * DFF, NIN = 3864, NINP = 4096, NMODC = 9216, NB = BP + BS;
constexpr int SBW = 1664, SFW = 392;
constexpr float LN_EPS = 1e-5f, RMS_EPS = 1e-6f;
constexpr float ALPHA = 1.41421356237f;
constexpr int C_RQ = 0, C_RK = 256, C_RV = 512, C_RG = 768, C_AQ = 1024, C_AK = 1152, C_AV = 1280, C_ALR = 1536, C_AG = 1552,
              C_HQ = 1808, C_HF = 2064, C_HI = 2320, C_HG = 2576, C_DQKV = 2832, C_DB = 3600, C_DA = 3604, C_DG = 3608;
constexpr int SB_RQ = 0, SB_RK = 256, SB_AQ = 512, SB_HQ = 640, SB_DQ = 896, SB_DK = 1152, SB_DV = 1408;
constexpr int SF_ADEC = 0, SF_HF = 128, SF_BETA = 384, SF_DDEC = 388;
constexpr size_t O_Y = 0;
constexpr size_t O_PRET = (size_t)M * D;
constexpr size_t O_PGLA = O_PRET + 2ull * BP * 4 * 64 * 64;
constexpr size_t O_PHG = O_PGLA + 2ull * BP * 4 * 32 * 64;
constexpr size_t O_PGDN = O_PHG + 2ull * BP * 4 * 64 * 64;
constexpr size_t O_PCONV = O_PGDN + 2ull * BP * 4 * 64 * 64;
constexpr size_t O_SRET = O_PCONV + 2ull * BP * 3 * 768;
constexpr size_t O_SGLA = O_SRET + 2ull * BS * 4 * 64 * 64;
constexpr size_t O_SHG = O_SGLA + 2ull * BS * 4 * 32 * 64;
constexpr size_t O_SGDN = O_SHG + 2ull * BS * 4 * 64 * 64;
constexpr size_t O_SCONV = O_SGDN + 2ull * BS * 4 * 64 * 64;
constexpr size_t O_END = O_SCONV + 2ull * BS * 3 * 768;

constexpr size_t MiB = 1u << 20;
constexpr size_t WS_ROPE = 1 * MiB;
constexpr size_t WS_AC = 2 * MiB;
constexpr size_t WS_MOD = 3 * MiB;
constexpr size_t WS_W = 13 * MiB;
constexpr size_t W_WI1 = 0, W_WO1 = 11 * MiB, W_WI2 = W_WO1 + 5 * MiB + MiB / 2, W_WO2 = W_WI2 + 11 * MiB, W_WIN = W_WO2 + 5 * MiB + MiB / 2, W_WOUT = W_WIN + 8 * MiB, W_LAYER = 43 * MiB;
constexpr size_t WS_H = WS_W + 2 * W_LAYER;
constexpr size_t WS_BIG = WS_H + 33 * MiB;
constexpr size_t WS_SB = WS_BIG + 132 * MiB;
constexpr size_t WS_SF = WS_SB + 54 * MiB;
constexpr size_t WS_END = WS_SF + 26 * MiB;
static_assert((size_t)M * SBW * 2 <= 54 * MiB && (size_t)M * SFW * 4 <= 26 * MiB && (size_t)M * 4096 * 2 <= 132 * MiB && (size_t)M * D * 2 <= 33 * MiB, "ws map");

constexpr int LDS_BYTES = 147456;
constexpr int NWAVES = 8;

#define GAS __attribute__((address_space(1)))
#define LAS __attribute__((address_space(3)))
typedef unsigned short bf16;
typedef unsigned v4u __attribute__((ext_vector_type(4)));
typedef unsigned v2u __attribute__((ext_vector_type(2)));
typedef float f32x4 __attribute__((ext_vector_type(4)));
typedef float f32x2 __attribute__((ext_vector_type(2)));
#define LDS_WAIT() asm volatile("s_waitcnt lgkmcnt(0)" ::: "memory")

__device__ __forceinline__ float bf2f(unsigned b) { return __uint_as_float(b << 16); }
__device__ __forceinline__ float bflo(unsigned w) { return __uint_as_float(w << 16); }
__device__ __forceinline__ float bfhi(unsigned w) { return __uint_as_float(w & 0xffff0000u); }
__device__ __forceinline__ unsigned pk2(float lo, float hi) { return pg8::cvt_pk_bf16(lo, hi); }
__device__ __forceinline__ float sigmoidf_(float x) { return 1.0f / (1.0f + __expf(-x)); }
__device__ __forceinline__ float siluf_(float x) { return x / (1.0f + __expf(-x)); }
__device__ __forceinline__ float wave_sum(float v) {
#pragma unroll
    for (int o = 1; o < 64; o <<= 1) v += __shfl_xor(v, o);
    return v;
}
template <int CTRL> __device__ __forceinline__ float dppmov(float v) { return __int_as_float(__builtin_amdgcn_update_dpp(0, __float_as_int(v), CTRL, 0xf, 0xf, true)); }
__device__ __forceinline__ float quad_sum(float v) { v += dppmov<0xB1>(v); v += dppmov<0x4E>(v); return v; }
__device__ __forceinline__ float row8_sum(float v) { v += dppmov<0xB1>(v); v += dppmov<0x4E>(v); v += dppmov<0x141>(v); return v; }
__device__ __forceinline__ float row16_sum(float v) { v += dppmov<0xB1>(v); v += dppmov<0x4E>(v); v += dppmov<0x141>(v); v += dppmov<0x140>(v); return v; }

struct Args { const float* in[28]; float* out; unsigned char* ws; };

struct Ctx {
    int tid, lane, wave, gw, NGW;
    LAS unsigned char* lds;
    float* out; unsigned char* ws;
};
template <class T> __device__ __forceinline__ T* fresh_ptr(T* p) {
    unsigned lo = (unsigned)(uintptr_t)p, hi = (unsigned)((uintptr_t)p >> 32);
    asm volatile("" : "+v"(lo), "+v"(hi));
    lo = __builtin_amdgcn_readfirstlane(lo); hi = __builtin_amdgcn_readfirstlane(hi);
    return (T*)(__attribute__((address_space(1))) T*)(((uintptr_t)hi << 32) | (uintptr_t)lo);
}
__device__ __forceinline__ Ctx make_ctx(const Args& args, LAS unsigned char* lds) {
    Ctx C; int t = threadIdx.x; asm volatile("" : "+v"(t));
    C.tid = t; C.lane = t & 63; C.wave = __builtin_amdgcn_readfirstlane(t >> 6);
    C.gw = (int)blockIdx.x * NWAVES + C.wave; C.NGW = (int)gridDim.x * NWAVES;
    float* op = fresh_ptr(args.out); unsigned char* wp = fresh_ptr(args.ws);
    C.lds = lds; C.out = op; C.ws = wp; return C;
}
__device__ __forceinline__ int batch_of_row(int r) { return r < MP ? (r >> 11) : BP + ((r - MP) >> 2); }


typedef GAS unsigned gu32;
#define RLX_AGENT __ATOMIC_RELAXED, __HIP_MEMORY_SCOPE_AGENT
#define XB_TMO      128
#define XB_XCNT(j)  (256  + 64 * (j))
#define XB_XSUB(j)  (1280 + 64 * (j))
#define XB_XGEN(j)  (2304 + 64 * (j))
#define XB_TOP      3328
#define XB_TOPGEN   3392
#define XCD_BAR_WORDS 3456
#define XB_SPIN_CAP (1u << 18)

__device__ __forceinline__ unsigned xb_ld(unsigned* p)              { return __hip_atomic_load(p, __ATOMIC_RELAXED, __HIP_MEMORY_SCOPE_AGENT); }
__device__ __forceinline__ unsigned xb_add(unsigned* p, unsigned v) { return __hip_atomic_fetch_add(p, v, __ATOMIC_RELAXED, __HIP_MEMORY_SCOPE_AGENT); }
__device__ __forceinline__ unsigned xb_xcc_id() { return (unsigned)__builtin_amdgcn_s_getreg((3 << 11) | 20) & 0xFu; }
#define XB_SPIN(cond, bar) do { unsigned _sp = 0; while (cond) { __builtin_amdgcn_s_sleep(1); \
    if ((++_sp & 255u) == 0u) { if (xb_ld(&(bar)[XB_TMO])) break; if (_sp > XB_SPIN_CAP) { atomicAdd(&(bar)[XB_TMO], 1u); break; } } } } while (0)

struct XcdBarrier {
    unsigned* bar; unsigned x;
    volatile LAS unsigned* st;
};

__device__ __forceinline__ XcdBarrier xcd_barrier_post(unsigned* bar, volatile LAS unsigned* st) {
    XcdBarrier b; b.bar = bar; b.x = xb_xcc_id(); b.st = st;
    if (threadIdx.x == 0) (void)xb_add(&bar[XB_XCNT(b.x)], 1u);
    return b;
}
__device__ __forceinline__ void xcd_barrier_complete(unsigned* bar, unsigned x, unsigned& nloc, unsigned& nx) {
    const unsigned G = gridDim.x * gridDim.y * gridDim.z;
    unsigned sum, cnt, mine, sp = 0u;
    for (;;) {
        sum = 0u; cnt = 0u; mine = 0u;
#pragma unroll
        for (unsigned j = 0; j < 16; ++j) { const unsigned c = xb_ld(&bar[XB_XCNT(j)]); sum += c; cnt += (c > 0u) ? 1u : 0u; mine = (j == x) ? c : mine; }
        if (sum == G) break;
        __builtin_amdgcn_s_sleep(1);
        if ((++sp & 255u) == 0u) { if (xb_ld(&bar[XB_TMO])) break; if (sp > XB_SPIN_CAP) { atomicAdd(&bar[XB_TMO], 1u); break; } }
    }
    nloc = mine > 0u ? mine : 1u; nx = cnt > 0u ? cnt : 1u;
}

__device__ __forceinline__ void xcd_barrier(const XcdBarrier& b) {
    asm volatile("s_waitcnt vmcnt(0)" ::: "memory");
    __syncthreads();
    if (threadIdx.x == 0) {
        unsigned* bar = b.bar;
        __builtin_amdgcn_s_waitcnt(0);
        unsigned nloc = b.st[0], nx = b.st[1];
        if (nloc == 0u) { xcd_barrier_complete(bar, b.x, nloc, nx); b.st[0] = nloc; b.st[1] = nx; }
        const unsigned old = xb_add(&bar[XB_XSUB(b.x)], 1u);
        const unsigned gen = old / nloc;
        if (old + 1u == (gen + 1u) * nloc) {
            __builtin_amdgcn_fence(__ATOMIC_RELEASE, "agent");
            asm volatile("s_waitcnt vmcnt(0)" ::: "memory");
            const unsigned og = xb_add(&bar[XB_TOP], 1u);
            const unsigned tg = og / nx;
            if (og + 1u == (tg + 1u) * nx) xb_add(&bar[XB_TOPGEN], 1u);
            else XB_SPIN(xb_ld(&bar[XB_TOPGEN]) == tg, bar);
            __builtin_amdgcn_fence(__ATOMIC_ACQUIRE, "agent");
            xb_add(&bar[XB_XGEN(b.x)], 1u);
            asm volatile("s_waitcnt vmcnt(0)" ::: "memory");
        } else {
            XB_SPIN(xb_ld(&bar[XB_XGEN(b.x)]) == gen, bar);
            __builtin_amdgcn_fence(__ATOMIC_ACQUIRE, "agent");
            asm volatile("s_waitcnt vmcnt(0)" ::: "memory");
        }
    }
    __syncthreads();
}

constexpr int MISC_OFF = LDS_BYTES - 256;
__device__ __forceinline__ void grid_bar(const Args& args, LAS unsigned char* lds) {
    XcdBarrier b; b.bar = (unsigned*)fresh_ptr(args.ws); b.x = xb_xcc_id(); b.st = (volatile LAS unsigned*)(lds + MISC_OFF);
    xcd_barrier(b);
}

__device__ __forceinline__ float wave_sum2(float v) { v = row16_sum(v); v += __shfl_xor(v, 16); v += __shfl_xor(v, 32); return v; }

namespace pg8 {
struct EpiSwiglu {
    static constexpr bool PERM = true, AFTER_DRAIN = false;
    bf16_t* O; int ldc;
    __device__ __forceinline__ void operator()(const f32x4 (&acc)[2][2][4][2], const Unit& u, int wr, int wc, int fr, int fq) const {
        const int row0 = u.pm * BM + wr * 64 + fr, col0 = u.pn * 128 + wc * 32 + 8 * fq;
#pragma unroll
        for (int ai = 0; ai < 2; ++ai)
#pragma unroll
            for (int m = 0; m < 4; ++m) {
                bf16_t* rowp = O + (size_t)(row0 + ai * HALF + m * 16) * ldc + col0;
                float h[8];
#pragma unroll
                for (int n = 0; n < 2; ++n)
#pragma unroll
                    for (int j = 0; j < 4; ++j) {
                        const float a = acc[ai][0][m][n][j], b = acc[ai][1][m][n][j];
                        const float e = __builtin_amdgcn_exp2f(-1.44269504f * a);
                        h[n * 4 + j] = a * __builtin_amdgcn_rcpf(1.0f + e) * b;
                    }
                u32x4 w; w.x = cvt_pk_bf16(h[0], h[1]); w.y = cvt_pk_bf16(h[2], h[3]); w.z = cvt_pk_bf16(h[4], h[5]); w.w = cvt_pk_bf16(h[6], h[7]);
                *(u32x4*)rowp = w;
            }
    }
};
struct EpiPlain {
    static constexpr bool PERM = true, AFTER_DRAIN = false;
    bf16_t* O; int ldc;
    __device__ __forceinline__ void operator()(const f32x4 (&acc)[2][2][4][2], const Unit& u, int wr, int wc, int fr, int fq) const {
        const int row0 = u.pm * BM + wr * 64 + fr, col0 = u.pn * BM + wc * 32 + 8 * fq;
#pragma unroll
        for (int ai = 0; ai < 2; ++ai)
#pragma unroll
            for (int m = 0; m < 4; ++m) {
                bf16_t* rowp = O + (size_t)(row0 + ai * HALF + m * 16) * ldc + col0;
#pragma unroll
                for (int bj = 0; bj < 2; ++bj) { const f32x4 v0 = acc[ai][bj][m][0], v1 = acc[ai][bj][m][1];
                    u32x4 w; w.x = cvt_pk_bf16(v0[0], v0[1]); w.y = cvt_pk_bf16(v0[2], v0[3]); w.z = cvt_pk_bf16(v1[0], v1[1]); w.w = cvt_pk_bf16(v1[2], v1[3]);
                    *(u32x4*)(rowp + bj * HALF) = w; }
            }
    }
};
struct EpiRes {
    static constexpr bool PERM = false, AFTER_DRAIN = false;
    float* X; float* PART; const float* gate; float scale; int ntf;
    __device__ __forceinline__ void operator()(const f32x4 (&acc)[2][2][4][2], const Unit& u, int wr, int wc, int fr, int fq) const {
        const int col0 = u.pn * BM + wc * 32 + 4 * fq;
        const bool full = (u.nt == ntf);
        float* pbase = PART + (size_t)(u.k0 / SplitOrder::PK) * (512 * 1024);
#pragma unroll
        for (int ai = 0; ai < 2; ++ai)
#pragma unroll
            for (int m = 0; m < 4; ++m) {
                const int r = u.pm * BM + ai * HALF + wr * 64 + m * 16 + fr;
                const int bi = r < 16384 ? (r >> 11) : 8 + ((r - 16384) >> 2);
                const float* gp = gate + (size_t)bi * 9216;
                float* xo = full ? X + (size_t)r * 1024 : pbase + (size_t)(r - 16384) * 1024;
#pragma unroll
                for (int bj = 0; bj < 2; ++bj)
#pragma unroll
                    for (int n = 0; n < 2; ++n) {
                        const int c = col0 + bj * HALF + n * 16;
                        const f32x4 gv = *(const f32x4*)(gp + c);
                        f32x4 o = (gv * scale + scale) * acc[ai][bj][m][n];
                        if (full) o += *(const f32x4*)(xo + c);
                        *(f32x4*)(xo + c) = o;
                    }
                asm volatile("" ::: "memory");
            }
    }
};
struct EpiMod {
    static constexpr bool PERM = false, AFTER_DRAIN = false;
    float* MODp; const float* ada_b;
    __device__ __forceinline__ void operator()(const f32x4 (&acc)[2][2][4][2], const Unit& u, int wr, int wc, int fr, int fq) const {
        const int col0 = u.pn * BM + wc * 32 + 4 * fq;
        const int l = (u.pn * BM) / 9216;
#pragma unroll
        for (int ai = 0; ai < 2; ++ai)
#pragma unroll
            for (int m = 0; m < 4; ++m) {
                const int r = u.pm * BM + ai * HALF + wr * 64 + m * 16 + fr;
                if (r < 136) {
#pragma unroll
                    for (int bj = 0; bj < 2; ++bj)
#pragma unroll
                        for (int n = 0; n < 2; ++n) {
                            const int c = col0 + bj * HALF + n * 16;
                            const f32x4 o = acc[ai][bj][m][n] + *(const f32x4*)(ada_b + c);
                            *(f32x4*)(MODp + (size_t)(l * 136 + r) * 9216 + (c - l * 9216)) = o;
                        }
                }
            }
    }
};
}

__device__ __forceinline__ void transpose_item(const float* W, int K, int N, bf16* WT, int dest_row0, LAS float* scr, int k0, int n0, int lane) {
    const int nn = n0 + (lane & 31); const bool ok = nn < N;
    float tv[32];
#pragma unroll
    for (int i = 0; i < 32; ++i) { const int kk = 2 * i + (lane >> 5); tv[i] = ok ? W[(size_t)(k0 + kk) * N + nn] : 0.f; }
#pragma unroll
    for (int i = 0; i < 32; ++i) { const int kk = 2 * i + (lane >> 5); scr[kk * 33 + (lane & 31)] = tv[i]; }
    LDS_WAIT();
    const int c = lane & 7;
#pragma unroll
    for (int j = 0; j < 4; ++j) { const int n = (lane >> 3) + 8 * j; const LAS float* s = scr + (8 * c) * 33 + n;
        v4u o; o.x = pk2(s[0 * 33], s[1 * 33]); o.y = pk2(s[2 * 33], s[3 * 33]); o.z = pk2(s[4 * 33], s[5 * 33]); o.w = pk2(s[6 * 33], s[7 * 33]);
        *(v4u*)(WT + (size_t)(dest_row0 + n) * K + k0 + 8 * c) = o; }
    LDS_WAIT();
}

constexpr int I_WI = 16 * 176, I_WO = 44 * 32, I_WIN = 16 * 121, I_WOUT = 16 * 32, I_ADA = 16 * 288;
constexpr int I_MAIN = 2 * I_WI + 2 * I_WO + I_WIN + I_WOUT, I_LAYER = I_MAIN + I_ADA;
__device__ __forceinline__ void convert_item(const Args& args, unsigned char* ws, int l, int r, LAS float* scr, int lane) {
    unsigned char* wl = ws + WS_W + (size_t)l * W_LAYER;
    if (r < 2 * (I_WI + I_WO)) {
        const int f = r / (I_WI + I_WO); r -= f * (I_WI + I_WO);
        if (r < I_WI) {
            const int kb = r / 176, nb = r % 176, n0 = nb * 32;
            const int half = n0 / DFF, j = n0 - half * DFF, t = j >> 7, jj = j & 127;
            transpose_item((f ? args.in[15] : args.in[13]) + (size_t)l * D * NWI, D, NWI, (bf16*)(wl + (f ? W_WI2 : W_WI1)), 256 * t + 128 * half + jj, scr, kb * 64, n0, lane);
        } else { r -= I_WI;
            const int kb = r / 32, nb = r % 32;
            transpose_item((f ? args.in[16] : args.in[14]) + (size_t)l * DFF * D, DFF, D, (bf16*)(wl + (f ? W_WO2 : W_WO1)), nb * 32, scr, kb * 64, nb * 32, lane);
        }
        return;
    }
    r -= 2 * (I_WI + I_WO);
    if (r < I_WIN) { const int kb = r / 121, nb = r % 121;
        transpose_item(args.in[17] + (size_t)l * D * NIN, D, NIN, (bf16*)(wl + W_WIN), nb * 32, scr, kb * 64, nb * 32, lane); return; }
    r -= I_WIN;
    if (r < I_WOUT) { const int kb = r / 32, nb = r % 32;
        transpose_item(args.in[27] + (size_t)l * D * D, D, D, (bf16*)(wl + W_WOUT), nb * 32, scr, kb * 64, nb * 32, lane); return; }
    r -= I_WOUT;
    { const int kb = r / 288, nb = r % 288;
        transpose_item(args.in[9] + (size_t)l * D * NMODC, D, NMODC, (bf16*)(ws + WS_BIG), l * NMODC + nb * 32, scr, kb * 64, nb * 32, lane); }
}

__device__ __forceinline__ void p0_prologue(const Args& args, LAS unsigned char* lds_) {
    const Ctx C = make_ctx(args, lds_);
    LAS float* scr = (LAS float*)(C.lds + C.wave * 16384);
    for (int it = C.gw; it < I_LAYER + I_ADA; it += C.NGW) {
        if (it < I_LAYER) convert_item(args, C.ws, 0, it, scr, C.lane);
        else convert_item(args, C.ws, 1, I_MAIN + (it - I_LAYER), scr, C.lane);
    }
    const int gt = C.gw * 64 + C.lane, NGT = C.NGW * 64;
    for (int i = gt; i < 2 * 224 * 128; i += NGT) { const int l = i / (224 * 128), rr = (i / 128) % 224, ch = i & 127;
        *(v4u*)(C.ws + WS_W + (size_t)l * W_LAYER + W_WIN + ((size_t)(3872 + rr) * 1024 + ch * 8) * 2) = (v4u){0u, 0u, 0u, 0u}; }
    for (int i = gt; i < 256 * 256; i += NGT) { const int row = i >> 8, c4 = (i & 255) * 4;
        v2u o = (v2u){0u, 0u};
        if (row < NB) { const float* src = row < BP ? args.in[7] + (size_t)row * D : args.in[8] + (size_t)(row - BP) * D; const f32x4 v = *(const f32x4*)(src + c4);
            o.x = pk2(siluf_(v.x), siluf_(v.y)); o.y = pk2(siluf_(v.z), siluf_(v.w)); }
        *(v2u*)(C.ws + WS_AC + ((size_t)row * D + c4) * 2) = o; }
    for (int i = gt; i < 2052 * 32; i += NGT) { const int p = i >> 5, j = i & 31; const double pos = p < 2048 ? (double)p : (double)(16384 + (p - 2048));
        double inv = 1.0; for (int q = 0; q < j; ++q) inv *= 0.7498942093324559;
        const double ang = pos * inv; const double n = rint(ang * 0.15915494309189535);
        const float rr = (float)((ang - n * 6.283185307179586) - n * 2.4492935982947064e-16);
        ((f32x2*)(C.ws + WS_ROPE))[i] = (f32x2){__cosf(rr), __sinf(rr)}; }
}

__device__ __forceinline__ void p2_modulate0(const Args& args, LAS unsigned char* lds_) {
    const Ctx C = make_ctx(args, lds_);
    const float* MOD = (const float*)(C.ws + WS_MOD); bf16* H = (bf16*)(C.ws + WS_H);
    for (int r = C.gw; r < M; r += C.NGW) {
        const float* xr = r < MP ? args.in[0] + (size_t)r * D : args.in[1] + (size_t)(r - MP) * D;
        const float* modr = MOD + (size_t)batch_of_row(r) * NMODC;
#pragma unroll
        for (int j = 0; j < 4; ++j) { const int c = (C.lane + 64 * j) * 4;
            const f32x4 v = *(const f32x4*)(xr + c), sh = *(const f32x4*)(modr + c), sc = *(const f32x4*)(modr + 1024 + c);
            const f32x4 h = v * (sc + 1.0f) + sh;
            *(f32x4*)(C.out + (size_t)r * D + c) = v * ALPHA;
            *(v2u*)(H + (size_t)r * D + c) = (v2u){pk2(h.x, h.y), pk2(h.z, h.w)}; }
    }
}

__device__ __forceinline__ void ln_phase(const Args& args, LAS unsigned char* lds_, int l, int which, bool write_h, int hl, int shc, int npart, float xscale) {
    const Ctx C = make_ctx(args, lds_);
    const float* MOD = (const float*)(C.ws + WS_MOD); bf16* H = (bf16*)(C.ws + WS_H);
    const float* g = args.in[11] + (size_t)(l * 3 + which) * D; const float* b = args.in[12] + (size_t)(l * 3 + which) * D;
    f32x4 nv[4];
    if (C.gw < M) {
#pragma unroll
        for (int j = 0; j < 4; ++j) nv[j] = *(const f32x4*)(C.out + (size_t)C.gw * D + (C.lane + 64 * j) * 4); }
#pragma unroll 1
    for (int r = C.gw; r < M; r += C.NGW) {
        float* xr = C.out + (size_t)r * D;
        f32x4 v[4]; float s = 0.f;
#pragma unroll
        for (int j = 0; j < 4; ++j) v[j] = nv[j];
        if (r + C.NGW < M) {
#pragma unroll
            for (int j = 0; j < 4; ++j) nv[j] = *(const f32x4*)(xr + (size_t)C.NGW * D + (C.lane + 64 * j) * 4); }
        if (r >= MP) { const float* pp = (const float*)(C.ws + WS_SB) + (size_t)(r - MP) * D;
#pragma unroll 1
            for (int p = 0; p < npart; ++p, pp += 512 * 1024) {
#pragma unroll
                for (int j = 0; j < 4; ++j) v[j] += *(const f32x4*)(pp + (C.lane + 64 * j) * 4); } }
#pragma unroll
        for (int j = 0; j < 4; ++j) s += (v[j].x + v[j].y) + (v[j].z + v[j].w);
        const float mean = wave_sum2(s) * (1.f / D); float s2 = 0.f;
#pragma unroll
        for (int j = 0; j < 4; ++j) { v[j] = v[j] - mean; s2 += (v[j].x * v[j].x + v[j].y * v[j].y) + (v[j].z * v[j].z + v[j].w * v[j].w); }
        const float rstd = 1.f / sqrtf(wave_sum2(s2) * (1.f / D) + LN_EPS);
        const float* modr = MOD + (size_t)(hl * NB + batch_of_row(r)) * NMODC + shc * 1024;
#pragma unroll
        for (int j = 0; j < 4; ++j) { const int c = (C.lane + 64 * j) * 4;
            const f32x4 xn = v[j] * rstd * *(const f32x4*)(g + c) + *(const f32x4*)(b + c);
            *(f32x4*)(xr + c) = xn * xscale;
            if (write_h) { const f32x4 sh = *(const f32x4*)(modr + c), sc = *(const f32x4*)(modr + 1024 + c); const f32x4 h = xn * (sc + 1.0f) + sh;
                *(v2u*)(H + (size_t)r * D + c) = (v2u){pk2(h.x, h.y), pk2(h.z, h.w)}; }
        }
    }
}

struct PrepRaw { unsigned short rq1[4], rq2[4], rk1[4], rk2[4], aq[2], hf[4], hq[4], dx[12], db, da; v4u alr0, alr1; };
__device__ __forceinline__ void prep_load(PrepRaw& x, const bf16* P, int lane) {
    const int j = lane & 31;
#pragma unroll
    for (int h = 0; h < 4; ++h) { x.rq1[h] = P[C_RQ + h * 64 + j]; x.rq2[h] = P[C_RQ + h * 64 + 32 + j]; x.rk1[h] = P[C_RK + h * 64 + j]; x.rk2[h] = P[C_RK + h * 64 + 32 + j]; }
    x.alr0 = *(const v4u*)(P + C_ALR); x.alr1 = *(const v4u*)(P + C_ALR + 8);
#pragma unroll
    for (int i = 0; i < 2; ++i) x.aq[i] = P[C_AQ + lane + 64 * i];
#pragma unroll
    for (int i = 0; i < 4; ++i) { x.hf[i] = P[C_HF + lane + 64 * i]; x.hq[i] = P[C_HQ + lane + 64 * i]; }
#pragma unroll
    for (int i = 0; i < 12; ++i) x.dx[i] = P[C_DQKV + lane + 64 * i];
    x.db = P[C_DB + (lane & 3)]; x.da = P[C_DA + (lane & 3)];
}

__device__ __forceinline__ void prep_phase(const Args& args, LAS unsigned char* lds_, int l) {
    const Ctx C = make_ctx(args, lds_);
    const bf16* PROJ = (const bf16*)(C.ws + WS_BIG); bf16* SB = (bf16*)(C.ws + WS_SB); float* SF = (float*)(C.ws + WS_SF);
    const f32x2* ROPE = (const f32x2*)(C.ws + WS_ROPE);
    const int lane = C.lane;
    const float* wg = args.in[18] + (size_t)l * 16 * 128; const float* bg = args.in[19] + (size_t)l * 128;
    const float* cw = args.in[21] + (size_t)l * 4 * 768;
    constexpr int CH = 9;
    const int r0 = C.gw * CH, r1 = min(r0 + CH, M);
    if (r0 >= M) return;
    float lbv[4];
#pragma unroll
    for (int i = 0; i < 4; ++i) { lbv[i] = 0.f; if (l == 1) lbv[i] = 1.0f / (1.0f + expf(args.in[20][lane + 64 * i] - args.in[20][256 + lane + 64 * i])); }
    const float a_neg = -expf(args.in[22][l * 4 + (lane & 3)]), dtb = args.in[23][l * 4 + (lane & 3)];
    const float bg0 = bg[lane], bg1 = bg[lane + 64];
    float w1[12], w2[12], w3[12];
    auto load_window = [&](int r) {
        const bool isp = r < MP; const int rs = r - MP; const int b = isp ? (r >> 11) : (rs >> 2), t = isp ? (r & 2047) : (rs & 3);
        const float* cst = args.in[6] + ((size_t)(l * BS + b) * 3) * 768;
#pragma unroll
        for (int i = 0; i < 12; ++i) { const int ch = lane + 64 * i; const bf16* Pc = PROJ + (size_t)r * NINP + C_DQKV + ch;
            w1[i] = t >= 1 ? bf2f(Pc[-1 * NINP]) : (isp ? 0.f : cst[2 * 768 + ch]);
            w2[i] = t >= 2 ? bf2f(Pc[-2 * NINP]) : (isp ? 0.f : cst[(1 + t) * 768 + ch]);
            w3[i] = t >= 3 ? bf2f(Pc[-3 * NINP]) : (isp ? 0.f : cst[t * 768 + ch]); }
    };
    PrepRaw A; prep_load(A, PROJ + (size_t)r0 * NINP, lane);
    load_window(r0);
#pragma unroll 1
    for (int r = r0; r < r1; ++r) {
        PrepRaw B = A;
        if (r + 1 < r1) prep_load(B, PROJ + (size_t)(r + 1) * NINP, lane);
        int zo = 0; asm volatile("" : "+v"(zo));
        const bool isp = r < MP; const int rs = r - MP;
        const int b = isp ? (r >> 11) : (rs >> 2), t = isp ? (r & 2047) : (rs & 3);
        const int ridx = isp ? t : 2048 + t;
        bf16* sb = SB + (size_t)r * SBW; float* sf = SF + (size_t)r * SFW;
        { const int j = lane & 31; const bool hi = lane >= 32; const f32x2 cs = ROPE[ridx * 32 + j];
#pragma unroll
          for (int h = 0; h < 4; ++h) {
              const float q1 = bf2f(A.rq1[h]), q2 = bf2f(A.rq2[h]), k1 = bf2f(A.rk1[h]), k2 = bf2f(A.rk2[h]);
              const float qo = hi ? (q1 * cs.y + q2 * cs.x) : (q1 * cs.x - q2 * cs.y);
              const float ko = hi ? (k1 * cs.y + k2 * cs.x) : (k1 * cs.x - k2 * cs.y);
              sb[SB_RQ + h * 64 + lane] = (bf16)(pk2(qo, 0.f) & 0xffffu);
              sb[SB_RK + h * 64 + lane] = (bf16)(pk2(ko * 0.125f, 0.f) & 0xffffu);
          } }
        { const unsigned aw[8] = {A.alr0.x, A.alr0.y, A.alr0.z, A.alr0.w, A.alr1.x, A.alr1.y, A.alr1.z, A.alr1.w};
          float x0 = bg0, x1 = bg1;
#pragma unroll
          for (int i = 0; i < 8; ++i) { const float a0 = bflo(aw[i]), a1 = bfhi(aw[i]);
              x0 += a0 * wg[(2 * i) * 128 + lane + zo] + a1 * wg[(2 * i + 1) * 128 + lane + zo];
              x1 += a0 * wg[(2 * i) * 128 + lane + 64 + zo] + a1 * wg[(2 * i + 1) * 128 + lane + 64 + zo]; }
          const float sp0 = fmaxf(-x0, 0.f) + log1pf(expf(-fabsf(x0))), sp1 = fmaxf(-x1, 0.f) + log1pf(expf(-fabsf(x1)));
          sf[SF_ADEC + lane] = expf(-sp0 * (1.0f / 16.0f)); sf[SF_ADEC + lane + 64] = expf(-sp1 * (1.0f / 16.0f));
          sb[SB_AQ + lane] = (bf16)(pk2(bf2f(A.aq[0]) * 0.17677669529663687f, 0.f) & 0xffffu);
          sb[SB_AQ + lane + 64] = (bf16)(pk2(bf2f(A.aq[1]) * 0.17677669529663687f, 0.f) & 0xffffu); }
#pragma unroll
        for (int i = 0; i < 4; ++i) { const int c = lane + 64 * i;
            sf[SF_HF + c] = lbv[i] + (1.0f - lbv[i]) * sigmoidf_(bf2f(A.hf[i]));
            sb[SB_HQ + c] = (bf16)(pk2(siluf_(bf2f(A.hq[i])) * 0.125f, 0.f) & 0xffffu); }
        { float* cso = isp ? C.out + O_PCONV + ((size_t)(l * BP + b) * 3) * 768 : C.out + O_SCONV + ((size_t)(l * BS + b) * 3) * 768;
          const int so = isp ? t - (TP - 3) : t - 1;
          float uu[12];
#pragma unroll
          for (int i = 0; i < 12; ++i) { const float x0 = bf2f(A.dx[i]);
              const float* cwc = cw + lane + 64 * i + zo;
              uu[i] = siluf_(x0 * cwc[3 * 768] + w1[i] * cwc[2 * 768] + w2[i] * cwc[768] + w3[i] * cwc[0]);
              if (so >= 0) cso[so * 768 + lane + 64 * i] = x0;
              w3[i] = w2[i]; w2[i] = w1[i]; w1[i] = x0; }
#pragma unroll
          for (int i = 0; i < 12; ++i) { float sc = 1.0f;
              if (i < 8) { const float nn = wave_sum2(uu[i] * uu[i]); sc = rsqrtf(nn + RMS_EPS) * (i < 4 ? 0.125f : 1.0f); }
              sb[SB_DQ + i * 64 + lane] = (bf16)(pk2(uu[i] * sc, 0.f) & 0xffffu); }
          if (lane < 4) { sf[SF_BETA + lane] = sigmoidf_(bf2f(A.db));
              const float xx = bf2f(A.da) + dtb; const float sp = fmaxf(xx, 0.f) + log1pf(expf(-fabsf(xx)));
              sf[SF_DDEC + lane] = expf(a_neg * sp); } }
        A = B;
        if (r + 1 < r1) { const int rn = r + 1; const bool ns = rn < MP ? ((rn & 2047) == 0) : (((rn - MP) & 3) == 0); if (ns) load_window(rn); }
    }
}

template <int KIND, int DH, int R> struct Raw { unsigned q[DH / 2]; unsigned k[DH / 2]; unsigned v[(R + 1) / 2]; float f[DH]; float be, de; };

template <int KIND, int DH, int R>
__device__ __forceinline__ void load_tok(Raw<KIND, DH, R>& x, const bf16* qp, const bf16* kp, const bf16* vp, const float* fp) {
    if constexpr (DH == 4) { const v2u w = *(const v2u*)qp; x.q[0] = w.x; x.q[1] = w.y; } else { x.q[0] = *(const unsigned*)qp; }
    if constexpr (KIND != 2) { if constexpr (DH == 4) { const v2u w = *(const v2u*)kp; x.k[0] = w.x; x.k[1] = w.y; } else { x.k[0] = *(const unsigned*)kp; } }
    if constexpr (R == 1) x.v[0] = *vp; else if constexpr (R == 2) x.v[0] = *(const unsigned*)vp; else { const v2u w = *(const v2u*)vp; x.v[0] = w.x; x.v[1] = w.y; }
    if constexpr (KIND == 1) { const f32x2 w = *(const f32x2*)fp; x.f[0] = w.x; x.f[1] = w.y; }
    if constexpr (KIND == 2) { const f32x4 w = *(const f32x4*)fp; x.f[0] = w.x; x.f[1] = w.y; x.f[2] = w.z; x.f[3] = w.w; }
    if constexpr (KIND == 3) { x.be = fp[0]; x.de = fp[4]; }
}

template <int KIND, int DH, int R>
__device__ __forceinline__ void scan_task(const Ctx& C, int row0, int T, int h, int slice, const float* sin, float* sout) {
    const bf16* PROJ = (const bf16*)(C.ws + WS_BIG); const bf16* SB = (const bf16*)(C.ws + WS_SB); const float* SF = (const float*)(C.ws + WS_SF);
    bf16* H = (bf16*)(C.ws + WS_H);
    const int lane = C.lane, dl = lane & 15, rw = lane >> 4;
    const int d0 = dl * DH, v0 = slice * (4 * R) + rw * R;
    constexpr int DK = 16 * DH;
    const bf16 *qp, *kp, *vp; const float* fp; int ks, vs;
    const bf16* sbr = SB + (size_t)row0 * SBW; const bf16* pr = PROJ + (size_t)row0 * NINP; const float* sfr = SF + (size_t)row0 * SFW;
    if constexpr (KIND == 0) { qp = sbr + SB_RQ + h * 64 + d0; kp = sbr + SB_RK + h * 64 + d0; ks = SBW; vp = pr + C_RV + h * 64 + v0; vs = NINP; fp = sfr; }
    if constexpr (KIND == 1) { qp = sbr + SB_AQ + h * 32 + d0; kp = pr + C_AK + h * 32 + d0; ks = NINP; vp = pr + C_AV + h * 64 + v0; vs = NINP; fp = sfr + SF_ADEC + h * 32 + d0; }
    if constexpr (KIND == 2) { qp = sbr + SB_HQ + h * 64 + d0; kp = sbr; ks = SBW; vp = pr + C_HI + h * 64 + v0; vs = NINP; fp = sfr + SF_HF + h * 64 + d0; }
    if constexpr (KIND == 3) { qp = sbr + SB_DQ + h * 64 + d0; kp = sbr + SB_DK + h * 64 + d0; ks = SBW; vp = sbr + SB_DV + h * 64 + v0; vs = SBW; fp = sfr + SF_BETA + h; }
    bf16* op = H + (size_t)row0 * D + KIND * 256 + h * 64 + v0;
    const float rdec = 1.0f - exp2f(-5.0f - (float)h);

    float S[DH][R];
#pragma unroll
    for (int dh = 0; dh < DH; ++dh)
#pragma unroll
        for (int vv = 0; vv < R; ++vv) S[dh][vv] = sin ? sin[(size_t)(d0 + dh) * 64 + v0 + vv] : 0.f;

    typedef Raw<KIND, DH, R> RawT;
    RawT A[4];
#pragma unroll
    for (int u = 0; u < 4; ++u) load_tok<KIND, DH, R>(A[u], qp + (size_t)u * SBW, kp + (size_t)u * ks, vp + (size_t)u * vs, fp + (size_t)u * SFW);
    for (int t0 = 0; t0 < T; t0 += 4) {
        RawT B[4];
        const bool more = t0 + 4 < T;
#pragma unroll
        for (int u = 0; u < 4; ++u) { B[u] = A[u]; }
        if (more) {
#pragma unroll
            for (int u = 0; u < 4; ++u) load_tok<KIND, DH, R>(B[u], qp + (size_t)(t0 + 4 + u) * SBW, kp + (size_t)(t0 + 4 + u) * ks, vp + (size_t)(t0 + 4 + u) * vs, fp + (size_t)(t0 + 4 + u) * SFW);
        }
#pragma unroll
        for (int u = 0; u < 4; ++u) {
            const RawT& x = A[u];
            float q[DH], k[DH], v[R];
            q[0] = bflo(x.q[0]); q[1] = bfhi(x.q[0]); if constexpr (DH == 4) { q[2] = bflo(x.q[1]); q[3] = bfhi(x.q[1]); }
            if constexpr (KIND != 2) { k[0] = bflo(x.k[0]); k[1] = bfhi(x.k[0]); if constexpr (DH == 4) { k[2] = bflo(x.k[1]); k[3] = bfhi(x.k[1]); } }
            if constexpr (R == 1) v[0] = bflo(x.v[0]);
            if constexpr (R >= 2) { v[0] = bflo(x.v[0]); v[1] = bfhi(x.v[0]); }
            if constexpr (R == 4) { v[2] = bflo(x.v[1]); v[3] = bfhi(x.v[1]); }
            float o[R];
            if constexpr (KIND == 3) {
                float ks_[R];
#pragma unroll
                for (int vv = 0; vv < R; ++vv) { float p = 0.f;
#pragma unroll
                    for (int dh = 0; dh < DH; ++dh) { S[dh][vv] *= x.de; p += k[dh] * S[dh][vv]; }
                    ks_[vv] = row16_sum(p); }
#pragma unroll
                for (int vv = 0; vv < R; ++vv) { const float uu = x.be * (v[vv] - ks_[vv]); float p = 0.f;
#pragma unroll
                    for (int dh = 0; dh < DH; ++dh) { S[dh][vv] += k[dh] * uu; p += q[dh] * S[dh][vv]; }
                    o[vv] = row16_sum(p); }
            } else {
#pragma unroll
                for (int dh = 0; dh < DH; ++dh) {
                    float dec, kk;
                    if constexpr (KIND == 0) { dec = rdec; kk = k[dh]; }
                    if constexpr (KIND == 1) { dec = x.f[dh]; kk = k[dh]; }
                    if constexpr (KIND == 2) { dec = x.f[dh]; kk = 1.0f - x.f[dh]; }
#pragma unroll
                    for (int vv = 0; vv < R; ++vv) S[dh][vv] = dec * S[dh][vv] + kk * v[vv];
                }
#pragma unroll
                for (int vv = 0; vv < R; ++vv) { float p = 0.f;
#pragma unroll
                    for (int dh = 0; dh < DH; ++dh) p += q[dh] * S[dh][vv];
                    o[vv] = row16_sum(p); }
            }
            if (dl == 0) {
                bf16* o_ = op + (size_t)(t0 + u) * D;
                if constexpr (R == 1) *o_ = (bf16)(pk2(o[0], 0.f) & 0xffffu);
                if constexpr (R == 2) *(unsigned*)o_ = pk2(o[0], o[1]);
                if constexpr (R == 4) *(v2u*)o_ = (v2u){pk2(o[0], o[1]), pk2(o[2], o[3])};
            }
        }
#pragma unroll
        for (int u = 0; u < 4; ++u) A[u] = B[u];
    }
#pragma unroll
    for (int dh = 0; dh < DH; ++dh)
#pragma unroll
        for (int vv = 0; vv < R; ++vv) sout[(size_t)(d0 + dh) * 64 + v0 + vv] = S[dh][vv];
    (void)DK;
}

template <int KIND, int DH, int R>
__device__ __forceinline__ void scan_long(const Ctx& C, LAS float* wl, int row0, int T, int h, int slice, float* sout) {
    constexpr int CT = 16, LR = 8, DK = LR * DH, NV = (64 / LR) * R, UNR = 8;
    constexpr bool HASK = true, GK = (KIND != 2), HASF = (KIND == 1 || KIND == 2), HASB = (KIND == 3);
    constexpr int OQ = 0, OK_ = OQ + CT * DK, OF = OK_ + (HASK ? CT * DK : 0), OV = OF + (HASF ? CT * DK : 0), OB = OV + CT * NV, BUF = OB + (HASB ? CT * 2 : 0);
    const bf16* PROJ = (const bf16*)(C.ws + WS_BIG); const bf16* SB = (const bf16*)(C.ws + WS_SB); const float* SF = (const float*)(C.ws + WS_SF);
    bf16* H = (bf16*)(C.ws + WS_H);
    const int lane = C.lane, dl = lane & (LR - 1), rw = lane / LR;
    const int d0 = dl * DH;
    const int stok = lane >> 2, spart = lane & 3;
    const GAS bf16 *qg, *kg, *vg; const GAS float *fg, *bg; int ks, vs;
    {
        const GAS bf16* sbr = (const GAS bf16*)(SB + (size_t)row0 * SBW); const GAS bf16* pr = (const GAS bf16*)(PROJ + (size_t)row0 * NINP); const GAS float* sfr = (const GAS float*)(SF + (size_t)row0 * SFW);
        const int vcol = slice * NV;
        if constexpr (KIND == 0) { qg = sbr + SB_RQ + h * 64; kg = sbr + SB_RK + h * 64; ks = SBW; vg = pr + C_RV + h * 64 + vcol; vs = NINP; fg = sfr; bg = sfr; }
        if constexpr (KIND == 1) { qg = sbr + SB_AQ + h * 32; kg = pr + C_AK + h * 32; ks = NINP; vg = pr + C_AV + h * 64 + vcol; vs = NINP; fg = sfr + SF_ADEC + h * 32; bg = sfr; }
        if constexpr (KIND == 2) { qg = sbr + SB_HQ + h * 64; kg = sbr; ks = SBW; vg = pr + C_HI + h * 64 + vcol; vs = NINP; fg = sfr + SF_HF + h * 64; bg = sfr; }
        if constexpr (KIND == 3) { qg = sbr + SB_DQ + h * 64; kg = sbr + SB_DK + h * 64; ks = SBW; vg = sbr + SB_DV + h * 64 + vcol; vs = SBW; fg = sfr; bg = sfr + SF_BETA + h; }
    }
    constexpr int QP = DK / 4;
    qg += (size_t)stok * SBW + spart * QP; kg += (size_t)stok * ks + spart * QP; fg += (size_t)stok * SFW + spart * QP;
    vg += (size_t)(lane & 15) * vs; bg += (size_t)(lane & 15) * SFW;
    GAS bf16* op = (GAS bf16*)(H + (size_t)row0 * D + KIND * 256 + h * 64 + slice * NV + rw * R);
    const float rdec = 1.0f - exp2f(-5.0f - (float)h);

    static_assert(R == 1, "scan_long: one column per lane row");
    f32x2 S2[DH / 2];
#pragma unroll
    for (int i = 0; i < DH / 2; ++i) S2[i] = (f32x2){0.f, 0.f};

    struct SR { v4u rq[QP / 8], rk[QP / 8]; f32x4 rf[QP / 4]; unsigned rv[NV / 2]; float rb0, rb1; };
    SR s0; s0.rb0 = s0.rb1 = 0.f;
    auto stage_load = [&](SR& sr, int c) {
        const size_t t = (size_t)c * CT;
#pragma unroll
        for (int i = 0; i < QP / 8; ++i) { sr.rq[i] = *(const GAS v4u*)(qg + t * SBW + i * 8); if constexpr (GK) sr.rk[i] = *(const GAS v4u*)(kg + t * ks + i * 8); }
        if constexpr (HASF) {
#pragma unroll
            for (int i = 0; i < QP / 4; ++i) sr.rf[i] = *(const GAS f32x4*)(fg + t * SFW + i * 4); }
        if (lane < 16) {
            if constexpr (NV == 4) { const v2u w = *(const GAS v2u*)(vg + t * vs); sr.rv[0] = w.x; sr.rv[1] = w.y; }
            if constexpr (NV == 8) { const v4u w = *(const GAS v4u*)(vg + t * vs); sr.rv[0] = w.x; sr.rv[1] = w.y; sr.rv[2] = w.z; sr.rv[3] = w.w; }
            if constexpr (NV == 16) { const v4u w = *(const GAS v4u*)(vg + t * vs), w2 = *(const GAS v4u*)(vg + t * vs + 8); sr.rv[0] = w.x; sr.rv[1] = w.y; sr.rv[2] = w.z; sr.rv[3] = w.w; sr.rv[4] = w2.x; sr.rv[5] = w2.y; sr.rv[6] = w2.z; sr.rv[7] = w2.w; }
            if constexpr (HASB) { sr.rb0 = bg[t * SFW]; sr.rb1 = bg[t * SFW + 4]; }
        }
    };
    auto stage_write = [&](SR& sr, int b) {
        LAS float* base = wl + b * BUF;
#pragma unroll
        for (int i = 0; i < QP / 8; ++i) {
            LAS float* qd = base + OQ + stok * DK + spart * QP + i * 8;
            *(LAS f32x4*)qd = (f32x4){bflo(sr.rq[i].x), bfhi(sr.rq[i].x), bflo(sr.rq[i].y), bfhi(sr.rq[i].y)}; *(LAS f32x4*)(qd + 4) = (f32x4){bflo(sr.rq[i].z), bfhi(sr.rq[i].z), bflo(sr.rq[i].w), bfhi(sr.rq[i].w)};
            if constexpr (GK) { LAS float* kd = base + OK_ + stok * DK + spart * QP + i * 8;
                *(LAS f32x4*)kd = (f32x4){bflo(sr.rk[i].x), bfhi(sr.rk[i].x), bflo(sr.rk[i].y), bfhi(sr.rk[i].y)}; *(LAS f32x4*)(kd + 4) = (f32x4){bflo(sr.rk[i].z), bfhi(sr.rk[i].z), bflo(sr.rk[i].w), bfhi(sr.rk[i].w)}; }
        }
        if constexpr (HASF) {
#pragma unroll
            for (int i = 0; i < QP / 4; ++i) { *(LAS f32x4*)(base + OF + stok * DK + spart * QP + i * 4) = sr.rf[i];
                if constexpr (KIND == 2) *(LAS f32x4*)(base + OK_ + stok * DK + spart * QP + i * 4) = 1.0f - sr.rf[i]; } }
        if (lane < 16) {
#pragma unroll
            for (int i = 0; i < NV / 2; ++i) { base[OV + lane * NV + 2 * i] = bflo(sr.rv[i]); base[OV + lane * NV + 2 * i + 1] = bfhi(sr.rv[i]); }
            if constexpr (HASB) { base[OB + lane * 2] = sr.rb0; base[OB + lane * 2 + 1] = sr.rb1; }
        }
    };
    static_assert(2 * BUF * 4 <= 26624, "per-wave LDS");
    const int nch = T / CT;
    struct Opnd { f32x2 q2[DH / 2], k2[DH / 2], f2[DH / 2]; float v; f32x2 bd; };
    auto ldop = [&](Opnd& x, const LAS float* bq, const LAS float* bv, const LAS float* bb, int uu) {
#pragma unroll
        for (int i = 0; i < DH / 4; ++i) { const f32x4 w = *(const LAS f32x4*)(bq + OQ + uu * DK + 4 * i); x.q2[2 * i] = (f32x2){w.x, w.y}; x.q2[2 * i + 1] = (f32x2){w.z, w.w}; }
#pragma unroll
        for (int i = 0; i < DH / 4; ++i) { const f32x4 w = *(const LAS f32x4*)(bq + OK_ + uu * DK + 4 * i); x.k2[2 * i] = (f32x2){w.x, w.y}; x.k2[2 * i + 1] = (f32x2){w.z, w.w}; }
        if constexpr (HASF) {
#pragma unroll
            for (int i = 0; i < DH / 4; ++i) { const f32x4 w = *(const LAS f32x4*)(bq + OF + uu * DK + 4 * i); x.f2[2 * i] = (f32x2){w.x, w.y}; x.f2[2 * i + 1] = (f32x2){w.z, w.w}; } }
        x.v = bv[uu * NV];
        if constexpr (HASB) x.bd = *(const LAS f32x2*)(bb + uu * 2);
    };
    auto compute = [&](int c, const LAS float* base) {
#pragma unroll 1
        for (int ub = 0; ub < CT; ub += UNR) {
        float okeep[R];
#pragma unroll
        for (int vv = 0; vv < R; ++vv) okeep[vv] = 0.f;
        Opnd X; X.bd = (f32x2){0.f, 0.f};
#pragma unroll
        for (int i = 0; i < DH / 2; ++i) X.f2[i] = (f32x2){0.f, 0.f};
        const LAS float* bq = base + ub * DK + d0; const LAS float* bv = base + OV + ub * NV + rw; const LAS float* bb = base + OB + ub * 2;
        ldop(X, bq, bv, bb, 0);
#pragma unroll
        for (int uu_ = 0; uu_ < UNR; ++uu_) { const int u = ub + uu_;
            Opnd Y = X;
            if (uu_ + 1 < UNR) ldop(Y, bq, bv, bb, uu_ + 1);
            f32x2 (&q2)[DH / 2] = X.q2; f32x2 (&k2)[DH / 2] = X.k2; f32x2 (&f2)[DH / 2] = X.f2; const float vv_ = X.v; const f32x2 bd = X.bd;
            float o[1];
            if constexpr (KIND == 3) {
                f32x2 a = k2[0] * S2[0];
#pragma unroll
                for (int i = 1; i < DH / 2; ++i) a = __builtin_elementwise_fma(k2[i], S2[i], a);
                const float ks_ = row8_sum(a.x + a.y) * bd.y;
                const float uu = bd.x * (vv_ - ks_);
                const f32x2 de2 = (f32x2){bd.y, bd.y}, uu2 = (f32x2){uu, uu};
#pragma unroll
                for (int i = 0; i < DH / 2; ++i) S2[i] = __builtin_elementwise_fma(S2[i], de2, k2[i] * uu2);
            } else {
                const f32x2 v2 = (f32x2){vv_, vv_};
#pragma unroll
                for (int i = 0; i < DH / 2; ++i) {
                    f32x2 dec2;
                    if constexpr (KIND == 0) dec2 = (f32x2){rdec, rdec}; else dec2 = f2[i];
                    S2[i] = __builtin_elementwise_fma(S2[i], dec2, k2[i] * v2);
                }
            }
            { f32x2 a = q2[0] * S2[0];
#pragma unroll
              for (int i = 1; i < DH / 2; ++i) a = __builtin_elementwise_fma(q2[i], S2[i], a);
              o[0] = row8_sum(a.x + a.y); }
#pragma unroll
            for (int vv = 0; vv < R; ++vv) okeep[vv] = (dl == uu_) ? o[vv] : okeep[vv];
            X = Y;
        }
        {
            GAS bf16* o_ = op + (size_t)(c * CT + ub + dl) * D;
            if constexpr (R == 1) *o_ = (bf16)(pk2(okeep[0], 0.f) & 0xffffu);
            if constexpr (R == 2) *(GAS unsigned*)o_ = pk2(okeep[0], okeep[1]);
            if constexpr (R == 4) *(GAS v2u*)o_ = (v2u){pk2(okeep[0], okeep[1]), pk2(okeep[2], okeep[3])};
        }
        }
    };
    stage_load(s0, 0); stage_write(s0, 0);
#pragma unroll 1
    for (int c = 0; c < nch; c += 2) {
        stage_load(s0, min(c + 1, nch - 1));
        compute(c, wl);
        stage_write(s0, 1);
        stage_load(s0, min(c + 2, nch - 1));
        compute(c + 1, wl + BUF);
        stage_write(s0, 0);
    }
    const int v0 = slice * NV + rw * R;
#pragma unroll
    for (int i = 0; i < DH / 2; ++i) { sout[(size_t)(d0 + 2 * i) * 64 + v0] = S2[i].x; sout[(size_t)(d0 + 2 * i + 1) * 64 + v0] = S2[i].y; }
}

__device__ __forceinline__ void scan_phase(const Args& args, LAS unsigned char* lds_, int l, int mode = 0) {
    const Ctx C = make_ctx(args, lds_);
    constexpr int NLONG = 1024, NSHORT = BS * 144;
    const int slot = C.wave * 256 + (int)blockIdx.x;
    const int nidle = C.NGW - NLONG;
    for (int it = 0;; ++it) {
        int kind, b, h, slice, row0, T; bool isp;
        if (slot < NLONG) { if (it > 0 || mode == 2) break; isp = true; T = TP;
            const int kk_ = slot >> 8, i = slot & 255; kind = kk_ == 0 ? 3 : (kk_ == 1 ? 0 : (kk_ == 2 ? 2 : 1));
            { const int stream = (i & 7) | ((i >> 6) << 3); slice = (i >> 3) & 7; b = stream >> 2; h = stream & 3; }
            row0 = b * TP;
        } else { const int st = (slot - NLONG) + it * nidle; if (st >= NSHORT || mode == 1) break; isp = false; T = TS;
            b = st / 144; int i = st - b * 144;
            if (i < 64) { kind = 3; h = i >> 4; slice = i & 15; }
            else if (i < 96) { i -= 64; kind = 0; h = i >> 3; slice = i & 7; }
            else if (i < 128) { i -= 96; kind = 2; h = i >> 3; slice = i & 7; }
            else { i -= 128; kind = 1; h = i >> 2; slice = i & 3; }
            row0 = MP + b * TS;
        }
        const int nbat = isp ? BP : BS;
        const size_t sidx = (size_t)((l * nbat + b) * 4 + h);
        if (isp) {
            LAS float* wl = (LAS float*)(C.lds + C.wave * 26624);
            if (kind == 0) scan_long<0, 8, 1>(C, wl, row0, T, h, slice, C.out + O_PRET + sidx * 4096);
            else if (kind == 1) scan_long<1, 4, 1>(C, wl, row0, T, h, slice, C.out + O_PGLA + sidx * 2048);
            else if (kind == 2) scan_long<2, 8, 1>(C, wl, row0, T, h, slice, C.out + O_PHG + sidx * 4096);
            else scan_long<3, 8, 1>(C, wl, row0, T, h, slice, C.out + O_PGDN + sidx * 4096);
        } else {
            if (kind == 0) { scan_task<0, 4, 2>(C, row0, T, h, slice, args.in[2] + sidx * 4096, C.out + O_SRET + sidx * 4096); }
            else if (kind == 1) { scan_task<1, 2, 4>(C, row0, T, h, slice, args.in[3] + sidx * 2048, C.out + O_SGLA + sidx * 2048); }
            else if (kind == 2) { scan_task<2, 4, 2>(C, row0, T, h, slice, args.in[4] + sidx * 4096, C.out + O_SHG + sidx * 4096); }
            else { scan_task<3, 4, 1>(C, row0, T, h, slice, args.in[5] + sidx * 4096, C.out + O_SGDN + sidx * 4096); }
        }
    }
    if (l == 0 && C.wave >= 4 && mode != 1) {
        LAS float* scr = (LAS float*)(C.lds + 4 * 26624 + (C.wave - 4) * 8704);
        for (int it = (C.wave - 4) * 256 + (int)blockIdx.x; it < I_MAIN; it += 1024) convert_item(args, C.ws, 1, it, scr, C.lane);
    }
}

__device__ __forceinline__ void post_phase(const Args& args, LAS unsigned char* lds_, int l) {
    const Ctx C = make_ctx(args, lds_);
    const bf16* PROJ = (const bf16*)(C.ws + WS_BIG); bf16* H = (bf16*)(C.ws + WS_H);
    const int lane = C.lane, mixer = lane >> 4, cc = (lane & 15) * 16;
    const int gbase = mixer == 0 ? C_RG : mixer == 1 ? C_AG : mixer == 2 ? C_HG : C_DG;
    const float* nw = mixer == 1 ? args.in[24] + l * 64 : mixer == 2 ? args.in[25] + l * 64 : args.in[26] + l * 64;
    float w[16];
#pragma unroll
    for (int i = 0; i < 16; ++i) w[i] = mixer == 0 ? 1.0f : nw[(cc + i) & 63];
    v4u na0, na1, ng0, ng1;
    if (C.gw < M) { const bf16* hp = H + (size_t)C.gw * D + lane * 16; const bf16* gp = PROJ + (size_t)C.gw * NINP + gbase + cc;
        na0 = *(const v4u*)hp; na1 = *(const v4u*)(hp + 8); ng0 = *(const v4u*)gp; ng1 = *(const v4u*)(gp + 8); }
#pragma unroll 1
    for (int r = C.gw; r < M; r += C.NGW) {
        bf16* hp = H + (size_t)r * D + lane * 16; const bf16* gp = PROJ + (size_t)r * NINP + gbase + cc;
        const v4u a0 = na0, a1 = na1, g0 = ng0, g1 = ng1;
        if (r + C.NGW < M) { const bf16* hn = hp + (size_t)C.NGW * D; const bf16* gn = gp + (size_t)C.NGW * NINP;
            na0 = *(const v4u*)hn; na1 = *(const v4u*)(hn + 8); ng0 = *(const v4u*)gn; ng1 = *(const v4u*)(gn + 8); }
        float y[16], g[16];
        const unsigned aw[8] = {a0.x, a0.y, a0.z, a0.w, a1.x, a1.y, a1.z, a1.w}, gw_[8] = {g0.x, g0.y, g0.z, g0.w, g1.x, g1.y, g1.z, g1.w};
        float ss = 0.f;
#pragma unroll
        for (int i = 0; i < 8; ++i) { y[2 * i] = bflo(aw[i]); y[2 * i + 1] = bfhi(aw[i]); g[2 * i] = bflo(gw_[i]); g[2 * i + 1] = bfhi(gw_[i]); ss += y[2 * i] * y[2 * i] + y[2 * i + 1] * y[2 * i + 1]; }
        ss = quad_sum(ss);
        const float rs = rsqrtf(ss * (1.0f / 64.0f) + RMS_EPS);
        unsigned ow[8];
#pragma unroll
        for (int i = 0; i < 8; ++i) ow[i] = pk2(y[2 * i] * rs * w[2 * i] * siluf_(g[2 * i]), y[2 * i + 1] * rs * w[2 * i + 1] * siluf_(g[2 * i + 1]));
        *(v4u*)hp = (v4u){ow[0], ow[1], ow[2], ow[3]}; *(v4u*)(hp + 8) = (v4u){ow[4], ow[5], ow[6], ow[7]};
    }
}

__global__ void __launch_bounds__(NWAVES * 64, 2) mega_fwd(Args args) {
    extern __shared__ __attribute__((aligned(16))) unsigned char lds[];
    cg::grid_group grid = cg::this_grid();
    LAS unsigned char* const LDSP = (LAS unsigned char*)lds;
    const int G = (int)gridDim.x, bx = (int)blockIdx.x;
    if (threadIdx.x < 64) ((LAS unsigned*)(LDSP + MISC_OFF))[threadIdx.x] = 0u;
    __syncthreads();
    (void)xcd_barrier_post((unsigned*)args.ws, (volatile LAS unsigned*)(LDSP + MISC_OFF));
#define FRESH() float* out_ = fresh_ptr(args.out); unsigned char* ws = fresh_ptr(args.ws); \
    float* MOD = (float*)(ws + WS_MOD); bf16* H = (bf16*)(ws + WS_H); bf16* BIG = (bf16*)(ws + WS_BIG); (void)MOD; (void)H; (void)BIG; (void)out_;

    p0_prologue(args, LDSP);
    grid.sync();
    {
        FRESH();
        pg8::Gemm g{(const bf16*)(ws + WS_AC), BIG, 256, 2 * NMODC, D}; pg8::StaticOrder S; S.init(256, 2 * NMODC, G, bx, D);
        pg8::EpiMod E{MOD, args.in[10]};
        pg8::gemm_phase<pg8::EpiMod, pg8::StaticOrder, PG8_ALIGN, PG8_SP2>(LDSP, g, S, E);
    }
    grid_bar(args, LDSP);
    p2_modulate0(args, LDSP);
    grid_bar(args, LDSP);
#pragma unroll 1
    for (int l = 0; l < 2; ++l) {
#pragma unroll 1
        for (int f = 0; f < 2; ++f) {
            if (f == 1) {
                {
                    FRESH();
                    pg8::Gemm g{H, (const bf16*)(ws + WS_W + (size_t)l * W_LAYER + W_WIN), M, NINP, D}; pg8::StaticOrder S; S.init(M, NINP, G, bx, D);
                    pg8::EpiPlain E{BIG, NINP};
                    pg8::gemm_phase<pg8::EpiPlain, pg8::StaticOrder, PG8_ALIGN, PG8_SP2>(LDSP, g, S, E);
                }
                grid_bar(args, LDSP);
                prep_phase(args, LDSP, l);
                grid_bar(args, LDSP);
                scan_phase(args, LDSP, l);
#ifdef PROBE_SCANMODE
                grid_bar(args, LDSP); scan_phase(args, LDSP, l, PROBE_SCANMODE);
#endif
                grid_bar(args, LDSP);
                post_phase(args, LDSP, l);
                grid_bar(args, LDSP);
                {
                    FRESH();
                    pg8::Gemm g{H, (const bf16*)(ws + WS_W + (size_t)l * W_LAYER + W_WOUT), M, D, D}; pg8::SplitOrder S; S.init(D, G, bx);
                    pg8::EpiRes E{out_, (float*)(ws + WS_SB), MOD + (size_t)l * NB * NMODC + 5 * 1024, 1.0f, D / 64};
                    pg8::gemm_phase<pg8::EpiRes, pg8::SplitOrder, PG8_ALIGN, PG8_SP2>(LDSP, g, S, E);
                }
                grid_bar(args, LDSP);
                ln_phase(args, LDSP, l, 1, true, l, 6, 4, ALPHA);
                grid_bar(args, LDSP);
            }
            {
                FRESH();
                pg8::Gemm g{H, (const bf16*)(ws + WS_W + (size_t)l * W_LAYER + (f ? W_WI2 : W_WI1)), M, NWI, D}; pg8::StaticOrder S; S.init(M, NWI, G, bx, D);
                pg8::EpiSwiglu E{BIG, DFF};
                pg8::gemm_phase<pg8::EpiSwiglu, pg8::StaticOrder, PG8_ALIGN, PG8_SP2>(LDSP, g, S, E);
            }
            grid_bar(args, LDSP);
            {
                FRESH();
                pg8::Gemm g{BIG, (const bf16*)(ws + WS_W + (size_t)l * W_LAYER + (f ? W_WO2 : W_WO1)), M, D, DFF}; pg8::SplitOrder S; S.init(DFF, G, bx);
                pg8::EpiRes E{out_, (float*)(ws + WS_SB), MOD + (size_t)l * NB * NMODC + (f ? 8 : 2) * 1024, 0.5f, DFF / 64};
                pg8::gemm_phase<pg8::EpiRes, pg8::SplitOrder, PG8_ALIGN, PG8_SP2>(LDSP, g, S, E);
            }
            grid_bar(args, LDSP);
            if (f == 0) ln_phase(args, LDSP, l, 0, true, l, 3, 11, ALPHA);
            else ln_phase(args, LDSP, l, 2, l == 0, 1, 0, 11, l == 0 ? ALPHA : 1.0f);
            if (!(l == 1 && f == 1)) grid_bar(args, LDSP);
        }
    }
}

extern "C" void kernel_launch(void* const* d_in, const int* in_sizes, int n_in, void* d_out, int out_size, void* d_ws, size_t ws_size, hipStream_t stream) {
    static int grid = 0;
    if (grid == 0) {
        if (n_in != 28 || (size_t)out_size != O_END || ws_size < WS_END) { fprintf(stderr, "kernel_launch: unexpected sizes n_in %d out %d ws %zu (need %zu)\n", n_in, out_size, ws_size, (size_t)WS_END); grid = -1; return; }
        int dev = 0, cus = 0, per_cu = 0;
        hipGetDevice(&dev); hipDeviceGetAttribute(&cus, hipDeviceAttributeMultiprocessorCount, dev);
        hipFuncSetAttribute((const void*)mega_fwd, hipFuncAttributeMaxDynamicSharedMemorySize, LDS_BYTES);
        hipOccupancyMaxActiveBlocksPerMultiprocessor(&per_cu, (const void*)mega_fwd, NWAVES * 64, LDS_BYTES);
        (void)hipGetLastError();
        if (per_cu < 1 || cus < 256) { fprintf(stderr, "kernel_launch: occupancy %d cus %d\n", per_cu, cus); grid = -1; return; }
        grid = 256;
    }
    if (grid < 0) return;
    if (hipMemsetAsync(d_ws, 0, 65536, stream) != hipSuccess) { fprintf(stderr, "memset failed\n"); return; }
    Args a{};
    for (int i = 0; i < 28; ++i) a.in[i] = (const float*)d_in[i];
    a.out = (float*)d_out; a.ws = (unsigned char*)d_ws;
    void* kargs[] = {&a};
    hipError_t e = hipLaunchCooperativeKernel((const void*)mega_fwd, dim3(grid), dim3(NWAVES * 64), kargs, LDS_BYTES, stream);
    if (e != hipSuccess) fprintf(stderr, "cooperative launch failed: %s\n", hipGetErrorString(e));
}
```

```cpp
#include <hip/hip_runtime.h>
#include <hip/hip_cooperative_groups.h>
#include <cstdio>
#include <cstdint>
namespace cg = cooperative_groups;
namespace pg8 {
#define PG8_LAS __attribute__((address_space(3)))
typedef unsigned short bf16_t;
typedef short bf16x8 __attribute__((ext_vector_type(8)));
typedef float f32x4 __attribute__((ext_vector_type(4)));
typedef unsigned u32x4 __attribute__((ext_vector_type(4)));
constexpr int BM = 256, BK = 64, HALF = 128, HTB = HALF * BK * 2  , STAGE_BYTES = 8 * HTB, NXCD = 8, WGM = 8;

__host__ __device__ __forceinline__ int lds_byte(int r, int c) { const int st = (r >> 4) * 2 + (c >> 5), rr = r & 15, cc = c & 31, ob = rr * 64 + cc * 2; return st * 1024 + (ob ^ (((ob >> 9) & 1) << 5)); }
__host__ __device__ __forceinline__ void stage_rc(int b, int& R, int& C) { const int st = b / 1024, sb = b % 1024, swz = sb ^ (((sb >> 9) & 1) << 5); R = (st >> 1) * 16 + swz / 64; C = (st & 1) * 32 + (swz % 64) / 2; }
__host__ __device__ __forceinline__ int perm32(int rho) { const int n = rho >> 4, i = rho & 15; return 8 * (i >> 2) + 4 * n + (i & 3); }

struct Unit { int pm, pn, k0, nt; };
struct Gemm { const bf16_t* A; const bf16_t* Bt; int M, N, K; };

struct StaticOrder {
    int nM, nN, nwg, G, c, ntf;
    __host__ __device__ void init(int M, int N, int G_, int c_, int K_ = 1024) { nM = M / BM; nN = N / BM; nwg = nM * nN; G = G_; c = c_; ntf = K_ / BK; }
    __host__ __device__ bool next(int i, Unit& u) const {
        const long L = (long)i * G + c; if (L >= nwg) return false;
        int wgid = (int)L; { const int q = nwg / NXCD, r = nwg % NXCD, xcd = wgid % NXCD, off = wgid / NXCD; wgid = (xcd < r ? xcd * (q + 1) : r * (q + 1) + (xcd - r) * q) + off; }
        const int nig = WGM * nN, gid = wgid / nig, fm = gid * WGM, gsz = (nM - fm) < WGM ? (nM - fm) : WGM;
        u.pm = fm + ((wgid % nig) % gsz); u.pn = (wgid % nig) / gsz; u.k0 = 0; u.nt = ntf; return true;
    }
    __device__ __forceinline__ void a_ready(const Unit&) const {}
    __device__ __forceinline__ void done(const Unit&) const {}
};

struct SplitOrder {
    StaticOrder base; int ppu, c;
    static constexpr int PK = 4;
    __host__ __device__ void init(int K_, int G_, int c_) { base.init(16384, 1024, G_, c_, K_); ppu = (K_ / BK) / PK; c = c_; }
    __host__ __device__ bool next(int i, Unit& u) const {
        if (i == 0) return base.next(0, u);
        if (i == 1 && c < 8 * ppu) { const int j = c / ppu, p = c - j * ppu; u.pm = 64 + (j >> 2); u.pn = j & 3; u.k0 = p * PK; u.nt = PK; return true; }
        return false;
    }
    __device__ __forceinline__ void a_ready(const Unit&) const {}
    __device__ __forceinline__ void done(const Unit&) const {}
};

__device__ __forceinline__ unsigned cvt_pk_bf16(float lo, float hi) { unsigned r; asm volatile("v_cvt_pk_bf16_f32 %0, %1, %2" : "=v"(r) : "v"(lo), "v"(hi)); return r; }
typedef float f32x2 __attribute__((ext_vector_type(2)));
__device__ __forceinline__ f32x2 gelu_pk(f32x2 v) {
    const f32x2 av = __builtin_elementwise_abs(v), d = av * 0.2316418882f + 1.0f;
    f32x2 t; t.x = __builtin_amdgcn_rcpf(d.x); t.y = __builtin_amdgcn_rcpf(d.y);
    f32x2 q = t * 0.5307027145f + (-0.7265760135f); q = q * t + 0.7107068705f; q = q * t + (-0.142248368f); q = q * t + 0.127414796f; q = q * t;
    const f32x2 s = (v * v) * (-0.72134752044f);
    f32x2 e; e.x = __builtin_amdgcn_exp2f(s.x); e.y = __builtin_amdgcn_exp2f(s.y);
    const f32x2 m = v * (q * e), r = v - m;
    f32x2 o; o.x = v.x < 0.f ? m.x : r.x; o.y = v.y < 0.f ? m.y : r.y; return o;
}

template <int ACT  > struct EpiBf16 {
    static constexpr bool PERM = true, AFTER_DRAIN = false; static_assert(ACT == 0 || ACT == 1, "EpiBf16: ACT is 0 (none) or 1 (gelu_pk)");
    bf16_t* O; int ldc; const float* bias; int split_cols; size_t split_stride; float scale0;
    __device__ __forceinline__ void operator()(const f32x4 (&acc)[2][2][4][2], const Unit& u, int wr, int wc, int fr, int fq) const {
        const int row0 = u.pm * BM + wr * 64 + fr; int colt = u.pn * BM; bf16_t* base = O;
        float sc = 1.f; if (split_cols) { const int t = colt / split_cols; base += (size_t)t * split_stride; colt -= t * split_cols; if (t == 0) sc = scale0; }
        const int col0 = colt + wc * 32 + 8 * fq, bcol0 = u.pn * BM + wc * 32 + 8 * fq;
        f32x4 bv[2][2];
#pragma unroll
        for (int bj = 0; bj < 2; ++bj)
#pragma unroll
            for (int n = 0; n < 2; ++n) bv[bj][n] = bias ? *(const f32x4*)(bias + bcol0 + bj * HALF + 4 * n) : (f32x4){0.f, 0.f, 0.f, 0.f};
#pragma unroll
        for (int ai = 0; ai < 2; ++ai)
#pragma unroll
            for (int m = 0; m < 4; ++m) { bf16_t* rowp = base + (size_t)(row0 + ai * HALF + m * 16) * ldc + col0;
#pragma unroll
                for (int bj = 0; bj < 2; ++bj) { f32x4 v0 = acc[ai][bj][m][0] + bv[bj][0], v1 = acc[ai][bj][m][1] + bv[bj][1];
                    if (ACT == 1) { f32x2 a = gelu_pk((f32x2){v0[0], v0[1]}), b = gelu_pk((f32x2){v0[2], v0[3]}), c = gelu_pk((f32x2){v1[0], v1[1]}), d = gelu_pk((f32x2){v1[2], v1[3]});
                        v0 = (f32x4){a.x, a.y, b.x, b.y}; v1 = (f32x4){c.x, c.y, d.x, d.y}; }
                    v0 = v0 * sc; v1 = v1 * sc; u32x4 w; w.x = cvt_pk_bf16(v0[0], v0[1]); w.y = cvt_pk_bf16(v0[2], v0[3]); w.z = cvt_pk_bf16(v1[0], v1[1]); w.w = cvt_pk_bf16(v1[2], v1[3]);
                    *(u32x4*)(rowp + bj * HALF) = w; } }
    }
};
template <class Epi, class Sched, bool ALIGN_EPI = false, bool SP2 = false>
__device__ __forceinline__ void gemm_phase(PG8_LAS unsigned char* lds, const Gemm g, const Sched& S, const Epi& E) {
    int tid_ = threadIdx.x; asm volatile("" : "+v"(tid_));
    const int tid = tid_, wid = __builtin_amdgcn_readfirstlane(tid >> 6), lane = tid & 63, wr = wid >> 2, wc = wid & 3, fr = lane & 15, fq = lane >> 4;
    const int K = g.K;
    unsigned voffA[2], voffB[2];
#pragma unroll
    for (int i = 0; i < 2; ++i) { int R, C; stage_rc(tid * 16 + i * 8192, R, C); const int Rb = Epi::PERM ? ((R & ~31) + perm32(R & 31)) : R;
        voffA[i] = (unsigned)(R * K + C) * 2u; voffB[i] = (unsigned)(Rb * K + C) * 2u; }
    const size_t kstep = (size_t)(BK * 2);
    const size_t hstep = (size_t)HALF * K * 2;
    const size_t tstep = 2 * hstep;
    const unsigned ldsw = (unsigned)wid * 1024u;
    const int aoff = lds_byte(wr * 64 + fr, fq * 8), boff = lds_byte(wc * 32 + fr, fq * 8);
#define PG8_SA(b, h) (((b) * 2 + (h)) * HTB)
#define PG8_SB(b, h) ((4 + (b) * 2 + (h)) * HTB)
#define PG8_STAGE(bufoff, gbase, voff) do { _Pragma("unroll") for (int _i = 0; _i < 2; ++_i) \
        __builtin_amdgcn_global_load_lds((const unsigned*)((const char*)(gbase) + (voff)[_i]), (PG8_LAS unsigned*)(lds + (bufoff) + ldsw + _i * 8192), 16, 0, 0); } while (0)
#define PG8_LDA(dst, b, h) do { _Pragma("unroll") for (int m = 0; m < 4; ++m) _Pragma("unroll") for (int k = 0; k < 2; ++k) dst[m][k] = *(const PG8_LAS bf16x8*)(lds + PG8_SA(b, h) + aoff + m * 2048 + k * 1024); } while (0)
#define PG8_LDB(dst, b, h) do { _Pragma("unroll") for (int n = 0; n < 2; ++n) _Pragma("unroll") for (int k = 0; k < 2; ++k) dst[n][k] = *(const PG8_LAS bf16x8*)(lds + PG8_SB(b, h) + boff + n * 2048 + k * 1024); } while (0)
#define PG8_MMA(ai, bj, At, Bt) do { __builtin_amdgcn_s_setprio(1); _Pragma("unroll") for (int m = 0; m < 4; ++m) _Pragma("unroll") for (int n = 0; n < 2; ++n) _Pragma("unroll") for (int k = 0; k < 2; ++k) \
        acc[ai][bj][m][n] = __builtin_amdgcn_mfma_f32_16x16x32_bf16(Bt[n][k], At[m][k], acc[ai][bj][m][n], 0, 0, 0); __builtin_amdgcn_s_setprio(0); } while (0)
#define PG8_WAIT_V(n) asm volatile("s_waitcnt vmcnt(" #n ")" ::: "memory")
#define PG8_WAIT_L(n) asm volatile("s_waitcnt lgkmcnt(" #n ")" ::: "memory")
#define PG8_BAR __builtin_amdgcn_s_barrier()
#define PG8_SCHED __builtin_amdgcn_sched_barrier(0)
    Unit cur, nxt; int ui = 0;
    if (!S.next(0, cur)) return;
    f32x4 acc[2][2][4][2];
#pragma unroll
    for (int a = 0; a < 2; ++a)
#pragma unroll
        for (int b = 0; b < 2; ++b)
#pragma unroll
            for (int m = 0; m < 4; ++m)
#pragma unroll
                for (int n = 0; n < 2; ++n) acc[a][b][m][n] = (f32x4){0.f, 0.f, 0.f, 0.f};
    bf16x8 At[4][2], B0[2][2], B1[2][2];
    const char* cA = (const char*)g.A + (size_t)cur.pm * tstep + (size_t)cur.k0 * kstep; const char* cB = (const char*)g.Bt + (size_t)cur.pn * tstep + (size_t)cur.k0 * kstep;
    S.a_ready(cur);
    if constexpr (SP2) {
        PG8_STAGE(PG8_SB(0, 0), cB, voffB); PG8_STAGE(PG8_SB(0, 1), cB + hstep, voffB); PG8_STAGE(PG8_SA(0, 0), cA, voffA); PG8_STAGE(PG8_SA(0, 1), cA + hstep, voffA);
        if (wr == 1) PG8_BAR;
        PG8_WAIT_V(2); PG8_BAR;
        PG8_STAGE(PG8_SB(1, 0), cB + kstep, voffB); PG8_STAGE(PG8_SA(1, 0), cA + kstep, voffA); PG8_STAGE(PG8_SB(1, 1), cB + hstep + kstep, voffB);
        PG8_WAIT_V(6); PG8_BAR;
    } else {
        PG8_STAGE(PG8_SB(0, 0), cB, voffB); PG8_STAGE(PG8_SA(0, 0), cA, voffA); PG8_STAGE(PG8_SB(0, 1), cB + hstep, voffB); PG8_STAGE(PG8_SA(0, 1), cA + hstep, voffA);
        if (wr == 1) PG8_BAR;
        PG8_WAIT_V(4); PG8_BAR;
        PG8_STAGE(PG8_SB(1, 0), cB + kstep, voffB); PG8_STAGE(PG8_SA(1, 0), cA + kstep, voffA); PG8_STAGE(PG8_SB(1, 1), cB + hstep + kstep, voffB);
        PG8_WAIT_V(6); PG8_BAR;
    }
    for (;;) {
        const bool has_next = S.next(ui + 1, nxt);
        const char* nA = has_next ? (const char*)g.A + (size_t)nxt.pm * tstep + (size_t)nxt.k0 * kstep : cA; const char* nB = has_next ? (const char*)g.Bt + (size_t)nxt.pn * tstep + (size_t)nxt.k0 * kstep : cB;
        const int nt = cur.nt;
        for (int t = 0; t < nt; t += 2) {
            const bool last = (t == nt - 2);
            const char* a1 = cA + (size_t)(t + 1) * kstep;
            const char* a2 = last ? nA : cA + (size_t)(t + 2) * kstep; const char* b2 = last ? nB : cB + (size_t)(t + 2) * kstep;
            const char* a3 = a2 + kstep; const char* b3 = b2 + kstep;
            if (last && has_next) S.a_ready(nxt);
            if constexpr (SP2) {
            PG8_LDB(B0, 0, 0); PG8_LDB(B1, 0, 1); PG8_SCHED; PG8_LDA(At, 0, 0); PG8_STAGE(PG8_SA(1, 1), a1 + hstep, voffA);
            PG8_WAIT_V(8); PG8_WAIT_L(0); PG8_BAR; PG8_MMA(0, 0, At, B0); PG8_MMA(0, 1, At, B1); PG8_BAR; PG8_SCHED;
            PG8_LDA(At, 0, 1); PG8_STAGE(PG8_SB(0, 0), b2, voffB); PG8_STAGE(PG8_SB(0, 1), b2 + hstep, voffB); PG8_STAGE(PG8_SA(0, 0), a2, voffA);
            PG8_WAIT_V(8); PG8_WAIT_L(0); PG8_BAR; PG8_MMA(1, 0, At, B0); PG8_MMA(1, 1, At, B1); PG8_BAR; PG8_SCHED;
            PG8_LDB(B0, 1, 0); PG8_LDB(B1, 1, 1); PG8_SCHED; PG8_LDA(At, 1, 0); PG8_STAGE(PG8_SA(0, 1), a2 + hstep, voffA);
            PG8_WAIT_V(8); PG8_WAIT_L(0); PG8_BAR; PG8_MMA(0, 0, At, B0); PG8_MMA(0, 1, At, B1); PG8_BAR; PG8_SCHED;
            PG8_LDA(At, 1, 1); PG8_STAGE(PG8_SB(1, 0), b3, voffB); PG8_STAGE(PG8_SB(1, 1), b3 + hstep, voffB); PG8_STAGE(PG8_SA(1, 0), a3, voffA);
            PG8_WAIT_V(8); PG8_WAIT_L(0); PG8_BAR; PG8_MMA(1, 0, At, B0); PG8_MMA(1, 1, At, B1); PG8_BAR; PG8_SCHED;
            } else {
            PG8_LDB(B0, 0, 0); PG8_SCHED; PG8_LDA(At, 0, 0); PG8_STAGE(PG8_SA(1, 1), a1 + hstep, voffA);
            PG8_WAIT_L(8); PG8_BAR; PG8_WAIT_L(0); PG8_MMA(0, 0, At, B0); PG8_BAR; PG8_SCHED;
            PG8_LDB(B1, 0, 1); PG8_STAGE(PG8_SB(0, 0), b2, voffB);
            PG8_BAR; PG8_WAIT_L(0); PG8_MMA(0, 1, At, B1); PG8_BAR;
            PG8_LDA(At, 0, 1); PG8_STAGE(PG8_SA(0, 0), a2, voffA);
            PG8_BAR; PG8_WAIT_L(0); PG8_MMA(1, 0, At, B0); PG8_BAR; PG8_SCHED;
            PG8_STAGE(PG8_SB(0, 1), b2 + hstep, voffB);
            PG8_WAIT_V(6); PG8_BAR; PG8_MMA(1, 1, At, B1); PG8_BAR;
            PG8_LDB(B0, 1, 0); PG8_SCHED; PG8_LDA(At, 1, 0); PG8_STAGE(PG8_SA(0, 1), a2 + hstep, voffA);
            PG8_WAIT_L(8); PG8_BAR; PG8_WAIT_L(0); PG8_MMA(0, 0, At, B0); PG8_BAR; PG8_SCHED;
            PG8_LDB(B1, 1, 1); PG8_STAGE(PG8_SB(1, 0), b3, voffB);
            PG8_BAR; PG8_WAIT_L(0); PG8_MMA(0, 1, At, B1); PG8_BAR;
            PG8_LDA(At, 1, 1); PG8_STAGE(PG8_SA(1, 0), a3, voffA);
            PG8_BAR; PG8_WAIT_L(0); PG8_MMA(1, 0, At, B0); PG8_BAR; PG8_SCHED;
            PG8_STAGE(PG8_SB(1, 1), b3 + hstep, voffB);
            PG8_WAIT_V(6); PG8_BAR; PG8_MMA(1, 1, At, B1); PG8_BAR;
            }
        }
        if constexpr (ALIGN_EPI) { if (wr == 0) PG8_BAR; }
        if constexpr (!Epi::AFTER_DRAIN) { E(acc, cur, wr, wc, fr, fq); S.done(cur); }
        if (!has_next) break;
#pragma unroll
        for (int a = 0; a < 2; ++a)
#pragma unroll
            for (int b = 0; b < 2; ++b)
#pragma unroll
                for (int m = 0; m < 4; ++m)
#pragma unroll
                    for (int n = 0; n < 2; ++n) acc[a][b][m][n] = (f32x4){0.f, 0.f, 0.f, 0.f};
        cur = nxt; cA = nA; cB = nB; ++ui;
        if constexpr (ALIGN_EPI) { if (wr == 1) PG8_BAR; }
    }
    PG8_WAIT_V(0);
    if constexpr (!ALIGN_EPI) { if (wr == 0) PG8_BAR; }
    PG8_BAR;
    if constexpr (Epi::AFTER_DRAIN) { E.fused(acc, cur, wr, wc, fr, fq, lds, wid, lane); S.done(cur); }
#undef PG8_SA
#undef PG8_SB
#undef PG8_STAGE
#undef PG8_LDA
#undef PG8_LDB
#undef PG8_MMA
#undef PG8_WAIT_V
#undef PG8_WAIT_L
#undef PG8_BAR
#undef PG8_SCHED
}
}
#define PG8_SP2 true
#define PG8_ALIGN true

constexpr int D = 1024, TP = 2048, BP = 8, BS = 128, TS = 4;
constexpr int MP = BP * TP, MS = BS * TS, M = MP + MS;
constexpr int DFF = 2816, NWI = 2 * DFF, NIN = 3864, NINP = 4096, NMODC = 9216, NB = BP + BS;
constexpr int SBW = 1664, SFW = 396;
constexpr float LN_EPS = 1e-5f, RMS_EPS = 1e-6f;
constexpr float ALPHA = 1.41421356237f;
constexpr int C_RQ = 0, C_RK = 256, C_RV = 512, C_RG = 768, C_AQ = 1024, C_AK = 1152, C_AV = 1280, C_ALR = 1536, C_AG = 1552,
              C_HQ = 1808, C_HF = 2064, C_HI = 2320, C_HG = 2576, C_DQKV = 2832, C_DB = 3600, C_DA = 3604, C_DG = 3608;
constexpr int SB_RQ = 0, SB_RK = 256, SB_AQ = 512, SB_HQ = 640, SB_DQ = 896, SB_DK = 1152, SB_DV = 1408;
constexpr int SF_ADEC = 0, SF_HF = 128, SF_BETA = 384, SF_DDEC = 388, SF_QK = 392;
constexpr size_t O_Y = 0;
constexpr size_t O_PRET = (size_t)M * D;
constexpr size_t O_PGLA = O_PRET + 2ull * BP * 4 * 64 * 64;
constexpr size_t O_PHG = O_PGLA + 2ull * BP * 4 * 32 * 64;
constexpr size_t O_PGDN = O_PHG + 2ull * BP * 4 * 64 * 64;
constexpr size_t O_PCONV = O_PGDN + 2ull * BP * 4 * 64 * 64;
constexpr size_t O_SRET = O_PCONV + 2ull * BP * 3 * 768;
constexpr size_t O_SGLA = O_SRET + 2ull * BS * 4 * 64 * 64;
constexpr size_t O_SHG = O_SGLA + 2ull * BS * 4 * 32 * 64;
constexpr size_t O_SGDN = O_SHG + 2ull * BS * 4 * 64 * 64;
constexpr size_t O_SCONV = O_SGDN + 2ull * BS * 4 * 64 * 64;
constexpr size_t O_END = O_SCONV + 2ull * BS * 3 * 768;

constexpr size_t MiB = 1u << 20;
constexpr size_t WS_ROPE = 1 * MiB;
constexpr size_t WS_AC = 2 * MiB;
constexpr size_t WS_MOD = 3 * MiB;
constexpr size_t WS_W = 13 * MiB;
constexpr size_t W_WI1 = 0, W_WO1 = 11 * MiB, W_WI2 = W_WO1 + 5 * MiB + MiB / 2, W_WO2 = W_WI2 + 11 * MiB, W_WIN = W_WO2 + 5 * MiB + MiB / 2, W_WOUT = W_WIN + 8 * MiB, W_LAYER = 43 * MiB;
constexpr size_t WS_H = WS_W + 2 * W_LAYER;
constexpr size_t WS_BIG = WS_H + 33 * MiB;
constexpr size_t WS_SB = WS_BIG + 132 * MiB;
constexpr size_t WS_SF = WS_SB + 54 * MiB;
constexpr size_t WS_END = WS_SF + 26 * MiB;
static_assert((size_t)M * SBW * 2 <= 54 * MiB && (size_t)M * SFW * 4 <= 26 * MiB && (size_t)M * 4096 * 2 <= 132 * MiB && (size_t)M * D * 2 <= 33 * MiB, "ws map");

constexpr int LDS_BYTES = 147456;
constexpr int NWAVES = 8;

#define GAS __attribute__((address_space(1)))
#define LAS __attribute__((address_space(3)))
typedef unsigned short bf16;
typedef unsigned v4u __attribute__((ext_vector_type(4)));
typedef unsigned v2u __attribute__((ext_vector_type(2)));
typedef float f32x4 __attribute__((ext_vector_type(4)));
typedef float f32x2 __attribute__((ext_vector_type(2)));
#define LDS_WAIT() asm volatile("s_waitcnt lgkmcnt(0)" ::: "memory")

__device__ __forceinline__ float bf2f(unsigned b) { return __uint_as_float(b << 16); }
__device__ __forceinline__ float bflo(unsigned w) { return __uint_as_float(w << 16); }
__device__ __forceinline__ float bfhi(unsigned w) { return __uint_as_float(w & 0xffff0000u); }
__device__ __forceinline__ unsigned pk2(float lo, float hi) { return pg8::cvt_pk_bf16(lo, hi); }
__device__ __forceinline__ float sigmoidf_(float x) { return 1.0f / (1.0f + __expf(-x)); }
__device__ __forceinline__ float siluf_(float x) { return x / (1.0f + __expf(-x)); }
__device__ __forceinline__ float wave_sum(float v) {
#pragma unroll
    for (int o = 1; o < 64; o <<= 1) v += __shfl_xor(v, o);
    return v;
}
template <int CTRL> __device__ __forceinline__ float dppmov(float v) { return __int_as_float(__builtin_amdgcn_update_dpp(0, __float_as_int(v), CTRL, 0xf, 0xf, true)); }
__device__ __forceinline__ float quad_sum(float v) { v += dppmov<0xB1>(v); v += dppmov<0x4E>(v); return v; }
__device__ __forceinline__ float row8_sum(float v) { v += dppmov<0xB1>(v); v += dppmov<0x4E>(v); v += dppmov<0x141>(v); return v; }
__device__ __forceinline__ float row16_sum(float v) { v += dppmov<0xB1>(v); v += dppmov<0x4E>(v); v += dppmov<0x141>(v); v += dppmov<0x140>(v); return v; }

struct Args { const float* in[28]; float* out; unsigned char* ws; };

struct Ctx {
    int tid, lane, wave, gw, NGW;
    LAS unsigned char* lds;
    float* out; unsigned char* ws;
};
template <class T> __device__ __forceinline__ T* fresh_ptr(T* p) {
    unsigned lo = (unsigned)(uintptr_t)p, hi = (unsigned)((uintptr_t)p >> 32);
    asm volatile("" : "+v"(lo), "+v"(hi));
    lo = __builtin_amdgcn_readfirstlane(lo); hi = __builtin_amdgcn_readfirstlane(hi);
    return (T*)(__attribute__((address_space(1))) T*)(((uintptr_t)hi << 32) | (uintptr_t)lo);
}
__device__ __forceinline__ Ctx make_ctx(const Args& args, LAS unsigned char* lds) {
    Ctx C; int t = threadIdx.x; asm volatile("" : "+v"(t));
    C.tid = t; C.lane = t & 63; C.wave = __builtin_amdgcn_readfirstlane(t >> 6);
    C.gw = (int)blockIdx.x * NWAVES + C.wave; C.NGW = (int)gridDim.x * NWAVES;
    float* op = fresh_ptr(args.out); unsigned char* wp = fresh_ptr(args.ws);
    C.lds = lds; C.out = op; C.ws = wp; return C;
}
__device__ __forceinline__ int batch_of_row(int r) { return r < MP ? (r >> 11) : BP + ((r - MP) >> 2); }


typedef GAS unsigned gu32;
#define RLX_AGENT __ATOMIC_RELAXED, __HIP_MEMORY_SCOPE_AGENT
#define XB_TMO      128
#define XB_XCNT(j)  (256  + 64 * (j))
#define XB_XSUB(j)  (1280 + 64 * (j))
#define XB_XGEN(j)  (2304 + 64 * (j))
#define XB_TOP      3328
#define XB_TOPGEN   3392
#define XCD_BAR_WORDS 3456
#define XB_SPIN_CAP (1u << 18)

__device__ __forceinline__ unsigned xb_ld(unsigned* p)              { return __hip_atomic_load(p, __ATOMIC_RELAXED, __HIP_MEMORY_SCOPE_AGENT); }
__device__ __forceinline__ unsigned xb_add(unsigned* p, unsigned v) { return __hip_atomic_fetch_add(p, v, __ATOMIC_RELAXED, __HIP_MEMORY_SCOPE_AGENT); }
__device__ __forceinline__ unsigned xb_xcc_id() { return (unsigned)__builtin_amdgcn_s_getreg((3 << 11) | 20) & 0xFu; }
#define XB_SPIN(cond, bar) do { unsigned _sp = 0; while (cond) { __builtin_amdgcn_s_sleep(1); \
    if ((++_sp & 255u) == 0u) { if (xb_ld(&(bar)[XB_TMO])) break; if (_sp > XB_SPIN_CAP) { atomicAdd(&(bar)[XB_TMO], 1u); break; } } } } while (0)

struct XcdBarrier {
    unsigned* bar; unsigned x;
    volatile LAS unsigned* st;
};

__device__ __forceinline__ XcdBarrier xcd_barrier_post(unsigned* bar, volatile LAS unsigned* st) {
    XcdBarrier b; b.bar = bar; b.x = xb_xcc_id(); b.st = st;
    if (threadIdx.x == 0) (void)xb_add(&bar[XB_XCNT(b.x)], 1u);
    return b;
}
__device__ __forceinline__ void xcd_barrier_complete(unsigned* bar, unsigned x, unsigned& nloc, unsigned& nx) {
    const unsigned G = gridDim.x * gridDim.y * gridDim.z;
    unsigned sum, cnt, mine, sp = 0u;
    for (;;) {
        sum = 0u; cnt = 0u; mine = 0u;
#pragma unroll
        for (unsigned j = 0; j < 16; ++j) { const unsigned c = xb_ld(&bar[XB_XCNT(j)]); sum += c; cnt += (c > 0u) ? 1u : 0u; mine = (j == x) ? c : mine; }
        if (sum == G) break;
        __builtin_amdgcn_s_sleep(1);
        if ((++sp & 255u) == 0u) { if (xb_ld(&bar[XB_TMO])) break; if (sp > XB_SPIN_CAP) { atomicAdd(&bar[XB_TMO], 1u); break; } }
    }
    nloc = mine > 0u ? mine : 1u; nx = cnt > 0u ? cnt : 1u;
}

__device__ __forceinline__ void xcd_barrier(const XcdBarrier& b) {
    asm volatile("s_waitcnt vmcnt(0)" ::: "memory");
    __syncthreads();
    if (threadIdx.x == 0) {
        unsigned* bar = b.bar;
        __builtin_amdgcn_s_waitcnt(0);
        unsigned nloc = b.st[0], nx = b.st[1];
        if (nloc == 0u) { xcd_barrier_complete(bar, b.x, nloc, nx); b.st[0] = nloc; b.st[1] = nx; }
        const unsigned old = xb_add(&bar[XB_XSUB(b.x)], 1u);
        const unsigned gen = old / nloc;
        if (old + 1u == (gen + 1u) * nloc) {
            __builtin_amdgcn_fence(__ATOMIC_RELEASE, "agent");
            asm volatile("s_waitcnt vmcnt(0)" ::: "memory");
            const unsigned og = xb_add(&bar[XB_TOP], 1u);
            const unsigned tg = og / nx;
            if (og + 1u == (tg + 1u) * nx) xb_add(&bar[XB_TOPGEN], 1u);
            else XB_SPIN(xb_ld(&bar[XB_TOPGEN]) == tg, bar);
            __builtin_amdgcn_fence(__ATOMIC_ACQUIRE, "agent");
            xb_add(&bar[XB_XGEN(b.x)], 1u);
            asm volatile("s_waitcnt vmcnt(0)" ::: "memory");
        } else {
            XB_SPIN(xb_ld(&bar[XB_XGEN(b.x)]) == gen, bar);
            __builtin_amdgcn_fence(__ATOMIC_ACQUIRE, "agent");
            asm volatile("s_waitcnt vmcnt(0)" ::: "memory");
        }
    }
    __syncthreads();
}

constexpr int MISC_OFF = LDS_BYTES - 256;
__device__ __forceinline__ void grid_bar(const Args& args, LAS unsigned char* lds) {
    XcdBarrier b; b.bar = (unsigned*)fresh_ptr(args.ws); b.x = xb_xcc_id(); b.st = (volatile LAS unsigned*)(lds + MISC_OFF);
    xcd_barrier(b);
}

__device__ __forceinline__ float wave_sum2(float v) { v = row16_sum(v); v += __shfl_xor(v, 16); v += __shfl_xor(v, 32); return v; }

namespace pg8 {
struct EpiSwiglu {
    static constexpr bool PERM = true, AFTER_DRAIN = false;
    bf16_t* O; int ldc;
    __device__ __forceinline__ void operator()(const f32x4 (&acc)[2][2][4][2], const Unit& u, int wr, int wc, int fr, int fq) const {
        const int row0 = u.pm * BM + wr * 64 + fr, col0 = u.pn * 128 + wc * 32 + 8 * fq;
#pragma unroll
        for (int ai = 0; ai < 2; ++ai)
#pragma unroll
            for (int m = 0; m < 4; ++m) {
                bf16_t* rowp = O + (size_t)(row0 + ai * HALF + m * 16) * ldc + col0;
                float h[8];
#pragma unroll
                for (int n = 0; n < 2; ++n)
#pragma unroll
                    for (int j = 0; j < 4; ++j) {
                        const float a = acc[ai][0][m][n][j], b = acc[ai][1][m][n][j];
                        const float e = __builtin_amdgcn_exp2f(-1.44269504f * a);
                        h[n * 4 + j] = a * __builtin_amdgcn_rcpf(1.0f + e) * b;
                    }
                u32x4 w; w.x = cvt_pk_bf16(h[0], h[1]); w.y = cvt_pk_bf16(h[2], h[3]); w.z = cvt_pk_bf16(h[4], h[5]); w.w = cvt_pk_bf16(h[6], h[7]);
                *(u32x4*)rowp = w;
            }
    }
};
struct EpiPlain {
    static constexpr bool PERM = true, AFTER_DRAIN = false;
    bf16_t* O; int ldc;
    __device__ __forceinline__ void operator()(const f32x4 (&acc)[2][2][4][2], const Unit& u, int wr, int wc, int fr, int fq) const {
        const int row0 = u.pm * BM + wr * 64 + fr, col0 = u.pn * BM + wc * 32 + 8 * fq;
#pragma unroll
        for (int ai = 0; ai < 2; ++ai)
#pragma unroll
            for (int m = 0; m < 4; ++m) {
                bf16_t* rowp = O + (size_t)(row0 + ai * HALF + m * 16) * ldc + col0;
#pragma unroll
                for (int bj = 0; bj < 2; ++bj) { const f32x4 v0 = acc[ai][bj][m][0], v1 = acc[ai][bj][m][1];
                    u32x4 w; w.x = cvt_pk_bf16(v0[0], v0[1]); w.y = cvt_pk_bf16(v0[2], v0[3]); w.z = cvt_pk_bf16(v1[0], v1[1]); w.w = cvt_pk_bf16(v1[2], v1[3]);
                    *(u32x4*)(rowp + bj * HALF) = w; }
            }
    }
};
struct EpiRes {
    static constexpr bool PERM = false, AFTER_DRAIN = false;
    float* X; float* PART; const float* gate; float scale; int ntf;
    __device__ __forceinline__ void operator()(const f32x4 (&acc)[2][2][4][2], const Unit& u, int wr, int wc, int fr, int fq) const {
        const int col0 = u.pn * BM + wc * 32 + 4 * fq;
        const bool full = (u.nt == ntf);
        float* pbase = PART + (size_t)(u.k0 / SplitOrder::PK) * (512 * 1024);
#pragma unroll
        for (int ai = 0; ai < 2; ++ai)
#pragma unroll
            for (int m = 0; m < 4; ++m) {
                const int r = u.pm * BM + ai * HALF + wr * 64 + m * 16 + fr;
                const int bi = r < 16384 ? (r >> 11) : 8 + ((r - 16384) >> 2);
                const float* gp = gate + (size_t)bi * 9216;
                float* xo = full ? X + (size_t)r * 1024 : pbase + (size_t)(r - 16384) * 1024;
#pragma unroll
                for (int bj = 0; bj < 2; ++bj)
#pragma unroll
                    for (int n = 0; n < 2; ++n) {
                        const int c = col0 + bj * HALF + n * 16;
                        const f32x4 gv = *(const f32x4*)(gp + c);
                        f32x4 o = (gv * scale + scale) * acc[ai][bj][m][n];
                        if (full) o += *(const f32x4*)(xo + c);
                        *(f32x4*)(xo + c) = o;
                    }
                asm volatile("" ::: "memory");
            }
    }
};
struct EpiMod {
    static constexpr bool PERM = false, AFTER_DRAIN = false;
    float* MODp; const float* ada_b;
    __device__ __forceinline__ void operator()(const f32x4 (&acc)[2][2][4][2], const Unit& u, int wr, int wc, int fr, int fq) const {
        const int col0 = u.pn * BM + wc * 32 + 4 * fq;
        const int l = (u.pn * BM) / 9216;
#pragma unroll
        for (int ai = 0; ai < 2; ++ai)
#pragma unroll
            for (int m = 0; m < 4; ++m) {
                const int r = u.pm * BM + ai * HALF + wr * 64 + m * 16 + fr;
                if (r < 136) {
#pragma unroll
                    for (int bj = 0; bj < 2; ++bj)
#pragma unroll
                        for (int n = 0; n < 2; ++n) {
                            const int c = col0 + bj * HALF + n * 16;
                            const f32x4 o = acc[ai][bj][m][n] + *(const f32x4*)(ada_b + c);
                            *(f32x4*)(MODp + (size_t)(l * 136 + r) * 9216 + (c - l * 9216)) = o;
                        }
                }
            }
    }
};
}

__device__ __forceinline__ void transpose_item(const float* W, int K, int N, bf16* WT, int dest_row0, LAS float* scr, int k0, int n0, int lane) {
    const int nn = n0 + (lane & 31); const bool ok = nn < N;
    float tv[32];
#pragma unroll
    for (int i = 0; i < 32; ++i) { const int kk = 2 * i + (lane >> 5); tv[i] = ok ? W[(size_t)(k0 + kk) * N + nn] : 0.f; }
#pragma unroll
    for (int i = 0; i < 32; ++i) { const int kk = 2 * i + (lane >> 5); scr[kk * 33 + (lane & 31)] = tv[i]; }
    LDS_WAIT();
    const int c = lane & 7;
#pragma unroll
    for (int j = 0; j < 4; ++j) { const int n = (lane >> 3) + 8 * j; const LAS float* s = scr + (8 * c) * 33 + n;
        v4u o; o.x = pk2(s[0 * 33], s[1 * 33]); o.y = pk2(s[2 * 33], s[3 * 33]); o.z = pk2(s[4 * 33], s[5 * 33]); o.w = pk2(s[6 * 33], s[7 * 33]);
        *(v4u*)(WT + (size_t)(dest_row0 + n) * K + k0 + 8 * c) = o; }
    LDS_WAIT();
}

constexpr int I_WI = 16 * 176, I_WO = 44 * 32, I_WIN = 16 * 121, I_WOUT = 16 * 32, I_ADA = 16 * 288;
constexpr int I_MAIN = 2 * I_WI + 2 * I_WO + I_WIN + I_WOUT, I_LAYER = I_MAIN + I_ADA;
__device__ __forceinline__ void convert_item(const Args& args, unsigned char* ws, int l, int r, LAS float* scr, int lane) {
    unsigned char* wl = ws + WS_W + (size_t)l * W_LAYER;
    if (r < 2 * (I_WI + I_WO)) {
        const int f = r / (I_WI + I_WO); r -= f * (I_WI + I_WO);
        if (r < I_WI) {
            const int kb = r / 176, nb = r % 176, n0 = nb * 32;
            const int half = n0 / DFF, j = n0 - half * DFF, t = j >> 7, jj = j & 127;
            transpose_item((f ? args.in[15] : args.in[13]) + (size_t)l * D * NWI, D, NWI, (bf16*)(wl + (f ? W_WI2 : W_WI1)), 256 * t + 128 * half + jj, scr, kb * 64, n0, lane);
        } else { r -= I_WI;
            const int kb = r / 32, nb = r % 32;
            transpose_item((f ? args.in[16] : args.in[14]) + (size_t)l * DFF * D, DFF, D, (bf16*)(wl + (f ? W_WO2 : W_WO1)), nb * 32, scr, kb * 64, nb * 32, lane);
        }
        return;
    }
    r -= 2 * (I_WI + I_WO);
    if (r < I_WIN) { const int kb = r / 121, nb = r % 121;
        transpose_item(args.in[17] + (size_t)l * D * NIN, D, NIN, (bf16*)(wl + W_WIN), nb * 32, scr, kb * 64, nb * 32, lane); return; }
    r -= I_WIN;
    if (r < I_WOUT) { const int kb = r / 32, nb = r % 32;
        transpose_item(args.in[27] + (size_t)l * D * D, D, D, (bf16*)(wl + W_WOUT), nb * 32, scr, kb * 64, nb * 32, lane); return; }
    r -= I_WOUT;
    { const int kb = r / 288, nb = r % 288;
        transpose_item(args.in[9] + (size_t)l * D * NMODC, D, NMODC, (bf16*)(ws + WS_BIG), l * NMODC + nb * 32, scr, kb * 64, nb * 32, lane); }
}

__device__ __forceinline__ void p0_prologue(const Args& args, LAS unsigned char* lds_) {
    const Ctx C = make_ctx(args, lds_);
    LAS float* scr = (LAS float*)(C.lds + C.wave * 16384);
    constexpr int I_F0 = I_WI + I_WO, I_P0 = I_F0 + I_WIN;
    for (int it = C.gw; it < I_P0 + 2 * I_ADA; it += C.NGW) {
        if (it < I_F0) convert_item(args, C.ws, 0, it, scr, C.lane);
        else if (it < I_P0) convert_item(args, C.ws, 0, 2 * I_F0 + (it - I_F0), scr, C.lane);
        else { const int a = it - I_P0; convert_item(args, C.ws, a / I_ADA, I_MAIN + a % I_ADA, scr, C.lane); }
    }
    const int gt = C.gw * 64 + C.lane, NGT = C.NGW * 64;
    for (int i = gt; i < 2 * 224 * 128; i += NGT) { const int l = i / (224 * 128), rr = (i / 128) % 224, ch = i & 127;
        *(v4u*)(C.ws + WS_W + (size_t)l * W_LAYER + W_WIN + ((size_t)(3872 + rr) * 1024 + ch * 8) * 2) = (v4u){0u, 0u, 0u, 0u}; }
    for (int i = gt; i < 256 * 256; i += NGT) { const int row = i >> 8, c4 = (i & 255) * 4;
        v2u o = (v2u){0u, 0u};
        if (row < NB) { const float* src = row < BP ? args.in[7] + (size_t)row * D : args.in[8] + (size_t)(row - BP) * D; const f32x4 v = *(const f32x4*)(src + c4);
            o.x = pk2(siluf_(v.x), siluf_(v.y)); o.y = pk2(siluf_(v.z), siluf_(v.w)); }
        *(v2u*)(C.ws + WS_AC + ((size_t)row * D + c4) * 2) = o; }
    for (int i = gt; i < 2052 * 32; i += NGT) { const int p = i >> 5, j = i & 31; const double pos = p < 2048 ? (double)p : (double)(16384 + (p - 2048));
        double inv = 1.0; for (int q = 0; q < j; ++q) inv *= 0.7498942093324559;
        const double ang = pos * inv; const double n = rint(ang * 0.15915494309189535);
        const float rr = (float)((ang - n * 6.283185307179586) - n * 2.4492935982947064e-16);
        ((f32x2*)(C.ws + WS_ROPE))[i] = (f32x2){__cosf(rr), __sinf(rr)}; }
}

__device__ __forceinline__ void p2_modulate0(const Args& args, LAS unsigned char* lds_) {
    const Ctx C = make_ctx(args, lds_);
    const float* MOD = (const float*)(C.ws + WS_MOD); bf16* H = (bf16*)(C.ws + WS_H);
    for (int r = C.gw; r < M; r += C.NGW) {
        const float* xr = r < MP ? args.in[0] + (size_t)r * D : args.in[1] + (size_t)(r - MP) * D;
        const float* modr = MOD + (size_t)batch_of_row(r) * NMODC;
#pragma unroll
        for (int j = 0; j < 4; ++j) { const int c = (C.lane + 64 * j) * 4;
            const f32x4 v = *(const f32x4*)(xr + c), sh = *(const f32x4*)(modr + c), sc = *(const f32x4*)(modr + 1024 + c);
            const f32x4 h = v * (sc + 1.0f) + sh;
            *(f32x4*)(C.out + (size_t)r * D + c) = v * ALPHA;
            *(v2u*)(H + (size_t)r * D + c) = (v2u){pk2(h.x, h.y), pk2(h.z, h.w)}; }
    }
}

__device__ __forceinline__ void ln_phase(const Args& args, LAS unsigned char* lds_, int l, int which, bool write_h, int hl, int shc, int npart, float xscale) {
    const Ctx C = make_ctx(args, lds_);
    const float* MOD = (const float*)(C.ws + WS_MOD); bf16* H = (bf16*)(C.ws + WS_H);
    const float* g = args.in[11] + (size_t)(l * 3 + which) * D; const float* b = args.in[12] + (size_t)(l * 3 + which) * D;
    f32x4 nv[4];
    if (C.gw < M) {
#pragma unroll
        for (int j = 0; j < 4; ++j) nv[j] = *(const f32x4*)(C.out + (size_t)C.gw * D + (C.lane + 64 * j) * 4); }
#pragma unroll 1
    for (int r = C.gw; r < M; r += C.NGW) {
        float* xr = C.out + (size_t)r * D;
        f32x4 v[4]; float s = 0.f;
#pragma unroll
        for (int j = 0; j < 4; ++j) v[j] = nv[j];
        if (r + C.NGW < M) {
#pragma unroll
            for (int j = 0; j < 4; ++j) nv[j] = *(const f32x4*)(xr + (size_t)C.NGW * D + (C.lane + 64 * j) * 4); }
        if (r >= MP) { const float* pp = (const float*)(C.ws + WS_SB) + (size_t)(r - MP) * D;
#pragma unroll 1
            for (int p = 0; p < npart; ++p, pp += 512 * 1024) {
#pragma unroll
                for (int j = 0; j < 4; ++j) v[j] += *(const f32x4*)(pp + (C.lane + 64 * j) * 4); } }
#pragma unroll
        for (int j = 0; j < 4; ++j) s += (v[j].x + v[j].y) + (v[j].z + v[j].w);
        const float mean = wave_sum2(s) * (1.f / D); float s2 = 0.f;
#pragma unroll
        for (int j = 0; j < 4; ++j) { v[j] = v[j] - mean; s2 += (v[j].x * v[j].x + v[j].y * v[j].y) + (v[j].z * v[j].z + v[j].w * v[j].w); }
        const float rstd = 1.f / sqrtf(wave_sum2(s2) * (1.f / D) + LN_EPS);
        const float* modr = MOD + (size_t)(hl * NB + batch_of_row(r)) * NMODC + shc * 1024;
#pragma unroll
        for (int j = 0; j < 4; ++j) { const int c = (C.lane + 64 * j) * 4;
            const f32x4 xn = v[j] * rstd * *(const f32x4*)(g + c) + *(const f32x4*)(b + c);
            *(f32x4*)(xr + c) = xn * xscale;
            if (write_h) { const f32x4 sh = *(const f32x4*)(modr + c), sc = *(const f32x4*)(modr + 1024 + c); const f32x4 h = xn * (sc + 1.0f) + sh;
                *(v2u*)(H + (size_t)r * D + c) = (v2u){pk2(h.x, h.y), pk2(h.z, h.w)}; }
        }
    }
}

struct PrepRaw { unsigned short rq1[4], rq2[4], rk1[4], rk2[4], aq[2], hf[4], hq[4], dx[12], db, da; v4u alr0, alr1; };
__device__ __forceinline__ void prep_load(PrepRaw& x, const bf16* P, int lane) {
    const int j = lane & 31;
#pragma unroll
    for (int h = 0; h < 4; ++h) { x.rq1[h] = P[C_RQ + h * 64 + j]; x.rq2[h] = P[C_RQ + h * 64 + 32 + j]; x.rk1[h] = P[C_RK + h * 64 + j]; x.rk2[h] = P[C_RK + h * 64 + 32 + j]; }
    x.alr0 = *(const v4u*)(P + C_ALR); x.alr1 = *(const v4u*)(P + C_ALR + 8);
#pragma unroll
    for (int i = 0; i < 2; ++i) x.aq[i] = P[C_AQ + lane + 64 * i];
#pragma unroll
    for (int i = 0; i < 4; ++i) { x.hf[i] = P[C_HF + lane + 64 * i]; x.hq[i] = P[C_HQ + lane + 64 * i]; }
#pragma unroll
    for (int i = 0; i < 12; ++i) x.dx[i] = P[C_DQKV + lane + 64 * i];
    x.db = P[C_DB + (lane & 3)]; x.da = P[C_DA + (lane & 3)];
}

__device__ __forceinline__ void prep_phase(const Args& args, LAS unsigned char* lds_, int l) {
    const Ctx C = make_ctx(args, lds_);
    const bf16* PROJ = (const bf16*)(C.ws + WS_BIG); bf16* SB = (bf16*)(C.ws + WS_SB); float* SF = (float*)(C.ws + WS_SF);
    const f32x2* ROPE = (const f32x2*)(C.ws + WS_ROPE);
    const int lane = C.lane;
    const float* wg = args.in[18] + (size_t)l * 16 * 128; const float* bg = args.in[19] + (size_t)l * 128;
    const float* cw = args.in[21] + (size_t)l * 4 * 768;
    LAS float* lwg = (LAS float*)C.lds; LAS float* lcw = lwg + 16 * 128;
    for (int i = C.tid; i < 16 * 128; i += NWAVES * 64) lwg[i] = wg[i];
    for (int i = C.tid; i < 4 * 768; i += NWAVES * 64) lcw[i] = cw[i];
    __syncthreads();
    constexpr int CH = 9;
    const int r0 = C.gw * CH, r1 = min(r0 + CH, M);
    if (r0 >= M) return;
    float lbv[4];
#pragma unroll
    for (int i = 0; i < 4; ++i) { lbv[i] = 0.f; if (l == 1) lbv[i] = 1.0f / (1.0f + expf(args.in[20][lane + 64 * i] - args.in[20][256 + lane + 64 * i])); }
    const float a_neg = -expf(args.in[22][l * 4 + (lane & 3)]), dtb = args.in[23][l * 4 + (lane & 3)];
    const float bg0 = bg[lane], bg1 = bg[lane + 64];
    float w1[12], w2[12], w3[12];
    auto load_window = [&](int r) {
        const bool isp = r < MP; const int rs = r - MP; const int b = isp ? (r >> 11) : (rs >> 2), t = isp ? (r & 2047) : (rs & 3);
        const float* cst = args.in[6] + ((size_t)(l * BS + b) * 3) * 768;
#pragma unroll
        for (int i = 0; i < 12; ++i) { const int ch = lane + 64 * i; const bf16* Pc = PROJ + (size_t)r * NINP + C_DQKV + ch;
            w1[i] = t >= 1 ? bf2f(Pc[-1 * NINP]) : (isp ? 0.f : cst[2 * 768 + ch]);
            w2[i] = t >= 2 ? bf2f(Pc[-2 * NINP]) : (isp ? 0.f : cst[(1 + t) * 768 + ch]);
            w3[i] = t >= 3 ? bf2f(Pc[-3 * NINP]) : (isp ? 0.f : cst[t * 768 + ch]); }
    };
    PrepRaw A; prep_load(A, PROJ + (size_t)r0 * NINP, lane);
    load_window(r0);
#pragma unroll 1
    for (int r = r0; r < r1; ++r) {
        PrepRaw B = A;
        if (r + 1 < r1) prep_load(B, PROJ + (size_t)(r + 1) * NINP, lane);
        int zo = 0; asm volatile("" : "+v"(zo));
        const bool isp = r < MP; const int rs = r - MP;
        const int b = isp ? (r >> 11) : (rs >> 2), t = isp ? (r & 2047) : (rs & 3);
        const int ridx = isp ? t : 2048 + t;
        bf16* sb = SB + (size_t)r * SBW; float* sf = SF + (size_t)r * SFW;
        { const int j = lane & 31; const bool hi = lane >= 32; const f32x2 cs = ROPE[ridx * 32 + j];
#pragma unroll
          for (int h = 0; h < 4; ++h) {
              const float q1 = bf2f(A.rq1[h]), q2 = bf2f(A.rq2[h]), k1 = bf2f(A.rk1[h]), k2 = bf2f(A.rk2[h]);
              const float qo = hi ? (q1 * cs.y + q2 * cs.x) : (q1 * cs.x - q2 * cs.y);
              const float ko = hi ? (k1 * cs.y + k2 * cs.x) : (k1 * cs.x - k2 * cs.y);
              sb[SB_RQ + h * 64 + lane] = (bf16)(pk2(qo, 0.f) & 0xffffu);
              sb[SB_RK + h * 64 + lane] = (bf16)(pk2(ko * 0.125f, 0.f) & 0xffffu);
          } }
        { const unsigned aw[8] = {A.alr0.x, A.alr0.y, A.alr0.z, A.alr0.w, A.alr1.x, A.alr1.y, A.alr1.z, A.alr1.w};
          float x0 = bg0, x1 = bg1;
#pragma unroll
          for (int i = 0; i < 8; ++i) { const float a0 = bflo(aw[i]), a1 = bfhi(aw[i]);
              x0 += a0 * lwg[(2 * i) * 128 + lane + zo] + a1 * lwg[(2 * i + 1) * 128 + lane + zo];
              x1 += a0 * lwg[(2 * i) * 128 + lane + 64 + zo] + a1 * lwg[(2 * i + 1) * 128 + lane + 64 + zo]; }
          const float sp0 = fmaxf(-x0, 0.f) + log1pf(expf(-fabsf(x0))), sp1 = fmaxf(-x1, 0.f) + log1pf(expf(-fabsf(x1)));
          sf[SF_ADEC + lane] = expf(-sp0 * (1.0f / 16.0f)); sf[SF_ADEC + lane + 64] = expf(-sp1 * (1.0f / 16.0f));
          sb[SB_AQ + lane] = (bf16)(pk2(bf2f(A.aq[0]) * 0.17677669529663687f, 0.f) & 0xffffu);
          sb[SB_AQ + lane + 64] = (bf16)(pk2(bf2f(A.aq[1]) * 0.17677669529663687f, 0.f) & 0xffffu); }
#pragma unroll
        for (int i = 0; i < 4; ++i) { const int c = lane + 64 * i;
            sf[SF_HF + c] = lbv[i] + (1.0f - lbv[i]) * sigmoidf_(bf2f(A.hf[i]));
            sb[SB_HQ + c] = (bf16)(pk2(siluf_(bf2f(A.hq[i])) * 0.125f, 0.f) & 0xffffu); }
        { float* cso = isp ? C.out + O_PCONV + ((size_t)(l * BP + b) * 3) * 768 : C.out + O_SCONV + ((size_t)(l * BS + b) * 3) * 768;
          const int so = isp ? t - (TP - 3) : t - 1;
          float uu[12];
#pragma unroll
          for (int i = 0; i < 12; ++i) { const float x0 = bf2f(A.dx[i]);
              const LAS float* cwc = lcw + lane + 64 * i + zo;
              uu[i] = siluf_(x0 * cwc[3 * 768] + w1[i] * cwc[2 * 768] + w2[i] * cwc[768] + w3[i] * cwc[0]);
              if (so >= 0) cso[so * 768 + lane + 64 * i] = x0;
              w3[i] = w2[i]; w2[i] = w1[i]; w1[i] = x0; }
float qr[4];
#pragma unroll
          for (int i = 0; i < 12; ++i) { float sc = 1.0f;
              if (i < 8) { const float nn = wave_sum2(uu[i] * uu[i]); sc = rsqrtf(nn + RMS_EPS) * (i < 4 ? 0.125f : 1.0f); }
              const unsigned wbits = pk2(uu[i] * sc, 0.f) & 0xffffu;
              sb[SB_DQ + i * 64 + lane] = (bf16)wbits;
              if (i < 4) qr[i] = bf2f(wbits);
              else if (i < 8) { const float qk = wave_sum2(qr[i - 4] * bf2f(wbits)); if (lane == 0) sf[SF_QK + (i - 4)] = qk; } }
          if (lane < 4) { sf[SF_BETA + lane] = sigmoidf_(bf2f(A.db));
              const float xx = bf2f(A.da) + dtb; const float sp = fmaxf(xx, 0.f) + log1pf(expf(-fabsf(xx)));
              sf[SF_DDEC + lane] = expf(a_neg * sp); } }
        A = B;
        if (r + 1 < r1) { const int rn = r + 1; const bool ns = rn < MP ? ((rn & 2047) == 0) : (((rn - MP) & 3) == 0); if (ns) load_window(rn); }
    }
}

template <int KIND, int DH, int R> struct Raw { unsigned q[DH / 2]; unsigned k[DH / 2]; unsigned v[(R + 1) / 2]; float f[DH]; float be, de; };

template <int KIND, int DH, int R>
__device__ __forceinline__ void load_tok(Raw<KIND, DH, R>& x, const bf16* qp, const bf16* kp, const bf16* vp, const float* fp) {
    if constexpr (DH == 4) { const v2u w = *(const v2u*)qp; x.q[0] = w.x; x.q[1] = w.y; } else { x.q[0] = *(const unsigned*)qp; }
    if constexpr (KIND != 2) { if constexpr (DH == 4) { const v2u w = *(const v2u*)kp; x.k[0] = w.x; x.k[1] = w.y; } else { x.k[0] = *(const unsigned*)kp; } }
    if constexpr (R == 1) x.v[0] = *vp; else if constexpr (R == 2) x.v[0] = *(const unsigned*)vp; else { const v2u w = *(const v2u*)vp; x.v[0] = w.x; x.v[1] = w.y; }
    if constexpr (KIND == 1) { const f32x2 w = *(const f32x2*)fp; x.f[0] = w.x; x.f[1] = w.y; }
    if constexpr (KIND == 2) { const f32x4 w = *(const f32x4*)fp; x.f[0] = w.x; x.f[1] = w.y; x.f[2] = w.z; x.f[3] = w.w; }
    if constexpr (KIND == 3) { x.be = fp[0]; x.de = fp[4]; }
}

template <int KIND, int DH, int R>
__device__ __forceinline__ void scan_task(const Ctx& C, int row0, int T, int h, int slice, const float* sin, float* sout) {
    const bf16* PROJ = (const bf16*)(C.ws + WS_BIG); const bf16* SB = (const bf16*)(C.ws + WS_SB); const float* SF = (const float*)(C.ws + WS_SF);
    bf16* H = (bf16*)(C.ws + WS_H);
    const int lane = C.lane, dl = lane & 15, rw = lane >> 4;
    const int d0 = dl * DH, v0 = slice * (4 * R) + rw * R;
    constexpr int DK = 16 * DH;
    const bf16 *qp, *kp, *vp; const float* fp; int ks, vs;
    const bf16* sbr = SB + (size_t)row0 * SBW; const bf16* pr = PROJ + (size_t)row0 * NINP; const float* sfr = SF + (size_t)row0 * SFW;
    if constexpr (KIND == 0) { qp = sbr + SB_RQ + h * 64 + d0; kp = sbr + SB_RK + h * 64 + d0; ks = SBW; vp = pr + C_RV + h * 64 + v0; vs = NINP; fp = sfr; }
    if constexpr (KIND == 1) { qp = sbr + SB_AQ + h * 32 + d0; kp = pr + C_AK + h * 32 + d0; ks = NINP; vp = pr + C_AV + h * 64 + v0; vs = NINP; fp = sfr + SF_ADEC + h * 32 + d0; }
    if constexpr (KIND == 2) { qp = sbr + SB_HQ + h * 64 + d0; kp = sbr; ks = SBW; vp = pr + C_HI + h * 64 + v0; vs = NINP; fp = sfr + SF_HF + h * 64 + d0; }
    if constexpr (KIND == 3) { qp = sbr + SB_DQ + h * 64 + d0; kp = sbr + SB_DK + h * 64 + d0; ks = SBW; vp = sbr + SB_DV + h * 64 + v0; vs = SBW; fp = sfr + SF_BETA + h; }
    bf16* op = H + (size_t)row0 * D + KIND * 256 + h * 64 + v0;
    const float rdec = 1.0f - exp2f(-5.0f - (float)h);

    float S[DH][R];
#pragma unroll
    for (int dh = 0; dh < DH; ++dh)
#pragma unroll
        for (int vv = 0; vv < R; ++vv) S[dh][vv] = sin ? sin[(size_t)(d0 + dh) * 64 + v0 + vv] : 0.f;

    typedef Raw<KIND, DH, R> RawT;
    RawT A[4];
#pragma unroll
    for (int u = 0; u < 4; ++u) load_tok<KIND, DH, R>(A[u], qp + (size_t)u * SBW, kp + (size_t)u * ks, vp + (size_t)u * vs, fp + (size_t)u * SFW);
    for (int t0 = 0; t0 < T; t0 += 4) {
        RawT B[4];
        const bool more = t0 + 4 < T;
#pragma unroll
        for (int u = 0; u < 4; ++u) { B[u] = A[u]; }
        if (more) {
#pragma unroll
            for (int u = 0; u < 4; ++u) load_tok<KIND, DH, R>(B[u], qp + (size_t)(t0 + 4 + u) * SBW, kp + (size_t)(t0 + 4 + u) * ks, vp + (size_t)(t0 + 4 + u) * vs, fp + (size_t)(t0 + 4 + u) * SFW);
        }
#pragma unroll
        for (int u = 0; u < 4; ++u) {
            const RawT& x = A[u];
            float q[DH], k[DH], v[R];
            q[0] = bflo(x.q[0]); q[1] = bfhi(x.q[0]); if constexpr (DH == 4) { q[2] = bflo(x.q[1]); q[3] = bfhi(x.q[1]); }
            if constexpr (KIND != 2) { k[0] = bflo(x.k[0]); k[1] = bfhi(x.k[0]); if constexpr (DH == 4) { k[2] = bflo(x.k[1]); k[3] = bfhi(x.k[1]); } }
            if constexpr (R == 1) v[0] = bflo(x.v[0]);
            if constexpr (R >= 2) { v[0] = bflo(x.v[0]); v[1] = bfhi(x.v[0]); }
            if constexpr (R == 4) { v[2] = bflo(x.v[1]); v[3] = bfhi(x.v[1]); }
            float o[R];
            if constexpr (KIND == 3) {
                float ks_[R];
#pragma unroll
                for (int vv = 0; vv < R; ++vv) { float p = 0.f;
#pragma unroll
                    for (int dh = 0; dh < DH; ++dh) { S[dh][vv] *= x.de; p += k[dh] * S[dh][vv]; }
                    ks_[vv] = row16_sum(p); }
#pragma unroll
                for (int vv = 0; vv < R; ++vv) { const float uu = x.be * (v[vv] - ks_[vv]); float p = 0.f;
#pragma unroll
                    for (int dh = 0; dh < DH; ++dh) { S[dh][vv] += k[dh] * uu; p += q[dh] * S[dh][vv]; }
                    o[vv] = row16_sum(p); }
            } else {
#pragma unroll
                for (int dh = 0; dh < DH; ++dh) {
                    float dec, kk;
                    if constexpr (KIND == 0) { dec = rdec; kk = k[dh]; }
                    if constexpr (KIND == 1) { dec = x.f[dh]; kk = k[dh]; }
                    if constexpr (KIND == 2) { dec = x.f[dh]; kk = 1.0f - x.f[dh]; }
#pragma unroll
                    for (int vv = 0; vv < R; ++vv) S[dh][vv] = dec * S[dh][vv] + kk * v[vv];
                }
#pragma unroll
                for (int vv = 0; vv < R; ++vv) { float p = 0.f;
#pragma unroll
                    for (int dh = 0; dh < DH; ++dh) p += q[dh] * S[dh][vv];
                    o[vv] = row16_sum(p); }
            }
            if (dl == 0) {
                bf16* o_ = op + (size_t)(t0 + u) * D;
                if constexpr (R == 1) *o_ = (bf16)(pk2(o[0], 0.f) & 0xffffu);
                if constexpr (R == 2) *(unsigned*)o_ = pk2(o[0], o[1]);
                if constexpr (R == 4) *(v2u*)o_ = (v2u){pk2(o[0], o[1]), pk2(o[2], o[3])};
            }
        }
#pragma unroll
        for (int u = 0; u < 4; ++u) A[u] = B[u];
    }
#pragma unroll
    for (int dh = 0; dh < DH; ++dh)
#pragma unroll
        for (int vv = 0; vv < R; ++vv) sout[(size_t)(d0 + dh) * 64 + v0 + vv] = S[dh][vv];
    (void)DK;
}

template <int KIND, int DH, int R>
__device__ __forceinline__ void scan_long(const Ctx& C, LAS float* wl, int row0, int T, int h, int slice, float* sout) {
    constexpr int CT = 16, LR = 8, DK = LR * DH, NV = (64 / LR) * R, UNR = 8;
    constexpr bool HASK = true, GK = (KIND != 2), HASF = (KIND == 1 || KIND == 2), HASB = (KIND == 3);
    constexpr int OQ = 0, OK_ = OQ + CT * DK, OF = OK_ + (HASK ? CT * DK : 0), OV = OF + (HASF ? CT * DK : 0), OB = OV + CT * NV, BUF = OB + (HASB ? CT * 4 : 0);
    const bf16* PROJ = (const bf16*)(C.ws + WS_BIG); const bf16* SB = (const bf16*)(C.ws + WS_SB); const float* SF = (const float*)(C.ws + WS_SF);
    bf16* H = (bf16*)(C.ws + WS_H);
    const int lane = C.lane, dl = lane & (LR - 1), rw = lane / LR;
    const int d0 = dl * DH;
    const int stok = lane >> 2, spart = lane & 3;
    const GAS bf16 *qg, *kg, *vg; const GAS float *fg, *bg; int ks, vs;
    {
        const GAS bf16* sbr = (const GAS bf16*)(SB + (size_t)row0 * SBW); const GAS bf16* pr = (const GAS bf16*)(PROJ + (size_t)row0 * NINP); const GAS float* sfr = (const GAS float*)(SF + (size_t)row0 * SFW);
        const int vcol = slice * NV;
        if constexpr (KIND == 0) { qg = sbr + SB_RQ + h * 64; kg = sbr + SB_RK + h * 64; ks = SBW; vg = pr + C_RV + h * 64 + vcol; vs = NINP; fg = sfr; bg = sfr; }
        if constexpr (KIND == 1) { qg = sbr + SB_AQ + h * 32; kg = pr + C_AK + h * 32; ks = NINP; vg = pr + C_AV + h * 64 + vcol; vs = NINP; fg = sfr + SF_ADEC + h * 32; bg = sfr; }
        if constexpr (KIND == 2) { qg = sbr + SB_HQ + h * 64; kg = sbr; ks = SBW; vg = pr + C_HI + h * 64 + vcol; vs = NINP; fg = sfr + SF_HF + h * 64; bg = sfr; }
        if constexpr (KIND == 3) { qg = sbr + SB_DQ + h * 64; kg = sbr + SB_DK + h * 64; ks = SBW; vg = sbr + SB_DV + h * 64 + vcol; vs = SBW; fg = sfr; bg = sfr + SF_BETA + h; }
    }
    constexpr int QP = DK / 4;
    qg += (size_t)stok * SBW + spart * QP; kg += (size_t)stok * ks + spart * QP; fg += (size_t)stok * SFW + spart * QP;
    vg += (size_t)(lane & 15) * vs; bg += (size_t)(lane & 15) * SFW;
    GAS bf16* op = (GAS bf16*)(H + (size_t)row0 * D + KIND * 256 + h * 64 + slice * NV + rw * R);
    const float rdec = 1.0f - exp2f(-5.0f - (float)h);

    static_assert(R == 1, "scan_long: one column per lane row");
    f32x2 S2[DH / 2];
#pragma unroll
    for (int i = 0; i < DH / 2; ++i) S2[i] = (f32x2){0.f, 0.f};

    struct SR { v4u rq[QP / 8], rk[QP / 8]; f32x4 rf[QP / 4]; unsigned rv[NV / 2]; float rb0, rb1, rb2; };
    SR s0; s0.rb0 = s0.rb1 = s0.rb2 = 0.f;
    auto stage_load = [&](SR& sr, int c) {
        const size_t t = (size_t)c * CT;
#pragma unroll
        for (int i = 0; i < QP / 8; ++i) { sr.rq[i] = *(const GAS v4u*)(qg + t * SBW + i * 8); if constexpr (GK) sr.rk[i] = *(const GAS v4u*)(kg + t * ks + i * 8); }
        if constexpr (HASF) {
#pragma unroll
            for (int i = 0; i < QP / 4; ++i) sr.rf[i] = *(const GAS f32x4*)(fg + t * SFW + i * 4); }
        if (lane < 16) {
            if constexpr (NV == 4) { const v2u w = *(const GAS v2u*)(vg + t * vs); sr.rv[0] = w.x; sr.rv[1] = w.y; }
            if constexpr (NV == 8) { const v4u w = *(const GAS v4u*)(vg + t * vs); sr.rv[0] = w.x; sr.rv[1] = w.y; sr.rv[2] = w.z; sr.rv[3] = w.w; }
            if constexpr (NV == 16) { const v4u w = *(const GAS v4u*)(vg + t * vs), w2 = *(const GAS v4u*)(vg + t * vs + 8); sr.rv[0] = w.x; sr.rv[1] = w.y; sr.rv[2] = w.z; sr.rv[3] = w.w; sr.rv[4] = w2.x; sr.rv[5] = w2.y; sr.rv[6] = w2.z; sr.rv[7] = w2.w; }
            if constexpr (HASB) { sr.rb0 = bg[t * SFW]; sr.rb1 = bg[t * SFW + 4]; sr.rb2 = bg[t * SFW + 8]; }
        }
    };
    auto stage_write = [&](SR& sr, int b) {
        LAS float* base = wl + b * BUF;
#pragma unroll
        for (int i = 0; i < QP / 8; ++i) {
            LAS float* qd = base + OQ + stok * DK + spart * QP + i * 8;
            *(LAS f32x4*)qd = (f32x4){bflo(sr.rq[i].x), bfhi(sr.rq[i].x), bflo(sr.rq[i].y), bfhi(sr.rq[i].y)}; *(LAS f32x4*)(qd + 4) = (f32x4){bflo(sr.rq[i].z), bfhi(sr.rq[i].z), bflo(sr.rq[i].w), bfhi(sr.rq[i].w)};
            if constexpr (GK) { LAS float* kd = base + OK_ + stok * DK + spart * QP + i * 8;
                *(LAS f32x4*)kd = (f32x4){bflo(sr.rk[i].x), bfhi(sr.rk[i].x), bflo(sr.rk[i].y), bfhi(sr.rk[i].y)}; *(LAS f32x4*)(kd + 4) = (f32x4){bflo(sr.rk[i].z), bfhi(sr.rk[i].z), bflo(sr.rk[i].w), bfhi(sr.rk[i].w)}; }
        }
        if constexpr (HASF) {
#pragma unroll
            for (int i = 0; i < QP / 4; ++i) { *(LAS f32x4*)(base + OF + stok * DK + spart * QP + i * 4) = sr.rf[i];
                if constexpr (KIND == 2) *(LAS f32x4*)(base + OK_ + stok * DK + spart * QP + i * 4) = 1.0f - sr.rf[i]; } }
        if (lane < 16) {
#pragma unroll
            for (int i = 0; i < NV / 2; ++i) { base[OV + lane * NV + 2 * i] = bflo(sr.rv[i]); base[OV + lane * NV + 2 * i + 1] = bfhi(sr.rv[i]); }
            if constexpr (HASB) *(LAS f32x4*)(base + OB + lane * 4) = (f32x4){sr.rb0, sr.rb1, sr.rb2, 0.f};
        }
    };
    static_assert(2 * BUF * 4 <= 26624, "per-wave LDS");
    const int nch = T / CT;
    struct Opnd { f32x2 q2[DH / 2], k2[DH / 2], f2[DH / 2]; float v; f32x4 bd; };
    auto ldop = [&](Opnd& x, const LAS float* bq, const LAS float* bv, const LAS float* bb, int uu) {
#pragma unroll
        for (int i = 0; i < DH / 4; ++i) { const f32x4 w = *(const LAS f32x4*)(bq + OQ + uu * DK + 4 * i); x.q2[2 * i] = (f32x2){w.x, w.y}; x.q2[2 * i + 1] = (f32x2){w.z, w.w}; }
#pragma unroll
        for (int i = 0; i < DH / 4; ++i) { const f32x4 w = *(const LAS f32x4*)(bq + OK_ + uu * DK + 4 * i); x.k2[2 * i] = (f32x2){w.x, w.y}; x.k2[2 * i + 1] = (f32x2){w.z, w.w}; }
        if constexpr (HASF) {
#pragma unroll
            for (int i = 0; i < DH / 4; ++i) { const f32x4 w = *(const LAS f32x4*)(bq + OF + uu * DK + 4 * i); x.f2[2 * i] = (f32x2){w.x, w.y}; x.f2[2 * i + 1] = (f32x2){w.z, w.w}; } }
        x.v = bv[uu * NV];
        if constexpr (HASB) x.bd = *(const LAS f32x4*)(bb + uu * 4);
    };
    auto compute = [&](int c, const LAS float* base) {
#pragma unroll 1
        for (int ub = 0; ub < CT; ub += UNR) {
        float okeep[R];
#pragma unroll
        for (int vv = 0; vv < R; ++vv) okeep[vv] = 0.f;
        Opnd X; X.bd = (f32x4){0.f, 0.f, 0.f, 0.f};
#pragma unroll
        for (int i = 0; i < DH / 2; ++i) X.f2[i] = (f32x2){0.f, 0.f};
        const LAS float* bq = base + ub * DK + d0; const LAS float* bv = base + OV + ub * NV + rw; const LAS float* bb = base + OB + ub * 4;
        ldop(X, bq, bv, bb, 0);
#pragma unroll
        for (int uu_ = 0; uu_ < UNR; ++uu_) { const int u = ub + uu_;
            Opnd Y = X;
            if (uu_ + 1 < UNR) ldop(Y, bq, bv, bb, uu_ + 1);
            f32x2 (&q2)[DH / 2] = X.q2; f32x2 (&k2)[DH / 2] = X.k2; f32x2 (&f2)[DH / 2] = X.f2; const float vv_ = X.v; const f32x4 bd = X.bd;
            float o[1];
            if constexpr (KIND == 3) {
                f32x2 a = k2[0] * S2[0], bq_ = q2[0] * S2[0];
#pragma unroll
                for (int i = 1; i < DH / 2; ++i) { a = __builtin_elementwise_fma(k2[i], S2[i], a); bq_ = __builtin_elementwise_fma(q2[i], S2[i], bq_); }
                const float ks_ = row8_sum(a.x + a.y) * bd.y, qs_ = row8_sum(bq_.x + bq_.y) * bd.y;
                const float uu = bd.x * (vv_ - ks_);
                o[0] = __builtin_fmaf(bd.z, uu, qs_);
                const f32x2 de2 = (f32x2){bd.y, bd.y}, uu2 = (f32x2){uu, uu};
#pragma unroll
                for (int i = 0; i < DH / 2; ++i) S2[i] = __builtin_elementwise_fma(S2[i], de2, k2[i] * uu2);
            } else {
                const f32x2 v2 = (f32x2){vv_, vv_};
#pragma unroll
                for (int i = 0; i < DH / 2; ++i) {
                    f32x2 dec2;
                    if constexpr (KIND == 0) dec2 = (f32x2){rdec, rdec}; else dec2 = f2[i];
                    S2[i] = __builtin_elementwise_fma(S2[i], dec2, k2[i] * v2);
                }
            }
            if constexpr (KIND != 3)
            { f32x2 a = q2[0] * S2[0];
#pragma unroll
              for (int i = 1; i < DH / 2; ++i) a = __builtin_elementwise_fma(q2[i], S2[i], a);
              o[0] = row8_sum(a.x + a.y); }
#pragma unroll
            for (int vv = 0; vv < R; ++vv) okeep[vv] = (dl == uu_) ? o[vv] : okeep[vv];
            X = Y;
        }
        {
            GAS bf16* o_ = op + (size_t)(c * CT + ub + dl) * D;
            if constexpr (R == 1) *o_ = (bf16)(pk2(okeep[0], 0.f) & 0xffffu);
            if constexpr (R == 2) *(GAS unsigned*)o_ = pk2(okeep[0], okeep[1]);
            if constexpr (R == 4) *(GAS v2u*)o_ = (v2u){pk2(okeep[0], okeep[1]), pk2(okeep[2], okeep[3])};
        }
        }
    };
    stage_load(s0, 0); stage_write(s0, 0);
#pragma unroll 1
    for (int c = 0; c < nch; c += 2) {
        stage_load(s0, min(c + 1, nch - 1));
        compute(c, wl);
        stage_write(s0, 1);
        stage_load(s0, min(c + 2, nch - 1));
        compute(c + 1, wl + BUF);
        stage_write(s0, 0);
    }
    const int v0 = slice * NV + rw * R;
#pragma unroll
    for (int i = 0; i < DH / 2; ++i) { sout[(size_t)(d0 + 2 * i) * 64 + v0] = S2[i].x; sout[(size_t)(d0 + 2 * i + 1) * 64 + v0] = S2[i].y; }
}

__device__ __forceinline__ void scan_phase(const Args& args, LAS unsigned char* lds_, int l, int mode = 0) {
    const Ctx C = make_ctx(args, lds_);
    constexpr int NLONG = 1024, NSHORT = BS * 144;
    const int slot = C.wave * 256 + (int)blockIdx.x;
    const int nidle = C.NGW - NLONG;
    for (int it = 0;; ++it) {
        int kind, b, h, slice, row0, T; bool isp;
        if (slot < NLONG) { if (it > 0 || mode == 2) break; isp = true; T = TP;
            const int kk_ = slot >> 8, i = slot & 255; kind = kk_ == 0 ? 3 : (kk_ == 1 ? 0 : (kk_ == 2 ? 2 : 1));
            { const int stream = (i & 7) | ((i >> 6) << 3); slice = (i >> 3) & 7; b = stream >> 2; h = stream & 3; }
            row0 = b * TP;
        } else { const int st = (slot - NLONG) + it * nidle; if (st >= NSHORT || mode == 1) break; isp = false; T = TS;
            b = st / 144; int i = st - b * 144;
            if (i < 64) { kind = 3; h = i >> 4; slice = i & 15; }
            else if (i < 96) { i -= 64; kind = 0; h = i >> 3; slice = i & 7; }
            else if (i < 128) { i -= 96; kind = 2; h = i >> 3; slice = i & 7; }
            else { i -= 128; kind = 1; h = i >> 2; slice = i & 3; }
            row0 = MP + b * TS;
        }
        const int nbat = isp ? BP : BS;
        const size_t sidx = (size_t)((l * nbat + b) * 4 + h);
        if (isp) {
            LAS float* wl = (LAS float*)(C.lds + C.wave * 26624);
            if (kind == 0) scan_long<0, 8, 1>(C, wl, row0, T, h, slice, C.out + O_PRET + sidx * 4096);
            else if (kind == 1) scan_long<1, 4, 1>(C, wl, row0, T, h, slice, C.out + O_PGLA + sidx * 2048);
            else if (kind == 2) scan_long<2, 8, 1>(C, wl, row0, T, h, slice, C.out + O_PHG + sidx * 4096);
            else scan_long<3, 8, 1>(C, wl, row0, T, h, slice, C.out + O_PGDN + sidx * 4096);
        } else {
            if (kind == 0) { scan_task<0, 4, 2>(C, row0, T, h, slice, args.in[2] + sidx * 4096, C.out + O_SRET + sidx * 4096); }
            else if (kind == 1) { scan_task<1, 2, 4>(C, row0, T, h, slice, args.in[3] + sidx * 2048, C.out + O_SGLA + sidx * 2048); }
            else if (kind == 2) { scan_task<2, 4, 2>(C, row0, T, h, slice, args.in[4] + sidx * 4096, C.out + O_SHG + sidx * 4096); }
            else { scan_task<3, 4, 1>(C, row0, T, h, slice, args.in[5] + sidx * 4096, C.out + O_SGDN + sidx * 4096); }
        }
    }
    if (l == 0 && C.wave >= 4 && mode != 1) {
        LAS float* scr = (LAS float*)(C.lds + 4 * 26624 + (C.wave - 4) * 8704);
        constexpr int I_F0 = I_WI + I_WO, I_L0B = I_F0 + I_WOUT;
        for (int it = (C.wave - 4) * 256 + (int)blockIdx.x; it < I_L0B + I_MAIN; it += 1024) {
            if (it < I_F0) convert_item(args, C.ws, 0, I_F0 + it, scr, C.lane);
            else if (it < I_L0B) convert_item(args, C.ws, 0, 2 * I_F0 + I_WIN + (it - I_F0), scr, C.lane);
            else convert_item(args, C.ws, 1, it - I_L0B, scr, C.lane);
        }
    }
}

__device__ __forceinline__ void post_phase(const Args& args, LAS unsigned char* lds_, int l) {
    const Ctx C = make_ctx(args, lds_);
    const bf16* PROJ = (const bf16*)(C.ws + WS_BIG); bf16* H = (bf16*)(C.ws + WS_H);
    const int lane = C.lane, mixer = lane >> 4, cc = (lane & 15) * 16;
    const int gbase = mixer == 0 ? C_RG : mixer == 1 ? C_AG : mixer == 2 ? C_HG : C_DG;
    const float* nw = mixer == 1 ? args.in[24] + l * 64 : mixer == 2 ? args.in[25] + l * 64 : args.in[26] + l * 64;
    float w[16];
#pragma unroll
    for (int i = 0; i < 16; ++i) w[i] = mixer == 0 ? 1.0f : nw[(cc + i) & 63];
    v4u na0, na1, ng0, ng1;
    if (C.gw < M) { const bf16* hp = H + (size_t)C.gw * D + lane * 16; const bf16* gp = PROJ + (size_t)C.gw * NINP + gbase + cc;
        na0 = *(const v4u*)hp; na1 = *(const v4u*)(hp + 8); ng0 = *(const v4u*)gp; ng1 = *(const v4u*)(gp + 8); }
#pragma unroll 1
    for (int r = C.gw; r < M; r += C.NGW) {
        bf16* hp = H + (size_t)r * D + lane * 16; const bf16* gp = PROJ + (size_t)r * NINP + gbase + cc;
        const v4u a0 = na0, a1 = na1, g0 = ng0, g1 = ng1;
        if (r + C.NGW < M) { const bf16* hn = hp + (size_t)C.NGW * D; const bf16* gn = gp + (size_t)C.NGW * NINP;
            na0 = *(const v4u*)hn; na1 = *(const v4u*)(hn + 8); ng0 = *(const v4u*)gn; ng1 = *(const v4u*)(gn + 8); }
        float y[16], g[16];
        const unsigned aw[8] = {a0.x, a0.y, a0.z, a0.w, a1.x, a1.y, a1.z, a1.w}, gw_[8] = {g0.x, g0.y, g0.z, g0.w, g1.x, g1.y, g1.z, g1.w};
        float ss = 0.f;
#pragma unroll
        for (int i = 0; i < 8; ++i) { y[2 * i] = bflo(aw[i]); y[2 * i + 1] = bfhi(aw[i]); g[2 * i] = bflo(gw_[i]); g[2 * i + 1] = bfhi(gw_[i]); ss += y[2 * i] * y[2 * i] + y[2 * i + 1] * y[2 * i + 1]; }
        ss = quad_sum(ss);
        const float rs = rsqrtf(ss * (1.0f / 64.0f) + RMS_EPS);
        unsigned ow[8];
#pragma unroll
        for (int i = 0; i < 8; ++i) ow[i] = pk2(y[2 * i] * rs * w[2 * i] * siluf_(g[2 * i]), y[2 * i + 1] * rs * w[2 * i + 1] * siluf_(g[2 * i + 1]));
        *(v4u*)hp = (v4u){ow[0], ow[1], ow[2], ow[3]}; *(v4u*)(hp + 8) = (v4u){ow[4], ow[5], ow[6], ow[7]};
    }
}

__global__ void __launch_bounds__(NWAVES * 64, 2) mega_fwd(Args args) {
    extern __shared__ __attribute__((aligned(16))) unsigned char lds[];
    cg::grid_group grid = cg::this_grid();
    LAS unsigned char* const LDSP = (LAS unsigned char*)lds;
    const int G = (int)gridDim.x, bx = (int)blockIdx.x;
    if (threadIdx.x < 64) ((LAS unsigned*)(LDSP + MISC_OFF))[threadIdx.x] = 0u;
    __syncthreads();
    (void)xcd_barrier_post((unsigned*)args.ws, (volatile LAS unsigned*)(LDSP + MISC_OFF));
#define FRESH() float* out_ = fresh_ptr(args.out); unsigned char* ws = fresh_ptr(args.ws); \
    float* MOD = (float*)(ws + WS_MOD); bf16* H = (bf16*)(ws + WS_H); bf16* BIG = (bf16*)(ws + WS_BIG); (void)MOD; (void)H; (void)BIG; (void)out_;

    p0_prologue(args, LDSP);
    if (args.ws == nullptr) grid.sync();
    grid_bar(args, LDSP);
    {
        FRESH();
        pg8::Gemm g{(const bf16*)(ws + WS_AC), BIG, 256, 2 * NMODC, D}; pg8::StaticOrder S; S.init(256, 2 * NMODC, G, bx, D);
        pg8::EpiMod E{MOD, args.in[10]};
        pg8::gemm_phase<pg8::EpiMod, pg8::StaticOrder, PG8_ALIGN, PG8_SP2>(LDSP, g, S, E);
    }
    grid_bar(args, LDSP);
    p2_modulate0(args, LDSP);
    grid_bar(args, LDSP);
#pragma unroll 1
    for (int l = 0; l < 2; ++l) {
#pragma unroll 1
        for (int f = 0; f < 2; ++f) {
            if (f == 1) {
                {
                    FRESH();
                    pg8::Gemm g{H, (const bf16*)(ws + WS_W + (size_t)l * W_LAYER + W_WIN), M, NINP, D}; pg8::StaticOrder S; S.init(M, NINP, G, bx, D);
                    pg8::EpiPlain E{BIG, NINP};
                    pg8::gemm_phase<pg8::EpiPlain, pg8::StaticOrder, PG8_ALIGN, PG8_SP2>(LDSP, g, S, E);
                }
                grid_bar(args, LDSP);
                prep_phase(args, LDSP, l);
                grid_bar(args, LDSP);
                scan_phase(args, LDSP, l);
#ifdef PROBE_SCANMODE
                grid_bar(args, LDSP); scan_phase(args, LDSP, l, PROBE_SCANMODE);
#endif
                grid_bar(args, LDSP);
                post_phase(args, LDSP, l);
                grid_bar(args, LDSP);
                {
                    FRESH();
                    pg8::Gemm g{H, (const bf16*)(ws + WS_W + (size_t)l * W_LAYER + W_WOUT), M, D, D}; pg8::SplitOrder S; S.init(D, G, bx);
                    pg8::EpiRes E{out_, (float*)(ws + WS_SB), MOD + (size_t)l * NB * NMODC + 5 * 1024, 1.0f, D / 64};
                    pg8::gemm_phase<pg8::EpiRes, pg8::SplitOrder, PG8_ALIGN, PG8_SP2>(LDSP, g, S, E);
                }
                grid_bar(args, LDSP);
                ln_phase(args, LDSP, l, 1, true, l, 6, 4, ALPHA);
                grid_bar(args, LDSP);
            }
            {
                FRESH();
                pg8::Gemm g{H, (const bf16*)(ws + WS_W + (size_t)l * W_LAYER + (f ? W_WI2 : W_WI1)), M, NWI, D}; pg8::StaticOrder S; S.init(M, NWI, G, bx, D);
                pg8::EpiSwiglu E{BIG, DFF};
                pg8::gemm_phase<pg8::EpiSwiglu, pg8::StaticOrder, PG8_ALIGN, PG8_SP2>(LDSP, g, S, E);
            }
            grid_bar(args, LDSP);
            {
                FRESH();
                pg8::Gemm g{BIG, (const bf16*)(ws + WS_W + (size_t)l * W_LAYER + (f ? W_WO2 : W_WO1)), M, D, DFF}; pg8::SplitOrder S; S.init(DFF, G, bx);
                pg8::EpiRes E{out_, (float*)(ws + WS_SB), MOD + (size_t)l * NB * NMODC + (f ? 8 : 2) * 1024, 0.5f, DFF / 64};
                pg8::gemm_phase<pg8::EpiRes, pg8::SplitOrder, PG8_ALIGN, PG8_SP2>(LDSP, g, S, E);
            }
            grid_bar(args, LDSP);
            if (f == 0) ln_phase(args, LDSP, l, 0, true, l, 3, 11, ALPHA);
            else ln_phase(args, LDSP, l, 2, l == 0, 1, 0, 11, l == 0 ? ALPHA : 1.0f);
            if (!(l == 1 && f == 1)) grid_bar(args, LDSP);
        }
    }
}

extern "C" void kernel_launch(void* const* d_in, const int* in_sizes, int n_in, void* d_out, int out_size, void* d_ws, size_t ws_size, hipStream_t stream) {
    static int grid = 0;
    if (grid == 0) {
        if (n_in != 28 || (size_t)out_size != O_END || ws_size < WS_END) { fprintf(stderr, "kernel_launch: unexpected sizes n_in %d out %d ws %zu (need %zu)\n", n_in, out_size, ws_size, (size_t)WS_END); grid = -1; return; }
        int dev = 0, cus = 0, per_cu = 0;
        hipGetDevice(&dev); hipDeviceGetAttribute(&cus, hipDeviceAttributeMultiprocessorCount, dev);
        hipFuncSetAttribute((const void*)mega_fwd, hipFuncAttributeMaxDynamicSharedMemorySize, LDS_BYTES);
        hipOccupancyMaxActiveBlocksPerMultiprocessor(&per_cu, (const void*)mega_fwd, NWAVES * 64, LDS_BYTES);
        (void)hipGetLastError();
        if (per_cu < 1 || cus < 256) { fprintf(stderr, "kernel_launch: occupancy %d cus %d\n", per_cu, cus); grid = -1; return; }
        grid = 256;
    }
    if (grid < 0) return;
    if (hipMemsetAsync(d_ws, 0, 65536, stream) != hipSuccess) { fprintf(stderr, "memset failed\n"); return; }
    Args a{};
    for (int i = 0; i < 28; ++i) a.in[i] = (const float*)d_in[i];
    a.out = (float*)d_out; a.ws = (unsigned char*)d_ws;
    void* kargs[] = {&a};
    hipError_t e = hipLaunchCooperativeKernel((const void*)mega_fwd, dim3(grid), dim3(NWAVES * 64), kargs, LDS_BYTES, stream);
    if (e != hipSuccess) fprintf(stderr, "cooperative launch failed: %s\n", hipGetErrorString(e));
}
```

```cpp
#include <hip/hip_runtime.h>
#include <hip/hip_cooperative_groups.h>
#include <cstdio>
#include <cstdint>
namespace cg = cooperative_groups;
namespace pg8 {
#define PG8_LAS __attribute__((address_space(3)))
typedef unsigned short bf16_t;
typedef short bf16x8 __attribute__((ext_vector_type(8)));
typedef float f32x4 __attribute__((ext_vector_type(4)));
typedef unsigned u32x4 __attribute__((ext_vector_type(4)));
constexpr int BM = 256, BK = 64, HALF = 128, HTB = HALF * BK * 2  , STAGE_BYTES = 8 * HTB, NXCD = 8, WGM = 8;

__host__ __device__ __forceinline__ int lds_byte(int r, int c) { const int st = (r >> 4) * 2 + (c >> 5), rr = r & 15, cc = c & 31, ob = rr * 64 + cc * 2; return st * 1024 + (ob ^ (((ob >> 9) & 1) << 5)); }
__host__ __device__ __forceinline__ void stage_rc(int b, int& R, int& C) { const int st = b / 1024, sb = b % 1024, swz = sb ^ (((sb >> 9) & 1) << 5); R = (st >> 1) * 16 + swz / 64; C = (st & 1) * 32 + (swz % 64) / 2; }
__host__ __device__ __forceinline__ int perm32(int rho) { const int n = rho >> 4, i = rho & 15; return 8 * (i >> 2) + 4 * n + (i & 3); }

struct Unit { int pm, pn, k0, nt; };
struct Gemm { const bf16_t* A; const bf16_t* Bt; int M, N, K; };

struct StaticOrder {
    int nM, nN, nwg, G, c, ntf;
    __host__ __device__ void init(int M, int N, int G_, int c_, int K_ = 1024) { nM = M / BM; nN = N / BM; nwg = nM * nN; G = G_; c = c_; ntf = K_ / BK; }
    __host__ __device__ bool next(int i, Unit& u) const {
        const long L = (long)i * G + c; if (L >= nwg) return false;
        int wgid = (int)L; { const int q = nwg / NXCD, r = nwg % NXCD, xcd = wgid % NXCD, off = wgid / NXCD; wgid = (xcd < r ? xcd * (q + 1) : r * (q + 1) + (xcd - r) * q) + off; }
        const int nig = WGM * nN, gid = wgid / nig, fm = gid * WGM, gsz = (nM - fm) < WGM ? (nM - fm) : WGM;
        u.pm = fm + ((wgid % nig) % gsz); u.pn = (wgid % nig) / gsz; u.k0 = 0; u.nt = ntf; return true;
    }
    __device__ __forceinline__ void a_ready(const Unit&) const {}
    __device__ __forceinline__ void done(const Unit&) const {}
};

struct SplitOrder {
    StaticOrder base; int ppu, c;
    static constexpr int PK = 4;
    __host__ __device__ void init(int K_, int G_, int c_) { base.init(16384, 1024, G_, c_, K_); ppu = (K_ / BK) / PK; c = c_; }
    __host__ __device__ bool next(int i, Unit& u) const {
        if (i == 0) return base.next(0, u);
        if (i == 1 && c < 8 * ppu) { const int j = c / ppu, p = c - j * ppu; u.pm = 64 + (j >> 2); u.pn = j & 3; u.k0 = p * PK; u.nt = PK; return true; }
        return false;
    }
    __device__ __forceinline__ void a_ready(const Unit&) const {}
    __device__ __forceinline__ void done(const Unit&) const {}
};

__device__ __forceinline__ unsigned cvt_pk_bf16(float lo, float hi) { unsigned r; asm volatile("v_cvt_pk_bf16_f32 %0, %1, %2" : "=v"(r) : "v"(lo), "v"(hi)); return r; }
typedef float f32x2 __attribute__((ext_vector_type(2)));
__device__ __forceinline__ f32x2 gelu_pk(f32x2 v) {
    const f32x2 av = __builtin_elementwise_abs(v), d = av * 0.2316418882f + 1.0f;
    f32x2 t; t.x = __builtin_amdgcn_rcpf(d.x); t.y = __builtin_amdgcn_rcpf(d.y);
    f32x2 q = t * 0.5307027145f + (-0.7265760135f); q = q * t + 0.7107068705f; q = q * t + (-0.142248368f); q = q * t + 0.127414796f; q = q * t;
    const f32x2 s = (v * v) * (-0.72134752044f);
    f32x2 e; e.x = __builtin_amdgcn_exp2f(s.x); e.y = __builtin_amdgcn_exp2f(s.y);
    const f32x2 m = v * (q * e), r = v - m;
    f32x2 o; o.x = v.x < 0.f ? m.x : r.x; o.y = v.y < 0.f ? m.y : r.y; return o;
}

template <int ACT  > struct EpiBf16 {
    static constexpr bool PERM = true, AFTER_DRAIN = false; static_assert(ACT == 0 || ACT == 1, "EpiBf16: ACT is 0 (none) or 1 (gelu_pk)");
    bf16_t* O; int ldc; const float* bias; int split_cols; size_t split_stride; float scale0;
    __device__ __forceinline__ void operator()(const f32x4 (&acc)[2][2][4][2], const Unit& u, int wr, int wc, int fr, int fq) const {
        const int row0 = u.pm * BM + wr * 64 + fr; int colt = u.pn * BM; bf16_t* base = O;
        float sc = 1.f; if (split_cols) { const int t = colt / split_cols; base += (size_t)t * split_stride; colt -= t * split_cols; if (t == 0) sc = scale0; }
        const int col0 = colt + wc * 32 + 8 * fq, bcol0 = u.pn * BM + wc * 32 + 8 * fq;
        f32x4 bv[2][2];
#pragma unroll
        for (int bj = 0; bj < 2; ++bj)
#pragma unroll
            for (int n = 0; n < 2; ++n) bv[bj][n] = bias ? *(const f32x4*)(bias + bcol0 + bj * HALF + 4 * n) : (f32x4){0.f, 0.f, 0.f, 0.f};
#pragma unroll
        for (int ai = 0; ai < 2; ++ai)
#pragma unroll
            for (int m = 0; m < 4; ++m) { bf16_t* rowp = base + (size_t)(row0 + ai * HALF + m * 16) * ldc + col0;
#pragma unroll
                for (int bj = 0; bj < 2; ++bj) { f32x4 v0 = acc[ai][bj][m][0] + bv[bj][0], v1 = acc[ai][bj][m][1] + bv[bj][1];
                    if (ACT == 1) { f32x2 a = gelu_pk((f32x2){v0[0], v0[1]}), b = gelu_pk((f32x2){v0[2], v0[3]}), c = gelu_pk((f32x2){v1[0], v1[1]}), d = gelu_pk((f32x2){v1[2], v1[3]});
                        v0 = (f32x4){a.x, a.y, b.x, b.y}; v1 = (f32x4){c.x, c.y, d.x, d.y}; }
                    v0 = v0 * sc; v1 = v1 * sc; u32x4 w; w.x = cvt_pk_bf16(v0[0], v0[1]); w.y = cvt_pk_bf16(v0[2], v0[3]); w.z = cvt_pk_bf16(v1[0], v1[1]); w.w = cvt_pk_bf16(v1[2], v1[3]);
                    *(u32x4*)(rowp + bj * HALF) = w; } }
    }
};
template <class Epi, class Sched, bool ALIGN_EPI = false, bool SP2 = false>
__device__ __forceinline__ void gemm_phase(PG8_LAS unsigned char* lds, const Gemm g, const Sched& S, const Epi& E) {
    int tid_ = threadIdx.x; asm volatile("" : "+v"(tid_));
    const int tid = tid_, wid = __builtin_amdgcn_readfirstlane(tid >> 6), lane = tid & 63, wr = wid >> 2, wc = wid & 3, fr = lane & 15, fq = lane >> 4;
    const int K = g.K;
    unsigned voffA[2], voffB[2];
#pragma unroll
    for (int i = 0; i < 2; ++i) { int R, C; stage_rc(tid * 16 + i * 8192, R, C); const int Rb = Epi::PERM ? ((R & ~31) + perm32(R & 31)) : R;
        voffA[i] = (unsigned)(R * K + C) * 2u; voffB[i] = (unsigned)(Rb * K + C) * 2u; }
    const size_t kstep = (size_t)(BK * 2);
    const size_t hstep = (size_t)HALF * K * 2;
    const size_t tstep = 2 * hstep;
    const unsigned ldsw = (unsigned)wid * 1024u;
    const int aoff = lds_byte(wr * 64 + fr, fq * 8), boff = lds_byte(wc * 32 + fr, fq * 8);
#define PG8_SA(b, h) (((b) * 2 + (h)) * HTB)
#define PG8_SB(b, h) ((4 + (b) * 2 + (h)) * HTB)
#define PG8_STAGE(bufoff, gbase, voff) do { _Pragma("unroll") for (int _i = 0; _i < 2; ++_i) \
        __builtin_amdgcn_global_load_lds((const unsigned*)((const char*)(gbase) + (voff)[_i]), (PG8_LAS unsigned*)(lds + (bufoff) + ldsw + _i * 8192), 16, 0, 0); } while (0)
#define PG8_LDA(dst, b, h) do { _Pragma("unroll") for (int m = 0; m < 4; ++m) _Pragma("unroll") for (int k = 0; k < 2; ++k) dst[m][k] = *(const PG8_LAS bf16x8*)(lds + PG8_SA(b, h) + aoff + m * 2048 + k * 1024); } while (0)
#define PG8_LDB(dst, b, h) do { _Pragma("unroll") for (int n = 0; n < 2; ++n) _Pragma("unroll") for (int k = 0; k < 2; ++k) dst[n][k] = *(const PG8_LAS bf16x8*)(lds + PG8_SB(b, h) + boff + n * 2048 + k * 1024); } while (0)
#define PG8_MMA(ai, bj, At, Bt) do { __builtin_amdgcn_s_setprio(1); _Pragma("unroll") for (int m = 0; m < 4; ++m) _Pragma("unroll") for (int n = 0; n < 2; ++n) _Pragma("unroll") for (int k = 0; k < 2; ++k) \
        acc[ai][bj][m][n] = __builtin_amdgcn_mfma_f32_16x16x32_bf16(Bt[n][k], At[m][k], acc[ai][bj][m][n], 0, 0, 0); __builtin_amdgcn_s_setprio(0); } while (0)
#define PG8_WAIT_V(n) asm volatile("s_waitcnt vmcnt(" #n ")" ::: "memory")
#define PG8_WAIT_L(n) asm volatile("s_waitcnt lgkmcnt(" #n ")" ::: "memory")
#define PG8_BAR __builtin_amdgcn_s_barrier()
#define PG8_SCHED __builtin_amdgcn_sched_barrier(0)
    Unit cur, nxt; int ui = 0;
    if (!S.next(0, cur)) return;
    f32x4 acc[2][2][4][2];
#pragma unroll
    for (int a = 0; a < 2; ++a)
#pragma unroll
        for (int b = 0; b < 2; ++b)
#pragma unroll
            for (int m = 0; m < 4; ++m)
#pragma unroll
                for (int n = 0; n < 2; ++n) acc[a][b][m][n] = (f32x4){0.f, 0.f, 0.f, 0.f};
    bf16x8 At[4][2], B0[2][2], B1[2][2];
    const char* cA = (const char*)g.A + (size_t)cur.pm * tstep + (size_t)cur.k0 * kstep; const char* cB = (const char*)g.Bt + (size_t)cur.pn * tstep + (size_t)cur.k0 * kstep;
    S.a_ready(cur);
    if constexpr (SP2) {
        PG8_STAGE(PG8_SB(0, 0), cB, voffB); PG8_STAGE(PG8_SB(0, 1), cB + hstep, voffB); PG8_STAGE(PG8_SA(0, 0), cA, voffA); PG8_STAGE(PG8_SA(0, 1), cA + hstep, voffA);
        if (wr == 1) PG8_BAR;
        PG8_WAIT_V(2); PG8_BAR;
        PG8_STAGE(PG8_SB(1, 0), cB + kstep, voffB); PG8_STAGE(PG8_SA(1, 0), cA + kstep, voffA); PG8_STAGE(PG8_SB(1, 1), cB + hstep + kstep, voffB);
        PG8_WAIT_V(6); PG8_BAR;
    } else {
        PG8_STAGE(PG8_SB(0, 0), cB, voffB); PG8_STAGE(PG8_SA(0, 0), cA, voffA); PG8_STAGE(PG8_SB(0, 1), cB + hstep, voffB); PG8_STAGE(PG8_SA(0, 1), cA + hstep, voffA);
        if (wr == 1) PG8_BAR;
        PG8_WAIT_V(4); PG8_BAR;
        PG8_STAGE(PG8_SB(1, 0), cB + kstep, voffB); PG8_STAGE(PG8_SA(1, 0), cA + kstep, voffA); PG8_STAGE(PG8_SB(1, 1), cB + hstep + kstep, voffB);
        PG8_WAIT_V(6); PG8_BAR;
    }
    for (;;) {
        const bool has_next = S.next(ui + 1, nxt);
        const char* nA = has_next ? (const char*)g.A + (size_t)nxt.pm * tstep + (size_t)nxt.k0 * kstep : cA; const char* nB = has_next ? (const char*)g.Bt + (size_t)nxt.pn * tstep + (size_t)nxt.k0 * kstep : cB;
        const int nt = cur.nt;
        for (int t = 0; t < nt; t += 2) {
            const bool last = (t == nt - 2);
            const char* a1 = cA + (size_t)(t + 1) * kstep;
            const char* a2 = last ? nA : cA + (size_t)(t + 2) * kstep; const char* b2 = last ? nB : cB + (size_t)(t + 2) * kstep;
            const char* a3 = a2 + kstep; const char* b3 = b2 + kstep;
            if (last && has_next) S.a_ready(nxt);
            if constexpr (SP2) {
            PG8_LDB(B0, 0, 0); PG8_LDB(B1, 0, 1); PG8_SCHED; PG8_LDA(At, 0, 0); PG8_STAGE(PG8_SA(1, 1), a1 + hstep, voffA);
            PG8_WAIT_V(8); PG8_WAIT_L(0); PG8_BAR; PG8_MMA(0, 0, At, B0); PG8_MMA(0, 1, At, B1); PG8_BAR; PG8_SCHED;
            PG8_LDA(At, 0, 1); PG8_STAGE(PG8_SB(0, 0), b2, voffB); PG8_STAGE(PG8_SB(0, 1), b2 + hstep, voffB); PG8_STAGE(PG8_SA(0, 0), a2, voffA);
            PG8_WAIT_V(8); PG8_WAIT_L(0); PG8_BAR; PG8_MMA(1, 0, At, B0); PG8_MMA(1, 1, At, B1); PG8_BAR; PG8_SCHED;
            PG8_LDB(B0, 1, 0); PG8_LDB(B1, 1, 1); PG8_SCHED; PG8_LDA(At, 1, 0); PG8_STAGE(PG8_SA(0, 1), a2 + hstep, voffA);
            PG8_WAIT_V(8); PG8_WAIT_L(0); PG8_BAR; PG8_MMA(0, 0, At, B0); PG8_MMA(0, 1, At, B1); PG8_BAR; PG8_SCHED;
            PG8_LDA(At, 1, 1); PG8_STAGE(PG8_SB(1, 0), b3, voffB); PG8_STAGE(PG8_SB(1, 1), b3 + hstep, voffB); PG8_STAGE(PG8_SA(1, 0), a3, voffA);
            PG8_WAIT_V(8); PG8_WAIT_L(0); PG8_BAR; PG8_MMA(1, 0, At, B0); PG8_MMA(1, 1, At, B1); PG8_BAR; PG8_SCHED;
            } else {
            PG8_LDB(B0, 0, 0); PG8_SCHED; PG8_LDA(At, 0, 0); PG8_STAGE(PG8_SA(1, 1), a1 + hstep, voffA);
            PG8_WAIT_L(8); PG8_BAR; PG8_WAIT_L(0); PG8_MMA(0, 0, At, B0); PG8_BAR; PG8_SCHED;
            PG8_LDB(B1, 0, 1); PG8_STAGE(PG8_SB(0, 0), b2, voffB);
            PG8_BAR; PG8_WAIT_L(0); PG8_MMA(0, 1, At, B1); PG8_BAR;
            PG8_LDA(At, 0, 1); PG8_STAGE(PG8_SA(0, 0), a2, voffA);
            PG8_BAR; PG8_WAIT_L(0); PG8_MMA(1, 0, At, B0); PG8_BAR; PG8_SCHED;
            PG8_STAGE(PG8_SB(0, 1), b2 + hstep, voffB);
            PG8_WAIT_V(6); PG8_BAR; PG8_MMA(1, 1, At, B1); PG8_BAR;
            PG8_LDB(B0, 1, 0); PG8_SCHED; PG8_LDA(At, 1, 0); PG8_STAGE(PG8_SA(0, 1), a2 + hstep, voffA);
            PG8_WAIT_L(8); PG8_BAR; PG8_WAIT_L(0); PG8_MMA(0, 0, At, B0); PG8_BAR; PG8_SCHED;
            PG8_LDB(B1, 1, 1); PG8_STAGE(PG8_SB(1, 0), b3, voffB);
            PG8_BAR; PG8_WAIT_L(0); PG8_MMA(0, 1, At, B1); PG8_BAR;
            PG8_LDA(At, 1, 1); PG8_STAGE(PG8_SA(1, 0), a3, voffA);
            PG8_BAR; PG8_WAIT_L(0); PG8_MMA(1, 0, At, B0); PG8_BAR; PG8_SCHED;
            PG8_STAGE(PG8_SB(1, 1), b3 + hstep, voffB);
            PG8_WAIT_V(6); PG8_BAR; PG8_MMA(1, 1, At, B1); PG8_BAR;
            }
        }
        if constexpr (ALIGN_EPI) { if (wr == 0) PG8_BAR; }
        if constexpr (!Epi::AFTER_DRAIN) { E(acc, cur, wr, wc, fr, fq); S.done(cur); }
        if (!has_next) break;
#pragma unroll
        for (int a = 0; a < 2; ++a)
#pragma unroll
            for (int b = 0; b < 2; ++b)
#pragma unroll
                for (int m = 0; m < 4; ++m)
#pragma unroll
                    for (int n = 0; n < 2; ++n) acc[a][b][m][n] = (f32x4){0.f, 0.f, 0.f, 0.f};
        cur = nxt; cA = nA; cB = nB; ++ui;
        if constexpr (ALIGN_EPI) { if (wr == 1) PG8_BAR; }
    }
    PG8_WAIT_V(0);
    if constexpr (!ALIGN_EPI) { if (wr == 0) PG8_BAR; }
    PG8_BAR;
    if constexpr (Epi::AFTER_DRAIN) { E.fused(acc, cur, wr, wc, fr, fq, lds, wid, lane); S.done(cur); }
#undef PG8_SA
#undef PG8_SB
#undef PG8_STAGE
#undef PG8_LDA
#undef PG8_LDB
#undef PG8_MMA
#undef PG8_WAIT_V
#undef PG8_WAIT_L
#undef PG8_BAR
#undef PG8_SCHED
}
}
#define PG8_SP2 true
#define PG8_ALIGN true

constexpr int D = 1024, TP = 2048, BP = 8, BS = 128, TS = 4;
constexpr int MP = BP * TP, MS = BS * TS, M = MP + MS;
constexpr int DFF = 2816, NWI = 2 * DFF, NIN = 3864, NINP = 4096, NMODC = 9216, NB = BP + BS;
constexpr int SBW = 1664, SFW = 396;
constexpr float LN_EPS = 1e-5f, RMS_EPS = 1e-6f;
constexpr float ALPHA = 1.41421356237f;
constexpr int C_RQ = 0, C_RK = 256, C_RV = 512, C_RG = 768, C_AQ = 1024, C_AK = 1152, C_AV = 1280, C_ALR = 1536, C_AG = 1552,
              C_HQ = 1808, C_HF = 2064, C_HI = 2320, C_HG = 2576, C_DQKV = 2832, C_DB = 3600, C_DA = 3604, C_DG = 3608;
constexpr int SB_RQ = 0, SB_RK = 256, SB_AQ = 512, SB_HQ = 640, SB_DQ = 896, SB_DK = 1152, SB_DV = 1408;
constexpr int SF_ADEC = 0, SF_HF = 128, SF_BETA = 384, SF_DDEC = 388, SF_QK = 392;
constexpr size_t O_Y = 0;
constexpr size_t O_PRET = (size_t)M * D;
constexpr size_t O_PGLA = O_PRET + 2ull * BP * 4 * 64 * 64;
constexpr size_t O_PHG = O_PGLA + 2ull * BP * 4 * 32 * 64;
constexpr size_t O_PGDN = O_PHG + 2ull * BP * 4 * 64 * 64;
constexpr size_t O_PCONV = O_PGDN + 2ull * BP * 4 * 64 * 64;
constexpr size_t O_SRET = O_PCONV + 2ull * BP * 3 * 768;
constexpr size_t O_SGLA = O_SRET + 2ull * BS * 4 * 64 * 64;
constexpr size_t O_SHG = O_SGLA + 2ull * BS * 4 * 32 * 64;
constexpr size_t O_SGDN = O_SHG + 2ull * BS * 4 * 64 * 64;
constexpr size_t O_SCONV = O_SGDN + 2ull * BS * 4 * 64 * 64;
constexpr size_t O_END = O_SCONV + 2ull * BS * 3 * 768;

constexpr size_t MiB = 1u << 20;
constexpr size_t WS_ROPE = 1 * MiB;
constexpr size_t WS_AC = 2 * MiB;
constexpr size_t WS_MOD = 3 * MiB;
constexpr size_t WS_W = 13 * MiB;
constexpr size_t W_WI1 = 0, W_WO1 = 11 * MiB, W_WI2 = W_WO1 + 5 * MiB + MiB / 2, W_WO2 = W_WI2 + 11 * MiB, W_WIN = W_WO2 + 5 * MiB + MiB / 2, W_WOUT = W_WIN + 8 * MiB, W_LAYER = 43 * MiB;
constexpr size_t WS_H = WS_W + 2 * W_LAYER;
constexpr size_t WS_BIG = WS_H + 33 * MiB;
constexpr size_t WS_SB = WS_BIG + 132 * MiB;
constexpr size_t WS_SF = WS_SB + 54 * MiB;
constexpr size_t WS_END = WS_SF + 26 * MiB;
static_assert((size_t)M * SBW * 2 <= 54 * MiB && (size_t)M * SFW * 4 <= 26 * MiB && (size_t)M * 4096 * 2 <= 132 * MiB && (size_t)M * D * 2 <= 33 * MiB, "ws map");

constexpr int LDS_BYTES = 147456;
constexpr int NWAVES = 8;

#define GAS __attribute__((address_space(1)))
#define LAS __attribute__((address_space(3)))
typedef unsigned short bf16;
typedef unsigned v4u __attribute__((ext_vector_type(4)));
typedef unsigned v2u __attribute__((ext_vector_type(2)));
typedef float f32x4 __attribute__((ext_vector_type(4)));
typedef float f32x2 __attribute__((ext_vector_type(2)));
#define LDS_WAIT() asm volatile("s_waitcnt lgkmcnt(0)" ::: "memory")

__device__ __forceinline__ float bf2f(unsigned b) { return __uint_as_float(b << 16); }
__device__ __forceinline__ float bflo(unsigned w) { return __uint_as_float(w << 16); }
__device__ __forceinline__ float bfhi(unsigned w) { return __uint_as_float(w & 0xffff0000u); }
__device__ __forceinline__ unsigned pk2(float lo, float hi) { return pg8::cvt_pk_bf16(lo, hi); }
__device__ __forceinline__ float sigmoidf_(float x) { return 1.0f / (1.0f + __expf(-x)); }
__device__ __forceinline__ float siluf_(float x) { return x / (1.0f + __expf(-x)); }
__device__ __forceinline__ float wave_sum(float v) {
#pragma unroll
    for (int o = 1; o < 64; o <<= 1) v += __shfl_xor(v, o);
    return v;
}
template <int CTRL> __device__ __forceinline__ float dppmov(float v) { return __int_as_float(__builtin_amdgcn_update_dpp(0, __float_as_int(v), CTRL, 0xf, 0xf, true)); }
__device__ __forceinline__ float quad_sum(float v) { v += dppmov<0xB1>(v); v += dppmov<0x4E>(v); return v; }
__device__ __forceinline__ float row8_sum(float v) { v += dppmov<0xB1>(v); v += dppmov<0x4E>(v); v += dppmov<0x141>(v); return v; }
__device__ __forceinline__ float row16_sum(float v) { v += dppmov<0xB1>(v); v += dppmov<0x4E>(v); v += dppmov<0x141>(v); v += dppmov<0x140>(v); return v; }

struct Args { const float* in[28]; float* out; unsigned char* ws; };

struct Ctx {
    int tid, lane, wave, gw, NGW;
    LAS unsigned char* lds;
    float* out; unsigned char* ws;
};
template <class T> __device__ __forceinline__ T* fresh_ptr(T* p) {
    unsigned lo = (unsigned)(uintptr_t)p, hi = (unsigned)((uintptr_t)p >> 32);
    asm volatile("" : "+v"(lo), "+v"(hi));
    lo = __builtin_amdgcn_readfirstlane(lo); hi = __builtin_amdgcn_readfirstlane(hi);
    return (T*)(__attribute__((address_space(1))) T*)(((uintptr_t)hi << 32) | (uintptr_t)lo);
}
__device__ __forceinline__ Ctx make_ctx(const Args& args, LAS unsigned char* lds) {
    Ctx C; int t = threadIdx.x; asm volatile("" : "+v"(t));
    C.tid = t; C.lane = t & 63; C.wave = __builtin_amdgcn_readfirstlane(t >> 6);
    C.gw = (int)blockIdx.x * NWAVES + C.wave; C.NGW = (int)gridDim.x * NWAVES;
    float* op = fresh_ptr(args.out); unsigned char* wp = fresh_ptr(args.ws);
    C.lds = lds; C.out = op; C.ws = wp; return C;
}
__device__ __forceinline__ int batch_of_row(int r) { return r < MP ? (r >> 11) : BP + ((r - MP) >> 2); }


typedef GAS unsigned gu32;
#define RLX_AGENT __ATOMIC_RELAXED, __HIP_MEMORY_SCOPE_AGENT
#define XB_TMO      128
#define XB_XCNT(j)  (256  + 64 * (j))
#define XB_XSUB(j)  (1280 + 64 * (j))
#define XB_XGEN(j)  (2304 + 64 * (j))
#define XB_TOP      3328
#define XB_TOPGEN   3392
#define XCD_BAR_WORDS 3456
#define XB_SPIN_CAP (1u << 18)

__device__ __forceinline__ unsigned xb_ld(unsigned* p)              { return __hip_atomic_load(p, __ATOMIC_RELAXED, __HIP_MEMORY_SCOPE_AGENT); }
__device__ __forceinline__ unsigned xb_add(unsigned* p, unsigned v) { return __hip_atomic_fetch_add(p, v, __ATOMIC_RELAXED, __HIP_MEMORY_SCOPE_AGENT); }
__device__ __forceinline__ unsigned xb_xcc_id() { return (unsigned)__builtin_amdgcn_s_getreg((3 << 11) | 20) & 0xFu; }
#define XB_SPIN(cond, bar) do { unsigned _sp = 0; while (cond) { __builtin_amdgcn_s_sleep(1); \
    if ((++_sp & 255u) == 0u) { if (xb_ld(&(bar)[XB_TMO])) break; if (_sp > XB_SPIN_CAP) { atomicAdd(&(bar)[XB_TMO], 1u); break; } } } } while (0)

struct XcdBarrier {
    unsigned* bar; unsigned x;
    volatile LAS unsigned* st;
};

__device__ __forceinline__ XcdBarrier xcd_barrier_post(unsigned* bar, volatile LAS unsigned* st) {
    XcdBarrier b; b.bar = bar; b.x = xb_xcc_id(); b.st = st;
    if (threadIdx.x == 0) (void)xb_add(&bar[XB_XCNT(b.x)], 1u);
    return b;
}
__device__ __forceinline__ void xcd_barrier_complete(unsigned* bar, unsigned x, unsigned& nloc, unsigned& nx) {
    const unsigned G = gridDim.x * gridDim.y * gridDim.z;
    unsigned sum, cnt, mine, sp = 0u;
    for (;;) {
        sum = 0u; cnt = 0u; mine = 0u;
#pragma unroll
        for (unsigned j = 0; j < 16; ++j) { const unsigned c = xb_ld(&bar[XB_XCNT(j)]); sum += c; cnt += (c > 0u) ? 1u : 0u; mine = (j == x) ? c : mine; }
        if (sum == G) break;
        __builtin_amdgcn_s_sleep(1);
        if ((++sp & 255u) == 0u) { if (xb_ld(&bar[XB_TMO])) break; if (sp > XB_SPIN_CAP) { atomicAdd(&bar[XB_TMO], 1u); break; } }
    }
    nloc = mine > 0u ? mine : 1u; nx = cnt > 0u ? cnt : 1u;
}

__device__ __forceinline__ void xcd_barrier(const XcdBarrier& b) {
    asm volatile("s_waitcnt vmcnt(0)" ::: "memory");
    __syncthreads();
    if (threadIdx.x == 0) {
        unsigned* bar = b.bar;
        __builtin_amdgcn_s_waitcnt(0);
        unsigned nloc = b.st[0], nx = b.st[1];
        if (nloc == 0u) { xcd_barrier_complete(bar, b.x, nloc, nx); b.st[0] = nloc; b.st[1] = nx; }
        const unsigned old = xb_add(&bar[XB_XSUB(b.x)], 1u);
        const unsigned gen = old / nloc;
        if (old + 1u == (gen + 1u) * nloc) {
            __builtin_amdgcn_fence(__ATOMIC_RELEASE, "agent");
            asm volatile("s_waitcnt vmcnt(0)" ::: "memory");
            const unsigned og = xb_add(&bar[XB_TOP], 1u);
            const unsigned tg = og / nx;
            if (og + 1u == (tg + 1u) * nx) xb_add(&bar[XB_TOPGEN], 1u);
            else XB_SPIN(xb_ld(&bar[XB_TOPGEN]) == tg, bar);
            __builtin_amdgcn_fence(__ATOMIC_ACQUIRE, "agent");
            xb_add(&bar[XB_XGEN(b.x)], 1u);
            asm volatile("s_waitcnt vmcnt(0)" ::: "memory");
        } else {
            XB_SPIN(xb_ld(&bar[XB_XGEN(b.x)]) == gen, bar);
            __builtin_amdgcn_fence(__ATOMIC_ACQUIRE, "agent");
            asm volatile("s_waitcnt vmcnt(0)" ::: "memory");
        }
    }
    __syncthreads();
}

constexpr int MISC_OFF = LDS_BYTES - 256;
__device__ __forceinline__ void grid_bar(const Args& args, LAS unsigned char* lds) {
    XcdBarrier b; b.bar = (unsigned*)fresh_ptr(args.ws); b.x = xb_xcc_id(); b.st = (volatile LAS unsigned*)(lds + MISC_OFF);
    xcd_barrier(b);
}

__device__ __forceinline__ float wave_sum2(float v) { v = row16_sum(v); v += __shfl_xor(v, 16); v += __shfl_xor(v, 32); return v; }

namespace pg8 {
struct EpiSwiglu {
    static constexpr bool PERM = true, AFTER_DRAIN = false;
    bf16_t* O; int ldc;
    __device__ __forceinline__ void operator()(const f32x4 (&acc)[2][2][4][2], const Unit& u, int wr, int wc, int fr, int fq) const {
        const int row0 = u.pm * BM + wr * 64 + fr, col0 = u.pn * 128 + wc * 32 + 8 * fq;
#pragma unroll
        for (int ai = 0; ai < 2; ++ai)
#pragma unroll
            for (int m = 0; m < 4; ++m) {
                bf16_t* rowp = O + (size_t)(row0 + ai * HALF + m * 16) * ldc + col0;
                float h[8];
#pragma unroll
                for (int n = 0; n < 2; ++n)
#pragma unroll
                    for (int j = 0; j < 4; ++j) {
                        const float a = acc[ai][0][m][n][j], b = acc[ai][1][m][n][j];
                        const float e = __builtin_amdgcn_exp2f(-1.44269504f * a);
                        h[n * 4 + j] = a * __builtin_amdgcn_rcpf(1.0f + e) * b;
                    }
                u32x4 w; w.x = cvt_pk_bf16(h[0], h[1]); w.y = cvt_pk_bf16(h[2], h[3]); w.z = cvt_pk_bf16(h[4], h[5]); w.w = cvt_pk_bf16(h[6], h[7]);
                *(u32x4*)rowp = w;
            }
    }
};
struct EpiPlain {
    static constexpr bool PERM = true, AFTER_DRAIN = false;
    bf16_t* O; int ldc;
    __device__ __forceinline__ void operator()(const f32x4 (&acc)[2][2][4][2], const Unit& u, int wr, int wc, int fr, int fq) const {
        const int row0 = u.pm * BM + wr * 64 + fr, col0 = u.pn * BM + wc * 32 + 8 * fq;
#pragma unroll
        for (int ai = 0; ai < 2; ++ai)
#pragma unroll
            for (int m = 0; m < 4; ++m) {
                bf16_t* rowp = O + (size_t)(row0 + ai * HALF + m * 16) * ldc + col0;
#pragma unroll
                for (int bj = 0; bj < 2; ++bj) { const f32x4 v0 = acc[ai][bj][m][0], v1 = acc[ai][bj][m][1];
                    u32x4 w; w.x = cvt_pk_bf16(v0[0], v0[1]); w.y = cvt_pk_bf16(v0[2], v0[3]); w.z = cvt_pk_bf16(v1[0], v1[1]); w.w = cvt_pk_bf16(v1[2], v1[3]);
                    *(u32x4*)(rowp + bj * HALF) = w; }
            }
    }
};
struct EpiRes {
    static constexpr bool PERM = false, AFTER_DRAIN = false;
    float* X; float* PART; const float* gate; float scale; int ntf;
    __device__ __forceinline__ void operator()(const f32x4 (&acc)[2][2][4][2], const Unit& u, int wr, int wc, int fr, int fq) const {
        const int col0 = u.pn * BM + wc * 32 + 4 * fq;
        const bool full = (u.nt == ntf);
        float* pbase = PART + (size_t)(u.k0 / SplitOrder::PK) * (512 * 1024);
#pragma unroll
        for (int ai = 0; ai < 2; ++ai)
#pragma unroll
            for (int m = 0; m < 4; ++m) {
                const int r = u.pm * BM + ai * HALF + wr * 64 + m * 16 + fr;
                const int bi = r < 16384 ? (r >> 11) : 8 + ((r - 16384) >> 2);
                const float* gp = gate + (size_t)bi * 9216;
                float* xo = full ? X + (size_t)r * 1024 : pbase + (size_t)(r - 16384) * 1024;
#pragma unroll
                for (int bj = 0; bj < 2; ++bj)
#pragma unroll
                    for (int n = 0; n < 2; ++n) {
                        const int c = col0 + bj * HALF + n * 16;
                        const f32x4 gv = *(const f32x4*)(gp + c);
                        f32x4 o = (gv * scale + scale) * acc[ai][bj][m][n];
                        if (full) o += *(const f32x4*)(xo + c);
                        *(f32x4*)(xo + c) = o;
                    }
                asm volatile("" ::: "memory");
            }
    }
};
struct EpiMod {
    static constexpr bool PERM = false, AFTER_DRAIN = false;
    float* MODp; const float* ada_b;
    __device__ __forceinline__ void operator()(const f32x4 (&acc)[2][2][4][2], const Unit& u, int wr, int wc, int fr, int fq) const {
        const int col0 = u.pn * BM + wc * 32 + 4 * fq;
        const int l = (u.pn * BM) / 9216;
#pragma unroll
        for (int ai = 0; ai < 2; ++ai)
#pragma unroll
            for (int m = 0; m < 4; ++m) {
                const int r = u.pm * BM + ai * HALF + wr * 64 + m * 16 + fr;
                if (r < 136) {
#pragma unroll
                    for (int bj = 0; bj < 2; ++bj)
#pragma unroll
                        for (int n = 0; n < 2; ++n) {
                            const int c = col0 + bj * HALF + n * 16;
                            const f32x4 o = acc[ai][bj][m][n] + *(const f32x4*)(ada_b + c);
                            *(f32x4*)(MODp + (size_t)(l * 136 + r) * 9216 + (c - l * 9216)) = o;
                        }
                }
            }
    }
};
}

__device__ __forceinline__ void transpose_item(const float* W, int K, int N, bf16* WT, int dest_row0, LAS float* scr, int k0, int n0, int lane) {
    const int nn = n0 + (lane & 31); const bool ok = nn < N;
    float tv[32];
#pragma unroll
    for (int i = 0; i < 32; ++i) { const int kk = 2 * i + (lane >> 5); tv[i] = ok ? W[(size_t)(k0 + kk) * N + nn] : 0.f; }
#pragma unroll
    for (int i = 0; i < 32; ++i) { const int kk = 2 * i + (lane >> 5); scr[kk * 33 + (lane & 31)] = tv[i]; }
    LDS_WAIT();
    const int c = lane & 7;
#pragma unroll
    for (int j = 0; j < 4; ++j) { const int n = (lane >> 3) + 8 * j; const LAS float* s = scr + (8 * c) * 33 + n;
        v4u o; o.x = pk2(s[0 * 33], s[1 * 33]); o.y = pk2(s[2 * 33], s[3 * 33]); o.z = pk2(s[4 * 33], s[5 * 33]); o.w = pk2(s[6 * 33], s[7 * 33]);
        *(v4u*)(WT + (size_t)(dest_row0 + n) * K + k0 + 8 * c) = o; }
    LDS_WAIT();
}

constexpr int I_WI = 16 * 176, I_WO = 44 * 32, I_WIN = 16 * 121, I_WOUT = 16 * 32, I_ADA = 16 * 288;
constexpr int I_MAIN = 2 * I_WI + 2 * I_WO + I_WIN + I_WOUT, I_LAYER = I_MAIN + I_ADA;
__device__ __forceinline__ void convert_item(const Args& args, unsigned char* ws, int l, int r, LAS float* scr, int lane) {
    unsigned char* wl = ws + WS_W + (size_t)l * W_LAYER;
    if (r < 2 * (I_WI + I_WO)) {
        const int f = r / (I_WI + I_WO); r -= f * (I_WI + I_WO);
        if (r < I_WI) {
            const int kb = r / 176, nb = r % 176, n0 = nb * 32;
            const int half = n0 / DFF, j = n0 - half * DFF, t = j >> 7, jj = j & 127;
            transpose_item((f ? args.in[15] : args.in[13]) + (size_t)l * D * NWI, D, NWI, (bf16*)(wl + (f ? W_WI2 : W_WI1)), 256 * t + 128 * half + jj, scr, kb * 64, n0, lane);
        } else { r -= I_WI;
            const int kb = r / 32, nb = r % 32;
            transpose_item((f ? args.in[16] : args.in[14]) + (size_t)l * DFF * D, DFF, D, (bf16*)(wl + (f ? W_WO2 : W_WO1)), nb * 32, scr, kb * 64, nb * 32, lane);
        }
        return;
    }
    r -= 2 * (I_WI + I_WO);
    if (r < I_WIN) { const int kb = r / 121, nb = r % 121;
        transpose_item(args.in[17] + (size_t)l * D * NIN, D, NIN, (bf16*)(wl + W_WIN), nb * 32, scr, kb * 64, nb * 32, lane); return; }
    r -= I_WIN;
    if (r < I_WOUT) { const int kb = r / 32, nb = r % 32;
        transpose_item(args.in[27] + (size_t)l * D * D, D, D, (bf16*)(wl + W_WOUT), nb * 32, scr, kb * 64, nb * 32, lane); return; }
    r -= I_WOUT;
    { const int kb = r / 288, nb = r % 288;
        transpose_item(args.in[9] + (size_t)l * D * NMODC, D, NMODC, (bf16*)(ws + WS_BIG), l * NMODC + nb * 32, scr, kb * 64, nb * 32, lane); }
}

__device__ __forceinline__ void p0_prologue(const Args& args, LAS unsigned char* lds_) {
    const Ctx C = make_ctx(args, lds_);
    LAS float* scr = (LAS float*)(C.lds + C.wave * 16384);
    for (int it = C.gw; it < 2 * I_ADA; it += C.NGW) convert_item(args, C.ws, it / I_ADA, I_MAIN + it % I_ADA, scr, C.lane);
    const int gt = C.gw * 64 + C.lane, NGT = C.NGW * 64;
    for (int i = gt; i < 2 * 224 * 128; i += NGT) { const int l = i / (224 * 128), rr = (i / 128) % 224, ch = i & 127;
        *(v4u*)(C.ws + WS_W + (size_t)l * W_LAYER + W_WIN + ((size_t)(3872 + rr) * 1024 + ch * 8) * 2) = (v4u){0u, 0u, 0u, 0u}; }
    for (int i = gt; i < 256 * 256; i += NGT) { const int row = i >> 8, c4 = (i & 255) * 4;
        v2u o = (v2u){0u, 0u};
        if (row < NB) { const float* src = row < BP ? args.in[7] + (size_t)row * D : args.in[8] + (size_t)(row - BP) * D; const f32x4 v = *(const f32x4*)(src + c4);
            o.x = pk2(siluf_(v.x), siluf_(v.y)); o.y = pk2(siluf_(v.z), siluf_(v.w)); }
        *(v2u*)(C.ws + WS_AC + ((size_t)row * D + c4) * 2) = o; }
    for (int i = gt; i < 2052 * 32; i += NGT) { const int p = i >> 5, j = i & 31; const double pos = p < 2048 ? (double)p : (double)(16384 + (p - 2048));
        double inv = 1.0; for (int q = 0; q < j; ++q) inv *= 0.7498942093324559;
        const double ang = pos * inv; const double n = rint(ang * 0.15915494309189535);
        const float rr = (float)((ang - n * 6.283185307179586) - n * 2.4492935982947064e-16);
        ((f32x2*)(C.ws + WS_ROPE))[i] = (f32x2){__cosf(rr), __sinf(rr)}; }
}

__device__ __forceinline__ void p1_convert(const Args& args, LAS unsigned char* lds_) {
    const Ctx C = make_ctx(args, lds_);
    if ((int)blockIdx.x < 72) return;
    LAS float* scr = (LAS float*)(C.lds + C.wave * 16384);
    constexpr int I_F0 = I_WI + I_WO, I_P0 = I_F0 + I_WIN;
    for (int it = ((int)blockIdx.x - 72) * NWAVES + C.wave; it < I_P0; it += 184 * NWAVES) {
        if (it < I_F0) convert_item(args, C.ws, 0, it, scr, C.lane);
        else convert_item(args, C.ws, 0, 2 * I_F0 + (it - I_F0), scr, C.lane);
    }
}

__device__ __forceinline__ void p2_modulate0(const Args& args, LAS unsigned char* lds_) {
    const Ctx C = make_ctx(args, lds_);
    const float* MOD = (const float*)(C.ws + WS_MOD); bf16* H = (bf16*)(C.ws + WS_H);
    for (int r = C.gw; r < M; r += C.NGW) {
        const float* xr = r < MP ? args.in[0] + (size_t)r * D : args.in[1] + (size_t)(r - MP) * D;
        const float* modr = MOD + (size_t)batch_of_row(r) * NMODC;
#pragma unroll
        for (int j = 0; j < 4; ++j) { const int c = (C.lane + 64 * j) * 4;
            const f32x4 v = *(const f32x4*)(xr + c), sh = *(const f32x4*)(modr + c), sc = *(const f32x4*)(modr + 1024 + c);
            const f32x4 h = v * (sc + 1.0f) + sh;
            *(f32x4*)(C.out + (size_t)r * D + c) = v * ALPHA;
            *(v2u*)(H + (size_t)r * D + c) = (v2u){pk2(h.x, h.y), pk2(h.z, h.w)}; }
    }
}

__device__ __forceinline__ void ln_phase(const Args& args, LAS unsigned char* lds_, int l, int which, bool write_h, int hl, int shc, int npart, float xscale) {
    const Ctx C = make_ctx(args, lds_);
    const float* MOD = (const float*)(C.ws + WS_MOD); bf16* H = (bf16*)(C.ws + WS_H);
    const float* g = args.in[11] + (size_t)(l * 3 + which) * D; const float* b = args.in[12] + (size_t)(l * 3 + which) * D;
    f32x4 nv[4];
    if (C.gw < M) {
#pragma unroll
        for (int j = 0; j < 4; ++j) nv[j] = *(const f32x4*)(C.out + (size_t)C.gw * D + (C.lane + 64 * j) * 4); }
#pragma unroll 1
    for (int r = C.gw; r < M; r += C.NGW) {
        float* xr = C.out + (size_t)r * D;
        f32x4 v[4]; float s = 0.f;
#pragma unroll
        for (int j = 0; j < 4; ++j) v[j] = nv[j];
        if (r + C.NGW < M) {
#pragma unroll
            for (int j = 0; j < 4; ++j) nv[j] = *(const f32x4*)(xr + (size_t)C.NGW * D + (C.lane + 64 * j) * 4); }
        if (r >= MP) { const float* pp = (const float*)(C.ws + WS_SB) + (size_t)(r - MP) * D;
#pragma unroll 1
            for (int p = 0; p < npart; ++p, pp += 512 * 1024) {
#pragma unroll
                for (int j = 0; j < 4; ++j) v[j] += *(const f32x4*)(pp + (C.lane + 64 * j) * 4); } }
#pragma unroll
        for (int j = 0; j < 4; ++j) s += (v[j].x + v[j].y) + (v[j].z + v[j].w);
        const float mean = wave_sum2(s) * (1.f / D); float s2 = 0.f;
#pragma unroll
        for (int j = 0; j < 4; ++j) { v[j] = v[j] - mean; s2 += (v[j].x * v[j].x + v[j].y * v[j].y) + (v[j].z * v[j].z + v[j].w * v[j].w); }
        const float rstd = 1.f / sqrtf(wave_sum2(s2) * (1.f / D) + LN_EPS);
        const float* modr = MOD + (size_t)(hl * NB + batch_of_row(r)) * NMODC + shc * 1024;
#pragma unroll
        for (int j = 0; j < 4; ++j) { const int c = (C.lane + 64 * j) * 4;
            const f32x4 xn = v[j] * rstd * *(const f32x4*)(g + c) + *(const f32x4*)(b + c);
            *(f32x4*)(xr + c) = xn * xscale;
            if (write_h) { const f32x4 sh = *(const f32x4*)(modr + c), sc = *(const f32x4*)(modr + 1024 + c); const f32x4 h = xn * (sc + 1.0f) + sh;
                *(v2u*)(H + (size_t)r * D + c) = (v2u){pk2(h.x, h.y), pk2(h.z, h.w)}; }
        }
    }
}

struct PrepRaw { unsigned short rq1[4], rq2[4], rk1[4], rk2[4], aq[2], hf[4], hq[4], dx[12], db, da; v4u alr0, alr1; };
__device__ __forceinline__ void prep_load(PrepRaw& x, const bf16* P, int lane) {
    const int j = lane & 31;
#pragma unroll
    for (int h = 0; h < 4; ++h) { x.rq1[h] = P[C_RQ + h * 64 + j]; x.rq2[h] = P[C_RQ + h * 64 + 32 + j]; x.rk1[h] = P[C_RK + h * 64 + j]; x.rk2[h] = P[C_RK + h * 64 + 32 + j]; }
    x.alr0 = *(const v4u*)(P + C_ALR); x.alr1 = *(const v4u*)(P + C_ALR + 8);
#pragma unroll
    for (int i = 0; i < 2; ++i) x.aq[i] = P[C_AQ + lane + 64 * i];
#pragma unroll
    for (int i = 0; i < 4; ++i) { x.hf[i] = P[C_HF + lane + 64 * i]; x.hq[i] = P[C_HQ + lane + 64 * i]; }
#pragma unroll
    for (int i = 0; i < 12; ++i) x.dx[i] = P[C_DQKV + lane + 64 * i];
    x.db = P[C_DB + (lane & 3)]; x.da = P[C_DA + (lane & 3)];
}

__device__ __forceinline__ void prep_phase(const Args& args, LAS unsigned char* lds_, int l) {
    const Ctx C = make_ctx(args, lds_);
    const bf16* PROJ = (const bf16*)(C.ws + WS_BIG); bf16* SB = (bf16*)(C.ws + WS_SB); float* SF = (float*)(C.ws + WS_SF);
    const f32x2* ROPE = (const f32x2*)(C.ws + WS_ROPE);
    const int lane = C.lane;
    const float* wg = args.in[18] + (size_t)l * 16 * 128; const float* bg = args.in[19] + (size_t)l * 128;
    const float* cw = args.in[21] + (size_t)l * 4 * 768;
    LAS float* lwg = (LAS float*)C.lds; LAS float* lcw = lwg + 16 * 128;
    for (int i = C.tid; i < 16 * 128; i += NWAVES * 64) lwg[i] = wg[i];
    for (int i = C.tid; i < 4 * 768; i += NWAVES * 64) lcw[i] = cw[i];
    __syncthreads();
    constexpr int CH = 9;
    const int r0 = C.gw * CH, r1 = min(r0 + CH, M);
    if (r0 >= M) return;
    float lbv[4];
#pragma unroll
    for (int i = 0; i < 4; ++i) { lbv[i] = 0.f; if (l == 1) lbv[i] = 1.0f / (1.0f + expf(args.in[20][lane + 64 * i] - args.in[20][256 + lane + 64 * i])); }
    const float a_neg = -expf(args.in[22][l * 4 + (lane & 3)]), dtb = args.in[23][l * 4 + (lane & 3)];
    const float bg0 = bg[lane], bg1 = bg[lane + 64];
    float w1[12], w2[12], w3[12];
    auto load_window = [&](int r) {
        const bool isp = r < MP; const int rs = r - MP; const int b = isp ? (r >> 11) : (rs >> 2), t = isp ? (r & 2047) : (rs & 3);
        const float* cst = args.in[6] + ((size_t)(l * BS + b) * 3) * 768;
#pragma unroll
        for (int i = 0; i < 12; ++i) { const int ch = lane + 64 * i; const bf16* Pc = PROJ + (size_t)r * NINP + C_DQKV + ch;
            w1[i] = t >= 1 ? bf2f(Pc[-1 * NINP]) : (isp ? 0.f : cst[2 * 768 + ch]);
            w2[i] = t >= 2 ? bf2f(Pc[-2 * NINP]) : (isp ? 0.f : cst[(1 + t) * 768 + ch]);
            w3[i] = t >= 3 ? bf2f(Pc[-3 * NINP]) : (isp ? 0.f : cst[t * 768 + ch]); }
    };
    PrepRaw A; prep_load(A, PROJ + (size_t)r0 * NINP, lane);
    load_window(r0);
#pragma unroll 1
    for (int r = r0; r < r1; ++r) {
        PrepRaw B = A;
        if (r + 1 < r1) prep_load(B, PROJ + (size_t)(r + 1) * NINP, lane);
        int zo = 0; asm volatile("" : "+v"(zo));
        const bool isp = r < MP; const int rs = r - MP;
        const int b = isp ? (r >> 11) : (rs >> 2), t = isp ? (r & 2047) : (rs & 3);
        const int ridx = isp ? t : 2048 + t;
        bf16* sb = SB + (size_t)r * SBW; float* sf = SF + (size_t)r * SFW;
        { const int j = lane & 31; const bool hi = lane >= 32; const f32x2 cs = ROPE[ridx * 32 + j];
#pragma unroll
          for (int h = 0; h < 4; ++h) {
              const float q1 = bf2f(A.rq1[h]), q2 = bf2f(A.rq2[h]), k1 = bf2f(A.rk1[h]), k2 = bf2f(A.rk2[h]);
              const float qo = hi ? (q1 * cs.y + q2 * cs.x) : (q1 * cs.x - q2 * cs.y);
              const float ko = hi ? (k1 * cs.y + k2 * cs.x) : (k1 * cs.x - k2 * cs.y);
              sb[SB_RQ + h * 64 + lane] = (bf16)(pk2(qo, 0.f) & 0xffffu);
              sb[SB_RK + h * 64 + lane] = (bf16)(pk2(ko * 0.125f, 0.f) & 0xffffu);
          } }
        { const unsigned aw[8] = {A.alr0.x, A.alr0.y, A.alr0.z, A.alr0.w, A.alr1.x, A.alr1.y, A.alr1.z, A.alr1.w};
          float x0 = bg0, x1 = bg1;
#pragma unroll
          for (int i = 0; i < 8; ++i) { const float a0 = bflo(aw[i]), a1 = bfhi(aw[i]);
              x0 += a0 * lwg[(2 * i) * 128 + lane + zo] + a1 * lwg[(2 * i + 1) * 128 + lane + zo];
              x1 += a0 * lwg[(2 * i) * 128 + lane + 64 + zo] + a1 * lwg[(2 * i + 1) * 128 + lane + 64 + zo]; }
          const float sp0 = fmaxf(-x0, 0.f) + log1pf(expf(-fabsf(x0))), sp1 = fmaxf(-x1, 0.f) + log1pf(expf(-fabsf(x1)));
          sf[SF_ADEC + lane] = expf(-sp0 * (1.0f / 16.0f)); sf[SF_ADEC + lane + 64] = expf(-sp1 * (1.0f / 16.0f));
          sb[SB_AQ + lane] = (bf16)(pk2(bf2f(A.aq[0]) * 0.17677669529663687f, 0.f) & 0xffffu);
          sb[SB_AQ + lane + 64] = (bf16)(pk2(bf2f(A.aq[1]) * 0.17677669529663687f, 0.f) & 0xffffu); }
#pragma unroll
        for (int i = 0; i < 4; ++i) { const int c = lane + 64 * i;
            sf[SF_HF + c] = lbv[i] + (1.0f - lbv[i]) * sigmoidf_(bf2f(A.hf[i]));
            sb[SB_HQ + c] = (bf16)(pk2(siluf_(bf2f(A.hq[i])) * 0.125f, 0.f) & 0xffffu); }
        { float* cso = isp ? C.out + O_PCONV + ((size_t)(l * BP + b) * 3) * 768 : C.out + O_SCONV + ((size_t)(l * BS + b) * 3) * 768;
          const int so = isp ? t - (TP - 3) : t - 1;
          float uu[12];
#pragma unroll
          for (int i = 0; i < 12; ++i) { const float x0 = bf2f(A.dx[i]);
              const LAS float* cwc = lcw + lane + 64 * i + zo;
              uu[i] = siluf_(x0 * cwc[3 * 768] + w1[i] * cwc[2 * 768] + w2[i] * cwc[768] + w3[i] * cwc[0]);
              if (so >= 0) cso[so * 768 + lane + 64 * i] = x0;
              w3[i] = w2[i]; w2[i] = w1[i]; w1[i] = x0; }
float qr[4];
#pragma unroll
          for (int i = 0; i < 12; ++i) { float sc = 1.0f;
              if (i < 8) { const float nn = wave_sum2(uu[i] * uu[i]); sc = rsqrtf(nn + RMS_EPS) * (i < 4 ? 0.125f : 1.0f); }
              const unsigned wbits = pk2(uu[i] * sc, 0.f) & 0xffffu;
              sb[SB_DQ + i * 64 + lane] = (bf16)wbits;
              if (i < 4) qr[i] = bf2f(wbits);
              else if (i < 8) { const float qk = wave_sum2(qr[i - 4] * bf2f(wbits)); if (lane == 0) sf[SF_QK + (i - 4)] = qk; } }
          if (lane < 4) { sf[SF_BETA + lane] = sigmoidf_(bf2f(A.db));
              const float xx = bf2f(A.da) + dtb; const float sp = fmaxf(xx, 0.f) + log1pf(expf(-fabsf(xx)));
              sf[SF_DDEC + lane] = expf(a_neg * sp); } }
        A = B;
        if (r + 1 < r1) { const int rn = r + 1; const bool ns = rn < MP ? ((rn & 2047) == 0) : (((rn - MP) & 3) == 0); if (ns) load_window(rn); }
    }
}

template <int KIND, int DH, int R> struct Raw { unsigned q[DH / 2]; unsigned k[DH / 2]; unsigned v[(R + 1) / 2]; float f[DH]; float be, de; };

template <int KIND, int DH, int R>
__device__ __forceinline__ void load_tok(Raw<KIND, DH, R>& x, const bf16* qp, const bf16* kp, const bf16* vp, const float* fp) {
    if constexpr (DH == 4) { const v2u w = *(const v2u*)qp; x.q[0] = w.x; x.q[1] = w.y; } else { x.q[0] = *(const unsigned*)qp; }
    if constexpr (KIND != 2) { if constexpr (DH == 4) { const v2u w = *(const v2u*)kp; x.k[0] = w.x; x.k[1] = w.y; } else { x.k[0] = *(const unsigned*)kp; } }
    if constexpr (R == 1) x.v[0] = *vp; else if constexpr (R == 2) x.v[0] = *(const unsigned*)vp; else { const v2u w = *(const v2u*)vp; x.v[0] = w.x; x.v[1] = w.y; }
    if constexpr (KIND == 1) { const f32x2 w = *(const f32x2*)fp; x.f[0] = w.x; x.f[1] = w.y; }
    if constexpr (KIND == 2) { const f32x4 w = *(const f32x4*)fp; x.f[0] = w.x; x.f[1] = w.y; x.f[2] = w.z; x.f[3] = w.w; }
    if constexpr (KIND == 3) { x.be = fp[0]; x.de = fp[4]; }
}

template <int KIND, int DH, int R>
__device__ __forceinline__ void scan_task(const Ctx& C, int row0, int T, int h, int slice, const float* sin, float* sout) {
    const bf16* PROJ = (const bf16*)(C.ws + WS_BIG); const bf16* SB = (const bf16*)(C.ws + WS_SB); const float* SF = (const float*)(C.ws + WS_SF);
    bf16* H = (bf16*)(C.ws + WS_H);
    const int lane = C.lane, dl = lane & 15, rw = lane >> 4;
    const int d0 = dl * DH, v0 = slice * (4 * R) + rw * R;
    constexpr int DK = 16 * DH;
    const bf16 *qp, *kp, *vp; const float* fp; int ks, vs;
    const bf16* sbr = SB + (size_t)row0 * SBW; const bf16* pr = PROJ + (size_t)row0 * NINP; const float* sfr = SF + (size_t)row0 * SFW;
    if constexpr (KIND == 0) { qp = sbr + SB_RQ + h * 64 + d0; kp = sbr + SB_RK + h * 64 + d0; ks = SBW; vp = pr + C_RV + h * 64 + v0; vs = NINP; fp = sfr; }
    if constexpr (KIND == 1) { qp = sbr + SB_AQ + h * 32 + d0; kp = pr + C_AK + h * 32 + d0; ks = NINP; vp = pr + C_AV + h * 64 + v0; vs = NINP; fp = sfr + SF_ADEC + h * 32 + d0; }
    if constexpr (KIND == 2) { qp = sbr + SB_HQ + h * 64 + d0; kp = sbr; ks = SBW; vp = pr + C_HI + h * 64 + v0; vs = NINP; fp = sfr + SF_HF + h * 64 + d0; }
    if constexpr (KIND == 3) { qp = sbr + SB_DQ + h * 64 + d0; kp = sbr + SB_DK + h * 64 + d0; ks = SBW; vp = sbr + SB_DV + h * 64 + v0; vs = SBW; fp = sfr + SF_BETA + h; }
    bf16* op = H + (size_t)row0 * D + KIND * 256 + h * 64 + v0;
    const float rdec = 1.0f - exp2f(-5.0f - (float)h);

    float S[DH][R];
#pragma unroll
    for (int dh = 0; dh < DH; ++dh)
#pragma unroll
        for (int vv = 0; vv < R; ++vv) S[dh][vv] = sin ? sin[(size_t)(d0 + dh) * 64 + v0 + vv] : 0.f;

    typedef Raw<KIND, DH, R> RawT;
    RawT A[4];
#pragma unroll
    for (int u = 0; u < 4; ++u) load_tok<KIND, DH, R>(A[u], qp + (size_t)u * SBW, kp + (size_t)u * ks, vp + (size_t)u * vs, fp + (size_t)u * SFW);
    for (int t0 = 0; t0 < T; t0 += 4) {
        RawT B[4];
        const bool more = t0 + 4 < T;
#pragma unroll
        for (int u = 0; u < 4; ++u) { B[u] = A[u]; }
        if (more) {
#pragma unroll
            for (int u = 0; u < 4; ++u) load_tok<KIND, DH, R>(B[u], qp + (size_t)(t0 + 4 + u) * SBW, kp + (size_t)(t0 + 4 + u) * ks, vp + (size_t)(t0 + 4 + u) * vs, fp + (size_t)(t0 + 4 + u) * SFW);
        }
#pragma unroll
        for (int u = 0; u < 4; ++u) {
            const RawT& x = A[u];
            float q[DH], k[DH], v[R];
            q[0] = bflo(x.q[0]); q[1] = bfhi(x.q[0]); if constexpr (DH == 4) { q[2] = bflo(x.q[1]); q[3] = bfhi(x.q[1]); }
            if constexpr (KIND != 2) { k[0] = bflo(x.k[0]); k[1] = bfhi(x.k[0]); if constexpr (DH == 4) { k[2] = bflo(x.k[1]); k[3] = bfhi(x.k[1]); } }
            if constexpr (R == 1) v[0] = bflo(x.v[0]);
            if constexpr (R >= 2) { v[0] = bflo(x.v[0]); v[1] = bfhi(x.v[0]); }
            if constexpr (R == 4) { v[2] = bflo(x.v[1]); v[3] = bfhi(x.v[1]); }
            float o[R];
            if constexpr (KIND == 3) {
                float ks_[R];
#pragma unroll
                for (int vv = 0; vv < R; ++vv) { float p = 0.f;
#pragma unroll
                    for (int dh = 0; dh < DH; ++dh) { S[dh][vv] *= x.de; p += k[dh] * S[dh][vv]; }
                    ks_[vv] = row16_sum(p); }
#pragma unroll
                for (int vv = 0; vv < R; ++vv) { const float uu = x.be * (v[vv] - ks_[vv]); float p = 0.f;
#pragma unroll
                    for (int dh = 0; dh < DH; ++dh) { S[dh][vv] += k[dh] * uu; p += q[dh] * S[dh][vv]; }
                    o[vv] = row16_sum(p); }
            } else {
#pragma unroll
                for (int dh = 0; dh < DH; ++dh) {
                    float dec, kk;
                    if constexpr (KIND == 0) { dec = rdec; kk = k[dh]; }
                    if constexpr (KIND == 1) { dec = x.f[dh]; kk = k[dh]; }
                    if constexpr (KIND == 2) { dec = x.f[dh]; kk = 1.0f - x.f[dh]; }
#pragma unroll
                    for (int vv = 0; vv < R; ++vv) S[dh][vv] = dec * S[dh][vv] + kk * v[vv];
                }
#pragma unroll
                for (int vv = 0; vv < R; ++vv) { float p = 0.f;
#pragma unroll
                    for (int dh = 0; dh < DH; ++dh) p += q[dh] * S[dh][vv];
                    o[vv] = row16_sum(p); }
            }
            if (dl == 0) {
                bf16* o_ = op + (size_t)(t0 + u) * D;
                if constexpr (R == 1) *o_ = (bf16)(pk2(o[0], 0.f) & 0xffffu);
                if constexpr (R == 2) *(unsigned*)o_ = pk2(o[0], o[1]);
                if constexpr (R == 4) *(v2u*)o_ = (v2u){pk2(o[0], o[1]), pk2(o[2], o[3])};
            }
        }
#pragma unroll
        for (int u = 0; u < 4; ++u) A[u] = B[u];
    }
#pragma unroll
    for (int dh = 0; dh < DH; ++dh)
#pragma unroll
        for (int vv = 0; vv < R; ++vv) sout[(size_t)(d0 + dh) * 64 + v0 + vv] = S[dh][vv];
    (void)DK;
}

template <int KIND, int DH, int R>
__device__ __forceinline__ void scan_long(const Ctx& C, LAS float* wl, int row0, int T, int h, int slice, float* sout) {
    constexpr int CT = 16, LR = 8, DK = LR * DH, NV = (64 / LR) * R, UNR = 8;
    constexpr bool HASK = true, GK = (KIND != 2), HASF = (KIND == 1 || KIND == 2), HASB = (KIND == 3);
    constexpr int OQ = 0, OK_ = OQ + CT * DK, OF = OK_ + (HASK ? CT * DK : 0), OV = OF + (HASF ? CT * DK : 0), OB = OV + CT * NV, BUF = OB + (HASB ? CT * 4 : 0);
    const bf16* PROJ = (const bf16*)(C.ws + WS_BIG); const bf16* SB = (const bf16*)(C.ws + WS_SB); const float* SF = (const float*)(C.ws + WS_SF);
    bf16* H = (bf16*)(C.ws + WS_H);
    const int lane = C.lane, dl = lane & (LR - 1), rw = lane / LR;
    const int d0 = dl * DH;
    const int stok = lane >> 2, spart = lane & 3;
    const GAS bf16 *qg, *kg, *vg; const GAS float *fg, *bg; int ks, vs;
    {
        const GAS bf16* sbr = (const GAS bf16*)(SB + (size_t)row0 * SBW); const GAS bf16* pr = (const GAS bf16*)(PROJ + (size_t)row0 * NINP); const GAS float* sfr = (const GAS float*)(SF + (size_t)row0 * SFW);
        const int vcol = slice * NV;
        if constexpr (KIND == 0) { qg = sbr + SB_RQ + h * 64; kg = sbr + SB_RK + h * 64; ks = SBW; vg = pr + C_RV + h * 64 + vcol; vs = NINP; fg = sfr; bg = sfr; }
        if constexpr (KIND == 1) { qg = sbr + SB_AQ + h * 32; kg = pr + C_AK + h * 32; ks = NINP; vg = pr + C_AV + h * 64 + vcol; vs = NINP; fg = sfr + SF_ADEC + h * 32; bg = sfr; }
        if constexpr (KIND == 2) { qg = sbr + SB_HQ + h * 64; kg = sbr; ks = SBW; vg = pr + C_HI + h * 64 + vcol; vs = NINP; fg = sfr + SF_HF + h * 64; bg = sfr; }
        if constexpr (KIND == 3) { qg = sbr + SB_DQ + h * 64; kg = sbr + SB_DK + h * 64; ks = SBW; vg = sbr + SB_DV + h * 64 + vcol; vs = SBW; fg = sfr; bg = sfr + SF_BETA + h; }
    }
    constexpr int QP = DK / 4;
    qg += (size_t)stok * SBW + spart * QP; kg += (size_t)stok * ks + spart * QP; fg += (size_t)stok * SFW + spart * QP;
    vg += (size_t)(lane & 15) * vs; bg += (size_t)(lane & 15) * SFW;
    GAS bf16* op = (GAS bf16*)(H + (size_t)row0 * D + KIND * 256 + h * 64 + slice * NV + rw * R);
    const float rdec = 1.0f - exp2f(-5.0f - (float)h);

    static_assert(R == 1, "scan_long: one column per lane row");
    f32x2 S2[DH / 2];
#pragma unroll
    for (int i = 0; i < DH / 2; ++i) S2[i] = (f32x2){0.f, 0.f};

    struct SR { v4u rq[QP / 8], rk[QP / 8]; f32x4 rf[QP / 4]; unsigned rv[NV / 2]; float rb0, rb1, rb2; };
    SR s0; s0.rb0 = s0.rb1 = s0.rb2 = 0.f;
    auto stage_load = [&](SR& sr, int c) {
        const size_t t = (size_t)c * CT;
#pragma unroll
        for (int i = 0; i < QP / 8; ++i) { sr.rq[i] = *(const GAS v4u*)(qg + t * SBW + i * 8); if constexpr (GK) sr.rk[i] = *(const GAS v4u*)(kg + t * ks + i * 8); }
        if constexpr (HASF) {
#pragma unroll
            for (int i = 0; i < QP / 4; ++i) sr.rf[i] = *(const GAS f32x4*)(fg + t * SFW + i * 4); }
        if (lane < 16) {
            if constexpr (NV == 4) { const v2u w = *(const GAS v2u*)(vg + t * vs); sr.rv[0] = w.x; sr.rv[1] = w.y; }
            if constexpr (NV == 8) { const v4u w = *(const GAS v4u*)(vg + t * vs); sr.rv[0] = w.x; sr.rv[1] = w.y; sr.rv[2] = w.z; sr.rv[3] = w.w; }
            if constexpr (NV == 16) { const v4u w = *(const GAS v4u*)(vg + t * vs), w2 = *(const GAS v4u*)(vg + t * vs + 8); sr.rv[0] = w.x; sr.rv[1] = w.y; sr.rv[2] = w.z; sr.rv[3] = w.w; sr.rv[4] = w2.x; sr.rv[5] = w2.y; sr.rv[6] = w2.z; sr.rv[7] = w2.w; }
            if constexpr (HASB) { sr.rb0 = bg[t * SFW]; sr.rb1 = bg[t * SFW + 4]; sr.rb2 = bg[t * SFW + 8]; }
        }
    };
    auto stage_write = [&](SR& sr, int b) {
        LAS float* base = wl + b * BUF;
#pragma unroll
        for (int i = 0; i < QP / 8; ++i) {
            LAS float* qd = base + OQ + stok * DK + spart * QP + i * 8;
            *(LAS f32x4*)qd = (f32x4){bflo(sr.rq[i].x), bfhi(sr.rq[i].x), bflo(sr.rq[i].y), bfhi(sr.rq[i].y)}; *(LAS f32x4*)(qd + 4) = (f32x4){bflo(sr.rq[i].z), bfhi(sr.rq[i].z), bflo(sr.rq[i].w), bfhi(sr.rq[i].w)};
            if constexpr (GK) { LAS float* kd = base + OK_ + stok * DK + spart * QP + i * 8;
                *(LAS f32x4*)kd = (f32x4){bflo(sr.rk[i].x), bfhi(sr.rk[i].x), bflo(sr.rk[i].y), bfhi(sr.rk[i].y)}; *(LAS f32x4*)(kd + 4) = (f32x4){bflo(sr.rk[i].z), bfhi(sr.rk[i].z), bflo(sr.rk[i].w), bfhi(sr.rk[i].w)}; }
        }
        if constexpr (HASF) {
#pragma unroll
            for (int i = 0; i < QP / 4; ++i) { *(LAS f32x4*)(base + OF + stok * DK + spart * QP + i * 4) = sr.rf[i];
                if constexpr (KIND == 2) *(LAS f32x4*)(base + OK_ + stok * DK + spart * QP + i * 4) = 1.0f - sr.rf[i]; } }
        if (lane < 16) {
#pragma unroll
            for (int i = 0; i < NV / 2; ++i) { base[OV + lane * NV + 2 * i] = bflo(sr.rv[i]); base[OV + lane * NV + 2 * i + 1] = bfhi(sr.rv[i]); }
            if constexpr (HASB) *(LAS f32x4*)(base + OB + lane * 4) = (f32x4){sr.rb0, sr.rb1, sr.rb2, 0.f};
        }
    };
    static_assert(2 * BUF * 4 <= 26624, "per-wave LDS");
    const int nch = T / CT;
    struct Opnd { f32x2 q2[DH / 2], k2[DH / 2], f2[DH / 2]; float v; f32x4 bd; };
    auto ldop = [&](Opnd& x, const LAS float* bq, const LAS float* bv, const LAS float* bb, int uu) {
#pragma unroll
        for (int i = 0; i < DH / 4; ++i) { const f32x4 w = *(const LAS f32x4*)(bq + OQ + uu * DK + 4 * i); x.q2[2 * i] = (f32x2){w.x, w.y}; x.q2[2 * i + 1] = (f32x2){w.z, w.w}; }
#pragma unroll
        for (int i = 0; i < DH / 4; ++i) { const f32x4 w = *(const LAS f32x4*)(bq + OK_ + uu * DK + 4 * i); x.k2[2 * i] = (f32x2){w.x, w.y}; x.k2[2 * i + 1] = (f32x2){w.z, w.w}; }
        if constexpr (HASF) {
#pragma unroll
            for (int i = 0; i < DH / 4; ++i) { const f32x4 w = *(const LAS f32x4*)(bq + OF + uu * DK + 4 * i); x.f2[2 * i] = (f32x2){w.x, w.y}; x.f2[2 * i + 1] = (f32x2){w.z, w.w}; } }
        x.v = bv[uu * NV];
        if constexpr (HASB) x.bd = *(const LAS f32x4*)(bb + uu * 4);
    };
    auto compute = [&](int c, const LAS float* base) {
#pragma unroll 1
        for (int ub = 0; ub < CT; ub += UNR) {
        float okeep[R];
#pragma unroll
        for (int vv = 0; vv < R; ++vv) okeep[vv] = 0.f;
        Opnd X; X.bd = (f32x4){0.f, 0.f, 0.f, 0.f};
#pragma unroll
        for (int i = 0; i < DH / 2; ++i) X.f2[i] = (f32x2){0.f, 0.f};
        const LAS float* bq = base + ub * DK + d0; const LAS float* bv = base + OV + ub * NV + rw; const LAS float* bb = base + OB + ub * 4;
        ldop(X, bq, bv, bb, 0);
#pragma unroll
        for (int uu_ = 0; uu_ < UNR; ++uu_) { const int u = ub + uu_;
            Opnd Y = X;
            if (uu_ + 1 < UNR) ldop(Y, bq, bv, bb, uu_ + 1);
            f32x2 (&q2)[DH / 2] = X.q2; f32x2 (&k2)[DH / 2] = X.k2; f32x2 (&f2)[DH / 2] = X.f2; const float vv_ = X.v; const f32x4 bd = X.bd;
            float o[1];
            if constexpr (KIND == 3) {
                f32x2 a = k2[0] * S2[0], bq_ = q2[0] * S2[0];
#pragma unroll
                for (int i = 1; i < DH / 2; ++i) { a = __builtin_elementwise_fma(k2[i], S2[i], a); bq_ = __builtin_elementwise_fma(q2[i], S2[i], bq_); }
                const float ks_ = row8_sum(a.x + a.y) * bd.y, qs_ = row8_sum(bq_.x + bq_.y) * bd.y;
                const float uu = bd.x * (vv_ - ks_);
                o[0] = __builtin_fmaf(bd.z, uu, qs_);
                const f32x2 de2 = (f32x2){bd.y, bd.y}, uu2 = (f32x2){uu, uu};
#pragma unroll
                for (int i = 0; i < DH / 2; ++i) S2[i] = __builtin_elementwise_fma(S2[i], de2, k2[i] * uu2);
            } else {
                const f32x2 v2 = (f32x2){vv_, vv_};
#pragma unroll
                for (int i = 0; i < DH / 2; ++i) {
                    f32x2 dec2;
                    if constexpr (KIND == 0) dec2 = (f32x2){rdec, rdec}; else dec2 = f2[i];
                    S2[i] = __builtin_elementwise_fma(S2[i], dec2, k2[i] * v2);
                }
            }
            if constexpr (KIND != 3)
            { f32x2 a = q2[0] * S2[0];
#pragma unroll
              for (int i = 1; i < DH / 2; ++i) a = __builtin_elementwise_fma(q2[i], S2[i], a);
              o[0] = row8_sum(a.x + a.y); }
#pragma unroll
            for (int vv = 0; vv < R; ++vv) okeep[vv] = (dl == uu_) ? o[vv] : okeep[vv];
            X = Y;
        }
        {
            GAS bf16* o_ = op + (size_t)(c * CT + ub + dl) * D;
            if constexpr (R == 1) *o_ = (bf16)(pk2(okeep[0], 0.f) & 0xffffu);
            if constexpr (R == 2) *(GAS unsigned*)o_ = pk2(okeep[0], okeep[1]);
            if constexpr (R == 4) *(GAS v2u*)o_ = (v2u){pk2(okeep[0], okeep[1]), pk2(okeep[2], okeep[3])};
        }
        }
    };
    stage_load(s0, 0); stage_write(s0, 0);
#pragma unroll 1
    for (int c = 0; c < nch; c += 2) {
        stage_load(s0, min(c + 1, nch - 1));
        compute(c, wl);
        stage_write(s0, 1);
        stage_load(s0, min(c + 2, nch - 1));
        compute(c + 1, wl + BUF);
        stage_write(s0, 0);
    }
    const int v0 = slice * NV + rw * R;
#pragma unroll
    for (int i = 0; i < DH / 2; ++i) { sout[(size_t)(d0 + 2 * i) * 64 + v0] = S2[i].x; sout[(size_t)(d0 + 2 * i + 1) * 64 + v0] = S2[i].y; }
}

__device__ __forceinline__ void scan_phase(const Args& args, LAS unsigned char* lds_, int l, int mode = 0) {
    const Ctx C = make_ctx(args, lds_);
    constexpr int NLONG = 1024, NSHORT = BS * 144;
    const int slot = C.wave * 256 + (int)blockIdx.x;
    const int nidle = C.NGW - NLONG;
    for (int it = 0;; ++it) {
        int kind, b, h, slice, row0, T; bool isp;
        if (slot < NLONG) { if (it > 0 || mode == 2) break; isp = true; T = TP;
            const int kk_ = slot >> 8, i = slot & 255; kind = kk_ == 0 ? 3 : (kk_ == 1 ? 0 : (kk_ == 2 ? 2 : 1));
            { const int stream = (i & 7) | ((i >> 6) << 3); slice = (i >> 3) & 7; b = stream >> 2; h = stream & 3; }
            row0 = b * TP;
        } else { const int st = (slot - NLONG) + it * nidle; if (st >= NSHORT || mode == 1) break; isp = false; T = TS;
            b = st / 144; int i = st - b * 144;
            if (i < 64) { kind = 3; h = i >> 4; slice = i & 15; }
            else if (i < 96) { i -= 64; kind = 0; h = i >> 3; slice = i & 7; }
            else if (i < 128) { i -= 96; kind = 2; h = i >> 3; slice = i & 7; }
            else { i -= 128; kind = 1; h = i >> 2; slice = i & 3; }
            row0 = MP + b * TS;
        }
        const int nbat = isp ? BP : BS;
        const size_t sidx = (size_t)((l * nbat + b) * 4 + h);
        if (isp) {
            LAS float* wl = (LAS float*)(C.lds + C.wave * 26624);
            if (kind == 0) scan_long<0, 8, 1>(C, wl, row0, T, h, slice, C.out + O_PRET + sidx * 4096);
            else if (kind == 1) scan_long<1, 4, 1>(C, wl, row0, T, h, slice, C.out + O_PGLA + sidx * 2048);
            else if (kind == 2) scan_long<2, 8, 1>(C, wl, row0, T, h, slice, C.out + O_PHG + sidx * 4096);
            else scan_long<3, 8, 1>(C, wl, row0, T, h, slice, C.out + O_PGDN + sidx * 4096);
        } else {
            if (kind == 0) { scan_task<0, 4, 2>(C, row0, T, h, slice, args.in[2] + sidx * 4096, C.out + O_SRET + sidx * 4096); }
            else if (kind == 1) { scan_task<1, 2, 4>(C, row0, T, h, slice, args.in[3] + sidx * 2048, C.out + O_SGLA + sidx * 2048); }
            else if (kind == 2) { scan_task<2, 4, 2>(C, row0, T, h, slice, args.in[4] + sidx * 4096, C.out + O_SHG + sidx * 4096); }
            else { scan_task<3, 4, 1>(C, row0, T, h, slice, args.in[5] + sidx * 4096, C.out + O_SGDN + sidx * 4096); }
        }
    }
    if (l == 0 && C.wave >= 4 && mode != 1) {
        LAS float* scr = (LAS float*)(C.lds + 4 * 26624 + (C.wave - 4) * 8704);
        constexpr int I_F0 = I_WI + I_WO, I_L0B = I_F0 + I_WOUT;
        for (int it = (C.wave - 4) * 256 + (int)blockIdx.x; it < I_L0B + I_MAIN; it += 1024) {
            if (it < I_F0) convert_item(args, C.ws, 0, I_F0 + it, scr, C.lane);
            else if (it < I_L0B) convert_item(args, C.ws, 0, 2 * I_F0 + I_WIN + (it - I_F0), scr, C.lane);
            else convert_item(args, C.ws, 1, it - I_L0B, scr, C.lane);
        }
    }
}

__device__ __forceinline__ void post_phase(const Args& args, LAS unsigned char* lds_, int l) {
    const Ctx C = make_ctx(args, lds_);
    const bf16* PROJ = (const bf16*)(C.ws + WS_BIG); bf16* H = (bf16*)(C.ws + WS_H);
    const int lane = C.lane, mixer = lane >> 4, cc = (lane & 15) * 16;
    const int gbase = mixer == 0 ? C_RG : mixer == 1 ? C_AG : mixer == 2 ? C_HG : C_DG;
    const float* nw = mixer == 1 ? args.in[24] + l * 64 : mixer == 2 ? args.in[25] + l * 64 : args.in[26] + l * 64;
    float w[16];
#pragma unroll
    for (int i = 0; i < 16; ++i) w[i] = mixer == 0 ? 1.0f : nw[(cc + i) & 63];
    v4u na0, na1, ng0, ng1;
    if (C.gw < M) { const bf16* hp = H + (size_t)C.gw * D + lane * 16; const bf16* gp = PROJ + (size_t)C.gw * NINP + gbase + cc;
        na0 = *(const v4u*)hp; na1 = *(const v4u*)(hp + 8); ng0 = *(const v4u*)gp; ng1 = *(const v4u*)(gp + 8); }
#pragma unroll 1
    for (int r = C.gw; r < M; r += C.NGW) {
        bf16* hp = H + (size_t)r * D + lane * 16; const bf16* gp = PROJ + (size_t)r * NINP + gbase + cc;
        const v4u a0 = na0, a1 = na1, g0 = ng0, g1 = ng1;
        if (r + C.NGW < M) { const bf16* hn = hp + (size_t)C.NGW * D; const bf16* gn = gp + (size_t)C.NGW * NINP;
            na0 = *(const v4u*)hn; na1 = *(const v4u*)(hn + 8); ng0 = *(const v4u*)gn; ng1 = *(const v4u*)(gn + 8); }
        float y[16], g[16];
        const unsigned aw[8] = {a0.x, a0.y, a0.z, a0.w, a1.x, a1.y, a1.z, a1.w}, gw_[8] = {g0.x, g0.y, g0.z, g0.w, g1.x, g1.y, g1.z, g1.w};
        float ss = 0.f;
#pragma unroll
        for (int i = 0; i < 8; ++i) { y[2 * i] = bflo(aw[i]); y[2 * i + 1] = bfhi(aw[i]); g[2 * i] = bflo(gw_[i]); g[2 * i + 1] = bfhi(gw_[i]); ss += y[2 * i] * y[2 * i] + y[2 * i + 1] * y[2 * i + 1]; }
        ss = quad_sum(ss);
        const float rs = rsqrtf(ss * (1.0f / 64.0f) + RMS_EPS);
        unsigned ow[8];
#pragma unroll
        for (int i = 0; i < 8; ++i) ow[i] = pk2(y[2 * i] * rs * w[2 * i] * siluf_(g[2 * i]), y[2 * i + 1] * rs * w[2 * i + 1] * siluf_(g[2 * i + 1]));
        *(v4u*)hp = (v4u){ow[0], ow[1], ow[2], ow[3]}; *(v4u*)(hp + 8) = (v4u){ow[4], ow[5], ow[6], ow[7]};
    }
}

__global__ void __launch_bounds__(NWAVES * 64, 2) mega_fwd(Args args) {
    extern __shared__ __attribute__((aligned(16))) unsigned char lds[];
    cg::grid_group grid = cg::this_grid();
    LAS unsigned char* const LDSP = (LAS unsigned char*)lds;
    const int G = (int)gridDim.x, bx = (int)blockIdx.x;
    if (threadIdx.x < 64) ((LAS unsigned*)(LDSP + MISC_OFF))[threadIdx.x] = 0u;
    __syncthreads();
    (void)xcd_barrier_post((unsigned*)args.ws, (volatile LAS unsigned*)(LDSP + MISC_OFF));
#define FRESH() float* out_ = fresh_ptr(args.out); unsigned char* ws = fresh_ptr(args.ws); \
    float* MOD = (float*)(ws + WS_MOD); bf16* H = (bf16*)(ws + WS_H); bf16* BIG = (bf16*)(ws + WS_BIG); (void)MOD; (void)H; (void)BIG; (void)out_;

    p0_prologue(args, LDSP);
    if (args.ws == nullptr) grid.sync();
    grid_bar(args, LDSP);
    {
        FRESH();
        pg8::Gemm g{(const bf16*)(ws + WS_AC), BIG, 256, 2 * NMODC, D}; pg8::StaticOrder S; S.init(256, 2 * NMODC, G, bx, D);
        pg8::EpiMod E{MOD, args.in[10]};
        pg8::gemm_phase<pg8::EpiMod, pg8::StaticOrder, PG8_ALIGN, PG8_SP2>(LDSP, g, S, E);
    }
    p1_convert(args, LDSP);
    grid_bar(args, LDSP);
    p2_modulate0(args, LDSP);
    grid_bar(args, LDSP);
#pragma unroll 1
    for (int l = 0; l < 2; ++l) {
#pragma unroll 1
        for (int f = 0; f < 2; ++f) {
            if (f == 1) {
                {
                    FRESH();
                    pg8::Gemm g{H, (const bf16*)(ws + WS_W + (size_t)l * W_LAYER + W_WIN), M, NINP, D}; pg8::StaticOrder S; S.init(M, NINP, G, bx, D);
                    pg8::EpiPlain E{BIG, NINP};
                    pg8::gemm_phase<pg8::EpiPlain, pg8::StaticOrder, PG8_ALIGN, PG8_SP2>(LDSP, g, S, E);
                }
                grid_bar(args, LDSP);
                prep_phase(args, LDSP, l);
                grid_bar(args, LDSP);
                scan_phase(args, LDSP, l);
#ifdef PROBE_SCANMODE
                grid_bar(args, LDSP); scan_phase(args, LDSP, l, PROBE_SCANMODE);
#endif
                grid_bar(args, LDSP);
                post_phase(args, LDSP, l);
                grid_bar(args, LDSP);
                {
                    FRESH();
                    pg8::Gemm g{H, (const bf16*)(ws + WS_W + (size_t)l * W_LAYER + W_WOUT), M, D, D}; pg8::SplitOrder S; S.init(D, G, bx);
                    pg8::EpiRes E{out_, (float*)(ws + WS_SB), MOD + (size_t)l * NB * NMODC + 5 * 1024, 1.0f, D / 64};
                    pg8::gemm_phase<pg8::EpiRes, pg8::SplitOrder, PG8_ALIGN, PG8_SP2>(LDSP, g, S, E);
                }
                grid_bar(args, LDSP);
                ln_phase(args, LDSP, l, 1, true, l, 6, 4, ALPHA);
                grid_bar(args, LDSP);
            }
            {
                FRESH();
                pg8::Gemm g{H, (const bf16*)(ws + WS_W + (size_t)l * W_LAYER + (f ? W_WI2 : W_WI1)), M, NWI, D}; pg8::StaticOrder S; S.init(M, NWI, G, bx, D);
                pg8::EpiSwiglu E{BIG, DFF};
                pg8::gemm_phase<pg8::EpiSwiglu, pg8::StaticOrder, PG8_ALIGN, PG8_SP2>(LDSP, g, S, E);
            }
            grid_bar(args, LDSP);
            {
                FRESH();
                pg8::Gemm g{BIG, (const bf16*)(ws + WS_W + (size_t)l * W_LAYER + (f ? W_WO2 : W_WO1)), M, D, DFF}; pg8::SplitOrder S; S.init(DFF, G, bx);
                pg8::EpiRes E{out_, (float*)(ws + WS_SB), MOD + (size_t)l * NB * NMODC + (f ? 8 : 2) * 1024, 0.5f, DFF / 64};
                pg8::gemm_phase<pg8::EpiRes, pg8::SplitOrder, PG8_ALIGN, PG8_SP2>(LDSP, g, S, E);
            }
            grid_bar(args, LDSP);
            if (f == 0) ln_phase(args, LDSP, l, 0, true, l, 3, 11, ALPHA);
            else ln_phase(args, LDSP, l, 2, l == 0, 1, 0, 11, l == 0 ? ALPHA : 1.0f);
            if (!(l == 1 && f == 1)) grid_bar(args, LDSP);
        }
    }
}

extern "C" void kernel_launch(void* const* d_in, const int* in_sizes, int n_in, void* d_out, int out_size, void* d_ws, size_t ws_size, hipStream_t stream) {
    static int grid = 0;
    if (grid == 0) {
        if (n_in != 28 || (size_t)out_size != O_END || ws_size < WS_END) { fprintf(stderr, "kernel_launch: unexpected sizes n_in %d out %d ws %zu (need %zu)\n", n_in, out_size, ws_size, (size_t)WS_END); grid = -1; return; }
        int dev = 0, cus = 0, per_cu = 0;
        hipGetDevice(&dev); hipDeviceGetAttribute(&cus, hipDeviceAttributeMultiprocessorCount, dev);
        hipFuncSetAttribute((const void*)mega_fwd, hipFuncAttributeMaxDynamicSharedMemorySize, LDS_BYTES);
        hipOccupancyMaxActiveBlocksPerMultiprocessor(&per_cu, (const void*)mega_fwd, NWAVES * 64, LDS_BYTES);
        (void)hipGetLastError();
        if (per_cu < 1 || cus < 256) { fprintf(stderr, "kernel_launch: occupancy %d cus %d\n", per_cu, cus); grid = -1; return; }
        grid = 256;
    }
    if (grid < 0) return;
    if (hipMemsetAsync(d_ws, 0, 65536, stream) != hipSuccess) { fprintf(stderr, "memset failed\n"); return; }
    Args a{};
    for (int i = 0; i < 28; ++i) a.in[i] = (const float*)d_in[i];
    a.out = (float*)d_out; a.ws = (unsigned char*)d_ws;
    void* kargs[] = {&a};
    hipError_t e = hipLaunchCooperativeKernel((const void*)mega_fwd, dim3(grid), dim3(NWAVES * 64), kargs, LDS_BYTES, stream);
    if (e != hipSuccess) fprintf(stderr, "cooperative launch failed: %s\n", hipGetErrorString(e));
}
```

```cpp
#include <hip/hip_runtime.h>
#include <hip/hip_cooperative_groups.h>
#include <cstdio>
#include <cstdint>
namespace cg = cooperative_groups;
namespace pg8 {
#define PG8_LAS __attribute__((address_space(3)))
typedef unsigned short bf16_t;
typedef short bf16x8 __attribute__((ext_vector_type(8)));
typedef float f32x4 __attribute__((ext_vector_type(4)));
typedef unsigned u32x4 __attribute__((ext_vector_type(4)));
constexpr int BM = 256, BK = 64, HALF = 128, HTB = HALF * BK * 2  , STAGE_BYTES = 8 * HTB, NXCD = 8, WGM = 8;

__host__ __device__ __forceinline__ int lds_byte(int r, int c) { const int st = (r >> 4) * 2 + (c >> 5), rr = r & 15, cc = c & 31, ob = rr * 64 + cc * 2; return st * 1024 + (ob ^ (((ob >> 9) & 1) << 5)); }
__host__ __device__ __forceinline__ void stage_rc(int b, int& R, int& C) { const int st = b / 1024, sb = b % 1024, swz = sb ^ (((sb >> 9) & 1) << 5); R = (st >> 1) * 16 + swz / 64; C = (st & 1) * 32 + (swz % 64) / 2; }
__host__ __device__ __forceinline__ int perm32(int rho) { const int n = rho >> 4, i = rho & 15; return 8 * (i >> 2) + 4 * n + (i & 3); }

struct Unit { int pm, pn, k0, nt; };
struct Gemm { const bf16_t* A; const bf16_t* Bt; int M, N, K; };

struct StaticOrder {
    int nM, nN, nwg, G, c, ntf;
    __host__ __device__ void init(int M, int N, int G_, int c_, int K_ = 1024) { nM = M / BM; nN = N / BM; nwg = nM * nN; G = G_; c = c_; ntf = K_ / BK; }
    __host__ __device__ bool next(int i, Unit& u) const {
        const long L = (long)i * G + c; if (L >= nwg) return false;
        int wgid = (int)L; { const int q = nwg / NXCD, r = nwg % NXCD, xcd = wgid % NXCD, off = wgid / NXCD; wgid = (xcd < r ? xcd * (q + 1) : r * (q + 1) + (xcd - r) * q) + off; }
        const int nig = WGM * nN, gid = wgid / nig, fm = gid * WGM, gsz = (nM - fm) < WGM ? (nM - fm) : WGM;
        u.pm = fm + ((wgid % nig) % gsz); u.pn = (wgid % nig) / gsz; u.k0 = 0; u.nt = ntf; return true;
    }
    __device__ __forceinline__ void a_ready(const Unit&) const {}
    __device__ __forceinline__ void done(const Unit&) const {}
};

struct SplitOrder {
    StaticOrder base; int ppu, c;
    static constexpr int PK = 4;
    __host__ __device__ void init(int K_, int G_, int c_) { base.init(16384, 1024, G_, c_, K_); ppu = (K_ / BK) / PK; c = c_; }
    __host__ __device__ bool next(int i, Unit& u) const {
        if (i == 0) return base.next(0, u);
        if (i == 1 && c < 8 * ppu) { const int j = c / ppu, p = c - j * ppu; u.pm = 64 + (j >> 2); u.pn = j & 3; u.k0 = p * PK; u.nt = PK; return true; }
        return false;
    }
    __device__ __forceinline__ void a_ready(const Unit&) const {}
    __device__ __forceinline__ void done(const Unit&) const {}
};

__device__ __forceinline__ unsigned cvt_pk_bf16(float lo, float hi) { unsigned r; asm volatile("v_cvt_pk_bf16_f32 %0, %1, %2" : "=v"(r) : "v"(lo), "v"(hi)); return r; }
typedef float f32x2 __attribute__((ext_vector_type(2)));
__device__ __forceinline__ f32x2 gelu_pk(f32x2 v) {
    const f32x2 av = __builtin_elementwise_abs(v), d = av * 0.2316418882f + 1.0f;
    f32x2 t; t.x = __builtin_amdgcn_rcpf(d.x); t.y = __builtin_amdgcn_rcpf(d.y);
    f32x2 q = t * 0.5307027145f + (-0.7265760135f); q = q * t + 0.7107068705f; q = q * t + (-0.142248368f); q = q * t + 0.127414796f; q = q * t;
    const f32x2 s = (v * v) * (-0.72134752044f);
    f32x2 e; e.x = __builtin_amdgcn_exp2f(s.x); e.y = __builtin_amdgcn_exp2f(s.y);
    const f32x2 m = v * (q * e), r = v - m;
    f32x2 o; o.x = v.x < 0.f ? m.x : r.x; o.y = v.y < 0.f ? m.y : r.y; return o;
}

template <int ACT  > struct EpiBf16 {
    static constexpr bool PERM = true, AFTER_DRAIN = false; static_assert(ACT == 0 || ACT == 1, "EpiBf16: ACT is 0 (none) or 1 (gelu_pk)");
    bf16_t* O; int ldc; const float* bias; int split_cols; size_t split_stride; float scale0;
    __device__ __forceinline__ void operator()(const f32x4 (&acc)[2][2][4][2], const Unit& u, int wr, int wc, int fr, int fq) const {
        const int row0 = u.pm * BM + wr * 64 + fr; int colt = u.pn * BM; bf16_t* base = O;
        float sc = 1.f; if (split_cols) { const int t = colt / split_cols; base += (size_t)t * split_stride; colt -= t * split_cols; if (t == 0) sc = scale0; }
        const int col0 = colt + wc * 32 + 8 * fq, bcol0 = u.pn * BM + wc * 32 + 8 * fq;
        f32x4 bv[2][2];
#pragma unroll
        for (int bj = 0; bj < 2; ++bj)
#pragma unroll
            for (int n = 0; n < 2; ++n) bv[bj][n] = bias ? *(const f32x4*)(bias + bcol0 + bj * HALF + 4 * n) : (f32x4){0.f, 0.f, 0.f, 0.f};
#pragma unroll
        for (int ai = 0; ai < 2; ++ai)
#pragma unroll
            for (int m = 0; m < 4; ++m) { bf16_t* rowp = base + (size_t)(row0 + ai * HALF + m * 16) * ldc + col0;
#pragma unroll
                for (int bj = 0; bj < 2; ++bj) { f32x4 v0 = acc[ai][bj][m][0] + bv[bj][0], v1 = acc[ai][bj][m][1] + bv[bj][1];
                    if (ACT == 1) { f32x2 a = gelu_pk((f32x2){v0[0], v0[1]}), b = gelu_pk((f32x2){v0[2], v0[3]}), c = gelu_pk((f32x2){v1[0], v1[1]}), d = gelu_pk((f32x2){v1[2], v1[3]});
                        v0 = (f32x4){a.x, a.y, b.x, b.y}; v1 = (f32x4){c.x, c.y, d.x, d.y}; }
                    v0 = v0 * sc; v1 = v1 * sc; u32x4 w; w.x = cvt_pk_bf16(v0[0], v0[1]); w.y = cvt_pk_bf16(v0[2], v0[3]); w.z = cvt_pk_bf16(v1[0], v1[1]); w.w = cvt_pk_bf16(v1[2], v1[3]);
                    *(u32x4*)(rowp + bj * HALF) = w; } }
    }
};
template <class Epi, class Sched, bool ALIGN_EPI = false, bool SP2 = false>
__device__ __forceinline__ void gemm_phase(PG8_LAS unsigned char* lds, const Gemm g, const Sched& S, const Epi& E) {
    int tid_ = threadIdx.x; asm volatile("" : "+v"(tid_));
    const int tid = tid_, wid = __builtin_amdgcn_readfirstlane(tid >> 6), lane = tid & 63, wr = wid >> 2, wc = wid & 3, fr = lane & 15, fq = lane >> 4;
    const int K = g.K;
    unsigned voffA[2], voffB[2];
#pragma unroll
    for (int i = 0; i < 2; ++i) { int R, C; stage_rc(tid * 16 + i * 8192, R, C); const int Rb = Epi::PERM ? ((R & ~31) + perm32(R & 31)) : R;
        voffA[i] = (unsigned)(R * K + C) * 2u; voffB[i] = (unsigned)(Rb * K + C) * 2u; }
    const size_t kstep = (size_t)(BK * 2);
    const size_t hstep = (size_t)HALF * K * 2;
    const size_t tstep = 2 * hstep;
    const unsigned ldsw = (unsigned)wid * 1024u;
    const int aoff = lds_byte(wr * 64 + fr, fq * 8), boff = lds_byte(wc * 32 + fr, fq * 8);
#define PG8_SA(b, h) (((b) * 2 + (h)) * HTB)
#define PG8_SB(b, h) ((4 + (b) * 2 + (h)) * HTB)
#define PG8_STAGE(bufoff, gbase, voff) do { _Pragma("unroll") for (int _i = 0; _i < 2; ++_i) \
        __builtin_amdgcn_global_load_lds((const unsigned*)((const char*)(gbase) + (voff)[_i]), (PG8_LAS unsigned*)(lds + (bufoff) + ldsw + _i * 8192), 16, 0, 0); } while (0)
#define PG8_LDA(dst, b, h) do { _Pragma("unroll") for (int m = 0; m < 4; ++m) _Pragma("unroll") for (int k = 0; k < 2; ++k) dst[m][k] = *(const PG8_LAS bf16x8*)(lds + PG8_SA(b, h) + aoff + m * 2048 + k * 1024); } while (0)
#define PG8_LDB(dst, b, h) do { _Pragma("unroll") for (int n = 0; n < 2; ++n) _Pragma("unroll") for (int k = 0; k < 2; ++k) dst[n][k] = *(const PG8_LAS bf16x8*)(lds + PG8_SB(b, h) + boff + n * 2048 + k * 1024); } while (0)
#define PG8_MMA(ai, bj, At, Bt) do { __builtin_amdgcn_s_setprio(1); _Pragma("unroll") for (int m = 0; m < 4; ++m) _Pragma("unroll") for (int n = 0; n < 2; ++n) _Pragma("unroll") for (int k = 0; k < 2; ++k) \
        acc[ai][bj][m][n] = __builtin_amdgcn_mfma_f32_16x16x32_bf16(Bt[n][k], At[m][k], acc[ai][bj][m][n], 0, 0, 0); __builtin_amdgcn_s_setprio(0); } while (0)
#define PG8_WAIT_V(n) asm volatile("s_waitcnt vmcnt(" #n ")" ::: "memory")
#define PG8_WAIT_L(n) asm volatile("s_waitcnt lgkmcnt(" #n ")" ::: "memory")
#define PG8_BAR __builtin_amdgcn_s_barrier()
#define PG8_SCHED __builtin_amdgcn_sched_barrier(0)
    Unit cur, nxt; int ui = 0;
    if (!S.next(0, cur)) return;
    f32x4 acc[2][2][4][2];
#pragma unroll
    for (int a = 0; a < 2; ++a)
#pragma unroll
        for (int b = 0; b < 2; ++b)
#pragma unroll
            for (int m = 0; m < 4; ++m)
#pragma unroll
                for (int n = 0; n < 2; ++n) acc[a][b][m][n] = (f32x4){0.f, 0.f, 0.f, 0.f};
    bf16x8 At[4][2], B0[2][2], B1[2][2];
    const char* cA = (const char*)g.A + (size_t)cur.pm * tstep + (size_t)cur.k0 * kstep; const char* cB = (const char*)g.Bt + (size_t)cur.pn * tstep + (size_t)cur.k0 * kstep;
    S.a_ready(cur);
    if constexpr (SP2) {
        PG8_STAGE(PG8_SB(0, 0), cB, voffB); PG8_STAGE(PG8_SB(0, 1), cB + hstep, voffB); PG8_STAGE(PG8_SA(0, 0), cA, voffA); PG8_STAGE(PG8_SA(0, 1), cA + hstep, voffA);
        if (wr == 1) PG8_BAR;
        PG8_WAIT_V(2); PG8_BAR;
        PG8_STAGE(PG8_SB(1, 0), cB + kstep, voffB); PG8_STAGE(PG8_SA(1, 0), cA + kstep, voffA); PG8_STAGE(PG8_SB(1, 1), cB + hstep + kstep, voffB);
        PG8_WAIT_V(6); PG8_BAR;
    } else {
        PG8_STAGE(PG8_SB(0, 0), cB, voffB); PG8_STAGE(PG8_SA(0, 0), cA, voffA); PG8_STAGE(PG8_SB(0, 1), cB + hstep, voffB); PG8_STAGE(PG8_SA(0, 1), cA + hstep, voffA);
        if (wr == 1) PG8_BAR;
        PG8_WAIT_V(4); PG8_BAR;
        PG8_STAGE(PG8_SB(1, 0), cB + kstep, voffB); PG8_STAGE(PG8_SA(1, 0), cA + kstep, voffA); PG8_STAGE(PG8_SB(1, 1), cB + hstep + kstep, voffB);
        PG8_WAIT_V(6); PG8_BAR;
    }
    for (;;) {
        const bool has_next = S.next(ui + 1, nxt);
        const char* nA = has_next ? (const char*)g.A + (size_t)nxt.pm * tstep + (size_t)nxt.k0 * kstep : cA; const char* nB = has_next ? (const char*)g.Bt + (size_t)nxt.pn * tstep + (size_t)nxt.k0 * kstep : cB;
        const int nt = cur.nt;
        for (int t = 0; t < nt; t += 2) {
            const bool last = (t == nt - 2);
            const char* a1 = cA + (size_t)(t + 1) * kstep;
            const char* a2 = last ? nA : cA + (size_t)(t + 2) * kstep; const char* b2 = last ? nB : cB + (size_t)(t + 2) * kstep;
            const char* a3 = a2 + kstep; const char* b3 = b2 + kstep;
            if (last && has_next) S.a_ready(nxt);
            if constexpr (SP2) {
            PG8_LDB(B0, 0, 0); PG8_LDB(B1, 0, 1); PG8_SCHED; PG8_LDA(At, 0, 0); PG8_STAGE(PG8_SA(1, 1), a1 + hstep, voffA);
            PG8_WAIT_V(8); PG8_WAIT_L(0); PG8_BAR; PG8_MMA(0, 0, At, B0); PG8_MMA(0, 1, At, B1); PG8_BAR; PG8_SCHED;
            PG8_LDA(At, 0, 1); PG8_STAGE(PG8_SB(0, 0), b2, voffB); PG8_STAGE(PG8_SB(0, 1), b2 + hstep, voffB); PG8_STAGE(PG8_SA(0, 0), a2, voffA);
            PG8_WAIT_V(8); PG8_WAIT_L(0); PG8_BAR; PG8_MMA(1, 0, At, B0); PG8_MMA(1, 1, At, B1); PG8_BAR; PG8_SCHED;
            PG8_LDB(B0, 1, 0); PG8_LDB(B1, 1, 1); PG8_SCHED; PG8_LDA(At, 1, 0); PG8_STAGE(PG8_SA(0, 1), a2 + hstep, voffA);
            PG8_WAIT_V(8); PG8_WAIT_L(0); PG8_BAR; PG8_MMA(0, 0, At, B0); PG8_MMA(0, 1, At, B1); PG8_BAR; PG8_SCHED;
            PG8_LDA(At, 1, 1); PG8_STAGE(PG8_SB(1, 0), b3, voffB); PG8_STAGE(PG8_SB(1, 1), b3 + hstep, voffB); PG8_STAGE(PG8_SA(1, 0), a3, voffA);
            PG8_WAIT_V(8); PG8_WAIT_L(0); PG8_BAR; PG8_MMA(1, 0, At, B0); PG8_MMA(1, 1, At, B1); PG8_BAR; PG8_SCHED;
            } else {
            PG8_LDB(B0, 0, 0); PG8_SCHED; PG8_LDA(At, 0, 0); PG8_STAGE(PG8_SA(1, 1), a1 + hstep, voffA);
            PG8_WAIT_L(8); PG8_BAR; PG8_WAIT_L(0); PG8_MMA(0, 0, At, B0); PG8_BAR; PG8_SCHED;
            PG8_LDB(B1, 0, 1); PG8_STAGE(PG8_SB(0, 0), b2, voffB);
            PG8_BAR; PG8_WAIT_L(0); PG8_MMA(0, 1, At, B1); PG8_BAR;
            PG8_LDA(At, 0, 1); PG8_STAGE(PG8_SA(0, 0), a2, voffA);
            PG8_BAR; PG8_WAIT_L(0); PG8_MMA(1, 0, At, B0); PG8_BAR; PG8_SCHED;
            PG8_STAGE(PG8_SB(0, 1), b2 + hstep, voffB);
            PG8_WAIT_V(6); PG8_BAR; PG8_MMA(1, 1, At, B1); PG8_BAR;
            PG8_LDB(B0, 1, 0); PG8_SCHED; PG8_LDA(At, 1, 0); PG8_STAGE(PG8_SA(0, 1), a2 + hstep, voffA);
            PG8_WAIT_L(8); PG8_BAR; PG8_WAIT_L(0); PG8_MMA(0, 0, At, B0); PG8_BAR; PG8_SCHED;
            PG8_LDB(B1, 1, 1); PG8_STAGE(PG8_SB(1, 0), b3, voffB);
            PG8_BAR; PG8_WAIT_L(0); PG8_MMA(0, 1, At, B1); PG8_BAR;
            PG8_LDA(At, 1, 1); PG8_STAGE(PG8_SA(1, 0), a3, voffA);
            PG8_BAR; PG8_WAIT_L(0); PG8_MMA(1, 0, At, B0); PG8_BAR; PG8_SCHED;
            PG8_STAGE(PG8_SB(1, 1), b3 + hstep, voffB);
            PG8_WAIT_V(6); PG8_BAR; PG8_MMA(1, 1, At, B1); PG8_BAR;
            }
        }
        if constexpr (ALIGN_EPI) { if (wr == 0) PG8_BAR; }
        if constexpr (!Epi::AFTER_DRAIN) { E(acc, cur, wr, wc, fr, fq); S.done(cur); }
        if (!has_next) break;
#pragma unroll
        for (int a = 0; a < 2; ++a)
#pragma unroll
            for (int b = 0; b < 2; ++b)
#pragma unroll
                for (int m = 0; m < 4; ++m)
#pragma unroll
                    for (int n = 0; n < 2; ++n) acc[a][b][m][n] = (f32x4){0.f, 0.f, 0.f, 0.f};
        cur = nxt; cA = nA; cB = nB; ++ui;
        if constexpr (ALIGN_EPI) { if (wr == 1) PG8_BAR; }
    }
    PG8_WAIT_V(0);
    if constexpr (!ALIGN_EPI) { if (wr == 0) PG8_BAR; }
    PG8_BAR;
    if constexpr (Epi::AFTER_DRAIN) { E.fused(acc, cur, wr, wc, fr, fq, lds, wid, lane); S.done(cur); }
#undef PG8_SA
#undef PG8_SB
#undef PG8_STAGE
#undef PG8_LDA
#undef PG8_LDB
#undef PG8_MMA
#undef PG8_WAIT_V
#undef PG8_WAIT_L
#undef PG8_BAR
#undef PG8_SCHED
}
}
#define PG8_SP2 true
#define PG8_ALIGN true

constexpr int D = 1024, TP = 2048, BP = 8, BS = 128, TS = 4;
constexpr int MP = BP * TP, MS = BS * TS, M = MP + MS;
constexpr int DFF = 2816, NWI = 2 * DFF, NIN = 3864, NINP = 4096, NMODC = 9216, NB = BP + BS;
constexpr int SBW = 1664, SFW = 396;
constexpr float LN_EPS = 1e-5f, RMS_EPS = 1e-6f;
constexpr float ALPHA = 1.41421356237f;
constexpr int C_RQ = 0, C_RK = 256, C_RV = 512, C_RG = 768, C_AQ = 1024, C_AK = 1152, C_AV = 1280, C_ALR = 1536, C_AG = 1552,
              C_HQ = 1808, C_HF = 2064, C_HI = 2320, C_HG = 2576, C_DQKV = 2832, C_DB = 3600, C_DA = 3604, C_DG = 3608;
constexpr int SB_RQ = 0, SB_RK = 256, SB_AQ = 512, SB_HQ = 640, SB_DQ = 896, SB_DK = 1152, SB_DV = 1408;
constexpr int SF_ADEC = 0, SF_HF = 128, SF_BETA = 384, SF_DDEC = 388, SF_QK = 392;
constexpr size_t O_Y = 0;
constexpr size_t O_PRET = (size_t)M * D;
constexpr size_t O_PGLA = O_PRET + 2ull * BP * 4 * 64 * 64;
constexpr size_t O_PHG = O_PGLA + 2ull * BP * 4 * 32 * 64;
constexpr size_t O_PGDN = O_PHG + 2ull * BP * 4 * 64 * 64;
constexpr size_t O_PCONV = O_PGDN + 2ull * BP * 4 * 64 * 64;
constexpr size_t O_SRET = O_PCONV + 2ull * BP * 3 * 768;
constexpr size_t O_SGLA = O_SRET + 2ull * BS * 4 * 64 * 64;
constexpr size_t O_SHG = O_SGLA + 2ull * BS * 4 * 32 * 64;
constexpr size_t O_SGDN = O_SHG + 2ull * BS * 4 * 64 * 64;
constexpr size_t O_SCONV = O_SGDN + 2ull * BS * 4 * 64 * 64;
constexpr size_t O_END = O_SCONV + 2ull * BS * 3 * 768;

constexpr size_t MiB = 1u << 20;
constexpr size_t WS_ROPE = 1 * MiB;
constexpr size_t WS_AC = 2 * MiB;
constexpr size_t WS_MOD = 3 * MiB;
constexpr size_t WS_STATS = 2 * MiB + 512 * 1024;
constexpr size_t WS_ID = 2 * MiB + 768 * 1024;
constexpr size_t WS_W = 13 * MiB;
constexpr size_t W_WI1 = 0, W_WO1 = 11 * MiB, W_WI2 = W_WO1 + 5 * MiB + MiB / 2, W_WO2 = W_WI2 + 11 * MiB, W_WIN = W_WO2 + 5 * MiB + MiB / 2, W_WOUT = W_WIN + 8 * MiB, W_LAYER = 43 * MiB;
constexpr size_t WS_H = WS_W + 2 * W_LAYER;
constexpr size_t WS_BIG = WS_H + 33 * MiB;
constexpr size_t WS_SB = WS_BIG + 132 * MiB;
constexpr size_t WS_SF = WS_SB + 54 * MiB;
constexpr size_t WS_END = WS_SF + 26 * MiB;
static_assert((size_t)M * SBW * 2 <= 54 * MiB && (size_t)M * SFW * 4 <= 26 * MiB && (size_t)M * 4096 * 2 <= 132 * MiB && (size_t)M * D * 2 <= 33 * MiB, "ws map");

constexpr int LDS_BYTES = 147456;
constexpr int NWAVES = 8;

#define GAS __attribute__((address_space(1)))
#define LAS __attribute__((address_space(3)))
typedef unsigned short bf16;
typedef unsigned v4u __attribute__((ext_vector_type(4)));
typedef unsigned v2u __attribute__((ext_vector_type(2)));
typedef float f32x4 __attribute__((ext_vector_type(4)));
typedef float f32x2 __attribute__((ext_vector_type(2)));
#define LDS_WAIT() asm volatile("s_waitcnt lgkmcnt(0)" ::: "memory")

__device__ __forceinline__ float bf2f(unsigned b) { return __uint_as_float(b << 16); }
__device__ __forceinline__ float bflo(unsigned w) { return __uint_as_float(w << 16); }
__device__ __forceinline__ float bfhi(unsigned w) { return __uint_as_float(w & 0xffff0000u); }
__device__ __forceinline__ unsigned pk2(float lo, float hi) { return pg8::cvt_pk_bf16(lo, hi); }
__device__ __forceinline__ float sigmoidf_(float x) { return 1.0f / (1.0f + __expf(-x)); }
__device__ __forceinline__ float siluf_(float x) { return x / (1.0f + __expf(-x)); }
__device__ __forceinline__ float wave_sum(float v) {
#pragma unroll
    for (int o = 1; o < 64; o <<= 1) v += __shfl_xor(v, o);
    return v;
}
template <int CTRL> __device__ __forceinline__ float dppmov(float v) { return __int_as_float(__builtin_amdgcn_update_dpp(0, __float_as_int(v), CTRL, 0xf, 0xf, true)); }
__device__ __forceinline__ float quad_sum(float v) { v += dppmov<0xB1>(v); v += dppmov<0x4E>(v); return v; }
__device__ __forceinline__ float row8_sum(float v) { v += dppmov<0xB1>(v); v += dppmov<0x4E>(v); v += dppmov<0x141>(v); return v; }
__device__ __forceinline__ float row16_sum(float v) { v += dppmov<0xB1>(v); v += dppmov<0x4E>(v); v += dppmov<0x141>(v); v += dppmov<0x140>(v); return v; }

struct Args { const float* in[28]; float* out; unsigned char* ws; };

struct Ctx {
    int tid, lane, wave, gw, NGW;
    LAS unsigned char* lds;
    float* out; unsigned char* ws;
};
template <class T> __device__ __forceinline__ T* fresh_ptr(T* p) {
    unsigned lo = (unsigned)(uintptr_t)p, hi = (unsigned)((uintptr_t)p >> 32);
    asm volatile("" : "+v"(lo), "+v"(hi));
    lo = __builtin_amdgcn_readfirstlane(lo); hi = __builtin_amdgcn_readfirstlane(hi);
    return (T*)(__attribute__((address_space(1))) T*)(((uintptr_t)hi << 32) | (uintptr_t)lo);
}
__device__ __forceinline__ Ctx make_ctx(const Args& args, LAS unsigned char* lds) {
    Ctx C; int t = threadIdx.x; asm volatile("" : "+v"(t));
    C.tid = t; C.lane = t & 63; C.wave = __builtin_amdgcn_readfirstlane(t >> 6);
    C.gw = (int)blockIdx.x * NWAVES + C.wave; C.NGW = (int)gridDim.x * NWAVES;
    float* op = fresh_ptr(args.out); unsigned char* wp = fresh_ptr(args.ws);
    C.lds = lds; C.out = op; C.ws = wp; return C;
}
__device__ __forceinline__ int batch_of_row(int r) { return r < MP ? (r >> 11) : BP + ((r - MP) >> 2); }


typedef GAS unsigned gu32;
#define RLX_AGENT __ATOMIC_RELAXED, __HIP_MEMORY_SCOPE_AGENT
#define XB_TMO      128
#define XB_XCNT(j)  (256  + 64 * (j))
#define XB_XSUB(j)  (1280 + 64 * (j))
#define XB_XGEN(j)  (2304 + 64 * (j))
#define XB_TOP      3328
#define XB_TOPGEN   3392
#define XCD_BAR_WORDS 3456
#define XB_SPIN_CAP (1u << 18)

__device__ __forceinline__ unsigned xb_ld(unsigned* p)              { return __hip_atomic_load(p, __ATOMIC_RELAXED, __HIP_MEMORY_SCOPE_AGENT); }
__device__ __forceinline__ unsigned xb_add(unsigned* p, unsigned v) { return __hip_atomic_fetch_add(p, v, __ATOMIC_RELAXED, __HIP_MEMORY_SCOPE_AGENT); }
__device__ __forceinline__ unsigned xb_xcc_id() { return (unsigned)__builtin_amdgcn_s_getreg((3 << 11) | 20) & 0xFu; }
#define XB_SPIN(cond, bar) do { unsigned _sp = 0; while (cond) { __builtin_amdgcn_s_sleep(1); \
    if ((++_sp & 255u) == 0u) { if (xb_ld(&(bar)[XB_TMO])) break; if (_sp > XB_SPIN_CAP) { atomicAdd(&(bar)[XB_TMO], 1u); break; } } } } while (0)

struct XcdBarrier {
    unsigned* bar; unsigned x;
    volatile LAS unsigned* st;
};

__device__ __forceinline__ XcdBarrier xcd_barrier_post(unsigned* bar, volatile LAS unsigned* st) {
    XcdBarrier b; b.bar = bar; b.x = xb_xcc_id(); b.st = st;
    if (threadIdx.x == 0) (void)xb_add(&bar[XB_XCNT(b.x)], 1u);
    return b;
}
__device__ __forceinline__ void xcd_barrier_complete(unsigned* bar, unsigned x, unsigned& nloc, unsigned& nx) {
    const unsigned G = gridDim.x * gridDim.y * gridDim.z;
    unsigned sum, cnt, mine, sp = 0u;
    for (;;) {
        sum = 0u; cnt = 0u; mine = 0u;
#pragma unroll
        for (unsigned j = 0; j < 16; ++j) { const unsigned c = xb_ld(&bar[XB_XCNT(j)]); sum += c; cnt += (c > 0u) ? 1u : 0u; mine = (j == x) ? c : mine; }
        if (sum == G) break;
        __builtin_amdgcn_s_sleep(1);
        if ((++sp & 255u) == 0u) { if (xb_ld(&bar[XB_TMO])) break; if (sp > XB_SPIN_CAP) { atomicAdd(&bar[XB_TMO], 1u); break; } }
    }
    nloc = mine > 0u ? mine : 1u; nx = cnt > 0u ? cnt : 1u;
}

__device__ __forceinline__ void xcd_barrier(const XcdBarrier& b) {
    asm volatile("s_waitcnt vmcnt(0)" ::: "memory");
    __syncthreads();
    if (threadIdx.x == 0) {
        unsigned* bar = b.bar;
        __builtin_amdgcn_s_waitcnt(0);
        unsigned nloc = b.st[0], nx = b.st[1];
        if (nloc == 0u) { xcd_barrier_complete(bar, b.x, nloc, nx); b.st[0] = nloc; b.st[1] = nx; }
        const unsigned old = xb_add(&bar[XB_XSUB(b.x)], 1u);
        const unsigned gen = old / nloc;
        if (old + 1u == (gen + 1u) * nloc) {
            __builtin_amdgcn_fence(__ATOMIC_RELEASE, "agent");
            asm volatile("s_waitcnt vmcnt(0)" ::: "memory");
            const unsigned og = xb_add(&bar[XB_TOP], 1u);
            const unsigned tg = og / nx;
            if (og + 1u == (tg + 1u) * nx) xb_add(&bar[XB_TOPGEN], 1u);
            else XB_SPIN(xb_ld(&bar[XB_TOPGEN]) == tg, bar);
            __builtin_amdgcn_fence(__ATOMIC_ACQUIRE, "agent");
            xb_add(&bar[XB_XGEN(b.x)], 1u);
            asm volatile("s_waitcnt vmcnt(0)" ::: "memory");
        } else {
            XB_SPIN(xb_ld(&bar[XB_XGEN(b.x)]) == gen, bar);
            __builtin_amdgcn_fence(__ATOMIC_ACQUIRE, "agent");
            asm volatile("s_waitcnt vmcnt(0)" ::: "memory");
        }
    }
    __syncthreads();
}

constexpr int MISC_OFF = LDS_BYTES - 256;
__device__ __forceinline__ void grid_bar(const Args& args, LAS unsigned char* lds) {
    XcdBarrier b; b.bar = (unsigned*)fresh_ptr(args.ws); b.x = xb_xcc_id(); b.st = (volatile LAS unsigned*)(lds + MISC_OFF);
    xcd_barrier(b);
}

__device__ __forceinline__ float wave_sum2(float v) { v = row16_sum(v); v += __shfl_xor(v, 16); v += __shfl_xor(v, 32); return v; }

namespace pg8 {
struct EpiSwiglu {
    static constexpr bool PERM = true, AFTER_DRAIN = false;
    bf16_t* O; int ldc;
    __device__ __forceinline__ void operator()(const f32x4 (&acc)[2][2][4][2], const Unit& u, int wr, int wc, int fr, int fq) const {
        const int row0 = u.pm * BM + wr * 64 + fr, col0 = u.pn * 128 + wc * 32 + 8 * fq;
#pragma unroll
        for (int ai = 0; ai < 2; ++ai)
#pragma unroll
            for (int m = 0; m < 4; ++m) {
                bf16_t* rowp = O + (size_t)(row0 + ai * HALF + m * 16) * ldc + col0;
                float h[8];
#pragma unroll
                for (int n = 0; n < 2; ++n)
#pragma unroll
                    for (int j = 0; j < 4; ++j) {
                        const float a = acc[ai][0][m][n][j], b = acc[ai][1][m][n][j];
                        const float e = __builtin_amdgcn_exp2f(-1.44269504f * a);
                        h[n * 4 + j] = a * __builtin_amdgcn_rcpf(1.0f + e) * b;
                    }
                u32x4 w; w.x = cvt_pk_bf16(h[0], h[1]); w.y = cvt_pk_bf16(h[2], h[3]); w.z = cvt_pk_bf16(h[4], h[5]); w.w = cvt_pk_bf16(h[6], h[7]);
                *(u32x4*)rowp = w;
            }
    }
};
struct EpiPlain {
    static constexpr bool PERM = true, AFTER_DRAIN = false;
    bf16_t* O; int ldc;
    __device__ __forceinline__ void operator()(const f32x4 (&acc)[2][2][4][2], const Unit& u, int wr, int wc, int fr, int fq) const {
        const int row0 = u.pm * BM + wr * 64 + fr, col0 = u.pn * BM + wc * 32 + 8 * fq;
#pragma unroll
        for (int ai = 0; ai < 2; ++ai)
#pragma unroll
            for (int m = 0; m < 4; ++m) {
                bf16_t* rowp = O + (size_t)(row0 + ai * HALF + m * 16) * ldc + col0;
#pragma unroll
                for (int bj = 0; bj < 2; ++bj) { const f32x4 v0 = acc[ai][bj][m][0], v1 = acc[ai][bj][m][1];
                    u32x4 w; w.x = cvt_pk_bf16(v0[0], v0[1]); w.y = cvt_pk_bf16(v0[2], v0[3]); w.z = cvt_pk_bf16(v1[0], v1[1]); w.w = cvt_pk_bf16(v1[2], v1[3]);
                    *(u32x4*)(rowp + bj * HALF) = w; }
            }
    }
};
struct EpiRes {
    static constexpr bool PERM = false, AFTER_DRAIN = false;
    float* X; float* PART; const float* gate; const float* stats; const float* lg; const float* lb; float scale; int ntf;
    __device__ __forceinline__ void operator()(const f32x4 (&acc)[2][2][4][2], const Unit& u, int wr, int wc, int fr, int fq) const {
        const int col0 = u.pn * BM + wc * 32 + 4 * fq;
        const bool full = (u.nt == ntf);
        float* pbase = PART + (size_t)(u.k0 / SplitOrder::PK) * (512 * 1024);
#pragma unroll
        for (int ai = 0; ai < 2; ++ai)
#pragma unroll
            for (int m = 0; m < 4; ++m) {
                const int r = u.pm * BM + ai * HALF + wr * 64 + m * 16 + fr;
                const int bi = r < 16384 ? (r >> 11) : 8 + ((r - 16384) >> 2);
                const float* gp = gate + (size_t)bi * 9216;
                float* xo = full ? X + (size_t)r * 1024 : pbase + (size_t)(r - 16384) * 1024;
                float mean = 0.f, rs = 0.f;
                if (full) { const f32x2 st = *(const f32x2*)(stats + 2 * (size_t)r); mean = st.x; rs = st.y * 1.41421356237f; }
#pragma unroll
                for (int bj = 0; bj < 2; ++bj)
#pragma unroll
                    for (int n = 0; n < 2; ++n) {
                        const int c = col0 + bj * HALF + n * 16;
                        const f32x4 gv = *(const f32x4*)(gp + c);
                        f32x4 o = (gv * scale + scale) * acc[ai][bj][m][n];
                        if (full) { const f32x4 y = *(const f32x4*)(xo + c), g4 = *(const f32x4*)(lg + c), b4 = *(const f32x4*)(lb + c);
                            o += (y - mean) * rs * g4 + b4 * 1.41421356237f; }
                        *(f32x4*)(xo + c) = o;
                        asm volatile("" ::: "memory");
                    }
            }
    }
};
struct EpiMod {
    static constexpr bool PERM = false, AFTER_DRAIN = false;
    float* MODp; const float* ada_b;
    __device__ __forceinline__ void operator()(const f32x4 (&acc)[2][2][4][2], const Unit& u, int wr, int wc, int fr, int fq) const {
        const int col0 = u.pn * BM + wc * 32 + 4 * fq;
        const int l = (u.pn * BM) / 9216;
#pragma unroll
        for (int ai = 0; ai < 2; ++ai)
#pragma unroll
            for (int m = 0; m < 4; ++m) {
                const int r = u.pm * BM + ai * HALF + wr * 64 + m * 16 + fr;
                if (r < 136) {
#pragma unroll
                    for (int bj = 0; bj < 2; ++bj)
#pragma unroll
                        for (int n = 0; n < 2; ++n) {
                            const int c = col0 + bj * HALF + n * 16;
                            const f32x4 o = acc[ai][bj][m][n] + *(const f32x4*)(ada_b + c);
                            *(f32x4*)(MODp + (size_t)(l * 136 + r) * 9216 + (c - l * 9216)) = o;
                        }
                }
            }
    }
};
}

__device__ __forceinline__ void transpose_item(const float* W, int K, int N, bf16* WT, int dest_row0, LAS float* scr, int k0, int n0, int lane) {
    const int nn = n0 + (lane & 31); const bool ok = nn < N;
    float tv[32];
#pragma unroll
    for (int i = 0; i < 32; ++i) { const int kk = 2 * i + (lane >> 5); tv[i] = ok ? W[(size_t)(k0 + kk) * N + nn] : 0.f; }
#pragma unroll
    for (int i = 0; i < 32; ++i) { const int kk = 2 * i + (lane >> 5); scr[kk * 33 + (lane & 31)] = tv[i]; }
    LDS_WAIT();
    const int c = lane & 7;
#pragma unroll
    for (int j = 0; j < 4; ++j) { const int n = (lane >> 3) + 8 * j; const LAS float* s = scr + (8 * c) * 33 + n;
        v4u o; o.x = pk2(s[0 * 33], s[1 * 33]); o.y = pk2(s[2 * 33], s[3 * 33]); o.z = pk2(s[4 * 33], s[5 * 33]); o.w = pk2(s[6 * 33], s[7 * 33]);
        *(v4u*)(WT + (size_t)(dest_row0 + n) * K + k0 + 8 * c) = o; }
    LDS_WAIT();
}

constexpr int I_WI = 16 * 176, I_WO = 44 * 32, I_WIN = 16 * 121, I_WOUT = 16 * 32, I_ADA = 16 * 288;
constexpr int I_MAIN = 2 * I_WI + 2 * I_WO + I_WIN + I_WOUT, I_LAYER = I_MAIN + I_ADA;
__device__ __forceinline__ void convert_item(const Args& args, unsigned char* ws, int l, int r, LAS float* scr, int lane) {
    unsigned char* wl = ws + WS_W + (size_t)l * W_LAYER;
    if (r < 2 * (I_WI + I_WO)) {
        const int f = r / (I_WI + I_WO); r -= f * (I_WI + I_WO);
        if (r < I_WI) {
            const int kb = r / 176, nb = r % 176, n0 = nb * 32;
            const int half = n0 / DFF, j = n0 - half * DFF, t = j >> 7, jj = j & 127;
            transpose_item((f ? args.in[15] : args.in[13]) + (size_t)l * D * NWI, D, NWI, (bf16*)(wl + (f ? W_WI2 : W_WI1)), 256 * t + 128 * half + jj, scr, kb * 64, n0, lane);
        } else { r -= I_WI;
            const int kb = r / 32, nb = r % 32;
            transpose_item((f ? args.in[16] : args.in[14]) + (size_t)l * DFF * D, DFF, D, (bf16*)(wl + (f ? W_WO2 : W_WO1)), nb * 32, scr, kb * 64, nb * 32, lane);
        }
        return;
    }
    r -= 2 * (I_WI + I_WO);
    if (r < I_WIN) { const int kb = r / 121, nb = r % 121;
        transpose_item(args.in[17] + (size_t)l * D * NIN, D, NIN, (bf16*)(wl + W_WIN), nb * 32, scr, kb * 64, nb * 32, lane); return; }
    r -= I_WIN;
    if (r < I_WOUT) { const int kb = r / 32, nb = r % 32;
        transpose_item(args.in[27] + (size_t)l * D * D, D, D, (bf16*)(wl + W_WOUT), nb * 32, scr, kb * 64, nb * 32, lane); return; }
    r -= I_WOUT;
    { const int kb = r / 288, nb = r % 288;
        transpose_item(args.in[9] + (size_t)l * D * NMODC, D, NMODC, (bf16*)(ws + WS_BIG), l * NMODC + nb * 32, scr, kb * 64, nb * 32, lane); }
}

__device__ __forceinline__ void p0_prologue(const Args& args, LAS unsigned char* lds_) {
    const Ctx C = make_ctx(args, lds_);
    LAS float* scr = (LAS float*)(C.lds + C.wave * 16384);
    for (int it = C.gw; it < 2 * I_ADA; it += C.NGW) convert_item(args, C.ws, it / I_ADA, I_MAIN + it % I_ADA, scr, C.lane);
    const int gt = C.gw * 64 + C.lane, NGT = C.NGW * 64;
    for (int i = gt; i < 2 * 224 * 128; i += NGT) { const int l = i / (224 * 128), rr = (i / 128) % 224, ch = i & 127;
        *(v4u*)(C.ws + WS_W + (size_t)l * W_LAYER + W_WIN + ((size_t)(3872 + rr) * 1024 + ch * 8) * 2) = (v4u){0u, 0u, 0u, 0u}; }
    for (int i = gt; i < 2048; i += NGT) ((float*)(C.ws + WS_ID))[i] = i < 1024 ? 1.0f : 0.f;
    for (int i = gt; i < 256 * 256; i += NGT) { const int row = i >> 8, c4 = (i & 255) * 4;
        v2u o = (v2u){0u, 0u};
        if (row < NB) { const float* src = row < BP ? args.in[7] + (size_t)row * D : args.in[8] + (size_t)(row - BP) * D; const f32x4 v = *(const f32x4*)(src + c4);
            o.x = pk2(siluf_(v.x), siluf_(v.y)); o.y = pk2(siluf_(v.z), siluf_(v.w)); }
        *(v2u*)(C.ws + WS_AC + ((size_t)row * D + c4) * 2) = o; }
    for (int i = gt; i < 2052 * 32; i += NGT) { const int p = i >> 5, j = i & 31; const double pos = p < 2048 ? (double)p : (double)(16384 + (p - 2048));
        double inv = 1.0; for (int q = 0; q < j; ++q) inv *= 0.7498942093324559;
        const double ang = pos * inv; const double n = rint(ang * 0.15915494309189535);
        const float rr = (float)((ang - n * 6.283185307179586) - n * 2.4492935982947064e-16);
        ((f32x2*)(C.ws + WS_ROPE))[i] = (f32x2){__cosf(rr), __sinf(rr)}; }
}

__device__ __forceinline__ void p1_convert(const Args& args, LAS unsigned char* lds_) {
    const Ctx C = make_ctx(args, lds_);
    if ((int)blockIdx.x < 72) return;
    LAS float* scr = (LAS float*)(C.lds + C.wave * 16384);
    constexpr int I_F0 = I_WI + I_WO, I_P0 = I_F0 + I_WIN;
    for (int it = ((int)blockIdx.x - 72) * NWAVES + C.wave; it < I_P0; it += 184 * NWAVES) {
        if (it < I_F0) convert_item(args, C.ws, 0, it, scr, C.lane);
        else convert_item(args, C.ws, 0, 2 * I_F0 + (it - I_F0), scr, C.lane);
    }
}

__device__ __forceinline__ void p2_modulate0(const Args& args, LAS unsigned char* lds_) {
    const Ctx C = make_ctx(args, lds_);
    const float* MOD = (const float*)(C.ws + WS_MOD); bf16* H = (bf16*)(C.ws + WS_H);
    for (int r = C.gw; r < M; r += C.NGW) {
        const float* xr = r < MP ? args.in[0] + (size_t)r * D : args.in[1] + (size_t)(r - MP) * D;
        const float* modr = MOD + (size_t)batch_of_row(r) * NMODC;
        if (C.lane == 0) *(f32x2*)((float*)(C.ws + WS_STATS) + 2 * (size_t)r) = (f32x2){0.f, 1.0f};
#pragma unroll
        for (int j = 0; j < 4; ++j) { const int c = (C.lane + 64 * j) * 4;
            const f32x4 v = *(const f32x4*)(xr + c), sh = *(const f32x4*)(modr + c), sc = *(const f32x4*)(modr + 1024 + c);
            const f32x4 h = v * (sc + 1.0f) + sh;
            *(f32x4*)(C.out + (size_t)r * D + c) = v * (r < MP ? 1.0f : ALPHA);
            *(v2u*)(H + (size_t)r * D + c) = (v2u){pk2(h.x, h.y), pk2(h.z, h.w)}; }
    }
}

__device__ __forceinline__ void ln_phase(const Args& args, LAS unsigned char* lds_, int l, int which, bool write_h, int hl, int shc, int npart, float xscale, bool write_x) {
    const Ctx C = make_ctx(args, lds_);
    const float* MOD = (const float*)(C.ws + WS_MOD); bf16* H = (bf16*)(C.ws + WS_H);
    const float* g = args.in[11] + (size_t)(l * 3 + which) * D; const float* b = args.in[12] + (size_t)(l * 3 + which) * D;
    f32x4 nv[4];
    if (C.gw < M) {
#pragma unroll
        for (int j = 0; j < 4; ++j) nv[j] = *(const f32x4*)(C.out + (size_t)C.gw * D + (C.lane + 64 * j) * 4); }
#pragma unroll 1
    for (int r = C.gw; r < M; r += C.NGW) {
        float* xr = C.out + (size_t)r * D;
        f32x4 v[4]; float s = 0.f;
#pragma unroll
        for (int j = 0; j < 4; ++j) v[j] = nv[j];
        if (r + C.NGW < M) {
#pragma unroll
            for (int j = 0; j < 4; ++j) nv[j] = *(const f32x4*)(xr + (size_t)C.NGW * D + (C.lane + 64 * j) * 4); }
        if (r >= MP) { const float* pp = (const float*)(C.ws + WS_SB) + (size_t)(r - MP) * D;
#pragma unroll 1
            for (int p = 0; p < npart; ++p, pp += 512 * 1024) {
#pragma unroll
                for (int j = 0; j < 4; ++j) v[j] += *(const f32x4*)(pp + (C.lane + 64 * j) * 4); } }
#pragma unroll
        for (int j = 0; j < 4; ++j) s += (v[j].x + v[j].y) + (v[j].z + v[j].w);
        const float mean = wave_sum2(s) * (1.f / D); float s2 = 0.f;
#pragma unroll
        for (int j = 0; j < 4; ++j) { v[j] = v[j] - mean; s2 += (v[j].x * v[j].x + v[j].y * v[j].y) + (v[j].z * v[j].z + v[j].w * v[j].w); }
        const float rstd = 1.f / sqrtf(wave_sum2(s2) * (1.f / D) + LN_EPS);
        if (C.lane == 0) *(f32x2*)((float*)(C.ws + WS_STATS) + 2 * (size_t)r) = (f32x2){mean, rstd};
        const float* modr = MOD + (size_t)(hl * NB + batch_of_row(r)) * NMODC + shc * 1024;
#pragma unroll
        for (int j = 0; j < 4; ++j) { const int c = (C.lane + 64 * j) * 4;
            const f32x4 xn = v[j] * rstd * *(const f32x4*)(g + c) + *(const f32x4*)(b + c);
            if (write_x || r >= MP) *(f32x4*)(xr + c) = xn * xscale;
            if (write_h) { const f32x4 sh = *(const f32x4*)(modr + c), sc = *(const f32x4*)(modr + 1024 + c); const f32x4 h = xn * (sc + 1.0f) + sh;
                *(v2u*)(H + (size_t)r * D + c) = (v2u){pk2(h.x, h.y), pk2(h.z, h.w)}; }
        }
    }
}

struct PrepRaw { unsigned short rq1[4], rq2[4], rk1[4], rk2[4], aq[2], hf[4], hq[4], dx[12], db, da; v4u alr0, alr1; };
__device__ __forceinline__ void prep_load(PrepRaw& x, const bf16* P, int lane) {
    const int j = lane & 31;
#pragma unroll
    for (int h = 0; h < 4; ++h) { x.rq1[h] = P[C_RQ + h * 64 + j]; x.rq2[h] = P[C_RQ + h * 64 + 32 + j]; x.rk1[h] = P[C_RK + h * 64 + j]; x.rk2[h] = P[C_RK + h * 64 + 32 + j]; }
    x.alr0 = *(const v4u*)(P + C_ALR); x.alr1 = *(const v4u*)(P + C_ALR + 8);
#pragma unroll
    for (int i = 0; i < 2; ++i) x.aq[i] = P[C_AQ + lane + 64 * i];
#pragma unroll
    for (int i = 0; i < 4; ++i) { x.hf[i] = P[C_HF + lane + 64 * i]; x.hq[i] = P[C_HQ + lane + 64 * i]; }
#pragma unroll
    for (int i = 0; i < 12; ++i) x.dx[i] = P[C_DQKV + lane + 64 * i];
    x.db = P[C_DB + (lane & 3)]; x.da = P[C_DA + (lane & 3)];
}

__device__ __forceinline__ void prep_phase(const Args& args, LAS unsigned char* lds_, int l) {
    const Ctx C = make_ctx(args, lds_);
    const bf16* PROJ = (const bf16*)(C.ws + WS_BIG); bf16* SB = (bf16*)(C.ws + WS_SB); float* SF = (float*)(C.ws + WS_SF);
    const f32x2* ROPE = (const f32x2*)(C.ws + WS_ROPE);
    const int lane = C.lane;
    const float* wg = args.in[18] + (size_t)l * 16 * 128; const float* bg = args.in[19] + (size_t)l * 128;
    const float* cw = args.in[21] + (size_t)l * 4 * 768;
    LAS float* lwg = (LAS float*)C.lds; LAS float* lcw = lwg + 16 * 128;
    for (int i = C.tid; i < 16 * 128; i += NWAVES * 64) lwg[i] = wg[i];
    for (int i = C.tid; i < 4 * 768; i += NWAVES * 64) lcw[i] = cw[i];
    __syncthreads();
    constexpr int CH = 9;
    const int r0 = C.gw * CH, r1 = min(r0 + CH, M);
    if (r0 >= M) return;
    float lbv[4];
#pragma unroll
    for (int i = 0; i < 4; ++i) { lbv[i] = 0.f; if (l == 1) lbv[i] = 1.0f / (1.0f + expf(args.in[20][lane + 64 * i] - args.in[20][256 + lane + 64 * i])); }
    const float a_neg = -expf(args.in[22][l * 4 + (lane & 3)]), dtb = args.in[23][l * 4 + (lane & 3)];
    const float bg0 = bg[lane], bg1 = bg[lane + 64];
    float w1[12], w2[12], w3[12];
    auto load_window = [&](int r) {
        const bool isp = r < MP; const int rs = r - MP; const int b = isp ? (r >> 11) : (rs >> 2), t = isp ? (r & 2047) : (rs & 3);
        const float* cst = args.in[6] + ((size_t)(l * BS + b) * 3) * 768;
#pragma unroll
        for (int i = 0; i < 12; ++i) { const int ch = lane + 64 * i; const bf16* Pc = PROJ + (size_t)r * NINP + C_DQKV + ch;
            w1[i] = t >= 1 ? bf2f(Pc[-1 * NINP]) : (isp ? 0.f : cst[2 * 768 + ch]);
            w2[i] = t >= 2 ? bf2f(Pc[-2 * NINP]) : (isp ? 0.f : cst[(1 + t) * 768 + ch]);
            w3[i] = t >= 3 ? bf2f(Pc[-3 * NINP]) : (isp ? 0.f : cst[t * 768 + ch]); }
    };
    PrepRaw A; prep_load(A, PROJ + (size_t)r0 * NINP, lane);
    load_window(r0);
#pragma unroll 1
    for (int r = r0; r < r1; ++r) {
        PrepRaw B = A;
        if (r + 1 < r1) prep_load(B, PROJ + (size_t)(r + 1) * NINP, lane);
        int zo = 0; asm volatile("" : "+v"(zo));
        const bool isp = r < MP; const int rs = r - MP;
        const int b = isp ? (r >> 11) : (rs >> 2), t = isp ? (r & 2047) : (rs & 3);
        const int ridx = isp ? t : 2048 + t;
        bf16* sb = SB + (size_t)r * SBW; float* sf = SF + (size_t)r * SFW;
        { const int j = lane & 31; const bool hi = lane >= 32; const f32x2 cs = ROPE[ridx * 32 + j];
#pragma unroll
          for (int h = 0; h < 4; ++h) {
              const float q1 = bf2f(A.rq1[h]), q2 = bf2f(A.rq2[h]), k1 = bf2f(A.rk1[h]), k2 = bf2f(A.rk2[h]);
              const float qo = hi ? (q1 * cs.y + q2 * cs.x) : (q1 * cs.x - q2 * cs.y);
              const float ko = hi ? (k1 * cs.y + k2 * cs.x) : (k1 * cs.x - k2 * cs.y);
              sb[SB_RQ + h * 64 + lane] = (bf16)(pk2(qo, 0.f) & 0xffffu);
              sb[SB_RK + h * 64 + lane] = (bf16)(pk2(ko * 0.125f, 0.f) & 0xffffu);
          } }
        { const unsigned aw[8] = {A.alr0.x, A.alr0.y, A.alr0.z, A.alr0.w, A.alr1.x, A.alr1.y, A.alr1.z, A.alr1.w};
          float x0 = bg0, x1 = bg1;
#pragma unroll
          for (int i = 0; i < 8; ++i) { const float a0 = bflo(aw[i]), a1 = bfhi(aw[i]);
              x0 += a0 * lwg[(2 * i) * 128 + lane + zo] + a1 * lwg[(2 * i + 1) * 128 + lane + zo];
              x1 += a0 * lwg[(2 * i) * 128 + lane + 64 + zo] + a1 * lwg[(2 * i + 1) * 128 + lane + 64 + zo]; }
          const float sp0 = fmaxf(-x0, 0.f) + log1pf(expf(-fabsf(x0))), sp1 = fmaxf(-x1, 0.f) + log1pf(expf(-fabsf(x1)));
          sf[SF_ADEC + lane] = expf(-sp0 * (1.0f / 16.0f)); sf[SF_ADEC + lane + 64] = expf(-sp1 * (1.0f / 16.0f));
          sb[SB_AQ + lane] = (bf16)(pk2(bf2f(A.aq[0]) * 0.17677669529663687f, 0.f) & 0xffffu);
          sb[SB_AQ + lane + 64] = (bf16)(pk2(bf2f(A.aq[1]) * 0.17677669529663687f, 0.f) & 0xffffu); }
#pragma unroll
        for (int i = 0; i < 4; ++i) { const int c = lane + 64 * i;
            sf[SF_HF + c] = lbv[i] + (1.0f - lbv[i]) * sigmoidf_(bf2f(A.hf[i]));
            sb[SB_HQ + c] = (bf16)(pk2(siluf_(bf2f(A.hq[i])) * 0.125f, 0.f) & 0xffffu); }
        { float* cso = isp ? C.out + O_PCONV + ((size_t)(l * BP + b) * 3) * 768 : C.out + O_SCONV + ((size_t)(l * BS + b) * 3) * 768;
          const int so = isp ? t - (TP - 3) : t - 1;
          float uu[12];
#pragma unroll
          for (int i = 0; i < 12; ++i) { const float x0 = bf2f(A.dx[i]);
              const LAS float* cwc = lcw + lane + 64 * i + zo;
              uu[i] = siluf_(x0 * cwc[3 * 768] + w1[i] * cwc[2 * 768] + w2[i] * cwc[768] + w3[i] * cwc[0]);
              if (so >= 0) cso[so * 768 + lane + 64 * i] = x0;
              w3[i] = w2[i]; w2[i] = w1[i]; w1[i] = x0; }
float qr[4];
#pragma unroll
          for (int i = 0; i < 12; ++i) { float sc = 1.0f;
              if (i < 8) { const float nn = wave_sum2(uu[i] * uu[i]); sc = rsqrtf(nn + RMS_EPS) * (i < 4 ? 0.125f : 1.0f); }
              const unsigned wbits = pk2(uu[i] * sc, 0.f) & 0xffffu;
              sb[SB_DQ + i * 64 + lane] = (bf16)wbits;
              if (i < 4) qr[i] = bf2f(wbits);
              else if (i < 8) { const float qk = wave_sum2(qr[i - 4] * bf2f(wbits)); if (lane == 0) sf[SF_QK + (i - 4)] = qk; } }
          if (lane < 4) { sf[SF_BETA + lane] = sigmoidf_(bf2f(A.db));
              const float xx = bf2f(A.da) + dtb; const float sp = fmaxf(xx, 0.f) + log1pf(expf(-fabsf(xx)));
              sf[SF_DDEC + lane] = expf(a_neg * sp); } }
        A = B;
        if (r + 1 < r1) { const int rn = r + 1; const bool ns = rn < MP ? ((rn & 2047) == 0) : (((rn - MP) & 3) == 0); if (ns) load_window(rn); }
    }
}

template <int KIND, int DH, int R> struct Raw { unsigned q[DH / 2]; unsigned k[DH / 2]; unsigned v[(R + 1) / 2]; float f[DH]; float be, de; };

template <int KIND, int DH, int R>
__device__ __forceinline__ void load_tok(Raw<KIND, DH, R>& x, const bf16* qp, const bf16* kp, const bf16* vp, const float* fp) {
    if constexpr (DH == 4) { const v2u w = *(const v2u*)qp; x.q[0] = w.x; x.q[1] = w.y; } else { x.q[0] = *(const unsigned*)qp; }
    if constexpr (KIND != 2) { if constexpr (DH == 4) { const v2u w = *(const v2u*)kp; x.k[0] = w.x; x.k[1] = w.y; } else { x.k[0] = *(const unsigned*)kp; } }
    if constexpr (R == 1) x.v[0] = *vp; else if constexpr (R == 2) x.v[0] = *(const unsigned*)vp; else { const v2u w = *(const v2u*)vp; x.v[0] = w.x; x.v[1] = w.y; }
    if constexpr (KIND == 1) { const f32x2 w = *(const f32x2*)fp; x.f[0] = w.x; x.f[1] = w.y; }
    if constexpr (KIND == 2) { const f32x4 w = *(const f32x4*)fp; x.f[0] = w.x; x.f[1] = w.y; x.f[2] = w.z; x.f[3] = w.w; }
    if constexpr (KIND == 3) { x.be = fp[0]; x.de = fp[4]; }
}

template <int KIND, int DH, int R>
__device__ __forceinline__ void scan_task(const Ctx& C, int row0, int T, int h, int slice, const float* sin, float* sout) {
    const bf16* PROJ = (const bf16*)(C.ws + WS_BIG); const bf16* SB = (const bf16*)(C.ws + WS_SB); const float* SF = (const float*)(C.ws + WS_SF);
    bf16* H = (bf16*)(C.ws + WS_H);
    const int lane = C.lane, dl = lane & 15, rw = lane >> 4;
    const int d0 = dl * DH, v0 = slice * (4 * R) + rw * R;
    constexpr int DK = 16 * DH;
    const bf16 *qp, *kp, *vp; const float* fp; int ks, vs;
    const bf16* sbr = SB + (size_t)row0 * SBW; const bf16* pr = PROJ + (size_t)row0 * NINP; const float* sfr = SF + (size_t)row0 * SFW;
    if constexpr (KIND == 0) { qp = sbr + SB_RQ + h * 64 + d0; kp = sbr + SB_RK + h * 64 + d0; ks = SBW; vp = pr + C_RV + h * 64 + v0; vs = NINP; fp = sfr; }
    if constexpr (KIND == 1) { qp = sbr + SB_AQ + h * 32 + d0; kp = pr + C_AK + h * 32 + d0; ks = NINP; vp = pr + C_AV + h * 64 + v0; vs = NINP; fp = sfr + SF_ADEC + h * 32 + d0; }
    if constexpr (KIND == 2) { qp = sbr + SB_HQ + h * 64 + d0; kp = sbr; ks = SBW; vp = pr + C_HI + h * 64 + v0; vs = NINP; fp = sfr + SF_HF + h * 64 + d0; }
    if constexpr (KIND == 3) { qp = sbr + SB_DQ + h * 64 + d0; kp = sbr + SB_DK + h * 64 + d0; ks = SBW; vp = sbr + SB_DV + h * 64 + v0; vs = SBW; fp = sfr + SF_BETA + h; }
    bf16* op = H + (size_t)row0 * D + KIND * 256 + h * 64 + v0;
    const float rdec = 1.0f - exp2f(-5.0f - (float)h);

    float S[DH][R];
#pragma unroll
    for (int dh = 0; dh < DH; ++dh)
#pragma unroll
        for (int vv = 0; vv < R; ++vv) S[dh][vv] = sin ? sin[(size_t)(d0 + dh) * 64 + v0 + vv] : 0.f;

    typedef Raw<KIND, DH, R> RawT;
    RawT A[4];
#pragma unroll
    for (int u = 0; u < 4; ++u) load_tok<KIND, DH, R>(A[u], qp + (size_t)u * SBW, kp + (size_t)u * ks, vp + (size_t)u * vs, fp + (size_t)u * SFW);
    for (int t0 = 0; t0 < T; t0 += 4) {
        RawT B[4];
        const bool more = t0 + 4 < T;
#pragma unroll
        for (int u = 0; u < 4; ++u) { B[u] = A[u]; }
        if (more) {
#pragma unroll
            for (int u = 0; u < 4; ++u) load_tok<KIND, DH, R>(B[u], qp + (size_t)(t0 + 4 + u) * SBW, kp + (size_t)(t0 + 4 + u) * ks, vp + (size_t)(t0 + 4 + u) * vs, fp + (size_t)(t0 + 4 + u) * SFW);
        }
#pragma unroll
        for (int u = 0; u < 4; ++u) {
            const RawT& x = A[u];
            float q[DH], k[DH], v[R];
            q[0] = bflo(x.q[0]); q[1] = bfhi(x.q[0]); if constexpr (DH == 4) { q[2] = bflo(x.q[1]); q[3] = bfhi(x.q[1]); }
            if constexpr (KIND != 2) { k[0] = bflo(x.k[0]); k[1] = bfhi(x.k[0]); if constexpr (DH == 4) { k[2] = bflo(x.k[1]); k[3] = bfhi(x.k[1]); } }
            if constexpr (R == 1) v[0] = bflo(x.v[0]);
            if constexpr (R >= 2) { v[0] = bflo(x.v[0]); v[1] = bfhi(x.v[0]); }
            if constexpr (R == 4) { v[2] = bflo(x.v[1]); v[3] = bfhi(x.v[1]); }
            float o[R];
            if constexpr (KIND == 3) {
                float ks_[R];
#pragma unroll
                for (int vv = 0; vv < R; ++vv) { float p = 0.f;
#pragma unroll
                    for (int dh = 0; dh < DH; ++dh) { S[dh][vv] *= x.de; p += k[dh] * S[dh][vv]; }
                    ks_[vv] = row16_sum(p); }
#pragma unroll
                for (int vv = 0; vv < R; ++vv) { const float uu = x.be * (v[vv] - ks_[vv]); float p = 0.f;
#pragma unroll
                    for (int dh = 0; dh < DH; ++dh) { S[dh][vv] += k[dh] * uu; p += q[dh] * S[dh][vv]; }
                    o[vv] = row16_sum(p); }
            } else {
#pragma unroll
                for (int dh = 0; dh < DH; ++dh) {
                    float dec, kk;
                    if constexpr (KIND == 0) { dec = rdec; kk = k[dh]; }
                    if constexpr (KIND == 1) { dec = x.f[dh]; kk = k[dh]; }
                    if constexpr (KIND == 2) { dec = x.f[dh]; kk = 1.0f - x.f[dh]; }
#pragma unroll
                    for (int vv = 0; vv < R; ++vv) S[dh][vv] = dec * S[dh][vv] + kk * v[vv];
                }
#pragma unroll
                for (int vv = 0; vv < R; ++vv) { float p = 0.f;
#pragma unroll
                    for (int dh = 0; dh < DH; ++dh) p += q[dh] * S[dh][vv];
                    o[vv] = row16_sum(p); }
            }
            if (dl == 0) {
                bf16* o_ = op + (size_t)(t0 + u) * D;
                if constexpr (R == 1) *o_ = (bf16)(pk2(o[0], 0.f) & 0xffffu);
                if constexpr (R == 2) *(unsigned*)o_ = pk2(o[0], o[1]);
                if constexpr (R == 4) *(v2u*)o_ = (v2u){pk2(o[0], o[1]), pk2(o[2], o[3])};
            }
        }
#pragma unroll
        for (int u = 0; u < 4; ++u) A[u] = B[u];
    }
#pragma unroll
    for (int dh = 0; dh < DH; ++dh)
#pragma unroll
        for (int vv = 0; vv < R; ++vv) sout[(size_t)(d0 + dh) * 64 + v0 + vv] = S[dh][vv];
    (void)DK;
}

template <int KIND, int DH, int R>
__device__ __forceinline__ void scan_long(const Ctx& C, LAS float* wl, int row0, int T, int h, int slice, float* sout) {
    constexpr int CT = 16, LR = 8, DK = LR * DH, NV = (64 / LR) * R, UNR = 8;
    constexpr bool HASK = true, GK = (KIND != 2), HASF = (KIND == 1 || KIND == 2), HASB = (KIND == 3);
    constexpr int OQ = 0, OK_ = OQ + CT * DK, OF = OK_ + (HASK ? CT * DK : 0), OV = OF + (HASF ? CT * DK : 0), OB = OV + CT * NV, BUF = OB + (HASB ? CT * 4 : 0);
    const bf16* PROJ = (const bf16*)(C.ws + WS_BIG); const bf16* SB = (const bf16*)(C.ws + WS_SB); const float* SF = (const float*)(C.ws + WS_SF);
    bf16* H = (bf16*)(C.ws + WS_H);
    const int lane = C.lane, dl = lane & (LR - 1), rw = lane / LR;
    const int d0 = dl * DH;
    const int stok = lane >> 2, spart = lane & 3;
    const GAS bf16 *qg, *kg, *vg; const GAS float *fg, *bg; int ks, vs;
    {
        const GAS bf16* sbr = (const GAS bf16*)(SB + (size_t)row0 * SBW); const GAS bf16* pr = (const GAS bf16*)(PROJ + (size_t)row0 * NINP); const GAS float* sfr = (const GAS float*)(SF + (size_t)row0 * SFW);
        const int vcol = slice * NV;
        if constexpr (KIND == 0) { qg = sbr + SB_RQ + h * 64; kg = sbr + SB_RK + h * 64; ks = SBW; vg = pr + C_RV + h * 64 + vcol; vs = NINP; fg = sfr; bg = sfr; }
        if constexpr (KIND == 1) { qg = sbr + SB_AQ + h * 32; kg = pr + C_AK + h * 32; ks = NINP; vg = pr + C_AV + h * 64 + vcol; vs = NINP; fg = sfr + SF_ADEC + h * 32; bg = sfr; }
        if constexpr (KIND == 2) { qg = sbr + SB_HQ + h * 64; kg = sbr; ks = SBW; vg = pr + C_HI + h * 64 + vcol; vs = NINP; fg = sfr + SF_HF + h * 64; bg = sfr; }
        if constexpr (KIND == 3) { qg = sbr + SB_DQ + h * 64; kg = sbr + SB_DK + h * 64; ks = SBW; vg = sbr + SB_DV + h * 64 + vcol; vs = SBW; fg = sfr; bg = sfr + SF_BETA + h; }
    }
    constexpr int QP = DK / 4;
    qg += (size_t)stok * SBW + spart * QP; kg += (size_t)stok * ks + spart * QP; fg += (size_t)stok * SFW + spart * QP;
    vg += (size_t)(lane & 15) * vs; bg += (size_t)(lane & 15) * SFW;
    GAS bf16* op = (GAS bf16*)(H + (size_t)row0 * D + KIND * 256 + h * 64 + slice * NV + rw * R);
    const float rdec = 1.0f - exp2f(-5.0f - (float)h);

    static_assert(R == 1, "scan_long: one column per lane row");
    f32x2 S2[DH / 2];
#pragma unroll
    for (int i = 0; i < DH / 2; ++i) S2[i] = (f32x2){0.f, 0.f};

    struct SR { v4u rq[QP / 8], rk[QP / 8]; f32x4 rf[QP / 4]; unsigned rv[NV / 2]; float rb0, rb1, rb2; };
    SR s0; s0.rb0 = s0.rb1 = s0.rb2 = 0.f;
    auto stage_load = [&](SR& sr, int c) {
        const size_t t = (size_t)c * CT;
#pragma unroll
        for (int i = 0; i < QP / 8; ++i) { sr.rq[i] = *(const GAS v4u*)(qg + t * SBW + i * 8); if constexpr (GK) sr.rk[i] = *(const GAS v4u*)(kg + t * ks + i * 8); }
        if constexpr (HASF) {
#pragma unroll
            for (int i = 0; i < QP / 4; ++i) sr.rf[i] = *(const GAS f32x4*)(fg + t * SFW + i * 4); }
        if (lane < 16) {
            if constexpr (NV == 4) { const v2u w = *(const GAS v2u*)(vg + t * vs); sr.rv[0] = w.x; sr.rv[1] = w.y; }
            if constexpr (NV == 8) { const v4u w = *(const GAS v4u*)(vg + t * vs); sr.rv[0] = w.x; sr.rv[1] = w.y; sr.rv[2] = w.z; sr.rv[3] = w.w; }
            if constexpr (NV == 16) { const v4u w = *(const GAS v4u*)(vg + t * vs), w2 = *(const GAS v4u*)(vg + t * vs + 8); sr.rv[0] = w.x; sr.rv[1] = w.y; sr.rv[2] = w.z; sr.rv[3] = w.w; sr.rv[4] = w2.x; sr.rv[5] = w2.y; sr.rv[6] = w2.z; sr.rv[7] = w2.w; }
            if constexpr (HASB) { sr.rb0 = bg[t * SFW]; sr.rb1 = bg[t * SFW + 4]; sr.rb2 = bg[t * SFW + 8]; }
        }
    };
    auto stage_write = [&](SR& sr, int b) {
        LAS float* base = wl + b * BUF;
#pragma unroll
        for (int i = 0; i < QP / 8; ++i) {
            LAS float* qd = base + OQ + stok * DK + spart * QP + i * 8;
            *(LAS f32x4*)qd = (f32x4){bflo(sr.rq[i].x), bfhi(sr.rq[i].x), bflo(sr.rq[i].y), bfhi(sr.rq[i].y)}; *(LAS f32x4*)(qd + 4) = (f32x4){bflo(sr.rq[i].z), bfhi(sr.rq[i].z), bflo(sr.rq[i].w), bfhi(sr.rq[i].w)};
            if constexpr (GK) { LAS float* kd = base + OK_ + stok * DK + spart * QP + i * 8;
                *(LAS f32x4*)kd = (f32x4){bflo(sr.rk[i].x), bfhi(sr.rk[i].x), bflo(sr.rk[i].y), bfhi(sr.rk[i].y)}; *(LAS f32x4*)(kd + 4) = (f32x4){bflo(sr.rk[i].z), bfhi(sr.rk[i].z), bflo(sr.rk[i].w), bfhi(sr.rk[i].w)}; }
        }
        if constexpr (HASF) {
#pragma unroll
            for (int i = 0; i < QP / 4; ++i) { *(LAS f32x4*)(base + OF + stok * DK + spart * QP + i * 4) = sr.rf[i];
                if constexpr (KIND == 2) *(LAS f32x4*)(base + OK_ + stok * DK + spart * QP + i * 4) = 1.0f - sr.rf[i]; } }
        if (lane < 16) {
#pragma unroll
            for (int i = 0; i < NV / 2; ++i) { base[OV + lane * NV + 2 * i] = bflo(sr.rv[i]); base[OV + lane * NV + 2 * i + 1] = bfhi(sr.rv[i]); }
            if constexpr (HASB) *(LAS f32x4*)(base + OB + lane * 4) = (f32x4){sr.rb0, sr.rb1, sr.rb2, 0.f};
        }
    };
    static_assert(2 * BUF * 4 <= 26624, "per-wave LDS");
    const int nch = T / CT;
    struct Opnd { f32x2 q2[DH / 2], k2[DH / 2], f2[DH / 2]; float v; f32x4 bd; };
    auto ldop = [&](Opnd& x, const LAS float* bq, const LAS float* bv, const LAS float* bb, int uu) {
#pragma unroll
        for (int i = 0; i < DH / 4; ++i) { const f32x4 w = *(const LAS f32x4*)(bq + OQ + uu * DK + 4 * i); x.q2[2 * i] = (f32x2){w.x, w.y}; x.q2[2 * i + 1] = (f32x2){w.z, w.w}; }
#pragma unroll
        for (int i = 0; i < DH / 4; ++i) { const f32x4 w = *(const LAS f32x4*)(bq + OK_ + uu * DK + 4 * i); x.k2[2 * i] = (f32x2){w.x, w.y}; x.k2[2 * i + 1] = (f32x2){w.z, w.w}; }
        if constexpr (HASF) {
#pragma unroll
            for (int i = 0; i < DH / 4; ++i) { const f32x4 w = *(const LAS f32x4*)(bq + OF + uu * DK + 4 * i); x.f2[2 * i] = (f32x2){w.x, w.y}; x.f2[2 * i + 1] = (f32x2){w.z, w.w}; } }
        x.v = bv[uu * NV];
        if constexpr (HASB) x.bd = *(const LAS f32x4*)(bb + uu * 4);
    };
    auto compute = [&](int c, const LAS float* base) {
#pragma unroll 1
        for (int ub = 0; ub < CT; ub += UNR) {
        float okeep[R];
#pragma unroll
        for (int vv = 0; vv < R; ++vv) okeep[vv] = 0.f;
        Opnd X; X.bd = (f32x4){0.f, 0.f, 0.f, 0.f};
#pragma unroll
        for (int i = 0; i < DH / 2; ++i) X.f2[i] = (f32x2){0.f, 0.f};
        const LAS float* bq = base + ub * DK + d0; const LAS float* bv = base + OV + ub * NV + rw; const LAS float* bb = base + OB + ub * 4;
        ldop(X, bq, bv, bb, 0);
#pragma unroll
        for (int uu_ = 0; uu_ < UNR; ++uu_) { const int u = ub + uu_;
            Opnd Y = X;
            if (uu_ + 1 < UNR) ldop(Y, bq, bv, bb, uu_ + 1);
            f32x2 (&q2)[DH / 2] = X.q2; f32x2 (&k2)[DH / 2] = X.k2; f32x2 (&f2)[DH / 2] = X.f2; const float vv_ = X.v; const f32x4 bd = X.bd;
            float o[1];
            if constexpr (KIND == 3) {
                f32x2 a = k2[0] * S2[0], bq_ = q2[0] * S2[0];
#pragma unroll
                for (int i = 1; i < DH / 2; ++i) { a = __builtin_elementwise_fma(k2[i], S2[i], a); bq_ = __builtin_elementwise_fma(q2[i], S2[i], bq_); }
                const float ks_ = row8_sum(a.x + a.y) * bd.y, qs_ = row8_sum(bq_.x + bq_.y) * bd.y;
                const float uu = bd.x * (vv_ - ks_);
                o[0] = __builtin_fmaf(bd.z, uu, qs_);
                const f32x2 de2 = (f32x2){bd.y, bd.y}, uu2 = (f32x2){uu, uu};
#pragma unroll
                for (int i = 0; i < DH / 2; ++i) S2[i] = __builtin_elementwise_fma(S2[i], de2, k2[i] * uu2);
            } else {
                const f32x2 v2 = (f32x2){vv_, vv_};
#pragma unroll
                for (int i = 0; i < DH / 2; ++i) {
                    f32x2 dec2;
                    if constexpr (KIND == 0) dec2 = (f32x2){rdec, rdec}; else dec2 = f2[i];
                    S2[i] = __builtin_elementwise_fma(S2[i], dec2, k2[i] * v2);
                }
            }
            if constexpr (KIND != 3)
            { f32x2 a = q2[0] * S2[0];
#pragma unroll
              for (int i = 1; i < DH / 2; ++i) a = __builtin_elementwise_fma(q2[i], S2[i], a);
              o[0] = row8_sum(a.x + a.y); }
#pragma unroll
            for (int vv = 0; vv < R; ++vv) okeep[vv] = (dl == uu_) ? o[vv] : okeep[vv];
            X = Y;
        }
        {
            GAS bf16* o_ = op + (size_t)(c * CT + ub + dl) * D;
            if constexpr (R == 1) *o_ = (bf16)(pk2(okeep[0], 0.f) & 0xffffu);
            if constexpr (R == 2) *(GAS unsigned*)o_ = pk2(okeep[0], okeep[1]);
            if constexpr (R == 4) *(GAS v2u*)o_ = (v2u){pk2(okeep[0], okeep[1]), pk2(okeep[2], okeep[3])};
        }
        }
    };
    stage_load(s0, 0); stage_write(s0, 0);
#pragma unroll 1
    for (int c = 0; c < nch; c += 2) {
        stage_load(s0, min(c + 1, nch - 1));
        compute(c, wl);
        stage_write(s0, 1);
        stage_load(s0, min(c + 2, nch - 1));
        compute(c + 1, wl + BUF);
        stage_write(s0, 0);
    }
    const int v0 = slice * NV + rw * R;
#pragma unroll
    for (int i = 0; i < DH / 2; ++i) { sout[(size_t)(d0 + 2 * i) * 64 + v0] = S2[i].x; sout[(size_t)(d0 + 2 * i + 1) * 64 + v0] = S2[i].y; }
}

__device__ __forceinline__ void scan_phase(const Args& args, LAS unsigned char* lds_, int l, int mode = 0) {
    const Ctx C = make_ctx(args, lds_);
    constexpr int NLONG = 1024, NSHORT = BS * 144;
    const int slot = C.wave * 256 + (int)blockIdx.x;
    const int nidle = C.NGW - NLONG - 256;
    for (int it = 0;; ++it) {
        int kind, b, h, slice, row0, T; bool isp;
        if (slot < NLONG) { if (it > 0 || mode == 2) break; isp = true; T = TP;
            const int kk_ = slot >> 8, i = slot & 255; kind = kk_ == 0 ? 3 : (kk_ == 1 ? 0 : (kk_ == 2 ? 2 : 1));
            { const int stream = (i & 7) | ((i >> 6) << 3); slice = (i >> 3) & 7; b = stream >> 2; h = stream & 3; }
            row0 = b * TP;
        } else { if (C.wave < 5) break;
            const int st = (slot - NLONG - 256) + it * nidle; if (st >= NSHORT || mode == 1) break; isp = false; T = TS;
            b = st / 144; int i = st - b * 144;
            if (i < 64) { kind = 3; h = i >> 4; slice = i & 15; }
            else if (i < 96) { i -= 64; kind = 0; h = i >> 3; slice = i & 7; }
            else if (i < 128) { i -= 96; kind = 2; h = i >> 3; slice = i & 7; }
            else { i -= 128; kind = 1; h = i >> 2; slice = i & 3; }
            row0 = MP + b * TS;
        }
        const int nbat = isp ? BP : BS;
        const size_t sidx = (size_t)((l * nbat + b) * 4 + h);
        if (isp) {
            LAS float* wl = (LAS float*)(C.lds + C.wave * 26624);
            if (kind == 0) scan_long<0, 8, 1>(C, wl, row0, T, h, slice, C.out + O_PRET + sidx * 4096);
            else if (kind == 1) scan_long<1, 4, 1>(C, wl, row0, T, h, slice, C.out + O_PGLA + sidx * 2048);
            else if (kind == 2) scan_long<2, 8, 1>(C, wl, row0, T, h, slice, C.out + O_PHG + sidx * 4096);
            else scan_long<3, 8, 1>(C, wl, row0, T, h, slice, C.out + O_PGDN + sidx * 4096);
        } else {
            if (kind == 0) { scan_task<0, 4, 2>(C, row0, T, h, slice, args.in[2] + sidx * 4096, C.out + O_SRET + sidx * 4096); }
            else if (kind == 1) { scan_task<1, 2, 4>(C, row0, T, h, slice, args.in[3] + sidx * 2048, C.out + O_SGLA + sidx * 2048); }
            else if (kind == 2) { scan_task<2, 4, 2>(C, row0, T, h, slice, args.in[4] + sidx * 4096, C.out + O_SHG + sidx * 4096); }
            else { scan_task<3, 4, 1>(C, row0, T, h, slice, args.in[5] + sidx * 4096, C.out + O_SGDN + sidx * 4096); }
        }
    }
    if (l == 0 && C.wave >= 5 && mode != 1) {
        LAS float* scr = (LAS float*)(C.lds + 4 * 26624 + (C.wave - 5) * 8704);
        constexpr int I_F0 = I_WI + I_WO, I_L0B = I_F0 + I_WOUT;
        for (int it = (C.wave - 5) * 256 + (int)blockIdx.x; it < I_L0B + I_MAIN; it += 768) {
            if (it < I_F0) convert_item(args, C.ws, 0, I_F0 + it, scr, C.lane);
            else if (it < I_L0B) convert_item(args, C.ws, 0, 2 * I_F0 + I_WIN + (it - I_F0), scr, C.lane);
            else convert_item(args, C.ws, 1, it - I_L0B, scr, C.lane);
        }
    }
}

__device__ __forceinline__ void post_phase(const Args& args, LAS unsigned char* lds_, int l) {
    const Ctx C = make_ctx(args, lds_);
    const bf16* PROJ = (const bf16*)(C.ws + WS_BIG); bf16* H = (bf16*)(C.ws + WS_H);
    const int lane = C.lane, mixer = lane >> 4, cc = (lane & 15) * 16;
    const int gbase = mixer == 0 ? C_RG : mixer == 1 ? C_AG : mixer == 2 ? C_HG : C_DG;
    const float* nw = mixer == 1 ? args.in[24] + l * 64 : mixer == 2 ? args.in[25] + l * 64 : args.in[26] + l * 64;
    float w[16];
#pragma unroll
    for (int i = 0; i < 16; ++i) w[i] = mixer == 0 ? 1.0f : nw[(cc + i) & 63];
    v4u na0, na1, ng0, ng1;
    if (C.gw < M) { const bf16* hp = H + (size_t)C.gw * D + lane * 16; const bf16* gp = PROJ + (size_t)C.gw * NINP + gbase + cc;
        na0 = *(const v4u*)hp; na1 = *(const v4u*)(hp + 8); ng0 = *(const v4u*)gp; ng1 = *(const v4u*)(gp + 8); }
#pragma unroll 1
    for (int r = C.gw; r < M; r += C.NGW) {
        bf16* hp = H + (size_t)r * D + lane * 16; const bf16* gp = PROJ + (size_t)r * NINP + gbase + cc;
        const v4u a0 = na0, a1 = na1, g0 = ng0, g1 = ng1;
        if (r + C.NGW < M) { const bf16* hn = hp + (size_t)C.NGW * D; const bf16* gn = gp + (size_t)C.NGW * NINP;
            na0 = *(const v4u*)hn; na1 = *(const v4u*)(hn + 8); ng0 = *(const v4u*)gn; ng1 = *(const v4u*)(gn + 8); }
        float y[16], g[16];
        const unsigned aw[8] = {a0.x, a0.y, a0.z, a0.w, a1.x, a1.y, a1.z, a1.w}, gw_[8] = {g0.x, g0.y, g0.z, g0.w, g1.x, g1.y, g1.z, g1.w};
        float ss = 0.f;
#pragma unroll
        for (int i = 0; i < 8; ++i) { y[2 * i] = bflo(aw[i]); y[2 * i + 1] = bfhi(aw[i]); g[2 * i] = bflo(gw_[i]); g[2 * i + 1] = bfhi(gw_[i]); ss += y[2 * i] * y[2 * i] + y[2 * i + 1] * y[2 * i + 1]; }
        ss = quad_sum(ss);
        const float rs = rsqrtf(ss * (1.0f / 64.0f) + RMS_EPS);
        unsigned ow[8];
#pragma unroll
        for (int i = 0; i < 8; ++i) ow[i] = pk2(y[2 * i] * rs * w[2 * i] * siluf_(g[2 * i]), y[2 * i + 1] * rs * w[2 * i + 1] * siluf_(g[2 * i + 1]));
        *(v4u*)hp = (v4u){ow[0], ow[1], ow[2], ow[3]}; *(v4u*)(hp + 8) = (v4u){ow[4], ow[5], ow[6], ow[7]};
    }
}

__global__ void __launch_bounds__(NWAVES * 64, 2) mega_fwd(Args args) {
    extern __shared__ __attribute__((aligned(16))) unsigned char lds[];
    cg::grid_group grid = cg::this_grid();
    LAS unsigned char* const LDSP = (LAS unsigned char*)lds;
    const int G = (int)gridDim.x, bx = (int)blockIdx.x;
    if (threadIdx.x < 64) ((LAS unsigned*)(LDSP + MISC_OFF))[threadIdx.x] = 0u;
    __syncthreads();
    (void)xcd_barrier_post((unsigned*)args.ws, (volatile LAS unsigned*)(LDSP + MISC_OFF));
#define FRESH() float* out_ = fresh_ptr(args.out); unsigned char* ws = fresh_ptr(args.ws); \
    float* MOD = (float*)(ws + WS_MOD); bf16* H = (bf16*)(ws + WS_H); bf16* BIG = (bf16*)(ws + WS_BIG); (void)MOD; (void)H; (void)BIG; (void)out_;

    p0_prologue(args, LDSP);
    if (args.ws == nullptr) grid.sync();
    grid_bar(args, LDSP);
    {
        FRESH();
        pg8::Gemm g{(const bf16*)(ws + WS_AC), BIG, 256, 2 * NMODC, D}; pg8::StaticOrder S; S.init(256, 2 * NMODC, G, bx, D);
        pg8::EpiMod E{MOD, args.in[10]};
        pg8::gemm_phase<pg8::EpiMod, pg8::StaticOrder, PG8_ALIGN, PG8_SP2>(LDSP, g, S, E);
    }
    p1_convert(args, LDSP);
    grid_bar(args, LDSP);
    p2_modulate0(args, LDSP);
    grid_bar(args, LDSP);
#pragma unroll 1
    for (int l = 0; l < 2; ++l) {
#pragma unroll 1
        for (int f = 0; f < 2; ++f) {
            if (f == 1) {
                {
                    FRESH();
                    pg8::Gemm g{H, (const bf16*)(ws + WS_W + (size_t)l * W_LAYER + W_WIN), M, NINP, D}; pg8::StaticOrder S; S.init(M, NINP, G, bx, D);
                    pg8::EpiPlain E{BIG, NINP};
                    pg8::gemm_phase<pg8::EpiPlain, pg8::StaticOrder, PG8_ALIGN, PG8_SP2>(LDSP, g, S, E);
                }
                grid_bar(args, LDSP);
                prep_phase(args, LDSP, l);
                grid_bar(args, LDSP);
                scan_phase(args, LDSP, l);
#ifdef PROBE_SCANMODE
                grid_bar(args, LDSP); scan_phase(args, LDSP, l, PROBE_SCANMODE);
#endif
                grid_bar(args, LDSP);
                post_phase(args, LDSP, l);
                grid_bar(args, LDSP);
                {
                    FRESH();
                    pg8::Gemm g{H, (const bf16*)(ws + WS_W + (size_t)l * W_LAYER + W_WOUT), M, D, D}; pg8::SplitOrder S; S.init(D, G, bx);
                    pg8::EpiRes E{out_, (float*)(ws + WS_SB), MOD + (size_t)l * NB * NMODC + 5 * 1024, (const float*)(ws + WS_STATS), args.in[11] + (size_t)(l * 3) * D, args.in[12] + (size_t)(l * 3) * D, 1.0f, D / 64};
                    pg8::gemm_phase<pg8::EpiRes, pg8::SplitOrder, PG8_ALIGN, PG8_SP2>(LDSP, g, S, E);
                }
                grid_bar(args, LDSP);
                ln_phase(args, LDSP, l, 1, true, l, 6, 4, ALPHA, false);
                grid_bar(args, LDSP);
            }
            {
                FRESH();
                pg8::Gemm g{H, (const bf16*)(ws + WS_W + (size_t)l * W_LAYER + (f ? W_WI2 : W_WI1)), M, NWI, D}; pg8::StaticOrder S; S.init(M, NWI, G, bx, D);
                pg8::EpiSwiglu E{BIG, DFF};
                pg8::gemm_phase<pg8::EpiSwiglu, pg8::StaticOrder, PG8_ALIGN, PG8_SP2>(LDSP, g, S, E);
            }
            grid_bar(args, LDSP);
            {
                FRESH();
                pg8::Gemm g{BIG, (const bf16*)(ws + WS_W + (size_t)l * W_LAYER + (f ? W_WO2 : W_WO1)), M, D, DFF}; pg8::SplitOrder S; S.init(DFF, G, bx);
                const bool first = (l == 0 && f == 0); const int pinst = f ? l * 3 + 1 : l * 3 - 1;
                pg8::EpiRes E{out_, (float*)(ws + WS_SB), MOD + (size_t)l * NB * NMODC + (f ? 8 : 2) * 1024, (const float*)(ws + WS_STATS),
                              first ? (const float*)(ws + WS_ID) : args.in[11] + (size_t)pinst * D, first ? (const float*)(ws + WS_ID) + 1024 : args.in[12] + (size_t)pinst * D, 0.5f, DFF / 64};
                pg8::gemm_phase<pg8::EpiRes, pg8::SplitOrder, PG8_ALIGN, PG8_SP2>(LDSP, g, S, E);
            }
            grid_bar(args, LDSP);
            if (f == 0) ln_phase(args, LDSP, l, 0, true, l, 3, 11, ALPHA, false);
            else ln_phase(args, LDSP, l, 2, l == 0, 1, 0, 11, l == 0 ? ALPHA : 1.0f, l == 1);
            if (!(l == 1 && f == 1)) grid_bar(args, LDSP);
        }
    }
}

extern "C" void kernel_launch(void* const* d_in, const int* in_sizes, int n_in, void* d_out, int out_size, void* d_ws, size_t ws_size, hipStream_t stream) {
    static int grid = 0;
    if (grid == 0) {
        if (n_in != 28 || (size_t)out_size != O_END || ws_size < WS_END) { fprintf(stderr, "kernel_launch: unexpected sizes n_in %d out %d ws %zu (need %zu)\n", n_in, out_size, ws_size, (size_t)WS_END); grid = -1; return; }
        int dev = 0, cus = 0, per_cu = 0;
        hipGetDevice(&dev); hipDeviceGetAttribute(&cus, hipDeviceAttributeMultiprocessorCount, dev);
        hipFuncSetAttribute((const void*)mega_fwd, hipFuncAttributeMaxDynamicSharedMemorySize, LDS_BYTES);
        hipOccupancyMaxActiveBlocksPerMultiprocessor(&per_cu, (const void*)mega_fwd, NWAVES * 64, LDS_BYTES);
        (void)hipGetLastError();
        if (per_cu < 1 || cus < 256) { fprintf(stderr, "kernel_launch: occupancy %d cus %d\n", per_cu, cus); grid = -1; return; }
        grid = 256;
    }
    if (grid < 0) return;
    if (hipMemsetAsync(d_ws, 0, 65536, stream) != hipSuccess) { fprintf(stderr, "memset failed\n"); return; }
    Args a{};
    for (int i = 0; i < 28; ++i) a.in[i] = (const float*)d_in[i];
    a.out = (float*)d_out; a.ws = (unsigned char*)d_ws;
    void* kargs[] = {&a};
    hipError_t e = hipLaunchCooperativeKernel((const void*)mega_fwd, dim3(grid), dim3(NWAVES * 64), kargs, LDS_BYTES, stream);
    if (e != hipSuccess) fprintf(stderr, "cooperative launch failed: %s\n", hipGetErrorString(e));
}
```

```cpp
#include <hip/hip_runtime.h>
#include <hip/hip_cooperative_groups.h>
#include <cstdio>
#include <cstdint>
namespace cg = cooperative_groups;
namespace pg8 {
#define PG8_LAS __attribute__((address_space(3)))
typedef unsigned short bf16_t;
typedef short bf16x8 __attribute__((ext_vector_type(8)));
typedef float f32x4 __attribute__((ext_vector_type(4)));
typedef unsigned u32x4 __attribute__((ext_vector_type(4)));
constexpr int BM = 256, BK = 64, HALF = 128, HTB = HALF * BK * 2  , STAGE_BYTES = 8 * HTB, NXCD = 8, WGM = 8;

__host__ __device__ __forceinline__ int lds_byte(int r, int c) { const int st = (r >> 4) * 2 + (c >> 5), rr = r & 15, cc = c & 31, ob = rr * 64 + cc * 2; return st * 1024 + (ob ^ (((ob >> 9) & 1) << 5)); }
__host__ __device__ __forceinline__ void stage_rc(int b, int& R, int& C) { const int st = b / 1024, sb = b % 1024, swz = sb ^ (((sb >> 9) & 1) << 5); R = (st >> 1) * 16 + swz / 64; C = (st & 1) * 32 + (swz % 64) / 2; }
__host__ __device__ __forceinline__ int perm32(int rho) { const int n = rho >> 4, i = rho & 15; return 8 * (i >> 2) + 4 * n + (i & 3); }

struct Unit { int pm, pn, k0, nt; };
struct Gemm { const bf16_t* A; const bf16_t* Bt; int M, N, K; };

struct StaticOrder {
    int nM, nN, nwg, G, c, ntf;
    __host__ __device__ void init(int M, int N, int G_, int c_, int K_ = 1024) { nM = M / BM; nN = N / BM; nwg = nM * nN; G = G_; c = c_; ntf = K_ / BK; }
    __host__ __device__ bool next(int i, Unit& u) const {
        const long L = (long)i * G + c; if (L >= nwg) return false;
        int wgid = (int)L; { const int q = nwg / NXCD, r = nwg % NXCD, xcd = wgid % NXCD, off = wgid / NXCD; wgid = (xcd < r ? xcd * (q + 1) : r * (q + 1) + (xcd - r) * q) + off; }
        const int nig = WGM * nN, gid = wgid / nig, fm = gid * WGM, gsz = (nM - fm) < WGM ? (nM - fm) : WGM;
        u.pm = fm + ((wgid % nig) % gsz); u.pn = (wgid % nig) / gsz; u.k0 = 0; u.nt = ntf; return true;
    }
    __device__ __forceinline__ void a_ready(const Unit&) const {}
    __device__ __forceinline__ void done(const Unit&) const {}
};

struct SplitOrder {
    StaticOrder base; int ppu, c;
    static constexpr int PK = 4;
    __host__ __device__ void init(int K_, int G_, int c_) { base.init(16384, 1024, G_, c_, K_); ppu = (K_ / BK) / PK; c = c_; }
    __host__ __device__ bool next(int i, Unit& u) const {
        if (i == 0) return base.next(0, u);
        if (i == 1 && c < 8 * ppu) { const int j = c / ppu, p = c - j * ppu; u.pm = 64 + (j >> 2); u.pn = j & 3; u.k0 = p * PK; u.nt = PK; return true; }
        return false;
    }
    __device__ __forceinline__ void a_ready(const Unit&) const {}
    __device__ __forceinline__ void done(const Unit&) const {}
};

__device__ __forceinline__ unsigned cvt_pk_bf16(float lo, float hi) { unsigned r; asm volatile("v_cvt_pk_bf16_f32 %0, %1, %2" : "=v"(r) : "v"(lo), "v"(hi)); return r; }
typedef float f32x2 __attribute__((ext_vector_type(2)));
__device__ __forceinline__ f32x2 gelu_pk(f32x2 v) {
    const f32x2 av = __builtin_elementwise_abs(v), d = av * 0.2316418882f + 1.0f;
    f32x2 t; t.x = __builtin_amdgcn_rcpf(d.x); t.y = __builtin_amdgcn_rcpf(d.y);
    f32x2 q = t * 0.5307027145f + (-0.7265760135f); q = q * t + 0.7107068705f; q = q * t + (-0.142248368f); q = q * t + 0.127414796f; q = q * t;
    const f32x2 s = (v * v) * (-0.72134752044f);
    f32x2 e; e.x = __builtin_amdgcn_exp2f(s.x); e.y = __builtin_amdgcn_exp2f(s.y);
    const f32x2 m = v * (q * e), r = v - m;
    f32x2 o; o.x = v.x < 0.f ? m.x : r.x; o.y = v.y < 0.f ? m.y : r.y; return o;
}

template <int ACT  > struct EpiBf16 {
    static constexpr bool PERM = true, AFTER_DRAIN = false; static_assert(ACT == 0 || ACT == 1, "EpiBf16: ACT is 0 (none) or 1 (gelu_pk)");
    bf16_t* O; int ldc; const float* bias; int split_cols; size_t split_stride; float scale0;
    __device__ __forceinline__ void operator()(const f32x4 (&acc)[2][2][4][2], const Unit& u, int wr, int wc, int fr, int fq) const {
        const int row0 = u.pm * BM + wr * 64 + fr; int colt = u.pn * BM; bf16_t* base = O;
        float sc = 1.f; if (split_cols) { const int t = colt / split_cols; base += (size_t)t * split_stride; colt -= t * split_cols; if (t == 0) sc = scale0; }
        const int col0 = colt + wc * 32 + 8 * fq, bcol0 = u.pn * BM + wc * 32 + 8 * fq;
        f32x4 bv[2][2];
#pragma unroll
        for (int bj = 0; bj < 2; ++bj)
#pragma unroll
            for (int n = 0; n < 2; ++n) bv[bj][n] = bias ? *(const f32x4*)(bias + bcol0 + bj * HALF + 4 * n) : (f32x4){0.f, 0.f, 0.f, 0.f};
#pragma unroll
        for (int ai = 0; ai < 2; ++ai)
#pragma unroll
            for (int m = 0; m < 4; ++m) { bf16_t* rowp = base + (size_t)(row0 + ai * HALF + m * 16) * ldc + col0;
#pragma unroll
                for (int bj = 0; bj < 2; ++bj) { f32x4 v0 = acc[ai][bj][m][0] + bv[bj][0], v1 = acc[ai][bj][m][1] + bv[bj][1];
                    if (ACT == 1) { f32x2 a = gelu_pk((f32x2){v0[0], v0[1]}), b = gelu_pk((f32x2){v0[2], v0[3]}), c = gelu_pk((f32x2){v1[0], v1[1]}), d = gelu_pk((f32x2){v1[2], v1[3]});
                        v0 = (f32x4){a.x, a.y, b.x, b.y}; v1 = (f32x4){c.x, c.y, d.x, d.y}; }
                    v0 = v0 * sc; v1 = v1 * sc; u32x4 w; w.x = cvt_pk_bf16(v0[0], v0[1]); w.y = cvt_pk_bf16(v0[2], v0[3]); w.z = cvt_pk_bf16(v1[0], v1[1]); w.w = cvt_pk_bf16(v1[2], v1[3]);
                    *(u32x4*)(rowp + bj * HALF) = w; } }
    }
};
template <class Epi, class Sched, bool ALIGN_EPI = false, bool SP2 = false>
__device__ __forceinline__ void gemm_phase(PG8_LAS unsigned char* lds, const Gemm g, const Sched& S, const Epi& E) {
    int tid_ = threadIdx.x; asm volatile("" : "+v"(tid_));
    const int tid = tid_, wid = __builtin_amdgcn_readfirstlane(tid >> 6), lane = tid & 63, wr = wid >> 2, wc = wid & 3, fr = lane & 15, fq = lane >> 4;
    const int K = g.K;
    unsigned voffA[2], voffB[2];
#pragma unroll
    for (int i = 0; i < 2; ++i) { int R, C; stage_rc(tid * 16 + i * 8192, R, C); const int Rb = Epi::PERM ? ((R & ~31) + perm32(R & 31)) : R;
        voffA[i] = (unsigned)(R * K + C) * 2u; voffB[i] = (unsigned)(Rb * K + C) * 2u; }
    const size_t kstep = (size_t)(BK * 2);
    const size_t hstep = (size_t)HALF * K * 2;
    const size_t tstep = 2 * hstep;
    const unsigned ldsw = (unsigned)wid * 1024u;
    const int aoff = lds_byte(wr * 64 + fr, fq * 8), boff = lds_byte(wc * 32 + fr, fq * 8);
#define PG8_SA(b, h) (((b) * 2 + (h)) * HTB)
#define PG8_SB(b, h) ((4 + (b) * 2 + (h)) * HTB)
#define PG8_STAGE(bufoff, gbase, voff) do { _Pragma("unroll") for (int _i = 0; _i < 2; ++_i) \
        __builtin_amdgcn_global_load_lds((const unsigned*)((const char*)(gbase) + (voff)[_i]), (PG8_LAS unsigned*)(lds + (bufoff) + ldsw + _i * 8192), 16, 0, 0); } while (0)
#define PG8_LDA(dst, b, h) do { _Pragma("unroll") for (int m = 0; m < 4; ++m) _Pragma("unroll") for (int k = 0; k < 2; ++k) dst[m][k] = *(const PG8_LAS bf16x8*)(lds + PG8_SA(b, h) + aoff + m * 2048 + k * 1024); } while (0)
#define PG8_LDB(dst, b, h) do { _Pragma("unroll") for (int n = 0; n < 2; ++n) _Pragma("unroll") for (int k = 0; k < 2; ++k) dst[n][k] = *(const PG8_LAS bf16x8*)(lds + PG8_SB(b, h) + boff + n * 2048 + k * 1024); } while (0)
#define PG8_MMA(ai, bj, At, Bt) do { __builtin_amdgcn_s_setprio(1); _Pragma("unroll") for (int m = 0; m < 4; ++m) _Pragma("unroll") for (int n = 0; n < 2; ++n) _Pragma("unroll") for (int k = 0; k < 2; ++k) \
        acc[ai][bj][m][n] = __builtin_amdgcn_mfma_f32_16x16x32_bf16(Bt[n][k], At[m][k], acc[ai][bj][m][n], 0, 0, 0); __builtin_amdgcn_s_setprio(0); } while (0)
#define PG8_WAIT_V(n) asm volatile("s_waitcnt vmcnt(" #n ")" ::: "memory")
#define PG8_WAIT_L(n) asm volatile("s_waitcnt lgkmcnt(" #n ")" ::: "memory")
#define PG8_BAR __builtin_amdgcn_s_barrier()
#define PG8_SCHED __builtin_amdgcn_sched_barrier(0)
    Unit cur, nxt; int ui = 0;
    if (!S.next(0, cur)) return;
    f32x4 acc[2][2][4][2];
#pragma unroll
    for (int a = 0; a < 2; ++a)
#pragma unroll
        for (int b = 0; b < 2; ++b)
#pragma unroll
            for (int m = 0; m < 4; ++m)
#pragma unroll
                for (int n = 0; n < 2; ++n) acc[a][b][m][n] = (f32x4){0.f, 0.f, 0.f, 0.f};
    bf16x8 At[4][2], B0[2][2], B1[2][2];
    const char* cA = (const char*)g.A + (size_t)cur.pm * tstep + (size_t)cur.k0 * kstep; const char* cB = (const char*)g.Bt + (size_t)cur.pn * tstep + (size_t)cur.k0 * kstep;
    S.a_ready(cur);
    if constexpr (SP2) {
        PG8_STAGE(PG8_SB(0, 0), cB, voffB); PG8_STAGE(PG8_SB(0, 1), cB + hstep, voffB); PG8_STAGE(PG8_SA(0, 0), cA, voffA); PG8_STAGE(PG8_SA(0, 1), cA + hstep, voffA);
        if (wr == 1) PG8_BAR;
        PG8_WAIT_V(2); PG8_BAR;
        PG8_STAGE(PG8_SB(1, 0), cB + kstep, voffB); PG8_STAGE(PG8_SA(1, 0), cA + kstep, voffA); PG8_STAGE(PG8_SB(1, 1), cB + hstep + kstep, voffB);
        PG8_WAIT_V(6); PG8_BAR;
    } else {
        PG8_STAGE(PG8_SB(0, 0), cB, voffB); PG8_STAGE(PG8_SA(0, 0), cA, voffA); PG8_STAGE(PG8_SB(0, 1), cB + hstep, voffB); PG8_STAGE(PG8_SA(0, 1), cA + hstep, voffA);
        if (wr == 1) PG8_BAR;
        PG8_WAIT_V(4); PG8_BAR;
        PG8_STAGE(PG8_SB(1, 0), cB + kstep, voffB); PG8_STAGE(PG8_SA(1, 0), cA + kstep, voffA); PG8_STAGE(PG8_SB(1, 1), cB + hstep + kstep, voffB);
        PG8_WAIT_V(6); PG8_BAR;
    }
    for (;;) {
        const bool has_next = S.next(ui + 1, nxt);
        const char* nA = has_next ? (const char*)g.A + (size_t)nxt.pm * tstep + (size_t)nxt.k0 * kstep : cA; const char* nB = has_next ? (const char*)g.Bt + (size_t)nxt.pn * tstep + (size_t)nxt.k0 * kstep : cB;
        const int nt = cur.nt;
        for (int t = 0; t < nt; t += 2) {
            const bool last = (t == nt - 2);
            const char* a1 = cA + (size_t)(t + 1) * kstep;
            const char* a2 = last ? nA : cA + (size_t)(t + 2) * kstep; const char* b2 = last ? nB : cB + (size_t)(t + 2) * kstep;
            const char* a3 = a2 + kstep; const char* b3 = b2 + kstep;
            if (last && has_next) S.a_ready(nxt);
            if constexpr (SP2) {
            PG8_LDB(B0, 0, 0); PG8_LDB(B1, 0, 1); PG8_SCHED; PG8_LDA(At, 0, 0); PG8_STAGE(PG8_SA(1, 1), a1 + hstep, voffA);
            PG8_WAIT_V(8); PG8_WAIT_L(0); PG8_BAR; PG8_MMA(0, 0, At, B0); PG8_MMA(0, 1, At, B1); PG8_BAR; PG8_SCHED;
            PG8_LDA(At, 0, 1); PG8_STAGE(PG8_SB(0, 0), b2, voffB); PG8_STAGE(PG8_SB(0, 1), b2 + hstep, voffB); PG8_STAGE(PG8_SA(0, 0), a2, voffA);
            PG8_WAIT_V(8); PG8_WAIT_L(0); PG8_BAR; PG8_MMA(1, 0, At, B0); PG8_MMA(1, 1, At, B1); PG8_BAR; PG8_SCHED;
            PG8_LDB(B0, 1, 0); PG8_LDB(B1, 1, 1); PG8_SCHED; PG8_LDA(At, 1, 0); PG8_STAGE(PG8_SA(0, 1), a2 + hstep, voffA);
            PG8_WAIT_V(8); PG8_WAIT_L(0); PG8_BAR; PG8_MMA(0, 0, At, B0); PG8_MMA(0, 1, At, B1); PG8_BAR; PG8_SCHED;
            PG8_LDA(At, 1, 1); PG8_STAGE(PG8_SB(1, 0), b3, voffB); PG8_STAGE(PG8_SB(1, 1), b3 + hstep, voffB); PG8_STAGE(PG8_SA(1, 0), a3, voffA);
            PG8_WAIT_V(8); PG8_WAIT_L(0); PG8_BAR; PG8_MMA(1, 0, At, B0); PG8_MMA(1, 1, At, B1); PG8_BAR; PG8_SCHED;
            } else {
            PG8_LDB(B0, 0, 0); PG8_SCHED; PG8_LDA(At, 0, 0); PG8_STAGE(PG8_SA(1, 1), a1 + hstep, voffA);
            PG8_WAIT_L(8); PG8_BAR; PG8_WAIT_L(0); PG8_MMA(0, 0, At, B0); PG8_BAR; PG8_SCHED;
            PG8_LDB(B1, 0, 1); PG8_STAGE(PG8_SB(0, 0), b2, voffB);
            PG8_BAR; PG8_WAIT_L(0); PG8_MMA(0, 1, At, B1); PG8_BAR;
            PG8_LDA(At, 0, 1); PG8_STAGE(PG8_SA(0, 0), a2, voffA);
            PG8_BAR; PG8_WAIT_L(0); PG8_MMA(1, 0, At, B0); PG8_BAR; PG8_SCHED;
            PG8_STAGE(PG8_SB(0, 1), b2 + hstep, voffB);
            PG8_WAIT_V(6); PG8_BAR; PG8_MMA(1, 1, At, B1); PG8_BAR;
            PG8_LDB(B0, 1, 0); PG8_SCHED; PG8_LDA(At, 1, 0); PG8_STAGE(PG8_SA(0, 1), a2 + hstep, voffA);
            PG8_WAIT_L(8); PG8_BAR; PG8_WAIT_L(0); PG8_MMA(0, 0, At, B0); PG8_BAR; PG8_SCHED;
            PG8_LDB(B1, 1, 1); PG8_STAGE(PG8_SB(1, 0), b3, voffB);
            PG8_BAR; PG8_WAIT_L(0); PG8_MMA(0, 1, At, B1); PG8_BAR;
            PG8_LDA(At, 1, 1); PG8_STAGE(PG8_SA(1, 0), a3, voffA);
            PG8_BAR; PG8_WAIT_L(0); PG8_MMA(1, 0, At, B0); PG8_BAR; PG8_SCHED;
            PG8_STAGE(PG8_SB(1, 1), b3 + hstep, voffB);
            PG8_WAIT_V(6); PG8_BAR; PG8_MMA(1, 1, At, B1); PG8_BAR;
            }
        }
        if constexpr (ALIGN_EPI) { if (wr == 0) PG8_BAR; }
        if constexpr (!Epi::AFTER_DRAIN) { E(acc, cur, wr, wc, fr, fq); S.done(cur); }
        if (!has_next) break;
#pragma unroll
        for (int a = 0; a < 2; ++a)
#pragma unroll
            for (int b = 0; b < 2; ++b)
#pragma unroll
                for (int m = 0; m < 4; ++m)
#pragma unroll
                    for (int n = 0; n < 2; ++n) acc[a][b][m][n] = (f32x4){0.f, 0.f, 0.f, 0.f};
        cur = nxt; cA = nA; cB = nB; ++ui;
        if constexpr (ALIGN_EPI) { if (wr == 1) PG8_BAR; }
    }
    PG8_WAIT_V(0);
    if constexpr (!ALIGN_EPI) { if (wr == 0) PG8_BAR; }
    PG8_BAR;
    if constexpr (Epi::AFTER_DRAIN) { E.fused(acc, cur, wr, wc, fr, fq, lds, wid, lane); S.done(cur); }
#undef PG8_SA
#undef PG8_SB
#undef PG8_STAGE
#undef PG8_LDA
#undef PG8_LDB
#undef PG8_MMA
#undef PG8_WAIT_V
#undef PG8_WAIT_L
#undef PG8_BAR
#undef PG8_SCHED
}
}
#define PG8_SP2 true
#define PG8_ALIGN true

constexpr int D = 1024, TP = 2048, BP = 8, BS = 128, TS = 4;
constexpr int MP = BP * TP, MS = BS * TS, M = MP + MS;
constexpr int DFF = 2816, NWI = 2 * DFF, NIN = 3864, NINP = 4096, NMODC = 9216, NB = BP + BS;
constexpr int SBW = 1664, SFW = 396;
constexpr float LN_EPS = 1e-5f, RMS_EPS = 1e-6f;
constexpr float ALPHA = 1.41421356237f;
constexpr int C_RQ = 0, C_RK = 256, C_RV = 512, C_RG = 768, C_AQ = 1024, C_AK = 1152, C_AV = 1280, C_ALR = 1536, C_AG = 1552,
              C_HQ = 1808, C_HF = 2064, C_HI = 2320, C_HG = 2576, C_DQKV = 2832, C_DB = 3600, C_DA = 3604, C_DG = 3608;
constexpr int SB_RQ = 0, SB_RK = 256, SB_AQ = 512, SB_HQ = 640, SB_DQ = 896, SB_DK = 1152, SB_DV = 1408;
constexpr int SF_ADEC = 0, SF_HF = 128, SF_BETA = 384, SF_DDEC = 388, SF_QK = 392;
constexpr size_t O_Y = 0;
constexpr size_t O_PRET = (size_t)M * D;
constexpr size_t O_PGLA = O_PRET + 2ull * BP * 4 * 64 * 64;
constexpr size_t O_PHG = O_PGLA + 2ull * BP * 4 * 32 * 64;
constexpr size_t O_PGDN = O_PHG + 2ull * BP * 4 * 64 * 64;
constexpr size_t O_PCONV = O_PGDN + 2ull * BP * 4 * 64 * 64;
constexpr size_t O_SRET = O_PCONV + 2ull * BP * 3 * 768;
constexpr size_t O_SGLA = O_SRET + 2ull * BS * 4 * 64 * 64;
constexpr size_t O_SHG = O_SGLA + 2ull * BS * 4 * 32 * 64;
constexpr size_t O_SGDN = O_SHG + 2ull * BS * 4 * 64 * 64;
constexpr size_t O_SCONV = O_SGDN + 2ull * BS * 4 * 64 * 64;
constexpr size_t O_END = O_SCONV + 2ull * BS * 3 * 768;

constexpr size_t MiB = 1u << 20;
constexpr size_t WS_ROPE = 1 * MiB;
constexpr size_t WS_AC = 2 * MiB;
constexpr size_t WS_MOD = 3 * MiB;
constexpr size_t WS_STATS = 2 * MiB + 512 * 1024;
constexpr size_t WS_ID = 2 * MiB + 768 * 1024;
constexpr size_t WS_W = 13 * MiB;
constexpr size_t W_WI1 = 0, W_WO1 = 11 * MiB, W_WI2 = W_WO1 + 5 * MiB + MiB / 2, W_WO2 = W_WI2 + 11 * MiB, W_WIN = W_WO2 + 5 * MiB + MiB / 2, W_WOUT = W_WIN + 8 * MiB, W_LAYER = 43 * MiB;
constexpr size_t WS_H = WS_W + 2 * W_LAYER;
constexpr size_t WS_BIG = WS_H + 33 * MiB;
constexpr size_t WS_SB = WS_BIG + 132 * MiB;
constexpr size_t WS_SF = WS_SB + 54 * MiB;
constexpr size_t WS_END = WS_SF + 26 * MiB;
static_assert((size_t)M * SBW * 2 <= 54 * MiB && (size_t)M * SFW * 4 <= 26 * MiB && (size_t)M * 4096 * 2 <= 132 * MiB && (size_t)M * D * 2 <= 33 * MiB, "ws map");

constexpr int LDS_BYTES = 147456;
constexpr int NWAVES = 8;

#define GAS __attribute__((address_space(1)))
#define LAS __attribute__((address_space(3)))
typedef unsigned short bf16;
typedef unsigned v4u __attribute__((ext_vector_type(4)));
typedef unsigned v2u __attribute__((ext_vector_type(2)));
typedef float f32x4 __attribute__((ext_vector_type(4)));
typedef float f32x2 __attribute__((ext_vector_type(2)));
#define LDS_WAIT() asm volatile("s_waitcnt lgkmcnt(0)" ::: "memory")

__device__ __forceinline__ float bf2f(unsigned b) { return __uint_as_float(b << 16); }
__device__ __forceinline__ float bflo(unsigned w) { return __uint_as_float(w << 16); }
__device__ __forceinline__ float bfhi(unsigned w) { return __uint_as_float(w & 0xffff0000u); }
__device__ __forceinline__ unsigned pk2(float lo, float hi) { return pg8::cvt_pk_bf16(lo, hi); }
__device__ __forceinline__ float sigmoidf_(float x) { return __builtin_amdgcn_rcpf(1.0f + __expf(-x)); }
__device__ __forceinline__ float siluf_(float x) { return x * __builtin_amdgcn_rcpf(1.0f + __expf(-x)); }
__device__ __forceinline__ float wave_sum(float v) {
#pragma unroll
    for (int o = 1; o < 64; o <<= 1) v += __shfl_xor(v, o);
    return v;
}
template <int CTRL> __device__ __forceinline__ float dppmov(float v) { return __int_as_float(__builtin_amdgcn_update_dpp(0, __float_as_int(v), CTRL, 0xf, 0xf, true)); }
__device__ __forceinline__ float quad_sum(float v) { v += dppmov<0xB1>(v); v += dppmov<0x4E>(v); return v; }
__device__ __forceinline__ float row8_sum(float v) { v += dppmov<0xB1>(v); v += dppmov<0x4E>(v); v += dppmov<0x141>(v); return v; }
__device__ __forceinline__ float row16_sum(float v) { v += dppmov<0xB1>(v); v += dppmov<0x4E>(v); v += dppmov<0x141>(v); v += dppmov<0x140>(v); return v; }

struct Args { const float* in[28]; float* out; unsigned char* ws; };

struct Ctx {
    int tid, lane, wave, gw, NGW;
    LAS unsigned char* lds;
    float* out; unsigned char* ws;
};
template <class T> __device__ __forceinline__ T* fresh_ptr(T* p) {
    unsigned lo = (unsigned)(uintptr_t)p, hi = (unsigned)((uintptr_t)p >> 32);
    asm volatile("" : "+v"(lo), "+v"(hi));
    lo = __builtin_amdgcn_readfirstlane(lo); hi = __builtin_amdgcn_readfirstlane(hi);
    return (T*)(__attribute__((address_space(1))) T*)(((uintptr_t)hi << 32) | (uintptr_t)lo);
}
__device__ __forceinline__ Ctx make_ctx(const Args& args, LAS unsigned char* lds) {
    Ctx C; int t = threadIdx.x; asm volatile("" : "+v"(t));
    C.tid = t; C.lane = t & 63; C.wave = __builtin_amdgcn_readfirstlane(t >> 6);
    C.gw = (int)blockIdx.x * NWAVES + C.wave; C.NGW = (int)gridDim.x * NWAVES;
    float* op = fresh_ptr(args.out); unsigned char* wp = fresh_ptr(args.ws);
    C.lds = lds; C.out = op; C.ws = wp; return C;
}
__device__ __forceinline__ int batch_of_row(int r) { return r < MP ? (r >> 11) : BP + ((r - MP) >> 2); }


typedef GAS unsigned gu32;
#define RLX_AGENT __ATOMIC_RELAXED, __HIP_MEMORY_SCOPE_AGENT
#define XB_TMO      128
#define XB_XCNT(j)  (256  + 64 * (j))
#define XB_XSUB(j)  (1280 + 64 * (j))
#define XB_XGEN(j)  (2304 + 64 * (j))
#define XB_TOP      3328
#define XB_TOPGEN   3392
#define XCD_BAR_WORDS 3456
#define XB_SPIN_CAP (1u << 18)

__device__ __forceinline__ unsigned xb_ld(unsigned* p)              { return __hip_atomic_load(p, __ATOMIC_RELAXED, __HIP_MEMORY_SCOPE_AGENT); }
__device__ __forceinline__ unsigned xb_add(unsigned* p, unsigned v) { return __hip_atomic_fetch_add(p, v, __ATOMIC_RELAXED, __HIP_MEMORY_SCOPE_AGENT); }
__device__ __forceinline__ unsigned xb_xcc_id() { return (unsigned)__builtin_amdgcn_s_getreg((3 << 11) | 20) & 0xFu; }
#define XB_SPIN(cond, bar) do { unsigned _sp = 0; while (cond) { __builtin_amdgcn_s_sleep(1); \
    if ((++_sp & 255u) == 0u) { if (xb_ld(&(bar)[XB_TMO])) break; if (_sp > XB_SPIN_CAP) { atomicAdd(&(bar)[XB_TMO], 1u); break; } } } } while (0)

struct XcdBarrier {
    unsigned* bar; unsigned x;
    volatile LAS unsigned* st;
};

__device__ __forceinline__ XcdBarrier xcd_barrier_post(unsigned* bar, volatile LAS unsigned* st) {
    XcdBarrier b; b.bar = bar; b.x = xb_xcc_id(); b.st = st;
    if (threadIdx.x == 0) (void)xb_add(&bar[XB_XCNT(b.x)], 1u);
    return b;
}
__device__ __forceinline__ void xcd_barrier_complete(unsigned* bar, unsigned x, unsigned& nloc, unsigned& nx) {
    const unsigned G = gridDim.x * gridDim.y * gridDim.z;
    unsigned sum, cnt, mine, sp = 0u;
    for (;;) {
        sum = 0u; cnt = 0u; mine = 0u;
#pragma unroll
        for (unsigned j = 0; j < 16; ++j) { const unsigned c = xb_ld(&bar[XB_XCNT(j)]); sum += c; cnt += (c > 0u) ? 1u : 0u; mine = (j == x) ? c : mine; }
        if (sum == G) break;
        __builtin_amdgcn_s_sleep(1);
        if ((++sp & 255u) == 0u) { if (xb_ld(&bar[XB_TMO])) break; if (sp > XB_SPIN_CAP) { atomicAdd(&bar[XB_TMO], 1u); break; } }
    }
    nloc = mine > 0u ? mine : 1u; nx = cnt > 0u ? cnt : 1u;
}

__device__ __forceinline__ void xcd_barrier(const XcdBarrier& b) {
    asm volatile("s_waitcnt vmcnt(0)" ::: "memory");
    __syncthreads();
    if (threadIdx.x == 0) {
        unsigned* bar = b.bar;
        __builtin_amdgcn_s_waitcnt(0);
        unsigned nloc = b.st[0], nx = b.st[1];
        if (nloc == 0u) { xcd_barrier_complete(bar, b.x, nloc, nx); b.st[0] = nloc; b.st[1] = nx; }
        const unsigned old = xb_add(&bar[XB_XSUB(b.x)], 1u);
        const unsigned gen = old / nloc;
        if (old + 1u == (gen + 1u) * nloc) {
            __builtin_amdgcn_fence(__ATOMIC_RELEASE, "agent");
            asm volatile("s_waitcnt vmcnt(0)" ::: "memory");
            const unsigned og = xb_add(&bar[XB_TOP], 1u);
            const unsigned tg = og / nx;
            if (og + 1u == (tg + 1u) * nx) xb_add(&bar[XB_TOPGEN], 1u);
            else XB_SPIN(xb_ld(&bar[XB_TOPGEN]) == tg, bar);
            __builtin_amdgcn_fence(__ATOMIC_ACQUIRE, "agent");
            xb_add(&bar[XB_XGEN(b.x)], 1u);
            asm volatile("s_waitcnt vmcnt(0)" ::: "memory");
        } else {
            XB_SPIN(xb_ld(&bar[XB_XGEN(b.x)]) == gen, bar);
            __builtin_amdgcn_fence(__ATOMIC_ACQUIRE, "agent");
            asm volatile("s_waitcnt vmcnt(0)" ::: "memory");
        }
    }
    __syncthreads();
}

constexpr int MISC_OFF = LDS_BYTES - 256;
__device__ __forceinline__ void grid_bar(const Args& args, LAS unsigned char* lds) {
    XcdBarrier b; b.bar = (unsigned*)fresh_ptr(args.ws); b.x = xb_xcc_id(); b.st = (volatile LAS unsigned*)(lds + MISC_OFF);
    xcd_barrier(b);
}

__device__ __forceinline__ float wave_sum2(float v) { v = row16_sum(v); v += __shfl_xor(v, 16); v += __shfl_xor(v, 32); return v; }

namespace pg8 {
struct EpiSwiglu {
    static constexpr bool PERM = true, AFTER_DRAIN = false;
    bf16_t* O; int ldc;
    __device__ __forceinline__ void operator()(const f32x4 (&acc)[2][2][4][2], const Unit& u, int wr, int wc, int fr, int fq) const {
        const int row0 = u.pm * BM + wr * 64 + fr, col0 = u.pn * 128 + wc * 32 + 8 * fq;
#pragma unroll
        for (int ai = 0; ai < 2; ++ai)
#pragma unroll
            for (int m = 0; m < 4; ++m) {
                bf16_t* rowp = O + (size_t)(row0 + ai * HALF + m * 16) * ldc + col0;
                float h[8];
#pragma unroll
                for (int n = 0; n < 2; ++n)
#pragma unroll
                    for (int j = 0; j < 4; ++j) {
                        const float a = acc[ai][0][m][n][j], b = acc[ai][1][m][n][j];
                        const float e = __builtin_amdgcn_exp2f(-1.44269504f * a);
                        h[n * 4 + j] = a * __builtin_amdgcn_rcpf(1.0f + e) * b;
                    }
                u32x4 w; w.x = cvt_pk_bf16(h[0], h[1]); w.y = cvt_pk_bf16(h[2], h[3]); w.z = cvt_pk_bf16(h[4], h[5]); w.w = cvt_pk_bf16(h[6], h[7]);
                *(u32x4*)rowp = w;
            }
    }
};
struct EpiPlain {
    static constexpr bool PERM = true, AFTER_DRAIN = false;
    bf16_t* O; int ldc;
    __device__ __forceinline__ void operator()(const f32x4 (&acc)[2][2][4][2], const Unit& u, int wr, int wc, int fr, int fq) const {
        const int row0 = u.pm * BM + wr * 64 + fr, col0 = u.pn * BM + wc * 32 + 8 * fq;
#pragma unroll
        for (int ai = 0; ai < 2; ++ai)
#pragma unroll
            for (int m = 0; m < 4; ++m) {
                bf16_t* rowp = O + (size_t)(row0 + ai * HALF + m * 16) * ldc + col0;
#pragma unroll
                for (int bj = 0; bj < 2; ++bj) { const f32x4 v0 = acc[ai][bj][m][0], v1 = acc[ai][bj][m][1];
                    u32x4 w; w.x = cvt_pk_bf16(v0[0], v0[1]); w.y = cvt_pk_bf16(v0[2], v0[3]); w.z = cvt_pk_bf16(v1[0], v1[1]); w.w = cvt_pk_bf16(v1[2], v1[3]);
                    *(u32x4*)(rowp + bj * HALF) = w; }
            }
    }
};
struct EpiRes {
    static constexpr bool PERM = false, AFTER_DRAIN = false;
    float* X; const float* Xr; float* PART; const float* gate; const float* stats; const float* lg; const float* lb; float scale; int ntf;
    __device__ __forceinline__ void operator()(const f32x4 (&acc)[2][2][4][2], const Unit& u, int wr, int wc, int fr, int fq) const {
        const int col0 = u.pn * BM + wc * 32 + 4 * fq;
        const bool full = (u.nt == ntf);
        float* pbase = PART + (size_t)(u.k0 / SplitOrder::PK) * (512 * 1024);
#pragma unroll
        for (int ai = 0; ai < 2; ++ai)
#pragma unroll
            for (int m = 0; m < 4; ++m) {
                const int r = u.pm * BM + ai * HALF + wr * 64 + m * 16 + fr;
                const int bi = r < 16384 ? (r >> 11) : 8 + ((r - 16384) >> 2);
                const float* gp = gate + (size_t)bi * 9216;
                float* xo = full ? X + (size_t)r * 1024 : pbase + (size_t)(r - 16384) * 1024;
                float mean = 0.f, rs = 0.f;
                if (full) { const f32x2 st = *(const f32x2*)(stats + 2 * (size_t)r); mean = st.x; rs = st.y * 1.41421356237f; }
#pragma unroll
                for (int bj = 0; bj < 2; ++bj)
#pragma unroll
                    for (int n = 0; n < 2; ++n) {
                        const int c = col0 + bj * HALF + n * 16;
                        const f32x4 gv = *(const f32x4*)(gp + c);
                        f32x4 o = (gv * scale + scale) * acc[ai][bj][m][n];
                        if (full) { const f32x4 y = *(const f32x4*)(Xr + (size_t)r * 1024 + c), g4 = *(const f32x4*)(lg + c), b4 = *(const f32x4*)(lb + c);
                            o += (y - mean) * rs * g4 + b4 * 1.41421356237f; }
                        *(f32x4*)(xo + c) = o;
                        asm volatile("" ::: "memory");
                    }
            }
    }
};
struct EpiMod {
    static constexpr bool PERM = false, AFTER_DRAIN = false;
    float* MODp; const float* ada_b;
    __device__ __forceinline__ void operator()(const f32x4 (&acc)[2][2][4][2], const Unit& u, int wr, int wc, int fr, int fq) const {
        const int col0 = u.pn * BM + wc * 32 + 4 * fq;
        const int l = (u.pn * BM) / 9216;
#pragma unroll
        for (int ai = 0; ai < 2; ++ai)
#pragma unroll
            for (int m = 0; m < 4; ++m) {
                const int r = u.pm * BM + ai * HALF + wr * 64 + m * 16 + fr;
                if (r < 136) {
#pragma unroll
                    for (int bj = 0; bj < 2; ++bj)
#pragma unroll
                        for (int n = 0; n < 2; ++n) {
                            const int c = col0 + bj * HALF + n * 16;
                            const f32x4 o = acc[ai][bj][m][n] + *(const f32x4*)(ada_b + c);
                            *(f32x4*)(MODp + (size_t)(l * 136 + r) * 9216 + (c - l * 9216)) = o;
                        }
                }
            }
    }
};
}

__device__ __forceinline__ void transpose_item(const float* W, int K, int N, bf16* WT, int dest_row0, LAS float* scr, int k0, int n0, int lane) {
    const int nn = n0 + (lane & 31); const bool ok = nn < N;
    float tv[32];
#pragma unroll
    for (int i = 0; i < 32; ++i) { const int kk = 2 * i + (lane >> 5); tv[i] = ok ? W[(size_t)(k0 + kk) * N + nn] : 0.f; }
#pragma unroll
    for (int i = 0; i < 32; ++i) { const int kk = 2 * i + (lane >> 5); scr[kk * 33 + (lane & 31)] = tv[i]; }
    LDS_WAIT();
    const int c = lane & 7;
#pragma unroll
    for (int j = 0; j < 4; ++j) { const int n = (lane >> 3) + 8 * j; const LAS float* s = scr + (8 * c) * 33 + n;
        v4u o; o.x = pk2(s[0 * 33], s[1 * 33]); o.y = pk2(s[2 * 33], s[3 * 33]); o.z = pk2(s[4 * 33], s[5 * 33]); o.w = pk2(s[6 * 33], s[7 * 33]);
        *(v4u*)(WT + (size_t)(dest_row0 + n) * K + k0 + 8 * c) = o; }
    LDS_WAIT();
}

constexpr int I_WI = 16 * 176, I_WO = 44 * 32, I_WIN = 16 * 121, I_WOUT = 16 * 32, I_ADA = 16 * 288;
constexpr int I_MAIN = 2 * I_WI + 2 * I_WO + I_WIN + I_WOUT, I_LAYER = I_MAIN + I_ADA;
__device__ __forceinline__ void convert_item(const Args& args, unsigned char* ws, int l, int r, LAS float* scr, int lane) {
    unsigned char* wl = ws + WS_W + (size_t)l * W_LAYER;
    if (r < 2 * (I_WI + I_WO)) {
        const int f = r / (I_WI + I_WO); r -= f * (I_WI + I_WO);
        if (r < I_WI) {
            const int kb = r / 176, nb = r % 176, n0 = nb * 32;
            const int half = n0 / DFF, j = n0 - half * DFF, t = j >> 7, jj = j & 127;
            transpose_item((f ? args.in[15] : args.in[13]) + (size_t)l * D * NWI, D, NWI, (bf16*)(wl + (f ? W_WI2 : W_WI1)), 256 * t + 128 * half + jj, scr, kb * 64, n0, lane);
        } else { r -= I_WI;
            const int kb = r / 32, nb = r % 32;
            transpose_item((f ? args.in[16] : args.in[14]) + (size_t)l * DFF * D, DFF, D, (bf16*)(wl + (f ? W_WO2 : W_WO1)), nb * 32, scr, kb * 64, nb * 32, lane);
        }
        return;
    }
    r -= 2 * (I_WI + I_WO);
    if (r < I_WIN) { const int kb = r / 121, nb = r % 121;
        transpose_item(args.in[17] + (size_t)l * D * NIN, D, NIN, (bf16*)(wl + W_WIN), nb * 32, scr, kb * 64, nb * 32, lane); return; }
    r -= I_WIN;
    if (r < I_WOUT) { const int kb = r / 32, nb = r % 32;
        transpose_item(args.in[27] + (size_t)l * D * D, D, D, (bf16*)(wl + W_WOUT), nb * 32, scr, kb * 64, nb * 32, lane); return; }
    r -= I_WOUT;
    { const int kb = r / 288, nb = r % 288;
        transpose_item(args.in[9] + (size_t)l * D * NMODC, D, NMODC, (bf16*)(ws + WS_BIG), l * NMODC + nb * 32, scr, kb * 64, nb * 32, lane); }
}

__device__ __forceinline__ void p0_prologue(const Args& args, LAS unsigned char* lds_) {
    const Ctx C = make_ctx(args, lds_);
    LAS float* scr = (LAS float*)(C.lds + C.wave * 16384);
    for (int it = C.gw; it < 2 * I_ADA; it += C.NGW) convert_item(args, C.ws, it / I_ADA, I_MAIN + it % I_ADA, scr, C.lane);
    const int gt = C.gw * 64 + C.lane, NGT = C.NGW * 64;
    for (int i = gt; i < 2 * 224 * 128; i += NGT) { const int l = i / (224 * 128), rr = (i / 128) % 224, ch = i & 127;
        *(v4u*)(C.ws + WS_W + (size_t)l * W_LAYER + W_WIN + ((size_t)(3872 + rr) * 1024 + ch * 8) * 2) = (v4u){0u, 0u, 0u, 0u}; }
    for (int i = gt; i < 2048; i += NGT) ((float*)(C.ws + WS_ID))[i] = i < 1024 ? 1.0f : 0.f;
    for (int i = gt; i < 256 * 256; i += NGT) { const int row = i >> 8, c4 = (i & 255) * 4;
        v2u o = (v2u){0u, 0u};
        if (row < NB) { const float* src = row < BP ? args.in[7] + (size_t)row * D : args.in[8] + (size_t)(row - BP) * D; const f32x4 v = *(const f32x4*)(src + c4);
            o.x = pk2(siluf_(v.x), siluf_(v.y)); o.y = pk2(siluf_(v.z), siluf_(v.w)); }
        *(v2u*)(C.ws + WS_AC + ((size_t)row * D + c4) * 2) = o; }
    for (int i = gt; i < 2052 * 32; i += NGT) { const int p = i >> 5, j = i & 31; const double pos = p < 2048 ? (double)p : (double)(16384 + (p - 2048));
        double inv = 1.0; for (int q = 0; q < j; ++q) inv *= 0.7498942093324559;
        const double ang = pos * inv; const double n = rint(ang * 0.15915494309189535);
        const float rr = (float)((ang - n * 6.283185307179586) - n * 2.4492935982947064e-16);
        ((f32x2*)(C.ws + WS_ROPE))[i] = (f32x2){__cosf(rr), __sinf(rr)}; }
}

__device__ __forceinline__ void p1_convert(const Args& args, LAS unsigned char* lds_) {
    const Ctx C = make_ctx(args, lds_);
    if ((int)blockIdx.x < 72) return;
    LAS float* scr = (LAS float*)(C.lds + C.wave * 16384);
    constexpr int I_F0 = I_WI + I_WO, I_P0 = I_F0 + I_WIN;
    for (int it = ((int)blockIdx.x - 72) * NWAVES + C.wave; it < I_P0; it += 184 * NWAVES) {
        if (it < I_F0) convert_item(args, C.ws, 0, it, scr, C.lane);
        else convert_item(args, C.ws, 0, 2 * I_F0 + (it - I_F0), scr, C.lane);
    }
}

__device__ __forceinline__ void p2_modulate0(const Args& args, LAS unsigned char* lds_) {
    const Ctx C = make_ctx(args, lds_);
    const float* MOD = (const float*)(C.ws + WS_MOD); bf16* H = (bf16*)(C.ws + WS_H);
    for (int r = C.gw; r < M; r += C.NGW) {
        const float* xr = r < MP ? args.in[0] + (size_t)r * D : args.in[1] + (size_t)(r - MP) * D;
        const float* modr = MOD + (size_t)batch_of_row(r) * NMODC;
        if (C.lane == 0) *(f32x2*)((float*)(C.ws + WS_STATS) + 2 * (size_t)r) = (f32x2){0.f, 1.0f};
#pragma unroll
        for (int j = 0; j < 4; ++j) { const int c = (C.lane + 64 * j) * 4;
            const f32x4 v = *(const f32x4*)(xr + c), sh = *(const f32x4*)(modr + c), sc = *(const f32x4*)(modr + 1024 + c);
            const f32x4 h = v * (sc + 1.0f) + sh;
            if (r >= MP) *(f32x4*)(C.out + (size_t)r * D + c) = v * ALPHA;
            *(v2u*)(H + (size_t)r * D + c) = (v2u){pk2(h.x, h.y), pk2(h.z, h.w)}; }
    }
}

__device__ __forceinline__ void ln_phase(const Args& args, LAS unsigned char* lds_, int l, int which, bool write_h, int hl, int shc, int npart, float xscale, bool write_x) {
    const Ctx C = make_ctx(args, lds_);
    const float* MOD = (const float*)(C.ws + WS_MOD); bf16* H = (bf16*)(C.ws + WS_H);
    const float* g = args.in[11] + (size_t)(l * 3 + which) * D; const float* b = args.in[12] + (size_t)(l * 3 + which) * D;
    f32x4 nv[4];
    if (C.gw < M) {
#pragma unroll
        for (int j = 0; j < 4; ++j) nv[j] = *(const f32x4*)(C.out + (size_t)C.gw * D + (C.lane + 64 * j) * 4); }
#pragma unroll 1
    for (int r = C.gw; r < M; r += C.NGW) {
        float* xr = C.out + (size_t)r * D;
        f32x4 v[4]; float s = 0.f;
#pragma unroll
        for (int j = 0; j < 4; ++j) v[j] = nv[j];
        if (r + C.NGW < M) {
#pragma unroll
            for (int j = 0; j < 4; ++j) nv[j] = *(const f32x4*)(xr + (size_t)C.NGW * D + (C.lane + 64 * j) * 4); }
        if (r >= MP) { const float* pp = (const float*)(C.ws + WS_SB) + (size_t)(r - MP) * D;
#pragma unroll 1
            for (int p = 0; p < npart; ++p, pp += 512 * 1024) {
#pragma unroll
                for (int j = 0; j < 4; ++j) v[j] += *(const f32x4*)(pp + (C.lane + 64 * j) * 4); } }
#pragma unroll
        for (int j = 0; j < 4; ++j) s += (v[j].x + v[j].y) + (v[j].z + v[j].w);
        const float mean = wave_sum2(s) * (1.f / D); float s2 = 0.f;
#pragma unroll
        for (int j = 0; j < 4; ++j) { v[j] = v[j] - mean; s2 += (v[j].x * v[j].x + v[j].y * v[j].y) + (v[j].z * v[j].z + v[j].w * v[j].w); }
        const float rstd = rsqrtf(wave_sum2(s2) * (1.f / D) + LN_EPS);
        if (C.lane == 0) *(f32x2*)((float*)(C.ws + WS_STATS) + 2 * (size_t)r) = (f32x2){mean, rstd};
        const float* modr = MOD + (size_t)(hl * NB + batch_of_row(r)) * NMODC + shc * 1024;
#pragma unroll
        for (int j = 0; j < 4; ++j) { const int c = (C.lane + 64 * j) * 4;
            const f32x4 xn = v[j] * rstd * *(const f32x4*)(g + c) + *(const f32x4*)(b + c);
            if (write_x || r >= MP) *(f32x4*)(xr + c) = xn * xscale;
            if (write_h) { const f32x4 sh = *(const f32x4*)(modr + c), sc = *(const f32x4*)(modr + 1024 + c); const f32x4 h = xn * (sc + 1.0f) + sh;
                *(v2u*)(H + (size_t)r * D + c) = (v2u){pk2(h.x, h.y), pk2(h.z, h.w)}; }
        }
    }
}

struct PrepRaw { unsigned short rq1[4], rq2[4], rk1[4], rk2[4], aq[2], hf[4], hq[4], dx[12], db, da; v4u alr0, alr1; };
__device__ __forceinline__ void prep_load(PrepRaw& x, const bf16* P, int lane) {
    const int j = lane & 31;
#pragma unroll
    for (int h = 0; h < 4; ++h) { x.rq1[h] = P[C_RQ + h * 64 + j]; x.rq2[h] = P[C_RQ + h * 64 + 32 + j]; x.rk1[h] = P[C_RK + h * 64 + j]; x.rk2[h] = P[C_RK + h * 64 + 32 + j]; }
    x.alr0 = *(const v4u*)(P + C_ALR); x.alr1 = *(const v4u*)(P + C_ALR + 8);
#pragma unroll
    for (int i = 0; i < 2; ++i) x.aq[i] = P[C_AQ + lane + 64 * i];
#pragma unroll
    for (int i = 0; i < 4; ++i) { x.hf[i] = P[C_HF + lane + 64 * i]; x.hq[i] = P[C_HQ + lane + 64 * i]; }
#pragma unroll
    for (int i = 0; i < 12; ++i) x.dx[i] = P[C_DQKV + lane + 64 * i];
    x.db = P[C_DB + (lane & 3)]; x.da = P[C_DA + (lane & 3)];
}

__device__ __forceinline__ void prep_phase(const Args& args, LAS unsigned char* lds_, int l) {
    const Ctx C = make_ctx(args, lds_);
    const bf16* PROJ = (const bf16*)(C.ws + WS_BIG); bf16* SB = (bf16*)(C.ws + WS_SB); float* SF = (float*)(C.ws + WS_SF);
    const f32x2* ROPE = (const f32x2*)(C.ws + WS_ROPE);
    const int lane = C.lane;
    const float* wg = args.in[18] + (size_t)l * 16 * 128; const float* bg = args.in[19] + (size_t)l * 128;
    const float* cw = args.in[21] + (size_t)l * 4 * 768;
    LAS float* lwg = (LAS float*)C.lds; LAS float* lcw = lwg + 16 * 128;
    for (int i = C.tid; i < 16 * 128; i += NWAVES * 64) lwg[i] = wg[i];
    for (int i = C.tid; i < 4 * 768; i += NWAVES * 64) lcw[i] = cw[i];
    __syncthreads();
    constexpr int CH = 9;
    const int r0 = C.gw * CH, r1 = min(r0 + CH, M);
    if (r0 >= M) return;
    float lbv[4];
#pragma unroll
    for (int i = 0; i < 4; ++i) { lbv[i] = 0.f; if (l == 1) lbv[i] = 1.0f / (1.0f + expf(args.in[20][lane + 64 * i] - args.in[20][256 + lane + 64 * i])); }
    const float a_neg = -expf(args.in[22][l * 4 + (lane & 3)]), dtb = args.in[23][l * 4 + (lane & 3)];
    const float bg0 = bg[lane], bg1 = bg[lane + 64];
    float w1[12], w2[12], w3[12];
    auto load_window = [&](int r) {
        const bool isp = r < MP; const int rs = r - MP; const int b = isp ? (r >> 11) : (rs >> 2), t = isp ? (r & 2047) : (rs & 3);
        const float* cst = args.in[6] + ((size_t)(l * BS + b) * 3) * 768;
#pragma unroll
        for (int i = 0; i < 12; ++i) { const int ch = lane + 64 * i; const bf16* Pc = PROJ + (size_t)r * NINP + C_DQKV + ch;
            w1[i] = t >= 1 ? bf2f(Pc[-1 * NINP]) : (isp ? 0.f : cst[2 * 768 + ch]);
            w2[i] = t >= 2 ? bf2f(Pc[-2 * NINP]) : (isp ? 0.f : cst[(1 + t) * 768 + ch]);
            w3[i] = t >= 3 ? bf2f(Pc[-3 * NINP]) : (isp ? 0.f : cst[t * 768 + ch]); }
    };
    PrepRaw A; prep_load(A, PROJ + (size_t)r0 * NINP, lane);
    load_window(r0);
#pragma unroll 1
    for (int r = r0; r < r1; ++r) {
        PrepRaw B = A;
        if (r + 1 < r1) prep_load(B, PROJ + (size_t)(r + 1) * NINP, lane);
        int zo = 0; asm volatile("" : "+v"(zo));
        const bool isp = r < MP; const int rs = r - MP;
        const int b = isp ? (r >> 11) : (rs >> 2), t = isp ? (r & 2047) : (rs & 3);
        const int ridx = isp ? t : 2048 + t;
        bf16* sb = SB + (size_t)r * SBW; float* sf = SF + (size_t)r * SFW;
        { const int j = lane & 31; const bool hi = lane >= 32; const f32x2 cs = ROPE[ridx * 32 + j];
#pragma unroll
          for (int h = 0; h < 4; ++h) {
              const float q1 = bf2f(A.rq1[h]), q2 = bf2f(A.rq2[h]), k1 = bf2f(A.rk1[h]), k2 = bf2f(A.rk2[h]);
              const float qo = hi ? (q1 * cs.y + q2 * cs.x) : (q1 * cs.x - q2 * cs.y);
              const float ko = hi ? (k1 * cs.y + k2 * cs.x) : (k1 * cs.x - k2 * cs.y);
              sb[SB_RQ + h * 64 + lane] = (bf16)(pk2(qo, 0.f) & 0xffffu);
              sb[SB_RK + h * 64 + lane] = (bf16)(pk2(ko * 0.125f, 0.f) & 0xffffu);
          } }
        { const unsigned aw[8] = {A.alr0.x, A.alr0.y, A.alr0.z, A.alr0.w, A.alr1.x, A.alr1.y, A.alr1.z, A.alr1.w};
          float x0 = bg0, x1 = bg1;
#pragma unroll
          for (int i = 0; i < 8; ++i) { const float a0 = bflo(aw[i]), a1 = bfhi(aw[i]);
              x0 += a0 * lwg[(2 * i) * 128 + lane + zo] + a1 * lwg[(2 * i + 1) * 128 + lane + zo];
              x1 += a0 * lwg[(2 * i) * 128 + lane + 64 + zo] + a1 * lwg[(2 * i + 1) * 128 + lane + 64 + zo]; }
          const float sp0 = fmaxf(-x0, 0.f) + __logf(1.0f + __expf(-fabsf(x0))), sp1 = fmaxf(-x1, 0.f) + __logf(1.0f + __expf(-fabsf(x1)));
          sf[SF_ADEC + lane] = __expf(-sp0 * (1.0f / 16.0f)); sf[SF_ADEC + lane + 64] = __expf(-sp1 * (1.0f / 16.0f));
          sb[SB_AQ + lane] = (bf16)(pk2(bf2f(A.aq[0]) * 0.17677669529663687f, 0.f) & 0xffffu);
          sb[SB_AQ + lane + 64] = (bf16)(pk2(bf2f(A.aq[1]) * 0.17677669529663687f, 0.f) & 0xffffu); }
#pragma unroll
        for (int i = 0; i < 4; ++i) { const int c = lane + 64 * i;
            sf[SF_HF + c] = lbv[i] + (1.0f - lbv[i]) * sigmoidf_(bf2f(A.hf[i]));
            sb[SB_HQ + c] = (bf16)(pk2(siluf_(bf2f(A.hq[i])) * 0.125f, 0.f) & 0xffffu); }
        { float* cso = isp ? C.out + O_PCONV + ((size_t)(l * BP + b) * 3) * 768 : C.out + O_SCONV + ((size_t)(l * BS + b) * 3) * 768;
          const int so = isp ? t - (TP - 3) : t - 1;
          float uu[12];
#pragma unroll
          for (int i = 0; i < 12; ++i) { const float x0 = bf2f(A.dx[i]);
              const LAS float* cwc = lcw + lane + 64 * i + zo;
              uu[i] = siluf_(x0 * cwc[3 * 768] + w1[i] * cwc[2 * 768] + w2[i] * cwc[768] + w3[i] * cwc[0]);
              if (so >= 0) cso[so * 768 + lane + 64 * i] = x0;
              w3[i] = w2[i]; w2[i] = w1[i]; w1[i] = x0; }
float qr[4];
#pragma unroll
          for (int i = 0; i < 12; ++i) { float sc = 1.0f;
              if (i < 8) { const float nn = wave_sum2(uu[i] * uu[i]); sc = rsqrtf(nn + RMS_EPS) * (i < 4 ? 0.125f : 1.0f); }
              const unsigned wbits = pk2(uu[i] * sc, 0.f) & 0xffffu;
              sb[SB_DQ + i * 64 + lane] = (bf16)wbits;
              if (i < 4) qr[i] = bf2f(wbits);
              else if (i < 8) { const float qk = wave_sum2(qr[i - 4] * bf2f(wbits)); if (lane == 0) sf[SF_QK + (i - 4)] = qk; } }
          if (lane < 4) { sf[SF_BETA + lane] = sigmoidf_(bf2f(A.db));
              const float xx = bf2f(A.da) + dtb; const float sp = fmaxf(xx, 0.f) + __logf(1.0f + __expf(-fabsf(xx)));
              sf[SF_DDEC + lane] = __expf(a_neg * sp); } }
        A = B;
        if (r + 1 < r1) { const int rn = r + 1; const bool ns = rn < MP ? ((rn & 2047) == 0) : (((rn - MP) & 3) == 0); if (ns) load_window(rn); }
    }
}

template <int KIND, int DH, int R> struct Raw { unsigned q[DH / 2]; unsigned k[DH / 2]; unsigned v[(R + 1) / 2]; float f[DH]; float be, de; };

template <int KIND, int DH, int R>
__device__ __forceinline__ void load_tok(Raw<KIND, DH, R>& x, const bf16* qp, const bf16* kp, const bf16* vp, const float* fp) {
    if constexpr (DH == 4) { const v2u w = *(const v2u*)qp; x.q[0] = w.x; x.q[1] = w.y; } else { x.q[0] = *(const unsigned*)qp; }
    if constexpr (KIND != 2) { if constexpr (DH == 4) { const v2u w = *(const v2u*)kp; x.k[0] = w.x; x.k[1] = w.y; } else { x.k[0] = *(const unsigned*)kp; } }
    if constexpr (R == 1) x.v[0] = *vp; else if constexpr (R == 2) x.v[0] = *(const unsigned*)vp; else { const v2u w = *(const v2u*)vp; x.v[0] = w.x; x.v[1] = w.y; }
    if constexpr (KIND == 1) { const f32x2 w = *(const f32x2*)fp; x.f[0] = w.x; x.f[1] = w.y; }
    if constexpr (KIND == 2) { const f32x4 w = *(const f32x4*)fp; x.f[0] = w.x; x.f[1] = w.y; x.f[2] = w.z; x.f[3] = w.w; }
    if constexpr (KIND == 3) { x.be = fp[0]; x.de = fp[4]; }
}

template <int KIND, int DH, int R>
__device__ __forceinline__ void scan_task(const Ctx& C, int row0, int T, int h, int slice, const float* sin, float* sout) {
    const bf16* PROJ = (const bf16*)(C.ws + WS_BIG); const bf16* SB = (const bf16*)(C.ws + WS_SB); const float* SF = (const float*)(C.ws + WS_SF);
    bf16* H = (bf16*)(C.ws + WS_H);
    const int lane = C.lane, dl = lane & 15, rw = lane >> 4;
    const int d0 = dl * DH, v0 = slice * (4 * R) + rw * R;
    constexpr int DK = 16 * DH;
    const bf16 *qp, *kp, *vp; const float* fp; int ks, vs;
    const bf16* sbr = SB + (size_t)row0 * SBW; const bf16* pr = PROJ + (size_t)row0 * NINP; const float* sfr = SF + (size_t)row0 * SFW;
    if constexpr (KIND == 0) { qp = sbr + SB_RQ + h * 64 + d0; kp = sbr + SB_RK + h * 64 + d0; ks = SBW; vp = pr + C_RV + h * 64 + v0; vs = NINP; fp = sfr; }
    if constexpr (KIND == 1) { qp = sbr + SB_AQ + h * 32 + d0; kp = pr + C_AK + h * 32 + d0; ks = NINP; vp = pr + C_AV + h * 64 + v0; vs = NINP; fp = sfr + SF_ADEC + h * 32 + d0; }
    if constexpr (KIND == 2) { qp = sbr + SB_HQ + h * 64 + d0; kp = sbr; ks = SBW; vp = pr + C_HI + h * 64 + v0; vs = NINP; fp = sfr + SF_HF + h * 64 + d0; }
    if constexpr (KIND == 3) { qp = sbr + SB_DQ + h * 64 + d0; kp = sbr + SB_DK + h * 64 + d0; ks = SBW; vp = sbr + SB_DV + h * 64 + v0; vs = SBW; fp = sfr + SF_BETA + h; }
    bf16* op = H + (size_t)row0 * D + KIND * 256 + h * 64 + v0;
    const float rdec = 1.0f - exp2f(-5.0f - (float)h);

    float S[DH][R];
#pragma unroll
    for (int dh = 0; dh < DH; ++dh)
#pragma unroll
        for (int vv = 0; vv < R; ++vv) S[dh][vv] = sin ? sin[(size_t)(d0 + dh) * 64 + v0 + vv] : 0.f;

    typedef Raw<KIND, DH, R> RawT;
    RawT A[4];
#pragma unroll
    for (int u = 0; u < 4; ++u) load_tok<KIND, DH, R>(A[u], qp + (size_t)u * SBW, kp + (size_t)u * ks, vp + (size_t)u * vs, fp + (size_t)u * SFW);
    for (int t0 = 0; t0 < T; t0 += 4) {
        RawT B[4];
        const bool more = t0 + 4 < T;
#pragma unroll
        for (int u = 0; u < 4; ++u) { B[u] = A[u]; }
        if (more) {
#pragma unroll
            for (int u = 0; u < 4; ++u) load_tok<KIND, DH, R>(B[u], qp + (size_t)(t0 + 4 + u) * SBW, kp + (size_t)(t0 + 4 + u) * ks, vp + (size_t)(t0 + 4 + u) * vs, fp + (size_t)(t0 + 4 + u) * SFW);
        }
#pragma unroll
        for (int u = 0; u < 4; ++u) {
            const RawT& x = A[u];
            float q[DH], k[DH], v[R];
            q[0] = bflo(x.q[0]); q[1] = bfhi(x.q[0]); if constexpr (DH == 4) { q[2] = bflo(x.q[1]); q[3] = bfhi(x.q[1]); }
            if constexpr (KIND != 2) { k[0] = bflo(x.k[0]); k[1] = bfhi(x.k[0]); if constexpr (DH == 4) { k[2] = bflo(x.k[1]); k[3] = bfhi(x.k[1]); } }
            if constexpr (R == 1) v[0] = bflo(x.v[0]);
            if constexpr (R >= 2) { v[0] = bflo(x.v[0]); v[1] = bfhi(x.v[0]); }
            if constexpr (R == 4) { v[2] = bflo(x.v[1]); v[3] = bfhi(x.v[1]); }
            float o[R];
            if constexpr (KIND == 3) {
                float ks_[R];
#pragma unroll
                for (int vv = 0; vv < R; ++vv) { float p = 0.f;
#pragma unroll
                    for (int dh = 0; dh < DH; ++dh) { S[dh][vv] *= x.de; p += k[dh] * S[dh][vv]; }
                    ks_[vv] = row16_sum(p); }
#pragma unroll
                for (int vv = 0; vv < R; ++vv) { const float uu = x.be * (v[vv] - ks_[vv]); float p = 0.f;
#pragma unroll
                    for (int dh = 0; dh < DH; ++dh) { S[dh][vv] += k[dh] * uu; p += q[dh] * S[dh][vv]; }
                    o[vv] = row16_sum(p); }
            } else {
#pragma unroll
                for (int dh = 0; dh < DH; ++dh) {
                    float dec, kk;
                    if constexpr (KIND == 0) { dec = rdec; kk = k[dh]; }
                    if constexpr (KIND == 1) { dec = x.f[dh]; kk = k[dh]; }
                    if constexpr (KIND == 2) { dec = x.f[dh]; kk = 1.0f - x.f[dh]; }
#pragma unroll
                    for (int vv = 0; vv < R; ++vv) S[dh][vv] = dec * S[dh][vv] + kk * v[vv];
                }
#pragma unroll
                for (int vv = 0; vv < R; ++vv) { float p = 0.f;
#pragma unroll
                    for (int dh = 0; dh < DH; ++dh) p += q[dh] * S[dh][vv];
                    o[vv] = row16_sum(p); }
            }
            if (dl == 0) {
                bf16* o_ = op + (size_t)(t0 + u) * D;
                if constexpr (R == 1) *o_ = (bf16)(pk2(o[0], 0.f) & 0xffffu);
                if constexpr (R == 2) *(unsigned*)o_ = pk2(o[0], o[1]);
                if constexpr (R == 4) *(v2u*)o_ = (v2u){pk2(o[0], o[1]), pk2(o[2], o[3])};
            }
        }
#pragma unroll
        for (int u = 0; u < 4; ++u) A[u] = B[u];
    }
#pragma unroll
    for (int dh = 0; dh < DH; ++dh)
#pragma unroll
        for (int vv = 0; vv < R; ++vv) sout[(size_t)(d0 + dh) * 64 + v0 + vv] = S[dh][vv];
    (void)DK;
}

template <int KIND, int DH, int R>
__device__ __forceinline__ void scan_long(const Ctx& C, LAS float* wl, int row0, int T, int h, int slice, float* sout) {
    constexpr int CT = 16, LR = 8, DK = LR * DH, NV = (64 / LR) * R, UNR = 8;
    constexpr bool HASK = true, GK = (KIND != 2), HASF = (KIND == 1 || KIND == 2), HASB = (KIND == 3);
    constexpr int OQ = 0, OK_ = OQ + CT * DK, OF = OK_ + (HASK ? CT * DK : 0), OV = OF + (HASF ? CT * DK : 0), OB = OV + CT * NV, BUF = OB + (HASB ? CT * 4 : 0);
    const bf16* PROJ = (const bf16*)(C.ws + WS_BIG); const bf16* SB = (const bf16*)(C.ws + WS_SB); const float* SF = (const float*)(C.ws + WS_SF);
    bf16* H = (bf16*)(C.ws + WS_H);
    const int lane = C.lane, dl = lane & (LR - 1), rw = lane / LR;
    const int d0 = dl * DH;
    const int stok = lane >> 2, spart = lane & 3;
    const GAS bf16 *qg, *kg, *vg; const GAS float *fg, *bg; int ks, vs;
    {
        const GAS bf16* sbr = (const GAS bf16*)(SB + (size_t)row0 * SBW); const GAS bf16* pr = (const GAS bf16*)(PROJ + (size_t)row0 * NINP); const GAS float* sfr = (const GAS float*)(SF + (size_t)row0 * SFW);
        const int vcol = slice * NV;
        if constexpr (KIND == 0) { qg = sbr + SB_RQ + h * 64; kg = sbr + SB_RK + h * 64; ks = SBW; vg = pr + C_RV + h * 64 + vcol; vs = NINP; fg = sfr; bg = sfr; }
        if constexpr (KIND == 1) { qg = sbr + SB_AQ + h * 32; kg = pr + C_AK + h * 32; ks = NINP; vg = pr + C_AV + h * 64 + vcol; vs = NINP; fg = sfr + SF_ADEC + h * 32; bg = sfr; }
        if constexpr (KIND == 2) { qg = sbr + SB_HQ + h * 64; kg = sbr; ks = SBW; vg = pr + C_HI + h * 64 + vcol; vs = NINP; fg = sfr + SF_HF + h * 64; bg = sfr; }
        if constexpr (KIND == 3) { qg = sbr + SB_DQ + h * 64; kg = sbr + SB_DK + h * 64; ks = SBW; vg = sbr + SB_DV + h * 64 + vcol; vs = SBW; fg = sfr; bg = sfr + SF_BETA + h; }
    }
    constexpr int QP = DK / 4;
    qg += (size_t)stok * SBW + spart * QP; kg += (size_t)stok * ks + spart * QP; fg += (size_t)stok * SFW + spart * QP;
    vg += (size_t)(lane & 15) * vs; bg += (size_t)(lane & 15) * SFW;
    GAS bf16* op = (GAS bf16*)(H + (size_t)row0 * D + KIND * 256 + h * 64 + slice * NV + rw * R);
    const float rdec = 1.0f - exp2f(-5.0f - (float)h);

    static_assert(R == 1, "scan_long: one column per lane row");
    f32x2 S2[DH / 2];
#pragma unroll
    for (int i = 0; i < DH / 2; ++i) S2[i] = (f32x2){0.f, 0.f};

    struct SR { v4u rq[QP / 8], rk[QP / 8]; f32x4 rf[QP / 4]; unsigned rv[NV / 2]; float rb0, rb1, rb2; };
    SR s0; s0.rb0 = s0.rb1 = s0.rb2 = 0.f;
    auto stage_load = [&](SR& sr, int c) {
        const size_t t = (size_t)c * CT;
#pragma unroll
        for (int i = 0; i < QP / 8; ++i) { sr.rq[i] = *(const GAS v4u*)(qg + t * SBW + i * 8); if constexpr (GK) sr.rk[i] = *(const GAS v4u*)(kg + t * ks + i * 8); }
        if constexpr (HASF) {
#pragma unroll
            for (int i = 0; i < QP / 4; ++i) sr.rf[i] = *(const GAS f32x4*)(fg + t * SFW + i * 4); }
        if (lane < 16) {
            if constexpr (NV == 4) { const v2u w = *(const GAS v2u*)(vg + t * vs); sr.rv[0] = w.x; sr.rv[1] = w.y; }
            if constexpr (NV == 8) { const v4u w = *(const GAS v4u*)(vg + t * vs); sr.rv[0] = w.x; sr.rv[1] = w.y; sr.rv[2] = w.z; sr.rv[3] = w.w; }
            if constexpr (NV == 16) { const v4u w = *(const GAS v4u*)(vg + t * vs), w2 = *(const GAS v4u*)(vg + t * vs + 8); sr.rv[0] = w.x; sr.rv[1] = w.y; sr.rv[2] = w.z; sr.rv[3] = w.w; sr.rv[4] = w2.x; sr.rv[5] = w2.y; sr.rv[6] = w2.z; sr.rv[7] = w2.w; }
            if constexpr (HASB) { sr.rb0 = bg[t * SFW]; sr.rb1 = bg[t * SFW + 4]; sr.rb2 = bg[t * SFW + 8]; }
        }
    };
    auto stage_write = [&](SR& sr, int b) {
        LAS float* base = wl + b * BUF;
#pragma unroll
        for (int i = 0; i < QP / 8; ++i) {
            LAS float* qd = base + OQ + stok * DK + spart * QP + i * 8;
            *(LAS f32x4*)qd = (f32x4){bflo(sr.rq[i].x), bfhi(sr.rq[i].x), bflo(sr.rq[i].y), bfhi(sr.rq[i].y)}; *(LAS f32x4*)(qd + 4) = (f32x4){bflo(sr.rq[i].z), bfhi(sr.rq[i].z), bflo(sr.rq[i].w), bfhi(sr.rq[i].w)};
            if constexpr (GK) { LAS float* kd = base + OK_ + stok * DK + spart * QP + i * 8;
                *(LAS f32x4*)kd = (f32x4){bflo(sr.rk[i].x), bfhi(sr.rk[i].x), bflo(sr.rk[i].y), bfhi(sr.rk[i].y)}; *(LAS f32x4*)(kd + 4) = (f32x4){bflo(sr.rk[i].z), bfhi(sr.rk[i].z), bflo(sr.rk[i].w), bfhi(sr.rk[i].w)}; }
        }
        if constexpr (HASF) {
#pragma unroll
            for (int i = 0; i < QP / 4; ++i) { *(LAS f32x4*)(base + OF + stok * DK + spart * QP + i * 4) = sr.rf[i];
                if constexpr (KIND == 2) *(LAS f32x4*)(base + OK_ + stok * DK + spart * QP + i * 4) = 1.0f - sr.rf[i]; } }
        if (lane < 16) {
#pragma unroll
            for (int i = 0; i < NV / 2; ++i) { base[OV + lane * NV + 2 * i] = bflo(sr.rv[i]); base[OV + lane * NV + 2 * i + 1] = bfhi(sr.rv[i]); }
            if constexpr (HASB) *(LAS f32x4*)(base + OB + lane * 4) = (f32x4){sr.rb0, sr.rb1, sr.rb2, 0.f};
        }
    };
    static_assert(2 * BUF * 4 <= 26624, "per-wave LDS");
    const int nch = T / CT;
    struct Opnd { f32x2 q2[DH / 2], k2[DH / 2], f2[DH / 2]; float v; f32x4 bd; };
    auto ldop = [&](Opnd& x, const LAS float* bq, const LAS float* bv, const LAS float* bb, int uu) {
#pragma unroll
        for (int i = 0; i < DH / 4; ++i) { const f32x4 w = *(const LAS f32x4*)(bq + OQ + uu * DK + 4 * i); x.q2[2 * i] = (f32x2){w.x, w.y}; x.q2[2 * i + 1] = (f32x2){w.z, w.w}; }
#pragma unroll
        for (int i = 0; i < DH / 4; ++i) { const f32x4 w = *(const LAS f32x4*)(bq + OK_ + uu * DK + 4 * i); x.k2[2 * i] = (f32x2){w.x, w.y}; x.k2[2 * i + 1] = (f32x2){w.z, w.w}; }
        if constexpr (HASF) {
#pragma unroll
            for (int i = 0; i < DH / 4; ++i) { const f32x4 w = *(const LAS f32x4*)(bq + OF + uu * DK + 4 * i); x.f2[2 * i] = (f32x2){w.x, w.y}; x.f2[2 * i + 1] = (f32x2){w.z, w.w}; } }
        x.v = bv[uu * NV];
        if constexpr (HASB) x.bd = *(const LAS f32x4*)(bb + uu * 4);
    };
    auto compute = [&](int c, const LAS float* base) {
#pragma unroll 1
        for (int ub = 0; ub < CT; ub += UNR) {
        float okeep[R];
#pragma unroll
        for (int vv = 0; vv < R; ++vv) okeep[vv] = 0.f;
        Opnd X; X.bd = (f32x4){0.f, 0.f, 0.f, 0.f};
#pragma unroll
        for (int i = 0; i < DH / 2; ++i) X.f2[i] = (f32x2){0.f, 0.f};
        const LAS float* bq = base + ub * DK + d0; const LAS float* bv = base + OV + ub * NV + rw; const LAS float* bb = base + OB + ub * 4;
        ldop(X, bq, bv, bb, 0);
#pragma unroll
        for (int uu_ = 0; uu_ < UNR; ++uu_) { const int u = ub + uu_;
            Opnd Y = X;
            if (uu_ + 1 < UNR) ldop(Y, bq, bv, bb, uu_ + 1);
            f32x2 (&q2)[DH / 2] = X.q2; f32x2 (&k2)[DH / 2] = X.k2; f32x2 (&f2)[DH / 2] = X.f2; const float vv_ = X.v; const f32x4 bd = X.bd;
            float o[1];
            if constexpr (KIND == 3) {
                f32x2 a = k2[0] * S2[0], bq_ = q2[0] * S2[0];
#pragma unroll
                for (int i = 1; i < DH / 2; ++i) { a = __builtin_elementwise_fma(k2[i], S2[i], a); bq_ = __builtin_elementwise_fma(q2[i], S2[i], bq_); }
                const float ks_ = row8_sum(a.x + a.y) * bd.y, qs_ = row8_sum(bq_.x + bq_.y) * bd.y;
                const float uu = bd.x * (vv_ - ks_);
                o[0] = __builtin_fmaf(bd.z, uu, qs_);
                const f32x2 de2 = (f32x2){bd.y, bd.y}, uu2 = (f32x2){uu, uu};
#pragma unroll
                for (int i = 0; i < DH / 2; ++i) S2[i] = __builtin_elementwise_fma(S2[i], de2, k2[i] * uu2);
            } else {
                const f32x2 v2 = (f32x2){vv_, vv_};
#pragma unroll
                for (int i = 0; i < DH / 2; ++i) {
                    f32x2 dec2;
                    if constexpr (KIND == 0) dec2 = (f32x2){rdec, rdec}; else dec2 = f2[i];
                    S2[i] = __builtin_elementwise_fma(S2[i], dec2, k2[i] * v2);
                }
            }
            if constexpr (KIND != 3)
            { f32x2 a = q2[0] * S2[0];
#pragma unroll
              for (int i = 1; i < DH / 2; ++i) a = __builtin_elementwise_fma(q2[i], S2[i], a);
              o[0] = row8_sum(a.x + a.y); }
#pragma unroll
            for (int vv = 0; vv < R; ++vv) okeep[vv] = (dl == uu_) ? o[vv] : okeep[vv];
            X = Y;
        }
        {
            GAS bf16* o_ = op + (size_t)(c * CT + ub + dl) * D;
            if constexpr (R == 1) *o_ = (bf16)(pk2(okeep[0], 0.f) & 0xffffu);
            if constexpr (R == 2) *(GAS unsigned*)o_ = pk2(okeep[0], okeep[1]);
            if constexpr (R == 4) *(GAS v2u*)o_ = (v2u){pk2(okeep[0], okeep[1]), pk2(okeep[2], okeep[3])};
        }
        }
    };
    stage_load(s0, 0); stage_write(s0, 0);
#pragma unroll 1
    for (int c = 0; c < nch; c += 2) {
        stage_load(s0, min(c + 1, nch - 1));
        compute(c, wl);
        stage_write(s0, 1);
        stage_load(s0, min(c + 2, nch - 1));
        compute(c + 1, wl + BUF);
        stage_write(s0, 0);
    }
    const int v0 = slice * NV + rw * R;
#pragma unroll
    for (int i = 0; i < DH / 2; ++i) { sout[(size_t)(d0 + 2 * i) * 64 + v0] = S2[i].x; sout[(size_t)(d0 + 2 * i + 1) * 64 + v0] = S2[i].y; }
}

__device__ __forceinline__ void scan_phase(const Args& args, LAS unsigned char* lds_, int l, int mode = 0) {
    const Ctx C = make_ctx(args, lds_);
    constexpr int NLONG = 1024, NSHORT = BS * 144;
    const int slot = C.wave * 256 + (int)blockIdx.x;
    const int nidle = C.NGW - NLONG - 256;
    for (int it = 0;; ++it) {
        int kind, b, h, slice, row0, T; bool isp;
        if (slot < NLONG) { if (it > 0 || mode == 2) break; isp = true; T = TP;
            const int kk_ = slot >> 8, i = slot & 255; kind = kk_ == 0 ? 3 : (kk_ == 1 ? 0 : (kk_ == 2 ? 2 : 1));
            { const int stream = (i & 7) | ((i >> 6) << 3); slice = (i >> 3) & 7; b = stream >> 2; h = stream & 3; }
            row0 = b * TP;
        } else { if (C.wave < 5) break;
            const int st = (slot - NLONG - 256) + it * nidle; if (st >= NSHORT || mode == 1) break; isp = false; T = TS;
            b = st / 144; int i = st - b * 144;
            if (i < 64) { kind = 3; h = i >> 4; slice = i & 15; }
            else if (i < 96) { i -= 64; kind = 0; h = i >> 3; slice = i & 7; }
            else if (i < 128) { i -= 96; kind = 2; h = i >> 3; slice = i & 7; }
            else { i -= 128; kind = 1; h = i >> 2; slice = i & 3; }
            row0 = MP + b * TS;
        }
        const int nbat = isp ? BP : BS;
        const size_t sidx = (size_t)((l * nbat + b) * 4 + h);
        if (isp) {
            LAS float* wl = (LAS float*)(C.lds + C.wave * 26624);
            if (kind == 0) scan_long<0, 8, 1>(C, wl, row0, T, h, slice, C.out + O_PRET + sidx * 4096);
            else if (kind == 1) scan_long<1, 4, 1>(C, wl, row0, T, h, slice, C.out + O_PGLA + sidx * 2048);
            else if (kind == 2) scan_long<2, 8, 1>(C, wl, row0, T, h, slice, C.out + O_PHG + sidx * 4096);
            else scan_long<3, 8, 1>(C, wl, row0, T, h, slice, C.out + O_PGDN + sidx * 4096);
        } else {
            if (kind == 0) { scan_task<0, 4, 2>(C, row0, T, h, slice, args.in[2] + sidx * 4096, C.out + O_SRET + sidx * 4096); }
            else if (kind == 1) { scan_task<1, 2, 4>(C, row0, T, h, slice, args.in[3] + sidx * 2048, C.out + O_SGLA + sidx * 2048); }
            else if (kind == 2) { scan_task<2, 4, 2>(C, row0, T, h, slice, args.in[4] + sidx * 4096, C.out + O_SHG + sidx * 4096); }
            else { scan_task<3, 4, 1>(C, row0, T, h, slice, args.in[5] + sidx * 4096, C.out + O_SGDN + sidx * 4096); }
        }
    }
    if (l == 0 && C.wave >= 5 && mode != 1) {
        LAS float* scr = (LAS float*)(C.lds + 4 * 26624 + (C.wave - 5) * 8704);
        constexpr int I_F0 = I_WI + I_WO, I_L0B = I_F0 + I_WOUT;
        for (int it = (C.wave - 5) * 256 + (int)blockIdx.x; it < I_L0B + I_MAIN; it += 768) {
            if (it < I_F0) convert_item(args, C.ws, 0, I_F0 + it, scr, C.lane);
            else if (it < I_L0B) convert_item(args, C.ws, 0, 2 * I_F0 + I_WIN + (it - I_F0), scr, C.lane);
            else convert_item(args, C.ws, 1, it - I_L0B, scr, C.lane);
        }
    }
}

__device__ __forceinline__ void post_phase(const Args& args, LAS unsigned char* lds_, int l) {
    const Ctx C = make_ctx(args, lds_);
    const bf16* PROJ = (const bf16*)(C.ws + WS_BIG); bf16* H = (bf16*)(C.ws + WS_H);
    const int lane = C.lane, mixer = lane >> 4, cc = (lane & 15) * 16;
    const int gbase = mixer == 0 ? C_RG : mixer == 1 ? C_AG : mixer == 2 ? C_HG : C_DG;
    const float* nw = mixer == 1 ? args.in[24] + l * 64 : mixer == 2 ? args.in[25] + l * 64 : args.in[26] + l * 64;
    float w[16];
#pragma unroll
    for (int i = 0; i < 16; ++i) w[i] = mixer == 0 ? 1.0f : nw[(cc + i) & 63];
    v4u na0, na1, ng0, ng1;
    if (C.gw < M) { const bf16* hp = H + (size_t)C.gw * D + lane * 16; const bf16* gp = PROJ + (size_t)C.gw * NINP + gbase + cc;
        na0 = *(const v4u*)hp; na1 = *(const v4u*)(hp + 8); ng0 = *(const v4u*)gp; ng1 = *(const v4u*)(gp + 8); }
#pragma unroll 1
    for (int r = C.gw; r < M; r += C.NGW) {
        bf16* hp = H + (size_t)r * D + lane * 16; const bf16* gp = PROJ + (size_t)r * NINP + gbase + cc;
        const v4u a0 = na0, a1 = na1, g0 = ng0, g1 = ng1;
        if (r + C.NGW < M) { const bf16* hn = hp + (size_t)C.NGW * D; const bf16* gn = gp + (size_t)C.NGW * NINP;
            na0 = *(const v4u*)hn; na1 = *(const v4u*)(hn + 8); ng0 = *(const v4u*)gn; ng1 = *(const v4u*)(gn + 8); }
        float y[16], g[16];
        const unsigned aw[8] = {a0.x, a0.y, a0.z, a0.w, a1.x, a1.y, a1.z, a1.w}, gw_[8] = {g0.x, g0.y, g0.z, g0.w, g1.x, g1.y, g1.z, g1.w};
        float ss = 0.f;
#pragma unroll
        for (int i = 0; i < 8; ++i) { y[2 * i] = bflo(aw[i]); y[2 * i + 1] = bfhi(aw[i]); g[2 * i] = bflo(gw_[i]); g[2 * i + 1] = bfhi(gw_[i]); ss += y[2 * i] * y[2 * i] + y[2 * i + 1] * y[2 * i + 1]; }
        ss = quad_sum(ss);
        const float rs = rsqrtf(ss * (1.0f / 64.0f) + RMS_EPS);
        unsigned ow[8];
#pragma unroll
        for (int i = 0; i < 8; ++i) ow[i] = pk2(y[2 * i] * rs * w[2 * i] * siluf_(g[2 * i]), y[2 * i + 1] * rs * w[2 * i + 1] * siluf_(g[2 * i + 1]));
        *(v4u*)hp = (v4u){ow[0], ow[1], ow[2], ow[3]}; *(v4u*)(hp + 8) = (v4u){ow[4], ow[5], ow[6], ow[7]};
    }
}

__global__ void __launch_bounds__(NWAVES * 64, 2) mega_fwd(Args args) {
    extern __shared__ __attribute__((aligned(16))) unsigned char lds[];
    cg::grid_group grid = cg::this_grid();
    LAS unsigned char* const LDSP = (LAS unsigned char*)lds;
    const int G = (int)gridDim.x, bx = (int)blockIdx.x;
    if (threadIdx.x < 64) ((LAS unsigned*)(LDSP + MISC_OFF))[threadIdx.x] = 0u;
    __syncthreads();
    (void)xcd_barrier_post((unsigned*)args.ws, (volatile LAS unsigned*)(LDSP + MISC_OFF));
#define FRESH() float* out_ = fresh_ptr(args.out); unsigned char* ws = fresh_ptr(args.ws); \
    float* MOD = (float*)(ws + WS_MOD); bf16* H = (bf16*)(ws + WS_H); bf16* BIG = (bf16*)(ws + WS_BIG); (void)MOD; (void)H; (void)BIG; (void)out_;

    p0_prologue(args, LDSP);
    if (args.ws == nullptr) grid.sync();
    grid_bar(args, LDSP);
    {
        FRESH();
        pg8::Gemm g{(const bf16*)(ws + WS_AC), BIG, 256, 2 * NMODC, D}; pg8::StaticOrder S; S.init(256, 2 * NMODC, G, bx, D);
        pg8::EpiMod E{MOD, args.in[10]};
        pg8::gemm_phase<pg8::EpiMod, pg8::StaticOrder, PG8_ALIGN, PG8_SP2>(LDSP, g, S, E);
    }
    p1_convert(args, LDSP);
    grid_bar(args, LDSP);
    p2_modulate0(args, LDSP);
    grid_bar(args, LDSP);
#pragma unroll 1
    for (int l = 0; l < 2; ++l) {
#pragma unroll 1
        for (int f = 0; f < 2; ++f) {
            if (f == 1) {
                {
                    FRESH();
                    pg8::Gemm g{H, (const bf16*)(ws + WS_W + (size_t)l * W_LAYER + W_WIN), M, NINP, D}; pg8::StaticOrder S; S.init(M, NINP, G, bx, D);
                    pg8::EpiPlain E{BIG, NINP};
                    pg8::gemm_phase<pg8::EpiPlain, pg8::StaticOrder, PG8_ALIGN, PG8_SP2>(LDSP, g, S, E);
                }
                grid_bar(args, LDSP);
                prep_phase(args, LDSP, l);
                grid_bar(args, LDSP);
                scan_phase(args, LDSP, l);
#ifdef PROBE_SCANMODE
                grid_bar(args, LDSP); scan_phase(args, LDSP, l, PROBE_SCANMODE);
#endif
                grid_bar(args, LDSP);
                post_phase(args, LDSP, l);
                grid_bar(args, LDSP);
                {
                    FRESH();
                    pg8::Gemm g{H, (const bf16*)(ws + WS_W + (size_t)l * W_LAYER + W_WOUT), M, D, D}; pg8::SplitOrder S; S.init(D, G, bx);
                    pg8::EpiRes E{out_, out_, (float*)(ws + WS_SB), MOD + (size_t)l * NB * NMODC + 5 * 1024, (const float*)(ws + WS_STATS), args.in[11] + (size_t)(l * 3) * D, args.in[12] + (size_t)(l * 3) * D, 1.0f, D / 64};
                    pg8::gemm_phase<pg8::EpiRes, pg8::SplitOrder, PG8_ALIGN, PG8_SP2>(LDSP, g, S, E);
                }
                grid_bar(args, LDSP);
                ln_phase(args, LDSP, l, 1, true, l, 6, 4, ALPHA, false);
                grid_bar(args, LDSP);
            }
            {
                FRESH();
                pg8::Gemm g{H, (const bf16*)(ws + WS_W + (size_t)l * W_LAYER + (f ? W_WI2 : W_WI1)), M, NWI, D}; pg8::StaticOrder S; S.init(M, NWI, G, bx, D);
                pg8::EpiSwiglu E{BIG, DFF};
                pg8::gemm_phase<pg8::EpiSwiglu, pg8::StaticOrder, PG8_ALIGN, PG8_SP2>(LDSP, g, S, E);
            }
            grid_bar(args, LDSP);
            {
                FRESH();
                pg8::Gemm g{BIG, (const bf16*)(ws + WS_W + (size_t)l * W_LAYER + (f ? W_WO2 : W_WO1)), M, D, DFF}; pg8::SplitOrder S; S.init(DFF, G, bx);
                const bool first = (l == 0 && f == 0); const int pinst = f ? l * 3 + 1 : l * 3 - 1;
                pg8::EpiRes E{out_, first ? args.in[0] : out_, (float*)(ws + WS_SB), MOD + (size_t)l * NB * NMODC + (f ? 8 : 2) * 1024, (const float*)(ws + WS_STATS),
                              first ? (const float*)(ws + WS_ID) : args.in[11] + (size_t)pinst * D, first ? (const float*)(ws + WS_ID) + 1024 : args.in[12] + (size_t)pinst * D, 0.5f, DFF / 64};
                pg8::gemm_phase<pg8::EpiRes, pg8::SplitOrder, PG8_ALIGN, PG8_SP2>(LDSP, g, S, E);
            }
            grid_bar(args, LDSP);
            if (f == 0) ln_phase(args, LDSP, l, 0, true, l, 3, 11, ALPHA, false);
            else ln_phase(args, LDSP, l, 2, l == 0, 1, 0, 11, l == 0 ? ALPHA : 1.0f, l == 1);
            if (!(l == 1 && f == 1)) grid_bar(args, LDSP);
        }
    }
}

extern "C" void kernel_launch(void* const* d_in, const int* in_sizes, int n_in, void* d_out, int out_size, void* d_ws, size_t ws_size, hipStream_t stream) {
    static int grid = 0;
    if (grid == 0) {
        if (n_in != 28 || (size_t)out_size != O_END || ws_size < WS_END) { fprintf(stderr, "kernel_launch: unexpected sizes n_in %d out %d ws %zu (need %zu)\n", n_in, out_size, ws_size, (size_t)WS_END); grid = -1; return; }
        int dev = 0, cus = 0, per_cu = 0;
        hipGetDevice(&dev); hipDeviceGetAttribute(&cus, hipDeviceAttributeMultiprocessorCount, dev);
        hipFuncSetAttribute((const void*)mega_fwd, hipFuncAttributeMaxDynamicSharedMemorySize, LDS_BYTES);
        hipOccupancyMaxActiveBlocksPerMultiprocessor(&per_cu, (const void*)mega_fwd, NWAVES * 64, LDS_BYTES);
        (void)hipGetLastError();
        if (per_cu < 1 || cus < 256) { fprintf(stderr, "kernel_launch: occupancy %d cus %d\n", per_cu, cus); grid = -1; return; }
        grid = 256;
    }
    if (grid < 0) return;
    if (hipMemsetAsync(d_ws, 0, 65536, stream) != hipSuccess) { fprintf(stderr, "memset failed\n"); return; }
    Args a{};
    for (int i = 0; i < 28; ++i) a.in[i] = (const float*)d_in[i];
    a.out = (float*)d_out; a.ws = (unsigned char*)d_ws;
    void* kargs[] = {&a};
    hipError_t e = hipLaunchCooperativeKernel((const void*)mega_fwd, dim3(grid), dim3(NWAVES * 64), kargs, LDS_BYTES, stream);
    if (e != hipSuccess) fprintf(stderr, "cooperative launch failed: %s\n", hipGetErrorString(e));
}
```

```cpp
#include <hip/hip_runtime.h>
#include <hip/hip_cooperative_groups.h>
#include <cstdio>
#include <cstdint>
namespace cg = cooperative_groups;
namespace pg8 {
#define PG8_LAS __attribute__((address_space(3)))
typedef unsigned short bf16_t;
typedef short bf16x8 __attribute__((ext_vector_type(8)));
typedef float f32x4 __attribute__((ext_vector_type(4)));
typedef unsigned u32x4 __attribute__((ext_vector_type(4)));
constexpr int BM = 256, BK = 64, HALF = 128, HTB = HALF * BK * 2  , STAGE_BYTES = 8 * HTB, NXCD = 8, WGM = 8;

__host__ __device__ __forceinline__ int lds_byte(int r, int c) { const int st = (r >> 4) * 2 + (c >> 5), rr = r & 15, cc = c & 31, ob = rr * 64 + cc * 2; return st * 1024 + (ob ^ (((ob >> 9) & 1) << 5)); }
__host__ __device__ __forceinline__ void stage_rc(int b, int& R, int& C) { const int st = b / 1024, sb = b % 1024, swz = sb ^ (((sb >> 9) & 1) << 5); R = (st >> 1) * 16 + swz / 64; C = (st & 1) * 32 + (swz % 64) / 2; }
__host__ __device__ __forceinline__ int perm32(int rho) { const int n = rho >> 4, i = rho & 15; return 8 * (i >> 2) + 4 * n + (i & 3); }

struct Unit { int pm, pn, k0, nt; };
struct Gemm { const bf16_t* A; const bf16_t* Bt; int M, N, K; };

struct StaticOrder {
    int nM, nN, nwg, G, c, ntf;
    __host__ __device__ void init(int M, int N, int G_, int c_, int K_ = 1024) { nM = M / BM; nN = N / BM; nwg = nM * nN; G = G_; c = c_; ntf = K_ / BK; }
    __host__ __device__ bool next(int i, Unit& u) const {
        const long L = (long)i * G + c; if (L >= nwg) return false;
        int wgid = (int)L; { const int q = nwg / NXCD, r = nwg % NXCD, xcd = wgid % NXCD, off = wgid / NXCD; wgid = (xcd < r ? xcd * (q + 1) : r * (q + 1) + (xcd - r) * q) + off; }
        const int nig = WGM * nN, gid = wgid / nig, fm = gid * WGM, gsz = (nM - fm) < WGM ? (nM - fm) : WGM;
        u.pm = fm + ((wgid % nig) % gsz); u.pn = (wgid % nig) / gsz; u.k0 = 0; u.nt = ntf; return true;
    }
    __device__ __forceinline__ void a_ready(const Unit&) const {}
    __device__ __forceinline__ void done(const Unit&) const {}
};

struct SplitOrder {
    StaticOrder base; int ppu, c;
    static constexpr int PK = 4;
    __host__ __device__ void init(int K_, int G_, int c_) { base.init(16384, 1024, G_, c_, K_); ppu = (K_ / BK) / PK; c = c_; }
    __host__ __device__ bool next(int i, Unit& u) const {
        if (i == 0) return base.next(0, u);
        if (i == 1 && c < 8 * ppu) { const int j = c / ppu, p = c - j * ppu; u.pm = 64 + (j >> 2); u.pn = j & 3; u.k0 = p * PK; u.nt = PK; return true; }
        return false;
    }
    __device__ __forceinline__ void a_ready(const Unit&) const {}
    __device__ __forceinline__ void done(const Unit&) const {}
};

__device__ __forceinline__ unsigned cvt_pk_bf16(float lo, float hi) { unsigned r; asm volatile("v_cvt_pk_bf16_f32 %0, %1, %2" : "=v"(r) : "v"(lo), "v"(hi)); return r; }
typedef float f32x2 __attribute__((ext_vector_type(2)));
__device__ __forceinline__ f32x2 gelu_pk(f32x2 v) {
    const f32x2 av = __builtin_elementwise_abs(v), d = av * 0.2316418882f + 1.0f;
    f32x2 t; t.x = __builtin_amdgcn_rcpf(d.x); t.y = __builtin_amdgcn_rcpf(d.y);
    f32x2 q = t * 0.5307027145f + (-0.7265760135f); q = q * t + 0.7107068705f; q = q * t + (-0.142248368f); q = q * t + 0.127414796f; q = q * t;
    const f32x2 s = (v * v) * (-0.72134752044f);
    f32x2 e; e.x = __builtin_amdgcn_exp2f(s.x); e.y = __builtin_amdgcn_exp2f(s.y);
    const f32x2 m = v * (q * e), r = v - m;
    f32x2 o; o.x = v.x < 0.f ? m.x : r.x; o.y = v.y < 0.f ? m.y : r.y; return o;
}

template <int ACT  > struct EpiBf16 {
    static constexpr bool PERM = true, AFTER_DRAIN = false; static_assert(ACT == 0 || ACT == 1, "EpiBf16: ACT is 0 (none) or 1 (gelu_pk)");
    bf16_t* O; int ldc; const float* bias; int split_cols; size_t split_stride; float scale0;
    __device__ __forceinline__ void operator()(const f32x4 (&acc)[2][2][4][2], const Unit& u, int wr, int wc, int fr, int fq) const {
        const int row0 = u.pm * BM + wr * 64 + fr; int colt = u.pn * BM; bf16_t* base = O;
        float sc = 1.f; if (split_cols) { const int t = colt / split_cols; base += (size_t)t * split_stride; colt -= t * split_cols; if (t == 0) sc = scale0; }
        const int col0 = colt + wc * 32 + 8 * fq, bcol0 = u.pn * BM + wc * 32 + 8 * fq;
        f32x4 bv[2][2];
#pragma unroll
        for (int bj = 0; bj < 2; ++bj)
#pragma unroll
            for (int n = 0; n < 2; ++n) bv[bj][n] = bias ? *(const f32x4*)(bias + bcol0 + bj * HALF + 4 * n) : (f32x4){0.f, 0.f, 0.f, 0.f};
#pragma unroll
        for (int ai = 0; ai < 2; ++ai)
#pragma unroll
            for (int m = 0; m < 4; ++m) { bf16_t* rowp = base + (size_t)(row0 + ai * HALF + m * 16) * ldc + col0;
#pragma unroll
                for (int bj = 0; bj < 2; ++bj) { f32x4 v0 = acc[ai][bj][m][0] + bv[bj][0], v1 = acc[ai][bj][m][1] + bv[bj][1];
                    if (ACT == 1) { f32x2 a = gelu_pk((f32x2){v0[0], v0[1]}), b = gelu_pk((f32x2){v0[2], v0[3]}), c = gelu_pk((f32x2){v1[0], v1[1]}), d = gelu_pk((f32x2){v1[2], v1[3]});
                        v0 = (f32x4){a.x, a.y, b.x, b.y}; v1 = (f32x4){c.x, c.y, d.x, d.y}; }
                    v0 = v0 * sc; v1 = v1 * sc; u32x4 w; w.x = cvt_pk_bf16(v0[0], v0[1]); w.y = cvt_pk_bf16(v0[2], v0[3]); w.z = cvt_pk_bf16(v1[0], v1[1]); w.w = cvt_pk_bf16(v1[2], v1[3]);
                    *(u32x4*)(rowp + bj * HALF) = w; } }
    }
};
template <class Epi, class Sched, bool ALIGN_EPI = false, bool SP2 = false>
__device__ __forceinline__ void gemm_phase(PG8_LAS unsigned char* lds, const Gemm g, const Sched& S, const Epi& E) {
    int tid_ = threadIdx.x; asm volatile("" : "+v"(tid_));
    const int tid = tid_, wid = __builtin_amdgcn_readfirstlane(tid >> 6), lane = tid & 63, wr = wid >> 2, wc = wid & 3, fr = lane & 15, fq = lane >> 4;
    const int K = g.K;
    unsigned voffA[2], voffB[2];
#pragma unroll
    for (int i = 0; i < 2; ++i) { int R, C; stage_rc(tid * 16 + i * 8192, R, C); const int Rb = Epi::PERM ? ((R & ~31) + perm32(R & 31)) : R;
        voffA[i] = (unsigned)(R * K + C) * 2u; voffB[i] = (unsigned)(Rb * K + C) * 2u; }
    const size_t kstep = (size_t)(BK * 2);
    const size_t hstep = (size_t)HALF * K * 2;
    const size_t tstep = 2 * hstep;
    const unsigned ldsw = (unsigned)wid * 1024u;
    const int aoff = lds_byte(wr * 64 + fr, fq * 8), boff = lds_byte(wc * 32 + fr, fq * 8);
#define PG8_SA(b, h) (((b) * 2 + (h)) * HTB)
#define PG8_SB(b, h) ((4 + (b) * 2 + (h)) * HTB)
#define PG8_STAGE(bufoff, gbase, voff) do { _Pragma("unroll") for (int _i = 0; _i < 2; ++_i) \
        __builtin_amdgcn_global_load_lds((const unsigned*)((const char*)(gbase) + (voff)[_i]), (PG8_LAS unsigned*)(lds + (bufoff) + ldsw + _i * 8192), 16, 0, 0); } while (0)
#define PG8_LDA(dst, b, h) do { _Pragma("unroll") for (int m = 0; m < 4; ++m) _Pragma("unroll") for (int k = 0; k < 2; ++k) dst[m][k] = *(const PG8_LAS bf16x8*)(lds + PG8_SA(b, h) + aoff + m * 2048 + k * 1024); } while (0)
#define PG8_LDB(dst, b, h) do { _Pragma("unroll") for (int n = 0; n < 2; ++n) _Pragma("unroll") for (int k = 0; k < 2; ++k) dst[n][k] = *(const PG8_LAS bf16x8*)(lds + PG8_SB(b, h) + boff + n * 2048 + k * 1024); } while (0)
#define PG8_MMA(ai, bj, At, Bt) do { __builtin_amdgcn_s_setprio(1); _Pragma("unroll") for (int m = 0; m < 4; ++m) _Pragma("unroll") for (int n = 0; n < 2; ++n) _Pragma("unroll") for (int k = 0; k < 2; ++k) \
        acc[ai][bj][m][n] = __builtin_amdgcn_mfma_f32_16x16x32_bf16(Bt[n][k], At[m][k], acc[ai][bj][m][n], 0, 0, 0); __builtin_amdgcn_s_setprio(0); } while (0)
#define PG8_WAIT_V(n) asm volatile("s_waitcnt vmcnt(" #n ")" ::: "memory")
#define PG8_WAIT_L(n) asm volatile("s_waitcnt lgkmcnt(" #n ")" ::: "memory")
#define PG8_BAR __builtin_amdgcn_s_barrier()
#define PG8_SCHED __builtin_amdgcn_sched_barrier(0)
    Unit cur, nxt; int ui = 0;
    if (!S.next(0, cur)) return;
    f32x4 acc[2][2][4][2];
#pragma unroll
    for (int a = 0; a < 2; ++a)
#pragma unroll
        for (int b = 0; b < 2; ++b)
#pragma unroll
            for (int m = 0; m < 4; ++m)
#pragma unroll
                for (int n = 0; n < 2; ++n) acc[a][b][m][n] = (f32x4){0.f, 0.f, 0.f, 0.f};
    bf16x8 At[4][2], B0[2][2], B1[2][2];
    const char* cA = (const char*)g.A + (size_t)cur.pm * tstep + (size_t)cur.k0 * kstep; const char* cB = (const char*)g.Bt + (size_t)cur.pn * tstep + (size_t)cur.k0 * kstep;
    S.a_ready(cur);
    if constexpr (SP2) {
        PG8_STAGE(PG8_SB(0, 0), cB, voffB); PG8_STAGE(PG8_SB(0, 1), cB + hstep, voffB); PG8_STAGE(PG8_SA(0, 0), cA, voffA); PG8_STAGE(PG8_SA(0, 1), cA + hstep, voffA);
        if (wr == 1) PG8_BAR;
        PG8_WAIT_V(2); PG8_BAR;
        PG8_STAGE(PG8_SB(1, 0), cB + kstep, voffB); PG8_STAGE(PG8_SA(1, 0), cA + kstep, voffA); PG8_STAGE(PG8_SB(1, 1), cB + hstep + kstep, voffB);
        PG8_WAIT_V(6); PG8_BAR;
    } else {
        PG8_STAGE(PG8_SB(0, 0), cB, voffB); PG8_STAGE(PG8_SA(0, 0), cA, voffA); PG8_STAGE(PG8_SB(0, 1), cB + hstep, voffB); PG8_STAGE(PG8_SA(0, 1), cA + hstep, voffA);
        if (wr == 1) PG8_BAR;
        PG8_WAIT_V(4); PG8_BAR;
        PG8_STAGE(PG8_SB(1, 0), cB + kstep, voffB); PG8_STAGE(PG8_SA(1, 0), cA + kstep, voffA); PG8_STAGE(PG8_SB(1, 1), cB + hstep + kstep, voffB);
        PG8_WAIT_V(6); PG8_BAR;
    }
    for (;;) {
        const bool has_next = S.next(ui + 1, nxt);
        const char* nA = has_next ? (const char*)g.A + (size_t)nxt.pm * tstep + (size_t)nxt.k0 * kstep : cA; const char* nB = has_next ? (const char*)g.Bt + (size_t)nxt.pn * tstep + (size_t)nxt.k0 * kstep : cB;
        const int nt = cur.nt;
        for (int t = 0; t < nt; t += 2) {
            const bool last = (t == nt - 2);
            const char* a1 = cA + (size_t)(t + 1) * kstep;
            const char* a2 = last ? nA : cA + (size_t)(t + 2) * kstep; const char* b2 = last ? nB : cB + (size_t)(t + 2) * kstep;
            const char* a3 = a2 + kstep; const char* b3 = b2 + kstep;
            if (last && has_next) S.a_ready(nxt);
            if constexpr (SP2) {
            PG8_LDB(B0, 0, 0); PG8_LDB(B1, 0, 1); PG8_SCHED; PG8_LDA(At, 0, 0); PG8_STAGE(PG8_SA(1, 1), a1 + hstep, voffA);
            PG8_WAIT_V(8); PG8_WAIT_L(0); PG8_BAR; PG8_MMA(0, 0, At, B0); PG8_MMA(0, 1, At, B1); PG8_BAR; PG8_SCHED;
            PG8_LDA(At, 0, 1); PG8_STAGE(PG8_SB(0, 0), b2, voffB); PG8_STAGE(PG8_SB(0, 1), b2 + hstep, voffB); PG8_STAGE(PG8_SA(0, 0), a2, voffA);
            PG8_WAIT_V(8); PG8_WAIT_L(0); PG8_BAR; PG8_MMA(1, 0, At, B0); PG8_MMA(1, 1, At, B1); PG8_BAR; PG8_SCHED;
            PG8_LDB(B0, 1, 0); PG8_LDB(B1, 1, 1); PG8_SCHED; PG8_LDA(At, 1, 0); PG8_STAGE(PG8_SA(0, 1), a2 + hstep, voffA);
            PG8_WAIT_V(8); PG8_WAIT_L(0); PG8_BAR; PG8_MMA(0, 0, At, B0); PG8_MMA(0, 1, At, B1); PG8_BAR; PG8_SCHED;
            PG8_LDA(At, 1, 1); PG8_STAGE(PG8_SB(1, 0), b3, voffB); PG8_STAGE(PG8_SB(1, 1), b3 + hstep, voffB); PG8_STAGE(PG8_SA(1, 0), a3, voffA);
            PG8_WAIT_V(8); PG8_WAIT_L(0); PG8_BAR; PG8_MMA(1, 0, At, B0); PG8_MMA(1, 1, At, B1); PG8_BAR; PG8_SCHED;
            } else {
            PG8_LDB(B0, 0, 0); PG8_SCHED; PG8_LDA(At, 0, 0); PG8_STAGE(PG8_SA(1, 1), a1 + hstep, voffA);
            PG8_WAIT_L(8); PG8_BAR; PG8_WAIT_L(0); PG8_MMA(0, 0, At, B0); PG8_BAR; PG8_SCHED;
            PG8_LDB(B1, 0, 1); PG8_STAGE(PG8_SB(0, 0), b2, voffB);
            PG8_BAR; PG8_WAIT_L(0); PG8_MMA(0, 1, At, B1); PG8_BAR;
            PG8_LDA(At, 0, 1); PG8_STAGE(PG8_SA(0, 0), a2, voffA);
            PG8_BAR; PG8_WAIT_L(0); PG8_MMA(1, 0, At, B0); PG8_BAR; PG8_SCHED;
            PG8_STAGE(PG8_SB(0, 1), b2 + hstep, voffB);
            PG8_WAIT_V(6); PG8_BAR; PG8_MMA(1, 1, At, B1); PG8_BAR;
            PG8_LDB(B0, 1, 0); PG8_SCHED; PG8_LDA(At, 1, 0); PG8_STAGE(PG8_SA(0, 1), a2 + hstep, voffA);
            PG8_WAIT_L(8); PG8_BAR; PG8_WAIT_L(0); PG8_MMA(0, 0, At, B0); PG8_BAR; PG8_SCHED;
            PG8_LDB(B1, 1, 1); PG8_STAGE(PG8_SB(1, 0), b3, voffB);
            PG8_BAR; PG8_WAIT_L(0); PG8_MMA(0, 1, At, B1); PG8_BAR;
            PG8_LDA(At, 1, 1); PG8_STAGE(PG8_SA(1, 0), a3, voffA);
            PG8_BAR; PG8_WAIT_L(0); PG8_MMA(1, 0, At, B0); PG8_BAR; PG8_SCHED;
            PG8_STAGE(PG8_SB(1, 1), b3 + hstep, voffB);
            PG8_WAIT_V(6); PG8_BAR; PG8_MMA(1, 1, At, B1); PG8_BAR;
            }
        }
        if constexpr (ALIGN_EPI) { if (wr == 0) PG8_BAR; }
        if constexpr (!Epi::AFTER_DRAIN) { E(acc, cur, wr, wc, fr, fq); S.done(cur); }
        if (!has_next) break;
#pragma unroll
        for (int a = 0; a < 2; ++a)
#pragma unroll
            for (int b = 0; b < 2; ++b)
#pragma unroll
                for (int m = 0; m < 4; ++m)
#pragma unroll
                    for (int n = 0; n < 2; ++n) acc[a][b][m][n] = (f32x4){0.f, 0.f, 0.f, 0.f};
        cur = nxt; cA = nA; cB = nB; ++ui;
        if constexpr (ALIGN_EPI) { if (wr == 1) PG8_BAR; }
    }
    PG8_WAIT_V(0);
    if constexpr (!ALIGN_EPI) { if (wr == 0) PG8_BAR; }
    PG8_BAR;
    if constexpr (Epi::AFTER_DRAIN) { E.fused(acc, cur, wr, wc, fr, fq, lds, wid, lane); S.done(cur); }
#undef PG8_SA
#undef PG8_SB
#undef PG8_STAGE
#undef PG8_LDA
#undef PG8_LDB
#undef PG8_MMA
#undef PG8_WAIT_V
#undef PG8_WAIT_L
#undef PG8_BAR
#undef PG8_SCHED
}
}
#define PG8_SP2 true
#define PG8_ALIGN true

constexpr int D = 1024, TP = 2048, BP = 8, BS = 128, TS = 4;
constexpr int MP = BP * TP, MS = BS * TS, M = MP + MS;
constexpr int DFF = 2816, NWI = 2 * DFF, NIN = 3864, NINP = 4096, NMODC = 9216, NB = BP + BS;
constexpr int SBW = 1664, SFW = 396;
constexpr float LN_EPS = 1e-5f, RMS_EPS = 1e-6f;
constexpr float ALPHA = 1.41421356237f;
constexpr int C_RQ = 0, C_RK = 256, C_RV = 512, C_RG = 768, C_AQ = 1024, C_AK = 1152, C_AV = 1280, C_ALR = 1536, C_AG = 1552,
              C_HQ = 1808, C_HF = 2064, C_HI = 2320, C_HG = 2576, C_DQKV = 2832, C_DB = 3600, C_DA = 3604, C_DG = 3608;
constexpr int SB_RQ = 0, SB_RK = 256, SB_AQ = 512, SB_HQ = 640, SB_DQ = 896, SB_DK = 1152, SB_DV = 1408;
constexpr int SF_ADEC = 0, SF_HF = 128, SF_BETA = 384, SF_DDEC = 388, SF_QK = 392;
constexpr size_t O_Y = 0;
constexpr size_t O_PRET = (size_t)M * D;
constexpr size_t O_PGLA = O_PRET + 2ull * BP * 4 * 64 * 64;
constexpr size_t O_PHG = O_PGLA + 2ull * BP * 4 * 32 * 64;
constexpr size_t O_PGDN = O_PHG + 2ull * BP * 4 * 64 * 64;
constexpr size_t O_PCONV = O_PGDN + 2ull * BP * 4 * 64 * 64;
constexpr size_t O_SRET = O_PCONV + 2ull * BP * 3 * 768;
constexpr size_t O_SGLA = O_SRET + 2ull * BS * 4 * 64 * 64;
constexpr size_t O_SHG = O_SGLA + 2ull * BS * 4 * 32 * 64;
constexpr size_t O_SGDN = O_SHG + 2ull * BS * 4 * 64 * 64;
constexpr size_t O_SCONV = O_SGDN + 2ull * BS * 4 * 64 * 64;
constexpr size_t O_END = O_SCONV + 2ull * BS * 3 * 768;

constexpr size_t MiB = 1u << 20;
constexpr size_t WS_ROPE = 1 * MiB;
constexpr size_t WS_AC = 2 * MiB;
constexpr size_t WS_MOD = 3 * MiB;
constexpr size_t WS_STATS = 2 * MiB + 512 * 1024;
constexpr size_t WS_ID = 2 * MiB + 768 * 1024;
constexpr size_t WS_W = 13 * MiB;
constexpr size_t W_WI1 = 0, W_WO1 = 11 * MiB, W_WI2 = W_WO1 + 5 * MiB + MiB / 2, W_WO2 = W_WI2 + 11 * MiB, W_WIN = W_WO2 + 5 * MiB + MiB / 2, W_WOUT = W_WIN + 8 * MiB, W_LAYER = 43 * MiB;
constexpr size_t WS_H = WS_W + 2 * W_LAYER;
constexpr size_t WS_BIG = WS_H + 33 * MiB;
constexpr size_t WS_SB = WS_BIG + 132 * MiB;
constexpr size_t WS_SF = WS_SB + 54 * MiB;
constexpr size_t WS_END = WS_SF + 26 * MiB;
static_assert((size_t)M * SBW * 2 <= 54 * MiB && (size_t)M * SFW * 4 <= 26 * MiB && (size_t)M * 4096 * 2 <= 132 * MiB && (size_t)M * D * 2 <= 33 * MiB, "ws map");

constexpr int LDS_BYTES = 147456;
constexpr int NWAVES = 8;

#define GAS __attribute__((address_space(1)))
#define LAS __attribute__((address_space(3)))
typedef unsigned short bf16;
typedef unsigned v4u __attribute__((ext_vector_type(4)));
typedef unsigned v2u __attribute__((ext_vector_type(2)));
typedef float f32x4 __attribute__((ext_vector_type(4)));
typedef float f32x2 __attribute__((ext_vector_type(2)));
#define LDS_WAIT() asm volatile("s_waitcnt lgkmcnt(0)" ::: "memory")

__device__ __forceinline__ float bf2f(unsigned b) { return __uint_as_float(b << 16); }
__device__ __forceinline__ float bflo(unsigned w) { return __uint_as_float(w << 16); }
__device__ __forceinline__ float bfhi(unsigned w) { return __uint_as_float(w & 0xffff0000u); }
__device__ __forceinline__ unsigned pk2(float lo, float hi) { return pg8::cvt_pk_bf16(lo, hi); }
__device__ __forceinline__ float sigmoidf_(float x) { return __builtin_amdgcn_rcpf(1.0f + __expf(-x)); }
__device__ __forceinline__ float siluf_(float x) { return x * __builtin_amdgcn_rcpf(1.0f + __expf(-x)); }
__device__ __forceinline__ float wave_sum(float v) {
#pragma unroll
    for (int o = 1; o < 64; o <<= 1) v += __shfl_xor(v, o);
    return v;
}
template <int CTRL> __device__ __forceinline__ float dppmov(float v) { return __int_as_float(__builtin_amdgcn_update_dpp(0, __float_as_int(v), CTRL, 0xf, 0xf, true)); }
__device__ __forceinline__ float quad_sum(float v) { v += dppmov<0xB1>(v); v += dppmov<0x4E>(v); return v; }
__device__ __forceinline__ float row8_sum(float v) { v += dppmov<0xB1>(v); v += dppmov<0x4E>(v); v += dppmov<0x141>(v); return v; }
__device__ __forceinline__ float row16_sum(float v) { v += dppmov<0xB1>(v); v += dppmov<0x4E>(v); v += dppmov<0x141>(v); v += dppmov<0x140>(v); return v; }

struct Args { const float* in[28]; float* out; unsigned char* ws; };

struct Ctx {
    int tid, lane, wave, gw, NGW;
    LAS unsigned char* lds;
    float* out; unsigned char* ws;
};
template <class T> __device__ __forceinline__ T* fresh_ptr(T* p) {
    unsigned lo = (unsigned)(uintptr_t)p, hi = (unsigned)((uintptr_t)p >> 32);
    asm volatile("" : "+v"(lo), "+v"(hi));
    lo = __builtin_amdgcn_readfirstlane(lo); hi = __builtin_amdgcn_readfirstlane(hi);
    return (T*)(__attribute__((address_space(1))) T*)(((uintptr_t)hi << 32) | (uintptr_t)lo);
}
__device__ __forceinline__ Ctx make_ctx(const Args& args, LAS unsigned char* lds) {
    Ctx C; int t = threadIdx.x; asm volatile("" : "+v"(t));
    C.tid = t; C.lane = t & 63; C.wave = __builtin_amdgcn_readfirstlane(t >> 6);
    C.gw = (int)blockIdx.x * NWAVES + C.wave; C.NGW = (int)gridDim.x * NWAVES;
    float* op = fresh_ptr(args.out); unsigned char* wp = fresh_ptr(args.ws);
    C.lds = lds; C.out = op; C.ws = wp; return C;
}
__device__ __forceinline__ int batch_of_row(int r) { return r < MP ? (r >> 11) : BP + ((r - MP) >> 2); }


typedef GAS unsigned gu32;
#define RLX_AGENT __ATOMIC_RELAXED, __HIP_MEMORY_SCOPE_AGENT
#define XB_TMO      128
#define XB_XCNT(j)  (256  + 64 * (j))
#define XB_XSUB(j)  (1280 + 64 * (j))
#define XB_XGEN(j)  (2304 + 64 * (j))
#define XB_TOP      3328
#define XB_TOPGEN   3392
#define XCD_BAR_WORDS 3456
#define XB_SPIN_CAP (1u << 18)

__device__ __forceinline__ unsigned xb_ld(unsigned* p)              { return __hip_atomic_load(p, __ATOMIC_RELAXED, __HIP_MEMORY_SCOPE_AGENT); }
__device__ __forceinline__ unsigned xb_add(unsigned* p, unsigned v) { return __hip_atomic_fetch_add(p, v, __ATOMIC_RELAXED, __HIP_MEMORY_SCOPE_AGENT); }
__device__ __forceinline__ unsigned xb_xcc_id() { return (unsigned)__builtin_amdgcn_s_getreg((3 << 11) | 20) & 0xFu; }
#define XB_SPIN(cond, bar) do { unsigned _sp = 0; while (cond) { __builtin_amdgcn_s_sleep(1); \
    if ((++_sp & 255u) == 0u) { if (xb_ld(&(bar)[XB_TMO])) break; if (_sp > XB_SPIN_CAP) { atomicAdd(&(bar)[XB_TMO], 1u); break; } } } } while (0)

struct XcdBarrier {
    unsigned* bar; unsigned x;
    volatile LAS unsigned* st;
};

__device__ __forceinline__ XcdBarrier xcd_barrier_post(unsigned* bar, volatile LAS unsigned* st) {
    XcdBarrier b; b.bar = bar; b.x = xb_xcc_id(); b.st = st;
    if (threadIdx.x == 0) (void)xb_add(&bar[XB_XCNT(b.x)], 1u);
    return b;
}
__device__ __forceinline__ void xcd_barrier_complete(unsigned* bar, unsigned x, unsigned& nloc, unsigned& nx) {
    const unsigned G = gridDim.x * gridDim.y * gridDim.z;
    unsigned sum, cnt, mine, sp = 0u;
    for (;;) {
        sum = 0u; cnt = 0u; mine = 0u;
#pragma unroll
        for (unsigned j = 0; j < 16; ++j) { const unsigned c = xb_ld(&bar[XB_XCNT(j)]); sum += c; cnt += (c > 0u) ? 1u : 0u; mine = (j == x) ? c : mine; }
        if (sum == G) break;
        __builtin_amdgcn_s_sleep(1);
        if ((++sp & 255u) == 0u) { if (xb_ld(&bar[XB_TMO])) break; if (sp > XB_SPIN_CAP) { atomicAdd(&bar[XB_TMO], 1u); break; } }
    }
    nloc = mine > 0u ? mine : 1u; nx = cnt > 0u ? cnt : 1u;
}

__device__ __forceinline__ void xcd_barrier(const XcdBarrier& b) {
    asm volatile("s_waitcnt vmcnt(0)" ::: "memory");
    __syncthreads();
    if (threadIdx.x == 0) {
        unsigned* bar = b.bar;
        __builtin_amdgcn_s_waitcnt(0);
        unsigned nloc = b.st[0], nx = b.st[1];
        if (nloc == 0u) { xcd_barrier_complete(bar, b.x, nloc, nx); b.st[0] = nloc; b.st[1] = nx; }
        const unsigned old = xb_add(&bar[XB_XSUB(b.x)], 1u);
        const unsigned gen = old / nloc;
        if (old + 1u == (gen + 1u) * nloc) {
            __builtin_amdgcn_fence(__ATOMIC_RELEASE, "agent");
            asm volatile("s_waitcnt vmcnt(0)" ::: "memory");
            const unsigned og = xb_add(&bar[XB_TOP], 1u);
            const unsigned tg = og / nx;
            if (og + 1u == (tg + 1u) * nx) xb_add(&bar[XB_TOPGEN], 1u);
            else XB_SPIN(xb_ld(&bar[XB_TOPGEN]) == tg, bar);
            __builtin_amdgcn_fence(__ATOMIC_ACQUIRE, "agent");
            xb_add(&bar[XB_XGEN(b.x)], 1u);
            asm volatile("s_waitcnt vmcnt(0)" ::: "memory");
        } else {
            XB_SPIN(xb_ld(&bar[XB_XGEN(b.x)]) == gen, bar);
            __builtin_amdgcn_fence(__ATOMIC_ACQUIRE, "agent");
            asm volatile("s_waitcnt vmcnt(0)" ::: "memory");
        }
    }
    __syncthreads();
}

constexpr int MISC_OFF = LDS_BYTES - 256;
__device__ __forceinline__ void grid_bar(const Args& args, LAS unsigned char* lds) {
    XcdBarrier b; b.bar = (unsigned*)fresh_ptr(args.ws); b.x = xb_xcc_id(); b.st = (volatile LAS unsigned*)(lds + MISC_OFF);
    xcd_barrier(b);
}

__device__ __forceinline__ float wave_sum2(float v) { v = row16_sum(v); v += __shfl_xor(v, 16); v += __shfl_xor(v, 32); return v; }

namespace pg8 {
struct EpiSwiglu {
    static constexpr bool PERM = true, AFTER_DRAIN = false;
    bf16_t* O; int ldc;
    __device__ __forceinline__ void operator()(const f32x4 (&acc)[2][2][4][2], const Unit& u, int wr, int wc, int fr, int fq) const {
        const int row0 = u.pm * BM + wr * 64 + fr, col0 = u.pn * 128 + wc * 32 + 8 * fq;
#pragma unroll
        for (int ai = 0; ai < 2; ++ai)
#pragma unroll
            for (int m = 0; m < 4; ++m) {
                bf16_t* rowp = O + (size_t)(row0 + ai * HALF + m * 16) * ldc + col0;
                float h[8];
#pragma unroll
                for (int n = 0; n < 2; ++n)
#pragma unroll
                    for (int j = 0; j < 4; ++j) {
                        const float a = acc[ai][0][m][n][j], b = acc[ai][1][m][n][j];
                        const float e = __builtin_amdgcn_exp2f(-1.44269504f * a);
                        h[n * 4 + j] = a * __builtin_amdgcn_rcpf(1.0f + e) * b;
                    }
                u32x4 w; w.x = cvt_pk_bf16(h[0], h[1]); w.y = cvt_pk_bf16(h[2], h[3]); w.z = cvt_pk_bf16(h[4], h[5]); w.w = cvt_pk_bf16(h[6], h[7]);
                *(u32x4*)rowp = w;
            }
    }
};
struct EpiPlain {
    static constexpr bool PERM = true, AFTER_DRAIN = false;
    bf16_t* O; int ldc;
    __device__ __forceinline__ void operator()(const f32x4 (&acc)[2][2][4][2], const Unit& u, int wr, int wc, int fr, int fq) const {
        const int row0 = u.pm * BM + wr * 64 + fr, col0 = u.pn * BM + wc * 32 + 8 * fq;
#pragma unroll
        for (int ai = 0; ai < 2; ++ai)
#pragma unroll
            for (int m = 0; m < 4; ++m) {
                bf16_t* rowp = O + (size_t)(row0 + ai * HALF + m * 16) * ldc + col0;
#pragma unroll
                for (int bj = 0; bj < 2; ++bj) { const f32x4 v0 = acc[ai][bj][m][0], v1 = acc[ai][bj][m][1];
                    u32x4 w; w.x = cvt_pk_bf16(v0[0], v0[1]); w.y = cvt_pk_bf16(v0[2], v0[3]); w.z = cvt_pk_bf16(v1[0], v1[1]); w.w = cvt_pk_bf16(v1[2], v1[3]);
                    *(u32x4*)(rowp + bj * HALF) = w; }
            }
    }
};
struct EpiRes {
    static constexpr bool PERM = false, AFTER_DRAIN = false;
    float* X; const float* Xr; float* PART; const float* gate; const float* stats; const float* lg; const float* lb; float scale; int ntf;
    __device__ __forceinline__ void operator()(const f32x4 (&acc)[2][2][4][2], const Unit& u, int wr, int wc, int fr, int fq) const {
        const int col0 = u.pn * BM + wc * 32 + 4 * fq;
        const bool full = (u.nt == ntf);
        float* pbase = PART + (size_t)(u.k0 / SplitOrder::PK) * (512 * 1024);
#pragma unroll
        for (int ai = 0; ai < 2; ++ai)
#pragma unroll
            for (int m = 0; m < 4; ++m) {
                const int r = u.pm * BM + ai * HALF + wr * 64 + m * 16 + fr;
                const int bi = r < 16384 ? (r >> 11) : 8 + ((r - 16384) >> 2);
                const float* gp = gate + (size_t)bi * 9216;
                float* xo = full ? X + (size_t)r * 1024 : pbase + (size_t)(r - 16384) * 1024;
                float mean = 0.f, rs = 0.f;
                if (full) { const f32x2 st = *(const f32x2*)(stats + 2 * (size_t)r); mean = st.x; rs = st.y * 1.41421356237f; }
#pragma unroll
                for (int bj = 0; bj < 2; ++bj)
#pragma unroll
                    for (int n = 0; n < 2; ++n) {
                        const int c = col0 + bj * HALF + n * 16;
                        const f32x4 gv = *(const f32x4*)(gp + c);
                        f32x4 o = (gv * scale + scale) * acc[ai][bj][m][n];
                        if (full) { const f32x4 y = *(const f32x4*)(Xr + (size_t)r * 1024 + c), g4 = *(const f32x4*)(lg + c), b4 = *(const f32x4*)(lb + c);
                            o += (y - mean) * rs * g4 + b4 * 1.41421356237f; }
                        *(f32x4*)(xo + c) = o;
                        asm volatile("" ::: "memory");
                    }
            }
    }
};
struct EpiMod {
    static constexpr bool PERM = false, AFTER_DRAIN = false;
    float* MODp; const float* ada_b;
    __device__ __forceinline__ void operator()(const f32x4 (&acc)[2][2][4][2], const Unit& u, int wr, int wc, int fr, int fq) const {
        const int col0 = u.pn * BM + wc * 32 + 4 * fq;
        const int l = (u.pn * BM) / 9216;
#pragma unroll
        for (int ai = 0; ai < 2; ++ai)
#pragma unroll
            for (int m = 0; m < 4; ++m) {
                const int r = u.pm * BM + ai * HALF + wr * 64 + m * 16 + fr;
                if (r < 136) {
#pragma unroll
                    for (int bj = 0; bj < 2; ++bj)
#pragma unroll
                        for (int n = 0; n < 2; ++n) {
                            const int c = col0 + bj * HALF + n * 16;
                            const f32x4 o = acc[ai][bj][m][n] + *(const f32x4*)(ada_b + c);
                            *(f32x4*)(MODp + (size_t)(l * 136 + r) * 9216 + (c - l * 9216)) = o;
                        }
                }
            }
    }
};
}

__device__ __forceinline__ void transpose_item(const float* W, int K, int N, bf16* WT, int dest_row0, LAS float* scr, int k0, int n0, int lane) {
    const int nn = n0 + (lane & 31); const bool ok = nn < N;
    float tv[32];
#pragma unroll
    for (int i = 0; i < 32; ++i) { const int kk = 2 * i + (lane >> 5); tv[i] = ok ? W[(size_t)(k0 + kk) * N + nn] : 0.f; }
#pragma unroll
    for (int i = 0; i < 32; ++i) { const int kk = 2 * i + (lane >> 5); scr[kk * 33 + (lane & 31)] = tv[i]; }
    LDS_WAIT();
    const int c = lane & 7;
#pragma unroll
    for (int j = 0; j < 4; ++j) { const int n = (lane >> 3) + 8 * j; const LAS float* s = scr + (8 * c) * 33 + n;
        v4u o; o.x = pk2(s[0 * 33], s[1 * 33]); o.y = pk2(s[2 * 33], s[3 * 33]); o.z = pk2(s[4 * 33], s[5 * 33]); o.w = pk2(s[6 * 33], s[7 * 33]);
        *(v4u*)(WT + (size_t)(dest_row0 + n) * K + k0 + 8 * c) = o; }
    LDS_WAIT();
}

constexpr int I_WI = 16 * 176, I_WO = 44 * 32, I_WIN = 16 * 121, I_WOUT = 16 * 32, I_ADA = 16 * 288;
constexpr int I_MAIN = 2 * I_WI + 2 * I_WO + I_WIN + I_WOUT, I_LAYER = I_MAIN + I_ADA;
__device__ __forceinline__ void convert_item(const Args& args, unsigned char* ws, int l, int r, LAS float* scr, int lane) {
    unsigned char* wl = ws + WS_W + (size_t)l * W_LAYER;
    if (r < 2 * (I_WI + I_WO)) {
        const int f = r / (I_WI + I_WO); r -= f * (I_WI + I_WO);
        if (r < I_WI) {
            const int kb = r / 176, nb = r % 176, n0 = nb * 32;
            const int half = n0 / DFF, j = n0 - half * DFF, t = j >> 7, jj = j & 127;
            transpose_item((f ? args.in[15] : args.in[13]) + (size_t)l * D * NWI, D, NWI, (bf16*)(wl + (f ? W_WI2 : W_WI1)), 256 * t + 128 * half + jj, scr, kb * 64, n0, lane);
        } else { r -= I_WI;
            const int kb = r / 32, nb = r % 32;
            transpose_item((f ? args.in[16] : args.in[14]) + (size_t)l * DFF * D, DFF, D, (bf16*)(wl + (f ? W_WO2 : W_WO1)), nb * 32, scr, kb * 64, nb * 32, lane);
        }
        return;
    }
    r -= 2 * (I_WI + I_WO);
    if (r < I_WIN) { const int kb = r / 121, nb = r % 121;
        transpose_item(args.in[17] + (size_t)l * D * NIN, D, NIN, (bf16*)(wl + W_WIN), nb * 32, scr, kb * 64, nb * 32, lane); return; }
    r -= I_WIN;
    if (r < I_WOUT) { const int kb = r / 32, nb = r % 32;
        transpose_item(args.in[27] + (size_t)l * D * D, D, D, (bf16*)(wl + W_WOUT), nb * 32, scr, kb * 64, nb * 32, lane); return; }
    r -= I_WOUT;
    { const int kb = r / 288, nb = r % 288;
        transpose_item(args.in[9] + (size_t)l * D * NMODC, D, NMODC, (bf16*)(ws + WS_BIG), l * NMODC + nb * 32, scr, kb * 64, nb * 32, lane); }
}

__device__ __forceinline__ void p0_prologue(const Args& args, LAS unsigned char* lds_) {
    const Ctx C = make_ctx(args, lds_);
    LAS float* scr = (LAS float*)(C.lds + C.wave * 16384);
    for (int it = C.gw; it < 2 * I_ADA; it += C.NGW) convert_item(args, C.ws, it / I_ADA, I_MAIN + it % I_ADA, scr, C.lane);
    const int gt = C.gw * 64 + C.lane, NGT = C.NGW * 64;
    for (int i = gt; i < 2 * 224 * 128; i += NGT) { const int l = i / (224 * 128), rr = (i / 128) % 224, ch = i & 127;
        *(v4u*)(C.ws + WS_W + (size_t)l * W_LAYER + W_WIN + ((size_t)(3872 + rr) * 1024 + ch * 8) * 2) = (v4u){0u, 0u, 0u, 0u}; }
    for (int i = gt; i < 2048; i += NGT) ((float*)(C.ws + WS_ID))[i] = i < 1024 ? 1.0f : 0.f;
    for (int i = gt; i < 256 * 256; i += NGT) { const int row = i >> 8, c4 = (i & 255) * 4;
        v2u o = (v2u){0u, 0u};
        if (row < NB) { const float* src = row < BP ? args.in[7] + (size_t)row * D : args.in[8] + (size_t)(row - BP) * D; const f32x4 v = *(const f32x4*)(src + c4);
            o.x = pk2(siluf_(v.x), siluf_(v.y)); o.y = pk2(siluf_(v.z), siluf_(v.w)); }
        *(v2u*)(C.ws + WS_AC + ((size_t)row * D + c4) * 2) = o; }
    for (int i = gt; i < 2052 * 32; i += NGT) { const int p = i >> 5, j = i & 31; const double pos = p < 2048 ? (double)p : (double)(16384 + (p - 2048));
        double inv = 1.0; for (int q = 0; q < j; ++q) inv *= 0.7498942093324559;
        const double ang = pos * inv; const double n = rint(ang * 0.15915494309189535);
        const float rr = (float)((ang - n * 6.283185307179586) - n * 2.4492935982947064e-16);
        ((f32x2*)(C.ws + WS_ROPE))[i] = (f32x2){__cosf(rr), __sinf(rr)}; }
}

__device__ __forceinline__ void p1_convert(const Args& args, LAS unsigned char* lds_) {
    const Ctx C = make_ctx(args, lds_);
    if ((int)blockIdx.x < 72) return;
    LAS float* scr = (LAS float*)(C.lds + C.wave * 16384);
    constexpr int I_F0 = I_WI + I_WO, I_P0 = I_F0 + I_WIN;
    for (int it = ((int)blockIdx.x - 72) * NWAVES + C.wave; it < I_P0; it += 184 * NWAVES) {
        if (it < I_F0) convert_item(args, C.ws, 0, it, scr, C.lane);
        else convert_item(args, C.ws, 0, 2 * I_F0 + (it - I_F0), scr, C.lane);
    }
}

__device__ __forceinline__ void p2_modulate0(const Args& args, LAS unsigned char* lds_) {
    const Ctx C = make_ctx(args, lds_);
    const float* MOD = (const float*)(C.ws + WS_MOD); bf16* H = (bf16*)(C.ws + WS_H);
    auto rowp = [&](int r) { return r < MP ? args.in[0] + (size_t)r * D : args.in[1] + (size_t)(r - MP) * D; };
    f32x4 nx[4], nsh[4], nsc[4];
    auto ld = [&](int r) { const float* xr = rowp(r); const float* modr = MOD + (size_t)batch_of_row(r) * NMODC;
#pragma unroll
        for (int j = 0; j < 4; ++j) { const int c = (C.lane + 64 * j) * 4; nx[j] = *(const f32x4*)(xr + c); nsh[j] = *(const f32x4*)(modr + c); nsc[j] = *(const f32x4*)(modr + 1024 + c); } };
    if (C.gw < M) ld(C.gw);
#pragma unroll 1
    for (int r = C.gw; r < M; r += C.NGW) {
        f32x4 v[4], sh[4], sc[4];
#pragma unroll
        for (int j = 0; j < 4; ++j) { v[j] = nx[j]; sh[j] = nsh[j]; sc[j] = nsc[j]; }
        if (r + C.NGW < M) ld(r + C.NGW);
        if (C.lane == 0) *(f32x2*)((float*)(C.ws + WS_STATS) + 2 * (size_t)r) = (f32x2){0.f, 1.0f};
#pragma unroll
        for (int j = 0; j < 4; ++j) { const int c = (C.lane + 64 * j) * 4;
            const f32x4 h = v[j] * (sc[j] + 1.0f) + sh[j];
            if (r >= MP) *(f32x4*)(C.out + (size_t)r * D + c) = v[j] * ALPHA;
            *(v2u*)(H + (size_t)r * D + c) = (v2u){pk2(h.x, h.y), pk2(h.z, h.w)}; }
    }
}

__device__ __forceinline__ void ln_phase(const Args& args, LAS unsigned char* lds_, int l, int which, bool write_h, int hl, int shc, int npart, float xscale, bool write_x) {
    const Ctx C = make_ctx(args, lds_);
    const float* MOD = (const float*)(C.ws + WS_MOD); bf16* H = (bf16*)(C.ws + WS_H);
    const float* g = args.in[11] + (size_t)(l * 3 + which) * D; const float* b = args.in[12] + (size_t)(l * 3 + which) * D;
    f32x4 nv[4], gg[4], bb[4];
#pragma unroll
    for (int j = 0; j < 4; ++j) { gg[j] = *(const f32x4*)(g + (C.lane + 64 * j) * 4); bb[j] = *(const f32x4*)(b + (C.lane + 64 * j) * 4); }
    if (C.gw < M) {
#pragma unroll
        for (int j = 0; j < 4; ++j) nv[j] = *(const f32x4*)(C.out + (size_t)C.gw * D + (C.lane + 64 * j) * 4); }
#pragma unroll 1
    for (int r = C.gw; r < M; r += C.NGW) {
        float* xr = C.out + (size_t)r * D;
        f32x4 v[4]; float s = 0.f;
        const float* modr = MOD + (size_t)(hl * NB + batch_of_row(r)) * NMODC + shc * 1024;
        f32x4 msh[4], msc[4];
        if (write_h) {
#pragma unroll
            for (int j = 0; j < 4; ++j) { msh[j] = *(const f32x4*)(modr + (C.lane + 64 * j) * 4); msc[j] = *(const f32x4*)(modr + 1024 + (C.lane + 64 * j) * 4); } }
#pragma unroll
        for (int j = 0; j < 4; ++j) v[j] = nv[j];
        if (r + C.NGW < M) {
#pragma unroll
            for (int j = 0; j < 4; ++j) nv[j] = *(const f32x4*)(xr + (size_t)C.NGW * D + (C.lane + 64 * j) * 4); }
        if (r >= MP) { const float* pp = (const float*)(C.ws + WS_SB) + (size_t)(r - MP) * D;
#pragma unroll 1
            for (int p = 0; p < npart; ++p, pp += 512 * 1024) {
#pragma unroll
                for (int j = 0; j < 4; ++j) v[j] += *(const f32x4*)(pp + (C.lane + 64 * j) * 4); } }
#pragma unroll
        for (int j = 0; j < 4; ++j) s += (v[j].x + v[j].y) + (v[j].z + v[j].w);
        const float mean = wave_sum2(s) * (1.f / D); float s2 = 0.f;
#pragma unroll
        for (int j = 0; j < 4; ++j) { v[j] = v[j] - mean; s2 += (v[j].x * v[j].x + v[j].y * v[j].y) + (v[j].z * v[j].z + v[j].w * v[j].w); }
        const float rstd = rsqrtf(wave_sum2(s2) * (1.f / D) + LN_EPS);
        if (C.lane == 0) *(f32x2*)((float*)(C.ws + WS_STATS) + 2 * (size_t)r) = (f32x2){mean, rstd};
#pragma unroll
        for (int j = 0; j < 4; ++j) { const int c = (C.lane + 64 * j) * 4;
            const f32x4 xn = v[j] * rstd * gg[j] + bb[j];
            if (write_x || r >= MP) *(f32x4*)(xr + c) = xn * xscale;
            if (write_h) { const f32x4 sh = msh[j], sc = msc[j]; const f32x4 h = xn * (sc + 1.0f) + sh;
                *(v2u*)(H + (size_t)r * D + c) = (v2u){pk2(h.x, h.y), pk2(h.z, h.w)}; }
        }
    }
}

struct PrepRaw { unsigned short rq1[4], rq2[4], rk1[4], rk2[4], aq[2], hf[4], hq[4], dx[12], db, da; v4u alr0, alr1; };
__device__ __forceinline__ void prep_load(PrepRaw& x, const bf16* P, int lane) {
    const int j = lane & 31;
#pragma unroll
    for (int h = 0; h < 4; ++h) { x.rq1[h] = P[C_RQ + h * 64 + j]; x.rq2[h] = P[C_RQ + h * 64 + 32 + j]; x.rk1[h] = P[C_RK + h * 64 + j]; x.rk2[h] = P[C_RK + h * 64 + 32 + j]; }
    x.alr0 = *(const v4u*)(P + C_ALR); x.alr1 = *(const v4u*)(P + C_ALR + 8);
#pragma unroll
    for (int i = 0; i < 2; ++i) x.aq[i] = P[C_AQ + lane + 64 * i];
#pragma unroll
    for (int i = 0; i < 4; ++i) { x.hf[i] = P[C_HF + lane + 64 * i]; x.hq[i] = P[C_HQ + lane + 64 * i]; }
#pragma unroll
    for (int i = 0; i < 12; ++i) x.dx[i] = P[C_DQKV + lane + 64 * i];
    x.db = P[C_DB + (lane & 3)]; x.da = P[C_DA + (lane & 3)];
}

__device__ __forceinline__ void prep_phase(const Args& args, LAS unsigned char* lds_, int l) {
    const Ctx C = make_ctx(args, lds_);
    const bf16* PROJ = (const bf16*)(C.ws + WS_BIG); bf16* SB = (bf16*)(C.ws + WS_SB); float* SF = (float*)(C.ws + WS_SF);
    const f32x2* ROPE = (const f32x2*)(C.ws + WS_ROPE);
    const int lane = C.lane;
    const float* wg = args.in[18] + (size_t)l * 16 * 128; const float* bg = args.in[19] + (size_t)l * 128;
    const float* cw = args.in[21] + (size_t)l * 4 * 768;
    LAS float* lwg = (LAS float*)C.lds; LAS float* lcw = lwg + 16 * 128;
    for (int i = C.tid; i < 16 * 128; i += NWAVES * 64) lwg[i] = wg[i];
    for (int i = C.tid; i < 4 * 768; i += NWAVES * 64) lcw[i] = cw[i];
    __syncthreads();
    constexpr int CH = 9;
    const int r0 = C.gw * CH, r1 = min(r0 + CH, M);
    if (r0 >= M) return;
    float lbv[4];
#pragma unroll
    for (int i = 0; i < 4; ++i) { lbv[i] = 0.f; if (l == 1) lbv[i] = 1.0f / (1.0f + expf(args.in[20][lane + 64 * i] - args.in[20][256 + lane + 64 * i])); }
    const float a_neg = -expf(args.in[22][l * 4 + (lane & 3)]), dtb = args.in[23][l * 4 + (lane & 3)];
    const float bg0 = bg[lane], bg1 = bg[lane + 64];
    float w1[12], w2[12], w3[12];
    auto load_window = [&](int r) {
        const bool isp = r < MP; const int rs = r - MP; const int b = isp ? (r >> 11) : (rs >> 2), t = isp ? (r & 2047) : (rs & 3);
        const float* cst = args.in[6] + ((size_t)(l * BS + b) * 3) * 768;
#pragma unroll
        for (int i = 0; i < 12; ++i) { const int ch = lane + 64 * i; const bf16* Pc = PROJ + (size_t)r * NINP + C_DQKV + ch;
            w1[i] = t >= 1 ? bf2f(Pc[-1 * NINP]) : (isp ? 0.f : cst[2 * 768 + ch]);
            w2[i] = t >= 2 ? bf2f(Pc[-2 * NINP]) : (isp ? 0.f : cst[(1 + t) * 768 + ch]);
            w3[i] = t >= 3 ? bf2f(Pc[-3 * NINP]) : (isp ? 0.f : cst[t * 768 + ch]); }
    };
    PrepRaw A; prep_load(A, PROJ + (size_t)r0 * NINP, lane);
    load_window(r0);
#pragma unroll 1
    for (int r = r0; r < r1; ++r) {
        PrepRaw B = A;
        if (r + 1 < r1) prep_load(B, PROJ + (size_t)(r + 1) * NINP, lane);
        int zo = 0; asm volatile("" : "+v"(zo));
        const bool isp = r < MP; const int rs = r - MP;
        const int b = isp ? (r >> 11) : (rs >> 2), t = isp ? (r & 2047) : (rs & 3);
        const int ridx = isp ? t : 2048 + t;
        bf16* sb = SB + (size_t)r * SBW; float* sf = SF + (size_t)r * SFW;
        { const int j = lane & 31; const bool hi = lane >= 32; const f32x2 cs = ROPE[ridx * 32 + j];
#pragma unroll
          for (int h = 0; h < 4; ++h) {
              const float q1 = bf2f(A.rq1[h]), q2 = bf2f(A.rq2[h]), k1 = bf2f(A.rk1[h]), k2 = bf2f(A.rk2[h]);
              const float qo = hi ? (q1 * cs.y + q2 * cs.x) : (q1 * cs.x - q2 * cs.y);
              const float ko = hi ? (k1 * cs.y + k2 * cs.x) : (k1 * cs.x - k2 * cs.y);
              sb[SB_RQ + h * 64 + lane] = (bf16)(pk2(qo, 0.f) & 0xffffu);
              sb[SB_RK + h * 64 + lane] = (bf16)(pk2(ko * 0.125f, 0.f) & 0xffffu);
          } }
        { const unsigned aw[8] = {A.alr0.x, A.alr0.y, A.alr0.z, A.alr0.w, A.alr1.x, A.alr1.y, A.alr1.z, A.alr1.w};
          float x0 = bg0, x1 = bg1;
#pragma unroll
          for (int i = 0; i < 8; ++i) { const float a0 = bflo(aw[i]), a1 = bfhi(aw[i]);
              x0 += a0 * lwg[(2 * i) * 128 + lane + zo] + a1 * lwg[(2 * i + 1) * 128 + lane + zo];
              x1 += a0 * lwg[(2 * i) * 128 + lane + 64 + zo] + a1 * lwg[(2 * i + 1) * 128 + lane + 64 + zo]; }
          const float sp0 = fmaxf(-x0, 0.f) + __logf(1.0f + __expf(-fabsf(x0))), sp1 = fmaxf(-x1, 0.f) + __logf(1.0f + __expf(-fabsf(x1)));
          sf[SF_ADEC + lane] = __expf(-sp0 * (1.0f / 16.0f)); sf[SF_ADEC + lane + 64] = __expf(-sp1 * (1.0f / 16.0f));
          sb[SB_AQ + lane] = (bf16)(pk2(bf2f(A.aq[0]) * 0.17677669529663687f, 0.f) & 0xffffu);
          sb[SB_AQ + lane + 64] = (bf16)(pk2(bf2f(A.aq[1]) * 0.17677669529663687f, 0.f) & 0xffffu); }
#pragma unroll
        for (int i = 0; i < 4; ++i) { const int c = lane + 64 * i;
            sf[SF_HF + c] = lbv[i] + (1.0f - lbv[i]) * sigmoidf_(bf2f(A.hf[i]));
            sb[SB_HQ + c] = (bf16)(pk2(siluf_(bf2f(A.hq[i])) * 0.125f, 0.f) & 0xffffu); }
        { float* cso = isp ? C.out + O_PCONV + ((size_t)(l * BP + b) * 3) * 768 : C.out + O_SCONV + ((size_t)(l * BS + b) * 3) * 768;
          const int so = isp ? t - (TP - 3) : t - 1;
          float uu[12];
#pragma unroll
          for (int i = 0; i < 12; ++i) { const float x0 = bf2f(A.dx[i]);
              const LAS float* cwc = lcw + lane + 64 * i + zo;
              uu[i] = siluf_(x0 * cwc[3 * 768] + w1[i] * cwc[2 * 768] + w2[i] * cwc[768] + w3[i] * cwc[0]);
              if (so >= 0) cso[so * 768 + lane + 64 * i] = x0;
              w3[i] = w2[i]; w2[i] = w1[i]; w1[i] = x0; }
float qr[4];
#pragma unroll
          for (int i = 0; i < 12; ++i) { float sc = 1.0f;
              if (i < 8) { const float nn = wave_sum2(uu[i] * uu[i]); sc = rsqrtf(nn + RMS_EPS) * (i < 4 ? 0.125f : 1.0f); }
              const unsigned wbits = pk2(uu[i] * sc, 0.f) & 0xffffu;
              sb[SB_DQ + i * 64 + lane] = (bf16)wbits;
              if (i < 4) qr[i] = bf2f(wbits);
              else if (i < 8) { const float qk = wave_sum2(qr[i - 4] * bf2f(wbits)); if (lane == 0) sf[SF_QK + (i - 4)] = qk; } }
          if (lane < 4) { sf[SF_BETA + lane] = sigmoidf_(bf2f(A.db));
              const float xx = bf2f(A.da) + dtb; const float sp = fmaxf(xx, 0.f) + __logf(1.0f + __expf(-fabsf(xx)));
              sf[SF_DDEC + lane] = __expf(a_neg * sp); } }
        A = B;
        if (r + 1 < r1) { const int rn = r + 1; const bool ns = rn < MP ? ((rn & 2047) == 0) : (((rn - MP) & 3) == 0); if (ns) load_window(rn); }
    }
}

template <int KIND, int DH, int R> struct Raw { unsigned q[DH / 2]; unsigned k[DH / 2]; unsigned v[(R + 1) / 2]; float f[DH]; float be, de; };

template <int KIND, int DH, int R>
__device__ __forceinline__ void load_tok(Raw<KIND, DH, R>& x, const bf16* qp, const bf16* kp, const bf16* vp, const float* fp) {
    if constexpr (DH == 4) { const v2u w = *(const v2u*)qp; x.q[0] = w.x; x.q[1] = w.y; } else { x.q[0] = *(const unsigned*)qp; }
    if constexpr (KIND != 2) { if constexpr (DH == 4) { const v2u w = *(const v2u*)kp; x.k[0] = w.x; x.k[1] = w.y; } else { x.k[0] = *(const unsigned*)kp; } }
    if constexpr (R == 1) x.v[0] = *vp; else if constexpr (R == 2) x.v[0] = *(const unsigned*)vp; else { const v2u w = *(const v2u*)vp; x.v[0] = w.x; x.v[1] = w.y; }
    if constexpr (KIND == 1) { const f32x2 w = *(const f32x2*)fp; x.f[0] = w.x; x.f[1] = w.y; }
    if constexpr (KIND == 2) { const f32x4 w = *(const f32x4*)fp; x.f[0] = w.x; x.f[1] = w.y; x.f[2] = w.z; x.f[3] = w.w; }
    if constexpr (KIND == 3) { x.be = fp[0]; x.de = fp[4]; }
}

template <int KIND, int DH, int R>
__device__ __forceinline__ void scan_task(const Ctx& C, int row0, int T, int h, int slice, const float* sin, float* sout) {
    const bf16* PROJ = (const bf16*)(C.ws + WS_BIG); const bf16* SB = (const bf16*)(C.ws + WS_SB); const float* SF = (const float*)(C.ws + WS_SF);
    bf16* H = (bf16*)(C.ws + WS_H);
    const int lane = C.lane, dl = lane & 15, rw = lane >> 4;
    const int d0 = dl * DH, v0 = slice * (4 * R) + rw * R;
    constexpr int DK = 16 * DH;
    const bf16 *qp, *kp, *vp; const float* fp; int ks, vs;
    const bf16* sbr = SB + (size_t)row0 * SBW; const bf16* pr = PROJ + (size_t)row0 * NINP; const float* sfr = SF + (size_t)row0 * SFW;
    if constexpr (KIND == 0) { qp = sbr + SB_RQ + h * 64 + d0; kp = sbr + SB_RK + h * 64 + d0; ks = SBW; vp = pr + C_RV + h * 64 + v0; vs = NINP; fp = sfr; }
    if constexpr (KIND == 1) { qp = sbr + SB_AQ + h * 32 + d0; kp = pr + C_AK + h * 32 + d0; ks = NINP; vp = pr + C_AV + h * 64 + v0; vs = NINP; fp = sfr + SF_ADEC + h * 32 + d0; }
    if constexpr (KIND == 2) { qp = sbr + SB_HQ + h * 64 + d0; kp = sbr; ks = SBW; vp = pr + C_HI + h * 64 + v0; vs = NINP; fp = sfr + SF_HF + h * 64 + d0; }
    if constexpr (KIND == 3) { qp = sbr + SB_DQ + h * 64 + d0; kp = sbr + SB_DK + h * 64 + d0; ks = SBW; vp = sbr + SB_DV + h * 64 + v0; vs = SBW; fp = sfr + SF_BETA + h; }
    bf16* op = H + (size_t)row0 * D + KIND * 256 + h * 64 + v0;
    const float rdec = 1.0f - exp2f(-5.0f - (float)h);

    float S[DH][R];
#pragma unroll
    for (int dh = 0; dh < DH; ++dh)
#pragma unroll
        for (int vv = 0; vv < R; ++vv) S[dh][vv] = sin ? sin[(size_t)(d0 + dh) * 64 + v0 + vv] : 0.f;

    typedef Raw<KIND, DH, R> RawT;
    RawT A[4];
#pragma unroll
    for (int u = 0; u < 4; ++u) load_tok<KIND, DH, R>(A[u], qp + (size_t)u * SBW, kp + (size_t)u * ks, vp + (size_t)u * vs, fp + (size_t)u * SFW);
    for (int t0 = 0; t0 < T; t0 += 4) {
        RawT B[4];
        const bool more = t0 + 4 < T;
#pragma unroll
        for (int u = 0; u < 4; ++u) { B[u] = A[u]; }
        if (more) {
#pragma unroll
            for (int u = 0; u < 4; ++u) load_tok<KIND, DH, R>(B[u], qp + (size_t)(t0 + 4 + u) * SBW, kp + (size_t)(t0 + 4 + u) * ks, vp + (size_t)(t0 + 4 + u) * vs, fp + (size_t)(t0 + 4 + u) * SFW);
        }
#pragma unroll
        for (int u = 0; u < 4; ++u) {
            const RawT& x = A[u];
            float q[DH], k[DH], v[R];
            q[0] = bflo(x.q[0]); q[1] = bfhi(x.q[0]); if constexpr (DH == 4) { q[2] = bflo(x.q[1]); q[3] = bfhi(x.q[1]); }
            if constexpr (KIND != 2) { k[0] = bflo(x.k[0]); k[1] = bfhi(x.k[0]); if constexpr (DH == 4) { k[2] = bflo(x.k[1]); k[3] = bfhi(x.k[1]); } }
            if constexpr (R == 1) v[0] = bflo(x.v[0]);
            if constexpr (R >= 2) { v[0] = bflo(x.v[0]); v[1] = bfhi(x.v[0]); }
            if constexpr (R == 4) { v[2] = bflo(x.v[1]); v[3] = bfhi(x.v[1]); }
            float o[R];
            if constexpr (KIND == 3) {
                float ks_[R];
#pragma unroll
                for (int vv = 0; vv < R; ++vv) { float p = 0.f;
#pragma unroll
                    for (int dh = 0; dh < DH; ++dh) { S[dh][vv] *= x.de; p += k[dh] * S[dh][vv]; }
                    ks_[vv] = row16_sum(p); }
#pragma unroll
                for (int vv = 0; vv < R; ++vv) { const float uu = x.be * (v[vv] - ks_[vv]); float p = 0.f;
#pragma unroll
                    for (int dh = 0; dh < DH; ++dh) { S[dh][vv] += k[dh] * uu; p += q[dh] * S[dh][vv]; }
                    o[vv] = row16_sum(p); }
            } else {
#pragma unroll
                for (int dh = 0; dh < DH; ++dh) {
                    float dec, kk;
                    if constexpr (KIND == 0) { dec = rdec; kk = k[dh]; }
                    if constexpr (KIND == 1) { dec = x.f[dh]; kk = k[dh]; }
                    if constexpr (KIND == 2) { dec = x.f[dh]; kk = 1.0f - x.f[dh]; }
#pragma unroll
                    for (int vv = 0; vv < R; ++vv) S[dh][vv] = dec * S[dh][vv] + kk * v[vv];
                }
#pragma unroll
                for (int vv = 0; vv < R; ++vv) { float p = 0.f;
#pragma unroll
                    for (int dh = 0; dh < DH; ++dh) p += q[dh] * S[dh][vv];
                    o[vv] = row16_sum(p); }
            }
            if (dl == 0) {
                bf16* o_ = op + (size_t)(t0 + u) * D;
                if constexpr (R == 1) *o_ = (bf16)(pk2(o[0], 0.f) & 0xffffu);
                if constexpr (R == 2) *(unsigned*)o_ = pk2(o[0], o[1]);
                if constexpr (R == 4) *(v2u*)o_ = (v2u){pk2(o[0], o[1]), pk2(o[2], o[3])};
            }
        }
#pragma unroll
        for (int u = 0; u < 4; ++u) A[u] = B[u];
    }
#pragma unroll
    for (int dh = 0; dh < DH; ++dh)
#pragma unroll
        for (int vv = 0; vv < R; ++vv) sout[(size_t)(d0 + dh) * 64 + v0 + vv] = S[dh][vv];
    (void)DK;
}

template <int KIND, int DH, int R>
__device__ __forceinline__ void scan_long(const Ctx& C, LAS float* wl, int row0, int T, int h, int slice, float* sout) {
    constexpr int CT = 16, LR = 8, DK = LR * DH, NV = (64 / LR) * R, UNR = 8;
    constexpr bool HASK = true, GK = (KIND != 2), HASF = (KIND == 1 || KIND == 2), HASB = (KIND == 3);
    constexpr int OQ = 0, OK_ = OQ + CT * DK, OF = OK_ + (HASK ? CT * DK : 0), OV = OF + (HASF ? CT * DK : 0), OB = OV + CT * NV, BUF = OB + (HASB ? CT * 4 : 0);
    const bf16* PROJ = (const bf16*)(C.ws + WS_BIG); const bf16* SB = (const bf16*)(C.ws + WS_SB); const float* SF = (const float*)(C.ws + WS_SF);
    bf16* H = (bf16*)(C.ws + WS_H);
    const int lane = C.lane, dl = lane & (LR - 1), rw = lane / LR;
    const int d0 = dl * DH;
    const int stok = lane >> 2, spart = lane & 3;
    const GAS bf16 *qg, *kg, *vg; const GAS float *fg, *bg; int ks, vs;
    {
        const GAS bf16* sbr = (const GAS bf16*)(SB + (size_t)row0 * SBW); const GAS bf16* pr = (const GAS bf16*)(PROJ + (size_t)row0 * NINP); const GAS float* sfr = (const GAS float*)(SF + (size_t)row0 * SFW);
        const int vcol = slice * NV;
        if constexpr (KIND == 0) { qg = sbr + SB_RQ + h * 64; kg = sbr + SB_RK + h * 64; ks = SBW; vg = pr + C_RV + h * 64 + vcol; vs = NINP; fg = sfr; bg = sfr; }
        if constexpr (KIND == 1) { qg = sbr + SB_AQ + h * 32; kg = pr + C_AK + h * 32; ks = NINP; vg = pr + C_AV + h * 64 + vcol; vs = NINP; fg = sfr + SF_ADEC + h * 32; bg = sfr; }
        if constexpr (KIND == 2) { qg = sbr + SB_HQ + h * 64; kg = sbr; ks = SBW; vg = pr + C_HI + h * 64 + vcol; vs = NINP; fg = sfr + SF_HF + h * 64; bg = sfr; }
        if constexpr (KIND == 3) { qg = sbr + SB_DQ + h * 64; kg = sbr + SB_DK + h * 64; ks = SBW; vg = sbr + SB_DV + h * 64 + vcol; vs = SBW; fg = sfr; bg = sfr + SF_BETA + h; }
    }
    constexpr int QP = DK / 4;
    qg += (size_t)stok * SBW + spart * QP; kg += (size_t)stok * ks + spart * QP; fg += (size_t)stok * SFW + spart * QP;
    vg += (size_t)(lane & 15) * vs; bg += (size_t)(lane & 15) * SFW;
    GAS bf16* op = (GAS bf16*)(H + (size_t)row0 * D + KIND * 256 + h * 64 + slice * NV + rw * R);
    const float rdec = 1.0f - exp2f(-5.0f - (float)h);

    static_assert(R == 1, "scan_long: one column per lane row");
    f32x2 S2[DH / 2];
#pragma unroll
    for (int i = 0; i < DH / 2; ++i) S2[i] = (f32x2){0.f, 0.f};

    struct SR { v4u rq[QP / 8], rk[QP / 8]; f32x4 rf[QP / 4]; unsigned rv[NV / 2]; float rb0, rb1, rb2; };
    SR s0; s0.rb0 = s0.rb1 = s0.rb2 = 0.f;
    auto stage_load = [&](SR& sr, int c) {
        const size_t t = (size_t)c * CT;
#pragma unroll
        for (int i = 0; i < QP / 8; ++i) { sr.rq[i] = *(const GAS v4u*)(qg + t * SBW + i * 8); if constexpr (GK) sr.rk[i] = *(const GAS v4u*)(kg + t * ks + i * 8); }
        if constexpr (HASF) {
#pragma unroll
            for (int i = 0; i < QP / 4; ++i) sr.rf[i] = *(const GAS f32x4*)(fg + t * SFW + i * 4); }
        if (lane < 16) {
            if constexpr (NV == 4) { const v2u w = *(const GAS v2u*)(vg + t * vs); sr.rv[0] = w.x; sr.rv[1] = w.y; }
            if constexpr (NV == 8) { const v4u w = *(const GAS v4u*)(vg + t * vs); sr.rv[0] = w.x; sr.rv[1] = w.y; sr.rv[2] = w.z; sr.rv[3] = w.w; }
            if constexpr (NV == 16) { const v4u w = *(const GAS v4u*)(vg + t * vs), w2 = *(const GAS v4u*)(vg + t * vs + 8); sr.rv[0] = w.x; sr.rv[1] = w.y; sr.rv[2] = w.z; sr.rv[3] = w.w; sr.rv[4] = w2.x; sr.rv[5] = w2.y; sr.rv[6] = w2.z; sr.rv[7] = w2.w; }
            if constexpr (HASB) { sr.rb0 = bg[t * SFW]; sr.rb1 = bg[t * SFW + 4]; sr.rb2 = bg[t * SFW + 8]; }
        }
    };
    auto stage_write = [&](SR& sr, int b) {
        LAS float* base = wl + b * BUF;
#pragma unroll
        for (int i = 0; i < QP / 8; ++i) {
            LAS float* qd = base + OQ + stok * DK + spart * QP + i * 8;
            *(LAS f32x4*)qd = (f32x4){bflo(sr.rq[i].x), bfhi(sr.rq[i].x), bflo(sr.rq[i].y), bfhi(sr.rq[i].y)}; *(LAS f32x4*)(qd + 4) = (f32x4){bflo(sr.rq[i].z), bfhi(sr.rq[i].z), bflo(sr.rq[i].w), bfhi(sr.rq[i].w)};
            if constexpr (GK) { LAS float* kd = base + OK_ + stok * DK + spart * QP + i * 8;
                *(LAS f32x4*)kd = (f32x4){bflo(sr.rk[i].x), bfhi(sr.rk[i].x), bflo(sr.rk[i].y), bfhi(sr.rk[i].y)}; *(LAS f32x4*)(kd + 4) = (f32x4){bflo(sr.rk[i].z), bfhi(sr.rk[i].z), bflo(sr.rk[i].w), bfhi(sr.rk[i].w)}; }
        }
        if constexpr (HASF) {
#pragma unroll
            for (int i = 0; i < QP / 4; ++i) { *(LAS f32x4*)(base + OF + stok * DK + spart * QP + i * 4) = sr.rf[i];
                if constexpr (KIND == 2) *(LAS f32x4*)(base + OK_ + stok * DK + spart * QP + i * 4) = 1.0f - sr.rf[i]; } }
        if (lane < 16) {
#pragma unroll
            for (int i = 0; i < NV / 2; ++i) { base[OV + lane * NV + 2 * i] = bflo(sr.rv[i]); base[OV + lane * NV + 2 * i + 1] = bfhi(sr.rv[i]); }
            if constexpr (HASB) *(LAS f32x4*)(base + OB + lane * 4) = (f32x4){sr.rb0, sr.rb1, sr.rb2, 0.f};
        }
    };
    static_assert(2 * BUF * 4 <= 26624, "per-wave LDS");
    const int nch = T / CT;
    struct Opnd { f32x2 q2[DH / 2], k2[DH / 2], f2[DH / 2]; float v; f32x4 bd; };
    auto ldop = [&](Opnd& x, const LAS float* bq, const LAS float* bv, const LAS float* bb, int uu) {
#pragma unroll
        for (int i = 0; i < DH / 4; ++i) { const f32x4 w = *(const LAS f32x4*)(bq + OQ + uu * DK + 4 * i); x.q2[2 * i] = (f32x2){w.x, w.y}; x.q2[2 * i + 1] = (f32x2){w.z, w.w}; }
#pragma unroll
        for (int i = 0; i < DH / 4; ++i) { const f32x4 w = *(const LAS f32x4*)(bq + OK_ + uu * DK + 4 * i); x.k2[2 * i] = (f32x2){w.x, w.y}; x.k2[2 * i + 1] = (f32x2){w.z, w.w}; }
        if constexpr (HASF) {
#pragma unroll
            for (int i = 0; i < DH / 4; ++i) { const f32x4 w = *(const LAS f32x4*)(bq + OF + uu * DK + 4 * i); x.f2[2 * i] = (f32x2){w.x, w.y}; x.f2[2 * i + 1] = (f32x2){w.z, w.w}; } }
        x.v = bv[uu * NV];
        if constexpr (HASB) x.bd = *(const LAS f32x4*)(bb + uu * 4);
    };
    auto compute = [&](int c, const LAS float* base) {
#pragma unroll 1
        for (int ub = 0; ub < CT; ub += UNR) {
        float okeep[R];
#pragma unroll
        for (int vv = 0; vv < R; ++vv) okeep[vv] = 0.f;
        Opnd X; X.bd = (f32x4){0.f, 0.f, 0.f, 0.f};
#pragma unroll
        for (int i = 0; i < DH / 2; ++i) X.f2[i] = (f32x2){0.f, 0.f};
        const LAS float* bq = base + ub * DK + d0; const LAS float* bv = base + OV + ub * NV + rw; const LAS float* bb = base + OB + ub * 4;
        ldop(X, bq, bv, bb, 0);
#pragma unroll
        for (int uu_ = 0; uu_ < UNR; ++uu_) { const int u = ub + uu_;
            Opnd Y = X;
            if (uu_ + 1 < UNR) ldop(Y, bq, bv, bb, uu_ + 1);
            f32x2 (&q2)[DH / 2] = X.q2; f32x2 (&k2)[DH / 2] = X.k2; f32x2 (&f2)[DH / 2] = X.f2; const float vv_ = X.v; const f32x4 bd = X.bd;
            float o[1];
            if constexpr (KIND == 3) {
                f32x2 a = k2[0] * S2[0], bq_ = q2[0] * S2[0];
#pragma unroll
                for (int i = 1; i < DH / 2; ++i) { a = __builtin_elementwise_fma(k2[i], S2[i], a); bq_ = __builtin_elementwise_fma(q2[i], S2[i], bq_); }
                const float ks_ = row8_sum(a.x + a.y) * bd.y, qs_ = row8_sum(bq_.x + bq_.y) * bd.y;
                const float uu = bd.x * (vv_ - ks_);
                o[0] = __builtin_fmaf(bd.z, uu, qs_);
                const f32x2 de2 = (f32x2){bd.y, bd.y}, uu2 = (f32x2){uu, uu};
#pragma unroll
                for (int i = 0; i < DH / 2; ++i) S2[i] = __builtin_elementwise_fma(S2[i], de2, k2[i] * uu2);
            } else {
                const f32x2 v2 = (f32x2){vv_, vv_};
#pragma unroll
                for (int i = 0; i < DH / 2; ++i) {
                    f32x2 dec2;
                    if constexpr (KIND == 0) dec2 = (f32x2){rdec, rdec}; else dec2 = f2[i];
                    S2[i] = __builtin_elementwise_fma(S2[i], dec2, k2[i] * v2);
                }
            }
            if constexpr (KIND != 3)
            { f32x2 a = q2[0] * S2[0];
#pragma unroll
              for (int i = 1; i < DH / 2; ++i) a = __builtin_elementwise_fma(q2[i], S2[i], a);
              o[0] = row8_sum(a.x + a.y); }
#pragma unroll
            for (int vv = 0; vv < R; ++vv) okeep[vv] = (dl == uu_) ? o[vv] : okeep[vv];
            X = Y;
        }
        {
            GAS bf16* o_ = op + (size_t)(c * CT + ub + dl) * D;
            if constexpr (R == 1) *o_ = (bf16)(pk2(okeep[0], 0.f) & 0xffffu);
            if constexpr (R == 2) *(GAS unsigned*)o_ = pk2(okeep[0], okeep[1]);
            if constexpr (R == 4) *(GAS v2u*)o_ = (v2u){pk2(okeep[0], okeep[1]), pk2(okeep[2], okeep[3])};
        }
        }
    };
    stage_load(s0, 0); stage_write(s0, 0);
#pragma unroll 1
    for (int c = 0; c < nch; c += 2) {
        stage_load(s0, min(c + 1, nch - 1));
        compute(c, wl);
        stage_write(s0, 1);
        stage_load(s0, min(c + 2, nch - 1));
        compute(c + 1, wl + BUF);
        stage_write(s0, 0);
    }
    const int v0 = slice * NV + rw * R;
#pragma unroll
    for (int i = 0; i < DH / 2; ++i) { sout[(size_t)(d0 + 2 * i) * 64 + v0] = S2[i].x; sout[(size_t)(d0 + 2 * i + 1) * 64 + v0] = S2[i].y; }
}

__device__ __forceinline__ void scan_phase(const Args& args, LAS unsigned char* lds_, int l, int mode = 0) {
    const Ctx C = make_ctx(args, lds_);
    constexpr int NLONG = 1024, NSHORT = BS * 144;
    const int slot = C.wave * 256 + (int)blockIdx.x;
    const int nidle = C.NGW - NLONG - 256;
    for (int it = 0;; ++it) {
        int kind, b, h, slice, row0, T; bool isp;
        if (slot < NLONG) { if (it > 0 || mode == 2) break; isp = true; T = TP;
            const int kk_ = slot >> 8, i = slot & 255; kind = kk_ == 0 ? 3 : (kk_ == 1 ? 0 : (kk_ == 2 ? 2 : 1));
            { const int stream = (i & 7) | ((i >> 6) << 3); slice = (i >> 3) & 7; b = stream >> 2; h = stream & 3; }
            row0 = b * TP;
        } else { if (C.wave < 5) break;
            const int st = (slot - NLONG - 256) + it * nidle; if (st >= NSHORT || mode == 1) break; isp = false; T = TS;
            b = st / 144; int i = st - b * 144;
            if (i < 64) { kind = 3; h = i >> 4; slice = i & 15; }
            else if (i < 96) { i -= 64; kind = 0; h = i >> 3; slice = i & 7; }
            else if (i < 128) { i -= 96; kind = 2; h = i >> 3; slice = i & 7; }
            else { i -= 128; kind = 1; h = i >> 2; slice = i & 3; }
            row0 = MP + b * TS;
        }
        const int nbat = isp ? BP : BS;
        const size_t sidx = (size_t)((l * nbat + b) * 4 + h);
        if (isp) {
            LAS float* wl = (LAS float*)(C.lds + C.wave * 26624);
            if (kind == 0) scan_long<0, 8, 1>(C, wl, row0, T, h, slice, C.out + O_PRET + sidx * 4096);
            else if (kind == 1) scan_long<1, 4, 1>(C, wl, row0, T, h, slice, C.out + O_PGLA + sidx * 2048);
            else if (kind == 2) scan_long<2, 8, 1>(C, wl, row0, T, h, slice, C.out + O_PHG + sidx * 4096);
            else scan_long<3, 8, 1>(C, wl, row0, T, h, slice, C.out + O_PGDN + sidx * 4096);
        } else {
            if (kind == 0) { scan_task<0, 4, 2>(C, row0, T, h, slice, args.in[2] + sidx * 4096, C.out + O_SRET + sidx * 4096); }
            else if (kind == 1) { scan_task<1, 2, 4>(C, row0, T, h, slice, args.in[3] + sidx * 2048, C.out + O_SGLA + sidx * 2048); }
            else if (kind == 2) { scan_task<2, 4, 2>(C, row0, T, h, slice, args.in[4] + sidx * 4096, C.out + O_SHG + sidx * 4096); }
            else { scan_task<3, 4, 1>(C, row0, T, h, slice, args.in[5] + sidx * 4096, C.out + O_SGDN + sidx * 4096); }
        }
    }
    if (l == 0 && C.wave >= 5 && mode != 1) {
        LAS float* scr = (LAS float*)(C.lds + 4 * 26624 + (C.wave - 5) * 8704);
        constexpr int I_F0 = I_WI + I_WO, I_L0B = I_F0 + I_WOUT;
        for (int it = (C.wave - 5) * 256 + (int)blockIdx.x; it < I_L0B + I_MAIN; it += 768) {
            if (it < I_F0) convert_item(args, C.ws, 0, I_F0 + it, scr, C.lane);
            else if (it < I_L0B) convert_item(args, C.ws, 0, 2 * I_F0 + I_WIN + (it - I_F0), scr, C.lane);
            else convert_item(args, C.ws, 1, it - I_L0B, scr, C.lane);
        }
    }
}

__device__ __forceinline__ void post_phase(const Args& args, LAS unsigned char* lds_, int l) {
    const Ctx C = make_ctx(args, lds_);
    const bf16* PROJ = (const bf16*)(C.ws + WS_BIG); bf16* H = (bf16*)(C.ws + WS_H);
    const int lane = C.lane, mixer = lane >> 4, cc = (lane & 15) * 16;
    const int gbase = mixer == 0 ? C_RG : mixer == 1 ? C_AG : mixer == 2 ? C_HG : C_DG;
    const float* nw = mixer == 1 ? args.in[24] + l * 64 : mixer == 2 ? args.in[25] + l * 64 : args.in[26] + l * 64;
    float w[16];
#pragma unroll
    for (int i = 0; i < 16; ++i) w[i] = mixer == 0 ? 1.0f : nw[(cc + i) & 63];
    v4u na0, na1, ng0, ng1;
    if (C.gw < M) { const bf16* hp = H + (size_t)C.gw * D + lane * 16; const bf16* gp = PROJ + (size_t)C.gw * NINP + gbase + cc;
        na0 = *(const v4u*)hp; na1 = *(const v4u*)(hp + 8); ng0 = *(const v4u*)gp; ng1 = *(const v4u*)(gp + 8); }
#pragma unroll 1
    for (int r = C.gw; r < M; r += C.NGW) {
        bf16* hp = H + (size_t)r * D + lane * 16; const bf16* gp = PROJ + (size_t)r * NINP + gbase + cc;
        const v4u a0 = na0, a1 = na1, g0 = ng0, g1 = ng1;
        if (r + C.NGW < M) { const bf16* hn = hp + (size_t)C.NGW * D; const bf16* gn = gp + (size_t)C.NGW * NINP;
            na0 = *(const v4u*)hn; na1 = *(const v4u*)(hn + 8); ng0 = *(const v4u*)gn; ng1 = *(const v4u*)(gn + 8); }
        float y[16], g[16];
        const unsigned aw[8] = {a0.x, a0.y, a0.z, a0.w, a1.x, a1.y, a1.z, a1.w}, gw_[8] = {g0.x, g0.y, g0.z, g0.w, g1.x, g1.y, g1.z, g1.w};
        float ss = 0.f;
#pragma unroll
        for (int i = 0; i < 8; ++i) { y[2 * i] = bflo(aw[i]); y[2 * i + 1] = bfhi(aw[i]); g[2 * i] = bflo(gw_[i]); g[2 * i + 1] = bfhi(gw_[i]); ss += y[2 * i] * y[2 * i] + y[2 * i + 1] * y[2 * i + 1]; }
        ss = quad_sum(ss);
        const float rs = rsqrtf(ss * (1.0f / 64.0f) + RMS_EPS);
        unsigned ow[8];
#pragma unroll
        for (int i = 0; i < 8; ++i) ow[i] = pk2(y[2 * i] * rs * w[2 * i] * siluf_(g[2 * i]), y[2 * i + 1] * rs * w[2 * i + 1] * siluf_(g[2 * i + 1]));
        *(v4u*)hp = (v4u){ow[0], ow[1], ow[2], ow[3]}; *(v4u*)(hp + 8) = (v4u){ow[4], ow[5], ow[6], ow[7]};
    }
}

__global__ void __launch_bounds__(NWAVES * 64, 2) mega_fwd(Args args) {
    extern __shared__ __attribute__((aligned(16))) unsigned char lds[];
    cg::grid_group grid = cg::this_grid();
    LAS unsigned char* const LDSP = (LAS unsigned char*)lds;
    const int G = (int)gridDim.x, bx = (int)blockIdx.x;
    if (threadIdx.x < 64) ((LAS unsigned*)(LDSP + MISC_OFF))[threadIdx.x] = 0u;
    __syncthreads();
    (void)xcd_barrier_post((unsigned*)args.ws, (volatile LAS unsigned*)(LDSP + MISC_OFF));
#define FRESH() float* out_ = fresh_ptr(args.out); unsigned char* ws = fresh_ptr(args.ws); \
    float* MOD = (float*)(ws + WS_MOD); bf16* H = (bf16*)(ws + WS_H); bf16* BIG = (bf16*)(ws + WS_BIG); (void)MOD; (void)H; (void)BIG; (void)out_;

    p0_prologue(args, LDSP);
    if (args.ws == nullptr) grid.sync();
    grid_bar(args, LDSP);
    {
        FRESH();
        pg8::Gemm g{(const bf16*)(ws + WS_AC), BIG, 256, 2 * NMODC, D}; pg8::StaticOrder S; S.init(256, 2 * NMODC, G, bx, D);
        pg8::EpiMod E{MOD, args.in[10]};
        pg8::gemm_phase<pg8::EpiMod, pg8::StaticOrder, PG8_ALIGN, PG8_SP2>(LDSP, g, S, E);
    }
    p1_convert(args, LDSP);
    grid_bar(args, LDSP);
    p2_modulate0(args, LDSP);
    grid_bar(args, LDSP);
#pragma unroll 1
    for (int l = 0; l < 2; ++l) {
#pragma unroll 1
        for (int f = 0; f < 2; ++f) {
            if (f == 1) {
                {
                    FRESH();
                    pg8::Gemm g{H, (const bf16*)(ws + WS_W + (size_t)l * W_LAYER + W_WIN), M, NINP, D}; pg8::StaticOrder S; S.init(M, NINP, G, bx, D);
                    pg8::EpiPlain E{BIG, NINP};
                    pg8::gemm_phase<pg8::EpiPlain, pg8::StaticOrder, PG8_ALIGN, PG8_SP2>(LDSP, g, S, E);
                }
                grid_bar(args, LDSP);
                prep_phase(args, LDSP, l);
                grid_bar(args, LDSP);
                scan_phase(args, LDSP, l);
#ifdef PROBE_SCANMODE
                grid_bar(args, LDSP); scan_phase(args, LDSP, l, PROBE_SCANMODE);
#endif
                grid_bar(args, LDSP);
                post_phase(args, LDSP, l);
                grid_bar(args, LDSP);
                {
                    FRESH();
                    pg8::Gemm g{H, (const bf16*)(ws + WS_W + (size_t)l * W_LAYER + W_WOUT), M, D, D}; pg8::SplitOrder S; S.init(D, G, bx);
                    pg8::EpiRes E{out_, out_, (float*)(ws + WS_SB), MOD + (size_t)l * NB * NMODC + 5 * 1024, (const float*)(ws + WS_STATS), args.in[11] + (size_t)(l * 3) * D, args.in[12] + (size_t)(l * 3) * D, 1.0f, D / 64};
                    pg8::gemm_phase<pg8::EpiRes, pg8::SplitOrder, PG8_ALIGN, PG8_SP2>(LDSP, g, S, E);
                }
                grid_bar(args, LDSP);
                ln_phase(args, LDSP, l, 1, true, l, 6, 4, ALPHA, false);
                grid_bar(args, LDSP);
            }
            {
                FRESH();
                pg8::Gemm g{H, (const bf16*)(ws + WS_W + (size_t)l * W_LAYER + (f ? W_WI2 : W_WI1)), M, NWI, D}; pg8::StaticOrder S; S.init(M, NWI, G, bx, D);
                pg8::EpiSwiglu E{BIG, DFF};
                pg8::gemm_phase<pg8::EpiSwiglu, pg8::StaticOrder, PG8_ALIGN, PG8_SP2>(LDSP, g, S, E);
            }
            grid_bar(args, LDSP);
            {
                FRESH();
                pg8::Gemm g{BIG, (const bf16*)(ws + WS_W + (size_t)l * W_LAYER + (f ? W_WO2 : W_WO1)), M, D, DFF}; pg8::SplitOrder S; S.init(DFF, G, bx);
                const bool first = (l == 0 && f == 0); const int pinst = f ? l * 3 + 1 : l * 3 - 1;
                pg8::EpiRes E{out_, first ? args.in[0] : out_, (float*)(ws + WS_SB), MOD + (size_t)l * NB * NMODC + (f ? 8 : 2) * 1024, (const float*)(ws + WS_STATS),
                              first ? (const float*)(ws + WS_ID) : args.in[11] + (size_t)pinst * D, first ? (const float*)(ws + WS_ID) + 1024 : args.in[12] + (size_t)pinst * D, 0.5f, DFF / 64};
                pg8::gemm_phase<pg8::EpiRes, pg8::SplitOrder, PG8_ALIGN, PG8_SP2>(LDSP, g, S, E);
            }
            grid_bar(args, LDSP);
            if (f == 0) ln_phase(args, LDSP, l, 0, true, l, 3, 11, ALPHA, false);
            else ln_phase(args, LDSP, l, 2, l == 0, 1, 0, 11, l == 0 ? ALPHA : 1.0f, l == 1);
            if (!(l == 1 && f == 1)) grid_bar(args, LDSP);
        }
    }
}

extern "C" void kernel_launch(void* const* d_in, const int* in_sizes, int n_in, void* d_out, int out_size, void* d_ws, size_t ws_size, hipStream_t stream) {
    static int grid = 0;
    if (grid == 0) {
        if (n_in != 28 || (size_t)out_size != O_END || ws_size < WS_END) { fprintf(stderr, "kernel_launch: unexpected sizes n_in %d out %d ws %zu (need %zu)\n", n_in, out_size, ws_size, (size_t)WS_END); grid = -1; return; }
        int dev = 0, cus = 0, per_cu = 0;
        hipGetDevice(&dev); hipDeviceGetAttribute(&cus, hipDeviceAttributeMultiprocessorCount, dev);
        hipFuncSetAttribute((const void*)mega_fwd, hipFuncAttributeMaxDynamicSharedMemorySize, LDS_BYTES);
        hipOccupancyMaxActiveBlocksPerMultiprocessor(&per_cu, (const void*)mega_fwd, NWAVES * 64, LDS_BYTES);
        (void)hipGetLastError();
        if (per_cu < 1 || cus < 256) { fprintf(stderr, "kernel_launch: occupancy %d cus %d\n", per_cu, cus); grid = -1; return; }
        grid = 256;
    }
    if (grid < 0) return;
    if (hipMemsetAsync(d_ws, 0, 65536, stream) != hipSuccess) { fprintf(stderr, "memset failed\n"); return; }
    Args a{};
    for (int i = 0; i < 28; ++i) a.in[i] = (const float*)d_in[i];
    a.out = (float*)d_out; a.ws = (unsigned char*)d_ws;
    void* kargs[] = {&a};
    hipError_t e = hipLaunchCooperativeKernel((const void*)mega_fwd, dim3(grid), dim3(NWAVES * 64), kargs, LDS_BYTES, stream);
    if (e != hipSuccess) fprintf(stderr, "cooperative launch failed: %s\n", hipGetErrorString(e));
}
```

```cpp
#include <hip/hip_runtime.h>
#include <hip/hip_cooperative_groups.h>
#include <cstdio>
#include <cstdint>
namespace cg = cooperative_groups;
namespace pg8 {
#define PG8_LAS __attribute__((address_space(3)))
typedef unsigned short bf16_t;
typedef short bf16x8 __attribute__((ext_vector_type(8)));
typedef float f32x4 __attribute__((ext_vector_type(4)));
typedef unsigned u32x4 __attribute__((ext_vector_type(4)));
constexpr int BM = 256, BK = 64, HALF = 128, HTB = HALF * BK * 2  , STAGE_BYTES = 8 * HTB, NXCD = 8, WGM = 8;

__host__ __device__ __forceinline__ int lds_byte(int r, int c) { const int st = (r >> 4) * 2 + (c >> 5), rr = r & 15, cc = c & 31, ob = rr * 64 + cc * 2; return st * 1024 + (ob ^ (((ob >> 9) & 1) << 5)); }
__host__ __device__ __forceinline__ void stage_rc(int b, int& R, int& C) { const int st = b / 1024, sb = b % 1024, swz = sb ^ (((sb >> 9) & 1) << 5); R = (st >> 1) * 16 + swz / 64; C = (st & 1) * 32 + (swz % 64) / 2; }
__host__ __device__ __forceinline__ int perm32(int rho) { const int n = rho >> 4, i = rho & 15; return 8 * (i >> 2) + 4 * n + (i & 3); }

struct Unit { int pm, pn, k0, nt; };
struct Gemm { const bf16_t* A; const bf16_t* Bt; int M, N, K; };

struct StaticOrder {
    int nM, nN, nwg, G, c, ntf;
    __host__ __device__ void init(int M, int N, int G_, int c_, int K_ = 1024) { nM = M / BM; nN = N / BM; nwg = nM * nN; G = G_; c = c_; ntf = K_ / BK; }
    __host__ __device__ bool next(int i, Unit& u) const {
        const long L = (long)i * G + c; if (L >= nwg) return false;
        int wgid = (int)L; { const int q = nwg / NXCD, r = nwg % NXCD, xcd = wgid % NXCD, off = wgid / NXCD; wgid = (xcd < r ? xcd * (q + 1) : r * (q + 1) + (xcd - r) * q) + off; }
        const int nig = WGM * nN, gid = wgid / nig, fm = gid * WGM, gsz = (nM - fm) < WGM ? (nM - fm) : WGM;
        u.pm = fm + ((wgid % nig) % gsz); u.pn = (wgid % nig) / gsz; u.k0 = 0; u.nt = ntf; return true;
    }
    __device__ __forceinline__ void a_ready(const Unit&) const {}
    __device__ __forceinline__ void done(const Unit&) const {}
};

struct SplitOrder {
    StaticOrder base; int ppu, c;
    static constexpr int PK = 4;
    __host__ __device__ void init(int K_, int G_, int c_) { base.init(16384, 1024, G_, c_, K_); ppu = (K_ / BK) / PK; c = c_; }
    __host__ __device__ bool next(int i, Unit& u) const {
        if (i == 0) return base.next(0, u);
        if (i == 1 && c < 8 * ppu) { const int j = c / ppu, p = c - j * ppu; u.pm = 64 + (j >> 2); u.pn = j & 3; u.k0 = p * PK; u.nt = PK; return true; }
        return false;
    }
    __device__ __forceinline__ void a_ready(const Unit&) const {}
    __device__ __forceinline__ void done(const Unit&) const {}
};

__device__ __forceinline__ unsigned cvt_pk_bf16(float lo, float hi) { unsigned r; asm volatile("v_cvt_pk_bf16_f32 %0, %1, %2" : "=v"(r) : "v"(lo), "v"(hi)); return r; }
typedef float f32x2 __attribute__((ext_vector_type(2)));
__device__ __forceinline__ f32x2 gelu_pk(f32x2 v) {
    const f32x2 av = __builtin_elementwise_abs(v), d = av * 0.2316418882f + 1.0f;
    f32x2 t; t.x = __builtin_amdgcn_rcpf(d.x); t.y = __builtin_amdgcn_rcpf(d.y);
    f32x2 q = t * 0.5307027145f + (-0.7265760135f); q = q * t + 0.7107068705f; q = q * t + (-0.142248368f); q = q * t + 0.127414796f; q = q * t;
    const f32x2 s = (v * v) * (-0.72134752044f);
    f32x2 e; e.x = __builtin_amdgcn_exp2f(s.x); e.y = __builtin_amdgcn_exp2f(s.y);
    const f32x2 m = v * (q * e), r = v - m;
    f32x2 o; o.x = v.x < 0.f ? m.x : r.x; o.y = v.y < 0.f ? m.y : r.y; return o;
}

template <int ACT  > struct EpiBf16 {
    static constexpr bool PERM = true, AFTER_DRAIN = false; static_assert(ACT == 0 || ACT == 1, "EpiBf16: ACT is 0 (none) or 1 (gelu_pk)");
    bf16_t* O; int ldc; const float* bias; int split_cols; size_t split_stride; float scale0;
    __device__ __forceinline__ void operator()(const f32x4 (&acc)[2][2][4][2], const Unit& u, int wr, int wc, int fr, int fq) const {
        const int row0 = u.pm * BM + wr * 64 + fr; int colt = u.pn * BM; bf16_t* base = O;
        float sc = 1.f; if (split_cols) { const int t = colt / split_cols; base += (size_t)t * split_stride; colt -= t * split_cols; if (t == 0) sc = scale0; }
        const int col0 = colt + wc * 32 + 8 * fq, bcol0 = u.pn * BM + wc * 32 + 8 * fq;
        f32x4 bv[2][2];
#pragma unroll
        for (int bj = 0; bj < 2; ++bj)
#pragma unroll
            for (int n = 0; n < 2; ++n) bv[bj][n] = bias ? *(const f32x4*)(bias + bcol0 + bj * HALF + 4 * n) : (f32x4){0.f, 0.f, 0.f, 0.f};
#pragma unroll
        for (int ai = 0; ai < 2; ++ai)
#pragma unroll
            for (int m = 0; m < 4; ++m) { bf16_t* rowp = base + (size_t)(row0 + ai * HALF + m * 16) * ldc + col0;
#pragma unroll
                for (int bj = 0; bj < 2; ++bj) { f32x4 v0 = acc[ai][bj][m][0] + bv[bj][0], v1 = acc[ai][bj][m][1] + bv[bj][1];
                    if (ACT == 1) { f32x2 a = gelu_pk((f32x2){v0[0], v0[1]}), b = gelu_pk((f32x2){v0[2], v0[3]}), c = gelu_pk((f32x2){v1[0], v1[1]}), d = gelu_pk((f32x2){v1[2], v1[3]});
                        v0 = (f32x4){a.x, a.y, b.x, b.y}; v1 = (f32x4){c.x, c.y, d.x, d.y}; }
                    v0 = v0 * sc; v1 = v1 * sc; u32x4 w; w.x = cvt_pk_bf16(v0[0], v0[1]); w.y = cvt_pk_bf16(v0[2], v0[3]); w.z = cvt_pk_bf16(v1[0], v1[1]); w.w = cvt_pk_bf16(v1[2], v1[3]);
                    *(u32x4*)(rowp + bj * HALF) = w; } }
    }
};
template <class Epi, class Sched, bool ALIGN_EPI = false, bool SP2 = false>
__device__ __forceinline__ void gemm_phase(PG8_LAS unsigned char* lds, const Gemm g, const Sched& S, const Epi& E) {
    int tid_ = threadIdx.x; asm volatile("" : "+v"(tid_));
    const int tid = tid_, wid = __builtin_amdgcn_readfirstlane(tid >> 6), lane = tid & 63, wr = wid >> 2, wc = wid & 3, fr = lane & 15, fq = lane >> 4;
    const int K = g.K;
    unsigned voffA[2], voffB[2];
#pragma unroll
    for (int i = 0; i < 2; ++i) { int R, C; stage_rc(tid * 16 + i * 8192, R, C); const int Rb = Epi::PERM ? ((R & ~31) + perm32(R & 31)) : R;
        voffA[i] = (unsigned)(R * K + C) * 2u; voffB[i] = (unsigned)(Rb * K + C) * 2u; }
    const size_t kstep = (size_t)(BK * 2);
    const size_t hstep = (size_t)HALF * K * 2;
    const size_t tstep = 2 * hstep;
    const unsigned ldsw = (unsigned)wid * 1024u;
    const int aoff = lds_byte(wr * 64 + fr, fq * 8), boff = lds_byte(wc * 32 + fr, fq * 8);
#define PG8_SA(b, h) (((b) * 2 + (h)) * HTB)
#define PG8_SB(b, h) ((4 + (b) * 2 + (h)) * HTB)
#define PG8_STAGE(bufoff, gbase, voff) do { _Pragma("unroll") for (int _i = 0; _i < 2; ++_i) \
        __builtin_amdgcn_global_load_lds((const unsigned*)((const char*)(gbase) + (voff)[_i]), (PG8_LAS unsigned*)(lds + (bufoff) + ldsw + _i * 8192), 16, 0, 0); } while (0)
#define PG8_LDA(dst, b, h) do { _Pragma("unroll") for (int m = 0; m < 4; ++m) _Pragma("unroll") for (int k = 0; k < 2; ++k) dst[m][k] = *(const PG8_LAS bf16x8*)(lds + PG8_SA(b, h) + aoff + m * 2048 + k * 1024); } while (0)
#define PG8_LDB(dst, b, h) do { _Pragma("unroll") for (int n = 0; n < 2; ++n) _Pragma("unroll") for (int k = 0; k < 2; ++k) dst[n][k] = *(const PG8_LAS bf16x8*)(lds + PG8_SB(b, h) + boff + n * 2048 + k * 1024); } while (0)
#define PG8_MMA(ai, bj, At, Bt) do { __builtin_amdgcn_s_setprio(1); _Pragma("unroll") for (int m = 0; m < 4; ++m) _Pragma("unroll") for (int n = 0; n < 2; ++n) _Pragma("unroll") for (int k = 0; k < 2; ++k) \
        acc[ai][bj][m][n] = __builtin_amdgcn_mfma_f32_16x16x32_bf16(Bt[n][k], At[m][k], acc[ai][bj][m][n], 0, 0, 0); __builtin_amdgcn_s_setprio(0); } while (0)
#define PG8_WAIT_V(n) asm volatile("s_waitcnt vmcnt(" #n ")" ::: "memory")
#define PG8_WAIT_L(n) asm volatile("s_waitcnt lgkmcnt(" #n ")" ::: "memory")
#define PG8_BAR __builtin_amdgcn_s_barrier()
#define PG8_SCHED __builtin_amdgcn_sched_barrier(0)
    Unit cur, nxt; int ui = 0;
    if (!S.next(0, cur)) return;
    f32x4 acc[2][2][4][2];
#pragma unroll
    for (int a = 0; a < 2; ++a)
#pragma unroll
        for (int b = 0; b < 2; ++b)
#pragma unroll
            for (int m = 0; m < 4; ++m)
#pragma unroll
                for (int n = 0; n < 2; ++n) acc[a][b][m][n] = (f32x4){0.f, 0.f, 0.f, 0.f};
    bf16x8 At[4][2], B0[2][2], B1[2][2];
    const char* cA = (const char*)g.A + (size_t)cur.pm * tstep + (size_t)cur.k0 * kstep; const char* cB = (const char*)g.Bt + (size_t)cur.pn * tstep + (size_t)cur.k0 * kstep;
    S.a_ready(cur);
    if constexpr (SP2) {
        PG8_STAGE(PG8_SB(0, 0), cB, voffB); PG8_STAGE(PG8_SB(0, 1), cB + hstep, voffB); PG8_STAGE(PG8_SA(0, 0), cA, voffA); PG8_STAGE(PG8_SA(0, 1), cA + hstep, voffA);
        if (wr == 1) PG8_BAR;
        PG8_WAIT_V(2); PG8_BAR;
        PG8_STAGE(PG8_SB(1, 0), cB + kstep, voffB); PG8_STAGE(PG8_SA(1, 0), cA + kstep, voffA); PG8_STAGE(PG8_SB(1, 1), cB + hstep + kstep, voffB);
        PG8_WAIT_V(6); PG8_BAR;
    } else {
        PG8_STAGE(PG8_SB(0, 0), cB, voffB); PG8_STAGE(PG8_SA(0, 0), cA, voffA); PG8_STAGE(PG8_SB(0, 1), cB + hstep, voffB); PG8_STAGE(PG8_SA(0, 1), cA + hstep, voffA);
        if (wr == 1) PG8_BAR;
        PG8_WAIT_V(4); PG8_BAR;
        PG8_STAGE(PG8_SB(1, 0), cB + kstep, voffB); PG8_STAGE(PG8_SA(1, 0), cA + kstep, voffA); PG8_STAGE(PG8_SB(1, 1), cB + hstep + kstep, voffB);
        PG8_WAIT_V(6); PG8_BAR;
    }
    for (;;) {
        const bool has_next = S.next(ui + 1, nxt);
        const char* nA = has_next ? (const char*)g.A + (size_t)nxt.pm * tstep + (size_t)nxt.k0 * kstep : cA; const char* nB = has_next ? (const char*)g.Bt + (size_t)nxt.pn * tstep + (size_t)nxt.k0 * kstep : cB;
        const int nt = cur.nt;
        for (int t = 0; t < nt; t += 2) {
            const bool last = (t == nt - 2);
            const char* a1 = cA + (size_t)(t + 1) * kstep;
            const char* a2 = last ? nA : cA + (size_t)(t + 2) * kstep; const char* b2 = last ? nB : cB + (size_t)(t + 2) * kstep;
            const char* a3 = a2 + kstep; const char* b3 = b2 + kstep;
            if (last && has_next) S.a_ready(nxt);
            if constexpr (SP2) {
            PG8_LDB(B0, 0, 0); PG8_LDB(B1, 0, 1); PG8_SCHED; PG8_LDA(At, 0, 0); PG8_STAGE(PG8_SA(1, 1), a1 + hstep, voffA);
            PG8_WAIT_V(8); PG8_WAIT_L(0); PG8_BAR; PG8_MMA(0, 0, At, B0); PG8_MMA(0, 1, At, B1); PG8_BAR; PG8_SCHED;
            PG8_LDA(At, 0, 1); PG8_STAGE(PG8_SB(0, 0), b2, voffB); PG8_STAGE(PG8_SB(0, 1), b2 + hstep, voffB); PG8_STAGE(PG8_SA(0, 0), a2, voffA);
            PG8_WAIT_V(8); PG8_WAIT_L(0); PG8_BAR; PG8_MMA(1, 0, At, B0); PG8_MMA(1, 1, At, B1); PG8_BAR; PG8_SCHED;
            PG8_LDB(B0, 1, 0); PG8_LDB(B1, 1, 1); PG8_SCHED; PG8_LDA(At, 1, 0); PG8_STAGE(PG8_SA(0, 1), a2 + hstep, voffA);
            PG8_WAIT_V(8); PG8_WAIT_L(0); PG8_BAR; PG8_MMA(0, 0, At, B0); PG8_MMA(0, 1, At, B1); PG8_BAR; PG8_SCHED;
            PG8_LDA(At, 1, 1); PG8_STAGE(PG8_SB(1, 0), b3, voffB); PG8_STAGE(PG8_SB(1, 1), b3 + hstep, voffB); PG8_STAGE(PG8_SA(1, 0), a3, voffA);
            PG8_WAIT_V(8); PG8_WAIT_L(0); PG8_BAR; PG8_MMA(1, 0, At, B0); PG8_MMA(1, 1, At, B1); PG8_BAR; PG8_SCHED;
            } else {
            PG8_LDB(B0, 0, 0); PG8_SCHED; PG8_LDA(At, 0, 0); PG8_STAGE(PG8_SA(1, 1), a1 + hstep, voffA);
            PG8_WAIT_L(8); PG8_BAR; PG8_WAIT_L(0); PG8_MMA(0, 0, At, B0); PG8_BAR; PG8_SCHED;
            PG8_LDB(B1, 0, 1); PG8_STAGE(PG8_SB(0, 0), b2, voffB);
            PG8_BAR; PG8_WAIT_L(0); PG8_MMA(0, 1, At, B1); PG8_BAR;
            PG8_LDA(At, 0, 1); PG8_STAGE(PG8_SA(0, 0), a2, voffA);
            PG8_BAR; PG8_WAIT_L(0); PG8_MMA(1, 0, At, B0); PG8_BAR; PG8_SCHED;
            PG8_STAGE(PG8_SB(0, 1), b2 + hstep, voffB);
            PG8_WAIT_V(6); PG8_BAR; PG8_MMA(1, 1, At, B1); PG8_BAR;
            PG8_LDB(B0, 1, 0); PG8_SCHED; PG8_LDA(At, 1, 0); PG8_STAGE(PG8_SA(0, 1), a2 + hstep, voffA);
            PG8_WAIT_L(8); PG8_BAR; PG8_WAIT_L(0); PG8_MMA(0, 0, At, B0); PG8_BAR; PG8_SCHED;
            PG8_LDB(B1, 1, 1); PG8_STAGE(PG8_SB(1, 0), b3, voffB);
            PG8_BAR; PG8_WAIT_L(0); PG8_MMA(0, 1, At, B1); PG8_BAR;
            PG8_LDA(At, 1, 1); PG8_STAGE(PG8_SA(1, 0), a3, voffA);
            PG8_BAR; PG8_WAIT_L(0); PG8_MMA(1, 0, At, B0); PG8_BAR; PG8_SCHED;
            PG8_STAGE(PG8_SB(1, 1), b3 + hstep, voffB);
            PG8_WAIT_V(6); PG8_BAR; PG8_MMA(1, 1, At, B1); PG8_BAR;
            }
        }
        if constexpr (ALIGN_EPI) { if (wr == 0) PG8_BAR; }
        if constexpr (!Epi::AFTER_DRAIN) { E(acc, cur, wr, wc, fr, fq); S.done(cur); }
        if (!has_next) break;
#pragma unroll
        for (int a = 0; a < 2; ++a)
#pragma unroll
            for (int b = 0; b < 2; ++b)
#pragma unroll
                for (int m = 0; m < 4; ++m)
#pragma unroll
                    for (int n = 0; n < 2; ++n) acc[a][b][m][n] = (f32x4){0.f, 0.f, 0.f, 0.f};
        cur = nxt; cA = nA; cB = nB; ++ui;
        if constexpr (ALIGN_EPI) { if (wr == 1) PG8_BAR; }
    }
    PG8_WAIT_V(0);
    if constexpr (!ALIGN_EPI) { if (wr == 0) PG8_BAR; }
    PG8_BAR;
    if constexpr (Epi::AFTER_DRAIN) { E.fused(acc, cur, wr, wc, fr, fq, lds, wid, lane); S.done(cur); }
#undef PG8_SA
#undef PG8_SB
#undef PG8_STAGE
#undef PG8_LDA
#undef PG8_LDB
#undef PG8_MMA
#undef PG8_WAIT_V
#undef PG8_WAIT_L
#undef PG8_BAR
#undef PG8_SCHED
}
}
#define PG8_SP2 true
#define PG8_ALIGN true

constexpr int D = 1024, TP = 2048, BP = 8, BS = 128, TS = 4;
constexpr int MP = BP * TP, MS = BS * TS, M = MP + MS;
constexpr int DFF = 2816, NWI = 2 * DFF, NIN = 3864, NINP = 4096, NMODC = 9216, NB = BP + BS;
constexpr int SBW = 1664, SFW = 396;
constexpr float LN_EPS = 1e-5f, RMS_EPS = 1e-6f;
constexpr float ALPHA = 1.41421356237f;
constexpr int C_RQ = 0, C_RK = 256, C_RV = 512, C_RG = 768, C_AQ = 1024, C_AK = 1152, C_AV = 1280, C_ALR = 1536, C_AG = 1552,
              C_HQ = 1808, C_HF = 2064, C_HI = 2320, C_HG = 2576, C_DQKV = 2832, C_DB = 3600, C_DA = 3604, C_DG = 3608;
constexpr int SB_RQ = 0, SB_RK = 256, SB_AQ = 512, SB_HQ = 640, SB_DQ = 896, SB_DK = 1152, SB_DV = 1408;
constexpr int SF_ADEC = 0, SF_HF = 128, SF_BETA = 384, SF_DDEC = 388, SF_QK = 392;
constexpr size_t O_Y = 0;
constexpr size_t O_PRET = (size_t)M * D;
constexpr size_t O_PGLA = O_PRET + 2ull * BP * 4 * 64 * 64;
constexpr size_t O_PHG = O_PGLA + 2ull * BP * 4 * 32 * 64;
constexpr size_t O_PGDN = O_PHG + 2ull * BP * 4 * 64 * 64;
constexpr size_t O_PCONV = O_PGDN + 2ull * BP * 4 * 64 * 64;
constexpr size_t O_SRET = O_PCONV + 2ull * BP * 3 * 768;
constexpr size_t O_SGLA = O_SRET + 2ull * BS * 4 * 64 * 64;
constexpr size_t O_SHG = O_SGLA + 2ull * BS * 4 * 32 * 64;
constexpr size_t O_SGDN = O_SHG + 2ull * BS * 4 * 64 * 64;
constexpr size_t O_SCONV = O_SGDN + 2ull * BS * 4 * 64 * 64;
constexpr size_t O_END = O_SCONV + 2ull * BS * 3 * 768;

constexpr size_t MiB = 1u << 20;
constexpr size_t WS_ROPE = 1 * MiB;
constexpr size_t WS_AC = 2 * MiB;
constexpr size_t WS_MOD = 3 * MiB;
constexpr size_t WS_STATS = 2 * MiB + 512 * 1024;
constexpr size_t WS_ID = 2 * MiB + 768 * 1024;
constexpr size_t WS_W = 13 * MiB;
constexpr size_t W_WI1 = 0, W_WO1 = 11 * MiB, W_WI2 = W_WO1 + 5 * MiB + MiB / 2, W_WO2 = W_WI2 + 11 * MiB, W_WIN = W_WO2 + 5 * MiB + MiB / 2, W_WOUT = W_WIN + 8 * MiB, W_LAYER = 43 * MiB;
constexpr size_t WS_H = WS_W + 2 * W_LAYER;
constexpr size_t WS_BIG = WS_H + 33 * MiB;
constexpr size_t WS_SB = WS_BIG + 132 * MiB;
constexpr size_t WS_SF = WS_SB + 54 * MiB;
constexpr size_t WS_END = WS_SF + 26 * MiB;
static_assert((size_t)M * SBW * 2 <= 54 * MiB && (size_t)M * SFW * 4 <= 26 * MiB && (size_t)M * 4096 * 2 <= 132 * MiB && (size_t)M * D * 2 <= 33 * MiB, "ws map");

constexpr int LDS_BYTES = 147456;
constexpr int NWAVES = 8;

#define GAS __attribute__((address_space(1)))
#define LAS __attribute__((address_space(3)))
typedef unsigned short bf16;
typedef unsigned v4u __attribute__((ext_vector_type(4)));
typedef unsigned v2u __attribute__((ext_vector_type(2)));
typedef float f32x4 __attribute__((ext_vector_type(4)));
typedef float f32x2 __attribute__((ext_vector_type(2)));
#define LDS_WAIT() asm volatile("s_waitcnt lgkmcnt(0)" ::: "memory")

__device__ __forceinline__ float bf2f(unsigned b) { return __uint_as_float(b << 16); }
__device__ __forceinline__ float bflo(unsigned w) { return __uint_as_float(w << 16); }
__device__ __forceinline__ float bfhi(unsigned w) { return __uint_as_float(w & 0xffff0000u); }
__device__ __forceinline__ unsigned pk2(float lo, float hi) { return pg8::cvt_pk_bf16(lo, hi); }
__device__ __forceinline__ float sigmoidf_(float x) { return __builtin_amdgcn_rcpf(1.0f + __expf(-x)); }
__device__ __forceinline__ float siluf_(float x) { return x * __builtin_amdgcn_rcpf(1.0f + __expf(-x)); }
__device__ __forceinline__ float wave_sum(float v) {
#pragma unroll
    for (int o = 1; o < 64; o <<= 1) v += __shfl_xor(v, o);
    return v;
}
template <int CTRL> __device__ __forceinline__ float dppmov(float v) { return __int_as_float(__builtin_amdgcn_update_dpp(0, __float_as_int(v), CTRL, 0xf, 0xf, true)); }
__device__ __forceinline__ float quad_sum(float v) { v += dppmov<0xB1>(v); v += dppmov<0x4E>(v); return v; }
__device__ __forceinline__ float row8_sum(float v) { v += dppmov<0xB1>(v); v += dppmov<0x4E>(v); v += dppmov<0x141>(v); return v; }
__device__ __forceinline__ float row16_sum(float v) { v += dppmov<0xB1>(v); v += dppmov<0x4E>(v); v += dppmov<0x141>(v); v += dppmov<0x140>(v); return v; }

struct Args { const float* in[28]; float* out; unsigned char* ws; };

struct Ctx {
    int tid, lane, wave, gw, NGW;
    LAS unsigned char* lds;
    float* out; unsigned char* ws;
};
template <class T> __device__ __forceinline__ T* fresh_ptr(T* p) {
    unsigned lo = (unsigned)(uintptr_t)p, hi = (unsigned)((uintptr_t)p >> 32);
    asm volatile("" : "+v"(lo), "+v"(hi));
    lo = __builtin_amdgcn_readfirstlane(lo); hi = __builtin_amdgcn_readfirstlane(hi);
    return (T*)(__attribute__((address_space(1))) T*)(((uintptr_t)hi << 32) | (uintptr_t)lo);
}
__device__ __forceinline__ Ctx make_ctx(const Args& args, LAS unsigned char* lds) {
    Ctx C; int t = threadIdx.x; asm volatile("" : "+v"(t));
    C.tid = t; C.lane = t & 63; C.wave = __builtin_amdgcn_readfirstlane(t >> 6);
    C.gw = (int)blockIdx.x * NWAVES + C.wave; C.NGW = (int)gridDim.x * NWAVES;
    float* op = fresh_ptr(args.out); unsigned char* wp = fresh_ptr(args.ws);
    C.lds = lds; C.out = op; C.ws = wp; return C;
}
__device__ __forceinline__ int batch_of_row(int r) { return r < MP ? (r >> 11) : BP + ((r - MP) >> 2); }


typedef GAS unsigned gu32;
#define RLX_AGENT __ATOMIC_RELAXED, __HIP_MEMORY_SCOPE_AGENT
#define XB_TMO      128
#define XB_XCNT(j)  (256  + 64 * (j))
#define XB_XSUB(j)  (1280 + 64 * (j))
#define XB_XGEN(j)  (2304 + 64 * (j))
#define XB_TOP      3328
#define XB_TOPGEN   3392
#define XCD_BAR_WORDS 3456
#define XB_SPIN_CAP (1u << 18)

__device__ __forceinline__ unsigned xb_ld(unsigned* p)              { return __hip_atomic_load(p, __ATOMIC_RELAXED, __HIP_MEMORY_SCOPE_AGENT); }
__device__ __forceinline__ unsigned xb_add(unsigned* p, unsigned v) { return __hip_atomic_fetch_add(p, v, __ATOMIC_RELAXED, __HIP_MEMORY_SCOPE_AGENT); }
__device__ __forceinline__ unsigned xb_xcc_id() { return (unsigned)__builtin_amdgcn_s_getreg((3 << 11) | 20) & 0xFu; }
#define XB_SPIN(cond, bar) do { unsigned _sp = 0; while (cond) { __builtin_amdgcn_s_sleep(1); \
    if ((++_sp & 255u) == 0u) { if (xb_ld(&(bar)[XB_TMO])) break; if (_sp > XB_SPIN_CAP) { atomicAdd(&(bar)[XB_TMO], 1u); break; } } } } while (0)

struct XcdBarrier {
    unsigned* bar; unsigned x;
    volatile LAS unsigned* st;
};

__device__ __forceinline__ XcdBarrier xcd_barrier_post(unsigned* bar, volatile LAS unsigned* st) {
    XcdBarrier b; b.bar = bar; b.x = xb_xcc_id(); b.st = st;
    if (threadIdx.x == 0) (void)xb_add(&bar[XB_XCNT(b.x)], 1u);
    return b;
}
__device__ __forceinline__ void xcd_barrier_complete(unsigned* bar, unsigned x, unsigned& nloc, unsigned& nx) {
    const unsigned G = gridDim.x * gridDim.y * gridDim.z;
    unsigned sum, cnt, mine, sp = 0u;
    for (;;) {
        sum = 0u; cnt = 0u; mine = 0u;
#pragma unroll
        for (unsigned j = 0; j < 16; ++j) { const unsigned c = xb_ld(&bar[XB_XCNT(j)]); sum += c; cnt += (c > 0u) ? 1u : 0u; mine = (j == x) ? c : mine; }
        if (sum == G) break;
        __builtin_amdgcn_s_sleep(1);
        if ((++sp & 255u) == 0u) { if (xb_ld(&bar[XB_TMO])) break; if (sp > XB_SPIN_CAP) { atomicAdd(&bar[XB_TMO], 1u); break; } }
    }
    nloc = mine > 0u ? mine : 1u; nx = cnt > 0u ? cnt : 1u;
}

__device__ __forceinline__ void xcd_barrier(const XcdBarrier& b) {
    asm volatile("s_waitcnt vmcnt(0)" ::: "memory");
    __syncthreads();
    if (threadIdx.x == 0) {
        unsigned* bar = b.bar;
        __builtin_amdgcn_s_waitcnt(0);
        unsigned nloc = b.st[0], nx = b.st[1];
        if (nloc == 0u) { xcd_barrier_complete(bar, b.x, nloc, nx); b.st[0] = nloc; b.st[1] = nx; }
        const unsigned old = xb_add(&bar[XB_XSUB(b.x)], 1u);
        const unsigned gen = old / nloc;
        if (old + 1u == (gen + 1u) * nloc) {
            __builtin_amdgcn_fence(__ATOMIC_RELEASE, "agent");
            asm volatile("s_waitcnt vmcnt(0)" ::: "memory");
            const unsigned og = xb_add(&bar[XB_TOP], 1u);
            const unsigned tg = og / nx;
            if (og + 1u == (tg + 1u) * nx) xb_add(&bar[XB_TOPGEN], 1u);
            else XB_SPIN(xb_ld(&bar[XB_TOPGEN]) == tg, bar);
            __builtin_amdgcn_fence(__ATOMIC_ACQUIRE, "agent");
            xb_add(&bar[XB_XGEN(b.x)], 1u);
            asm volatile("s_waitcnt vmcnt(0)" ::: "memory");
        } else {
            XB_SPIN(xb_ld(&bar[XB_XGEN(b.x)]) == gen, bar);
            __builtin_amdgcn_fence(__ATOMIC_ACQUIRE, "agent");
            asm volatile("s_waitcnt vmcnt(0)" ::: "memory");
        }
    }
    __syncthreads();
}

constexpr int MISC_OFF = LDS_BYTES - 256;
__device__ __forceinline__ void grid_bar(const Args& args, LAS unsigned char* lds) {
    XcdBarrier b; b.bar = (unsigned*)fresh_ptr(args.ws); b.x = xb_xcc_id(); b.st = (volatile LAS unsigned*)(lds + MISC_OFF);
    xcd_barrier(b);
}

__device__ __forceinline__ float wave_sum2(float v) { v = row16_sum(v); v += __shfl_xor(v, 16); v += __shfl_xor(v, 32); return v; }

namespace pg8 {
struct EpiSwiglu {
    static constexpr bool PERM = true, AFTER_DRAIN = false;
    bf16_t* O; int ldc;
    __device__ __forceinline__ void operator()(const f32x4 (&acc)[2][2][4][2], const Unit& u, int wr, int wc, int fr, int fq) const {
        const int row0 = u.pm * BM + wr * 64 + fr, col0 = u.pn * 128 + wc * 32 + 8 * fq;
#pragma unroll
        for (int ai = 0; ai < 2; ++ai)
#pragma unroll
            for (int m = 0; m < 4; ++m) {
                bf16_t* rowp = O + (size_t)(row0 + ai * HALF + m * 16) * ldc + col0;
                float h[8];
#pragma unroll
                for (int n = 0; n < 2; ++n)
#pragma unroll
                    for (int j = 0; j < 4; ++j) {
                        const float a = acc[ai][0][m][n][j], b = acc[ai][1][m][n][j];
                        const float e = __builtin_amdgcn_exp2f(-1.44269504f * a);
                        h[n * 4 + j] = a * __builtin_amdgcn_rcpf(1.0f + e) * b;
                    }
                u32x4 w; w.x = cvt_pk_bf16(h[0], h[1]); w.y = cvt_pk_bf16(h[2], h[3]); w.z = cvt_pk_bf16(h[4], h[5]); w.w = cvt_pk_bf16(h[6], h[7]);
                *(u32x4*)rowp = w;
            }
    }
};
struct EpiPlain {
    static constexpr bool PERM = true, AFTER_DRAIN = false;
    bf16_t* O; int ldc;
    __device__ __forceinline__ void operator()(const f32x4 (&acc)[2][2][4][2], const Unit& u, int wr, int wc, int fr, int fq) const {
        const int row0 = u.pm * BM + wr * 64 + fr, col0 = u.pn * BM + wc * 32 + 8 * fq;
#pragma unroll
        for (int ai = 0; ai < 2; ++ai)
#pragma unroll
            for (int m = 0; m < 4; ++m) {
                bf16_t* rowp = O + (size_t)(row0 + ai * HALF + m * 16) * ldc + col0;
#pragma unroll
                for (int bj = 0; bj < 2; ++bj) { const f32x4 v0 = acc[ai][bj][m][0], v1 = acc[ai][bj][m][1];
                    u32x4 w; w.x = cvt_pk_bf16(v0[0], v0[1]); w.y = cvt_pk_bf16(v0[2], v0[3]); w.z = cvt_pk_bf16(v1[0], v1[1]); w.w = cvt_pk_bf16(v1[2], v1[3]);
                    *(u32x4*)(rowp + bj * HALF) = w; }
            }
    }
};
struct EpiRes {
    static constexpr bool PERM = false, AFTER_DRAIN = false;
    float* X; const float* Xr; float* PART; const float* gate; const float* stats; const float* lg; const float* lb; float scale; int ntf;
    __device__ __forceinline__ void operator()(const f32x4 (&acc)[2][2][4][2], const Unit& u, int wr, int wc, int fr, int fq) const {
        const int col0 = u.pn * BM + wc * 32 + 4 * fq;
        if (u.nt == ntf) {
            const float* gp = gate + (size_t)(u.pm >> 3) * 9216 + col0;
            f32x4 gs[2][2], g4[2][2], b4[2][2];
#pragma unroll
            for (int bj = 0; bj < 2; ++bj)
#pragma unroll
                for (int n = 0; n < 2; ++n) { const int cc = bj * HALF + n * 16;
                    gs[bj][n] = *(const f32x4*)(gp + cc) * scale + scale; g4[bj][n] = *(const f32x4*)(lg + col0 + cc); b4[bj][n] = *(const f32x4*)(lb + col0 + cc) * 1.41421356237f; }
#pragma unroll
            for (int ai = 0; ai < 2; ++ai)
#pragma unroll
                for (int m = 0; m < 4; ++m) {
                    const int r = u.pm * BM + ai * HALF + wr * 64 + m * 16 + fr;
                    const f32x2 st = *(const f32x2*)(stats + 2 * (size_t)r); const float mean = st.x, rs = st.y * 1.41421356237f;
                    const float* yr = Xr + (size_t)r * 1024 + col0; float* xo = X + (size_t)r * 1024 + col0;
                    f32x4 y[2][2];
#pragma unroll
                    for (int bj = 0; bj < 2; ++bj)
#pragma unroll
                        for (int n = 0; n < 2; ++n) y[bj][n] = *(const f32x4*)(yr + bj * HALF + n * 16);
#pragma unroll
                    for (int bj = 0; bj < 2; ++bj)
#pragma unroll
                        for (int n = 0; n < 2; ++n)
                            *(f32x4*)(xo + bj * HALF + n * 16) = gs[bj][n] * acc[ai][bj][m][n] + ((y[bj][n] - mean) * rs * g4[bj][n] + b4[bj][n]);
                    asm volatile("" ::: "memory");
                }
            return;
        }
        float* pbase = PART + (size_t)(u.k0 / SplitOrder::PK) * (512 * 1024);
#pragma unroll
        for (int ai = 0; ai < 2; ++ai)
#pragma unroll
            for (int m = 0; m < 4; ++m) {
                const int r = u.pm * BM + ai * HALF + wr * 64 + m * 16 + fr - 16384;
                const float* gp = gate + (size_t)(8 + (r >> 2)) * 9216 + col0;
                float* xo = pbase + (size_t)r * 1024 + col0;
#pragma unroll
                for (int bj = 0; bj < 2; ++bj)
#pragma unroll
                    for (int n = 0; n < 2; ++n) { const int cc = bj * HALF + n * 16;
                        *(f32x4*)(xo + cc) = (*(const f32x4*)(gp + cc) * scale + scale) * acc[ai][bj][m][n]; }
                asm volatile("" ::: "memory");
            }
    }
};
struct EpiMod {
    static constexpr bool PERM = false, AFTER_DRAIN = false;
    float* MODp; const float* ada_b;
    __device__ __forceinline__ void operator()(const f32x4 (&acc)[2][2][4][2], const Unit& u, int wr, int wc, int fr, int fq) const {
        const int col0 = u.pn * BM + wc * 32 + 4 * fq;
        const int l = (u.pn * BM) / 9216;
#pragma unroll
        for (int ai = 0; ai < 2; ++ai)
#pragma unroll
            for (int m = 0; m < 4; ++m) {
                const int r = u.pm * BM + ai * HALF + wr * 64 + m * 16 + fr;
                if (r < 136) {
#pragma unroll
                    for (int bj = 0; bj < 2; ++bj)
#pragma unroll
                        for (int n = 0; n < 2; ++n) {
                            const int c = col0 + bj * HALF + n * 16;
                            const f32x4 o = acc[ai][bj][m][n] + *(const f32x4*)(ada_b + c);
                            *(f32x4*)(MODp + (size_t)(l * 136 + r) * 9216 + (c - l * 9216)) = o;
                        }
                }
            }
    }
};
}

__device__ __forceinline__ void transpose_item(const float* W, int K, int N, bf16* WT, int dest_row0, LAS float* scr, int k0, int n0, int lane) {
    const int nn = n0 + (lane & 31); const bool ok = nn < N;
    float tv[32];
#pragma unroll
    for (int i = 0; i < 32; ++i) { const int kk = 2 * i + (lane >> 5); tv[i] = ok ? W[(size_t)(k0 + kk) * N + nn] : 0.f; }
#pragma unroll
    for (int i = 0; i < 32; ++i) { const int kk = 2 * i + (lane >> 5); scr[kk * 33 + (lane & 31)] = tv[i]; }
    LDS_WAIT();
    const int c = lane & 7;
#pragma unroll
    for (int j = 0; j < 4; ++j) { const int n = (lane >> 3) + 8 * j; const LAS float* s = scr + (8 * c) * 33 + n;
        v4u o; o.x = pk2(s[0 * 33], s[1 * 33]); o.y = pk2(s[2 * 33], s[3 * 33]); o.z = pk2(s[4 * 33], s[5 * 33]); o.w = pk2(s[6 * 33], s[7 * 33]);
        *(v4u*)(WT + (size_t)(dest_row0 + n) * K + k0 + 8 * c) = o; }
    LDS_WAIT();
}

constexpr int I_WI = 16 * 176, I_WO = 44 * 32, I_WIN = 16 * 121, I_WOUT = 16 * 32, I_ADA = 16 * 288;
constexpr int I_MAIN = 2 * I_WI + 2 * I_WO + I_WIN + I_WOUT, I_LAYER = I_MAIN + I_ADA;
__device__ __forceinline__ void convert_item(const Args& args, unsigned char* ws, int l, int r, LAS float* scr, int lane) {
    unsigned char* wl = ws + WS_W + (size_t)l * W_LAYER;
    if (r < 2 * (I_WI + I_WO)) {
        const int f = r / (I_WI + I_WO); r -= f * (I_WI + I_WO);
        if (r < I_WI) {
            const int kb = r / 176, nb = r % 176, n0 = nb * 32;
            const int half = n0 / DFF, j = n0 - half * DFF, t = j >> 7, jj = j & 127;
            transpose_item((f ? args.in[15] : args.in[13]) + (size_t)l * D * NWI, D, NWI, (bf16*)(wl + (f ? W_WI2 : W_WI1)), 256 * t + 128 * half + jj, scr, kb * 64, n0, lane);
        } else { r -= I_WI;
            const int kb = r / 32, nb = r % 32;
            transpose_item((f ? args.in[16] : args.in[14]) + (size_t)l * DFF * D, DFF, D, (bf16*)(wl + (f ? W_WO2 : W_WO1)), nb * 32, scr, kb * 64, nb * 32, lane);
        }
        return;
    }
    r -= 2 * (I_WI + I_WO);
    if (r < I_WIN) { const int kb = r / 121, nb = r % 121;
        transpose_item(args.in[17] + (size_t)l * D * NIN, D, NIN, (bf16*)(wl + W_WIN), nb * 32, scr, kb * 64, nb * 32, lane); return; }
    r -= I_WIN;
    if (r < I_WOUT) { const int kb = r / 32, nb = r % 32;
        transpose_item(args.in[27] + (size_t)l * D * D, D, D, (bf16*)(wl + W_WOUT), nb * 32, scr, kb * 64, nb * 32, lane); return; }
    r -= I_WOUT;
    { const int kb = r / 288, nb = r % 288;
        transpose_item(args.in[9] + (size_t)l * D * NMODC, D, NMODC, (bf16*)(ws + WS_BIG), l * NMODC + nb * 32, scr, kb * 64, nb * 32, lane); }
}

__device__ __forceinline__ void p0_prologue(const Args& args, LAS unsigned char* lds_) {
    const Ctx C = make_ctx(args, lds_);
    LAS float* scr = (LAS float*)(C.lds + C.wave * 16384);
    for (int it = C.gw; it < 2 * I_ADA; it += C.NGW) convert_item(args, C.ws, it / I_ADA, I_MAIN + it % I_ADA, scr, C.lane);
    const int gt = C.gw * 64 + C.lane, NGT = C.NGW * 64;
    for (int i = gt; i < 2 * 224 * 128; i += NGT) { const int l = i / (224 * 128), rr = (i / 128) % 224, ch = i & 127;
        *(v4u*)(C.ws + WS_W + (size_t)l * W_LAYER + W_WIN + ((size_t)(3872 + rr) * 1024 + ch * 8) * 2) = (v4u){0u, 0u, 0u, 0u}; }
    for (int i = gt; i < 2048; i += NGT) ((float*)(C.ws + WS_ID))[i] = i < 1024 ? 1.0f : 0.f;
    for (int i = gt; i < 256 * 256; i += NGT) { const int row = i >> 8, c4 = (i & 255) * 4;
        v2u o = (v2u){0u, 0u};
        if (row < NB) { const float* src = row < BP ? args.in[7] + (size_t)row * D : args.in[8] + (size_t)(row - BP) * D; const f32x4 v = *(const f32x4*)(src + c4);
            o.x = pk2(siluf_(v.x), siluf_(v.y)); o.y = pk2(siluf_(v.z), siluf_(v.w)); }
        *(v2u*)(C.ws + WS_AC + ((size_t)row * D + c4) * 2) = o; }
    for (int i = gt; i < 2052 * 32; i += NGT) { const int p = i >> 5, j = i & 31; const double pos = p < 2048 ? (double)p : (double)(16384 + (p - 2048));
        double inv = 1.0; for (int q = 0; q < j; ++q) inv *= 0.7498942093324559;
        const double ang = pos * inv; const double n = rint(ang * 0.15915494309189535);
        const float rr = (float)((ang - n * 6.283185307179586) - n * 2.4492935982947064e-16);
        ((f32x2*)(C.ws + WS_ROPE))[i] = (f32x2){__cosf(rr), __sinf(rr)}; }
}

__device__ __forceinline__ void p1_convert(const Args& args, LAS unsigned char* lds_) {
    const Ctx C = make_ctx(args, lds_);
    if ((int)blockIdx.x < 72) return;
    LAS float* scr = (LAS float*)(C.lds + C.wave * 16384);
    constexpr int I_F0 = I_WI + I_WO, I_P0 = I_F0 + I_WIN;
    for (int it = ((int)blockIdx.x - 72) * NWAVES + C.wave; it < I_P0; it += 184 * NWAVES) {
        if (it < I_F0) convert_item(args, C.ws, 0, it, scr, C.lane);
        else convert_item(args, C.ws, 0, 2 * I_F0 + (it - I_F0), scr, C.lane);
    }
}

__device__ __forceinline__ void p2_modulate0(const Args& args, LAS unsigned char* lds_) {
    const Ctx C = make_ctx(args, lds_);
    const float* MOD = (const float*)(C.ws + WS_MOD); bf16* H = (bf16*)(C.ws + WS_H);
    auto rowp = [&](int r) { return r < MP ? args.in[0] + (size_t)r * D : args.in[1] + (size_t)(r - MP) * D; };
    f32x4 nx[4], nsh[4], nsc[4];
    auto ld = [&](int r) { const float* xr = rowp(r); const float* modr = MOD + (size_t)batch_of_row(r) * NMODC;
#pragma unroll
        for (int j = 0; j < 4; ++j) { const int c = (C.lane + 64 * j) * 4; nx[j] = *(const f32x4*)(xr + c); nsh[j] = *(const f32x4*)(modr + c); nsc[j] = *(const f32x4*)(modr + 1024 + c); } };
    if (C.gw < M) ld(C.gw);
#pragma unroll 1
    for (int r = C.gw; r < M; r += C.NGW) {
        f32x4 v[4], sh[4], sc[4];
#pragma unroll
        for (int j = 0; j < 4; ++j) { v[j] = nx[j]; sh[j] = nsh[j]; sc[j] = nsc[j]; }
        if (r + C.NGW < M) ld(r + C.NGW);
        if (C.lane == 0) *(f32x2*)((float*)(C.ws + WS_STATS) + 2 * (size_t)r) = (f32x2){0.f, 1.0f};
#pragma unroll
        for (int j = 0; j < 4; ++j) { const int c = (C.lane + 64 * j) * 4;
            const f32x4 h = v[j] * (sc[j] + 1.0f) + sh[j];
            if (r >= MP) *(f32x4*)(C.out + (size_t)r * D + c) = v[j] * ALPHA;
            *(v2u*)(H + (size_t)r * D + c) = (v2u){pk2(h.x, h.y), pk2(h.z, h.w)}; }
    }
}

__device__ __forceinline__ void ln_phase(const Args& args, LAS unsigned char* lds_, int l, int which, bool write_h, int hl, int shc, int npart, float xscale, bool write_x) {
    const Ctx C = make_ctx(args, lds_);
    const float* MOD = (const float*)(C.ws + WS_MOD); bf16* H = (bf16*)(C.ws + WS_H);
    const float* g = args.in[11] + (size_t)(l * 3 + which) * D; const float* b = args.in[12] + (size_t)(l * 3 + which) * D;
    f32x4 nv[4], gg[4], bb[4];
#pragma unroll
    for (int j = 0; j < 4; ++j) { gg[j] = *(const f32x4*)(g + (C.lane + 64 * j) * 4); bb[j] = *(const f32x4*)(b + (C.lane + 64 * j) * 4); }
    if (C.gw < M) {
#pragma unroll
        for (int j = 0; j < 4; ++j) nv[j] = *(const f32x4*)(C.out + (size_t)C.gw * D + (C.lane + 64 * j) * 4); }
#pragma unroll 1
    for (int r = C.gw; r < M; r += C.NGW) {
        float* xr = C.out + (size_t)r * D;
        f32x4 v[4]; float s = 0.f;
        const float* modr = MOD + (size_t)(hl * NB + batch_of_row(r)) * NMODC + shc * 1024;
        f32x4 msh[4], msc[4];
        if (write_h) {
#pragma unroll
            for (int j = 0; j < 4; ++j) { msh[j] = *(const f32x4*)(modr + (C.lane + 64 * j) * 4); msc[j] = *(const f32x4*)(modr + 1024 + (C.lane + 64 * j) * 4); } }
#pragma unroll
        for (int j = 0; j < 4; ++j) v[j] = nv[j];
        if (r + C.NGW < M) {
#pragma unroll
            for (int j = 0; j < 4; ++j) nv[j] = *(const f32x4*)(xr + (size_t)C.NGW * D + (C.lane + 64 * j) * 4); }
        if (r >= MP) { const float* pp = (const float*)(C.ws + WS_SB) + (size_t)(r - MP) * D;
#pragma unroll 1
            for (int p = 0; p < npart; ++p, pp += 512 * 1024) {
#pragma unroll
                for (int j = 0; j < 4; ++j) v[j] += *(const f32x4*)(pp + (C.lane + 64 * j) * 4); } }
#pragma unroll
        for (int j = 0; j < 4; ++j) s += (v[j].x + v[j].y) + (v[j].z + v[j].w);
        const float mean = wave_sum2(s) * (1.f / D); float s2 = 0.f;
#pragma unroll
        for (int j = 0; j < 4; ++j) { v[j] = v[j] - mean; s2 += (v[j].x * v[j].x + v[j].y * v[j].y) + (v[j].z * v[j].z + v[j].w * v[j].w); }
        const float rstd = rsqrtf(wave_sum2(s2) * (1.f / D) + LN_EPS);
        if (C.lane == 0) *(f32x2*)((float*)(C.ws + WS_STATS) + 2 * (size_t)r) = (f32x2){mean, rstd};
#pragma unroll
        for (int j = 0; j < 4; ++j) { const int c = (C.lane + 64 * j) * 4;
            const f32x4 xn = v[j] * rstd * gg[j] + bb[j];
            if (write_x || r >= MP) *(f32x4*)(xr + c) = xn * xscale;
            if (write_h) { const f32x4 sh = msh[j], sc = msc[j]; const f32x4 h = xn * (sc + 1.0f) + sh;
                *(v2u*)(H + (size_t)r * D + c) = (v2u){pk2(h.x, h.y), pk2(h.z, h.w)}; }
        }
    }
}

struct PrepRaw { unsigned short rq1[4], rq2[4], rk1[4], rk2[4], aq[2], hf[4], hq[4], dx[12], db, da; v4u alr0, alr1; };
__device__ __forceinline__ void prep_load(PrepRaw& x, const bf16* P, int lane) {
    const int j = lane & 31;
#pragma unroll
    for (int h = 0; h < 4; ++h) { x.rq1[h] = P[C_RQ + h * 64 + j]; x.rq2[h] = P[C_RQ + h * 64 + 32 + j]; x.rk1[h] = P[C_RK + h * 64 + j]; x.rk2[h] = P[C_RK + h * 64 + 32 + j]; }
    x.alr0 = *(const v4u*)(P + C_ALR); x.alr1 = *(const v4u*)(P + C_ALR + 8);
#pragma unroll
    for (int i = 0; i < 2; ++i) x.aq[i] = P[C_AQ + lane + 64 * i];
#pragma unroll
    for (int i = 0; i < 4; ++i) { x.hf[i] = P[C_HF + lane + 64 * i]; x.hq[i] = P[C_HQ + lane + 64 * i]; }
#pragma unroll
    for (int i = 0; i < 12; ++i) x.dx[i] = P[C_DQKV + lane + 64 * i];
    x.db = P[C_DB + (lane & 3)]; x.da = P[C_DA + (lane & 3)];
}

__device__ __forceinline__ void prep_phase(const Args& args, LAS unsigned char* lds_, int l) {
    const Ctx C = make_ctx(args, lds_);
    const bf16* PROJ = (const bf16*)(C.ws + WS_BIG); bf16* SB = (bf16*)(C.ws + WS_SB); float* SF = (float*)(C.ws + WS_SF);
    const f32x2* ROPE = (const f32x2*)(C.ws + WS_ROPE);
    const int lane = C.lane;
    const float* wg = args.in[18] + (size_t)l * 16 * 128; const float* bg = args.in[19] + (size_t)l * 128;
    const float* cw = args.in[21] + (size_t)l * 4 * 768;
    LAS float* lwg = (LAS float*)C.lds; LAS float* lcw = lwg + 16 * 128;
    for (int i = C.tid; i < 16 * 128; i += NWAVES * 64) lwg[i] = wg[i];
    for (int i = C.tid; i < 4 * 768; i += NWAVES * 64) lcw[i] = cw[i];
    __syncthreads();
    constexpr int CH = 9;
    const int r0 = C.gw * CH, r1 = min(r0 + CH, M);
    if (r0 >= M) return;
    float lbv[4];
#pragma unroll
    for (int i = 0; i < 4; ++i) { lbv[i] = 0.f; if (l == 1) lbv[i] = 1.0f / (1.0f + expf(args.in[20][lane + 64 * i] - args.in[20][256 + lane + 64 * i])); }
    const float a_neg = -expf(args.in[22][l * 4 + (lane & 3)]), dtb = args.in[23][l * 4 + (lane & 3)];
    const float bg0 = bg[lane], bg1 = bg[lane + 64];
    float w1[12], w2[12], w3[12];
    auto load_window = [&](int r) {
        const bool isp = r < MP; const int rs = r - MP; const int b = isp ? (r >> 11) : (rs >> 2), t = isp ? (r & 2047) : (rs & 3);
        const float* cst = args.in[6] + ((size_t)(l * BS + b) * 3) * 768;
#pragma unroll
        for (int i = 0; i < 12; ++i) { const int ch = lane + 64 * i; const bf16* Pc = PROJ + (size_t)r * NINP + C_DQKV + ch;
            w1[i] = t >= 1 ? bf2f(Pc[-1 * NINP]) : (isp ? 0.f : cst[2 * 768 + ch]);
            w2[i] = t >= 2 ? bf2f(Pc[-2 * NINP]) : (isp ? 0.f : cst[(1 + t) * 768 + ch]);
            w3[i] = t >= 3 ? bf2f(Pc[-3 * NINP]) : (isp ? 0.f : cst[t * 768 + ch]); }
    };
    PrepRaw A; prep_load(A, PROJ + (size_t)r0 * NINP, lane);
    load_window(r0);
#pragma unroll 1
    for (int r = r0; r < r1; ++r) {
        PrepRaw B = A;
        if (r + 1 < r1) prep_load(B, PROJ + (size_t)(r + 1) * NINP, lane);
        int zo = 0; asm volatile("" : "+v"(zo));
        const bool isp = r < MP; const int rs = r - MP;
        const int b = isp ? (r >> 11) : (rs >> 2), t = isp ? (r & 2047) : (rs & 3);
        const int ridx = isp ? t : 2048 + t;
        bf16* sb = SB + (size_t)r * SBW; float* sf = SF + (size_t)r * SFW;
        { const int j = lane & 31; const bool hi = lane >= 32; const f32x2 cs = ROPE[ridx * 32 + j];
#pragma unroll
          for (int h = 0; h < 4; ++h) {
              const float q1 = bf2f(A.rq1[h]), q2 = bf2f(A.rq2[h]), k1 = bf2f(A.rk1[h]), k2 = bf2f(A.rk2[h]);
              const float qo = hi ? (q1 * cs.y + q2 * cs.x) : (q1 * cs.x - q2 * cs.y);
              const float ko = hi ? (k1 * cs.y + k2 * cs.x) : (k1 * cs.x - k2 * cs.y);
              sb[SB_RQ + h * 64 + lane] = (bf16)(pk2(qo, 0.f) & 0xffffu);
              sb[SB_RK + h * 64 + lane] = (bf16)(pk2(ko * 0.125f, 0.f) & 0xffffu);
          } }
        { const unsigned aw[8] = {A.alr0.x, A.alr0.y, A.alr0.z, A.alr0.w, A.alr1.x, A.alr1.y, A.alr1.z, A.alr1.w};
          float x0 = bg0, x1 = bg1;
#pragma unroll
          for (int i = 0; i < 8; ++i) { const float a0 = bflo(aw[i]), a1 = bfhi(aw[i]);
              x0 += a0 * lwg[(2 * i) * 128 + lane + zo] + a1 * lwg[(2 * i + 1) * 128 + lane + zo];
              x1 += a0 * lwg[(2 * i) * 128 + lane + 64 + zo] + a1 * lwg[(2 * i + 1) * 128 + lane + 64 + zo]; }
          const float sp0 = fmaxf(-x0, 0.f) + __logf(1.0f + __expf(-fabsf(x0))), sp1 = fmaxf(-x1, 0.f) + __logf(1.0f + __expf(-fabsf(x1)));
          sf[SF_ADEC + lane] = __expf(-sp0 * (1.0f / 16.0f)); sf[SF_ADEC + lane + 64] = __expf(-sp1 * (1.0f / 16.0f));
          sb[SB_AQ + lane] = (bf16)(pk2(bf2f(A.aq[0]) * 0.17677669529663687f, 0.f) & 0xffffu);
          sb[SB_AQ + lane + 64] = (bf16)(pk2(bf2f(A.aq[1]) * 0.17677669529663687f, 0.f) & 0xffffu); }
#pragma unroll
        for (int i = 0; i < 4; ++i) { const int c = lane + 64 * i;
            sf[SF_HF + c] = lbv[i] + (1.0f - lbv[i]) * sigmoidf_(bf2f(A.hf[i]));
            sb[SB_HQ + c] = (bf16)(pk2(siluf_(bf2f(A.hq[i])) * 0.125f, 0.f) & 0xffffu); }
        { float* cso = isp ? C.out + O_PCONV + ((size_t)(l * BP + b) * 3) * 768 : C.out + O_SCONV + ((size_t)(l * BS + b) * 3) * 768;
          const int so = isp ? t - (TP - 3) : t - 1;
          float uu[12];
#pragma unroll
          for (int i = 0; i < 12; ++i) { const float x0 = bf2f(A.dx[i]);
              const LAS float* cwc = lcw + lane + 64 * i + zo;
              uu[i] = siluf_(x0 * cwc[3 * 768] + w1[i] * cwc[2 * 768] + w2[i] * cwc[768] + w3[i] * cwc[0]);
              if (so >= 0) cso[so * 768 + lane + 64 * i] = x0;
              w3[i] = w2[i]; w2[i] = w1[i]; w1[i] = x0; }
float qr[4];
#pragma unroll
          for (int i = 0; i < 12; ++i) { float sc = 1.0f;
              if (i < 8) { const float nn = wave_sum2(uu[i] * uu[i]); sc = rsqrtf(nn + RMS_EPS) * (i < 4 ? 0.125f : 1.0f); }
              const unsigned wbits = pk2(uu[i] * sc, 0.f) & 0xffffu;
              sb[SB_DQ + i * 64 + lane] = (bf16)wbits;
              if (i < 4) qr[i] = bf2f(wbits);
              else if (i < 8) { const float qk = wave_sum2(qr[i - 4] * bf2f(wbits)); if (lane == 0) sf[SF_QK + (i - 4)] = qk; } }
          if (lane < 4) { sf[SF_BETA + lane] = sigmoidf_(bf2f(A.db));
              const float xx = bf2f(A.da) + dtb; const float sp = fmaxf(xx, 0.f) + __logf(1.0f + __expf(-fabsf(xx)));
              sf[SF_DDEC + lane] = __expf(a_neg * sp); } }
        A = B;
        if (r + 1 < r1) { const int rn = r + 1; const bool ns = rn < MP ? ((rn & 2047) == 0) : (((rn - MP) & 3) == 0); if (ns) load_window(rn); }
    }
}

template <int KIND, int DH, int R> struct Raw { unsigned q[DH / 2]; unsigned k[DH / 2]; unsigned v[(R + 1) / 2]; float f[DH]; float be, de; };

template <int KIND, int DH, int R>
__device__ __forceinline__ void load_tok(Raw<KIND, DH, R>& x, const bf16* qp, const bf16* kp, const bf16* vp, const float* fp) {
    if constexpr (DH == 4) { const v2u w = *(const v2u*)qp; x.q[0] = w.x; x.q[1] = w.y; } else { x.q[0] = *(const unsigned*)qp; }
    if constexpr (KIND != 2) { if constexpr (DH == 4) { const v2u w = *(const v2u*)kp; x.k[0] = w.x; x.k[1] = w.y; } else { x.k[0] = *(const unsigned*)kp; } }
    if constexpr (R == 1) x.v[0] = *vp; else if constexpr (R == 2) x.v[0] = *(const unsigned*)vp; else { const v2u w = *(const v2u*)vp; x.v[0] = w.x; x.v[1] = w.y; }
    if constexpr (KIND == 1) { const f32x2 w = *(const f32x2*)fp; x.f[0] = w.x; x.f[1] = w.y; }
    if constexpr (KIND == 2) { const f32x4 w = *(const f32x4*)fp; x.f[0] = w.x; x.f[1] = w.y; x.f[2] = w.z; x.f[3] = w.w; }
    if constexpr (KIND == 3) { x.be = fp[0]; x.de = fp[4]; }
}

template <int KIND, int DH, int R>
__device__ __forceinline__ void scan_task(const Ctx& C, int row0, int T, int h, int slice, const float* sin, float* sout) {
    const bf16* PROJ = (const bf16*)(C.ws + WS_BIG); const bf16* SB = (const bf16*)(C.ws + WS_SB); const float* SF = (const float*)(C.ws + WS_SF);
    bf16* H = (bf16*)(C.ws + WS_H);
    const int lane = C.lane, dl = lane & 15, rw = lane >> 4;
    const int d0 = dl * DH, v0 = slice * (4 * R) + rw * R;
    constexpr int DK = 16 * DH;
    const bf16 *qp, *kp, *vp; const float* fp; int ks, vs;
    const bf16* sbr = SB + (size_t)row0 * SBW; const bf16* pr = PROJ + (size_t)row0 * NINP; const float* sfr = SF + (size_t)row0 * SFW;
    if constexpr (KIND == 0) { qp = sbr + SB_RQ + h * 64 + d0; kp = sbr + SB_RK + h * 64 + d0; ks = SBW; vp = pr + C_RV + h * 64 + v0; vs = NINP; fp = sfr; }
    if constexpr (KIND == 1) { qp = sbr + SB_AQ + h * 32 + d0; kp = pr + C_AK + h * 32 + d0; ks = NINP; vp = pr + C_AV + h * 64 + v0; vs = NINP; fp = sfr + SF_ADEC + h * 32 + d0; }
    if constexpr (KIND == 2) { qp = sbr + SB_HQ + h * 64 + d0; kp = sbr; ks = SBW; vp = pr + C_HI + h * 64 + v0; vs = NINP; fp = sfr + SF_HF + h * 64 + d0; }
    if constexpr (KIND == 3) { qp = sbr + SB_DQ + h * 64 + d0; kp = sbr + SB_DK + h * 64 + d0; ks = SBW; vp = sbr + SB_DV + h * 64 + v0; vs = SBW; fp = sfr + SF_BETA + h; }
    bf16* op = H + (size_t)row0 * D + KIND * 256 + h * 64 + v0;
    const float rdec = 1.0f - exp2f(-5.0f - (float)h);

    float S[DH][R];
#pragma unroll
    for (int dh = 0; dh < DH; ++dh)
#pragma unroll
        for (int vv = 0; vv < R; ++vv) S[dh][vv] = sin ? sin[(size_t)(d0 + dh) * 64 + v0 + vv] : 0.f;

    typedef Raw<KIND, DH, R> RawT;
    RawT A[4];
#pragma unroll
    for (int u = 0; u < 4; ++u) load_tok<KIND, DH, R>(A[u], qp + (size_t)u * SBW, kp + (size_t)u * ks, vp + (size_t)u * vs, fp + (size_t)u * SFW);
    for (int t0 = 0; t0 < T; t0 += 4) {
        RawT B[4];
        const bool more = t0 + 4 < T;
#pragma unroll
        for (int u = 0; u < 4; ++u) { B[u] = A[u]; }
        if (more) {
#pragma unroll
            for (int u = 0; u < 4; ++u) load_tok<KIND, DH, R>(B[u], qp + (size_t)(t0 + 4 + u) * SBW, kp + (size_t)(t0 + 4 + u) * ks, vp + (size_t)(t0 + 4 + u) * vs, fp + (size_t)(t0 + 4 + u) * SFW);
        }
#pragma unroll
        for (int u = 0; u < 4; ++u) {
            const RawT& x = A[u];
            float q[DH], k[DH], v[R];
            q[0] = bflo(x.q[0]); q[1] = bfhi(x.q[0]); if constexpr (DH == 4) { q[2] = bflo(x.q[1]); q[3] = bfhi(x.q[1]); }
            if constexpr (KIND != 2) { k[0] = bflo(x.k[0]); k[1] = bfhi(x.k[0]); if constexpr (DH == 4) { k[2] = bflo(x.k[1]); k[3] = bfhi(x.k[1]); } }
            if constexpr (R == 1) v[0] = bflo(x.v[0]);
            if constexpr (R >= 2) { v[0] = bflo(x.v[0]); v[1] = bfhi(x.v[0]); }
            if constexpr (R == 4) { v[2] = bflo(x.v[1]); v[3] = bfhi(x.v[1]); }
            float o[R];
            if constexpr (KIND == 3) {
                float ks_[R];
#pragma unroll
                for (int vv = 0; vv < R; ++vv) { float p = 0.f;
#pragma unroll
                    for (int dh = 0; dh < DH; ++dh) { S[dh][vv] *= x.de; p += k[dh] * S[dh][vv]; }
                    ks_[vv] = row16_sum(p); }
#pragma unroll
                for (int vv = 0; vv < R; ++vv) { const float uu = x.be * (v[vv] - ks_[vv]); float p = 0.f;
#pragma unroll
                    for (int dh = 0; dh < DH; ++dh) { S[dh][vv] += k[dh] * uu; p += q[dh] * S[dh][vv]; }
                    o[vv] = row16_sum(p); }
            } else {
#pragma unroll
                for (int dh = 0; dh < DH; ++dh) {
                    float dec, kk;
                    if constexpr (KIND == 0) { dec = rdec; kk = k[dh]; }
                    if constexpr (KIND == 1) { dec = x.f[dh]; kk = k[dh]; }
                    if constexpr (KIND == 2) { dec = x.f[dh]; kk = 1.0f - x.f[dh]; }
#pragma unroll
                    for (int vv = 0; vv < R; ++vv) S[dh][vv] = dec * S[dh][vv] + kk * v[vv];
                }
#pragma unroll
                for (int vv = 0; vv < R; ++vv) { float p = 0.f;
#pragma unroll
                    for (int dh = 0; dh < DH; ++dh) p += q[dh] * S[dh][vv];
                    o[vv] = row16_sum(p); }
            }
            if (dl == 0) {
                bf16* o_ = op + (size_t)(t0 + u) * D;
                if constexpr (R == 1) *o_ = (bf16)(pk2(o[0], 0.f) & 0xffffu);
                if constexpr (R == 2) *(unsigned*)o_ = pk2(o[0], o[1]);
                if constexpr (R == 4) *(v2u*)o_ = (v2u){pk2(o[0], o[1]), pk2(o[2], o[3])};
            }
        }
#pragma unroll
        for (int u = 0; u < 4; ++u) A[u] = B[u];
    }
#pragma unroll
    for (int dh = 0; dh < DH; ++dh)
#pragma unroll
        for (int vv = 0; vv < R; ++vv) sout[(size_t)(d0 + dh) * 64 + v0 + vv] = S[dh][vv];
    (void)DK;
}

template <int KIND, int DH, int R>
__device__ __forceinline__ void scan_long(const Ctx& C, LAS float* wl, int row0, int T, int h, int slice, float* sout) {
    constexpr int CT = 16, LR = 8, DK = LR * DH, NV = (64 / LR) * R, UNR = 8;
    constexpr bool HASK = true, GK = (KIND != 2), HASF = (KIND == 1 || KIND == 2), HASB = (KIND == 3);
    constexpr int OQ = 0, OK_ = OQ + CT * DK, OF = OK_ + (HASK ? CT * DK : 0), OV = OF + (HASF ? CT * DK : 0), OB = OV + CT * NV, BUF = OB + (HASB ? CT * 4 : 0);
    const bf16* PROJ = (const bf16*)(C.ws + WS_BIG); const bf16* SB = (const bf16*)(C.ws + WS_SB); const float* SF = (const float*)(C.ws + WS_SF);
    bf16* H = (bf16*)(C.ws + WS_H);
    const int lane = C.lane, dl = lane & (LR - 1), rw = lane / LR;
    const int d0 = dl * DH;
    const int stok = lane >> 2, spart = lane & 3;
    const GAS bf16 *qg, *kg, *vg; const GAS float *fg, *bg; int ks, vs;
    {
        const GAS bf16* sbr = (const GAS bf16*)(SB + (size_t)row0 * SBW); const GAS bf16* pr = (const GAS bf16*)(PROJ + (size_t)row0 * NINP); const GAS float* sfr = (const GAS float*)(SF + (size_t)row0 * SFW);
        const int vcol = slice * NV;
        if constexpr (KIND == 0) { qg = sbr + SB_RQ + h * 64; kg = sbr + SB_RK + h * 64; ks = SBW; vg = pr + C_RV + h * 64 + vcol; vs = NINP; fg = sfr; bg = sfr; }
        if constexpr (KIND == 1) { qg = sbr + SB_AQ + h * 32; kg = pr + C_AK + h * 32; ks = NINP; vg = pr + C_AV + h * 64 + vcol; vs = NINP; fg = sfr + SF_ADEC + h * 32; bg = sfr; }
        if constexpr (KIND == 2) { qg = sbr + SB_HQ + h * 64; kg = sbr; ks = SBW; vg = pr + C_HI + h * 64 + vcol; vs = NINP; fg = sfr + SF_HF + h * 64; bg = sfr; }
        if constexpr (KIND == 3) { qg = sbr + SB_DQ + h * 64; kg = sbr + SB_DK + h * 64; ks = SBW; vg = sbr + SB_DV + h * 64 + vcol; vs = SBW; fg = sfr; bg = sfr + SF_BETA + h; }
    }
    constexpr int QP = DK / 4;
    qg += (size_t)stok * SBW + spart * QP; kg += (size_t)stok * ks + spart * QP; fg += (size_t)stok * SFW + spart * QP;
    vg += (size_t)(lane & 15) * vs; bg += (size_t)(lane & 15) * SFW;
    GAS bf16* op = (GAS bf16*)(H + (size_t)row0 * D + KIND * 256 + h * 64 + slice * NV + rw * R);
    const float rdec = 1.0f - exp2f(-5.0f - (float)h);

    static_assert(R == 1, "scan_long: one column per lane row");
    f32x2 S2[DH / 2];
#pragma unroll
    for (int i = 0; i < DH / 2; ++i) S2[i] = (f32x2){0.f, 0.f};

    struct SR { v4u rq[QP / 8], rk[QP / 8]; f32x4 rf[QP / 4]; unsigned rv[NV / 2]; float rb0, rb1, rb2; };
    SR s0; s0.rb0 = s0.rb1 = s0.rb2 = 0.f;
    auto stage_load = [&](SR& sr, int c) {
        const size_t t = (size_t)c * CT;
#pragma unroll
        for (int i = 0; i < QP / 8; ++i) { sr.rq[i] = *(const GAS v4u*)(qg + t * SBW + i * 8); if constexpr (GK) sr.rk[i] = *(const GAS v4u*)(kg + t * ks + i * 8); }
        if constexpr (HASF) {
#pragma unroll
            for (int i = 0; i < QP / 4; ++i) sr.rf[i] = *(const GAS f32x4*)(fg + t * SFW + i * 4); }
        if (lane < 16) {
            if constexpr (NV == 4) { const v2u w = *(const GAS v2u*)(vg + t * vs); sr.rv[0] = w.x; sr.rv[1] = w.y; }
            if constexpr (NV == 8) { const v4u w = *(const GAS v4u*)(vg + t * vs); sr.rv[0] = w.x; sr.rv[1] = w.y; sr.rv[2] = w.z; sr.rv[3] = w.w; }
            if constexpr (NV == 16) { const v4u w = *(const GAS v4u*)(vg + t * vs), w2 = *(const GAS v4u*)(vg + t * vs + 8); sr.rv[0] = w.x; sr.rv[1] = w.y; sr.rv[2] = w.z; sr.rv[3] = w.w; sr.rv[4] = w2.x; sr.rv[5] = w2.y; sr.rv[6] = w2.z; sr.rv[7] = w2.w; }
            if constexpr (HASB) { sr.rb0 = bg[t * SFW]; sr.rb1 = bg[t * SFW + 4]; sr.rb2 = bg[t * SFW + 8]; }
        }
    };
    auto stage_write = [&](SR& sr, int b) {
        LAS float* base = wl + b * BUF;
#pragma unroll
        for (int i = 0; i < QP / 8; ++i) {
            LAS float* qd = base + OQ + stok * DK + spart * QP + i * 8;
            *(LAS f32x4*)qd = (f32x4){bflo(sr.rq[i].x), bfhi(sr.rq[i].x), bflo(sr.rq[i].y), bfhi(sr.rq[i].y)}; *(LAS f32x4*)(qd + 4) = (f32x4){bflo(sr.rq[i].z), bfhi(sr.rq[i].z), bflo(sr.rq[i].w), bfhi(sr.rq[i].w)};
            if constexpr (GK) { LAS float* kd = base + OK_ + stok * DK + spart * QP + i * 8;
                *(LAS f32x4*)kd = (f32x4){bflo(sr.rk[i].x), bfhi(sr.rk[i].x), bflo(sr.rk[i].y), bfhi(sr.rk[i].y)}; *(LAS f32x4*)(kd + 4) = (f32x4){bflo(sr.rk[i].z), bfhi(sr.rk[i].z), bflo(sr.rk[i].w), bfhi(sr.rk[i].w)}; }
        }
        if constexpr (HASF) {
#pragma unroll
            for (int i = 0; i < QP / 4; ++i) { *(LAS f32x4*)(base + OF + stok * DK + spart * QP + i * 4) = sr.rf[i];
                if constexpr (KIND == 2) *(LAS f32x4*)(base + OK_ + stok * DK + spart * QP + i * 4) = 1.0f - sr.rf[i]; } }
        if (lane < 16) {
#pragma unroll
            for (int i = 0; i < NV / 2; ++i) { base[OV + lane * NV + 2 * i] = bflo(sr.rv[i]); base[OV + lane * NV + 2 * i + 1] = bfhi(sr.rv[i]); }
            if constexpr (HASB) *(LAS f32x4*)(base + OB + lane * 4) = (f32x4){sr.rb0, sr.rb1, sr.rb2, 0.f};
        }
    };
    static_assert(2 * BUF * 4 <= 26624, "per-wave LDS");
    const int nch = T / CT;
    struct Opnd { f32x2 q2[DH / 2], k2[DH / 2], f2[DH / 2]; float v; f32x4 bd; };
    auto ldop = [&](Opnd& x, const LAS float* bq, const LAS float* bv, const LAS float* bb, int uu) {
#pragma unroll
        for (int i = 0; i < DH / 4; ++i) { const f32x4 w = *(const LAS f32x4*)(bq + OQ + uu * DK + 4 * i); x.q2[2 * i] = (f32x2){w.x, w.y}; x.q2[2 * i + 1] = (f32x2){w.z, w.w}; }
#pragma unroll
        for (int i = 0; i < DH / 4; ++i) { const f32x4 w = *(const LAS f32x4*)(bq + OK_ + uu * DK + 4 * i); x.k2[2 * i] = (f32x2){w.x, w.y}; x.k2[2 * i + 1] = (f32x2){w.z, w.w}; }
        if constexpr (HASF) {
#pragma unroll
            for (int i = 0; i < DH / 4; ++i) { const f32x4 w = *(const LAS f32x4*)(bq + OF + uu * DK + 4 * i); x.f2[2 * i] = (f32x2){w.x, w.y}; x.f2[2 * i + 1] = (f32x2){w.z, w.w}; } }
        x.v = bv[uu * NV];
        if constexpr (HASB) x.bd = *(const LAS f32x4*)(bb + uu * 4);
    };
    auto compute = [&](int c, const LAS float* base) {
#pragma unroll 1
        for (int ub = 0; ub < CT; ub += UNR) {
        float okeep[R];
#pragma unroll
        for (int vv = 0; vv < R; ++vv) okeep[vv] = 0.f;
        Opnd X; X.bd = (f32x4){0.f, 0.f, 0.f, 0.f};
#pragma unroll
        for (int i = 0; i < DH / 2; ++i) X.f2[i] = (f32x2){0.f, 0.f};
        const LAS float* bq = base + ub * DK + d0; const LAS float* bv = base + OV + ub * NV + rw; const LAS float* bb = base + OB + ub * 4;
        ldop(X, bq, bv, bb, 0);
#pragma unroll
        for (int uu_ = 0; uu_ < UNR; ++uu_) { const int u = ub + uu_;
            Opnd Y = X;
            if (uu_ + 1 < UNR) ldop(Y, bq, bv, bb, uu_ + 1);
            f32x2 (&q2)[DH / 2] = X.q2; f32x2 (&k2)[DH / 2] = X.k2; f32x2 (&f2)[DH / 2] = X.f2; const float vv_ = X.v; const f32x4 bd = X.bd;
            float o[1];
            if constexpr (KIND == 3) {
                f32x2 a = k2[0] * S2[0], bq_ = q2[0] * S2[0];
#pragma unroll
                for (int i = 1; i < DH / 2; ++i) { a = __builtin_elementwise_fma(k2[i], S2[i], a); bq_ = __builtin_elementwise_fma(q2[i], S2[i], bq_); }
                const float ks_ = row8_sum(a.x + a.y) * bd.y, qs_ = row8_sum(bq_.x + bq_.y) * bd.y;
                const float uu = bd.x * (vv_ - ks_);
                o[0] = __builtin_fmaf(bd.z, uu, qs_);
                const f32x2 de2 = (f32x2){bd.y, bd.y}, uu2 = (f32x2){uu, uu};
#pragma unroll
                for (int i = 0; i < DH / 2; ++i) S2[i] = __builtin_elementwise_fma(S2[i], de2, k2[i] * uu2);
            } else {
                const f32x2 v2 = (f32x2){vv_, vv_};
#pragma unroll
                for (int i = 0; i < DH / 2; ++i) {
                    f32x2 dec2;
                    if constexpr (KIND == 0) dec2 = (f32x2){rdec, rdec}; else dec2 = f2[i];
                    S2[i] = __builtin_elementwise_fma(S2[i], dec2, k2[i] * v2);
                }
            }
            if constexpr (KIND != 3)
            { f32x2 a = q2[0] * S2[0];
#pragma unroll
              for (int i = 1; i < DH / 2; ++i) a = __builtin_elementwise_fma(q2[i], S2[i], a);
              o[0] = row8_sum(a.x + a.y); }
#pragma unroll
            for (int vv = 0; vv < R; ++vv) okeep[vv] = (dl == uu_) ? o[vv] : okeep[vv];
            X = Y;
        }
        {
            GAS bf16* o_ = op + (size_t)(c * CT + ub + dl) * D;
            if constexpr (R == 1) *o_ = (bf16)(pk2(okeep[0], 0.f) & 0xffffu);
            if constexpr (R == 2) *(GAS unsigned*)o_ = pk2(okeep[0], okeep[1]);
            if constexpr (R == 4) *(GAS v2u*)o_ = (v2u){pk2(okeep[0], okeep[1]), pk2(okeep[2], okeep[3])};
        }
        }
    };
    stage_load(s0, 0); stage_write(s0, 0);
#pragma unroll 1
    for (int c = 0; c < nch; c += 2) {
        stage_load(s0, min(c + 1, nch - 1));
        compute(c, wl);
        stage_write(s0, 1);
        stage_load(s0, min(c + 2, nch - 1));
        compute(c + 1, wl + BUF);
        stage_write(s0, 0);
    }
    const int v0 = slice * NV + rw * R;
#pragma unroll
    for (int i = 0; i < DH / 2; ++i) { sout[(size_t)(d0 + 2 * i) * 64 + v0] = S2[i].x; sout[(size_t)(d0 + 2 * i + 1) * 64 + v0] = S2[i].y; }
}

__device__ __forceinline__ void scan_phase(const Args& args, LAS unsigned char* lds_, int l, int mode = 0) {
    const Ctx C = make_ctx(args, lds_);
    constexpr int NLONG = 1024, NSHORT = BS * 144;
    const int slot = C.wave * 256 + (int)blockIdx.x;
    const int nidle = C.NGW - NLONG - 256;
    for (int it = 0;; ++it) {
        int kind, b, h, slice, row0, T; bool isp;
        if (slot < NLONG) { if (it > 0 || mode == 2) break; isp = true; T = TP;
            const int kk_ = slot >> 8, i = slot & 255; kind = kk_ == 0 ? 3 : (kk_ == 1 ? 0 : (kk_ == 2 ? 2 : 1));
            { const int stream = (i & 7) | ((i >> 6) << 3); slice = (i >> 3) & 7; b = stream >> 2; h = stream & 3; }
            row0 = b * TP;
        } else { if (C.wave < 5) break;
            const int st = (slot - NLONG - 256) + it * nidle; if (st >= NSHORT || mode == 1) break; isp = false; T = TS;
            b = st / 144; int i = st - b * 144;
            if (i < 64) { kind = 3; h = i >> 4; slice = i & 15; }
            else if (i < 96) { i -= 64; kind = 0; h = i >> 3; slice = i & 7; }
            else if (i < 128) { i -= 96; kind = 2; h = i >> 3; slice = i & 7; }
            else { i -= 128; kind = 1; h = i >> 2; slice = i & 3; }
            row0 = MP + b * TS;
        }
        const int nbat = isp ? BP : BS;
        const size_t sidx = (size_t)((l * nbat + b) * 4 + h);
        if (isp) {
            LAS float* wl = (LAS float*)(C.lds + C.wave * 26624);
            if (kind == 0) scan_long<0, 8, 1>(C, wl, row0, T, h, slice, C.out + O_PRET + sidx * 4096);
            else if (kind == 1) scan_long<1, 4, 1>(C, wl, row0, T, h, slice, C.out + O_PGLA + sidx * 2048);
            else if (kind == 2) scan_long<2, 8, 1>(C, wl, row0, T, h, slice, C.out + O_PHG + sidx * 4096);
            else scan_long<3, 8, 1>(C, wl, row0, T, h, slice, C.out + O_PGDN + sidx * 4096);
        } else {
            if (kind == 0) { scan_task<0, 4, 2>(C, row0, T, h, slice, args.in[2] + sidx * 4096, C.out + O_SRET + sidx * 4096); }
            else if (kind == 1) { scan_task<1, 2, 4>(C, row0, T, h, slice, args.in[3] + sidx * 2048, C.out + O_SGLA + sidx * 2048); }
            else if (kind == 2) { scan_task<2, 4, 2>(C, row0, T, h, slice, args.in[4] + sidx * 4096, C.out + O_SHG + sidx * 4096); }
            else { scan_task<3, 4, 1>(C, row0, T, h, slice, args.in[5] + sidx * 4096, C.out + O_SGDN + sidx * 4096); }
        }
    }
    if (l == 0 && C.wave >= 5 && mode != 1) {
        LAS float* scr = (LAS float*)(C.lds + 4 * 26624 + (C.wave - 5) * 8704);
        constexpr int I_F0 = I_WI + I_WO, I_L0B = I_F0 + I_WOUT;
        for (int it = (C.wave - 5) * 256 + (int)blockIdx.x; it < I_L0B + I_MAIN; it += 768) {
            if (it < I_F0) convert_item(args, C.ws, 0, I_F0 + it, scr, C.lane);
            else if (it < I_L0B) convert_item(args, C.ws, 0, 2 * I_F0 + I_WIN + (it - I_F0), scr, C.lane);
            else convert_item(args, C.ws, 1, it - I_L0B, scr, C.lane);
        }
    }
}

__device__ __forceinline__ void post_phase(const Args& args, LAS unsigned char* lds_, int l) {
    const Ctx C = make_ctx(args, lds_);
    const bf16* PROJ = (const bf16*)(C.ws + WS_BIG); bf16* H = (bf16*)(C.ws + WS_H);
    const int lane = C.lane, mixer = lane >> 4, cc = (lane & 15) * 16;
    const int gbase = mixer == 0 ? C_RG : mixer == 1 ? C_AG : mixer == 2 ? C_HG : C_DG;
    const float* nw = mixer == 1 ? args.in[24] + l * 64 : mixer == 2 ? args.in[25] + l * 64 : args.in[26] + l * 64;
    float w[16];
#pragma unroll
    for (int i = 0; i < 16; ++i) w[i] = mixer == 0 ? 1.0f : nw[(cc + i) & 63];
    v4u na0, na1, ng0, ng1;
    if (C.gw < M) { const bf16* hp = H + (size_t)C.gw * D + lane * 16; const bf16* gp = PROJ + (size_t)C.gw * NINP + gbase + cc;
        na0 = *(const v4u*)hp; na1 = *(const v4u*)(hp + 8); ng0 = *(const v4u*)gp; ng1 = *(const v4u*)(gp + 8); }
#pragma unroll 1
    for (int r = C.gw; r < M; r += C.NGW) {
        bf16* hp = H + (size_t)r * D + lane * 16; const bf16* gp = PROJ + (size_t)r * NINP + gbase + cc;
        const v4u a0 = na0, a1 = na1, g0 = ng0, g1 = ng1;
        if (r + C.NGW < M) { const bf16* hn = hp + (size_t)C.NGW * D; const bf16* gn = gp + (size_t)C.NGW * NINP;
            na0 = *(const v4u*)hn; na1 = *(const v4u*)(hn + 8); ng0 = *(const v4u*)gn; ng1 = *(const v4u*)(gn + 8); }
        float y[16], g[16];
        const unsigned aw[8] = {a0.x, a0.y, a0.z, a0.w, a1.x, a1.y, a1.z, a1.w}, gw_[8] = {g0.x, g0.y, g0.z, g0.w, g1.x, g1.y, g1.z, g1.w};
        float ss = 0.f;
#pragma unroll
        for (int i = 0; i < 8; ++i) { y[2 * i] = bflo(aw[i]); y[2 * i + 1] = bfhi(aw[i]); g[2 * i] = bflo(gw_[i]); g[2 * i + 1] = bfhi(gw_[i]); ss += y[2 * i] * y[2 * i] + y[2 * i + 1] * y[2 * i + 1]; }
        ss = quad_sum(ss);
        const float rs = rsqrtf(ss * (1.0f / 64.0f) + RMS_EPS);
        unsigned ow[8];
#pragma unroll
        for (int i = 0; i < 8; ++i) ow[i] = pk2(y[2 * i] * rs * w[2 * i] * siluf_(g[2 * i]), y[2 * i + 1] * rs * w[2 * i + 1] * siluf_(g[2 * i + 1]));
        *(v4u*)hp = (v4u){ow[0], ow[1], ow[2], ow[3]}; *(v4u*)(hp + 8) = (v4u){ow[4], ow[5], ow[6], ow[7]};
    }
}

__global__ void __launch_bounds__(NWAVES * 64, 2) mega_fwd(Args args) {
    extern __shared__ __attribute__((aligned(16))) unsigned char lds[];
    cg::grid_group grid = cg::this_grid();
    LAS unsigned char* const LDSP = (LAS unsigned char*)lds;
    const int G = (int)gridDim.x, bx = (int)blockIdx.x;
    if (threadIdx.x < 64) ((LAS unsigned*)(LDSP + MISC_OFF))[threadIdx.x] = 0u;
    __syncthreads();
    (void)xcd_barrier_post((unsigned*)args.ws, (volatile LAS unsigned*)(LDSP + MISC_OFF));
#define FRESH() float* out_ = fresh_ptr(args.out); unsigned char* ws = fresh_ptr(args.ws); \
    float* MOD = (float*)(ws + WS_MOD); bf16* H = (bf16*)(ws + WS_H); bf16* BIG = (bf16*)(ws + WS_BIG); (void)MOD; (void)H; (void)BIG; (void)out_;

    p0_prologue(args, LDSP);
    if (args.ws == nullptr) grid.sync();
    grid_bar(args, LDSP);
    {
        FRESH();
        pg8::Gemm g{(const bf16*)(ws + WS_AC), BIG, 256, 2 * NMODC, D}; pg8::StaticOrder S; S.init(256, 2 * NMODC, G, bx, D);
        pg8::EpiMod E{MOD, args.in[10]};
        pg8::gemm_phase<pg8::EpiMod, pg8::StaticOrder, PG8_ALIGN, PG8_SP2>(LDSP, g, S, E);
    }
    p1_convert(args, LDSP);
    grid_bar(args, LDSP);
    p2_modulate0(args, LDSP);
    grid_bar(args, LDSP);
#pragma unroll 1
    for (int l = 0; l < 2; ++l) {
#pragma unroll 1
        for (int f = 0; f < 2; ++f) {
            if (f == 1) {
                {
                    FRESH();
                    pg8::Gemm g{H, (const bf16*)(ws + WS_W + (size_t)l * W_LAYER + W_WIN), M, NINP, D}; pg8::StaticOrder S; S.init(M, NINP, G, bx, D);
                    pg8::EpiPlain E{BIG, NINP};
                    pg8::gemm_phase<pg8::EpiPlain, pg8::StaticOrder, PG8_ALIGN, PG8_SP2>(LDSP, g, S, E);
                }
                grid_bar(args, LDSP);
                prep_phase(args, LDSP, l);
                grid_bar(args, LDSP);
                scan_phase(args, LDSP, l);
#ifdef PROBE_SCANMODE
                grid_bar(args, LDSP); scan_phase(args, LDSP, l, PROBE_SCANMODE);
#endif
                grid_bar(args, LDSP);
                post_phase(args, LDSP, l);
                grid_bar(args, LDSP);
                {
                    FRESH();
                    pg8::Gemm g{H, (const bf16*)(ws + WS_W + (size_t)l * W_LAYER + W_WOUT), M, D, D}; pg8::SplitOrder S; S.init(D, G, bx);
                    pg8::EpiRes E{out_, out_, (float*)(ws + WS_SB), MOD + (size_t)l * NB * NMODC + 5 * 1024, (const float*)(ws + WS_STATS), args.in[11] + (size_t)(l * 3) * D, args.in[12] + (size_t)(l * 3) * D, 1.0f, D / 64};
                    pg8::gemm_phase<pg8::EpiRes, pg8::SplitOrder, PG8_ALIGN, PG8_SP2>(LDSP, g, S, E);
                }
                grid_bar(args, LDSP);
                ln_phase(args, LDSP, l, 1, true, l, 6, 4, ALPHA, false);
                grid_bar(args, LDSP);
            }
            {
                FRESH();
                pg8::Gemm g{H, (const bf16*)(ws + WS_W + (size_t)l * W_LAYER + (f ? W_WI2 : W_WI1)), M, NWI, D}; pg8::StaticOrder S; S.init(M, NWI, G, bx, D);
                pg8::EpiSwiglu E{BIG, DFF};
                pg8::gemm_phase<pg8::EpiSwiglu, pg8::StaticOrder, PG8_ALIGN, PG8_SP2>(LDSP, g, S, E);
            }
            grid_bar(args, LDSP);
            {
                FRESH();
                pg8::Gemm g{BIG, (const bf16*)(ws + WS_W + (size_t)l * W_LAYER + (f ? W_WO2 : W_WO1)), M, D, DFF}; pg8::SplitOrder S; S.init(DFF, G, bx);
                const bool first = (l == 0 && f == 0); const int pinst = f ? l * 3 + 1 : l * 3 - 1;
                pg8::EpiRes E{out_, first ? args.in[0] : out_, (float*)(ws + WS_SB), MOD + (size_t)l * NB * NMODC + (f ? 8 : 2) * 1024, (const float*)(ws + WS_STATS),
                              first ? (const float*)(ws + WS_ID) : args.in[11] + (size_t)pinst * D, first ? (const float*)(ws + WS_ID) + 1024 : args.in[12] + (size_t)pinst * D, 0.5f, DFF / 64};
                pg8::gemm_phase<pg8::EpiRes, pg8::SplitOrder, PG8_ALIGN, PG8_SP2>(LDSP, g, S, E);
            }
            grid_bar(args, LDSP);
            if (f == 0) ln_phase(args, LDSP, l, 0, true, l, 3, 11, ALPHA, false);
            else ln_phase(args, LDSP, l, 2, l == 0, 1, 0, 11, l == 0 ? ALPHA : 1.0f, l == 1);
            if (!(l == 1 && f == 1)) grid_bar(args, LDSP);
        }
    }
}

extern "C" void kernel_launch(void* const* d_in, const int* in_sizes, int n_in, void* d_out, int out_size, void* d_ws, size_t ws_size, hipStream_t stream) {
    static int grid = 0;
    if (grid == 0) {
        if (n_in != 28 || (size_t)out_size != O_END || ws_size < WS_END) { fprintf(stderr, "kernel_launch: unexpected sizes n_in %d out %d ws %zu (need %zu)\n", n_in, out_size, ws_size, (size_t)WS_END); grid = -1; return; }
        int dev = 0, cus = 0, per_cu = 0;
        hipGetDevice(&dev); hipDeviceGetAttribute(&cus, hipDeviceAttributeMultiprocessorCount, dev);
        hipFuncSetAttribute((const void*)mega_fwd, hipFuncAttributeMaxDynamicSharedMemorySize, LDS_BYTES);
        hipOccupancyMaxActiveBlocksPerMultiprocessor(&per_cu, (const void*)mega_fwd, NWAVES * 64, LDS_BYTES);
        (void)hipGetLastError();
        if (per_cu < 1 || cus < 256) { fprintf(stderr, "kernel_launch: occupancy %d cus %d\n", per_cu, cus); grid = -1; return; }
        grid = 256;
    }
    if (grid < 0) return;
    if (hipMemsetAsync(d_ws, 0, 65536, stream) != hipSuccess) { fprintf(stderr, "memset failed\n"); return; }
    Args a{};
    for (int i = 0; i < 28; ++i) a.in[i] = (const float*)d_in[i];
    a.out = (float*)d_out; a.ws = (unsigned char*)d_ws;
    void* kargs[] = {&a};
    hipError_t e = hipLaunchCooperativeKernel((const void*)mega_fwd, dim3(grid), dim3(NWAVES * 64), kargs, LDS_BYTES, stream);
    if (e != hipSuccess) fprintf(stderr, "cooperative launch failed: %s\n", hipGetErrorString(e));
}
```

```cpp
#include <hip/hip_runtime.h>
#include <hip/hip_cooperative_groups.h>
#include <cstdio>
#include <cstdint>
namespace cg = cooperative_groups;
namespace pg8 {
#define PG8_LAS __attribute__((address_space(3)))
typedef unsigned short bf16_t;
typedef short bf16x8 __attribute__((ext_vector_type(8)));
typedef float f32x4 __attribute__((ext_vector_type(4)));
typedef unsigned u32x4 __attribute__((ext_vector_type(4)));
constexpr int BM = 256, BK = 64, HALF = 128, HTB = HALF * BK * 2  , STAGE_BYTES = 8 * HTB, NXCD = 8, WGM = 8;

__host__ __device__ __forceinline__ int lds_byte(int r, int c) { const int st = (r >> 4) * 2 + (c >> 5), rr = r & 15, cc = c & 31, ob = rr * 64 + cc * 2; return st * 1024 + (ob ^ (((ob >> 9) & 1) << 5)); }
__host__ __device__ __forceinline__ void stage_rc(int b, int& R, int& C) { const int st = b / 1024, sb = b % 1024, swz = sb ^ (((sb >> 9) & 1) << 5); R = (st >> 1) * 16 + swz / 64; C = (st & 1) * 32 + (swz % 64) / 2; }
__host__ __device__ __forceinline__ int perm32(int rho) { const int n = rho >> 4, i = rho & 15; return 8 * (i >> 2) + 4 * n + (i & 3); }

struct Unit { int pm, pn, k0, nt; };
struct Gemm { const bf16_t* A; const bf16_t* Bt; int M, N, K; };

struct StaticOrder {
    int nM, nN, nwg, G, c, ntf;
    __host__ __device__ void init(int M, int N, int G_, int c_, int K_ = 1024) { nM = M / BM; nN = N / BM; nwg = nM * nN; G = G_; c = c_; ntf = K_ / BK; }
    __host__ __device__ bool next(int i, Unit& u) const {
        const long L = (long)i * G + c; if (L >= nwg) return false;
        int wgid = (int)L; { const int q = nwg / NXCD, r = nwg % NXCD, xcd = wgid % NXCD, off = wgid / NXCD; wgid = (xcd < r ? xcd * (q + 1) : r * (q + 1) + (xcd - r) * q) + off; }
        const int nig = WGM * nN, gid = wgid / nig, fm = gid * WGM, gsz = (nM - fm) < WGM ? (nM - fm) : WGM;
        u.pm = fm + ((wgid % nig) % gsz); u.pn = (wgid % nig) / gsz; u.k0 = 0; u.nt = ntf; return true;
    }
    __device__ __forceinline__ void a_ready(const Unit&) const {}
    __device__ __forceinline__ void done(const Unit&) const {}
};

struct SplitOrder {
    StaticOrder base; int ppu, c;
    static constexpr int PK = 4;
    __host__ __device__ void init(int K_, int G_, int c_) { base.init(16384, 1024, G_, c_, K_); ppu = (K_ / BK) / PK; c = c_; }
    __host__ __device__ bool next(int i, Unit& u) const {
        if (i == 0) return base.next(0, u);
        if (i == 1 && c < 8 * ppu) { const int j = c / ppu, p = c - j * ppu; u.pm = 64 + (j >> 2); u.pn = j & 3; u.k0 = p * PK; u.nt = PK; return true; }
        return false;
    }
    __device__ __forceinline__ void a_ready(const Unit&) const {}
    __device__ __forceinline__ void done(const Unit&) const {}
};

__device__ __forceinline__ unsigned cvt_pk_bf16(float lo, float hi) { unsigned r; asm volatile("v_cvt_pk_bf16_f32 %0, %1, %2" : "=v"(r) : "v"(lo), "v"(hi)); return r; }
typedef float f32x2 __attribute__((ext_vector_type(2)));
__device__ __forceinline__ f32x2 gelu_pk(f32x2 v) {
    const f32x2 av = __builtin_elementwise_abs(v), d = av * 0.2316418882f + 1.0f;
    f32x2 t; t.x = __builtin_amdgcn_rcpf(d.x); t.y = __builtin_amdgcn_rcpf(d.y);
    f32x2 q = t * 0.5307027145f + (-0.7265760135f); q = q * t + 0.7107068705f; q = q * t + (-0.142248368f); q = q * t + 0.127414796f; q = q * t;
    const f32x2 s = (v * v) * (-0.72134752044f);
    f32x2 e; e.x = __builtin_amdgcn_exp2f(s.x); e.y = __builtin_amdgcn_exp2f(s.y);
    const f32x2 m = v * (q * e), r = v - m;
    f32x2 o; o.x = v.x < 0.f ? m.x : r.x; o.y = v.y < 0.f ? m.y : r.y; return o;
}

template <int ACT  > struct EpiBf16 {
    static constexpr bool PERM = true, AFTER_DRAIN = false; static_assert(ACT == 0 || ACT == 1, "EpiBf16: ACT is 0 (none) or 1 (gelu_pk)");
    bf16_t* O; int ldc; const float* bias; int split_cols; size_t split_stride; float scale0;
    __device__ __forceinline__ void operator()(const f32x4 (&acc)[2][2][4][2], const Unit& u, int wr, int wc, int fr, int fq) const {
        const int row0 = u.pm * BM + wr * 64 + fr; int colt = u.pn * BM; bf16_t* base = O;
        float sc = 1.f; if (split_cols) { const int t = colt / split_cols; base += (size_t)t * split_stride; colt -= t * split_cols; if (t == 0) sc = scale0; }
        const int col0 = colt + wc * 32 + 8 * fq, bcol0 = u.pn * BM + wc * 32 + 8 * fq;
        f32x4 bv[2][2];
#pragma unroll
        for (int bj = 0; bj < 2; ++bj)
#pragma unroll
            for (int n = 0; n < 2; ++n) bv[bj][n] = bias ? *(const f32x4*)(bias + bcol0 + bj * HALF + 4 * n) : (f32x4){0.f, 0.f, 0.f, 0.f};
#pragma unroll
        for (int ai = 0; ai < 2; ++ai)
#pragma unroll
            for (int m = 0; m < 4; ++m) { bf16_t* rowp = base + (size_t)(row0 + ai * HALF + m * 16) * ldc + col0;
#pragma unroll
                for (int bj = 0; bj < 2; ++bj) { f32x4 v0 = acc[ai][bj][m][0] + bv[bj][0], v1 = acc[ai][bj][m][1] + bv[bj][1];
                    if (ACT == 1) { f32x2 a = gelu_pk((f32x2){v0[0], v0[1]}), b = gelu_pk((f32x2){v0[2], v0[3]}), c = gelu_pk((f32x2){v1[0], v1[1]}), d = gelu_pk((f32x2){v1[2], v1[3]});
                        v0 = (f32x4){a.x, a.y, b.x, b.y}; v1 = (f32x4){c.x, c.y, d.x, d.y}; }
                    v0 = v0 * sc; v1 = v1 * sc; u32x4 w; w.x = cvt_pk_bf16(v0[0], v0[1]); w.y = cvt_pk_bf16(v0[2], v0[3]); w.z = cvt_pk_bf16(v1[0], v1[1]); w.w = cvt_pk_bf16(v1[2], v1[3]);
                    *(u32x4*)(rowp + bj * HALF) = w; } }
    }
};
template <class Epi, class Sched, bool ALIGN_EPI = false, bool SP2 = false>
__device__ __forceinline__ void gemm_phase(PG8_LAS unsigned char* lds, const Gemm g, const Sched& S, const Epi& E) {
    int tid_ = threadIdx.x; asm volatile("" : "+v"(tid_));
    const int tid = tid_, wid = __builtin_amdgcn_readfirstlane(tid >> 6), lane = tid & 63, wr = wid >> 2, wc = wid & 3, fr = lane & 15, fq = lane >> 4;
    const int K = g.K;
    unsigned voffA[2], voffB[2];
#pragma unroll
    for (int i = 0; i < 2; ++i) { int R, C; stage_rc(tid * 16 + i * 8192, R, C); const int Rb = Epi::PERM ? ((R & ~31) + perm32(R & 31)) : R;
        voffA[i] = (unsigned)(R * K + C) * 2u; voffB[i] = (unsigned)(Rb * K + C) * 2u; }
    const size_t kstep = (size_t)(BK * 2);
    const size_t hstep = (size_t)HALF * K * 2;
    const size_t tstep = 2 * hstep;
    const unsigned ldsw = (unsigned)wid * 1024u;
    const int aoff = lds_byte(wr * 64 + fr, fq * 8), boff = lds_byte(wc * 32 + fr, fq * 8);
#define PG8_SA(b, h) (((b) * 2 + (h)) * HTB)
#define PG8_SB(b, h) ((4 + (b) * 2 + (h)) * HTB)
#define PG8_STAGE(bufoff, gbase, voff) do { _Pragma("unroll") for (int _i = 0; _i < 2; ++_i) \
        __builtin_amdgcn_global_load_lds((const unsigned*)((const char*)(gbase) + (voff)[_i]), (PG8_LAS unsigned*)(lds + (bufoff) + ldsw + _i * 8192), 16, 0, 0); } while (0)
#define PG8_LDA(dst, b, h) do { _Pragma("unroll") for (int m = 0; m < 4; ++m) _Pragma("unroll") for (int k = 0; k < 2; ++k) dst[m][k] = *(const PG8_LAS bf16x8*)(lds + PG8_SA(b, h) + aoff + m * 2048 + k * 1024); } while (0)
#define PG8_LDB(dst, b, h) do { _Pragma("unroll") for (int n = 0; n < 2; ++n) _Pragma("unroll") for (int k = 0; k < 2; ++k) dst[n][k] = *(const PG8_LAS bf16x8*)(lds + PG8_SB(b, h) + boff + n * 2048 + k * 1024); } while (0)
#define PG8_MMA(ai, bj, At, Bt) do { __builtin_amdgcn_s_setprio(1); _Pragma("unroll") for (int m = 0; m < 4; ++m) _Pragma("unroll") for (int n = 0; n < 2; ++n) _Pragma("unroll") for (int k = 0; k < 2; ++k) \
        acc[ai][bj][m][n] = __builtin_amdgcn_mfma_f32_16x16x32_bf16(Bt[n][k], At[m][k], acc[ai][bj][m][n], 0, 0, 0); __builtin_amdgcn_s_setprio(0); } while (0)
#define PG8_WAIT_V(n) asm volatile("s_waitcnt vmcnt(" #n ")" ::: "memory")
#define PG8_WAIT_L(n) asm volatile("s_waitcnt lgkmcnt(" #n ")" ::: "memory")
#define PG8_BAR __builtin_amdgcn_s_barrier()
#define PG8_SCHED __builtin_amdgcn_sched_barrier(0)
    Unit cur, nxt; int ui = 0;
    if (!S.next(0, cur)) return;
    f32x4 acc[2][2][4][2];
#pragma unroll
    for (int a = 0; a < 2; ++a)
#pragma unroll
        for (int b = 0; b < 2; ++b)
#pragma unroll
            for (int m = 0; m < 4; ++m)
#pragma unroll
                for (int n = 0; n < 2; ++n) acc[a][b][m][n] = (f32x4){0.f, 0.f, 0.f, 0.f};
    bf16x8 At[4][2], B0[2][2], B1[2][2];
    const char* cA = (const char*)g.A + (size_t)cur.pm * tstep + (size_t)cur.k0 * kstep; const char* cB = (const char*)g.Bt + (size_t)cur.pn * tstep + (size_t)cur.k0 * kstep;
    S.a_ready(cur);
    if constexpr (SP2) {
        PG8_STAGE(PG8_SB(0, 0), cB, voffB); PG8_STAGE(PG8_SB(0, 1), cB + hstep, voffB); PG8_STAGE(PG8_SA(0, 0), cA, voffA); PG8_STAGE(PG8_SA(0, 1), cA + hstep, voffA);
        if (wr == 1) PG8_BAR;
        PG8_WAIT_V(2); PG8_BAR;
        PG8_STAGE(PG8_SB(1, 0), cB + kstep, voffB); PG8_STAGE(PG8_SA(1, 0), cA + kstep, voffA); PG8_STAGE(PG8_SB(1, 1), cB + hstep + kstep, voffB);
        PG8_WAIT_V(6); PG8_BAR;
    } else {
        PG8_STAGE(PG8_SB(0, 0), cB, voffB); PG8_STAGE(PG8_SA(0, 0), cA, voffA); PG8_STAGE(PG8_SB(0, 1), cB + hstep, voffB); PG8_STAGE(PG8_SA(0, 1), cA + hstep, voffA);
        if (wr == 1) PG8_BAR;
        PG8_WAIT_V(4); PG8_BAR;
        PG8_STAGE(PG8_SB(1, 0), cB + kstep, voffB); PG8_STAGE(PG8_SA(1, 0), cA + kstep, voffA); PG8_STAGE(PG8_SB(1, 1), cB + hstep + kstep, voffB);
        PG8_WAIT_V(6); PG8_BAR;
    }
    for (;;) {
        const bool has_next = S.next(ui + 1, nxt);
        const char* nA = has_next ? (const char*)g.A + (size_t)nxt.pm * tstep + (size_t)nxt.k0 * kstep : cA; const char* nB = has_next ? (const char*)g.Bt + (size_t)nxt.pn * tstep + (size_t)nxt.k0 * kstep : cB;
        const int nt = cur.nt;
        for (int t = 0; t < nt; t += 2) {
            const bool last = (t == nt - 2);
            const char* a1 = cA + (size_t)(t + 1) * kstep;
            const char* a2 = last ? nA : cA + (size_t)(t + 2) * kstep; const char* b2 = last ? nB : cB + (size_t)(t + 2) * kstep;
            const char* a3 = a2 + kstep; const char* b3 = b2 + kstep;
            if (last && has_next) S.a_ready(nxt);
            if constexpr (SP2) {
            PG8_LDB(B0, 0, 0); PG8_LDB(B1, 0, 1); PG8_SCHED; PG8_LDA(At, 0, 0); PG8_STAGE(PG8_SA(1, 1), a1 + hstep, voffA);
            PG8_WAIT_V(8); PG8_WAIT_L(0); PG8_BAR; PG8_MMA(0, 0, At, B0); PG8_MMA(0, 1, At, B1); PG8_BAR; PG8_SCHED;
            PG8_LDA(At, 0, 1); PG8_STAGE(PG8_SB(0, 0), b2, voffB); PG8_STAGE(PG8_SB(0, 1), b2 + hstep, voffB); PG8_STAGE(PG8_SA(0, 0), a2, voffA);
            PG8_WAIT_V(8); PG8_WAIT_L(0); PG8_BAR; PG8_MMA(1, 0, At, B0); PG8_MMA(1, 1, At, B1); PG8_BAR; PG8_SCHED;
            PG8_LDB(B0, 1, 0); PG8_LDB(B1, 1, 1); PG8_SCHED; PG8_LDA(At, 1, 0); PG8_STAGE(PG8_SA(0, 1), a2 + hstep, voffA);
            PG8_WAIT_V(8); PG8_WAIT_L(0); PG8_BAR; PG8_MMA(0, 0, At, B0); PG8_MMA(0, 1, At, B1); PG8_BAR; PG8_SCHED;
            PG8_LDA(At, 1, 1); PG8_STAGE(PG8_SB(1, 0), b3, voffB); PG8_STAGE(PG8_SB(1, 1), b3 + hstep, voffB); PG8_STAGE(PG8_SA(1, 0), a3, voffA);
            PG8_WAIT_V(8); PG8_WAIT_L(0); PG8_BAR; PG8_MMA(1, 0, At, B0); PG8_MMA(1, 1, At, B1); PG8_BAR; PG8_SCHED;
            } else {
            PG8_LDB(B0, 0, 0); PG8_SCHED; PG8_LDA(At, 0, 0); PG8_STAGE(PG8_SA(1, 1), a1 + hstep, voffA);
            PG8_WAIT_L(8); PG8_BAR; PG8_WAIT_L(0); PG8_MMA(0, 0, At, B0); PG8_BAR; PG8_SCHED;
            PG8_LDB(B1, 0, 1); PG8_STAGE(PG8_SB(0, 0), b2, voffB);
            PG8_BAR; PG8_WAIT_L(0); PG8_MMA(0, 1, At, B1); PG8_BAR;
            PG8_LDA(At, 0, 1); PG8_STAGE(PG8_SA(0, 0), a2, voffA);
            PG8_BAR; PG8_WAIT_L(0); PG8_MMA(1, 0, At, B0); PG8_BAR; PG8_SCHED;
            PG8_STAGE(PG8_SB(0, 1), b2 + hstep, voffB);
            PG8_WAIT_V(6); PG8_BAR; PG8_MMA(1, 1, At, B1); PG8_BAR;
            PG8_LDB(B0, 1, 0); PG8_SCHED; PG8_LDA(At, 1, 0); PG8_STAGE(PG8_SA(0, 1), a2 + hstep, voffA);
            PG8_WAIT_L(8); PG8_BAR; PG8_WAIT_L(0); PG8_MMA(0, 0, At, B0); PG8_BAR; PG8_SCHED;
            PG8_LDB(B1, 1, 1); PG8_STAGE(PG8_SB(1, 0), b3, voffB);
            PG8_BAR; PG8_WAIT_L(0); PG8_MMA(0, 1, At, B1); PG8_BAR;
            PG8_LDA(At, 1, 1); PG8_STAGE(PG8_SA(1, 0), a3, voffA);
            PG8_BAR; PG8_WAIT_L(0); PG8_MMA(1, 0, At, B0); PG8_BAR; PG8_SCHED;
            PG8_STAGE(PG8_SB(1, 1), b3 + hstep, voffB);
            PG8_WAIT_V(6); PG8_BAR; PG8_MMA(1, 1, At, B1); PG8_BAR;
            }
        }
        if constexpr (ALIGN_EPI) { if (wr == 0) PG8_BAR; }
        if constexpr (!Epi::AFTER_DRAIN) { E(acc, cur, wr, wc, fr, fq); S.done(cur); }
        if (!has_next) break;
#pragma unroll
        for (int a = 0; a < 2; ++a)
#pragma unroll
            for (int b = 0; b < 2; ++b)
#pragma unroll
                for (int m = 0; m < 4; ++m)
#pragma unroll
                    for (int n = 0; n < 2; ++n) acc[a][b][m][n] = (f32x4){0.f, 0.f, 0.f, 0.f};
        cur = nxt; cA = nA; cB = nB; ++ui;
        if constexpr (ALIGN_EPI) { if (wr == 1) PG8_BAR; }
    }
    PG8_WAIT_V(0);
    if constexpr (!ALIGN_EPI) { if (wr == 0) PG8_BAR; }
    PG8_BAR;
    if constexpr (Epi::AFTER_DRAIN) { E.fused(acc, cur, wr, wc, fr, fq, lds, wid, lane); S.done(cur); }
#undef PG8_SA
#undef PG8_SB
#undef PG8_STAGE
#undef PG8_LDA
#undef PG8_LDB
#undef PG8_MMA
#undef PG8_WAIT_V
#undef PG8_WAIT_L
#undef PG8_BAR
#undef PG8_SCHED
}
}
#define PG8_SP2 true
#define PG8_ALIGN true

constexpr int D = 1024, TP = 2048, BP = 8, BS = 128, TS = 4;
constexpr int MP = BP * TP, MS = BS * TS, M = MP + MS;
constexpr int DFF = 2816, NWI = 2 * DFF, NIN = 3864, NINP = 4096, NMODC = 9216, NB = BP + BS;
constexpr int SBW = 1664, SFW = 396;
constexpr float LN_EPS = 1e-5f, RMS_EPS = 1e-6f;
constexpr float ALPHA = 1.41421356237f;
constexpr int C_RQ = 0, C_RK = 256, C_RV = 512, C_RG = 768, C_AQ = 1024, C_AK = 1152, C_AV = 1280, C_ALR = 1536, C_AG = 1552,
              C_HQ = 1808, C_HF = 2064, C_HI = 2320, C_HG = 2576, C_DQKV = 2832, C_DB = 3600, C_DA = 3604, C_DG = 3608;
constexpr int SB_RQ = 0, SB_RK = 256, SB_AQ = 512, SB_HQ = 640, SB_DQ = 896, SB_DK = 1152, SB_DV = 1408;
constexpr int SF_ADEC = 0, SF_HF = 128, SF_BETA = 384, SF_DDEC = 388, SF_QK = 392;
constexpr size_t O_Y = 0;
constexpr size_t O_PRET = (size_t)M * D;
constexpr size_t O_PGLA = O_PRET + 2ull * BP * 4 * 64 * 64;
constexpr size_t O_PHG = O_PGLA + 2ull * BP * 4 * 32 * 64;
constexpr size_t O_PGDN = O_PHG + 2ull * BP * 4 * 64 * 64;
constexpr size_t O_PCONV = O_PGDN + 2ull * BP * 4 * 64 * 64;
constexpr size_t O_SRET = O_PCONV + 2ull * BP * 3 * 768;
constexpr size_t O_SGLA = O_SRET + 2ull * BS * 4 * 64 * 64;
constexpr size_t O_SHG = O_SGLA + 2ull * BS * 4 * 32 * 64;
constexpr size_t O_SGDN = O_SHG + 2ull * BS * 4 * 64 * 64;
constexpr size_t O_SCONV = O_SGDN + 2ull * BS * 4 * 64 * 64;
constexpr size_t O_END = O_SCONV + 2ull * BS * 3 * 768;

constexpr size_t MiB = 1u << 20;
constexpr size_t WS_ROPE = 1 * MiB;
constexpr size_t WS_AC = 2 * MiB;
constexpr size_t WS_MOD = 3 * MiB;
constexpr size_t WS_STATS = 2 * MiB + 512 * 1024;
constexpr size_t WS_ID = 2 * MiB + 768 * 1024;
constexpr size_t WS_W = 13 * MiB;
constexpr size_t W_WI1 = 0, W_WO1 = 11 * MiB, W_WI2 = W_WO1 + 5 * MiB + MiB / 2, W_WO2 = W_WI2 + 11 * MiB, W_WIN = W_WO2 + 5 * MiB + MiB / 2, W_WOUT = W_WIN + 8 * MiB, W_LAYER = 43 * MiB;
constexpr size_t WS_H = WS_W + 2 * W_LAYER;
constexpr size_t WS_BIG = WS_H + 33 * MiB;
constexpr size_t WS_SB = WS_BIG + 132 * MiB;
constexpr size_t WS_SF = WS_SB + 54 * MiB;
constexpr size_t WS_END = WS_SF + 26 * MiB;
static_assert((size_t)M * SBW * 2 <= 54 * MiB && (size_t)M * SFW * 4 <= 26 * MiB && (size_t)M * 4096 * 2 <= 132 * MiB && (size_t)M * D * 2 <= 33 * MiB, "ws map");

constexpr int LDS_BYTES = 147456;
constexpr int NWAVES = 8;

#define GAS __attribute__((address_space(1)))
#define LAS __attribute__((address_space(3)))
typedef unsigned short bf16;
typedef unsigned v4u __attribute__((ext_vector_type(4)));
typedef unsigned v2u __attribute__((ext_vector_type(2)));
typedef float f32x4 __attribute__((ext_vector_type(4)));
typedef float f32x2 __attribute__((ext_vector_type(2)));
#define LDS_WAIT() asm volatile("s_waitcnt lgkmcnt(0)" ::: "memory")

__device__ __forceinline__ float bf2f(unsigned b) { return __uint_as_float(b << 16); }
__device__ __forceinline__ float bflo(unsigned w) { return __uint_as_float(w << 16); }
__device__ __forceinline__ float bfhi(unsigned w) { return __uint_as_float(w & 0xffff0000u); }
__device__ __forceinline__ unsigned pk2(float lo, float hi) { return pg8::cvt_pk_bf16(lo, hi); }
__device__ __forceinline__ float sigmoidf_(float x) { return __builtin_amdgcn_rcpf(1.0f + __expf(-x)); }
__device__ __forceinline__ float siluf_(float x) { return x * __builtin_amdgcn_rcpf(1.0f + __expf(-x)); }
__device__ __forceinline__ float wave_sum(float v) {
#pragma unroll
    for (int o = 1; o < 64; o <<= 1) v += __shfl_xor(v, o);
    return v;
}
template <int CTRL> __device__ __forceinline__ float dppmov(float v) { return __int_as_float(__builtin_amdgcn_update_dpp(0, __float_as_int(v), CTRL, 0xf, 0xf, true)); }
__device__ __forceinline__ float quad_sum(float v) { v += dppmov<0xB1>(v); v += dppmov<0x4E>(v); return v; }
__device__ __forceinline__ float row8_sum(float v) { v += dppmov<0xB1>(v); v += dppmov<0x4E>(v); v += dppmov<0x141>(v); return v; }
__device__ __forceinline__ float row16_sum(float v) { v += dppmov<0xB1>(v); v += dppmov<0x4E>(v); v += dppmov<0x141>(v); v += dppmov<0x140>(v); return v; }

struct Args { const float* in[28]; float* out; unsigned char* ws; };

struct Ctx {
    int tid, lane, wave, gw, NGW;
    LAS unsigned char* lds;
    float* out; unsigned char* ws;
};
template <class T> __device__ __forceinline__ T* fresh_ptr(T* p) {
    unsigned lo = (unsigned)(uintptr_t)p, hi = (unsigned)((uintptr_t)p >> 32);
    asm volatile("" : "+v"(lo), "+v"(hi));
    lo = __builtin_amdgcn_readfirstlane(lo); hi = __builtin_amdgcn_readfirstlane(hi);
    return (T*)(__attribute__((address_space(1))) T*)(((uintptr_t)hi << 32) | (uintptr_t)lo);
}
__device__ __forceinline__ Ctx make_ctx(const Args& args, LAS unsigned char* lds) {
    Ctx C; int t = threadIdx.x; asm volatile("" : "+v"(t));
    C.tid = t; C.lane = t & 63; C.wave = __builtin_amdgcn_readfirstlane(t >> 6);
    C.gw = (int)blockIdx.x * NWAVES + C.wave; C.NGW = (int)gridDim.x * NWAVES;
    float* op = fresh_ptr(args.out); unsigned char* wp = fresh_ptr(args.ws);
    C.lds = lds; C.out = op; C.ws = wp; return C;
}
__device__ __forceinline__ int batch_of_row(int r) { return r < MP ? (r >> 11) : BP + ((r - MP) >> 2); }


typedef GAS unsigned gu32;
#define RLX_AGENT __ATOMIC_RELAXED, __HIP_MEMORY_SCOPE_AGENT
#define XB_TMO      128
#define XB_XCNT(j)  (256  + 64 * (j))
#define XB_XSUB(j)  (1280 + 64 * (j))
#define XB_XGEN(j)  (2304 + 64 * (j))
#define XB_TOP      3328
#define XB_TOPGEN   3392
#define XCD_BAR_WORDS 3456
#define XB_SPIN_CAP (1u << 18)

__device__ __forceinline__ unsigned xb_ld(unsigned* p)              { return __hip_atomic_load(p, __ATOMIC_RELAXED, __HIP_MEMORY_SCOPE_AGENT); }
__device__ __forceinline__ unsigned xb_add(unsigned* p, unsigned v) { return __hip_atomic_fetch_add(p, v, __ATOMIC_RELAXED, __HIP_MEMORY_SCOPE_AGENT); }
__device__ __forceinline__ unsigned xb_xcc_id() { return (unsigned)__builtin_amdgcn_s_getreg((3 << 11) | 20) & 0xFu; }
#define XB_SPIN(cond, bar) do { unsigned _sp = 0; while (cond) { __builtin_amdgcn_s_sleep(1); \
    if ((++_sp & 255u) == 0u) { if (xb_ld(&(bar)[XB_TMO])) break; if (_sp > XB_SPIN_CAP) { atomicAdd(&(bar)[XB_TMO], 1u); break; } } } } while (0)

struct XcdBarrier {
    unsigned* bar; unsigned x;
    volatile LAS unsigned* st;
};

__device__ __forceinline__ XcdBarrier xcd_barrier_post(unsigned* bar, volatile LAS unsigned* st) {
    XcdBarrier b; b.bar = bar; b.x = xb_xcc_id(); b.st = st;
    if (threadIdx.x == 0) (void)xb_add(&bar[XB_XCNT(b.x)], 1u);
    return b;
}
__device__ __forceinline__ void xcd_barrier_complete(unsigned* bar, unsigned x, unsigned& nloc, unsigned& nx) {
    const unsigned G = gridDim.x * gridDim.y * gridDim.z;
    unsigned sum, cnt, mine, sp = 0u;
    for (;;) {
        sum = 0u; cnt = 0u; mine = 0u;
#pragma unroll
        for (unsigned j = 0; j < 16; ++j) { const unsigned c = xb_ld(&bar[XB_XCNT(j)]); sum += c; cnt += (c > 0u) ? 1u : 0u; mine = (j == x) ? c : mine; }
        if (sum == G) break;
        __builtin_amdgcn_s_sleep(1);
        if ((++sp & 255u) == 0u) { if (xb_ld(&bar[XB_TMO])) break; if (sp > XB_SPIN_CAP) { atomicAdd(&bar[XB_TMO], 1u); break; } }
    }
    nloc = mine > 0u ? mine : 1u; nx = cnt > 0u ? cnt : 1u;
}

__device__ __forceinline__ void xcd_barrier(const XcdBarrier& b) {
    asm volatile("s_waitcnt vmcnt(0)" ::: "memory");
    __syncthreads();
    if (threadIdx.x == 0) {
        unsigned* bar = b.bar;
        __builtin_amdgcn_s_waitcnt(0);
        unsigned nloc = b.st[0], nx = b.st[1];
        if (nloc == 0u) { xcd_barrier_complete(bar, b.x, nloc, nx); b.st[0] = nloc; b.st[1] = nx; }
        const unsigned old = xb_add(&bar[XB_XSUB(b.x)], 1u);
        const unsigned gen = old / nloc;
        if (old + 1u == (gen + 1u) * nloc) {
            __builtin_amdgcn_fence(__ATOMIC_RELEASE, "agent");
            asm volatile("s_waitcnt vmcnt(0)" ::: "memory");
            const unsigned og = xb_add(&bar[XB_TOP], 1u);
            const unsigned tg = og / nx;
            if (og + 1u == (tg + 1u) * nx) xb_add(&bar[XB_TOPGEN], 1u);
            else XB_SPIN(xb_ld(&bar[XB_TOPGEN]) == tg, bar);
            __builtin_amdgcn_fence(__ATOMIC_ACQUIRE, "agent");
            xb_add(&bar[XB_XGEN(b.x)], 1u);
            asm volatile("s_waitcnt vmcnt(0)" ::: "memory");
        } else {
            XB_SPIN(xb_ld(&bar[XB_XGEN(b.x)]) == gen, bar);
            __builtin_amdgcn_fence(__ATOMIC_ACQUIRE, "agent");
            asm volatile("s_waitcnt vmcnt(0)" ::: "memory");
        }
    }
    __syncthreads();
}

constexpr int MISC_OFF = LDS_BYTES - 256;
__device__ __forceinline__ void grid_bar(const Args& args, LAS unsigned char* lds) {
    XcdBarrier b; b.bar = (unsigned*)fresh_ptr(args.ws); b.x = xb_xcc_id(); b.st = (volatile LAS unsigned*)(lds + MISC_OFF);
    xcd_barrier(b);
}

__device__ __forceinline__ float wave_sum2(float v) { v = row16_sum(v); v += __shfl_xor(v, 16); v += __shfl_xor(v, 32); return v; }

namespace pg8 {
struct EpiSwiglu {
    static constexpr bool PERM = true, AFTER_DRAIN = false;
    bf16_t* O; int ldc;
    __device__ __forceinline__ void operator()(const f32x4 (&acc)[2][2][4][2], const Unit& u, int wr, int wc, int fr, int fq) const {
        const int row0 = u.pm * BM + wr * 64 + fr, col0 = u.pn * 128 + wc * 32 + 8 * fq;
#pragma unroll
        for (int ai = 0; ai < 2; ++ai)
#pragma unroll
            for (int m = 0; m < 4; ++m) {
                bf16_t* rowp = O + (size_t)(row0 + ai * HALF + m * 16) * ldc + col0;
                float h[8];
#pragma unroll
                for (int n = 0; n < 2; ++n)
#pragma unroll
                    for (int j = 0; j < 4; ++j) {
                        const float a = acc[ai][0][m][n][j], b = acc[ai][1][m][n][j];
                        const float e = __builtin_amdgcn_exp2f(-1.44269504f * a);
                        h[n * 4 + j] = a * __builtin_amdgcn_rcpf(1.0f + e) * b;
                    }
                u32x4 w; w.x = cvt_pk_bf16(h[0], h[1]); w.y = cvt_pk_bf16(h[2], h[3]); w.z = cvt_pk_bf16(h[4], h[5]); w.w = cvt_pk_bf16(h[6], h[7]);
                *(u32x4*)rowp = w;
            }
    }
};
struct EpiPlain {
    static constexpr bool PERM = true, AFTER_DRAIN = false;
    bf16_t* O; int ldc;
    __device__ __forceinline__ void operator()(const f32x4 (&acc)[2][2][4][2], const Unit& u, int wr, int wc, int fr, int fq) const {
        const int row0 = u.pm * BM + wr * 64 + fr, col0 = u.pn * BM + wc * 32 + 8 * fq;
#pragma unroll
        for (int ai = 0; ai < 2; ++ai)
#pragma unroll
            for (int m = 0; m < 4; ++m) {
                bf16_t* rowp = O + (size_t)(row0 + ai * HALF + m * 16) * ldc + col0;
#pragma unroll
                for (int bj = 0; bj < 2; ++bj) { const f32x4 v0 = acc[ai][bj][m][0], v1 = acc[ai][bj][m][1];
                    u32x4 w; w.x = cvt_pk_bf16(v0[0], v0[1]); w.y = cvt_pk_bf16(v0[2], v0[3]); w.z = cvt_pk_bf16(v1[0], v1[1]); w.w = cvt_pk_bf16(v1[2], v1[3]);
                    *(u32x4*)(rowp + bj * HALF) = w; }
            }
    }
};
struct EpiRes {
    static constexpr bool PERM = false, AFTER_DRAIN = false;
    float* X; const float* Xr; float* PART; const float* gate; const float* stats; const float* lg; const float* lb; float scale; int ntf;
    __device__ __forceinline__ void operator()(const f32x4 (&acc)[2][2][4][2], const Unit& u, int wr, int wc, int fr, int fq) const {
        const int col0 = u.pn * BM + wc * 32 + 4 * fq;
        if (u.nt == ntf) {
            const float* gp = gate + (size_t)(u.pm >> 3) * 9216 + col0;
            f32x4 gs[2][2], g4[2][2], b4[2][2];
#pragma unroll
            for (int bj = 0; bj < 2; ++bj)
#pragma unroll
                for (int n = 0; n < 2; ++n) { const int cc = bj * HALF + n * 16;
                    gs[bj][n] = *(const f32x4*)(gp + cc) * scale + scale; g4[bj][n] = *(const f32x4*)(lg + col0 + cc); b4[bj][n] = *(const f32x4*)(lb + col0 + cc) * 1.41421356237f; }
#pragma unroll
            for (int ai = 0; ai < 2; ++ai)
#pragma unroll
                for (int m = 0; m < 4; ++m) {
                    const int r = u.pm * BM + ai * HALF + wr * 64 + m * 16 + fr;
                    const f32x2 st = *(const f32x2*)(stats + 2 * (size_t)r); const float mean = st.x, rs = st.y * 1.41421356237f;
                    const float* yr = Xr + (size_t)r * 1024 + col0; float* xo = X + (size_t)r * 1024 + col0;
                    f32x4 y[2][2];
#pragma unroll
                    for (int bj = 0; bj < 2; ++bj)
#pragma unroll
                        for (int n = 0; n < 2; ++n) y[bj][n] = *(const f32x4*)(yr + bj * HALF + n * 16);
#pragma unroll
                    for (int bj = 0; bj < 2; ++bj)
#pragma unroll
                        for (int n = 0; n < 2; ++n)
                            *(f32x4*)(xo + bj * HALF + n * 16) = gs[bj][n] * acc[ai][bj][m][n] + ((y[bj][n] - mean) * rs * g4[bj][n] + b4[bj][n]);
                    asm volatile("" ::: "memory");
                }
            return;
        }
        float* pbase = PART + (size_t)(u.k0 / SplitOrder::PK) * (512 * 1024);
#pragma unroll
        for (int ai = 0; ai < 2; ++ai)
#pragma unroll
            for (int m = 0; m < 4; ++m) {
                const int r = u.pm * BM + ai * HALF + wr * 64 + m * 16 + fr - 16384;
                const float* gp = gate + (size_t)(8 + (r >> 2)) * 9216 + col0;
                float* xo = pbase + (size_t)r * 1024 + col0;
#pragma unroll
                for (int bj = 0; bj < 2; ++bj)
#pragma unroll
                    for (int n = 0; n < 2; ++n) { const int cc = bj * HALF + n * 16;
                        *(f32x4*)(xo + cc) = (*(const f32x4*)(gp + cc) * scale + scale) * acc[ai][bj][m][n]; }
                asm volatile("" ::: "memory");
            }
    }
};
struct EpiMod {
    static constexpr bool PERM = false, AFTER_DRAIN = false;
    float* MODp; const float* ada_b;
    __device__ __forceinline__ void operator()(const f32x4 (&acc)[2][2][4][2], const Unit& u, int wr, int wc, int fr, int fq) const {
        const int col0 = u.pn * BM + wc * 32 + 4 * fq;
        const int l = (u.pn * BM) / 9216;
#pragma unroll
        for (int ai = 0; ai < 2; ++ai)
#pragma unroll
            for (int m = 0; m < 4; ++m) {
                const int r = u.pm * BM + ai * HALF + wr * 64 + m * 16 + fr;
                if (r < 136) {
#pragma unroll
                    for (int bj = 0; bj < 2; ++bj)
#pragma unroll
                        for (int n = 0; n < 2; ++n) {
                            const int c = col0 + bj * HALF + n * 16;
                            const f32x4 o = acc[ai][bj][m][n] + *(const f32x4*)(ada_b + c);
                            *(f32x4*)(MODp + (size_t)(l * 136 + r) * 9216 + (c - l * 9216)) = o;
                        }
                }
            }
    }
};
}

__device__ __forceinline__ void transpose_item(const float* W, int K, int N, bf16* WT, int dest_row0, LAS float* scr, int k0, int n0, int lane) {
    const int nn = n0 + (lane & 31); const bool ok = nn < N;
    float tv[32];
#pragma unroll
    for (int i = 0; i < 32; ++i) { const int kk = 2 * i + (lane >> 5); tv[i] = ok ? W[(size_t)(k0 + kk) * N + nn] : 0.f; }
#pragma unroll
    for (int i = 0; i < 32; ++i) { const int kk = 2 * i + (lane >> 5); scr[kk * 33 + (lane & 31)] = tv[i]; }
    LDS_WAIT();
    const int c = lane & 7;
#pragma unroll
    for (int j = 0; j < 4; ++j) { const int n = (lane >> 3) + 8 * j; const LAS float* s = scr + (8 * c) * 33 + n;
        v4u o; o.x = pk2(s[0 * 33], s[1 * 33]); o.y = pk2(s[2 * 33], s[3 * 33]); o.z = pk2(s[4 * 33], s[5 * 33]); o.w = pk2(s[6 * 33], s[7 * 33]);
        *(v4u*)(WT + (size_t)(dest_row0 + n) * K + k0 + 8 * c) = o; }
    LDS_WAIT();
}

constexpr int I_WI = 16 * 176, I_WO = 44 * 32, I_WIN = 16 * 121, I_WOUT = 16 * 32, I_ADA = 16 * 288;
constexpr int I_MAIN = 2 * I_WI + 2 * I_WO + I_WIN + I_WOUT, I_LAYER = I_MAIN + I_ADA;
__device__ __forceinline__ void convert_item(const Args& args, unsigned char* ws, int l, int r, LAS float* scr, int lane) {
    unsigned char* wl = ws + WS_W + (size_t)l * W_LAYER;
    if (r < 2 * (I_WI + I_WO)) {
        const int f = r / (I_WI + I_WO); r -= f * (I_WI + I_WO);
        if (r < I_WI) {
            const int kb = r / 176, nb = r % 176, n0 = nb * 32;
            const int half = n0 / DFF, j = n0 - half * DFF, t = j >> 7, jj = j & 127;
            transpose_item((f ? args.in[15] : args.in[13]) + (size_t)l * D * NWI, D, NWI, (bf16*)(wl + (f ? W_WI2 : W_WI1)), 256 * t + 128 * half + jj, scr, kb * 64, n0, lane);
        } else { r -= I_WI;
            const int kb = r / 32, nb = r % 32;
            transpose_item((f ? args.in[16] : args.in[14]) + (size_t)l * DFF * D, DFF, D, (bf16*)(wl + (f ? W_WO2 : W_WO1)), nb * 32, scr, kb * 64, nb * 32, lane);
        }
        return;
    }
    r -= 2 * (I_WI + I_WO);
    if (r < I_WIN) { const int kb = r / 121, nb = r % 121;
        transpose_item(args.in[17] + (size_t)l * D * NIN, D, NIN, (bf16*)(wl + W_WIN), nb * 32, scr, kb * 64, nb * 32, lane); return; }
    r -= I_WIN;
    if (r < I_WOUT) { const int kb = r / 32, nb = r % 32;
        transpose_item(args.in[27] + (size_t)l * D * D, D, D, (bf16*)(wl + W_WOUT), nb * 32, scr, kb * 64, nb * 32, lane); return; }
    r -= I_WOUT;
    { const int kb = r / 288, nb = r % 288;
        transpose_item(args.in[9] + (size_t)l * D * NMODC, D, NMODC, (bf16*)(ws + WS_BIG), l * NMODC + nb * 32, scr, kb * 64, nb * 32, lane); }
}

__device__ __forceinline__ void p0_prologue(const Args& args, LAS unsigned char* lds_) {
    const Ctx C = make_ctx(args, lds_);
    LAS float* scr = (LAS float*)(C.lds + C.wave * 16384);
    for (int it = C.gw; it < 2 * I_ADA; it += C.NGW) convert_item(args, C.ws, it / I_ADA, I_MAIN + it % I_ADA, scr, C.lane);
    const int gt = C.gw * 64 + C.lane, NGT = C.NGW * 64;
    for (int i = gt; i < 2 * 224 * 128; i += NGT) { const int l = i / (224 * 128), rr = (i / 128) % 224, ch = i & 127;
        *(v4u*)(C.ws + WS_W + (size_t)l * W_LAYER + W_WIN + ((size_t)(3872 + rr) * 1024 + ch * 8) * 2) = (v4u){0u, 0u, 0u, 0u}; }
    for (int i = gt; i < 2048; i += NGT) ((float*)(C.ws + WS_ID))[i] = i < 1024 ? 1.0f : 0.f;
    for (int i = gt; i < 256 * 256; i += NGT) { const int row = i >> 8, c4 = (i & 255) * 4;
        v2u o = (v2u){0u, 0u};
        if (row < NB) { const float* src = row < BP ? args.in[7] + (size_t)row * D : args.in[8] + (size_t)(row - BP) * D; const f32x4 v = *(const f32x4*)(src + c4);
            o.x = pk2(siluf_(v.x), siluf_(v.y)); o.y = pk2(siluf_(v.z), siluf_(v.w)); }
        *(v2u*)(C.ws + WS_AC + ((size_t)row * D + c4) * 2) = o; }
    for (int i = gt; i < 2052 * 32; i += NGT) { const int p = i >> 5, j = i & 31; const double pos = p < 2048 ? (double)p : (double)(16384 + (p - 2048));
        double inv = 1.0; for (int q = 0; q < j; ++q) inv *= 0.7498942093324559;
        const double ang = pos * inv; const double n = rint(ang * 0.15915494309189535);
        const float rr = (float)((ang - n * 6.283185307179586) - n * 2.4492935982947064e-16);
        ((f32x2*)(C.ws + WS_ROPE))[i] = (f32x2){__cosf(rr), __sinf(rr)}; }
}

__device__ __forceinline__ void p1_convert(const Args& args, LAS unsigned char* lds_) {
    const Ctx C = make_ctx(args, lds_);
    if ((int)blockIdx.x < 72) return;
    LAS float* scr = (LAS float*)(C.lds + C.wave * 16384);
    constexpr int I_F0 = I_WI + I_WO, I_P0 = I_F0 + I_WIN;
    for (int it = ((int)blockIdx.x - 72) * NWAVES + C.wave; it < I_P0; it += 184 * NWAVES) {
        if (it < I_F0) convert_item(args, C.ws, 0, it, scr, C.lane);
        else convert_item(args, C.ws, 0, 2 * I_F0 + (it - I_F0), scr, C.lane);
    }
}

__device__ __forceinline__ void p2_modulate0(const Args& args, LAS unsigned char* lds_) {
    const Ctx C = make_ctx(args, lds_);
    const float* MOD = (const float*)(C.ws + WS_MOD); bf16* H = (bf16*)(C.ws + WS_H);
    auto rowp = [&](int r) { return r < MP ? args.in[0] + (size_t)r * D : args.in[1] + (size_t)(r - MP) * D; };
    f32x4 nx[4], nsh[4], nsc[4];
    auto ld = [&](int r) { const float* xr = rowp(r); const float* modr = MOD + (size_t)batch_of_row(r) * NMODC;
#pragma unroll
        for (int j = 0; j < 4; ++j) { const int c = (C.lane + 64 * j) * 4; nx[j] = *(const f32x4*)(xr + c); nsh[j] = *(const f32x4*)(modr + c); nsc[j] = *(const f32x4*)(modr + 1024 + c); } };
    if (C.gw < M) ld(C.gw);
#pragma unroll 1
    for (int r = C.gw; r < M; r += C.NGW) {
        f32x4 v[4], sh[4], sc[4];
#pragma unroll
        for (int j = 0; j < 4; ++j) { v[j] = nx[j]; sh[j] = nsh[j]; sc[j] = nsc[j]; }
        if (r + C.NGW < M) ld(r + C.NGW);
        if (C.lane == 0) *(f32x2*)((float*)(C.ws + WS_STATS) + 2 * (size_t)r) = (f32x2){0.f, 1.0f};
#pragma unroll
        for (int j = 0; j < 4; ++j) { const int c = (C.lane + 64 * j) * 4;
            const f32x4 h = v[j] * (sc[j] + 1.0f) + sh[j];
            if (r >= MP) *(f32x4*)(C.out + (size_t)r * D + c) = v[j] * ALPHA;
            *(v2u*)(H + (size_t)r * D + c) = (v2u){pk2(h.x, h.y), pk2(h.z, h.w)}; }
    }
}

__device__ __forceinline__ void ln_phase(const Args& args, LAS unsigned char* lds_, int l, int which, bool write_h, int hl, int shc, int npart, float xscale, bool write_x) {
    const Ctx C = make_ctx(args, lds_);
    const float* MOD = (const float*)(C.ws + WS_MOD); bf16* H = (bf16*)(C.ws + WS_H);
    const float* g = args.in[11] + (size_t)(l * 3 + which) * D; const float* b = args.in[12] + (size_t)(l * 3 + which) * D;
    f32x4 nv[4], gg[4], bb[4];
#pragma unroll
    for (int j = 0; j < 4; ++j) { gg[j] = *(const f32x4*)(g + (C.lane + 64 * j) * 4); bb[j] = *(const f32x4*)(b + (C.lane + 64 * j) * 4); }
    if (C.gw < M) {
#pragma unroll
        for (int j = 0; j < 4; ++j) nv[j] = *(const f32x4*)(C.out + (size_t)C.gw * D + (C.lane + 64 * j) * 4); }
#pragma unroll 1
    for (int r = C.gw; r < M; r += C.NGW) {
        float* xr = C.out + (size_t)r * D;
        f32x4 v[4]; float s = 0.f;
        const float* modr = MOD + (size_t)(hl * NB + batch_of_row(r)) * NMODC + shc * 1024;
        f32x4 msh[4], msc[4];
        if (write_h) {
#pragma unroll
            for (int j = 0; j < 4; ++j) { msh[j] = *(const f32x4*)(modr + (C.lane + 64 * j) * 4); msc[j] = *(const f32x4*)(modr + 1024 + (C.lane + 64 * j) * 4); } }
#pragma unroll
        for (int j = 0; j < 4; ++j) v[j] = nv[j];
        if (r + C.NGW < M) {
#pragma unroll
            for (int j = 0; j < 4; ++j) nv[j] = *(const f32x4*)(xr + (size_t)C.NGW * D + (C.lane + 64 * j) * 4); }
        if (r >= MP) { const float* pp = (const float*)(C.ws + WS_SB) + (size_t)(r - MP) * D;
#pragma unroll 1
            for (int p = 0; p < npart; ++p, pp += 512 * 1024) {
#pragma unroll
                for (int j = 0; j < 4; ++j) v[j] += *(const f32x4*)(pp + (C.lane + 64 * j) * 4); } }
#pragma unroll
        for (int j = 0; j < 4; ++j) s += (v[j].x + v[j].y) + (v[j].z + v[j].w);
        const float mean = wave_sum2(s) * (1.f / D); float s2 = 0.f;
#pragma unroll
        for (int j = 0; j < 4; ++j) { v[j] = v[j] - mean; s2 += (v[j].x * v[j].x + v[j].y * v[j].y) + (v[j].z * v[j].z + v[j].w * v[j].w); }
        const float rstd = rsqrtf(wave_sum2(s2) * (1.f / D) + LN_EPS);
        if (C.lane == 0) *(f32x2*)((float*)(C.ws + WS_STATS) + 2 * (size_t)r) = (f32x2){mean, rstd};
#pragma unroll
        for (int j = 0; j < 4; ++j) { const int c = (C.lane + 64 * j) * 4;
            const f32x4 xn = v[j] * rstd * gg[j] + bb[j];
            if (write_x || r >= MP) *(f32x4*)(xr + c) = xn * xscale;
            if (write_h) { const f32x4 sh = msh[j], sc = msc[j]; const f32x4 h = xn * (sc + 1.0f) + sh;
                *(v2u*)(H + (size_t)r * D + c) = (v2u){pk2(h.x, h.y), pk2(h.z, h.w)}; }
        }
    }
}

struct PrepRaw { unsigned short rq1[4], rq2[4], rk1[4], rk2[4], aq[2], hf[4], hq[4], dx[12], db, da; v4u alr0, alr1; f32x2 cs; };
__device__ __forceinline__ void prep_load(PrepRaw& x, const bf16* P, int lane, const f32x2* rope_row) {
    const int j = lane & 31;
    x.cs = rope_row[j];
#pragma unroll
    for (int h = 0; h < 4; ++h) { x.rq1[h] = P[C_RQ + h * 64 + j]; x.rq2[h] = P[C_RQ + h * 64 + 32 + j]; x.rk1[h] = P[C_RK + h * 64 + j]; x.rk2[h] = P[C_RK + h * 64 + 32 + j]; }
    x.alr0 = *(const v4u*)(P + C_ALR); x.alr1 = *(const v4u*)(P + C_ALR + 8);
#pragma unroll
    for (int i = 0; i < 2; ++i) x.aq[i] = P[C_AQ + lane + 64 * i];
#pragma unroll
    for (int i = 0; i < 4; ++i) { x.hf[i] = P[C_HF + lane + 64 * i]; x.hq[i] = P[C_HQ + lane + 64 * i]; }
#pragma unroll
    for (int i = 0; i < 12; ++i) x.dx[i] = P[C_DQKV + lane + 64 * i];
    x.db = P[C_DB + (lane & 3)]; x.da = P[C_DA + (lane & 3)];
}

__device__ __forceinline__ void prep_phase(const Args& args, LAS unsigned char* lds_, int l) {
    const Ctx C = make_ctx(args, lds_);
    const bf16* PROJ = (const bf16*)(C.ws + WS_BIG); bf16* SB = (bf16*)(C.ws + WS_SB); float* SF = (float*)(C.ws + WS_SF);
    const f32x2* ROPE = (const f32x2*)(C.ws + WS_ROPE);
    const int lane = C.lane;
    const float* wg = args.in[18] + (size_t)l * 16 * 128; const float* bg = args.in[19] + (size_t)l * 128;
    const float* cw = args.in[21] + (size_t)l * 4 * 768;
    LAS float* lwg = (LAS float*)C.lds; LAS float* lcw = lwg + 16 * 128;
    for (int i = C.tid; i < 16 * 128; i += NWAVES * 64) lwg[i] = wg[i];
    for (int i = C.tid; i < 4 * 768; i += NWAVES * 64) lcw[i] = cw[i];
    __syncthreads();
    constexpr int CH = 9;
    const int r0 = C.gw * CH, r1 = min(r0 + CH, M);
    if (r0 >= M) return;
    float lbv[4];
#pragma unroll
    for (int i = 0; i < 4; ++i) { lbv[i] = 0.f; if (l == 1) lbv[i] = 1.0f / (1.0f + expf(args.in[20][lane + 64 * i] - args.in[20][256 + lane + 64 * i])); }
    const float a_neg = -expf(args.in[22][l * 4 + (lane & 3)]), dtb = args.in[23][l * 4 + (lane & 3)];
    const float bg0 = bg[lane], bg1 = bg[lane + 64];
    float w1[12], w2[12], w3[12];
    auto load_window = [&](int r) {
        const bool isp = r < MP; const int rs = r - MP; const int b = isp ? (r >> 11) : (rs >> 2), t = isp ? (r & 2047) : (rs & 3);
        const float* cst = args.in[6] + ((size_t)(l * BS + b) * 3) * 768;
#pragma unroll
        for (int i = 0; i < 12; ++i) { const int ch = lane + 64 * i; const bf16* Pc = PROJ + (size_t)r * NINP + C_DQKV + ch;
            w1[i] = t >= 1 ? bf2f(Pc[-1 * NINP]) : (isp ? 0.f : cst[2 * 768 + ch]);
            w2[i] = t >= 2 ? bf2f(Pc[-2 * NINP]) : (isp ? 0.f : cst[(1 + t) * 768 + ch]);
            w3[i] = t >= 3 ? bf2f(Pc[-3 * NINP]) : (isp ? 0.f : cst[t * 768 + ch]); }
    };
    auto rope_of = [&](int r) { return ROPE + (size_t)(r < MP ? (r & 2047) : 2048 + ((r - MP) & 3)) * 32; };
    PrepRaw A; prep_load(A, PROJ + (size_t)r0 * NINP, lane, rope_of(r0));
    load_window(r0);
#pragma unroll 1
    for (int r = r0; r < r1; ++r) {
        PrepRaw B = A;
        if (r + 1 < r1) prep_load(B, PROJ + (size_t)(r + 1) * NINP, lane, rope_of(r + 1));
        int zo = 0; asm volatile("" : "+v"(zo));
        const bool isp = r < MP; const int rs = r - MP;
        const int b = isp ? (r >> 11) : (rs >> 2), t = isp ? (r & 2047) : (rs & 3);
        const int ridx = isp ? t : 2048 + t;
        bf16* sb = SB + (size_t)r * SBW; float* sf = SF + (size_t)r * SFW;
        { const bool hi = lane >= 32; const f32x2 cs = A.cs;
#pragma unroll
          for (int h = 0; h < 4; ++h) {
              const float q1 = bf2f(A.rq1[h]), q2 = bf2f(A.rq2[h]), k1 = bf2f(A.rk1[h]), k2 = bf2f(A.rk2[h]);
              const float qo = hi ? (q1 * cs.y + q2 * cs.x) : (q1 * cs.x - q2 * cs.y);
              const float ko = hi ? (k1 * cs.y + k2 * cs.x) : (k1 * cs.x - k2 * cs.y);
              sb[SB_RQ + h * 64 + lane] = (bf16)(pk2(qo, 0.f) & 0xffffu);
              sb[SB_RK + h * 64 + lane] = (bf16)(pk2(ko * 0.125f, 0.f) & 0xffffu);
          } }
        { const unsigned aw[8] = {A.alr0.x, A.alr0.y, A.alr0.z, A.alr0.w, A.alr1.x, A.alr1.y, A.alr1.z, A.alr1.w};
          float x0 = bg0, x1 = bg1;
#pragma unroll
          for (int i = 0; i < 8; ++i) { const float a0 = bflo(aw[i]), a1 = bfhi(aw[i]);
              x0 += a0 * lwg[(2 * i) * 128 + lane + zo] + a1 * lwg[(2 * i + 1) * 128 + lane + zo];
              x1 += a0 * lwg[(2 * i) * 128 + lane + 64 + zo] + a1 * lwg[(2 * i + 1) * 128 + lane + 64 + zo]; }
          const float sp0 = fmaxf(-x0, 0.f) + __logf(1.0f + __expf(-fabsf(x0))), sp1 = fmaxf(-x1, 0.f) + __logf(1.0f + __expf(-fabsf(x1)));
          sf[SF_ADEC + lane] = __expf(-sp0 * (1.0f / 16.0f)); sf[SF_ADEC + lane + 64] = __expf(-sp1 * (1.0f / 16.0f));
          sb[SB_AQ + lane] = (bf16)(pk2(bf2f(A.aq[0]) * 0.17677669529663687f, 0.f) & 0xffffu);
          sb[SB_AQ + lane + 64] = (bf16)(pk2(bf2f(A.aq[1]) * 0.17677669529663687f, 0.f) & 0xffffu); }
#pragma unroll
        for (int i = 0; i < 4; ++i) { const int c = lane + 64 * i;
            sf[SF_HF + c] = lbv[i] + (1.0f - lbv[i]) * sigmoidf_(bf2f(A.hf[i]));
            sb[SB_HQ + c] = (bf16)(pk2(siluf_(bf2f(A.hq[i])) * 0.125f, 0.f) & 0xffffu); }
        { float* cso = isp ? C.out + O_PCONV + ((size_t)(l * BP + b) * 3) * 768 : C.out + O_SCONV + ((size_t)(l * BS + b) * 3) * 768;
          const int so = isp ? t - (TP - 3) : t - 1;
          float uu[12];
#pragma unroll
          for (int i = 0; i < 12; ++i) { const float x0 = bf2f(A.dx[i]);
              const LAS float* cwc = lcw + lane + 64 * i + zo;
              uu[i] = siluf_(x0 * cwc[3 * 768] + w1[i] * cwc[2 * 768] + w2[i] * cwc[768] + w3[i] * cwc[0]);
              if (so >= 0) cso[so * 768 + lane + 64 * i] = x0;
              w3[i] = w2[i]; w2[i] = w1[i]; w1[i] = x0; }
float qr[4];
#pragma unroll
          for (int i = 0; i < 12; ++i) { float sc = 1.0f;
              if (i < 8) { const float nn = wave_sum2(uu[i] * uu[i]); sc = rsqrtf(nn + RMS_EPS) * (i < 4 ? 0.125f : 1.0f); }
              const unsigned wbits = pk2(uu[i] * sc, 0.f) & 0xffffu;
              sb[SB_DQ + i * 64 + lane] = (bf16)wbits;
              if (i < 4) qr[i] = bf2f(wbits);
              else if (i < 8) { const float qk = wave_sum2(qr[i - 4] * bf2f(wbits)); if (lane == 0) sf[SF_QK + (i - 4)] = qk; } }
          if (lane < 4) { sf[SF_BETA + lane] = sigmoidf_(bf2f(A.db));
              const float xx = bf2f(A.da) + dtb; const float sp = fmaxf(xx, 0.f) + __logf(1.0f + __expf(-fabsf(xx)));
              sf[SF_DDEC + lane] = __expf(a_neg * sp); } }
        A = B;
        if (r + 1 < r1) { const int rn = r + 1; const bool ns = rn < MP ? ((rn & 2047) == 0) : (((rn - MP) & 3) == 0); if (ns) load_window(rn); }
    }
}

template <int KIND, int DH, int R> struct Raw { unsigned q[DH / 2]; unsigned k[DH / 2]; unsigned v[(R + 1) / 2]; float f[DH]; float be, de; };

template <int KIND, int DH, int R>
__device__ __forceinline__ void load_tok(Raw<KIND, DH, R>& x, const bf16* qp, const bf16* kp, const bf16* vp, const float* fp) {
    if constexpr (DH == 4) { const v2u w = *(const v2u*)qp; x.q[0] = w.x; x.q[1] = w.y; } else { x.q[0] = *(const unsigned*)qp; }
    if constexpr (KIND != 2) { if constexpr (DH == 4) { const v2u w = *(const v2u*)kp; x.k[0] = w.x; x.k[1] = w.y; } else { x.k[0] = *(const unsigned*)kp; } }
    if constexpr (R == 1) x.v[0] = *vp; else if constexpr (R == 2) x.v[0] = *(const unsigned*)vp; else { const v2u w = *(const v2u*)vp; x.v[0] = w.x; x.v[1] = w.y; }
    if constexpr (KIND == 1) { const f32x2 w = *(const f32x2*)fp; x.f[0] = w.x; x.f[1] = w.y; }
    if constexpr (KIND == 2) { const f32x4 w = *(const f32x4*)fp; x.f[0] = w.x; x.f[1] = w.y; x.f[2] = w.z; x.f[3] = w.w; }
    if constexpr (KIND == 3) { x.be = fp[0]; x.de = fp[4]; }
}

template <int KIND, int DH, int R>
__device__ __forceinline__ void scan_task(const Ctx& C, int row0, int T, int h, int slice, const float* sin, float* sout) {
    const bf16* PROJ = (const bf16*)(C.ws + WS_BIG); const bf16* SB = (const bf16*)(C.ws + WS_SB); const float* SF = (const float*)(C.ws + WS_SF);
    bf16* H = (bf16*)(C.ws + WS_H);
    const int lane = C.lane, dl = lane & 15, rw = lane >> 4;
    const int d0 = dl * DH, v0 = slice * (4 * R) + rw * R;
    constexpr int DK = 16 * DH;
    const bf16 *qp, *kp, *vp; const float* fp; int ks, vs;
    const bf16* sbr = SB + (size_t)row0 * SBW; const bf16* pr = PROJ + (size_t)row0 * NINP; const float* sfr = SF + (size_t)row0 * SFW;
    if constexpr (KIND == 0) { qp = sbr + SB_RQ + h * 64 + d0; kp = sbr + SB_RK + h * 64 + d0; ks = SBW; vp = pr + C_RV + h * 64 + v0; vs = NINP; fp = sfr; }
    if constexpr (KIND == 1) { qp = sbr + SB_AQ + h * 32 + d0; kp = pr + C_AK + h * 32 + d0; ks = NINP; vp = pr + C_AV + h * 64 + v0; vs = NINP; fp = sfr + SF_ADEC + h * 32 + d0; }
    if constexpr (KIND == 2) { qp = sbr + SB_HQ + h * 64 + d0; kp = sbr; ks = SBW; vp = pr + C_HI + h * 64 + v0; vs = NINP; fp = sfr + SF_HF + h * 64 + d0; }
    if constexpr (KIND == 3) { qp = sbr + SB_DQ + h * 64 + d0; kp = sbr + SB_DK + h * 64 + d0; ks = SBW; vp = sbr + SB_DV + h * 64 + v0; vs = SBW; fp = sfr + SF_BETA + h; }
    bf16* op = H + (size_t)row0 * D + KIND * 256 + h * 64 + v0;
    const float rdec = 1.0f - exp2f(-5.0f - (float)h);

    float S[DH][R];
#pragma unroll
    for (int dh = 0; dh < DH; ++dh)
#pragma unroll
        for (int vv = 0; vv < R; ++vv) S[dh][vv] = sin ? sin[(size_t)(d0 + dh) * 64 + v0 + vv] : 0.f;

    typedef Raw<KIND, DH, R> RawT;
    RawT A[4];
#pragma unroll
    for (int u = 0; u < 4; ++u) load_tok<KIND, DH, R>(A[u], qp + (size_t)u * SBW, kp + (size_t)u * ks, vp + (size_t)u * vs, fp + (size_t)u * SFW);
    for (int t0 = 0; t0 < T; t0 += 4) {
        RawT B[4];
        const bool more = t0 + 4 < T;
#pragma unroll
        for (int u = 0; u < 4; ++u) { B[u] = A[u]; }
        if (more) {
#pragma unroll
            for (int u = 0; u < 4; ++u) load_tok<KIND, DH, R>(B[u], qp + (size_t)(t0 + 4 + u) * SBW, kp + (size_t)(t0 + 4 + u) * ks, vp + (size_t)(t0 + 4 + u) * vs, fp + (size_t)(t0 + 4 + u) * SFW);
        }
#pragma unroll
        for (int u = 0; u < 4; ++u) {
            const RawT& x = A[u];
            float q[DH], k[DH], v[R];
            q[0] = bflo(x.q[0]); q[1] = bfhi(x.q[0]); if constexpr (DH == 4) { q[2] = bflo(x.q[1]); q[3] = bfhi(x.q[1]); }
            if constexpr (KIND != 2) { k[0] = bflo(x.k[0]); k[1] = bfhi(x.k[0]); if constexpr (DH == 4) { k[2] = bflo(x.k[1]); k[3] = bfhi(x.k[1]); } }
            if constexpr (R == 1) v[0] = bflo(x.v[0]);
            if constexpr (R >= 2) { v[0] = bflo(x.v[0]); v[1] = bfhi(x.v[0]); }
            if constexpr (R == 4) { v[2] = bflo(x.v[1]); v[3] = bfhi(x.v[1]); }
            float o[R];
            if constexpr (KIND == 3) {
                float ks_[R];
#pragma unroll
                for (int vv = 0; vv < R; ++vv) { float p = 0.f;
#pragma unroll
                    for (int dh = 0; dh < DH; ++dh) { S[dh][vv] *= x.de; p += k[dh] * S[dh][vv]; }
                    ks_[vv] = row16_sum(p); }
#pragma unroll
                for (int vv = 0; vv < R; ++vv) { const float uu = x.be * (v[vv] - ks_[vv]); float p = 0.f;
#pragma unroll
                    for (int dh = 0; dh < DH; ++dh) { S[dh][vv] += k[dh] * uu; p += q[dh] * S[dh][vv]; }
                    o[vv] = row16_sum(p); }
            } else {
#pragma unroll
                for (int dh = 0; dh < DH; ++dh) {
                    float dec, kk;
                    if constexpr (KIND == 0) { dec = rdec; kk = k[dh]; }
                    if constexpr (KIND == 1) { dec = x.f[dh]; kk = k[dh]; }
                    if constexpr (KIND == 2) { dec = x.f[dh]; kk = 1.0f - x.f[dh]; }
#pragma unroll
                    for (int vv = 0; vv < R; ++vv) S[dh][vv] = dec * S[dh][vv] + kk * v[vv];
                }
#pragma unroll
                for (int vv = 0; vv < R; ++vv) { float p = 0.f;
#pragma unroll
                    for (int dh = 0; dh < DH; ++dh) p += q[dh] * S[dh][vv];
                    o[vv] = row16_sum(p); }
            }
            if (dl == 0) {
                bf16* o_ = op + (size_t)(t0 + u) * D;
                if constexpr (R == 1) *o_ = (bf16)(pk2(o[0], 0.f) & 0xffffu);
                if constexpr (R == 2) *(unsigned*)o_ = pk2(o[0], o[1]);
                if constexpr (R == 4) *(v2u*)o_ = (v2u){pk2(o[0], o[1]), pk2(o[2], o[3])};
            }
        }
#pragma unroll
        for (int u = 0; u < 4; ++u) A[u] = B[u];
    }
#pragma unroll
    for (int dh = 0; dh < DH; ++dh)
#pragma unroll
        for (int vv = 0; vv < R; ++vv) sout[(size_t)(d0 + dh) * 64 + v0 + vv] = S[dh][vv];
    (void)DK;
}

template <int KIND, int DH, int R>
__device__ __forceinline__ void scan_long(const Ctx& C, LAS float* wl, int row0, int T, int h, int slice, float* sout) {
    constexpr int CT = 16, LR = 8, DK = LR * DH, NV = (64 / LR) * R, UNR = 8;
    constexpr bool HASK = true, GK = (KIND != 2), HASF = (KIND == 1 || KIND == 2), HASB = (KIND == 3);
    constexpr int OQ = 0, OK_ = OQ + CT * DK, OF = OK_ + (HASK ? CT * DK : 0), OV = OF + (HASF ? CT * DK : 0), OB = OV + CT * NV, BUF = OB + (HASB ? CT * 4 : 0);
    const bf16* PROJ = (const bf16*)(C.ws + WS_BIG); const bf16* SB = (const bf16*)(C.ws + WS_SB); const float* SF = (const float*)(C.ws + WS_SF);
    bf16* H = (bf16*)(C.ws + WS_H);
    const int lane = C.lane, dl = lane & (LR - 1), rw = lane / LR;
    const int d0 = dl * DH;
    const int stok = lane >> 2, spart = lane & 3;
    const GAS bf16 *qg, *kg, *vg; const GAS float *fg, *bg; int ks, vs;
    {
        const GAS bf16* sbr = (const GAS bf16*)(SB + (size_t)row0 * SBW); const GAS bf16* pr = (const GAS bf16*)(PROJ + (size_t)row0 * NINP); const GAS float* sfr = (const GAS float*)(SF + (size_t)row0 * SFW);
        const int vcol = slice * NV;
        if constexpr (KIND == 0) { qg = sbr + SB_RQ + h * 64; kg = sbr + SB_RK + h * 64; ks = SBW; vg = pr + C_RV + h * 64 + vcol; vs = NINP; fg = sfr; bg = sfr; }
        if constexpr (KIND == 1) { qg = sbr + SB_AQ + h * 32; kg = pr + C_AK + h * 32; ks = NINP; vg = pr + C_AV + h * 64 + vcol; vs = NINP; fg = sfr + SF_ADEC + h * 32; bg = sfr; }
        if constexpr (KIND == 2) { qg = sbr + SB_HQ + h * 64; kg = sbr; ks = SBW; vg = pr + C_HI + h * 64 + vcol; vs = NINP; fg = sfr + SF_HF + h * 64; bg = sfr; }
        if constexpr (KIND == 3) { qg = sbr + SB_DQ + h * 64; kg = sbr + SB_DK + h * 64; ks = SBW; vg = sbr + SB_DV + h * 64 + vcol; vs = SBW; fg = sfr; bg = sfr + SF_BETA + h; }
    }
    constexpr int QP = DK / 4;
    qg += (size_t)stok * SBW + spart * QP; kg += (size_t)stok * ks + spart * QP; fg += (size_t)stok * SFW + spart * QP;
    vg += (size_t)(lane & 15) * vs; bg += (size_t)(lane & 15) * SFW;
    GAS bf16* op = (GAS bf16*)(H + (size_t)row0 * D + KIND * 256 + h * 64 + slice * NV + rw * R);
    const float rdec = 1.0f - exp2f(-5.0f - (float)h);

    static_assert(R == 1, "scan_long: one column per lane row");
    f32x2 S2[DH / 2];
#pragma unroll
    for (int i = 0; i < DH / 2; ++i) S2[i] = (f32x2){0.f, 0.f};

    struct SR { v4u rq[QP / 8], rk[QP / 8]; f32x4 rf[QP / 4]; unsigned rv[NV / 2]; float rb0, rb1, rb2; };
    SR s0; s0.rb0 = s0.rb1 = s0.rb2 = 0.f;
    auto stage_load = [&](SR& sr, int c) {
        const size_t t = (size_t)c * CT;
#pragma unroll
        for (int i = 0; i < QP / 8; ++i) { sr.rq[i] = *(const GAS v4u*)(qg + t * SBW + i * 8); if constexpr (GK) sr.rk[i] = *(const GAS v4u*)(kg + t * ks + i * 8); }
        if constexpr (HASF) {
#pragma unroll
            for (int i = 0; i < QP / 4; ++i) sr.rf[i] = *(const GAS f32x4*)(fg + t * SFW + i * 4); }
        if (lane < 16) {
            if constexpr (NV == 4) { const v2u w = *(const GAS v2u*)(vg + t * vs); sr.rv[0] = w.x; sr.rv[1] = w.y; }
            if constexpr (NV == 8) { const v4u w = *(const GAS v4u*)(vg + t * vs); sr.rv[0] = w.x; sr.rv[1] = w.y; sr.rv[2] = w.z; sr.rv[3] = w.w; }
            if constexpr (NV == 16) { const v4u w = *(const GAS v4u*)(vg + t * vs), w2 = *(const GAS v4u*)(vg + t * vs + 8); sr.rv[0] = w.x; sr.rv[1] = w.y; sr.rv[2] = w.z; sr.rv[3] = w.w; sr.rv[4] = w2.x; sr.rv[5] = w2.y; sr.rv[6] = w2.z; sr.rv[7] = w2.w; }
            if constexpr (HASB) { sr.rb0 = bg[t * SFW]; sr.rb1 = bg[t * SFW + 4]; sr.rb2 = bg[t * SFW + 8]; }
        }
    };
    auto stage_write = [&](SR& sr, int b) {
        LAS float* base = wl + b * BUF;
#pragma unroll
        for (int i = 0; i < QP / 8; ++i) {
            LAS float* qd = base + OQ + stok * DK + spart * QP + i * 8;
            *(LAS f32x4*)qd = (f32x4){bflo(sr.rq[i].x), bfhi(sr.rq[i].x), bflo(sr.rq[i].y), bfhi(sr.rq[i].y)}; *(LAS f32x4*)(qd + 4) = (f32x4){bflo(sr.rq[i].z), bfhi(sr.rq[i].z), bflo(sr.rq[i].w), bfhi(sr.rq[i].w)};
            if constexpr (GK) { LAS float* kd = base + OK_ + stok * DK + spart * QP + i * 8;
                *(LAS f32x4*)kd = (f32x4){bflo(sr.rk[i].x), bfhi(sr.rk[i].x), bflo(sr.rk[i].y), bfhi(sr.rk[i].y)}; *(LAS f32x4*)(kd + 4) = (f32x4){bflo(sr.rk[i].z), bfhi(sr.rk[i].z), bflo(sr.rk[i].w), bfhi(sr.rk[i].w)}; }
        }
        if constexpr (HASF) {
#pragma unroll
            for (int i = 0; i < QP / 4; ++i) { *(LAS f32x4*)(base + OF + stok * DK + spart * QP + i * 4) = sr.rf[i];
                if constexpr (KIND == 2) *(LAS f32x4*)(base + OK_ + stok * DK + spart * QP + i * 4) = 1.0f - sr.rf[i]; } }
        if (lane < 16) {
#pragma unroll
            for (int i = 0; i < NV / 2; ++i) { base[OV + lane * NV + 2 * i] = bflo(sr.rv[i]); base[OV + lane * NV + 2 * i + 1] = bfhi(sr.rv[i]); }
            if constexpr (HASB) *(LAS f32x4*)(base + OB + lane * 4) = (f32x4){sr.rb0, sr.rb1, sr.rb2, 0.f};
        }
    };
    static_assert(2 * BUF * 4 <= 26624, "per-wave LDS");
    const int nch = T / CT;
    struct Opnd { f32x2 q2[DH / 2], k2[DH / 2], f2[DH / 2]; float v; f32x4 bd; };
    auto ldop = [&](Opnd& x, const LAS float* bq, const LAS float* bv, const LAS float* bb, int uu) {
#pragma unroll
        for (int i = 0; i < DH / 4; ++i) { const f32x4 w = *(const LAS f32x4*)(bq + OQ + uu * DK + 4 * i); x.q2[2 * i] = (f32x2){w.x, w.y}; x.q2[2 * i + 1] = (f32x2){w.z, w.w}; }
#pragma unroll
        for (int i = 0; i < DH / 4; ++i) { const f32x4 w = *(const LAS f32x4*)(bq + OK_ + uu * DK + 4 * i); x.k2[2 * i] = (f32x2){w.x, w.y}; x.k2[2 * i + 1] = (f32x2){w.z, w.w}; }
        if constexpr (HASF) {
#pragma unroll
            for (int i = 0; i < DH / 4; ++i) { const f32x4 w = *(const LAS f32x4*)(bq + OF + uu * DK + 4 * i); x.f2[2 * i] = (f32x2){w.x, w.y}; x.f2[2 * i + 1] = (f32x2){w.z, w.w}; } }
        x.v = bv[uu * NV];
        if constexpr (HASB) x.bd = *(const LAS f32x4*)(bb + uu * 4);
    };
    auto compute = [&](int c, const LAS float* base) {
#pragma unroll 1
        for (int ub = 0; ub < CT; ub += UNR) {
        float okeep[R];
#pragma unroll
        for (int vv = 0; vv < R; ++vv) okeep[vv] = 0.f;
        Opnd X; X.bd = (f32x4){0.f, 0.f, 0.f, 0.f};
#pragma unroll
        for (int i = 0; i < DH / 2; ++i) X.f2[i] = (f32x2){0.f, 0.f};
        const LAS float* bq = base + ub * DK + d0; const LAS float* bv = base + OV + ub * NV + rw; const LAS float* bb = base + OB + ub * 4;
        ldop(X, bq, bv, bb, 0);
#pragma unroll
        for (int uu_ = 0; uu_ < UNR; ++uu_) { const int u = ub + uu_;
            Opnd Y = X;
            if (uu_ + 1 < UNR) ldop(Y, bq, bv, bb, uu_ + 1);
            f32x2 (&q2)[DH / 2] = X.q2; f32x2 (&k2)[DH / 2] = X.k2; f32x2 (&f2)[DH / 2] = X.f2; const float vv_ = X.v; const f32x4 bd = X.bd;
            float o[1];
            if constexpr (KIND == 3) {
                f32x2 a = k2[0] * S2[0], bq_ = q2[0] * S2[0];
#pragma unroll
                for (int i = 1; i < DH / 2; ++i) { a = __builtin_elementwise_fma(k2[i], S2[i], a); bq_ = __builtin_elementwise_fma(q2[i], S2[i], bq_); }
                const float ks_ = row8_sum(a.x + a.y) * bd.y, qs_ = row8_sum(bq_.x + bq_.y) * bd.y;
                const float uu = bd.x * (vv_ - ks_);
                o[0] = __builtin_fmaf(bd.z, uu, qs_);
                const f32x2 de2 = (f32x2){bd.y, bd.y}, uu2 = (f32x2){uu, uu};
#pragma unroll
                for (int i = 0; i < DH / 2; ++i) S2[i] = __builtin_elementwise_fma(S2[i], de2, k2[i] * uu2);
            } else {
                const f32x2 v2 = (f32x2){vv_, vv_};
#pragma unroll
                for (int i = 0; i < DH / 2; ++i) {
                    f32x2 dec2;
                    if constexpr (KIND == 0) dec2 = (f32x2){rdec, rdec}; else dec2 = f2[i];
                    S2[i] = __builtin_elementwise_fma(S2[i], dec2, k2[i] * v2);
                }
            }
            if constexpr (KIND != 3)
            { f32x2 a = q2[0] * S2[0];
#pragma unroll
              for (int i = 1; i < DH / 2; ++i) a = __builtin_elementwise_fma(q2[i], S2[i], a);
              o[0] = row8_sum(a.x + a.y); }
#pragma unroll
            for (int vv = 0; vv < R; ++vv) okeep[vv] = (dl == uu_) ? o[vv] : okeep[vv];
            X = Y;
        }
        {
            GAS bf16* o_ = op + (size_t)(c * CT + ub + dl) * D;
            if constexpr (R == 1) *o_ = (bf16)(pk2(okeep[0], 0.f) & 0xffffu);
            if constexpr (R == 2) *(GAS unsigned*)o_ = pk2(okeep[0], okeep[1]);
            if constexpr (R == 4) *(GAS v2u*)o_ = (v2u){pk2(okeep[0], okeep[1]), pk2(okeep[2], okeep[3])};
        }
        }
    };
    stage_load(s0, 0); stage_write(s0, 0);
#pragma unroll 1
    for (int c = 0; c < nch; c += 2) {
        stage_load(s0, min(c + 1, nch - 1));
        compute(c, wl);
        stage_write(s0, 1);
        stage_load(s0, min(c + 2, nch - 1));
        compute(c + 1, wl + BUF);
        stage_write(s0, 0);
    }
    const int v0 = slice * NV + rw * R;
#pragma unroll
    for (int i = 0; i < DH / 2; ++i) { sout[(size_t)(d0 + 2 * i) * 64 + v0] = S2[i].x; sout[(size_t)(d0 + 2 * i + 1) * 64 + v0] = S2[i].y; }
}

__device__ __forceinline__ void scan_phase(const Args& args, LAS unsigned char* lds_, int l, int mode = 0) {
    const Ctx C = make_ctx(args, lds_);
    constexpr int NLONG = 1024, NSHORT = BS * 144;
    const int slot = C.wave * 256 + (int)blockIdx.x;
    const int nidle = C.NGW - NLONG - 256;
    for (int it = 0;; ++it) {
        int kind, b, h, slice, row0, T; bool isp;
        if (slot < NLONG) { if (it > 0 || mode == 2) break; isp = true; T = TP;
            const int kk_ = slot >> 8, i = slot & 255; kind = kk_ == 0 ? 3 : (kk_ == 1 ? 0 : (kk_ == 2 ? 2 : 1));
            { const int stream = (i & 7) | ((i >> 6) << 3); slice = (i >> 3) & 7; b = stream >> 2; h = stream & 3; }
            row0 = b * TP;
        } else { if (C.wave < 5) break;
            const int st = (slot - NLONG - 256) + it * nidle; if (st >= NSHORT || mode == 1) break; isp = false; T = TS;
            b = st / 144; int i = st - b * 144;
            if (i < 64) { kind = 3; h = i >> 4; slice = i & 15; }
            else if (i < 96) { i -= 64; kind = 0; h = i >> 3; slice = i & 7; }
            else if (i < 128) { i -= 96; kind = 2; h = i >> 3; slice = i & 7; }
            else { i -= 128; kind = 1; h = i >> 2; slice = i & 3; }
            row0 = MP + b * TS;
        }
        const int nbat = isp ? BP : BS;
        const size_t sidx = (size_t)((l * nbat + b) * 4 + h);
        if (isp) {
            LAS float* wl = (LAS float*)(C.lds + C.wave * 26624);
            if (kind == 0) scan_long<0, 8, 1>(C, wl, row0, T, h, slice, C.out + O_PRET + sidx * 4096);
            else if (kind == 1) scan_long<1, 4, 1>(C, wl, row0, T, h, slice, C.out + O_PGLA + sidx * 2048);
            else if (kind == 2) scan_long<2, 8, 1>(C, wl, row0, T, h, slice, C.out + O_PHG + sidx * 4096);
            else scan_long<3, 8, 1>(C, wl, row0, T, h, slice, C.out + O_PGDN + sidx * 4096);
        } else {
            if (kind == 0) { scan_task<0, 4, 2>(C, row0, T, h, slice, args.in[2] + sidx * 4096, C.out + O_SRET + sidx * 4096); }
            else if (kind == 1) { scan_task<1, 2, 4>(C, row0, T, h, slice, args.in[3] + sidx * 2048, C.out + O_SGLA + sidx * 2048); }
            else if (kind == 2) { scan_task<2, 4, 2>(C, row0, T, h, slice, args.in[4] + sidx * 4096, C.out + O_SHG + sidx * 4096); }
            else { scan_task<3, 4, 1>(C, row0, T, h, slice, args.in[5] + sidx * 4096, C.out + O_SGDN + sidx * 4096); }
        }
    }
    if (l == 0 && C.wave >= 5 && mode != 1) {
        LAS float* scr = (LAS float*)(C.lds + 4 * 26624 + (C.wave - 5) * 8704);
        constexpr int I_F0 = I_WI + I_WO, I_L0B = I_F0 + I_WOUT;
        for (int it = (C.wave - 5) * 256 + (int)blockIdx.x; it < I_L0B + I_MAIN; it += 768) {
            if (it < I_F0) convert_item(args, C.ws, 0, I_F0 + it, scr, C.lane);
            else if (it < I_L0B) convert_item(args, C.ws, 0, 2 * I_F0 + I_WIN + (it - I_F0), scr, C.lane);
            else convert_item(args, C.ws, 1, it - I_L0B, scr, C.lane);
        }
    }
}

__device__ __forceinline__ void post_phase(const Args& args, LAS unsigned char* lds_, int l) {
    const Ctx C = make_ctx(args, lds_);
    const bf16* PROJ = (const bf16*)(C.ws + WS_BIG); bf16* H = (bf16*)(C.ws + WS_H);
    const int lane = C.lane, mixer = lane >> 4, cc = (lane & 15) * 16;
    const int gbase = mixer == 0 ? C_RG : mixer == 1 ? C_AG : mixer == 2 ? C_HG : C_DG;
    const float* nw = mixer == 1 ? args.in[24] + l * 64 : mixer == 2 ? args.in[25] + l * 64 : args.in[26] + l * 64;
    float w[16];
#pragma unroll
    for (int i = 0; i < 16; ++i) w[i] = mixer == 0 ? 1.0f : nw[(cc + i) & 63];
    v4u na0, na1, ng0, ng1;
    if (C.gw < M) { const bf16* hp = H + (size_t)C.gw * D + lane * 16; const bf16* gp = PROJ + (size_t)C.gw * NINP + gbase + cc;
        na0 = *(const v4u*)hp; na1 = *(const v4u*)(hp + 8); ng0 = *(const v4u*)gp; ng1 = *(const v4u*)(gp + 8); }
#pragma unroll 1
    for (int r = C.gw; r < M; r += C.NGW) {
        bf16* hp = H + (size_t)r * D + lane * 16; const bf16* gp = PROJ + (size_t)r * NINP + gbase + cc;
        const v4u a0 = na0, a1 = na1, g0 = ng0, g1 = ng1;
        if (r + C.NGW < M) { const bf16* hn = hp + (size_t)C.NGW * D; const bf16* gn = gp + (size_t)C.NGW * NINP;
            na0 = *(const v4u*)hn; na1 = *(const v4u*)(hn + 8); ng0 = *(const v4u*)gn; ng1 = *(const v4u*)(gn + 8); }
        float y[16], g[16];
        const unsigned aw[8] = {a0.x, a0.y, a0.z, a0.w, a1.x, a1.y, a1.z, a1.w}, gw_[8] = {g0.x, g0.y, g0.z, g0.w, g1.x, g1.y, g1.z, g1.w};
        float ss = 0.f;
#pragma unroll
        for (int i = 0; i < 8; ++i) { y[2 * i] = bflo(aw[i]); y[2 * i + 1] = bfhi(aw[i]); g[2 * i] = bflo(gw_[i]); g[2 * i + 1] = bfhi(gw_[i]); ss += y[2 * i] * y[2 * i] + y[2 * i + 1] * y[2 * i + 1]; }
        ss = quad_sum(ss);
        const float rs = rsqrtf(ss * (1.0f / 64.0f) + RMS_EPS);
        unsigned ow[8];
#pragma unroll
        for (int i = 0; i < 8; ++i) ow[i] = pk2(y[2 * i] * rs * w[2 * i] * siluf_(g[2 * i]), y[2 * i + 1] * rs * w[2 * i + 1] * siluf_(g[2 * i + 1]));
        *(v4u*)hp = (v4u){ow[0], ow[1], ow[2], ow[3]}; *(v4u*)(hp + 8) = (v4u){ow[4], ow[5], ow[6], ow[7]};
    }
}

__global__ void __launch_bounds__(NWAVES * 64, 2) mega_fwd(Args args) {
    extern __shared__ __attribute__((aligned(16))) unsigned char lds[];
    cg::grid_group grid = cg::this_grid();
    LAS unsigned char* const LDSP = (LAS unsigned char*)lds;
    const int G = (int)gridDim.x, bx = (int)blockIdx.x;
    if (threadIdx.x < 64) ((LAS unsigned*)(LDSP + MISC_OFF))[threadIdx.x] = 0u;
    __syncthreads();
    (void)xcd_barrier_post((unsigned*)args.ws, (volatile LAS unsigned*)(LDSP + MISC_OFF));
#define FRESH() float* out_ = fresh_ptr(args.out); unsigned char* ws = fresh_ptr(args.ws); \
    float* MOD = (float*)(ws + WS_MOD); bf16* H = (bf16*)(ws + WS_H); bf16* BIG = (bf16*)(ws + WS_BIG); (void)MOD; (void)H; (void)BIG; (void)out_;

    p0_prologue(args, LDSP);
    if (args.ws == nullptr) grid.sync();
    grid_bar(args, LDSP);
    {
        FRESH();
        pg8::Gemm g{(const bf16*)(ws + WS_AC), BIG, 256, 2 * NMODC, D}; pg8::StaticOrder S; S.init(256, 2 * NMODC, G, bx, D);
        pg8::EpiMod E{MOD, args.in[10]};
        pg8::gemm_phase<pg8::EpiMod, pg8::StaticOrder, PG8_ALIGN, PG8_SP2>(LDSP, g, S, E);
    }
    p1_convert(args, LDSP);
    grid_bar(args, LDSP);
    p2_modulate0(args, LDSP);
    grid_bar(args, LDSP);
#pragma unroll 1
    for (int l = 0; l < 2; ++l) {
#pragma unroll 1
        for (int f = 0; f < 2; ++f) {
            if (f == 1) {
                {
                    FRESH();
                    pg8::Gemm g{H, (const bf16*)(ws + WS_W + (size_t)l * W_LAYER + W_WIN), M, NINP, D}; pg8::StaticOrder S; S.init(M, NINP, G, bx, D);
                    pg8::EpiPlain E{BIG, NINP};
                    pg8::gemm_phase<pg8::EpiPlain, pg8::StaticOrder, PG8_ALIGN, PG8_SP2>(LDSP, g, S, E);
                }
                grid_bar(args, LDSP);
                prep_phase(args, LDSP, l);
                grid_bar(args, LDSP);
                scan_phase(args, LDSP, l);
#ifdef PROBE_SCANMODE
                grid_bar(args, LDSP); scan_phase(args, LDSP, l, PROBE_SCANMODE);
#endif
                grid_bar(args, LDSP);
                post_phase(args, LDSP, l);
                grid_bar(args, LDSP);
                {
                    FRESH();
                    pg8::Gemm g{H, (const bf16*)(ws + WS_W + (size_t)l * W_LAYER + W_WOUT), M, D, D}; pg8::SplitOrder S; S.init(D, G, bx);
                    pg8::EpiRes E{out_, out_, (float*)(ws + WS_SB), MOD + (size_t)l * NB * NMODC + 5 * 1024, (const float*)(ws + WS_STATS), args.in[11] + (size_t)(l * 3) * D, args.in[12] + (size_t)(l * 3) * D, 1.0f, D / 64};
                    pg8::gemm_phase<pg8::EpiRes, pg8::SplitOrder, PG8_ALIGN, PG8_SP2>(LDSP, g, S, E);
                }
                grid_bar(args, LDSP);
                ln_phase(args, LDSP, l, 1, true, l, 6, 4, ALPHA, false);
                grid_bar(args, LDSP);
            }
            {
                FRESH();
                pg8::Gemm g{H, (const bf16*)(ws + WS_W + (size_t)l * W_LAYER + (f ? W_WI2 : W_WI1)), M, NWI, D}; pg8::StaticOrder S; S.init(M, NWI, G, bx, D);
                pg8::EpiSwiglu E{BIG, DFF};
                pg8::gemm_phase<pg8::EpiSwiglu, pg8::StaticOrder, PG8_ALIGN, PG8_SP2>(LDSP, g, S, E);
            }
            grid_bar(args, LDSP);
            {
                FRESH();
                pg8::Gemm g{BIG, (const bf16*)(ws + WS_W + (size_t)l * W_LAYER + (f ? W_WO2 : W_WO1)), M, D, DFF}; pg8::SplitOrder S; S.init(DFF, G, bx);
                const bool first = (l == 0 && f == 0); const int pinst = f ? l * 3 + 1 : l * 3 - 1;
                pg8::EpiRes E{out_, first ? args.in[0] : out_, (float*)(ws + WS_SB), MOD + (size_t)l * NB * NMODC + (f ? 8 : 2) * 1024, (const float*)(ws + WS_STATS),
                              first ? (const float*)(ws + WS_ID) : args.in[11] + (size_t)pinst * D, first ? (const float*)(ws + WS_ID) + 1024 : args.in[12] + (size_t)pinst * D, 0.5f, DFF / 64};
                pg8::gemm_phase<pg8::EpiRes, pg8::SplitOrder, PG8_ALIGN, PG8_SP2>(LDSP, g, S, E);
            }
            grid_bar(args, LDSP);
            if (f == 0) ln_phase(args, LDSP, l, 0, true, l, 3, 11, ALPHA, false);
            else ln_phase(args, LDSP, l, 2, l == 0, 1, 0, 11, l == 0 ? ALPHA : 1.0f, l == 1);
            if (!(l == 1 && f == 1)) grid_bar(args, LDSP);
        }
    }
}

extern "C" void kernel_launch(void* const* d_in, const int* in_sizes, int n_in, void* d_out, int out_size, void* d_ws, size_t ws_size, hipStream_t stream) {
    static int grid = 0;
    if (grid == 0) {
        if (n_in != 28 || (size_t)out_size != O_END || ws_size < WS_END) { fprintf(stderr, "kernel_launch: unexpected sizes n_in %d out %d ws %zu (need %zu)\n", n_in, out_size, ws_size, (size_t)WS_END); grid = -1; return; }
        int dev = 0, cus = 0, per_cu = 0;
        hipGetDevice(&dev); hipDeviceGetAttribute(&cus, hipDeviceAttributeMultiprocessorCount, dev);
        hipFuncSetAttribute((const void*)mega_fwd, hipFuncAttributeMaxDynamicSharedMemorySize, LDS_BYTES);
        hipOccupancyMaxActiveBlocksPerMultiprocessor(&per_cu, (const void*)mega_fwd, NWAVES * 64, LDS_BYTES);
        (void)hipGetLastError();
        if (per_cu < 1 || cus < 256) { fprintf(stderr, "kernel_launch: occupancy %d cus %d\n", per_cu, cus); grid = -1; return; }
        grid = 256;
    }
    if (grid < 0) return;
    if (hipMemsetAsync(d_ws, 0, 65536, stream) != hipSuccess) { fprintf(stderr, "memset failed\n"); return; }
    Args a{};
    for (int i = 0; i < 28; ++i) a.in[i] = (const float*)d_in[i];
    a.out = (float*)d_out; a.ws = (unsigned char*)d_ws;
    void* kargs[] = {&a};
    hipError_t e = hipLaunchCooperativeKernel((const void*)mega_fwd, dim3(grid), dim3(NWAVES * 64), kargs, LDS_BYTES, stream);
    if (e != hipSuccess) fprintf(stderr, "cooperative launch failed: %s\n", hipGetErrorString(e));
}
```

```cpp
#include <hip/hip_runtime.h>
#include <hip/hip_cooperative_groups.h>
#include <cstdio>
#include <cstdint>
namespace cg = cooperative_groups;
namespace pg8 {
#define PG8_LAS __attribute__((address_space(3)))
typedef unsigned short bf16_t;
typedef short bf16x8 __attribute__((ext_vector_type(8)));
typedef float f32x4 __attribute__((ext_vector_type(4)));
typedef unsigned u32x4 __attribute__((ext_vector_type(4)));
constexpr int BM = 256, BK = 64, HALF = 128, HTB = HALF * BK * 2  , STAGE_BYTES = 8 * HTB, NXCD = 8, WGM = 8;

__host__ __device__ __forceinline__ int lds_byte(int r, int c) { const int st = (r >> 4) * 2 + (c >> 5), rr = r & 15, cc = c & 31, ob = rr * 64 + cc * 2; return st * 1024 + (ob ^ (((ob >> 9) & 1) << 5)); }
__host__ __device__ __forceinline__ void stage_rc(int b, int& R, int& C) { const int st = b / 1024, sb = b % 1024, swz = sb ^ (((sb >> 9) & 1) << 5); R = (st >> 1) * 16 + swz / 64; C = (st & 1) * 32 + (swz % 64) / 2; }
__host__ __device__ __forceinline__ int perm32(int rho) { const int n = rho >> 4, i = rho & 15; return 8 * (i >> 2) + 4 * n + (i & 3); }

struct Unit { int pm, pn, k0, nt; };
struct Gemm { const bf16_t* A; const bf16_t* Bt; int M, N, K; };

struct StaticOrder {
    int nM, nN, nwg, G, c, ntf;
    __host__ __device__ void init(int M, int N, int G_, int c_, int K_ = 1024) { nM = M / BM; nN = N / BM; nwg = nM * nN; G = G_; c = c_; ntf = K_ / BK; }
    __host__ __device__ bool next(int i, Unit& u) const {
        const long L = (long)i * G + c; if (L >= nwg) return false;
        int wgid = (int)L; { const int q = nwg / NXCD, r = nwg % NXCD, xcd = wgid % NXCD, off = wgid / NXCD; wgid = (xcd < r ? xcd * (q + 1) : r * (q + 1) + (xcd - r) * q) + off; }
        const int nig = WGM * nN, gid = wgid / nig, fm = gid * WGM, gsz = (nM - fm) < WGM ? (nM - fm) : WGM;
        u.pm = fm + ((wgid % nig) % gsz); u.pn = (wgid % nig) / gsz; u.k0 = 0; u.nt = ntf; return true;
    }
    __device__ __forceinline__ void a_ready(const Unit&) const {}
    __device__ __forceinline__ void done(const Unit&) const {}
};

struct SplitOrder {
    StaticOrder base; int ppu, c;
    static constexpr int PK = 4;
    __host__ __device__ void init(int K_, int G_, int c_) { base.init(16384, 1024, G_, c_, K_); ppu = (K_ / BK) / PK; c = c_; }
    __host__ __device__ bool next(int i, Unit& u) const {
        if (i == 0) return base.next(0, u);
        if (i == 1 && c < 8 * ppu) { const int j = c / ppu, p = c - j * ppu; u.pm = 64 + (j >> 2); u.pn = j & 3; u.k0 = p * PK; u.nt = PK; return true; }
        return false;
    }
    __device__ __forceinline__ void a_ready(const Unit&) const {}
    __device__ __forceinline__ void done(const Unit&) const {}
};

__device__ __forceinline__ unsigned cvt_pk_bf16(float lo, float hi) { unsigned r; asm volatile("v_cvt_pk_bf16_f32 %0, %1, %2" : "=v"(r) : "v"(lo), "v"(hi)); return r; }
typedef float f32x2 __attribute__((ext_vector_type(2)));
__device__ __forceinline__ f32x2 gelu_pk(f32x2 v) {
    const f32x2 av = __builtin_elementwise_abs(v), d = av * 0.2316418882f + 1.0f;
    f32x2 t; t.x = __builtin_amdgcn_rcpf(d.x); t.y = __builtin_amdgcn_rcpf(d.y);
    f32x2 q = t * 0.5307027145f + (-0.7265760135f); q = q * t + 0.7107068705f; q = q * t + (-0.142248368f); q = q * t + 0.127414796f; q = q * t;
    const f32x2 s = (v * v) * (-0.72134752044f);
    f32x2 e; e.x = __builtin_amdgcn_exp2f(s.x); e.y = __builtin_amdgcn_exp2f(s.y);
    const f32x2 m = v * (q * e), r = v - m;
    f32x2 o; o.x = v.x < 0.f ? m.x : r.x; o.y = v.y < 0.f ? m.y : r.y; return o;
}

template <int ACT  > struct EpiBf16 {
    static constexpr bool PERM = true, AFTER_DRAIN = false; static_assert(ACT == 0 || ACT == 1, "EpiBf16: ACT is 0 (none) or 1 (gelu_pk)");
    bf16_t* O; int ldc; const float* bias; int split_cols; size_t split_stride; float scale0;
    __device__ __forceinline__ void operator()(const f32x4 (&acc)[2][2][4][2], const Unit& u, int wr, int wc, int fr, int fq) const {
        const int row0 = u.pm * BM + wr * 64 + fr; int colt = u.pn * BM; bf16_t* base = O;
        float sc = 1.f; if (split_cols) { const int t = colt / split_cols; base += (size_t)t * split_stride; colt -= t * split_cols; if (t == 0) sc = scale0; }
        const int col0 = colt + wc * 32 + 8 * fq, bcol0 = u.pn * BM + wc * 32 + 8 * fq;
        f32x4 bv[2][2];
#pragma unroll
        for (int bj = 0; bj < 2; ++bj)
#pragma unroll
            for (int n = 0; n < 2; ++n) bv[bj][n] = bias ? *(const f32x4*)(bias + bcol0 + bj * HALF + 4 * n) : (f32x4){0.f, 0.f, 0.f, 0.f};
#pragma unroll
        for (int ai = 0; ai < 2; ++ai)
#pragma unroll
            for (int m = 0; m < 4; ++m) { bf16_t* rowp = base + (size_t)(row0 + ai * HALF + m * 16) * ldc + col0;
#pragma unroll
                for (int bj = 0; bj < 2; ++bj) { f32x4 v0 = acc[ai][bj][m][0] + bv[bj][0], v1 = acc[ai][bj][m][1] + bv[bj][1];
                    if (ACT == 1) { f32x2 a = gelu_pk((f32x2){v0[0], v0[1]}), b = gelu_pk((f32x2){v0[2], v0[3]}), c = gelu_pk((f32x2){v1[0], v1[1]}), d = gelu_pk((f32x2){v1[2], v1[3]});
                        v0 = (f32x4){a.x, a.y, b.x, b.y}; v1 = (f32x4){c.x, c.y, d.x, d.y}; }
                    v0 = v0 * sc; v1 = v1 * sc; u32x4 w; w.x = cvt_pk_bf16(v0[0], v0[1]); w.y = cvt_pk_bf16(v0[2], v0[3]); w.z = cvt_pk_bf16(v1[0], v1[1]); w.w = cvt_pk_bf16(v1[2], v1[3]);
                    *(u32x4*)(rowp + bj * HALF) = w; } }
    }
};
template <class Epi, class Sched, bool ALIGN_EPI = false, bool SP2 = false>
__device__ __forceinline__ void gemm_phase(PG8_LAS unsigned char* lds, const Gemm g, const Sched& S, const Epi& E) {
    int tid_ = threadIdx.x; asm volatile("" : "+v"(tid_));
    const int tid = tid_, wid = __builtin_amdgcn_readfirstlane(tid >> 6), lane = tid & 63, wr = wid >> 2, wc = wid & 3, fr = lane & 15, fq = lane >> 4;
    const int K = g.K;
    unsigned voffA[2], voffB[2];
#pragma unroll
    for (int i = 0; i < 2; ++i) { int R, C; stage_rc(tid * 16 + i * 8192, R, C); const int Rb = Epi::PERM ? ((R & ~31) + perm32(R & 31)) : R;
        voffA[i] = (unsigned)(R * K + C) * 2u; voffB[i] = (unsigned)(Rb * K + C) * 2u; }
    const size_t kstep = (size_t)(BK * 2);
    const size_t hstep = (size_t)HALF * K * 2;
    const size_t tstep = 2 * hstep;
    const unsigned ldsw = (unsigned)wid * 1024u;
    const int aoff = lds_byte(wr * 64 + fr, fq * 8), boff = lds_byte(wc * 32 + fr, fq * 8);
#define PG8_SA(b, h) (((b) * 2 + (h)) * HTB)
#define PG8_SB(b, h) ((4 + (b) * 2 + (h)) * HTB)
#define PG8_STAGE(bufoff, gbase, voff) do { _Pragma("unroll") for (int _i = 0; _i < 2; ++_i) \
        __builtin_amdgcn_global_load_lds((const unsigned*)((const char*)(gbase) + (voff)[_i]), (PG8_LAS unsigned*)(lds + (bufoff) + ldsw + _i * 8192), 16, 0, 0); } while (0)
#define PG8_LDA(dst, b, h) do { _Pragma("unroll") for (int m = 0; m < 4; ++m) _Pragma("unroll") for (int k = 0; k < 2; ++k) dst[m][k] = *(const PG8_LAS bf16x8*)(lds + PG8_SA(b, h) + aoff + m * 2048 + k * 1024); } while (0)
#define PG8_LDB(dst, b, h) do { _Pragma("unroll") for (int n = 0; n < 2; ++n) _Pragma("unroll") for (int k = 0; k < 2; ++k) dst[n][k] = *(const PG8_LAS bf16x8*)(lds + PG8_SB(b, h) + boff + n * 2048 + k * 1024); } while (0)
#define PG8_MMA(ai, bj, At, Bt) do { __builtin_amdgcn_s_setprio(1); _Pragma("unroll") for (int m = 0; m < 4; ++m) _Pragma("unroll") for (int n = 0; n < 2; ++n) _Pragma("unroll") for (int k = 0; k < 2; ++k) \
        acc[ai][bj][m][n] = __builtin_amdgcn_mfma_f32_16x16x32_bf16(Bt[n][k], At[m][k], acc[ai][bj][m][n], 0, 0, 0); __builtin_amdgcn_s_setprio(0); } while (0)
#define PG8_WAIT_V(n) asm volatile("s_waitcnt vmcnt(" #n ")" ::: "memory")
#define PG8_WAIT_L(n) asm volatile("s_waitcnt lgkmcnt(" #n ")" ::: "memory")
#define PG8_BAR __builtin_amdgcn_s_barrier()
#define PG8_SCHED __builtin_amdgcn_sched_barrier(0)
    Unit cur, nxt; int ui = 0;
    if (!S.next(0, cur)) return;
    f32x4 acc[2][2][4][2];
#pragma unroll
    for (int a = 0; a < 2; ++a)
#pragma unroll
        for (int b = 0; b < 2; ++b)
#pragma unroll
            for (int m = 0; m < 4; ++m)
#pragma unroll
                for (int n = 0; n < 2; ++n) acc[a][b][m][n] = (f32x4){0.f, 0.f, 0.f, 0.f};
    bf16x8 At[4][2], B0[2][2], B1[2][2];
    const char* cA = (const char*)g.A + (size_t)cur.pm * tstep + (size_t)cur.k0 * kstep; const char* cB = (const char*)g.Bt + (size_t)cur.pn * tstep + (size_t)cur.k0 * kstep;
    S.a_ready(cur);
    if constexpr (SP2) {
        PG8_STAGE(PG8_SB(0, 0), cB, voffB); PG8_STAGE(PG8_SB(0, 1), cB + hstep, voffB); PG8_STAGE(PG8_SA(0, 0), cA, voffA); PG8_STAGE(PG8_SA(0, 1), cA + hstep, voffA);
        if (wr == 1) PG8_BAR;
        PG8_WAIT_V(2); PG8_BAR;
        PG8_STAGE(PG8_SB(1, 0), cB + kstep, voffB); PG8_STAGE(PG8_SA(1, 0), cA + kstep, voffA); PG8_STAGE(PG8_SB(1, 1), cB + hstep + kstep, voffB);
        PG8_WAIT_V(6); PG8_BAR;
    } else {
        PG8_STAGE(PG8_SB(0, 0), cB, voffB); PG8_STAGE(PG8_SA(0, 0), cA, voffA); PG8_STAGE(PG8_SB(0, 1), cB + hstep, voffB); PG8_STAGE(PG8_SA(0, 1), cA + hstep, voffA);
        if (wr == 1) PG8_BAR;
        PG8_WAIT_V(4); PG8_BAR;
        PG8_STAGE(PG8_SB(1, 0), cB + kstep, voffB); PG8_STAGE(PG8_SA(1, 0), cA + kstep, voffA); PG8_STAGE(PG8_SB(1, 1), cB + hstep + kstep, voffB);
        PG8_WAIT_V(6); PG8_BAR;
    }
    for (;;) {
        const bool has_next = S.next(ui + 1, nxt);
        const char* nA = has_next ? (const char*)g.A + (size_t)nxt.pm * tstep + (size_t)nxt.k0 * kstep : cA; const char* nB = has_next ? (const char*)g.Bt + (size_t)nxt.pn * tstep + (size_t)nxt.k0 * kstep : cB;
        const int nt = cur.nt;
        for (int t = 0; t < nt; t += 2) {
            const bool last = (t == nt - 2);
            const char* a1 = cA + (size_t)(t + 1) * kstep;
            const char* a2 = last ? nA : cA + (size_t)(t + 2) * kstep; const char* b2 = last ? nB : cB + (size_t)(t + 2) * kstep;
            const char* a3 = a2 + kstep; const char* b3 = b2 + kstep;
            if (last && has_next) S.a_ready(nxt);
            if constexpr (SP2) {
            PG8_LDB(B0, 0, 0); PG8_LDB(B1, 0, 1); PG8_SCHED; PG8_LDA(At, 0, 0); PG8_STAGE(PG8_SA(1, 1), a1 + hstep, voffA);
            PG8_WAIT_V(8); PG8_WAIT_L(0); PG8_BAR; PG8_MMA(0, 0, At, B0); PG8_MMA(0, 1, At, B1); PG8_BAR; PG8_SCHED;
            PG8_LDA(At, 0, 1); PG8_STAGE(PG8_SB(0, 0), b2, voffB); PG8_STAGE(PG8_SB(0, 1), b2 + hstep, voffB); PG8_STAGE(PG8_SA(0, 0), a2, voffA);
            PG8_WAIT_V(8); PG8_WAIT_L(0); PG8_BAR; PG8_MMA(1, 0, At, B0); PG8_MMA(1, 1, At, B1); PG8_BAR; PG8_SCHED;
            PG8_LDB(B0, 1, 0); PG8_LDB(B1, 1, 1); PG8_SCHED; PG8_LDA(At, 1, 0); PG8_STAGE(PG8_SA(0, 1), a2 + hstep, voffA);
            PG8_WAIT_V(8); PG8_WAIT_L(0); PG8_BAR; PG8_MMA(0, 0, At, B0); PG8_MMA(0, 1, At, B1); PG8_BAR; PG8_SCHED;
            PG8_LDA(At, 1, 1); PG8_STAGE(PG8_SB(1, 0), b3, voffB); PG8_STAGE(PG8_SB(1, 1), b3 + hstep, voffB); PG8_STAGE(PG8_SA(1, 0), a3, voffA);
            PG8_WAIT_V(8); PG8_WAIT_L(0); PG8_BAR; PG8_MMA(1, 0, At, B0); PG8_MMA(1, 1, At, B1); PG8_BAR; PG8_SCHED;
            } else {
            PG8_LDB(B0, 0, 0); PG8_SCHED; PG8_LDA(At, 0, 0); PG8_STAGE(PG8_SA(1, 1), a1 + hstep, voffA);
            PG8_WAIT_L(8); PG8_BAR; PG8_WAIT_L(0); PG8_MMA(0, 0, At, B0); PG8_BAR; PG8_SCHED;
            PG8_LDB(B1, 0, 1); PG8_STAGE(PG8_SB(0, 0), b2, voffB);
            PG8_BAR; PG8_WAIT_L(0); PG8_MMA(0, 1, At, B1); PG8_BAR;
            PG8_LDA(At, 0, 1); PG8_STAGE(PG8_SA(0, 0), a2, voffA);
            PG8_BAR; PG8_WAIT_L(0); PG8_MMA(1, 0, At, B0); PG8_BAR; PG8_SCHED;
            PG8_STAGE(PG8_SB(0, 1), b2 + hstep, voffB);
            PG8_WAIT_V(6); PG8_BAR; PG8_MMA(1, 1, At, B1); PG8_BAR;
            PG8_LDB(B0, 1, 0); PG8_SCHED; PG8_LDA(At, 1, 0); PG8_STAGE(PG8_SA(0, 1), a2 + hstep, voffA);
            PG8_WAIT_L(8); PG8_BAR; PG8_WAIT_L(0); PG8_MMA(0, 0, At, B0); PG8_BAR; PG8_SCHED;
            PG8_LDB(B1, 1, 1); PG8_STAGE(PG8_SB(1, 0), b3, voffB);
            PG8_BAR; PG8_WAIT_L(0); PG8_MMA(0, 1, At, B1); PG8_BAR;
            PG8_LDA(At, 1, 1); PG8_STAGE(PG8_SA(1, 0), a3, voffA);
            PG8_BAR; PG8_WAIT_L(0); PG8_MMA(1, 0, At, B0); PG8_BAR; PG8_SCHED;
            PG8_STAGE(PG8_SB(1, 1), b3 + hstep, voffB);
            PG8_WAIT_V(6); PG8_BAR; PG8_MMA(1, 1, At, B1); PG8_BAR;
            }
        }
        if constexpr (ALIGN_EPI) { if (wr == 0) PG8_BAR; }
        if constexpr (!Epi::AFTER_DRAIN) { E(acc, cur, wr, wc, fr, fq); S.done(cur); }
        if (!has_next) break;
#pragma unroll
        for (int a = 0; a < 2; ++a)
#pragma unroll
            for (int b = 0; b < 2; ++b)
#pragma unroll
                for (int m = 0; m < 4; ++m)
#pragma unroll
                    for (int n = 0; n < 2; ++n) acc[a][b][m][n] = (f32x4){0.f, 0.f, 0.f, 0.f};
        cur = nxt; cA = nA; cB = nB; ++ui;
        if constexpr (ALIGN_EPI) { if (wr == 1) PG8_BAR; }
    }
    PG8_WAIT_V(0);
    if constexpr (!ALIGN_EPI) { if (wr == 0) PG8_BAR; }
    PG8_BAR;
    if constexpr (Epi::AFTER_DRAIN) { E.fused(acc, cur, wr, wc, fr, fq, lds, wid, lane); S.done(cur); }
#undef PG8_SA
#undef PG8_SB
#undef PG8_STAGE
#undef PG8_LDA
#undef PG8_LDB
#undef PG8_MMA
#undef PG8_WAIT_V
#undef PG8_WAIT_L
#undef PG8_BAR
#undef PG8_SCHED
}
}
#define PG8_SP2 true
#define PG8_ALIGN true

constexpr int D = 1024, TP = 2048, BP = 8, BS = 128, TS = 4;
constexpr int MP = BP * TP, MS = BS * TS, M = MP + MS;
constexpr int DFF = 2816, NWI = 2 * DFF, NIN = 3864, NINP = 4096, NMODC = 9216, NB = BP + BS;
constexpr int SBW = 1664, SFW = 396;
constexpr float LN_EPS = 1e-5f, RMS_EPS = 1e-6f;
constexpr float ALPHA = 1.41421356237f;
constexpr int C_RQ = 0, C_RK = 256, C_RV = 512, C_RG = 768, C_AQ = 1024, C_AK = 1152, C_AV = 1280, C_ALR = 1536, C_AG = 1552,
              C_HQ = 1808, C_HF = 2064, C_HI = 2320, C_HG = 2576, C_DQKV = 2832, C_DB = 3600, C_DA = 3604, C_DG = 3608;
constexpr int SB_RQ = 0, SB_RK = 256, SB_AQ = 512, SB_HQ = 640, SB_DQ = 896, SB_DK = 1152, SB_DV = 1408;
constexpr int SF_ADEC = 0, SF_HF = 128, SF_BETA = 384, SF_DDEC = 388, SF_QK = 392;
constexpr size_t O_Y = 0;
constexpr size_t O_PRET = (size_t)M * D;
constexpr size_t O_PGLA = O_PRET + 2ull * BP * 4 * 64 * 64;
constexpr size_t O_PHG = O_PGLA + 2ull * BP * 4 * 32 * 64;
constexpr size_t O_PGDN = O_PHG + 2ull * BP * 4 * 64 * 64;
constexpr size_t O_PCONV = O_PGDN + 2ull * BP * 4 * 64 * 64;
constexpr size_t O_SRET = O_PCONV + 2ull * BP * 3 * 768;
constexpr size_t O_SGLA = O_SRET + 2ull * BS * 4 * 64 * 64;
constexpr size_t O_SHG = O_SGLA + 2ull * BS * 4 * 32 * 64;
constexpr size_t O_SGDN = O_SHG + 2ull * BS * 4 * 64 * 64;
constexpr size_t O_SCONV = O_SGDN + 2ull * BS * 4 * 64 * 64;
constexpr size_t O_END = O_SCONV + 2ull * BS * 3 * 768;

constexpr size_t MiB = 1u << 20;
constexpr size_t WS_ROPE = 1 * MiB;
constexpr size_t WS_AC = 2 * MiB;
constexpr size_t WS_MOD = 3 * MiB;
constexpr size_t WS_STATS = 2 * MiB + 512 * 1024;
constexpr size_t WS_ID = 2 * MiB + 768 * 1024;
constexpr size_t WS_W = 13 * MiB;
constexpr size_t W_WI1 = 0, W_WO1 = 11 * MiB, W_WI2 = W_WO1 + 5 * MiB + MiB / 2, W_WO2 = W_WI2 + 11 * MiB, W_WIN = W_WO2 + 5 * MiB + MiB / 2, W_WOUT = W_WIN + 8 * MiB, W_LAYER = 43 * MiB;
constexpr size_t WS_H = WS_W + 2 * W_LAYER;
constexpr size_t WS_BIG = WS_H + 33 * MiB;
constexpr size_t WS_SB = WS_BIG + 132 * MiB;
constexpr size_t WS_SF = WS_SB + 54 * MiB;
constexpr size_t WS_END = WS_SF + 26 * MiB;
static_assert((size_t)M * SBW * 2 <= 54 * MiB && (size_t)M * SFW * 4 <= 26 * MiB && (size_t)M * 4096 * 2 <= 132 * MiB && (size_t)M * D * 2 <= 33 * MiB, "ws map");

constexpr int LDS_BYTES = 147456;
constexpr int NWAVES = 8;

#define GAS __attribute__((address_space(1)))
#define LAS __attribute__((address_space(3)))
typedef unsigned short bf16;
typedef unsigned v4u __attribute__((ext_vector_type(4)));
typedef unsigned v2u __attribute__((ext_vector_type(2)));
typedef float f32x4 __attribute__((ext_vector_type(4)));
typedef float f32x2 __attribute__((ext_vector_type(2)));
#define LDS_WAIT() asm volatile("s_waitcnt lgkmcnt(0)" ::: "memory")

__device__ __forceinline__ float bf2f(unsigned b) { return __uint_as_float(b << 16); }
__device__ __forceinline__ float bflo(unsigned w) { return __uint_as_float(w << 16); }
__device__ __forceinline__ float bfhi(unsigned w) { return __uint_as_float(w & 0xffff0000u); }
__device__ __forceinline__ unsigned pk2(float lo, float hi) { return pg8::cvt_pk_bf16(lo, hi); }
__device__ __forceinline__ float sigmoidf_(float x) { return __builtin_amdgcn_rcpf(1.0f + __expf(-x)); }
__device__ __forceinline__ float siluf_(float x) { return x * __builtin_amdgcn_rcpf(1.0f + __expf(-x)); }
__device__ __forceinline__ float wave_sum(float v) {
#pragma unroll
    for (int o = 1; o < 64; o <<= 1) v += __shfl_xor(v, o);
    return v;
}
template <int CTRL> __device__ __forceinline__ float dppmov(float v) { return __int_as_float(__builtin_amdgcn_update_dpp(0, __float_as_int(v), CTRL, 0xf, 0xf, true)); }
__device__ __forceinline__ float quad_sum(float v) { v += dppmov<0xB1>(v); v += dppmov<0x4E>(v); return v; }
__device__ __forceinline__ float row8_sum(float v) { v += dppmov<0xB1>(v); v += dppmov<0x4E>(v); v += dppmov<0x141>(v); return v; }
__device__ __forceinline__ float row16_sum(float v) { v += dppmov<0xB1>(v); v += dppmov<0x4E>(v); v += dppmov<0x141>(v); v += dppmov<0x140>(v); return v; }

struct Args { const float* in[28]; float* out; unsigned char* ws; };

struct Ctx {
    int tid, lane, wave, gw, NGW;
    LAS unsigned char* lds;
    float* out; unsigned char* ws;
};
template <class T> __device__ __forceinline__ T* fresh_ptr(T* p) {
    unsigned lo = (unsigned)(uintptr_t)p, hi = (unsigned)((uintptr_t)p >> 32);
    asm volatile("" : "+v"(lo), "+v"(hi));
    lo = __builtin_amdgcn_readfirstlane(lo); hi = __builtin_amdgcn_readfirstlane(hi);
    return (T*)(__attribute__((address_space(1))) T*)(((uintptr_t)hi << 32) | (uintptr_t)lo);
}
__device__ __forceinline__ Ctx make_ctx(const Args& args, LAS unsigned char* lds) {
    Ctx C; int t = threadIdx.x; asm volatile("" : "+v"(t));
    C.tid = t; C.lane = t & 63; C.wave = __builtin_amdgcn_readfirstlane(t >> 6);
    C.gw = (int)blockIdx.x * NWAVES + C.wave; C.NGW = (int)gridDim.x * NWAVES;
    float* op = fresh_ptr(args.out); unsigned char* wp = fresh_ptr(args.ws);
    C.lds = lds; C.out = op; C.ws = wp; return C;
}
__device__ __forceinline__ int batch_of_row(int r) { return r < MP ? (r >> 11) : BP + ((r - MP) >> 2); }


typedef GAS unsigned gu32;
#define RLX_AGENT __ATOMIC_RELAXED, __HIP_MEMORY_SCOPE_AGENT
#define XB_TMO      128
#define XB_XCNT(j)  (256  + 64 * (j))
#define XB_XSUB(j)  (1280 + 64 * (j))
#define XB_XGEN(j)  (2304 + 64 * (j))
#define XB_TOP      3328
#define XB_TOPGEN   3392
#define XCD_BAR_WORDS 3456
#define XB_SPIN_CAP (1u << 18)

__device__ __forceinline__ unsigned xb_ld(unsigned* p)              { return __hip_atomic_load(p, __ATOMIC_RELAXED, __HIP_MEMORY_SCOPE_AGENT); }
__device__ __forceinline__ unsigned xb_add(unsigned* p, unsigned v) { return __hip_atomic_fetch_add(p, v, __ATOMIC_RELAXED, __HIP_MEMORY_SCOPE_AGENT); }
__device__ __forceinline__ unsigned xb_xcc_id() { return (unsigned)__builtin_amdgcn_s_getreg((3 << 11) | 20) & 0xFu; }
#define XB_SPIN(cond, bar) do { unsigned _sp = 0; while (cond) { __builtin_amdgcn_s_sleep(1); \
    if ((++_sp & 255u) == 0u) { if (xb_ld(&(bar)[XB_TMO])) break; if (_sp > XB_SPIN_CAP) { atomicAdd(&(bar)[XB_TMO], 1u); break; } } } } while (0)

struct XcdBarrier {
    unsigned* bar; unsigned x;
    volatile LAS unsigned* st;
};

__device__ __forceinline__ XcdBarrier xcd_barrier_post(unsigned* bar, volatile LAS unsigned* st) {
    XcdBarrier b; b.bar = bar; b.x = xb_xcc_id(); b.st = st;
    if (threadIdx.x == 0) (void)xb_add(&bar[XB_XCNT(b.x)], 1u);
    return b;
}
__device__ __forceinline__ void xcd_barrier_complete(unsigned* bar, unsigned x, unsigned& nloc, unsigned& nx) {
    const unsigned G = gridDim.x * gridDim.y * gridDim.z;
    unsigned sum, cnt, mine, sp = 0u;
    for (;;) {
        sum = 0u; cnt = 0u; mine = 0u;
#pragma unroll
        for (unsigned j = 0; j < 16; ++j) { const unsigned c = xb_ld(&bar[XB_XCNT(j)]); sum += c; cnt += (c > 0u) ? 1u : 0u; mine = (j == x) ? c : mine; }
        if (sum == G) break;
        __builtin_amdgcn_s_sleep(1);
        if ((++sp & 255u) == 0u) { if (xb_ld(&bar[XB_TMO])) break; if (sp > XB_SPIN_CAP) { atomicAdd(&bar[XB_TMO], 1u); break; } }
    }
    nloc = mine > 0u ? mine : 1u; nx = cnt > 0u ? cnt : 1u;
}

__device__ __forceinline__ void xcd_barrier(const XcdBarrier& b) {
    asm volatile("s_waitcnt vmcnt(0)" ::: "memory");
    __syncthreads();
    if (threadIdx.x == 0) {
        unsigned* bar = b.bar;
        __builtin_amdgcn_s_waitcnt(0);
        unsigned nloc = b.st[0], nx = b.st[1];
        if (nloc == 0u) { xcd_barrier_complete(bar, b.x, nloc, nx); b.st[0] = nloc; b.st[1] = nx; }
        const unsigned old = xb_add(&bar[XB_XSUB(b.x)], 1u);
        const unsigned gen = old / nloc;
        if (old + 1u == (gen + 1u) * nloc) {
            __builtin_amdgcn_fence(__ATOMIC_RELEASE, "agent");
            asm volatile("s_waitcnt vmcnt(0)" ::: "memory");
            const unsigned og = xb_add(&bar[XB_TOP], 1u);
            const unsigned tg = og / nx;
            if (og + 1u == (tg + 1u) * nx) xb_add(&bar[XB_TOPGEN], 1u);
            else XB_SPIN(xb_ld(&bar[XB_TOPGEN]) == tg, bar);
            __builtin_amdgcn_fence(__ATOMIC_ACQUIRE, "agent");
            xb_add(&bar[XB_XGEN(b.x)], 1u);
            asm volatile("s_waitcnt vmcnt(0)" ::: "memory");
        } else {
            XB_SPIN(xb_ld(&bar[XB_XGEN(b.x)]) == gen, bar);
            __builtin_amdgcn_fence(__ATOMIC_ACQUIRE, "agent");
            asm volatile("s_waitcnt vmcnt(0)" ::: "memory");
        }
    }
    __syncthreads();
}

constexpr int MISC_OFF = LDS_BYTES - 256;
__device__ __forceinline__ void grid_bar(const Args& args, LAS unsigned char* lds) {
    XcdBarrier b; b.bar = (unsigned*)fresh_ptr(args.ws); b.x = xb_xcc_id(); b.st = (volatile LAS unsigned*)(lds + MISC_OFF);
    xcd_barrier(b);
}

__device__ __forceinline__ float wave_sum2(float v) { v = row16_sum(v); v += __shfl_xor(v, 16); v += __shfl_xor(v, 32); return v; }

namespace pg8 {
struct EpiSwiglu {
    static constexpr bool PERM = true, AFTER_DRAIN = false;
    bf16_t* O; int ldc;
    __device__ __forceinline__ void operator()(const f32x4 (&acc)[2][2][4][2], const Unit& u, int wr, int wc, int fr, int fq) const {
        const int row0 = u.pm * BM + wr * 64 + fr, col0 = u.pn * 128 + wc * 32 + 8 * fq;
#pragma unroll
        for (int ai = 0; ai < 2; ++ai)
#pragma unroll
            for (int m = 0; m < 4; ++m) {
                bf16_t* rowp = O + (size_t)(row0 + ai * HALF + m * 16) * ldc + col0;
                float h[8];
#pragma unroll
                for (int n = 0; n < 2; ++n)
#pragma unroll
                    for (int j = 0; j < 4; ++j) {
                        const float a = acc[ai][0][m][n][j], b = acc[ai][1][m][n][j];
                        const float e = __builtin_amdgcn_exp2f(-1.44269504f * a);
                        h[n * 4 + j] = a * __builtin_amdgcn_rcpf(1.0f + e) * b;
                    }
                u32x4 w; w.x = cvt_pk_bf16(h[0], h[1]); w.y = cvt_pk_bf16(h[2], h[3]); w.z = cvt_pk_bf16(h[4], h[5]); w.w = cvt_pk_bf16(h[6], h[7]);
                *(u32x4*)rowp = w;
            }
    }
};
struct EpiPlain {
    static constexpr bool PERM = true, AFTER_DRAIN = false;
    bf16_t* O; int ldc;
    __device__ __forceinline__ void operator()(const f32x4 (&acc)[2][2][4][2], const Unit& u, int wr, int wc, int fr, int fq) const {
        const int row0 = u.pm * BM + wr * 64 + fr, col0 = u.pn * BM + wc * 32 + 8 * fq;
#pragma unroll
        for (int ai = 0; ai < 2; ++ai)
#pragma unroll
            for (int m = 0; m < 4; ++m) {
                bf16_t* rowp = O + (size_t)(row0 + ai * HALF + m * 16) * ldc + col0;
#pragma unroll
                for (int bj = 0; bj < 2; ++bj) { const f32x4 v0 = acc[ai][bj][m][0], v1 = acc[ai][bj][m][1];
                    u32x4 w; w.x = cvt_pk_bf16(v0[0], v0[1]); w.y = cvt_pk_bf16(v0[2], v0[3]); w.z = cvt_pk_bf16(v1[0], v1[1]); w.w = cvt_pk_bf16(v1[2], v1[3]);
                    *(u32x4*)(rowp + bj * HALF) = w; }
            }
    }
};
struct EpiRes {
    static constexpr bool PERM = false, AFTER_DRAIN = false;
    float* X; const float* Xr; float* PART; const float* gate; const float* stats; const float* lg; const float* lb; float scale; int ntf;
    __device__ __forceinline__ void operator()(const f32x4 (&acc)[2][2][4][2], const Unit& u, int wr, int wc, int fr, int fq) const {
        const int col0 = u.pn * BM + wc * 32 + 4 * fq;
        if (u.nt == ntf) {
            const float* gp = gate + (size_t)(u.pm >> 3) * 9216 + col0;
            f32x4 gs[2][2], g4[2][2], b4[2][2];
#pragma unroll
            for (int bj = 0; bj < 2; ++bj)
#pragma unroll
                for (int n = 0; n < 2; ++n) { const int cc = bj * HALF + n * 16;
                    gs[bj][n] = *(const f32x4*)(gp + cc) * scale + scale; g4[bj][n] = *(const f32x4*)(lg + col0 + cc); b4[bj][n] = *(const f32x4*)(lb + col0 + cc) * 1.41421356237f; }
#pragma unroll
            for (int ai = 0; ai < 2; ++ai)
#pragma unroll
                for (int m = 0; m < 4; ++m) {
                    const int r = u.pm * BM + ai * HALF + wr * 64 + m * 16 + fr;
                    const f32x2 st = *(const f32x2*)(stats + 2 * (size_t)r); const float mean = st.x, rs = st.y * 1.41421356237f;
                    const float* yr = Xr + (size_t)r * 1024 + col0; float* xo = X + (size_t)r * 1024 + col0;
                    f32x4 y[2][2];
#pragma unroll
                    for (int bj = 0; bj < 2; ++bj)
#pragma unroll
                        for (int n = 0; n < 2; ++n) y[bj][n] = *(const f32x4*)(yr + bj * HALF + n * 16);
#pragma unroll
                    for (int bj = 0; bj < 2; ++bj)
#pragma unroll
                        for (int n = 0; n < 2; ++n)
                            *(f32x4*)(xo + bj * HALF + n * 16) = gs[bj][n] * acc[ai][bj][m][n] + ((y[bj][n] - mean) * rs * g4[bj][n] + b4[bj][n]);
                    asm volatile("" ::: "memory");
                }
            return;
        }
        float* pbase = PART + (size_t)(u.k0 / SplitOrder::PK) * (512 * 1024);
#pragma unroll
        for (int ai = 0; ai < 2; ++ai)
#pragma unroll
            for (int m = 0; m < 4; ++m) {
                const int r = u.pm * BM + ai * HALF + wr * 64 + m * 16 + fr - 16384;
                const float* gp = gate + (size_t)(8 + (r >> 2)) * 9216 + col0;
                float* xo = pbase + (size_t)r * 1024 + col0;
#pragma unroll
                for (int bj = 0; bj < 2; ++bj)
#pragma unroll
                    for (int n = 0; n < 2; ++n) { const int cc = bj * HALF + n * 16;
                        *(f32x4*)(xo + cc) = (*(const f32x4*)(gp + cc) * scale + scale) * acc[ai][bj][m][n]; }
                asm volatile("" ::: "memory");
            }
    }
};
struct EpiMod {
    static constexpr bool PERM = false, AFTER_DRAIN = false;
    float* MODp; const float* ada_b;
    __device__ __forceinline__ void operator()(const f32x4 (&acc)[2][2][4][2], const Unit& u, int wr, int wc, int fr, int fq) const {
        const int col0 = u.pn * BM + wc * 32 + 4 * fq;
        const int l = (u.pn * BM) / 9216;
#pragma unroll
        for (int ai = 0; ai < 2; ++ai)
#pragma unroll
            for (int m = 0; m < 4; ++m) {
                const int r = u.pm * BM + ai * HALF + wr * 64 + m * 16 + fr;
                if (r < 136) {
#pragma unroll
                    for (int bj = 0; bj < 2; ++bj)
#pragma unroll
                        for (int n = 0; n < 2; ++n) {
                            const int c = col0 + bj * HALF + n * 16;
                            const f32x4 o = acc[ai][bj][m][n] + *(const f32x4*)(ada_b + c);
                            *(f32x4*)(MODp + (size_t)(l * 136 + r) * 9216 + (c - l * 9216)) = o;
                        }
                }
            }
    }
};
}

__device__ __forceinline__ void transpose_item(const float* W, int K, int N, bf16* WT, int dest_row0, LAS float* scr, int k0, int n0, int lane) {
    const int nn = n0 + (lane & 31); const bool ok = nn < N;
    float tv[32];
#pragma unroll
    for (int i = 0; i < 32; ++i) { const int kk = 2 * i + (lane >> 5); tv[i] = ok ? W[(size_t)(k0 + kk) * N + nn] : 0.f; }
#pragma unroll
    for (int i = 0; i < 32; ++i) { const int kk = 2 * i + (lane >> 5); scr[kk * 33 + (lane & 31)] = tv[i]; }
    LDS_WAIT();
    const int c = lane & 7;
#pragma unroll
    for (int j = 0; j < 4; ++j) { const int n = (lane >> 3) + 8 * j; const LAS float* s = scr + (8 * c) * 33 + n;
        v4u o; o.x = pk2(s[0 * 33], s[1 * 33]); o.y = pk2(s[2 * 33], s[3 * 33]); o.z = pk2(s[4 * 33], s[5 * 33]); o.w = pk2(s[6 * 33], s[7 * 33]);
        *(v4u*)(WT + (size_t)(dest_row0 + n) * K + k0 + 8 * c) = o; }
    LDS_WAIT();
}

constexpr int I_WI = 16 * 176, I_WO = 44 * 32, I_WIN = 16 * 121, I_WOUT = 16 * 32, I_ADA = 16 * 288;
constexpr int I_MAIN = 2 * I_WI + 2 * I_WO + I_WIN + I_WOUT, I_LAYER = I_MAIN + I_ADA;
__device__ __forceinline__ void convert_item(const Args& args, unsigned char* ws, int l, int r, LAS float* scr, int lane) {
    unsigned char* wl = ws + WS_W + (size_t)l * W_LAYER;
    if (r < 2 * (I_WI + I_WO)) {
        const int f = r / (I_WI + I_WO); r -= f * (I_WI + I_WO);
        if (r < I_WI) {
            const int kb = r / 176, nb = r % 176, n0 = nb * 32;
            const int half = n0 / DFF, j = n0 - half * DFF, t = j >> 7, jj = j & 127;
            transpose_item((f ? args.in[15] : args.in[13]) + (size_t)l * D * NWI, D, NWI, (bf16*)(wl + (f ? W_WI2 : W_WI1)), 256 * t + 128 * half + jj, scr, kb * 64, n0, lane);
        } else { r -= I_WI;
            const int kb = r / 32, nb = r % 32;
            transpose_item((f ? args.in[16] : args.in[14]) + (size_t)l * DFF * D, DFF, D, (bf16*)(wl + (f ? W_WO2 : W_WO1)), nb * 32, scr, kb * 64, nb * 32, lane);
        }
        return;
    }
    r -= 2 * (I_WI + I_WO);
    if (r < I_WIN) { const int kb = r / 121, nb = r % 121;
        transpose_item(args.in[17] + (size_t)l * D * NIN, D, NIN, (bf16*)(wl + W_WIN), nb * 32, scr, kb * 64, nb * 32, lane); return; }
    r -= I_WIN;
    if (r < I_WOUT) { const int kb = r / 32, nb = r % 32;
        transpose_item(args.in[27] + (size_t)l * D * D, D, D, (bf16*)(wl + W_WOUT), nb * 32, scr, kb * 64, nb * 32, lane); return; }
    r -= I_WOUT;
    { const int kb = r / 288, nb = r % 288;
        transpose_item(args.in[9] + (size_t)l * D * NMODC, D, NMODC, (bf16*)(ws + WS_BIG), l * NMODC + nb * 32, scr, kb * 64, nb * 32, lane); }
}

__device__ __forceinline__ void p0_prologue(const Args& args, LAS unsigned char* lds_) {
    const Ctx C = make_ctx(args, lds_);
    LAS float* scr = (LAS float*)(C.lds + C.wave * 16384);
    for (int it = C.gw; it < 2 * I_ADA; it += C.NGW) convert_item(args, C.ws, it / I_ADA, I_MAIN + it % I_ADA, scr, C.lane);
    const int gt = C.gw * 64 + C.lane, NGT = C.NGW * 64;
    for (int i = gt; i < 2 * 224 * 128; i += NGT) { const int l = i / (224 * 128), rr = (i / 128) % 224, ch = i & 127;
        *(v4u*)(C.ws + WS_W + (size_t)l * W_LAYER + W_WIN + ((size_t)(3872 + rr) * 1024 + ch * 8) * 2) = (v4u){0u, 0u, 0u, 0u}; }
    for (int i = gt; i < 2048; i += NGT) ((float*)(C.ws + WS_ID))[i] = i < 1024 ? 1.0f : 0.f;
    for (int i = gt; i < 256 * 256; i += NGT) { const int row = i >> 8, c4 = (i & 255) * 4;
        v2u o = (v2u){0u, 0u};
        if (row < NB) { const float* src = row < BP ? args.in[7] + (size_t)row * D : args.in[8] + (size_t)(row - BP) * D; const f32x4 v = *(const f32x4*)(src + c4);
            o.x = pk2(siluf_(v.x), siluf_(v.y)); o.y = pk2(siluf_(v.z), siluf_(v.w)); }
        *(v2u*)(C.ws + WS_AC + ((size_t)row * D + c4) * 2) = o; }
    for (int i = gt; i < 2052 * 32; i += NGT) { const int p = i >> 5, j = i & 31; const double pos = p < 2048 ? (double)p : (double)(16384 + (p - 2048));
        double inv = 1.0; for (int q = 0; q < j; ++q) inv *= 0.7498942093324559;
        const double ang = pos * inv; const double n = rint(ang * 0.15915494309189535);
        const float rr = (float)((ang - n * 6.283185307179586) - n * 2.4492935982947064e-16);
        ((f32x2*)(C.ws + WS_ROPE))[i] = (f32x2){__cosf(rr), __sinf(rr)}; }
}

__device__ __forceinline__ void p1_convert(const Args& args, LAS unsigned char* lds_) {
    const Ctx C = make_ctx(args, lds_);
    if ((int)blockIdx.x < 72) return;
    LAS float* scr = (LAS float*)(C.lds + C.wave * 16384);
    constexpr int I_F0 = I_WI + I_WO, I_P0 = I_F0 + I_WIN;
    for (int it = ((int)blockIdx.x - 72) * NWAVES + C.wave; it < I_P0; it += 184 * NWAVES) {
        if (it < I_F0) convert_item(args, C.ws, 0, it, scr, C.lane);
        else convert_item(args, C.ws, 0, 2 * I_F0 + (it - I_F0), scr, C.lane);
    }
}

__device__ __forceinline__ void p2_modulate0(const Args& args, LAS unsigned char* lds_) {
    const Ctx C = make_ctx(args, lds_);
    const float* MOD = (const float*)(C.ws + WS_MOD); bf16* H = (bf16*)(C.ws + WS_H);
    auto rowp = [&](int r) { return r < MP ? args.in[0] + (size_t)r * D : args.in[1] + (size_t)(r - MP) * D; };
    f32x4 nx[4], nsh[4], nsc[4];
    auto ld = [&](int r) { const float* xr = rowp(r); const float* modr = MOD + (size_t)batch_of_row(r) * NMODC;
#pragma unroll
        for (int j = 0; j < 4; ++j) { const int c = (C.lane + 64 * j) * 4; nx[j] = *(const f32x4*)(xr + c); nsh[j] = *(const f32x4*)(modr + c); nsc[j] = *(const f32x4*)(modr + 1024 + c); } };
    if (C.gw < M) ld(C.gw);
#pragma unroll 1
    for (int r = C.gw; r < M; r += C.NGW) {
        f32x4 v[4], sh[4], sc[4];
#pragma unroll
        for (int j = 0; j < 4; ++j) { v[j] = nx[j]; sh[j] = nsh[j]; sc[j] = nsc[j]; }
        if (r + C.NGW < M) ld(r + C.NGW);
        if (C.lane == 0) *(f32x2*)((float*)(C.ws + WS_STATS) + 2 * (size_t)r) = (f32x2){0.f, 1.0f};
#pragma unroll
        for (int j = 0; j < 4; ++j) { const int c = (C.lane + 64 * j) * 4;
            const f32x4 h = v[j] * (sc[j] + 1.0f) + sh[j];
            if (r >= MP) *(f32x4*)(C.out + (size_t)r * D + c) = v[j] * ALPHA;
            *(v2u*)(H + (size_t)r * D + c) = (v2u){pk2(h.x, h.y), pk2(h.z, h.w)}; }
    }
}

__device__ __forceinline__ void ln_phase(const Args& args, LAS unsigned char* lds_, int l, int which, bool write_h, int hl, int shc, int npart, float xscale, bool write_x) {
    const Ctx C = make_ctx(args, lds_);
    const float* MOD = (const float*)(C.ws + WS_MOD); bf16* H = (bf16*)(C.ws + WS_H);
    const float* g = args.in[11] + (size_t)(l * 3 + which) * D; const float* b = args.in[12] + (size_t)(l * 3 + which) * D;
    f32x4 nv[4], gg[4], bb[4];
#pragma unroll
    for (int j = 0; j < 4; ++j) { gg[j] = *(const f32x4*)(g + (C.lane + 64 * j) * 4); bb[j] = *(const f32x4*)(b + (C.lane + 64 * j) * 4); }
    f32x4 nw[4];
    if (C.gw < M) {
#pragma unroll
        for (int j = 0; j < 4; ++j) nv[j] = *(const f32x4*)(C.out + (size_t)C.gw * D + (C.lane + 64 * j) * 4); }
    if (C.gw + C.NGW < M) {
#pragma unroll
        for (int j = 0; j < 4; ++j) nw[j] = *(const f32x4*)(C.out + (size_t)(C.gw + C.NGW) * D + (C.lane + 64 * j) * 4); }
#pragma unroll 1
    for (int r = C.gw; r < M; r += C.NGW) {
        float* xr = C.out + (size_t)r * D;
        f32x4 v[4]; float s = 0.f;
        const float* modr = MOD + (size_t)(hl * NB + batch_of_row(r)) * NMODC + shc * 1024;
        f32x4 msh[4], msc[4];
        if (write_h) {
#pragma unroll
            for (int j = 0; j < 4; ++j) { msh[j] = *(const f32x4*)(modr + (C.lane + 64 * j) * 4); msc[j] = *(const f32x4*)(modr + 1024 + (C.lane + 64 * j) * 4); } }
#pragma unroll
        for (int j = 0; j < 4; ++j) { v[j] = nv[j]; nv[j] = nw[j]; }
        if (r + 2 * C.NGW < M) {
#pragma unroll
            for (int j = 0; j < 4; ++j) nw[j] = *(const f32x4*)(xr + (size_t)(2 * C.NGW) * D + (C.lane + 64 * j) * 4); }
        if (r >= MP) { const float* pp = (const float*)(C.ws + WS_SB) + (size_t)(r - MP) * D;
#pragma unroll 1
            for (int p = 0; p < npart; ++p, pp += 512 * 1024) {
#pragma unroll
                for (int j = 0; j < 4; ++j) v[j] += *(const f32x4*)(pp + (C.lane + 64 * j) * 4); } }
#pragma unroll
        for (int j = 0; j < 4; ++j) s += (v[j].x + v[j].y) + (v[j].z + v[j].w);
        const float mean = wave_sum2(s) * (1.f / D); float s2 = 0.f;
#pragma unroll
        for (int j = 0; j < 4; ++j) { v[j] = v[j] - mean; s2 += (v[j].x * v[j].x + v[j].y * v[j].y) + (v[j].z * v[j].z + v[j].w * v[j].w); }
        const float rstd = rsqrtf(wave_sum2(s2) * (1.f / D) + LN_EPS);
        if (C.lane == 0) *(f32x2*)((float*)(C.ws + WS_STATS) + 2 * (size_t)r) = (f32x2){mean, rstd};
#pragma unroll
        for (int j = 0; j < 4; ++j) { const int c = (C.lane + 64 * j) * 4;
            const f32x4 xn = v[j] * rstd * gg[j] + bb[j];
            if (write_x || r >= MP) *(f32x4*)(xr + c) = xn * xscale;
            if (write_h) { const f32x4 sh = msh[j], sc = msc[j]; const f32x4 h = xn * (sc + 1.0f) + sh;
                *(v2u*)(H + (size_t)r * D + c) = (v2u){pk2(h.x, h.y), pk2(h.z, h.w)}; }
        }
    }
}

struct PrepRaw { unsigned short rq1[4], rq2[4], rk1[4], rk2[4], aq[2], hf[4], hq[4], dx[12], db, da; v4u alr0, alr1; f32x2 cs; };
__device__ __forceinline__ void prep_load(PrepRaw& x, const bf16* P, int lane, const f32x2* rope_row) {
    const int j = lane & 31;
    x.cs = rope_row[j];
#pragma unroll
    for (int h = 0; h < 4; ++h) { x.rq1[h] = P[C_RQ + h * 64 + j]; x.rq2[h] = P[C_RQ + h * 64 + 32 + j]; x.rk1[h] = P[C_RK + h * 64 + j]; x.rk2[h] = P[C_RK + h * 64 + 32 + j]; }
    x.alr0 = *(const v4u*)(P + C_ALR); x.alr1 = *(const v4u*)(P + C_ALR + 8);
#pragma unroll
    for (int i = 0; i < 2; ++i) x.aq[i] = P[C_AQ + lane + 64 * i];
#pragma unroll
    for (int i = 0; i < 4; ++i) { x.hf[i] = P[C_HF + lane + 64 * i]; x.hq[i] = P[C_HQ + lane + 64 * i]; }
#pragma unroll
    for (int i = 0; i < 12; ++i) x.dx[i] = P[C_DQKV + lane + 64 * i];
    x.db = P[C_DB + (lane & 3)]; x.da = P[C_DA + (lane & 3)];
}

__device__ __forceinline__ void prep_phase(const Args& args, LAS unsigned char* lds_, int l) {
    const Ctx C = make_ctx(args, lds_);
    const bf16* PROJ = (const bf16*)(C.ws + WS_BIG); bf16* SB = (bf16*)(C.ws + WS_SB); float* SF = (float*)(C.ws + WS_SF);
    const f32x2* ROPE = (const f32x2*)(C.ws + WS_ROPE);
    const int lane = C.lane;
    const float* wg = args.in[18] + (size_t)l * 16 * 128; const float* bg = args.in[19] + (size_t)l * 128;
    const float* cw = args.in[21] + (size_t)l * 4 * 768;
    LAS float* lwg = (LAS float*)C.lds; LAS float* lcw = lwg + 16 * 128;
    for (int i = C.tid; i < 16 * 128; i += NWAVES * 64) lwg[i] = wg[i];
    for (int i = C.tid; i < 4 * 768; i += NWAVES * 64) lcw[i] = cw[i];
    __syncthreads();
    constexpr int CH = 9;
    const int r0 = C.gw * CH, r1 = min(r0 + CH, M);
    if (r0 >= M) return;
    float lbv[4];
#pragma unroll
    for (int i = 0; i < 4; ++i) { lbv[i] = 0.f; if (l == 1) lbv[i] = 1.0f / (1.0f + expf(args.in[20][lane + 64 * i] - args.in[20][256 + lane + 64 * i])); }
    const float a_neg = -expf(args.in[22][l * 4 + (lane & 3)]), dtb = args.in[23][l * 4 + (lane & 3)];
    const float bg0 = bg[lane], bg1 = bg[lane + 64];
    float w1[12], w2[12], w3[12];
    auto load_window = [&](int r) {
        const bool isp = r < MP; const int rs = r - MP; const int b = isp ? (r >> 11) : (rs >> 2), t = isp ? (r & 2047) : (rs & 3);
        const float* cst = args.in[6] + ((size_t)(l * BS + b) * 3) * 768;
#pragma unroll
        for (int i = 0; i < 12; ++i) { const int ch = lane + 64 * i; const bf16* Pc = PROJ + (size_t)r * NINP + C_DQKV + ch;
            w1[i] = t >= 1 ? bf2f(Pc[-1 * NINP]) : (isp ? 0.f : cst[2 * 768 + ch]);
            w2[i] = t >= 2 ? bf2f(Pc[-2 * NINP]) : (isp ? 0.f : cst[(1 + t) * 768 + ch]);
            w3[i] = t >= 3 ? bf2f(Pc[-3 * NINP]) : (isp ? 0.f : cst[t * 768 + ch]); }
    };
    auto rope_of = [&](int r) { return ROPE + (size_t)(r < MP ? (r & 2047) : 2048 + ((r - MP) & 3)) * 32; };
    PrepRaw A; prep_load(A, PROJ + (size_t)r0 * NINP, lane, rope_of(r0));
    load_window(r0);
#pragma unroll 1
    for (int r = r0; r < r1; ++r) {
        PrepRaw B = A;
        if (r + 1 < r1) prep_load(B, PROJ + (size_t)(r + 1) * NINP, lane, rope_of(r + 1));
        int zo = 0; asm volatile("" : "+v"(zo));
        const bool isp = r < MP; const int rs = r - MP;
        const int b = isp ? (r >> 11) : (rs >> 2), t = isp ? (r & 2047) : (rs & 3);
        const int ridx = isp ? t : 2048 + t;
        bf16* sb = SB + (size_t)r * SBW; float* sf = SF + (size_t)r * SFW;
        { const bool hi = lane >= 32; const f32x2 cs = A.cs;
#pragma unroll
          for (int h = 0; h < 4; ++h) {
              const float q1 = bf2f(A.rq1[h]), q2 = bf2f(A.rq2[h]), k1 = bf2f(A.rk1[h]), k2 = bf2f(A.rk2[h]);
              const float qo = hi ? (q1 * cs.y + q2 * cs.x) : (q1 * cs.x - q2 * cs.y);
              const float ko = hi ? (k1 * cs.y + k2 * cs.x) : (k1 * cs.x - k2 * cs.y);
              sb[SB_RQ + h * 64 + lane] = (bf16)(pk2(qo, 0.f) & 0xffffu);
              sb[SB_RK + h * 64 + lane] = (bf16)(pk2(ko * 0.125f, 0.f) & 0xffffu);
          } }
        { const unsigned aw[8] = {A.alr0.x, A.alr0.y, A.alr0.z, A.alr0.w, A.alr1.x, A.alr1.y, A.alr1.z, A.alr1.w};
          float x0 = bg0, x1 = bg1;
#pragma unroll
          for (int i = 0; i < 8; ++i) { const float a0 = bflo(aw[i]), a1 = bfhi(aw[i]);
              x0 += a0 * lwg[(2 * i) * 128 + lane + zo] + a1 * lwg[(2 * i + 1) * 128 + lane + zo];
              x1 += a0 * lwg[(2 * i) * 128 + lane + 64 + zo] + a1 * lwg[(2 * i + 1) * 128 + lane + 64 + zo]; }
          const float sp0 = fmaxf(-x0, 0.f) + __logf(1.0f + __expf(-fabsf(x0))), sp1 = fmaxf(-x1, 0.f) + __logf(1.0f + __expf(-fabsf(x1)));
          sf[SF_ADEC + lane] = __expf(-sp0 * (1.0f / 16.0f)); sf[SF_ADEC + lane + 64] = __expf(-sp1 * (1.0f / 16.0f));
          sb[SB_AQ + lane] = (bf16)(pk2(bf2f(A.aq[0]) * 0.17677669529663687f, 0.f) & 0xffffu);
          sb[SB_AQ + lane + 64] = (bf16)(pk2(bf2f(A.aq[1]) * 0.17677669529663687f, 0.f) & 0xffffu); }
#pragma unroll
        for (int i = 0; i < 4; ++i) { const int c = lane + 64 * i;
            sf[SF_HF + c] = lbv[i] + (1.0f - lbv[i]) * sigmoidf_(bf2f(A.hf[i]));
            sb[SB_HQ + c] = (bf16)(pk2(siluf_(bf2f(A.hq[i])) * 0.125f, 0.f) & 0xffffu); }
        { float* cso = isp ? C.out + O_PCONV + ((size_t)(l * BP + b) * 3) * 768 : C.out + O_SCONV + ((size_t)(l * BS + b) * 3) * 768;
          const int so = isp ? t - (TP - 3) : t - 1;
          float uu[12];
#pragma unroll
          for (int i = 0; i < 12; ++i) { const float x0 = bf2f(A.dx[i]);
              const LAS float* cwc = lcw + lane + 64 * i + zo;
              uu[i] = siluf_(x0 * cwc[3 * 768] + w1[i] * cwc[2 * 768] + w2[i] * cwc[768] + w3[i] * cwc[0]);
              if (so >= 0) cso[so * 768 + lane + 64 * i] = x0;
              w3[i] = w2[i]; w2[i] = w1[i]; w1[i] = x0; }
float qr[4];
#pragma unroll
          for (int i = 0; i < 12; ++i) { float sc = 1.0f;
              if (i < 8) { const float nn = wave_sum2(uu[i] * uu[i]); sc = rsqrtf(nn + RMS_EPS) * (i < 4 ? 0.125f : 1.0f); }
              const unsigned wbits = pk2(uu[i] * sc, 0.f) & 0xffffu;
              sb[SB_DQ + i * 64 + lane] = (bf16)wbits;
              if (i < 4) qr[i] = bf2f(wbits);
              else if (i < 8) { const float qk = wave_sum2(qr[i - 4] * bf2f(wbits)); if (lane == 0) sf[SF_QK + (i - 4)] = qk; } }
          if (lane < 4) { sf[SF_BETA + lane] = sigmoidf_(bf2f(A.db));
              const float xx = bf2f(A.da) + dtb; const float sp = fmaxf(xx, 0.f) + __logf(1.0f + __expf(-fabsf(xx)));
              sf[SF_DDEC + lane] = __expf(a_neg * sp); } }
        A = B;
        if (r + 1 < r1) { const int rn = r + 1; const bool ns = rn < MP ? ((rn & 2047) == 0) : (((rn - MP) & 3) == 0); if (ns) load_window(rn); }
    }
}

template <int KIND, int DH, int R> struct Raw { unsigned q[DH / 2]; unsigned k[DH / 2]; unsigned v[(R + 1) / 2]; float f[DH]; float be, de; };

template <int KIND, int DH, int R>
__device__ __forceinline__ void load_tok(Raw<KIND, DH, R>& x, const bf16* qp, const bf16* kp, const bf16* vp, const float* fp) {
    if constexpr (DH == 4) { const v2u w = *(const v2u*)qp; x.q[0] = w.x; x.q[1] = w.y; } else { x.q[0] = *(const unsigned*)qp; }
    if constexpr (KIND != 2) { if constexpr (DH == 4) { const v2u w = *(const v2u*)kp; x.k[0] = w.x; x.k[1] = w.y; } else { x.k[0] = *(const unsigned*)kp; } }
    if constexpr (R == 1) x.v[0] = *vp; else if constexpr (R == 2) x.v[0] = *(const unsigned*)vp; else { const v2u w = *(const v2u*)vp; x.v[0] = w.x; x.v[1] = w.y; }
    if constexpr (KIND == 1) { const f32x2 w = *(const f32x2*)fp; x.f[0] = w.x; x.f[1] = w.y; }
    if constexpr (KIND == 2) { const f32x4 w = *(const f32x4*)fp; x.f[0] = w.x; x.f[1] = w.y; x.f[2] = w.z; x.f[3] = w.w; }
    if constexpr (KIND == 3) { x.be = fp[0]; x.de = fp[4]; }
}

template <int KIND, int DH, int R>
__device__ __forceinline__ void scan_task(const Ctx& C, int row0, int T, int h, int slice, const float* sin, float* sout) {
    const bf16* PROJ = (const bf16*)(C.ws + WS_BIG); const bf16* SB = (const bf16*)(C.ws + WS_SB); const float* SF = (const float*)(C.ws + WS_SF);
    bf16* H = (bf16*)(C.ws + WS_H);
    const int lane = C.lane, dl = lane & 15, rw = lane >> 4;
    const int d0 = dl * DH, v0 = slice * (4 * R) + rw * R;
    constexpr int DK = 16 * DH;
    const bf16 *qp, *kp, *vp; const float* fp; int ks, vs;
    const bf16* sbr = SB + (size_t)row0 * SBW; const bf16* pr = PROJ + (size_t)row0 * NINP; const float* sfr = SF + (size_t)row0 * SFW;
    if constexpr (KIND == 0) { qp = sbr + SB_RQ + h * 64 + d0; kp = sbr + SB_RK + h * 64 + d0; ks = SBW; vp = pr + C_RV + h * 64 + v0; vs = NINP; fp = sfr; }
    if constexpr (KIND == 1) { qp = sbr + SB_AQ + h * 32 + d0; kp = pr + C_AK + h * 32 + d0; ks = NINP; vp = pr + C_AV + h * 64 + v0; vs = NINP; fp = sfr + SF_ADEC + h * 32 + d0; }
    if constexpr (KIND == 2) { qp = sbr + SB_HQ + h * 64 + d0; kp = sbr; ks = SBW; vp = pr + C_HI + h * 64 + v0; vs = NINP; fp = sfr + SF_HF + h * 64 + d0; }
    if constexpr (KIND == 3) { qp = sbr + SB_DQ + h * 64 + d0; kp = sbr + SB_DK + h * 64 + d0; ks = SBW; vp = sbr + SB_DV + h * 64 + v0; vs = SBW; fp = sfr + SF_BETA + h; }
    bf16* op = H + (size_t)row0 * D + KIND * 256 + h * 64 + v0;
    const float rdec = 1.0f - exp2f(-5.0f - (float)h);

    float S[DH][R];
#pragma unroll
    for (int dh = 0; dh < DH; ++dh)
#pragma unroll
        for (int vv = 0; vv < R; ++vv) S[dh][vv] = sin ? sin[(size_t)(d0 + dh) * 64 + v0 + vv] : 0.f;

    typedef Raw<KIND, DH, R> RawT;
    RawT A[4];
#pragma unroll
    for (int u = 0; u < 4; ++u) load_tok<KIND, DH, R>(A[u], qp + (size_t)u * SBW, kp + (size_t)u * ks, vp + (size_t)u * vs, fp + (size_t)u * SFW);
    for (int t0 = 0; t0 < T; t0 += 4) {
        RawT B[4];
        const bool more = t0 + 4 < T;
#pragma unroll
        for (int u = 0; u < 4; ++u) { B[u] = A[u]; }
        if (more) {
#pragma unroll
            for (int u = 0; u < 4; ++u) load_tok<KIND, DH, R>(B[u], qp + (size_t)(t0 + 4 + u) * SBW, kp + (size_t)(t0 + 4 + u) * ks, vp + (size_t)(t0 + 4 + u) * vs, fp + (size_t)(t0 + 4 + u) * SFW);
        }
#pragma unroll
        for (int u = 0; u < 4; ++u) {
            const RawT& x = A[u];
            float q[DH], k[DH], v[R];
            q[0] = bflo(x.q[0]); q[1] = bfhi(x.q[0]); if constexpr (DH == 4) { q[2] = bflo(x.q[1]); q[3] = bfhi(x.q[1]); }
            if constexpr (KIND != 2) { k[0] = bflo(x.k[0]); k[1] = bfhi(x.k[0]); if constexpr (DH == 4) { k[2] = bflo(x.k[1]); k[3] = bfhi(x.k[1]); } }
            if constexpr (R == 1) v[0] = bflo(x.v[0]);
            if constexpr (R >= 2) { v[0] = bflo(x.v[0]); v[1] = bfhi(x.v[0]); }
            if constexpr (R == 4) { v[2] = bflo(x.v[1]); v[3] = bfhi(x.v[1]); }
            float o[R];
            if constexpr (KIND == 3) {
                float ks_[R];
#pragma unroll
                for (int vv = 0; vv < R; ++vv) { float p = 0.f;
#pragma unroll
                    for (int dh = 0; dh < DH; ++dh) { S[dh][vv] *= x.de; p += k[dh] * S[dh][vv]; }
                    ks_[vv] = row16_sum(p); }
#pragma unroll
                for (int vv = 0; vv < R; ++vv) { const float uu = x.be * (v[vv] - ks_[vv]); float p = 0.f;
#pragma unroll
                    for (int dh = 0; dh < DH; ++dh) { S[dh][vv] += k[dh] * uu; p += q[dh] * S[dh][vv]; }
                    o[vv] = row16_sum(p); }
            } else {
#pragma unroll
                for (int dh = 0; dh < DH; ++dh) {
                    float dec, kk;
                    if constexpr (KIND == 0) { dec = rdec; kk = k[dh]; }
                    if constexpr (KIND == 1) { dec = x.f[dh]; kk = k[dh]; }
                    if constexpr (KIND == 2) { dec = x.f[dh]; kk = 1.0f - x.f[dh]; }
#pragma unroll
                    for (int vv = 0; vv < R; ++vv) S[dh][vv] = dec * S[dh][vv] + kk * v[vv];
                }
#pragma unroll
                for (int vv = 0; vv < R; ++vv) { float p = 0.f;
#pragma unroll
                    for (int dh = 0; dh < DH; ++dh) p += q[dh] * S[dh][vv];
                    o[vv] = row16_sum(p); }
            }
            if (dl == 0) {
                bf16* o_ = op + (size_t)(t0 + u) * D;
                if constexpr (R == 1) *o_ = (bf16)(pk2(o[0], 0.f) & 0xffffu);
                if constexpr (R == 2) *(unsigned*)o_ = pk2(o[0], o[1]);
                if constexpr (R == 4) *(v2u*)o_ = (v2u){pk2(o[0], o[1]), pk2(o[2], o[3])};
            }
        }
#pragma unroll
        for (int u = 0; u < 4; ++u) A[u] = B[u];
    }
#pragma unroll
    for (int dh = 0; dh < DH; ++dh)
#pragma unroll
        for (int vv = 0; vv < R; ++vv) sout[(size_t)(d0 + dh) * 64 + v0 + vv] = S[dh][vv];
    (void)DK;
}

template <int KIND, int DH, int R>
__device__ __forceinline__ void scan_long(const Ctx& C, LAS float* wl, int row0, int T, int h, int slice, float* sout) {
    constexpr int CT = 16, LR = 8, DK = LR * DH, NV = (64 / LR) * R, UNR = 8;
    constexpr bool HASK = true, GK = (KIND != 2), HASF = (KIND == 1 || KIND == 2), HASB = (KIND == 3);
    constexpr int OQ = 0, OK_ = OQ + CT * DK, OF = OK_ + (HASK ? CT * DK : 0), OV = OF + (HASF ? CT * DK : 0), OB = OV + CT * NV, BUF = OB + (HASB ? CT * 4 : 0);
    const bf16* PROJ = (const bf16*)(C.ws + WS_BIG); const bf16* SB = (const bf16*)(C.ws + WS_SB); const float* SF = (const float*)(C.ws + WS_SF);
    bf16* H = (bf16*)(C.ws + WS_H);
    const int lane = C.lane, dl = lane & (LR - 1), rw = lane / LR;
    const int d0 = dl * DH;
    const int stok = lane >> 2, spart = lane & 3;
    const GAS bf16 *qg, *kg, *vg; const GAS float *fg, *bg; int ks, vs;
    {
        const GAS bf16* sbr = (const GAS bf16*)(SB + (size_t)row0 * SBW); const GAS bf16* pr = (const GAS bf16*)(PROJ + (size_t)row0 * NINP); const GAS float* sfr = (const GAS float*)(SF + (size_t)row0 * SFW);
        const int vcol = slice * NV;
        if constexpr (KIND == 0) { qg = sbr + SB_RQ + h * 64; kg = sbr + SB_RK + h * 64; ks = SBW; vg = pr + C_RV + h * 64 + vcol; vs = NINP; fg = sfr; bg = sfr; }
        if constexpr (KIND == 1) { qg = sbr + SB_AQ + h * 32; kg = pr + C_AK + h * 32; ks = NINP; vg = pr + C_AV + h * 64 + vcol; vs = NINP; fg = sfr + SF_ADEC + h * 32; bg = sfr; }
        if constexpr (KIND == 2) { qg = sbr + SB_HQ + h * 64; kg = sbr; ks = SBW; vg = pr + C_HI + h * 64 + vcol; vs = NINP; fg = sfr + SF_HF + h * 64; bg = sfr; }
        if constexpr (KIND == 3) { qg = sbr + SB_DQ + h * 64; kg = sbr + SB_DK + h * 64; ks = SBW; vg = sbr + SB_DV + h * 64 + vcol; vs = SBW; fg = sfr; bg = sfr + SF_BETA + h; }
    }
    constexpr int QP = DK / 4;
    qg += (size_t)stok * SBW + spart * QP; kg += (size_t)stok * ks + spart * QP; fg += (size_t)stok * SFW + spart * QP;
    vg += (size_t)(lane & 15) * vs; bg += (size_t)(lane & 15) * SFW;
    GAS bf16* op = (GAS bf16*)(H + (size_t)row0 * D + KIND * 256 + h * 64 + slice * NV + rw * R);
    const float rdec = 1.0f - exp2f(-5.0f - (float)h);

    static_assert(R == 1, "scan_long: one column per lane row");
    f32x2 S2[DH / 2];
#pragma unroll
    for (int i = 0; i < DH / 2; ++i) S2[i] = (f32x2){0.f, 0.f};

    struct SR { v4u rq[QP / 8], rk[QP / 8]; f32x4 rf[QP / 4]; unsigned rv[NV / 2]; float rb0, rb1, rb2; };
    SR s0; s0.rb0 = s0.rb1 = s0.rb2 = 0.f;
    auto stage_load = [&](SR& sr, int c) {
        const size_t t = (size_t)c * CT;
#pragma unroll
        for (int i = 0; i < QP / 8; ++i) { sr.rq[i] = *(const GAS v4u*)(qg + t * SBW + i * 8); if constexpr (GK) sr.rk[i] = *(const GAS v4u*)(kg + t * ks + i * 8); }
        if constexpr (HASF) {
#pragma unroll
            for (int i = 0; i < QP / 4; ++i) sr.rf[i] = *(const GAS f32x4*)(fg + t * SFW + i * 4); }
        if (lane < 16) {
            if constexpr (NV == 4) { const v2u w = *(const GAS v2u*)(vg + t * vs); sr.rv[0] = w.x; sr.rv[1] = w.y; }
            if constexpr (NV == 8) { const v4u w = *(const GAS v4u*)(vg + t * vs); sr.rv[0] = w.x; sr.rv[1] = w.y; sr.rv[2] = w.z; sr.rv[3] = w.w; }
            if constexpr (NV == 16) { const v4u w = *(const GAS v4u*)(vg + t * vs), w2 = *(const GAS v4u*)(vg + t * vs + 8); sr.rv[0] = w.x; sr.rv[1] = w.y; sr.rv[2] = w.z; sr.rv[3] = w.w; sr.rv[4] = w2.x; sr.rv[5] = w2.y; sr.rv[6] = w2.z; sr.rv[7] = w2.w; }
            if constexpr (HASB) { sr.rb0 = bg[t * SFW]; sr.rb1 = bg[t * SFW + 4]; sr.rb2 = bg[t * SFW + 8]; }
        }
    };
    auto stage_write = [&](SR& sr, int b) {
        LAS float* base = wl + b * BUF;
#pragma unroll
        for (int i = 0; i < QP / 8; ++i) {
            LAS float* qd = base + OQ + stok * DK + spart * QP + i * 8;
            *(LAS f32x4*)qd = (f32x4){bflo(sr.rq[i].x), bfhi(sr.rq[i].x), bflo(sr.rq[i].y), bfhi(sr.rq[i].y)}; *(LAS f32x4*)(qd + 4) = (f32x4){bflo(sr.rq[i].z), bfhi(sr.rq[i].z), bflo(sr.rq[i].w), bfhi(sr.rq[i].w)};
            if constexpr (GK) { LAS float* kd = base + OK_ + stok * DK + spart * QP + i * 8;
                *(LAS f32x4*)kd = (f32x4){bflo(sr.rk[i].x), bfhi(sr.rk[i].x), bflo(sr.rk[i].y), bfhi(sr.rk[i].y)}; *(LAS f32x4*)(kd + 4) = (f32x4){bflo(sr.rk[i].z), bfhi(sr.rk[i].z), bflo(sr.rk[i].w), bfhi(sr.rk[i].w)}; }
        }
        if constexpr (HASF) {
#pragma unroll
            for (int i = 0; i < QP / 4; ++i) { *(LAS f32x4*)(base + OF + stok * DK + spart * QP + i * 4) = sr.rf[i];
                if constexpr (KIND == 2) *(LAS f32x4*)(base + OK_ + stok * DK + spart * QP + i * 4) = 1.0f - sr.rf[i]; } }
        if (lane < 16) {
#pragma unroll
            for (int i = 0; i < NV / 2; ++i) { base[OV + lane * NV + 2 * i] = bflo(sr.rv[i]); base[OV + lane * NV + 2 * i + 1] = bfhi(sr.rv[i]); }
            if constexpr (HASB) *(LAS f32x4*)(base + OB + lane * 4) = (f32x4){sr.rb0, sr.rb1, sr.rb2, 0.f};
        }
    };
    static_assert(2 * BUF * 4 <= 26624, "per-wave LDS");
    const int nch = T / CT;
    struct Opnd { f32x2 q2[DH / 2], k2[DH / 2], f2[DH / 2]; float v; f32x4 bd; };
    auto ldop = [&](Opnd& x, const LAS float* bq, const LAS float* bv, const LAS float* bb, int uu) {
#pragma unroll
        for (int i = 0; i < DH / 4; ++i) { const f32x4 w = *(const LAS f32x4*)(bq + OQ + uu * DK + 4 * i); x.q2[2 * i] = (f32x2){w.x, w.y}; x.q2[2 * i + 1] = (f32x2){w.z, w.w}; }
#pragma unroll
        for (int i = 0; i < DH / 4; ++i) { const f32x4 w = *(const LAS f32x4*)(bq + OK_ + uu * DK + 4 * i); x.k2[2 * i] = (f32x2){w.x, w.y}; x.k2[2 * i + 1] = (f32x2){w.z, w.w}; }
        if constexpr (HASF) {
#pragma unroll
            for (int i = 0; i < DH / 4; ++i) { const f32x4 w = *(const LAS f32x4*)(bq + OF + uu * DK + 4 * i); x.f2[2 * i] = (f32x2){w.x, w.y}; x.f2[2 * i + 1] = (f32x2){w.z, w.w}; } }
        x.v = bv[uu * NV];
        if constexpr (HASB) x.bd = *(const LAS f32x4*)(bb + uu * 4);
    };
    auto compute = [&](int c, const LAS float* base) {
#pragma unroll 1
        for (int ub = 0; ub < CT; ub += UNR) {
        float okeep[R];
#pragma unroll
        for (int vv = 0; vv < R; ++vv) okeep[vv] = 0.f;
        Opnd X; X.bd = (f32x4){0.f, 0.f, 0.f, 0.f};
#pragma unroll
        for (int i = 0; i < DH / 2; ++i) X.f2[i] = (f32x2){0.f, 0.f};
        const LAS float* bq = base + ub * DK + d0; const LAS float* bv = base + OV + ub * NV + rw; const LAS float* bb = base + OB + ub * 4;
        ldop(X, bq, bv, bb, 0);
#pragma unroll
        for (int uu_ = 0; uu_ < UNR; ++uu_) { const int u = ub + uu_;
            Opnd Y = X;
            if (uu_ + 1 < UNR) ldop(Y, bq, bv, bb, uu_ + 1);
            f32x2 (&q2)[DH / 2] = X.q2; f32x2 (&k2)[DH / 2] = X.k2; f32x2 (&f2)[DH / 2] = X.f2; const float vv_ = X.v; const f32x4 bd = X.bd;
            float o[1];
            if constexpr (KIND == 3) {
                f32x2 a = k2[0] * S2[0], bq_ = q2[0] * S2[0];
#pragma unroll
                for (int i = 1; i < DH / 2; ++i) { a = __builtin_elementwise_fma(k2[i], S2[i], a); bq_ = __builtin_elementwise_fma(q2[i], S2[i], bq_); }
                const float ks_ = row8_sum(a.x + a.y) * bd.y, qs_ = row8_sum(bq_.x + bq_.y) * bd.y;
                const float uu = bd.x * (vv_ - ks_);
                o[0] = __builtin_fmaf(bd.z, uu, qs_);
                const f32x2 de2 = (f32x2){bd.y, bd.y}, uu2 = (f32x2){uu, uu};
#pragma unroll
                for (int i = 0; i < DH / 2; ++i) S2[i] = __builtin_elementwise_fma(S2[i], de2, k2[i] * uu2);
            } else {
                const f32x2 v2 = (f32x2){vv_, vv_};
#pragma unroll
                for (int i = 0; i < DH / 2; ++i) {
                    f32x2 dec2;
                    if constexpr (KIND == 0) dec2 = (f32x2){rdec, rdec}; else dec2 = f2[i];
                    S2[i] = __builtin_elementwise_fma(S2[i], dec2, k2[i] * v2);
                }
            }
            if constexpr (KIND != 3)
            { f32x2 a = q2[0] * S2[0];
#pragma unroll
              for (int i = 1; i < DH / 2; ++i) a = __builtin_elementwise_fma(q2[i], S2[i], a);
              o[0] = row8_sum(a.x + a.y); }
#pragma unroll
            for (int vv = 0; vv < R; ++vv) okeep[vv] = (dl == uu_) ? o[vv] : okeep[vv];
            X = Y;
        }
        {
            GAS bf16* o_ = op + (size_t)(c * CT + ub + dl) * D;
            if constexpr (R == 1) *o_ = (bf16)(pk2(okeep[0], 0.f) & 0xffffu);
            if constexpr (R == 2) *(GAS unsigned*)o_ = pk2(okeep[0], okeep[1]);
            if constexpr (R == 4) *(GAS v2u*)o_ = (v2u){pk2(okeep[0], okeep[1]), pk2(okeep[2], okeep[3])};
        }
        }
    };
    stage_load(s0, 0); stage_write(s0, 0);
#pragma unroll 1
    for (int c = 0; c < nch; c += 2) {
        stage_load(s0, min(c + 1, nch - 1));
        compute(c, wl);
        stage_write(s0, 1);
        stage_load(s0, min(c + 2, nch - 1));
        compute(c + 1, wl + BUF);
        stage_write(s0, 0);
    }
    const int v0 = slice * NV + rw * R;
#pragma unroll
    for (int i = 0; i < DH / 2; ++i) { sout[(size_t)(d0 + 2 * i) * 64 + v0] = S2[i].x; sout[(size_t)(d0 + 2 * i + 1) * 64 + v0] = S2[i].y; }
}

__device__ __forceinline__ void scan_phase(const Args& args, LAS unsigned char* lds_, int l, int mode = 0) {
    const Ctx C = make_ctx(args, lds_);
    constexpr int NLONG = 1024, NSHORT = BS * 144;
    const int slot = C.wave * 256 + (int)blockIdx.x;
    const int nidle = C.NGW - NLONG - 256;
    for (int it = 0;; ++it) {
        int kind, b, h, slice, row0, T; bool isp;
        if (slot < NLONG) { if (it > 0 || mode == 2) break; isp = true; T = TP;
            const int kk_ = slot >> 8, i = slot & 255; kind = kk_ == 0 ? 3 : (kk_ == 1 ? 0 : (kk_ == 2 ? 2 : 1));
            { const int stream = (i & 7) | ((i >> 6) << 3); slice = (i >> 3) & 7; b = stream >> 2; h = stream & 3; }
            row0 = b * TP;
        } else { if (C.wave < 5) break;
            const int st = (slot - NLONG - 256) + it * nidle; if (st >= NSHORT || mode == 1) break; isp = false; T = TS;
            b = st / 144; int i = st - b * 144;
            if (i < 64) { kind = 3; h = i >> 4; slice = i & 15; }
            else if (i < 96) { i -= 64; kind = 0; h = i >> 3; slice = i & 7; }
            else if (i < 128) { i -= 96; kind = 2; h = i >> 3; slice = i & 7; }
            else { i -= 128; kind = 1; h = i >> 2; slice = i & 3; }
            row0 = MP + b * TS;
        }
        const int nbat = isp ? BP : BS;
        const size_t sidx = (size_t)((l * nbat + b) * 4 + h);
        if (isp) {
            LAS float* wl = (LAS float*)(C.lds + C.wave * 26624);
            if (kind == 0) scan_long<0, 8, 1>(C, wl, row0, T, h, slice, C.out + O_PRET + sidx * 4096);
            else if (kind == 1) scan_long<1, 4, 1>(C, wl, row0, T, h, slice, C.out + O_PGLA + sidx * 2048);
            else if (kind == 2) scan_long<2, 8, 1>(C, wl, row0, T, h, slice, C.out + O_PHG + sidx * 4096);
            else scan_long<3, 8, 1>(C, wl, row0, T, h, slice, C.out + O_PGDN + sidx * 4096);
        } else {
            if (kind == 0) { scan_task<0, 4, 2>(C, row0, T, h, slice, args.in[2] + sidx * 4096, C.out + O_SRET + sidx * 4096); }
            else if (kind == 1) { scan_task<1, 2, 4>(C, row0, T, h, slice, args.in[3] + sidx * 2048, C.out + O_SGLA + sidx * 2048); }
            else if (kind == 2) { scan_task<2, 4, 2>(C, row0, T, h, slice, args.in[4] + sidx * 4096, C.out + O_SHG + sidx * 4096); }
            else { scan_task<3, 4, 1>(C, row0, T, h, slice, args.in[5] + sidx * 4096, C.out + O_SGDN + sidx * 4096); }
        }
    }
    if (l == 0 && C.wave >= 5 && mode != 1) {
        LAS float* scr = (LAS float*)(C.lds + 4 * 26624 + (C.wave - 5) * 8704);
        constexpr int I_F0 = I_WI + I_WO, I_L0B = I_F0 + I_WOUT;
        for (int it = (C.wave - 5) * 256 + (int)blockIdx.x; it < I_L0B + I_MAIN; it += 768) {
            if (it < I_F0) convert_item(args, C.ws, 0, I_F0 + it, scr, C.lane);
            else if (it < I_L0B) convert_item(args, C.ws, 0, 2 * I_F0 + I_WIN + (it - I_F0), scr, C.lane);
            else convert_item(args, C.ws, 1, it - I_L0B, scr, C.lane);
        }
    }
}

__device__ __forceinline__ void post_phase(const Args& args, LAS unsigned char* lds_, int l) {
    const Ctx C = make_ctx(args, lds_);
    const bf16* PROJ = (const bf16*)(C.ws + WS_BIG); bf16* H = (bf16*)(C.ws + WS_H);
    const int lane = C.lane, mixer = lane >> 4, cc = (lane & 15) * 16;
    const int gbase = mixer == 0 ? C_RG : mixer == 1 ? C_AG : mixer == 2 ? C_HG : C_DG;
    const float* nw = mixer == 1 ? args.in[24] + l * 64 : mixer == 2 ? args.in[25] + l * 64 : args.in[26] + l * 64;
    float w[16];
#pragma unroll
    for (int i = 0; i < 16; ++i) w[i] = mixer == 0 ? 1.0f : nw[(cc + i) & 63];
    v4u na0, na1, ng0, ng1;
    if (C.gw < M) { const bf16* hp = H + (size_t)C.gw * D + lane * 16; const bf16* gp = PROJ + (size_t)C.gw * NINP + gbase + cc;
        na0 = *(const v4u*)hp; na1 = *(const v4u*)(hp + 8); ng0 = *(const v4u*)gp; ng1 = *(const v4u*)(gp + 8); }
#pragma unroll 1
    for (int r = C.gw; r < M; r += C.NGW) {
        bf16* hp = H + (size_t)r * D + lane * 16; const bf16* gp = PROJ + (size_t)r * NINP + gbase + cc;
        const v4u a0 = na0, a1 = na1, g0 = ng0, g1 = ng1;
        if (r + C.NGW < M) { const bf16* hn = hp + (size_t)C.NGW * D; const bf16* gn = gp + (size_t)C.NGW * NINP;
            na0 = *(const v4u*)hn; na1 = *(const v4u*)(hn + 8); ng0 = *(const v4u*)gn; ng1 = *(const v4u*)(gn + 8); }
        float y[16], g[16];
        const unsigned aw[8] = {a0.x, a0.y, a0.z, a0.w, a1.x, a1.y, a1.z, a1.w}, gw_[8] = {g0.x, g0.y, g0.z, g0.w, g1.x, g1.y, g1.z, g1.w};
        float ss = 0.f;
#pragma unroll
        for (int i = 0; i < 8; ++i) { y[2 * i] = bflo(aw[i]); y[2 * i + 1] = bfhi(aw[i]); g[2 * i] = bflo(gw_[i]); g[2 * i + 1] = bfhi(gw_[i]); ss += y[2 * i] * y[2 * i] + y[2 * i + 1] * y[2 * i + 1]; }
        ss = quad_sum(ss);
        const float rs = rsqrtf(ss * (1.0f / 64.0f) + RMS_EPS);
        unsigned ow[8];
#pragma unroll
        for (int i = 0; i < 8; ++i) ow[i] = pk2(y[2 * i] * rs * w[2 * i] * siluf_(g[2 * i]), y[2 * i + 1] * rs * w[2 * i + 1] * siluf_(g[2 * i + 1]));
        *(v4u*)hp = (v4u){ow[0], ow[1], ow[2], ow[3]}; *(v4u*)(hp + 8) = (v4u){ow[4], ow[5], ow[6], ow[7]};
    }
}

__global__ void __launch_bounds__(NWAVES * 64, 2) mega_fwd(Args args) {
    extern __shared__ __attribute__((aligned(16))) unsigned char lds[];
    cg::grid_group grid = cg::this_grid();
    LAS unsigned char* const LDSP = (LAS unsigned char*)lds;
    const int G = (int)gridDim.x, bx = (int)blockIdx.x;
    if (threadIdx.x < 64) ((LAS unsigned*)(LDSP + MISC_OFF))[threadIdx.x] = 0u;
    __syncthreads();
    (void)xcd_barrier_post((unsigned*)args.ws, (volatile LAS unsigned*)(LDSP + MISC_OFF));
#define FRESH() float* out_ = fresh_ptr(args.out); unsigned char* ws = fresh_ptr(args.ws); \
    float* MOD = (float*)(ws + WS_MOD); bf16* H = (bf16*)(ws + WS_H); bf16* BIG = (bf16*)(ws + WS_BIG); (void)MOD; (void)H; (void)BIG; (void)out_;

    p0_prologue(args, LDSP);
    if (args.ws == nullptr) grid.sync();
    grid_bar(args, LDSP);
    {
        FRESH();
        pg8::Gemm g{(const bf16*)(ws + WS_AC), BIG, 256, 2 * NMODC, D}; pg8::StaticOrder S; S.init(256, 2 * NMODC, G, bx, D);
        pg8::EpiMod E{MOD, args.in[10]};
        pg8::gemm_phase<pg8::EpiMod, pg8::StaticOrder, PG8_ALIGN, PG8_SP2>(LDSP, g, S, E);
    }
    p1_convert(args, LDSP);
    grid_bar(args, LDSP);
    p2_modulate0(args, LDSP);
    grid_bar(args, LDSP);
#pragma unroll 1
    for (int l = 0; l < 2; ++l) {
#pragma unroll 1
        for (int f = 0; f < 2; ++f) {
            if (f == 1) {
                {
                    FRESH();
                    pg8::Gemm g{H, (const bf16*)(ws + WS_W + (size_t)l * W_LAYER + W_WIN), M, NINP, D}; pg8::StaticOrder S; S.init(M, NINP, G, bx, D);
                    pg8::EpiPlain E{BIG, NINP};
                    pg8::gemm_phase<pg8::EpiPlain, pg8::StaticOrder, PG8_ALIGN, PG8_SP2>(LDSP, g, S, E);
                }
                grid_bar(args, LDSP);
                prep_phase(args, LDSP, l);
                grid_bar(args, LDSP);
                scan_phase(args, LDSP, l);
#ifdef PROBE_SCANMODE
                grid_bar(args, LDSP); scan_phase(args, LDSP, l, PROBE_SCANMODE);
#endif
                grid_bar(args, LDSP);
                post_phase(args, LDSP, l);
                grid_bar(args, LDSP);
                {
                    FRESH();
                    pg8::Gemm g{H, (const bf16*)(ws + WS_W + (size_t)l * W_LAYER + W_WOUT), M, D, D}; pg8::SplitOrder S; S.init(D, G, bx);
                    pg8::EpiRes E{out_, out_, (float*)(ws + WS_SB), MOD + (size_t)l * NB * NMODC + 5 * 1024, (const float*)(ws + WS_STATS), args.in[11] + (size_t)(l * 3) * D, args.in[12] + (size_t)(l * 3) * D, 1.0f, D / 64};
                    pg8::gemm_phase<pg8::EpiRes, pg8::SplitOrder, PG8_ALIGN, PG8_SP2>(LDSP, g, S, E);
                }
                grid_bar(args, LDSP);
                ln_phase(args, LDSP, l, 1, true, l, 6, 4, ALPHA, false);
                grid_bar(args, LDSP);
            }
            {
                FRESH();
                pg8::Gemm g{H, (const bf16*)(ws + WS_W + (size_t)l * W_LAYER + (f ? W_WI2 : W_WI1)), M, NWI, D}; pg8::StaticOrder S; S.init(M, NWI, G, bx, D);
                pg8::EpiSwiglu E{BIG, DFF};
                pg8::gemm_phase<pg8::EpiSwiglu, pg8::StaticOrder, PG8_ALIGN, PG8_SP2>(LDSP, g, S, E);
            }
            grid_bar(args, LDSP);
            {
                FRESH();
                pg8::Gemm g{BIG, (const bf16*)(ws + WS_W + (size_t)l * W_LAYER + (f ? W_WO2 : W_WO1)), M, D, DFF}; pg8::SplitOrder S; S.init(DFF, G, bx);
                const bool first = (l == 0 && f == 0); const int pinst = f ? l * 3 + 1 : l * 3 - 1;
                pg8::EpiRes E{out_, first ? args.in[0] : out_, (float*)(ws + WS_SB), MOD + (size_t)l * NB * NMODC + (f ? 8 : 2) * 1024, (const float*)(ws + WS_STATS),
                              first ? (const float*)(ws + WS_ID) : args.in[11] + (size_t)pinst * D, first ? (const float*)(ws + WS_ID) + 1024 : args.in[12] + (size_t)pinst * D, 0.5f, DFF / 64};
                pg8::gemm_phase<pg8::EpiRes, pg8::SplitOrder, PG8_ALIGN, PG8_SP2>(LDSP, g, S, E);
            }
            grid_bar(args, LDSP);
            if (f == 0) ln_phase(args, LDSP, l, 0, true, l, 3, 11, ALPHA, false);
            else ln_phase(args, LDSP, l, 2, l == 0, 1, 0, 11, l == 0 ? ALPHA : 1.0f, l == 1);
            if (!(l == 1 && f == 1)) grid_bar(args, LDSP);
        }
    }
}

extern "C" void kernel_launch(void* const* d_in, const int* in_sizes, int n_in, void* d_out, int out_size, void* d_ws, size_t ws_size, hipStream_t stream) {
    static int grid = 0;
    if (grid == 0) {
        if (n_in != 28 || (size_t)out_size != O_END || ws_size < WS_END) { fprintf(stderr, "kernel_launch: unexpected sizes n_in %d out %d ws %zu (need %zu)\n", n_in, out_size, ws_size, (size_t)WS_END); grid = -1; return; }
        int dev = 0, cus = 0, per_cu = 0;
        hipGetDevice(&dev); hipDeviceGetAttribute(&cus, hipDeviceAttributeMultiprocessorCount, dev);
        hipFuncSetAttribute((const void*)mega_fwd, hipFuncAttributeMaxDynamicSharedMemorySize, LDS_BYTES);
        hipOccupancyMaxActiveBlocksPerMultiprocessor(&per_cu, (const void*)mega_fwd, NWAVES * 64, LDS_BYTES);
        (void)hipGetLastError();
        if (per_cu < 1 || cus < 256) { fprintf(stderr, "kernel_launch: occupancy %d cus %d\n", per_cu, cus); grid = -1; return; }
        grid = 256;
    }
    if (grid < 0) return;
    if (hipMemsetAsync(d_ws, 0, 65536, stream) != hipSuccess) { fprintf(stderr, "memset failed\n"); return; }
    Args a{};
    for (int i = 0; i < 28; ++i) a.in[i] = (const float*)d_in[i];
    a.out = (float*)d_out; a.ws = (unsigned char*)d_ws;
    void* kargs[] = {&a};
    hipError_t e = hipLaunchCooperativeKernel((const void*)mega_fwd, dim3(grid), dim3(NWAVES * 64), kargs, LDS_BYTES, stream);
    if (e != hipSuccess) fprintf(stderr, "cooperative launch failed: %s\n", hipGetErrorString(e));
}
```

```cpp
#include <hip/hip_runtime.h>
#include <hip/hip_cooperative_groups.h>
#include <cstdio>
#include <cstdint>
namespace cg = cooperative_groups;
namespace pg8 {
#define PG8_LAS __attribute__((address_space(3)))
typedef unsigned short bf16_t;
typedef short bf16x8 __attribute__((ext_vector_type(8)));
typedef float f32x4 __attribute__((ext_vector_type(4)));
typedef unsigned u32x4 __attribute__((ext_vector_type(4)));
constexpr int BM = 256, BK = 64, HALF = 128, HTB = HALF * BK * 2  , STAGE_BYTES = 8 * HTB, NXCD = 8, WGM = 8;

__host__ __device__ __forceinline__ int lds_byte(int r, int c) { const int st = (r >> 4) * 2 + (c >> 5), rr = r & 15, cc = c & 31, ob = rr * 64 + cc * 2; return st * 1024 + (ob ^ (((ob >> 9) & 1) << 5)); }
__host__ __device__ __forceinline__ void stage_rc(int b, int& R, int& C) { const int st = b / 1024, sb = b % 1024, swz = sb ^ (((sb >> 9) & 1) << 5); R = (st >> 1) * 16 + swz / 64; C = (st & 1) * 32 + (swz % 64) / 2; }
__host__ __device__ __forceinline__ int perm32(int rho) { const int n = rho >> 4, i = rho & 15; return 8 * (i >> 2) + 4 * n + (i & 3); }

struct Unit { int pm, pn, k0, nt; };
struct Gemm { const bf16_t* A; const bf16_t* Bt; int M, N, K; };

struct StaticOrder {
    int nM, nN, nwg, G, c, ntf;
    __host__ __device__ void init(int M, int N, int G_, int c_, int K_ = 1024) { nM = M / BM; nN = N / BM; nwg = nM * nN; G = G_; c = c_; ntf = K_ / BK; }
    __host__ __device__ bool next(int i, Unit& u) const {
        const long L = (long)i * G + c; if (L >= nwg) return false;
        int wgid = (int)L; { const int q = nwg / NXCD, r = nwg % NXCD, xcd = wgid % NXCD, off = wgid / NXCD; wgid = (xcd < r ? xcd * (q + 1) : r * (q + 1) + (xcd - r) * q) + off; }
        const int nig = WGM * nN, gid = wgid / nig, fm = gid * WGM, gsz = (nM - fm) < WGM ? (nM - fm) : WGM;
        u.pm = fm + ((wgid % nig) % gsz); u.pn = (wgid % nig) / gsz; u.k0 = 0; u.nt = ntf; return true;
    }
    __device__ __forceinline__ void a_ready(const Unit&) const {}
    __device__ __forceinline__ void done(const Unit&) const {}
};

struct SplitOrder {
    StaticOrder base; int ppu, c;
    static constexpr int PK = 4;
    __host__ __device__ void init(int K_, int G_, int c_) { base.init(16384, 1024, G_, c_, K_); ppu = (K_ / BK) / PK; c = c_; }
    __host__ __device__ bool next(int i, Unit& u) const {
        if (i == 0) return base.next(0, u);
        if (i == 1 && c < 8 * ppu) { const int j = c / ppu, p = c - j * ppu; u.pm = 64 + (j >> 2); u.pn = j & 3; u.k0 = p * PK; u.nt = PK; return true; }
        return false;
    }
    __device__ __forceinline__ void a_ready(const Unit&) const {}
    __device__ __forceinline__ void done(const Unit&) const {}
};

__device__ __forceinline__ unsigned cvt_pk_bf16(float lo, float hi) { unsigned r; asm volatile("v_cvt_pk_bf16_f32 %0, %1, %2" : "=v"(r) : "v"(lo), "v"(hi)); return r; }
typedef float f32x2 __attribute__((ext_vector_type(2)));
__device__ __forceinline__ f32x2 gelu_pk(f32x2 v) {
    const f32x2 av = __builtin_elementwise_abs(v), d = av * 0.2316418882f + 1.0f;
    f32x2 t; t.x = __builtin_amdgcn_rcpf(d.x); t.y = __builtin_amdgcn_rcpf(d.y);
    f32x2 q = t * 0.5307027145f + (-0.7265760135f); q = q * t + 0.7107068705f; q = q * t + (-0.142248368f); q = q * t + 0.127414796f; q = q * t;
    const f32x2 s = (v * v) * (-0.72134752044f);
    f32x2 e; e.x = __builtin_amdgcn_exp2f(s.x); e.y = __builtin_amdgcn_exp2f(s.y);
    const f32x2 m = v * (q * e), r = v - m;
    f32x2 o; o.x = v.x < 0.f ? m.x : r.x; o.y = v.y < 0.f ? m.y : r.y; return o;
}

template <int ACT  > struct EpiBf16 {
    static constexpr bool PERM = true, AFTER_DRAIN = false; static_assert(ACT == 0 || ACT == 1, "EpiBf16: ACT is 0 (none) or 1 (gelu_pk)");
    bf16_t* O; int ldc; const float* bias; int split_cols; size_t split_stride; float scale0;
    __device__ __forceinline__ void operator()(const f32x4 (&acc)[2][2][4][2], const Unit& u, int wr, int wc, int fr, int fq) const {
        const int row0 = u.pm * BM + wr * 64 + fr; int colt = u.pn * BM; bf16_t* base = O;
        float sc = 1.f; if (split_cols) { const int t = colt / split_cols; base += (size_t)t * split_stride; colt -= t * split_cols; if (t == 0) sc = scale0; }
        const int col0 = colt + wc * 32 + 8 * fq, bcol0 = u.pn * BM + wc * 32 + 8 * fq;
        f32x4 bv[2][2];
#pragma unroll
        for (int bj = 0; bj < 2; ++bj)
#pragma unroll
            for (int n = 0; n < 2; ++n) bv[bj][n] = bias ? *(const f32x4*)(bias + bcol0 + bj * HALF + 4 * n) : (f32x4){0.f, 0.f, 0.f, 0.f};
#pragma unroll
        for (int ai = 0; ai < 2; ++ai)
#pragma unroll
            for (int m = 0; m < 4; ++m) { bf16_t* rowp = base + (size_t)(row0 + ai * HALF + m * 16) * ldc + col0;
#pragma unroll
                for (int bj = 0; bj < 2; ++bj) { f32x4 v0 = acc[ai][bj][m][0] + bv[bj][0], v1 = acc[ai][bj][m][1] + bv[bj][1];
                    if (ACT == 1) { f32x2 a = gelu_pk((f32x2){v0[0], v0[1]}), b = gelu_pk((f32x2){v0[2], v0[3]}), c = gelu_pk((f32x2){v1[0], v1[1]}), d = gelu_pk((f32x2){v1[2], v1[3]});
                        v0 = (f32x4){a.x, a.y, b.x, b.y}; v1 = (f32x4){c.x, c.y, d.x, d.y}; }
                    v0 = v0 * sc; v1 = v1 * sc; u32x4 w; w.x = cvt_pk_bf16(v0[0], v0[1]); w.y = cvt_pk_bf16(v0[2], v0[3]); w.z = cvt_pk_bf16(v1[0], v1[1]); w.w = cvt_pk_bf16(v1[2], v1[3]);
                    *(u32x4*)(rowp + bj * HALF) = w; } }
    }
};
template <class Epi, class Sched, bool ALIGN_EPI = false, bool SP2 = false>
__device__ __forceinline__ void gemm_phase(PG8_LAS unsigned char* lds, const Gemm g, const Sched& S, const Epi& E) {
    int tid_ = threadIdx.x; asm volatile("" : "+v"(tid_));
    const int tid = tid_, wid = __builtin_amdgcn_readfirstlane(tid >> 6), lane = tid & 63, wr = wid >> 2, wc = wid & 3, fr = lane & 15, fq = lane >> 4;
    const int K = g.K;
    unsigned voffA[2], voffB[2];
#pragma unroll
    for (int i = 0; i < 2; ++i) { int R, C; stage_rc(tid * 16 + i * 8192, R, C); const int Rb = Epi::PERM ? ((R & ~31) + perm32(R & 31)) : R;
        voffA[i] = (unsigned)(R * K + C) * 2u; voffB[i] = (unsigned)(Rb * K + C) * 2u; }
    const size_t kstep = (size_t)(BK * 2);
    const size_t hstep = (size_t)HALF * K * 2;
    const size_t tstep = 2 * hstep;
    const unsigned ldsw = (unsigned)wid * 1024u;
    const int aoff = lds_byte(wr * 64 + fr, fq * 8), boff = lds_byte(wc * 32 + fr, fq * 8);
#define PG8_SA(b, h) (((b) * 2 + (h)) * HTB)
#define PG8_SB(b, h) ((4 + (b) * 2 + (h)) * HTB)
#define PG8_STAGE(bufoff, gbase, voff) do { _Pragma("unroll") for (int _i = 0; _i < 2; ++_i) \
        __builtin_amdgcn_global_load_lds((const unsigned*)((const char*)(gbase) + (voff)[_i]), (PG8_LAS unsigned*)(lds + (bufoff) + ldsw + _i * 8192), 16, 0, 0); } while (0)
#define PG8_LDA(dst, b, h) do { _Pragma("unroll") for (int m = 0; m < 4; ++m) _Pragma("unroll") for (int k = 0; k < 2; ++k) dst[m][k] = *(const PG8_LAS bf16x8*)(lds + PG8_SA(b, h) + aoff + m * 2048 + k * 1024); } while (0)
#define PG8_LDB(dst, b, h) do { _Pragma("unroll") for (int n = 0; n < 2; ++n) _Pragma("unroll") for (int k = 0; k < 2; ++k) dst[n][k] = *(const PG8_LAS bf16x8*)(lds + PG8_SB(b, h) + boff + n * 2048 + k * 1024); } while (0)
#define PG8_MMA(ai, bj, At, Bt) do { __builtin_amdgcn_s_setprio(1); _Pragma("unroll") for (int m = 0; m < 4; ++m) _Pragma("unroll") for (int n = 0; n < 2; ++n) _Pragma("unroll") for (int k = 0; k < 2; ++k) \
        acc[ai][bj][m][n] = __builtin_amdgcn_mfma_f32_16x16x32_bf16(Bt[n][k], At[m][k], acc[ai][bj][m][n], 0, 0, 0); __builtin_amdgcn_s_setprio(0); } while (0)
#define PG8_WAIT_V(n) asm volatile("s_waitcnt vmcnt(" #n ")" ::: "memory")
#define PG8_WAIT_L(n) asm volatile("s_waitcnt lgkmcnt(" #n ")" ::: "memory")
#define PG8_BAR __builtin_amdgcn_s_barrier()
#define PG8_SCHED __builtin_amdgcn_sched_barrier(0)
    Unit cur, nxt; int ui = 0;
    if (!S.next(0, cur)) return;
    f32x4 acc[2][2][4][2];
#pragma unroll
    for (int a = 0; a < 2; ++a)
#pragma unroll
        for (int b = 0; b < 2; ++b)
#pragma unroll
            for (int m = 0; m < 4; ++m)
#pragma unroll
                for (int n = 0; n < 2; ++n) acc[a][b][m][n] = (f32x4){0.f, 0.f, 0.f, 0.f};
    bf16x8 At[4][2], B0[2][2], B1[2][2];
    const char* cA = (const char*)g.A + (size_t)cur.pm * tstep + (size_t)cur.k0 * kstep; const char* cB = (const char*)g.Bt + (size_t)cur.pn * tstep + (size_t)cur.k0 * kstep;
    S.a_ready(cur);
    if constexpr (SP2) {
        PG8_STAGE(PG8_SB(0, 0), cB, voffB); PG8_STAGE(PG8_SB(0, 1), cB + hstep, voffB); PG8_STAGE(PG8_SA(0, 0), cA, voffA); PG8_STAGE(PG8_SA(0, 1), cA + hstep, voffA);
        if (wr == 1) PG8_BAR;
        PG8_WAIT_V(2); PG8_BAR;
        PG8_STAGE(PG8_SB(1, 0), cB + kstep, voffB); PG8_STAGE(PG8_SA(1, 0), cA + kstep, voffA); PG8_STAGE(PG8_SB(1, 1), cB + hstep + kstep, voffB);
        PG8_WAIT_V(6); PG8_BAR;
    } else {
        PG8_STAGE(PG8_SB(0, 0), cB, voffB); PG8_STAGE(PG8_SA(0, 0), cA, voffA); PG8_STAGE(PG8_SB(0, 1), cB + hstep, voffB); PG8_STAGE(PG8_SA(0, 1), cA + hstep, voffA);
        if (wr == 1) PG8_BAR;
        PG8_WAIT_V(4); PG8_BAR;
        PG8_STAGE(PG8_SB(1, 0), cB + kstep, voffB); PG8_STAGE(PG8_SA(1, 0), cA + kstep, voffA); PG8_STAGE(PG8_SB(1, 1), cB + hstep + kstep, voffB);
        PG8_WAIT_V(6); PG8_BAR;
    }
    for (;;) {
        const bool has_next = S.next(ui + 1, nxt);
        const char* nA = has_next ? (const char*)g.A + (size_t)nxt.pm * tstep + (size_t)nxt.k0 * kstep : cA; const char* nB = has_next ? (const char*)g.Bt + (size_t)nxt.pn * tstep + (size_t)nxt.k0 * kstep : cB;
        const int nt = cur.nt;
        for (int t = 0; t < nt; t += 2) {
            const bool last = (t == nt - 2);
            const char* a1 = cA + (size_t)(t + 1) * kstep;
            const char* a2 = last ? nA : cA + (size_t)(t + 2) * kstep; const char* b2 = last ? nB : cB + (size_t)(t + 2) * kstep;
            const char* a3 = a2 + kstep; const char* b3 = b2 + kstep;
            if (last && has_next) S.a_ready(nxt);
            if constexpr (SP2) {
            PG8_LDB(B0, 0, 0); PG8_LDB(B1, 0, 1); PG8_SCHED; PG8_LDA(At, 0, 0); PG8_STAGE(PG8_SA(1, 1), a1 + hstep, voffA);
            PG8_WAIT_V(8); PG8_WAIT_L(0); PG8_BAR; PG8_MMA(0, 0, At, B0); PG8_MMA(0, 1, At, B1); PG8_BAR; PG8_SCHED;
            PG8_LDA(At, 0, 1); PG8_STAGE(PG8_SB(0, 0), b2, voffB); PG8_STAGE(PG8_SB(0, 1), b2 + hstep, voffB); PG8_STAGE(PG8_SA(0, 0), a2, voffA);
            PG8_WAIT_V(8); PG8_WAIT_L(0); PG8_BAR; PG8_MMA(1, 0, At, B0); PG8_MMA(1, 1, At, B1); PG8_BAR; PG8_SCHED;
            PG8_LDB(B0, 1, 0); PG8_LDB(B1, 1, 1); PG8_SCHED; PG8_LDA(At, 1, 0); PG8_STAGE(PG8_SA(0, 1), a2 + hstep, voffA);
            PG8_WAIT_V(8); PG8_WAIT_L(0); PG8_BAR; PG8_MMA(0, 0, At, B0); PG8_MMA(0, 1, At, B1); PG8_BAR; PG8_SCHED;
            PG8_LDA(At, 1, 1); PG8_STAGE(PG8_SB(1, 0), b3, voffB); PG8_STAGE(PG8_SB(1, 1), b3 + hstep, voffB); PG8_STAGE(PG8_SA(1, 0), a3, voffA);
            PG8_WAIT_V(8); PG8_WAIT_L(0); PG8_BAR; PG8_MMA(1, 0, At, B0); PG8_MMA(1, 1, At, B1); PG8_BAR; PG8_SCHED;
            } else {
            PG8_LDB(B0, 0, 0); PG8_SCHED; PG8_LDA(At, 0, 0); PG8_STAGE(PG8_SA(1, 1), a1 + hstep, voffA);
            PG8_WAIT_L(8); PG8_BAR; PG8_WAIT_L(0); PG8_MMA(0, 0, At, B0); PG8_BAR; PG8_SCHED;
            PG8_LDB(B1, 0, 1); PG8_STAGE(PG8_SB(0, 0), b2, voffB);
            PG8_BAR; PG8_WAIT_L(0); PG8_MMA(0, 1, At, B1); PG8_BAR;
            PG8_LDA(At, 0, 1); PG8_STAGE(PG8_SA(0, 0), a2, voffA);
            PG8_BAR; PG8_WAIT_L(0); PG8_MMA(1, 0, At, B0); PG8_BAR; PG8_SCHED;
            PG8_STAGE(PG8_SB(0, 1), b2 + hstep, voffB);
            PG8_WAIT_V(6); PG8_BAR; PG8_MMA(1, 1, At, B1); PG8_BAR;
            PG8_LDB(B0, 1, 0); PG8_SCHED; PG8_LDA(At, 1, 0); PG8_STAGE(PG8_SA(0, 1), a2 + hstep, voffA);
            PG8_WAIT_L(8); PG8_BAR; PG8_WAIT_L(0); PG8_MMA(0, 0, At, B0); PG8_BAR; PG8_SCHED;
            PG8_LDB(B1, 1, 1); PG8_STAGE(PG8_SB(1, 0), b3, voffB);
            PG8_BAR; PG8_WAIT_L(0); PG8_MMA(0, 1, At, B1); PG8_BAR;
            PG8_LDA(At, 1, 1); PG8_STAGE(PG8_SA(1, 0), a3, voffA);
            PG8_BAR; PG8_WAIT_L(0); PG8_MMA(1, 0, At, B0); PG8_BAR; PG8_SCHED;
            PG8_STAGE(PG8_SB(1, 1), b3 + hstep, voffB);
            PG8_WAIT_V(6); PG8_BAR; PG8_MMA(1, 1, At, B1); PG8_BAR;
            }
        }
        if constexpr (ALIGN_EPI) { if (wr == 0) PG8_BAR; }
        if constexpr (!Epi::AFTER_DRAIN) { E(acc, cur, wr, wc, fr, fq); S.done(cur); }
        if (!has_next) break;
#pragma unroll
        for (int a = 0; a < 2; ++a)
#pragma unroll
            for (int b = 0; b < 2; ++b)
#pragma unroll
                for (int m = 0; m < 4; ++m)
#pragma unroll
                    for (int n = 0; n < 2; ++n) acc[a][b][m][n] = (f32x4){0.f, 0.f, 0.f, 0.f};
        cur = nxt; cA = nA; cB = nB; ++ui;
        if constexpr (ALIGN_EPI) { if (wr == 1) PG8_BAR; }
    }
    PG8_WAIT_V(0);
    if constexpr (!ALIGN_EPI) { if (wr == 0) PG8_BAR; }
    PG8_BAR;
    if constexpr (Epi::AFTER_DRAIN) { E.fused(acc, cur, wr, wc, fr, fq, lds, wid, lane); S.done(cur); }
#undef PG8_SA
#undef PG8_SB
#undef PG8_STAGE
#undef PG8_LDA
#undef PG8_LDB
#undef PG8_MMA
#undef PG8_WAIT_V
#undef PG8_WAIT_L
#undef PG8_BAR
#undef PG8_SCHED
}
}
#define PG8_SP2 true
#define PG8_ALIGN true

constexpr int D = 1024, TP = 2048, BP = 8, BS = 128, TS = 4;
constexpr int MP = BP * TP, MS = BS * TS, M = MP + MS;
constexpr int DFF = 2816, NWI = 2 * DFF, NIN = 3864, NINP = 4096, NMODC = 9216, NB = BP + BS;
constexpr int SBW = 1664, SFW = 396;
constexpr float LN_EPS = 1e-5f, RMS_EPS = 1e-6f;
constexpr float ALPHA = 1.41421356237f;
constexpr int C_RQ = 0, C_RK = 256, C_RV = 512, C_RG = 768, C_AQ = 1024, C_AK = 1152, C_AV = 1280, C_ALR = 1536, C_AG = 1552,
              C_HQ = 1808, C_HF = 2064, C_HI = 2320, C_HG = 2576, C_DQKV = 2832, C_DB = 3600, C_DA = 3604, C_DG = 3608;
constexpr int SB_RQ = 0, SB_RK = 256, SB_AQ = 512, SB_HQ = 640, SB_DQ = 896, SB_DK = 1152, SB_DV = 1408;
constexpr int SF_ADEC = 0, SF_HF = 128, SF_BETA = 384, SF_DDEC = 388, SF_QK = 392;
constexpr size_t O_Y = 0;
constexpr size_t O_PRET = (size_t)M * D;
constexpr size_t O_PGLA = O_PRET + 2ull * BP * 4 * 64 * 64;
constexpr size_t O_PHG = O_PGLA + 2ull * BP * 4 * 32 * 64;
constexpr size_t O_PGDN = O_PHG + 2ull * BP * 4 * 64 * 64;
constexpr size_t O_PCONV = O_PGDN + 2ull * BP * 4 * 64 * 64;
constexpr size_t O_SRET = O_PCONV + 2ull * BP * 3 * 768;
constexpr size_t O_SGLA = O_SRET + 2ull * BS * 4 * 64 * 64;
constexpr size_t O_SHG = O_SGLA + 2ull * BS * 4 * 32 * 64;
constexpr size_t O_SGDN = O_SHG + 2ull * BS * 4 * 64 * 64;
constexpr size_t O_SCONV = O_SGDN + 2ull * BS * 4 * 64 * 64;
constexpr size_t O_END = O_SCONV + 2ull * BS * 3 * 768;

constexpr size_t MiB = 1u << 20;
constexpr size_t WS_ROPE = 1 * MiB;
constexpr size_t WS_AC = 2 * MiB;
constexpr size_t WS_MOD = 3 * MiB;
constexpr size_t WS_STATS = 2 * MiB + 512 * 1024;
constexpr size_t WS_ID = 2 * MiB + 768 * 1024;
constexpr size_t WS_W = 13 * MiB;
constexpr size_t W_WI1 = 0, W_WO1 = 11 * MiB, W_WI2 = W_WO1 + 5 * MiB + MiB / 2, W_WO2 = W_WI2 + 11 * MiB, W_WIN = W_WO2 + 5 * MiB + MiB / 2, W_WOUT = W_WIN + 8 * MiB, W_LAYER = 43 * MiB;
constexpr size_t WS_H = WS_W + 2 * W_LAYER;
constexpr size_t WS_BIG = WS_H + 33 * MiB;
constexpr size_t WS_SB = WS_BIG + 132 * MiB;
constexpr size_t WS_SF = WS_SB + 54 * MiB;
constexpr size_t WS_END = WS_SF + 26 * MiB;
static_assert((size_t)M * SBW * 2 <= 54 * MiB && (size_t)M * SFW * 4 <= 26 * MiB && (size_t)M * 4096 * 2 <= 132 * MiB && (size_t)M * D * 2 <= 33 * MiB, "ws map");

constexpr int LDS_BYTES = 147456;
constexpr int NWAVES = 8;

#define GAS __attribute__((address_space(1)))
#define LAS __attribute__((address_space(3)))
typedef unsigned short bf16;
typedef unsigned v4u __attribute__((ext_vector_type(4)));
typedef unsigned v2u __attribute__((ext_vector_type(2)));
typedef float f32x4 __attribute__((ext_vector_type(4)));
typedef float f32x2 __attribute__((ext_vector_type(2)));
#define LDS_WAIT() asm volatile("s_waitcnt lgkmcnt(0)" ::: "memory")

__device__ __forceinline__ float bf2f(unsigned b) { return __uint_as_float(b << 16); }
__device__ __forceinline__ float bflo(unsigned w) { return __uint_as_float(w << 16); }
__device__ __forceinline__ float bfhi(unsigned w) { return __uint_as_float(w & 0xffff0000u); }
__device__ __forceinline__ unsigned pk2(float lo, float hi) { return pg8::cvt_pk_bf16(lo, hi); }
__device__ __forceinline__ float sigmoidf_(float x) { return __builtin_amdgcn_rcpf(1.0f + __expf(-x)); }
__device__ __forceinline__ float siluf_(float x) { return x * __builtin_amdgcn_rcpf(1.0f + __expf(-x)); }
__device__ __forceinline__ float wave_sum(float v) {
#pragma unroll
    for (int o = 1; o < 64; o <<= 1) v += __shfl_xor(v, o);
    return v;
}
template <int CTRL> __device__ __forceinline__ float dppmov(float v) { return __int_as_float(__builtin_amdgcn_update_dpp(0, __float_as_int(v), CTRL, 0xf, 0xf, true)); }
__device__ __forceinline__ float quad_sum(float v) { v += dppmov<0xB1>(v); v += dppmov<0x4E>(v); return v; }
__device__ __forceinline__ float row8_sum(float v) { v += dppmov<0xB1>(v); v += dppmov<0x4E>(v); v += dppmov<0x141>(v); return v; }
__device__ __forceinline__ float row16_sum(float v) { v += dppmov<0xB1>(v); v += dppmov<0x4E>(v); v += dppmov<0x141>(v); v += dppmov<0x140>(v); return v; }

struct Args { const float* in[28]; float* out; unsigned char* ws; };

struct Ctx {
    int tid, lane, wave, gw, NGW;
    LAS unsigned char* lds;
    float* out; unsigned char* ws;
};
template <class T> __device__ __forceinline__ T* fresh_ptr(T* p) {
    unsigned lo = (unsigned)(uintptr_t)p, hi = (unsigned)((uintptr_t)p >> 32);
    asm volatile("" : "+v"(lo), "+v"(hi));
    lo = __builtin_amdgcn_readfirstlane(lo); hi = __builtin_amdgcn_readfirstlane(hi);
    return (T*)(__attribute__((address_space(1))) T*)(((uintptr_t)hi << 32) | (uintptr_t)lo);
}
__device__ __forceinline__ Ctx make_ctx(const Args& args, LAS unsigned char* lds) {
    Ctx C; int t = threadIdx.x; asm volatile("" : "+v"(t));
    C.tid = t; C.lane = t & 63; C.wave = __builtin_amdgcn_readfirstlane(t >> 6);
    C.gw = (int)blockIdx.x * NWAVES + C.wave; C.NGW = (int)gridDim.x * NWAVES;
    float* op = fresh_ptr(args.out); unsigned char* wp = fresh_ptr(args.ws);
    C.lds = lds; C.out = op; C.ws = wp; return C;
}
__device__ __forceinline__ int batch_of_row(int r) { return r < MP ? (r >> 11) : BP + ((r - MP) >> 2); }


typedef GAS unsigned gu32;
#define RLX_AGENT __ATOMIC_RELAXED, __HIP_MEMORY_SCOPE_AGENT
#define XB_TMO      128
#define XB_XCNT(j)  (256  + 64 * (j))
#define XB_XSUB(j)  (1280 + 64 * (j))
#define XB_XGEN(j)  (2304 + 64 * (j))
#define XB_TOP      3328
#define XB_TOPGEN   3392
#define XCD_BAR_WORDS 3456
#define XB_SPIN_CAP (1u << 18)

__device__ __forceinline__ unsigned xb_ld(unsigned* p)              { return __hip_atomic_load(p, __ATOMIC_RELAXED, __HIP_MEMORY_SCOPE_AGENT); }
__device__ __forceinline__ unsigned xb_add(unsigned* p, unsigned v) { return __hip_atomic_fetch_add(p, v, __ATOMIC_RELAXED, __HIP_MEMORY_SCOPE_AGENT); }
__device__ __forceinline__ unsigned xb_xcc_id() { return (unsigned)__builtin_amdgcn_s_getreg((3 << 11) | 20) & 0xFu; }
#define XB_SPIN(cond, bar) do { unsigned _sp = 0; while (cond) { __builtin_amdgcn_s_sleep(1); \
    if ((++_sp & 255u) == 0u) { if (xb_ld(&(bar)[XB_TMO])) break; if (_sp > XB_SPIN_CAP) { atomicAdd(&(bar)[XB_TMO], 1u); break; } } } } while (0)

struct XcdBarrier {
    unsigned* bar; unsigned x;
    volatile LAS unsigned* st;
};

__device__ __forceinline__ XcdBarrier xcd_barrier_post(unsigned* bar, volatile LAS unsigned* st) {
    XcdBarrier b; b.bar = bar; b.x = xb_xcc_id(); b.st = st;
    if (threadIdx.x == 0) (void)xb_add(&bar[XB_XCNT(b.x)], 1u);
    return b;
}
__device__ __forceinline__ void xcd_barrier_complete(unsigned* bar, unsigned x, unsigned& nloc, unsigned& nx) {
    const unsigned G = gridDim.x * gridDim.y * gridDim.z;
    unsigned sum, cnt, mine, sp = 0u;
    for (;;) {
        sum = 0u; cnt = 0u; mine = 0u;
#pragma unroll
        for (unsigned j = 0; j < 16; ++j) { const unsigned c = xb_ld(&bar[XB_XCNT(j)]); sum += c; cnt += (c > 0u) ? 1u : 0u; mine = (j == x) ? c : mine; }
        if (sum == G) break;
        __builtin_amdgcn_s_sleep(1);
        if ((++sp & 255u) == 0u) { if (xb_ld(&bar[XB_TMO])) break; if (sp > XB_SPIN_CAP) { atomicAdd(&bar[XB_TMO], 1u); break; } }
    }
    nloc = mine > 0u ? mine : 1u; nx = cnt > 0u ? cnt : 1u;
}

__device__ __forceinline__ void xcd_barrier(const XcdBarrier& b) {
    asm volatile("s_waitcnt vmcnt(0)" ::: "memory");
    __syncthreads();
    if (threadIdx.x == 0) {
        unsigned* bar = b.bar;
        __builtin_amdgcn_s_waitcnt(0);
        unsigned nloc = b.st[0], nx = b.st[1];
        if (nloc == 0u) { xcd_barrier_complete(bar, b.x, nloc, nx); b.st[0] = nloc; b.st[1] = nx; }
        const unsigned old = xb_add(&bar[XB_XSUB(b.x)], 1u);
        const unsigned gen = old / nloc;
        if (old + 1u == (gen + 1u) * nloc) {
            __builtin_amdgcn_fence(__ATOMIC_RELEASE, "agent");
            asm volatile("s_waitcnt vmcnt(0)" ::: "memory");
            const unsigned og = xb_add(&bar[XB_TOP], 1u);
            const unsigned tg = og / nx;
            if (og + 1u == (tg + 1u) * nx) xb_add(&bar[XB_TOPGEN], 1u);
            else XB_SPIN(xb_ld(&bar[XB_TOPGEN]) == tg, bar);
            __builtin_amdgcn_fence(__ATOMIC_ACQUIRE, "agent");
            xb_add(&bar[XB_XGEN(b.x)], 1u);
            asm volatile("s_waitcnt vmcnt(0)" ::: "memory");
        } else {
            XB_SPIN(xb_ld(&bar[XB_XGEN(b.x)]) == gen, bar);
            __builtin_amdgcn_fence(__ATOMIC_ACQUIRE, "agent");
            asm volatile("s_waitcnt vmcnt(0)" ::: "memory");
        }
    }
    __syncthreads();
}

constexpr int MISC_OFF = LDS_BYTES - 256;
__device__ __forceinline__ void grid_bar(const Args& args, LAS unsigned char* lds) {
    XcdBarrier b; b.bar = (unsigned*)fresh_ptr(args.ws); b.x = xb_xcc_id(); b.st = (volatile LAS unsigned*)(lds + MISC_OFF);
    xcd_barrier(b);
}

__device__ __forceinline__ float wave_sum2(float v) { v = row16_sum(v); v += __shfl_xor(v, 16); v += __shfl_xor(v, 32); return v; }

namespace pg8 {
struct EpiSwiglu {
    static constexpr bool PERM = true, AFTER_DRAIN = false;
    bf16_t* O; int ldc;
    __device__ __forceinline__ void operator()(const f32x4 (&acc)[2][2][4][2], const Unit& u, int wr, int wc, int fr, int fq) const {
        const int row0 = u.pm * BM + wr * 64 + fr, col0 = u.pn * 128 + wc * 32 + 8 * fq;
#pragma unroll
        for (int ai = 0; ai < 2; ++ai)
#pragma unroll
            for (int m = 0; m < 4; ++m) {
                bf16_t* rowp = O + (size_t)(row0 + ai * HALF + m * 16) * ldc + col0;
                float h[8];
#pragma unroll
                for (int n = 0; n < 2; ++n)
#pragma unroll
                    for (int j = 0; j < 4; ++j) {
                        const float a = acc[ai][0][m][n][j], b = acc[ai][1][m][n][j];
                        const float e = __builtin_amdgcn_exp2f(-1.44269504f * a);
                        h[n * 4 + j] = a * __builtin_amdgcn_rcpf(1.0f + e) * b;
                    }
                u32x4 w; w.x = cvt_pk_bf16(h[0], h[1]); w.y = cvt_pk_bf16(h[2], h[3]); w.z = cvt_pk_bf16(h[4], h[5]); w.w = cvt_pk_bf16(h[6], h[7]);
                *(u32x4*)rowp = w;
            }
    }
};
struct EpiPlain {
    static constexpr bool PERM = true, AFTER_DRAIN = false;
    bf16_t* O; int ldc;
    __device__ __forceinline__ void operator()(const f32x4 (&acc)[2][2][4][2], const Unit& u, int wr, int wc, int fr, int fq) const {
        const int row0 = u.pm * BM + wr * 64 + fr, col0 = u.pn * BM + wc * 32 + 8 * fq;
#pragma unroll
        for (int ai = 0; ai < 2; ++ai)
#pragma unroll
            for (int m = 0; m < 4; ++m) {
                bf16_t* rowp = O + (size_t)(row0 + ai * HALF + m * 16) * ldc + col0;
#pragma unroll
                for (int bj = 0; bj < 2; ++bj) { const f32x4 v0 = acc[ai][bj][m][0], v1 = acc[ai][bj][m][1];
                    u32x4 w; w.x = cvt_pk_bf16(v0[0], v0[1]); w.y = cvt_pk_bf16(v0[2], v0[3]); w.z = cvt_pk_bf16(v1[0], v1[1]); w.w = cvt_pk_bf16(v1[2], v1[3]);
                    *(u32x4*)(rowp + bj * HALF) = w; }
            }
    }
};
struct EpiRes {
    static constexpr bool PERM = false, AFTER_DRAIN = false;
    float* X; const float* Xr; float* PART; const float* gate; const float* stats; const float* lg; const float* lb; float scale; int ntf;
    __device__ __forceinline__ void operator()(const f32x4 (&acc)[2][2][4][2], const Unit& u, int wr, int wc, int fr, int fq) const {
        const int col0 = u.pn * BM + wc * 32 + 4 * fq;
        if (u.nt == ntf) {
            const float* gp = gate + (size_t)(u.pm >> 3) * 9216 + col0;
            f32x4 gs[2][2], g4[2][2], b4[2][2];
#pragma unroll
            for (int bj = 0; bj < 2; ++bj)
#pragma unroll
                for (int n = 0; n < 2; ++n) { const int cc = bj * HALF + n * 16;
                    gs[bj][n] = *(const f32x4*)(gp + cc) * scale + scale; g4[bj][n] = *(const f32x4*)(lg + col0 + cc); b4[bj][n] = *(const f32x4*)(lb + col0 + cc) * 1.41421356237f; }
#pragma unroll
            for (int ai = 0; ai < 2; ++ai)
#pragma unroll
                for (int m = 0; m < 4; ++m) {
                    const int r = u.pm * BM + ai * HALF + wr * 64 + m * 16 + fr;
                    const f32x2 st = *(const f32x2*)(stats + 2 * (size_t)r); const float mean = st.x, rs = st.y * 1.41421356237f;
                    const float* yr = Xr + (size_t)r * 1024 + col0; float* xo = X + (size_t)r * 1024 + col0;
                    f32x4 y[2][2];
#pragma unroll
                    for (int bj = 0; bj < 2; ++bj)
#pragma unroll
                        for (int n = 0; n < 2; ++n) y[bj][n] = *(const f32x4*)(yr + bj * HALF + n * 16);
#pragma unroll
                    for (int bj = 0; bj < 2; ++bj)
#pragma unroll
                        for (int n = 0; n < 2; ++n)
                            *(f32x4*)(xo + bj * HALF + n * 16) = gs[bj][n] * acc[ai][bj][m][n] + ((y[bj][n] - mean) * rs * g4[bj][n] + b4[bj][n]);
                    asm volatile("" ::: "memory");
                }
            return;
        }
        float* pbase = PART + (size_t)(u.k0 / SplitOrder::PK) * (512 * 1024);
#pragma unroll
        for (int ai = 0; ai < 2; ++ai)
#pragma unroll
            for (int m = 0; m < 4; ++m) {
                const int r = u.pm * BM + ai * HALF + wr * 64 + m * 16 + fr - 16384;
                const float* gp = gate + (size_t)(8 + (r >> 2)) * 9216 + col0;
                float* xo = pbase + (size_t)r * 1024 + col0;
#pragma unroll
                for (int bj = 0; bj < 2; ++bj)
#pragma unroll
                    for (int n = 0; n < 2; ++n) { const int cc = bj * HALF + n * 16;
                        *(f32x4*)(xo + cc) = (*(const f32x4*)(gp + cc) * scale + scale) * acc[ai][bj][m][n]; }
                asm volatile("" ::: "memory");
            }
    }
};
struct EpiMod {
    static constexpr bool PERM = false, AFTER_DRAIN = false;
    float* MODp; const float* ada_b;
    __device__ __forceinline__ void operator()(const f32x4 (&acc)[2][2][4][2], const Unit& u, int wr, int wc, int fr, int fq) const {
        const int col0 = u.pn * BM + wc * 32 + 4 * fq;
        const int l = (u.pn * BM) / 9216;
#pragma unroll
        for (int ai = 0; ai < 2; ++ai)
#pragma unroll
            for (int m = 0; m < 4; ++m) {
                const int r = u.pm * BM + ai * HALF + wr * 64 + m * 16 + fr;
                if (r < 136) {
#pragma unroll
                    for (int bj = 0; bj < 2; ++bj)
#pragma unroll
                        for (int n = 0; n < 2; ++n) {
                            const int c = col0 + bj * HALF + n * 16;
                            const f32x4 o = acc[ai][bj][m][n] + *(const f32x4*)(ada_b + c);
                            *(f32x4*)(MODp + (size_t)(l * 136 + r) * 9216 + (c - l * 9216)) = o;
                        }
                }
            }
    }
};
}

__device__ __forceinline__ void transpose_item(const float* W, int K, int N, bf16* WT, int dest_row0, LAS float* scr, int k0, int n0, int lane) {
    const int nn = n0 + (lane & 31); const bool ok = nn < N;
    float tv[32];
#pragma unroll
    for (int i = 0; i < 32; ++i) { const int kk = 2 * i + (lane >> 5); tv[i] = ok ? W[(size_t)(k0 + kk) * N + nn] : 0.f; }
#pragma unroll
    for (int i = 0; i < 32; ++i) { const int kk = 2 * i + (lane >> 5); scr[kk * 33 + (lane & 31)] = tv[i]; }
    LDS_WAIT();
    const int c = lane & 7;
#pragma unroll
    for (int j = 0; j < 4; ++j) { const int n = (lane >> 3) + 8 * j; const LAS float* s = scr + (8 * c) * 33 + n;
        v4u o; o.x = pk2(s[0 * 33], s[1 * 33]); o.y = pk2(s[2 * 33], s[3 * 33]); o.z = pk2(s[4 * 33], s[5 * 33]); o.w = pk2(s[6 * 33], s[7 * 33]);
        *(v4u*)(WT + (size_t)(dest_row0 + n) * K + k0 + 8 * c) = o; }
    LDS_WAIT();
}

constexpr int I_WI = 16 * 176, I_WO = 44 * 32, I_WIN = 16 * 121, I_WOUT = 16 * 32, I_ADA = 16 * 288;
constexpr int I_MAIN = 2 * I_WI + 2 * I_WO + I_WIN + I_WOUT, I_LAYER = I_MAIN + I_ADA;
__device__ __forceinline__ void convert_item(const Args& args, unsigned char* ws, int l, int r, LAS float* scr, int lane) {
    unsigned char* wl = ws + WS_W + (size_t)l * W_LAYER;
    if (r < 2 * (I_WI + I_WO)) {
        const int f = r / (I_WI + I_WO); r -= f * (I_WI + I_WO);
        if (r < I_WI) {
            const int kb = r / 176, nb = r % 176, n0 = nb * 32;
            const int half = n0 / DFF, j = n0 - half * DFF, t = j >> 7, jj = j & 127;
            transpose_item((f ? args.in[15] : args.in[13]) + (size_t)l * D * NWI, D, NWI, (bf16*)(wl + (f ? W_WI2 : W_WI1)), 256 * t + 128 * half + jj, scr, kb * 64, n0, lane);
        } else { r -= I_WI;
            const int kb = r / 32, nb = r % 32;
            transpose_item((f ? args.in[16] : args.in[14]) + (size_t)l * DFF * D, DFF, D, (bf16*)(wl + (f ? W_WO2 : W_WO1)), nb * 32, scr, kb * 64, nb * 32, lane);
        }
        return;
    }
    r -= 2 * (I_WI + I_WO);
    if (r < I_WIN) { const int kb = r / 121, nb = r % 121;
        transpose_item(args.in[17] + (size_t)l * D * NIN, D, NIN, (bf16*)(wl + W_WIN), nb * 32, scr, kb * 64, nb * 32, lane); return; }
    r -= I_WIN;
    if (r < I_WOUT) { const int kb = r / 32, nb = r % 32;
        transpose_item(args.in[27] + (size_t)l * D * D, D, D, (bf16*)(wl + W_WOUT), nb * 32, scr, kb * 64, nb * 32, lane); return; }
    r -= I_WOUT;
    { const int kb = r / 288, nb = r % 288;
        transpose_item(args.in[9] + (size_t)l * D * NMODC, D, NMODC, (bf16*)(ws + WS_BIG), l * NMODC + nb * 32, scr, kb * 64, nb * 32, lane); }
}

__device__ __forceinline__ void p0_prologue(const Args& args, LAS unsigned char* lds_) {
    const Ctx C = make_ctx(args, lds_);
    LAS float* scr = (LAS float*)(C.lds + C.wave * 16384);
    for (int it = C.gw; it < 2 * I_ADA; it += C.NGW) convert_item(args, C.ws, it / I_ADA, I_MAIN + it % I_ADA, scr, C.lane);
    const int gt = C.gw * 64 + C.lane, NGT = C.NGW * 64;
    for (int i = gt; i < 2 * 224 * 128; i += NGT) { const int l = i / (224 * 128), rr = (i / 128) % 224, ch = i & 127;
        *(v4u*)(C.ws + WS_W + (size_t)l * W_LAYER + W_WIN + ((size_t)(3872 + rr) * 1024 + ch * 8) * 2) = (v4u){0u, 0u, 0u, 0u}; }
    for (int i = gt; i < 2048; i += NGT) ((float*)(C.ws + WS_ID))[i] = i < 1024 ? 1.0f : 0.f;
    for (int i = gt; i < 256 * 256; i += NGT) { const int row = i >> 8, c4 = (i & 255) * 4;
        v2u o = (v2u){0u, 0u};
        if (row < NB) { const float* src = row < BP ? args.in[7] + (size_t)row * D : args.in[8] + (size_t)(row - BP) * D; const f32x4 v = *(const f32x4*)(src + c4);
            o.x = pk2(siluf_(v.x), siluf_(v.y)); o.y = pk2(siluf_(v.z), siluf_(v.w)); }
        *(v2u*)(C.ws + WS_AC + ((size_t)row * D + c4) * 2) = o; }
    for (int i = gt; i < 2052 * 32; i += NGT) { const int p = i >> 5, j = i & 31; const double pos = p < 2048 ? (double)p : (double)(16384 + (p - 2048));
        double inv = 1.0; for (int q = 0; q < j; ++q) inv *= 0.7498942093324559;
        const double ang = pos * inv; const double n = rint(ang * 0.15915494309189535);
        const float rr = (float)((ang - n * 6.283185307179586) - n * 2.4492935982947064e-16);
        ((f32x2*)(C.ws + WS_ROPE))[i] = (f32x2){__cosf(rr), __sinf(rr)}; }
}

__device__ __forceinline__ void p1_convert(const Args& args, LAS unsigned char* lds_) {
    const Ctx C = make_ctx(args, lds_);
    if ((int)blockIdx.x < 72) return;
    LAS float* scr = (LAS float*)(C.lds + C.wave * 16384);
    constexpr int I_F0 = I_WI + I_WO, I_P0 = I_F0 + I_WIN;
    for (int it = ((int)blockIdx.x - 72) * NWAVES + C.wave; it < I_P0; it += 184 * NWAVES) {
        if (it < I_F0) convert_item(args, C.ws, 0, it, scr, C.lane);
        else convert_item(args, C.ws, 0, 2 * I_F0 + (it - I_F0), scr, C.lane);
    }
}

__device__ __forceinline__ void p2_modulate0(const Args& args, LAS unsigned char* lds_) {
    const Ctx C = make_ctx(args, lds_);
    const float* MOD = (const float*)(C.ws + WS_MOD); bf16* H = (bf16*)(C.ws + WS_H);
    auto rowp = [&](int r) { return r < MP ? args.in[0] + (size_t)r * D : args.in[1] + (size_t)(r - MP) * D; };
    f32x4 nx[4], nsh[4], nsc[4];
    auto ld = [&](int r) { const float* xr = rowp(r); const float* modr = MOD + (size_t)batch_of_row(r) * NMODC;
#pragma unroll
        for (int j = 0; j < 4; ++j) { const int c = (C.lane + 64 * j) * 4; nx[j] = *(const f32x4*)(xr + c); nsh[j] = *(const f32x4*)(modr + c); nsc[j] = *(const f32x4*)(modr + 1024 + c); } };
    if (C.gw < M) ld(C.gw);
#pragma unroll 1
    for (int r = C.gw; r < M; r += C.NGW) {
        f32x4 v[4], sh[4], sc[4];
#pragma unroll
        for (int j = 0; j < 4; ++j) { v[j] = nx[j]; sh[j] = nsh[j]; sc[j] = nsc[j]; }
        if (r + C.NGW < M) ld(r + C.NGW);
        if (C.lane == 0) *(f32x2*)((float*)(C.ws + WS_STATS) + 2 * (size_t)r) = (f32x2){0.f, 1.0f};
#pragma unroll
        for (int j = 0; j < 4; ++j) { const int c = (C.lane + 64 * j) * 4;
            const f32x4 h = v[j] * (sc[j] + 1.0f) + sh[j];
            if (r >= MP) *(f32x4*)(C.out + (size_t)r * D + c) = v[j] * ALPHA;
            *(v2u*)(H + (size_t)r * D + c) = (v2u){pk2(h.x, h.y), pk2(h.z, h.w)}; }
    }
}

__device__ __forceinline__ void ln_phase(const Args& args, LAS unsigned char* lds_, int l, int which, bool write_h, int hl, int shc, int npart, float xscale, bool write_x) {
    const Ctx C = make_ctx(args, lds_);
    const float* MOD = (const float*)(C.ws + WS_MOD); bf16* H = (bf16*)(C.ws + WS_H);
    const float* g = args.in[11] + (size_t)(l * 3 + which) * D; const float* b = args.in[12] + (size_t)(l * 3 + which) * D;
    f32x4 nv[4], gg[4], bb[4];
#pragma unroll
    for (int j = 0; j < 4; ++j) { gg[j] = *(const f32x4*)(g + (C.lane + 64 * j) * 4); bb[j] = *(const f32x4*)(b + (C.lane + 64 * j) * 4); }
    f32x4 nw[4];
    if (C.gw < M) {
#pragma unroll
        for (int j = 0; j < 4; ++j) nv[j] = *(const f32x4*)(C.out + (size_t)C.gw * D + (C.lane + 64 * j) * 4); }
    if (C.gw + C.NGW < M) {
#pragma unroll
        for (int j = 0; j < 4; ++j) nw[j] = *(const f32x4*)(C.out + (size_t)(C.gw + C.NGW) * D + (C.lane + 64 * j) * 4); }
#pragma unroll 1
    for (int r = C.gw; r < M; r += C.NGW) {
        float* xr = C.out + (size_t)r * D;
        f32x4 v[4]; float s = 0.f;
        const float* modr = MOD + (size_t)(hl * NB + batch_of_row(r)) * NMODC + shc * 1024;
        f32x4 msh[4], msc[4];
        if (write_h) {
#pragma unroll
            for (int j = 0; j < 4; ++j) { msh[j] = *(const f32x4*)(modr + (C.lane + 64 * j) * 4); msc[j] = *(const f32x4*)(modr + 1024 + (C.lane + 64 * j) * 4); } }
#pragma unroll
        for (int j = 0; j < 4; ++j) { v[j] = nv[j]; nv[j] = nw[j]; }
        if (r + 2 * C.NGW < M) {
#pragma unroll
            for (int j = 0; j < 4; ++j) nw[j] = *(const f32x4*)(xr + (size_t)(2 * C.NGW) * D + (C.lane + 64 * j) * 4); }
        if (r >= MP) { const float* pp = (const float*)(C.ws + WS_SB) + (size_t)(r - MP) * D;
#pragma unroll 1
            for (int p = 0; p < npart; ++p, pp += 512 * 1024) {
#pragma unroll
                for (int j = 0; j < 4; ++j) v[j] += *(const f32x4*)(pp + (C.lane + 64 * j) * 4); } }
#pragma unroll
        for (int j = 0; j < 4; ++j) s += (v[j].x + v[j].y) + (v[j].z + v[j].w);
        const float mean = wave_sum2(s) * (1.f / D); float s2 = 0.f;
#pragma unroll
        for (int j = 0; j < 4; ++j) { v[j] = v[j] - mean; s2 += (v[j].x * v[j].x + v[j].y * v[j].y) + (v[j].z * v[j].z + v[j].w * v[j].w); }
        const float rstd = rsqrtf(wave_sum2(s2) * (1.f / D) + LN_EPS);
        if (C.lane == 0) *(f32x2*)((float*)(C.ws + WS_STATS) + 2 * (size_t)r) = (f32x2){mean, rstd};
#pragma unroll
        for (int j = 0; j < 4; ++j) { const int c = (C.lane + 64 * j) * 4;
            const f32x4 xn = v[j] * rstd * gg[j] + bb[j];
            if (write_x || r >= MP) *(f32x4*)(xr + c) = xn * xscale;
            if (write_h) { const f32x4 sh = msh[j], sc = msc[j]; const f32x4 h = xn * (sc + 1.0f) + sh;
                *(v2u*)(H + (size_t)r * D + c) = (v2u){pk2(h.x, h.y), pk2(h.z, h.w)}; }
        }
    }
}

struct PrepRaw { v2u rq, rqp, rk, rkp, hf, hq, dq, dk, dv; unsigned aq; unsigned short db, da; v4u alr0, alr1; f32x4 cs0, cs1; };
__device__ __forceinline__ void prep_load(PrepRaw& x, const bf16* P, int lane, const f32x2* rope_row) {
    const int c = lane * 4;
    const f32x4* cp = (const f32x4*)(rope_row + (c & 31)); x.cs0 = cp[0]; x.cs1 = cp[1];
    x.rq = *(const v2u*)(P + C_RQ + c); x.rqp = *(const v2u*)(P + C_RQ + (c ^ 32)); x.rk = *(const v2u*)(P + C_RK + c); x.rkp = *(const v2u*)(P + C_RK + (c ^ 32));
    x.alr0 = *(const v4u*)(P + C_ALR); x.alr1 = *(const v4u*)(P + C_ALR + 8);
    x.aq = *(const unsigned*)(P + C_AQ + lane * 2);
    x.hf = *(const v2u*)(P + C_HF + c); x.hq = *(const v2u*)(P + C_HQ + c);
    x.dq = *(const v2u*)(P + C_DQKV + c); x.dk = *(const v2u*)(P + C_DQKV + 256 + c); x.dv = *(const v2u*)(P + C_DQKV + 512 + c);
    x.db = P[C_DB + (lane & 3)]; x.da = P[C_DA + (lane & 3)];
}
__device__ __forceinline__ void unpack4(const v2u w, float (&o)[4]) { o[0] = bflo(w.x); o[1] = bfhi(w.x); o[2] = bflo(w.y); o[3] = bfhi(w.y); }

__device__ __forceinline__ void prep_phase(const Args& args, LAS unsigned char* lds_, int l) {
    const Ctx C = make_ctx(args, lds_);
    const bf16* PROJ = (const bf16*)(C.ws + WS_BIG); bf16* SB = (bf16*)(C.ws + WS_SB); float* SF = (float*)(C.ws + WS_SF);
    const f32x2* ROPE = (const f32x2*)(C.ws + WS_ROPE);
    const int lane = C.lane, c4 = lane * 4;
    const float* wg = args.in[18] + (size_t)l * 16 * 128; const float* bg = args.in[19] + (size_t)l * 128;
    const float* cw = args.in[21] + (size_t)l * 4 * 768;
    LAS float* lwg = (LAS float*)C.lds; LAS float* lcw = lwg + 16 * 128;
    for (int i = C.tid; i < 16 * 128; i += NWAVES * 64) lwg[i] = wg[i];
    for (int i = C.tid; i < 4 * 768; i += NWAVES * 64) lcw[i] = cw[i];
    __syncthreads();
    constexpr int CH = 9;
    const int r0 = C.gw * CH, r1 = min(r0 + CH, M);
    if (r0 >= M) return;
    float lbv[4];
#pragma unroll
    for (int i = 0; i < 4; ++i) { lbv[i] = 0.f; if (l == 1) lbv[i] = 1.0f / (1.0f + expf(args.in[20][c4 + i] - args.in[20][256 + c4 + i])); }
    const float a_neg = -expf(args.in[22][l * 4 + (lane & 3)]), dtb = args.in[23][l * 4 + (lane & 3)];
    const float bg0 = bg[lane * 2], bg1 = bg[lane * 2 + 1];
    float w1[3][4], w2[3][4], w3[3][4];
    auto load_window = [&](int r) {
        const bool isp = r < MP; const int rs = r - MP; const int b = isp ? (r >> 11) : (rs >> 2), t = isp ? (r & 2047) : (rs & 3);
        const float* cst = args.in[6] + ((size_t)(l * BS + b) * 3) * 768;
#pragma unroll
        for (int g = 0; g < 3; ++g) { const int ch = g * 256 + c4; const bf16* Pc = PROJ + (size_t)r * NINP + C_DQKV + ch;
            if (t >= 1) unpack4(*(const v2u*)(Pc - 1 * NINP), w1[g]); else { const f32x4 z = isp ? (f32x4){0.f, 0.f, 0.f, 0.f} : *(const f32x4*)(cst + 2 * 768 + ch); w1[g][0] = z.x; w1[g][1] = z.y; w1[g][2] = z.z; w1[g][3] = z.w; }
            if (t >= 2) unpack4(*(const v2u*)(Pc - 2 * NINP), w2[g]); else { const f32x4 z = isp ? (f32x4){0.f, 0.f, 0.f, 0.f} : *(const f32x4*)(cst + (1 + t) * 768 + ch); w2[g][0] = z.x; w2[g][1] = z.y; w2[g][2] = z.z; w2[g][3] = z.w; }
            if (t >= 3) unpack4(*(const v2u*)(Pc - 3 * NINP), w3[g]); else { const f32x4 z = isp ? (f32x4){0.f, 0.f, 0.f, 0.f} : *(const f32x4*)(cst + t * 768 + ch); w3[g][0] = z.x; w3[g][1] = z.y; w3[g][2] = z.z; w3[g][3] = z.w; } }
    };
    auto rope_of = [&](int r) { return ROPE + (size_t)(r < MP ? (r & 2047) : 2048 + ((r - MP) & 3)) * 32; };
    PrepRaw A; prep_load(A, PROJ + (size_t)r0 * NINP, lane, rope_of(r0));
    load_window(r0);
    const bool hi = (c4 & 32) != 0;
#pragma unroll 1
    for (int r = r0; r < r1; ++r) {
        PrepRaw B = A;
        if (r + 1 < r1) prep_load(B, PROJ + (size_t)(r + 1) * NINP, lane, rope_of(r + 1));
        int zo = 0; asm volatile("" : "+v"(zo));
        const bool isp = r < MP; const int rs = r - MP;
        const int b = isp ? (r >> 11) : (rs >> 2), t = isp ? (r & 2047) : (rs & 3);
        bf16* sb = SB + (size_t)r * SBW; float* sf = SF + (size_t)r * SFW;
        { float q[4], qp[4], k[4], kp[4], qo[4], ko[4]; unpack4(A.rq, q); unpack4(A.rqp, qp); unpack4(A.rk, k); unpack4(A.rkp, kp);
          const float cs[8] = {A.cs0.x, A.cs0.y, A.cs0.z, A.cs0.w, A.cs1.x, A.cs1.y, A.cs1.z, A.cs1.w};
#pragma unroll
          for (int e = 0; e < 4; ++e) { const float co = cs[2 * e], si = cs[2 * e + 1];
              qo[e] = hi ? (qp[e] * si + q[e] * co) : (q[e] * co - qp[e] * si);
              ko[e] = (hi ? (kp[e] * si + k[e] * co) : (k[e] * co - kp[e] * si)) * 0.125f; }
          *(v2u*)(sb + SB_RQ + c4) = (v2u){pk2(qo[0], qo[1]), pk2(qo[2], qo[3])};
          *(v2u*)(sb + SB_RK + c4) = (v2u){pk2(ko[0], ko[1]), pk2(ko[2], ko[3])}; }
        { const unsigned aw[8] = {A.alr0.x, A.alr0.y, A.alr0.z, A.alr0.w, A.alr1.x, A.alr1.y, A.alr1.z, A.alr1.w};
          float x0 = bg0, x1 = bg1;
#pragma unroll
          for (int i = 0; i < 8; ++i) { const float a0 = bflo(aw[i]), a1 = bfhi(aw[i]);
              const f32x2 wa = *(const LAS f32x2*)(lwg + (2 * i) * 128 + lane * 2 + zo), wb = *(const LAS f32x2*)(lwg + (2 * i + 1) * 128 + lane * 2 + zo);
              x0 += a0 * wa.x + a1 * wb.x; x1 += a0 * wa.y + a1 * wb.y; }
          const float sp0 = fmaxf(-x0, 0.f) + __logf(1.0f + __expf(-fabsf(x0))), sp1 = fmaxf(-x1, 0.f) + __logf(1.0f + __expf(-fabsf(x1)));
          *(f32x2*)(sf + SF_ADEC + lane * 2) = (f32x2){__expf(-sp0 * (1.0f / 16.0f)), __expf(-sp1 * (1.0f / 16.0f))};
          *(unsigned*)(sb + SB_AQ + lane * 2) = pk2(bflo(A.aq) * 0.17677669529663687f, bfhi(A.aq) * 0.17677669529663687f); }
        { float zf[4], zq[4], fo[4], qo[4]; unpack4(A.hf, zf); unpack4(A.hq, zq);
#pragma unroll
          for (int e = 0; e < 4; ++e) { fo[e] = lbv[e] + (1.0f - lbv[e]) * sigmoidf_(zf[e]); qo[e] = siluf_(zq[e]) * 0.125f; }
          *(f32x4*)(sf + SF_HF + c4) = (f32x4){fo[0], fo[1], fo[2], fo[3]};
          *(v2u*)(sb + SB_HQ + c4) = (v2u){pk2(qo[0], qo[1]), pk2(qo[2], qo[3])}; }
        { float* cso = isp ? C.out + O_PCONV + ((size_t)(l * BP + b) * 3) * 768 : C.out + O_SCONV + ((size_t)(l * BS + b) * 3) * 768;
          const int so = isp ? t - (TP - 3) : t - 1;
          float uu[3][4];
#pragma unroll
          for (int g = 0; g < 3; ++g) { float x0[4]; unpack4(g == 0 ? A.dq : g == 1 ? A.dk : A.dv, x0);
              const LAS float* cwc = lcw + g * 256 + c4 + zo;
              const f32x4 k0 = *(const LAS f32x4*)(cwc), k1 = *(const LAS f32x4*)(cwc + 768), k2 = *(const LAS f32x4*)(cwc + 2 * 768), k3 = *(const LAS f32x4*)(cwc + 3 * 768);
#pragma unroll
              for (int e = 0; e < 4; ++e) { uu[g][e] = siluf_(x0[e] * k3[e] + w1[g][e] * k2[e] + w2[g][e] * k1[e] + w3[g][e] * k0[e]);
                  w3[g][e] = w2[g][e]; w2[g][e] = w1[g][e]; w1[g][e] = x0[e]; }
              if (so >= 0) *(f32x4*)(cso + so * 768 + g * 256 + c4) = (f32x4){x0[0], x0[1], x0[2], x0[3]}; }
          const float qn = row16_sum(uu[0][0] * uu[0][0] + uu[0][1] * uu[0][1] + uu[0][2] * uu[0][2] + uu[0][3] * uu[0][3]);
          const float kn = row16_sum(uu[1][0] * uu[1][0] + uu[1][1] * uu[1][1] + uu[1][2] * uu[1][2] + uu[1][3] * uu[1][3]);
          const float qs = rsqrtf(qn + RMS_EPS) * 0.125f, ks = rsqrtf(kn + RMS_EPS);
          const unsigned q01 = pk2(uu[0][0] * qs, uu[0][1] * qs), q23 = pk2(uu[0][2] * qs, uu[0][3] * qs), k01 = pk2(uu[1][0] * ks, uu[1][1] * ks), k23 = pk2(uu[1][2] * ks, uu[1][3] * ks);
          *(v2u*)(sb + SB_DQ + c4) = (v2u){q01, q23}; *(v2u*)(sb + SB_DK + c4) = (v2u){k01, k23};
          *(v2u*)(sb + SB_DV + c4) = (v2u){pk2(uu[2][0], uu[2][1]), pk2(uu[2][2], uu[2][3])};
          const float qk = row16_sum(bflo(q01) * bflo(k01) + bfhi(q01) * bfhi(k01) + bflo(q23) * bflo(k23) + bfhi(q23) * bfhi(k23));
          if ((lane & 15) == 0) sf[SF_QK + (lane >> 4)] = qk;
          if (lane < 4) { sf[SF_BETA + lane] = sigmoidf_(bf2f(A.db));
              const float xx = bf2f(A.da) + dtb; const float sp = fmaxf(xx, 0.f) + __logf(1.0f + __expf(-fabsf(xx)));
              sf[SF_DDEC + lane] = __expf(a_neg * sp); } }
        A = B;
        if (r + 1 < r1) { const int rn = r + 1; const bool ns = rn < MP ? ((rn & 2047) == 0) : (((rn - MP) & 3) == 0); if (ns) load_window(rn); }
    }
}

template <int KIND, int DH, int R> struct Raw { unsigned q[DH / 2]; unsigned k[DH / 2]; unsigned v[(R + 1) / 2]; float f[DH]; float be, de; };

template <int KIND, int DH, int R>
__device__ __forceinline__ void load_tok(Raw<KIND, DH, R>& x, const bf16* qp, const bf16* kp, const bf16* vp, const float* fp) {
    if constexpr (DH == 4) { const v2u w = *(const v2u*)qp; x.q[0] = w.x; x.q[1] = w.y; } else { x.q[0] = *(const unsigned*)qp; }
    if constexpr (KIND != 2) { if constexpr (DH == 4) { const v2u w = *(const v2u*)kp; x.k[0] = w.x; x.k[1] = w.y; } else { x.k[0] = *(const unsigned*)kp; } }
    if constexpr (R == 1) x.v[0] = *vp; else if constexpr (R == 2) x.v[0] = *(const unsigned*)vp; else { const v2u w = *(const v2u*)vp; x.v[0] = w.x; x.v[1] = w.y; }
    if constexpr (KIND == 1) { const f32x2 w = *(const f32x2*)fp; x.f[0] = w.x; x.f[1] = w.y; }
    if constexpr (KIND == 2) { const f32x4 w = *(const f32x4*)fp; x.f[0] = w.x; x.f[1] = w.y; x.f[2] = w.z; x.f[3] = w.w; }
    if constexpr (KIND == 3) { x.be = fp[0]; x.de = fp[4]; }
}

template <int KIND, int DH, int R>
__device__ __forceinline__ void scan_task(const Ctx& C, int row0, int T, int h, int slice, const float* sin, float* sout) {
    const bf16* PROJ = (const bf16*)(C.ws + WS_BIG); const bf16* SB = (const bf16*)(C.ws + WS_SB); const float* SF = (const float*)(C.ws + WS_SF);
    bf16* H = (bf16*)(C.ws + WS_H);
    const int lane = C.lane, dl = lane & 15, rw = lane >> 4;
    const int d0 = dl * DH, v0 = slice * (4 * R) + rw * R;
    constexpr int DK = 16 * DH;
    const bf16 *qp, *kp, *vp; const float* fp; int ks, vs;
    const bf16* sbr = SB + (size_t)row0 * SBW; const bf16* pr = PROJ + (size_t)row0 * NINP; const float* sfr = SF + (size_t)row0 * SFW;
    if constexpr (KIND == 0) { qp = sbr + SB_RQ + h * 64 + d0; kp = sbr + SB_RK + h * 64 + d0; ks = SBW; vp = pr + C_RV + h * 64 + v0; vs = NINP; fp = sfr; }
    if constexpr (KIND == 1) { qp = sbr + SB_AQ + h * 32 + d0; kp = pr + C_AK + h * 32 + d0; ks = NINP; vp = pr + C_AV + h * 64 + v0; vs = NINP; fp = sfr + SF_ADEC + h * 32 + d0; }
    if constexpr (KIND == 2) { qp = sbr + SB_HQ + h * 64 + d0; kp = sbr; ks = SBW; vp = pr + C_HI + h * 64 + v0; vs = NINP; fp = sfr + SF_HF + h * 64 + d0; }
    if constexpr (KIND == 3) { qp = sbr + SB_DQ + h * 64 + d0; kp = sbr + SB_DK + h * 64 + d0; ks = SBW; vp = sbr + SB_DV + h * 64 + v0; vs = SBW; fp = sfr + SF_BETA + h; }
    bf16* op = H + (size_t)row0 * D + KIND * 256 + h * 64 + v0;
    const float rdec = 1.0f - exp2f(-5.0f - (float)h);

    float S[DH][R];
#pragma unroll
    for (int dh = 0; dh < DH; ++dh)
#pragma unroll
        for (int vv = 0; vv < R; ++vv) S[dh][vv] = sin ? sin[(size_t)(d0 + dh) * 64 + v0 + vv] : 0.f;

    typedef Raw<KIND, DH, R> RawT;
    RawT A[4];
#pragma unroll
    for (int u = 0; u < 4; ++u) load_tok<KIND, DH, R>(A[u], qp + (size_t)u * SBW, kp + (size_t)u * ks, vp + (size_t)u * vs, fp + (size_t)u * SFW);
    for (int t0 = 0; t0 < T; t0 += 4) {
        RawT B[4];
        const bool more = t0 + 4 < T;
#pragma unroll
        for (int u = 0; u < 4; ++u) { B[u] = A[u]; }
        if (more) {
#pragma unroll
            for (int u = 0; u < 4; ++u) load_tok<KIND, DH, R>(B[u], qp + (size_t)(t0 + 4 + u) * SBW, kp + (size_t)(t0 + 4 + u) * ks, vp + (size_t)(t0 + 4 + u) * vs, fp + (size_t)(t0 + 4 + u) * SFW);
        }
#pragma unroll
        for (int u = 0; u < 4; ++u) {
            const RawT& x = A[u];
            float q[DH], k[DH], v[R];
            q[0] = bflo(x.q[0]); q[1] = bfhi(x.q[0]); if constexpr (DH == 4) { q[2] = bflo(x.q[1]); q[3] = bfhi(x.q[1]); }
            if constexpr (KIND != 2) { k[0] = bflo(x.k[0]); k[1] = bfhi(x.k[0]); if constexpr (DH == 4) { k[2] = bflo(x.k[1]); k[3] = bfhi(x.k[1]); } }
            if constexpr (R == 1) v[0] = bflo(x.v[0]);
            if constexpr (R >= 2) { v[0] = bflo(x.v[0]); v[1] = bfhi(x.v[0]); }
            if constexpr (R == 4) { v[2] = bflo(x.v[1]); v[3] = bfhi(x.v[1]); }
            float o[R];
            if constexpr (KIND == 3) {
                float ks_[R];
#pragma unroll
                for (int vv = 0; vv < R; ++vv) { float p = 0.f;
#pragma unroll
                    for (int dh = 0; dh < DH; ++dh) { S[dh][vv] *= x.de; p += k[dh] * S[dh][vv]; }
                    ks_[vv] = row16_sum(p); }
#pragma unroll
                for (int vv = 0; vv < R; ++vv) { const float uu = x.be * (v[vv] - ks_[vv]); float p = 0.f;
#pragma unroll
                    for (int dh = 0; dh < DH; ++dh) { S[dh][vv] += k[dh] * uu; p += q[dh] * S[dh][vv]; }
                    o[vv] = row16_sum(p); }
            } else {
#pragma unroll
                for (int dh = 0; dh < DH; ++dh) {
                    float dec, kk;
                    if constexpr (KIND == 0) { dec = rdec; kk = k[dh]; }
                    if constexpr (KIND == 1) { dec = x.f[dh]; kk = k[dh]; }
                    if constexpr (KIND == 2) { dec = x.f[dh]; kk = 1.0f - x.f[dh]; }
#pragma unroll
                    for (int vv = 0; vv < R; ++vv) S[dh][vv] = dec * S[dh][vv] + kk * v[vv];
                }
#pragma unroll
                for (int vv = 0; vv < R; ++vv) { float p = 0.f;
#pragma unroll
                    for (int dh = 0; dh < DH; ++dh) p += q[dh] * S[dh][vv];
                    o[vv] = row16_sum(p); }
            }
            if (dl == 0) {
                bf16* o_ = op + (size_t)(t0 + u) * D;
                if constexpr (R == 1) *o_ = (bf16)(pk2(o[0], 0.f) & 0xffffu);
                if constexpr (R == 2) *(unsigned*)o_ = pk2(o[0], o[1]);
                if constexpr (R == 4) *(v2u*)o_ = (v2u){pk2(o[0], o[1]), pk2(o[2], o[3])};
            }
        }
#pragma unroll
        for (int u = 0; u < 4; ++u) A[u] = B[u];
    }
#pragma unroll
    for (int dh = 0; dh < DH; ++dh)
#pragma unroll
        for (int vv = 0; vv < R; ++vv) sout[(size_t)(d0 + dh) * 64 + v0 + vv] = S[dh][vv];
    (void)DK;
}

template <int KIND, int DH, int R>
__device__ __forceinline__ void scan_long(const Ctx& C, LAS float* wl, int row0, int T, int h, int slice, float* sout) {
    constexpr int CT = 16, LR = 8, DK = LR * DH, NV = (64 / LR) * R, UNR = 8;
    constexpr bool HASK = true, GK = (KIND != 2), HASF = (KIND == 1 || KIND == 2), HASB = (KIND == 3);
    constexpr int OQ = 0, OK_ = OQ + CT * DK, OF = OK_ + (HASK ? CT * DK : 0), OV = OF + (HASF ? CT * DK : 0), OB = OV + CT * NV, BUF = OB + (HASB ? CT * 4 : 0);
    const bf16* PROJ = (const bf16*)(C.ws + WS_BIG); const bf16* SB = (const bf16*)(C.ws + WS_SB); const float* SF = (const float*)(C.ws + WS_SF);
    bf16* H = (bf16*)(C.ws + WS_H);
    const int lane = C.lane, dl = lane & (LR - 1), rw = lane / LR;
    const int d0 = dl * DH;
    const int stok = lane >> 2, spart = lane & 3;
    const GAS bf16 *qg, *kg, *vg; const GAS float *fg, *bg; int ks, vs;
    {
        const GAS bf16* sbr = (const GAS bf16*)(SB + (size_t)row0 * SBW); const GAS bf16* pr = (const GAS bf16*)(PROJ + (size_t)row0 * NINP); const GAS float* sfr = (const GAS float*)(SF + (size_t)row0 * SFW);
        const int vcol = slice * NV;
        if constexpr (KIND == 0) { qg = sbr + SB_RQ + h * 64; kg = sbr + SB_RK + h * 64; ks = SBW; vg = pr + C_RV + h * 64 + vcol; vs = NINP; fg = sfr; bg = sfr; }
        if constexpr (KIND == 1) { qg = sbr + SB_AQ + h * 32; kg = pr + C_AK + h * 32; ks = NINP; vg = pr + C_AV + h * 64 + vcol; vs = NINP; fg = sfr + SF_ADEC + h * 32; bg = sfr; }
        if constexpr (KIND == 2) { qg = sbr + SB_HQ + h * 64; kg = sbr; ks = SBW; vg = pr + C_HI + h * 64 + vcol; vs = NINP; fg = sfr + SF_HF + h * 64; bg = sfr; }
        if constexpr (KIND == 3) { qg = sbr + SB_DQ + h * 64; kg = sbr + SB_DK + h * 64; ks = SBW; vg = sbr + SB_DV + h * 64 + vcol; vs = SBW; fg = sfr; bg = sfr + SF_BETA + h; }
    }
    constexpr int QP = DK / 4;
    qg += (size_t)stok * SBW + spart * QP; kg += (size_t)stok * ks + spart * QP; fg += (size_t)stok * SFW + spart * QP;
    vg += (size_t)(lane & 15) * vs; bg += (size_t)(lane & 15) * SFW;
    GAS bf16* op = (GAS bf16*)(H + (size_t)row0 * D + KIND * 256 + h * 64 + slice * NV + rw * R);
    const float rdec = 1.0f - exp2f(-5.0f - (float)h);

    static_assert(R == 1, "scan_long: one column per lane row");
    f32x2 S2[DH / 2];
#pragma unroll
    for (int i = 0; i < DH / 2; ++i) S2[i] = (f32x2){0.f, 0.f};

    struct SR { v4u rq[QP / 8], rk[QP / 8]; f32x4 rf[QP / 4]; unsigned rv[NV / 2]; float rb0, rb1, rb2; };
    SR s0; s0.rb0 = s0.rb1 = s0.rb2 = 0.f;
    auto stage_load = [&](SR& sr, int c) {
        const size_t t = (size_t)c * CT;
#pragma unroll
        for (int i = 0; i < QP / 8; ++i) { sr.rq[i] = *(const GAS v4u*)(qg + t * SBW + i * 8); if constexpr (GK) sr.rk[i] = *(const GAS v4u*)(kg + t * ks + i * 8); }
        if constexpr (HASF) {
#pragma unroll
            for (int i = 0; i < QP / 4; ++i) sr.rf[i] = *(const GAS f32x4*)(fg + t * SFW + i * 4); }
        if (lane < 16) {
            if constexpr (NV == 4) { const v2u w = *(const GAS v2u*)(vg + t * vs); sr.rv[0] = w.x; sr.rv[1] = w.y; }
            if constexpr (NV == 8) { const v4u w = *(const GAS v4u*)(vg + t * vs); sr.rv[0] = w.x; sr.rv[1] = w.y; sr.rv[2] = w.z; sr.rv[3] = w.w; }
            if constexpr (NV == 16) { const v4u w = *(const GAS v4u*)(vg + t * vs), w2 = *(const GAS v4u*)(vg + t * vs + 8); sr.rv[0] = w.x; sr.rv[1] = w.y; sr.rv[2] = w.z; sr.rv[3] = w.w; sr.rv[4] = w2.x; sr.rv[5] = w2.y; sr.rv[6] = w2.z; sr.rv[7] = w2.w; }
            if constexpr (HASB) { sr.rb0 = bg[t * SFW]; sr.rb1 = bg[t * SFW + 4]; sr.rb2 = bg[t * SFW + 8]; }
        }
    };
    auto stage_write = [&](SR& sr, int b) {
        LAS float* base = wl + b * BUF;
#pragma unroll
        for (int i = 0; i < QP / 8; ++i) {
            LAS float* qd = base + OQ + stok * DK + spart * QP + i * 8;
            *(LAS f32x4*)qd = (f32x4){bflo(sr.rq[i].x), bfhi(sr.rq[i].x), bflo(sr.rq[i].y), bfhi(sr.rq[i].y)}; *(LAS f32x4*)(qd + 4) = (f32x4){bflo(sr.rq[i].z), bfhi(sr.rq[i].z), bflo(sr.rq[i].w), bfhi(sr.rq[i].w)};
            if constexpr (GK) { LAS float* kd = base + OK_ + stok * DK + spart * QP + i * 8;
                *(LAS f32x4*)kd = (f32x4){bflo(sr.rk[i].x), bfhi(sr.rk[i].x), bflo(sr.rk[i].y), bfhi(sr.rk[i].y)}; *(LAS f32x4*)(kd + 4) = (f32x4){bflo(sr.rk[i].z), bfhi(sr.rk[i].z), bflo(sr.rk[i].w), bfhi(sr.rk[i].w)}; }
        }
        if constexpr (HASF) {
#pragma unroll
            for (int i = 0; i < QP / 4; ++i) { *(LAS f32x4*)(base + OF + stok * DK + spart * QP + i * 4) = sr.rf[i];
                if constexpr (KIND == 2) *(LAS f32x4*)(base + OK_ + stok * DK + spart * QP + i * 4) = 1.0f - sr.rf[i]; } }
        if (lane < 16) {
#pragma unroll
            for (int i = 0; i < NV / 2; ++i) { base[OV + lane * NV + 2 * i] = bflo(sr.rv[i]); base[OV + lane * NV + 2 * i + 1] = bfhi(sr.rv[i]); }
            if constexpr (HASB) *(LAS f32x4*)(base + OB + lane * 4) = (f32x4){sr.rb0, sr.rb1, sr.rb2, 0.f};
        }
    };
    static_assert(2 * BUF * 4 <= 26624, "per-wave LDS");
    const int nch = T / CT;
    struct Opnd { f32x2 q2[DH / 2], k2[DH / 2], f2[DH / 2]; float v; f32x4 bd; };
    auto ldop = [&](Opnd& x, const LAS float* bq, const LAS float* bv, const LAS float* bb, int uu) {
#pragma unroll
        for (int i = 0; i < DH / 4; ++i) { const f32x4 w = *(const LAS f32x4*)(bq + OQ + uu * DK + 4 * i); x.q2[2 * i] = (f32x2){w.x, w.y}; x.q2[2 * i + 1] = (f32x2){w.z, w.w}; }
#pragma unroll
        for (int i = 0; i < DH / 4; ++i) { const f32x4 w = *(const LAS f32x4*)(bq + OK_ + uu * DK + 4 * i); x.k2[2 * i] = (f32x2){w.x, w.y}; x.k2[2 * i + 1] = (f32x2){w.z, w.w}; }
        if constexpr (HASF) {
#pragma unroll
            for (int i = 0; i < DH / 4; ++i) { const f32x4 w = *(const LAS f32x4*)(bq + OF + uu * DK + 4 * i); x.f2[2 * i] = (f32x2){w.x, w.y}; x.f2[2 * i + 1] = (f32x2){w.z, w.w}; } }
        x.v = bv[uu * NV];
        if constexpr (HASB) x.bd = *(const LAS f32x4*)(bb + uu * 4);
    };
    auto compute = [&](int c, const LAS float* base) {
#pragma unroll 1
        for (int ub = 0; ub < CT; ub += UNR) {
        float okeep[R];
#pragma unroll
        for (int vv = 0; vv < R; ++vv) okeep[vv] = 0.f;
        Opnd X; X.bd = (f32x4){0.f, 0.f, 0.f, 0.f};
#pragma unroll
        for (int i = 0; i < DH / 2; ++i) X.f2[i] = (f32x2){0.f, 0.f};
        const LAS float* bq = base + ub * DK + d0; const LAS float* bv = base + OV + ub * NV + rw; const LAS float* bb = base + OB + ub * 4;
        ldop(X, bq, bv, bb, 0);
#pragma unroll
        for (int uu_ = 0; uu_ < UNR; ++uu_) { const int u = ub + uu_;
            Opnd Y = X;
            if (uu_ + 1 < UNR) ldop(Y, bq, bv, bb, uu_ + 1);
            f32x2 (&q2)[DH / 2] = X.q2; f32x2 (&k2)[DH / 2] = X.k2; f32x2 (&f2)[DH / 2] = X.f2; const float vv_ = X.v; const f32x4 bd = X.bd;
            float o[1];
            if constexpr (KIND == 3) {
                f32x2 a = k2[0] * S2[0], bq_ = q2[0] * S2[0];
#pragma unroll
                for (int i = 1; i < DH / 2; ++i) { a = __builtin_elementwise_fma(k2[i], S2[i], a); bq_ = __builtin_elementwise_fma(q2[i], S2[i], bq_); }
                const float ks_ = row8_sum(a.x + a.y) * bd.y, qs_ = row8_sum(bq_.x + bq_.y) * bd.y;
                const float uu = bd.x * (vv_ - ks_);
                o[0] = __builtin_fmaf(bd.z, uu, qs_);
                const f32x2 de2 = (f32x2){bd.y, bd.y}, uu2 = (f32x2){uu, uu};
#pragma unroll
                for (int i = 0; i < DH / 2; ++i) S2[i] = __builtin_elementwise_fma(S2[i], de2, k2[i] * uu2);
            } else {
                const f32x2 v2 = (f32x2){vv_, vv_};
#pragma unroll
                for (int i = 0; i < DH / 2; ++i) {
                    f32x2 dec2;
                    if constexpr (KIND == 0) dec2 = (f32x2){rdec, rdec}; else dec2 = f2[i];
                    S2[i] = __builtin_elementwise_fma(S2[i], dec2, k2[i] * v2);
                }
            }
            if constexpr (KIND != 3)
            { f32x2 a = q2[0] * S2[0];
#pragma unroll
              for (int i = 1; i < DH / 2; ++i) a = __builtin_elementwise_fma(q2[i], S2[i], a);
              o[0] = row8_sum(a.x + a.y); }
#pragma unroll
            for (int vv = 0; vv < R; ++vv) okeep[vv] = (dl == uu_) ? o[vv] : okeep[vv];
            X = Y;
        }
        {
            GAS bf16* o_ = op + (size_t)(c * CT + ub + dl) * D;
            if constexpr (R == 1) *o_ = (bf16)(pk2(okeep[0], 0.f) & 0xffffu);
            if constexpr (R == 2) *(GAS unsigned*)o_ = pk2(okeep[0], okeep[1]);
            if constexpr (R == 4) *(GAS v2u*)o_ = (v2u){pk2(okeep[0], okeep[1]), pk2(okeep[2], okeep[3])};
        }
        }
    };
    stage_load(s0, 0); stage_write(s0, 0);
#pragma unroll 1
    for (int c = 0; c < nch; c += 2) {
        stage_load(s0, min(c + 1, nch - 1));
        compute(c, wl);
        stage_write(s0, 1);
        stage_load(s0, min(c + 2, nch - 1));
        compute(c + 1, wl + BUF);
        stage_write(s0, 0);
    }
    const int v0 = slice * NV + rw * R;
#pragma unroll
    for (int i = 0; i < DH / 2; ++i) { sout[(size_t)(d0 + 2 * i) * 64 + v0] = S2[i].x; sout[(size_t)(d0 + 2 * i + 1) * 64 + v0] = S2[i].y; }
}

__device__ __forceinline__ void scan_phase(const Args& args, LAS unsigned char* lds_, int l, int mode = 0) {
    const Ctx C = make_ctx(args, lds_);
    constexpr int NLONG = 1024, NSHORT = BS * 144;
    const int slot = C.wave * 256 + (int)blockIdx.x;
    const int nidle = C.NGW - NLONG - 256;
    for (int it = 0;; ++it) {
        int kind, b, h, slice, row0, T; bool isp;
        if (slot < NLONG) { if (it > 0 || mode == 2) break; isp = true; T = TP;
            const int kk_ = slot >> 8, i = slot & 255; kind = kk_ == 0 ? 3 : (kk_ == 1 ? 0 : (kk_ == 2 ? 2 : 1));
            { const int stream = (i & 7) | ((i >> 6) << 3); slice = (i >> 3) & 7; b = stream >> 2; h = stream & 3; }
            row0 = b * TP;
        } else { if (C.wave < 5) break;
            const int st = (slot - NLONG - 256) + it * nidle; if (st >= NSHORT || mode == 1) break; isp = false; T = TS;
            b = st / 144; int i = st - b * 144;
            if (i < 64) { kind = 3; h = i >> 4; slice = i & 15; }
            else if (i < 96) { i -= 64; kind = 0; h = i >> 3; slice = i & 7; }
            else if (i < 128) { i -= 96; kind = 2; h = i >> 3; slice = i & 7; }
            else { i -= 128; kind = 1; h = i >> 2; slice = i & 3; }
            row0 = MP + b * TS;
        }
        const int nbat = isp ? BP : BS;
        const size_t sidx = (size_t)((l * nbat + b) * 4 + h);
        if (isp) {
            LAS float* wl = (LAS float*)(C.lds + C.wave * 26624);
            if (kind == 0) scan_long<0, 8, 1>(C, wl, row0, T, h, slice, C.out + O_PRET + sidx * 4096);
            else if (kind == 1) scan_long<1, 4, 1>(C, wl, row0, T, h, slice, C.out + O_PGLA + sidx * 2048);
            else if (kind == 2) scan_long<2, 8, 1>(C, wl, row0, T, h, slice, C.out + O_PHG + sidx * 4096);
            else scan_long<3, 8, 1>(C, wl, row0, T, h, slice, C.out + O_PGDN + sidx * 4096);
        } else {
            if (kind == 0) { scan_task<0, 4, 2>(C, row0, T, h, slice, args.in[2] + sidx * 4096, C.out + O_SRET + sidx * 4096); }
            else if (kind == 1) { scan_task<1, 2, 4>(C, row0, T, h, slice, args.in[3] + sidx * 2048, C.out + O_SGLA + sidx * 2048); }
            else if (kind == 2) { scan_task<2, 4, 2>(C, row0, T, h, slice, args.in[4] + sidx * 4096, C.out + O_SHG + sidx * 4096); }
            else { scan_task<3, 4, 1>(C, row0, T, h, slice, args.in[5] + sidx * 4096, C.out + O_SGDN + sidx * 4096); }
        }
    }
    if (l == 0 && C.wave >= 5 && mode != 1) {
        LAS float* scr = (LAS float*)(C.lds + 4 * 26624 + (C.wave - 5) * 8704);
        constexpr int I_F0 = I_WI + I_WO, I_L0B = I_F0 + I_WOUT;
        for (int it = (C.wave - 5) * 256 + (int)blockIdx.x; it < I_L0B + I_MAIN; it += 768) {
            if (it < I_F0) convert_item(args, C.ws, 0, I_F0 + it, scr, C.lane);
            else if (it < I_L0B) convert_item(args, C.ws, 0, 2 * I_F0 + I_WIN + (it - I_F0), scr, C.lane);
            else convert_item(args, C.ws, 1, it - I_L0B, scr, C.lane);
        }
    }
}

__device__ __forceinline__ void post_phase(const Args& args, LAS unsigned char* lds_, int l) {
    const Ctx C = make_ctx(args, lds_);
    const bf16* PROJ = (const bf16*)(C.ws + WS_BIG); bf16* H = (bf16*)(C.ws + WS_H);
    const int lane = C.lane, mixer = lane >> 4, cc = (lane & 15) * 16;
    const int gbase = mixer == 0 ? C_RG : mixer == 1 ? C_AG : mixer == 2 ? C_HG : C_DG;
    const float* nw = mixer == 1 ? args.in[24] + l * 64 : mixer == 2 ? args.in[25] + l * 64 : args.in[26] + l * 64;
    float w[16];
#pragma unroll
    for (int i = 0; i < 16; ++i) w[i] = mixer == 0 ? 1.0f : nw[(cc + i) & 63];
    v4u na0, na1, ng0, ng1;
    if (C.gw < M) { const bf16* hp = H + (size_t)C.gw * D + lane * 16; const bf16* gp = PROJ + (size_t)C.gw * NINP + gbase + cc;
        na0 = *(const v4u*)hp; na1 = *(const v4u*)(hp + 8); ng0 = *(const v4u*)gp; ng1 = *(const v4u*)(gp + 8); }
#pragma unroll 1
    for (int r = C.gw; r < M; r += C.NGW) {
        bf16* hp = H + (size_t)r * D + lane * 16; const bf16* gp = PROJ + (size_t)r * NINP + gbase + cc;
        const v4u a0 = na0, a1 = na1, g0 = ng0, g1 = ng1;
        if (r + C.NGW < M) { const bf16* hn = hp + (size_t)C.NGW * D; const bf16* gn = gp + (size_t)C.NGW * NINP;
            na0 = *(const v4u*)hn; na1 = *(const v4u*)(hn + 8); ng0 = *(const v4u*)gn; ng1 = *(const v4u*)(gn + 8); }
        float y[16], g[16];
        const unsigned aw[8] = {a0.x, a0.y, a0.z, a0.w, a1.x, a1.y, a1.z, a1.w}, gw_[8] = {g0.x, g0.y, g0.z, g0.w, g1.x, g1.y, g1.z, g1.w};
        float ss = 0.f;
#pragma unroll
        for (int i = 0; i < 8; ++i) { y[2 * i] = bflo(aw[i]); y[2 * i + 1] = bfhi(aw[i]); g[2 * i] = bflo(gw_[i]); g[2 * i + 1] = bfhi(gw_[i]); ss += y[2 * i] * y[2 * i] + y[2 * i + 1] * y[2 * i + 1]; }
        ss = quad_sum(ss);
        const float rs = rsqrtf(ss * (1.0f / 64.0f) + RMS_EPS);
        unsigned ow[8];
#pragma unroll
        for (int i = 0; i < 8; ++i) ow[i] = pk2(y[2 * i] * rs * w[2 * i] * siluf_(g[2 * i]), y[2 * i + 1] * rs * w[2 * i + 1] * siluf_(g[2 * i + 1]));
        *(v4u*)hp = (v4u){ow[0], ow[1], ow[2], ow[3]}; *(v4u*)(hp + 8) = (v4u){ow[4], ow[5], ow[6], ow[7]};
    }
}

__global__ void __launch_bounds__(NWAVES * 64, 2) mega_fwd(Args args) {
    extern __shared__ __attribute__((aligned(16))) unsigned char lds[];
    cg::grid_group grid = cg::this_grid();
    LAS unsigned char* const LDSP = (LAS unsigned char*)lds;
    const int G = (int)gridDim.x, bx = (int)blockIdx.x;
    if (threadIdx.x < 64) ((LAS unsigned*)(LDSP + MISC_OFF))[threadIdx.x] = 0u;
    __syncthreads();
    (void)xcd_barrier_post((unsigned*)args.ws, (volatile LAS unsigned*)(LDSP + MISC_OFF));
#define FRESH() float* out_ = fresh_ptr(args.out); unsigned char* ws = fresh_ptr(args.ws); \
    float* MOD = (float*)(ws + WS_MOD); bf16* H = (bf16*)(ws + WS_H); bf16* BIG = (bf16*)(ws + WS_BIG); (void)MOD; (void)H; (void)BIG; (void)out_;

    p0_prologue(args, LDSP);
    if (args.ws == nullptr) grid.sync();
    grid_bar(args, LDSP);
    {
        FRESH();
        pg8::Gemm g{(const bf16*)(ws + WS_AC), BIG, 256, 2 * NMODC, D}; pg8::StaticOrder S; S.init(256, 2 * NMODC, G, bx, D);
        pg8::EpiMod E{MOD, args.in[10]};
        pg8::gemm_phase<pg8::EpiMod, pg8::StaticOrder, PG8_ALIGN, PG8_SP2>(LDSP, g, S, E);
    }
    p1_convert(args, LDSP);
    grid_bar(args, LDSP);
    p2_modulate0(args, LDSP);
    grid_bar(args, LDSP);
#pragma unroll 1
    for (int l = 0; l < 2; ++l) {
#pragma unroll 1
        for (int f = 0; f < 2; ++f) {
            if (f == 1) {
                {
                    FRESH();
                    pg8::Gemm g{H, (const bf16*)(ws + WS_W + (size_t)l * W_LAYER + W_WIN), M, NINP, D}; pg8::StaticOrder S; S.init(M, NINP, G, bx, D);
                    pg8::EpiPlain E{BIG, NINP};
                    pg8::gemm_phase<pg8::EpiPlain, pg8::StaticOrder, PG8_ALIGN, PG8_SP2>(LDSP, g, S, E);
                }
                grid_bar(args, LDSP);
                prep_phase(args, LDSP, l);
                grid_bar(args, LDSP);
                scan_phase(args, LDSP, l);
#ifdef PROBE_SCANMODE
                grid_bar(args, LDSP); scan_phase(args, LDSP, l, PROBE_SCANMODE);
#endif
                grid_bar(args, LDSP);
                post_phase(args, LDSP, l);
                grid_bar(args, LDSP);
                {
                    FRESH();
                    pg8::Gemm g{H, (const bf16*)(ws + WS_W + (size_t)l * W_LAYER + W_WOUT), M, D, D}; pg8::SplitOrder S; S.init(D, G, bx);
                    pg8::EpiRes E{out_, out_, (float*)(ws + WS_SB), MOD + (size_t)l * NB * NMODC + 5 * 1024, (const float*)(ws + WS_STATS), args.in[11] + (size_t)(l * 3) * D, args.in[12] + (size_t)(l * 3) * D, 1.0f, D / 64};
                    pg8::gemm_phase<pg8::EpiRes, pg8::SplitOrder, PG8_ALIGN, PG8_SP2>(LDSP, g, S, E);
                }
                grid_bar(args, LDSP);
                ln_phase(args, LDSP, l, 1, true, l, 6, 4, ALPHA, false);
                grid_bar(args, LDSP);
            }
            {
                FRESH();
                pg8::Gemm g{H, (const bf16*)(ws + WS_W + (size_t)l * W_LAYER + (f ? W_WI2 : W_WI1)), M, NWI, D}; pg8::StaticOrder S; S.init(M, NWI, G, bx, D);
                pg8::EpiSwiglu E{BIG, DFF};
                pg8::gemm_phase<pg8::EpiSwiglu, pg8::StaticOrder, PG8_ALIGN, PG8_SP2>(LDSP, g, S, E);
            }
            grid_bar(args, LDSP);
            {
                FRESH();
                pg8::Gemm g{BIG, (const bf16*)(ws + WS_W + (size_t)l * W_LAYER + (f ? W_WO2 : W_WO1)), M, D, DFF}; pg8::SplitOrder S; S.init(DFF, G, bx);
                const bool first = (l == 0 && f == 0); const int pinst = f ? l * 3 + 1 : l * 3 - 1;
                pg8::EpiRes E{out_, first ? args.in[0] : out_, (float*)(ws + WS_SB), MOD + (size_t)l * NB * NMODC + (f ? 8 : 2) * 1024, (const float*)(ws + WS_STATS),
                              first ? (const float*)(ws + WS_ID) : args.in[11] + (size_t)pinst * D, first ? (const float*)(ws + WS_ID) + 1024 : args.in[12] + (size_t)pinst * D, 0.5f, DFF / 64};
                pg8::gemm_phase<pg8::EpiRes, pg8::SplitOrder, PG8_ALIGN, PG8_SP2>(LDSP, g, S, E);
            }
            grid_bar(args, LDSP);
            if (f == 0) ln_phase(args, LDSP, l, 0, true, l, 3, 11, ALPHA, false);
            else ln_phase(args, LDSP, l, 2, l == 0, 1, 0, 11, l == 0 ? ALPHA : 1.0f, l == 1);
            if (!(l == 1 && f == 1)) grid_bar(args, LDSP);
        }
    }
}

extern "C" void kernel_launch(void* const* d_in, const int* in_sizes, int n_in, void* d_out, int out_size, void* d_ws, size_t ws_size, hipStream_t stream) {
    static int grid = 0;
    if (grid == 0) {
        if (n_in != 28 || (size_t)out_size != O_END || ws_size < WS_END) { fprintf(stderr, "kernel_launch: unexpected sizes n_in %d out %d ws %zu (need %zu)\n", n_in, out_size, ws_size, (size_t)WS_END); grid = -1; return; }
        int dev = 0, cus = 0, per_cu = 0;
        hipGetDevice(&dev); hipDeviceGetAttribute(&cus, hipDeviceAttributeMultiprocessorCount, dev);
        hipFuncSetAttribute((const void*)mega_fwd, hipFuncAttributeMaxDynamicSharedMemorySize, LDS_BYTES);
        hipOccupancyMaxActiveBlocksPerMultiprocessor(&per_cu, (const void*)mega_fwd, NWAVES * 64, LDS_BYTES);
        (void)hipGetLastError();
        if (per_cu < 1 || cus < 256) { fprintf(stderr, "kernel_launch: occupancy %d cus %d\n", per_cu, cus); grid = -1; return; }
        grid = 256;
    }
    if (grid < 0) return;
    if (hipMemsetAsync(d_ws, 0, 65536, stream) != hipSuccess) { fprintf(stderr, "memset failed\n"); return; }
    Args a{};
    for (int i = 0; i < 28; ++i) a.in[i] = (const float*)d_in[i];
    a.out = (float*)d_out; a.ws = (unsigned char*)d_ws;
    void* kargs[] = {&a};
    hipError_t e = hipLaunchCooperativeKernel((const void*)mega_fwd, dim3(grid), dim3(NWAVES * 64), kargs, LDS_BYTES, stream);
    if (e != hipSuccess) fprintf(stderr, "cooperative launch failed: %s\n", hipGetErrorString(e));
}
```

```cpp
#include <hip/hip_runtime.h>
#include <hip/hip_cooperative_groups.h>
#include <cstdio>
#include <cstdint>
namespace cg = cooperative_groups;
namespace pg8 {
#define PG8_LAS __attribute__((address_space(3)))
typedef unsigned short bf16_t;
typedef short bf16x8 __attribute__((ext_vector_type(8)));
typedef float f32x4 __attribute__((ext_vector_type(4)));
typedef unsigned u32x4 __attribute__((ext_vector_type(4)));
constexpr int BM = 256, BK = 64, HALF = 128, HTB = HALF * BK * 2  , STAGE_BYTES = 8 * HTB, NXCD = 8, WGM = 8;

__host__ __device__ __forceinline__ int lds_byte(int r, int c) { const int st = (r >> 4) * 2 + (c >> 5), rr = r & 15, cc = c & 31, ob = rr * 64 + cc * 2; return st * 1024 + (ob ^ (((ob >> 9) & 1) << 5)); }
__host__ __device__ __forceinline__ void stage_rc(int b, int& R, int& C) { const int st = b / 1024, sb = b % 1024, swz = sb ^ (((sb >> 9) & 1) << 5); R = (st >> 1) * 16 + swz / 64; C = (st & 1) * 32 + (swz % 64) / 2; }
__host__ __device__ __forceinline__ int perm32(int rho) { const int n = rho >> 4, i = rho & 15; return 8 * (i >> 2) + 4 * n + (i & 3); }

struct Unit { int pm, pn, k0, nt; };
struct Gemm { const bf16_t* A; const bf16_t* Bt; int M, N, K; };

struct StaticOrder {
    int nM, nN, nwg, G, c, ntf;
    __host__ __device__ void init(int M, int N, int G_, int c_, int K_ = 1024) { nM = M / BM; nN = N / BM; nwg = nM * nN; G = G_; c = c_; ntf = K_ / BK; }
    __host__ __device__ bool next(int i, Unit& u) const {
        const long L = (long)i * G + c; if (L >= nwg) return false;
        int wgid = (int)L; { const int q = nwg / NXCD, r = nwg % NXCD, xcd = wgid % NXCD, off = wgid / NXCD; wgid = (xcd < r ? xcd * (q + 1) : r * (q + 1) + (xcd - r) * q) + off; }
        const int nig = WGM * nN, gid = wgid / nig, fm = gid * WGM, gsz = (nM - fm) < WGM ? (nM - fm) : WGM;
        u.pm = fm + ((wgid % nig) % gsz); u.pn = (wgid % nig) / gsz; u.k0 = 0; u.nt = ntf; return true;
    }
    __device__ __forceinline__ void a_ready(const Unit&) const {}
    __device__ __forceinline__ void done(const Unit&) const {}
};

struct SplitOrder {
    StaticOrder base; int ppu, c;
    static constexpr int PK = 4;
    __host__ __device__ void init(int K_, int G_, int c_) { base.init(16384, 1024, G_, c_, K_); ppu = (K_ / BK) / PK; c = c_; }
    __host__ __device__ bool next(int i, Unit& u) const {
        if (i == 0) return base.next(0, u);
        if (i == 1 && c < 8 * ppu) { const int j = c / ppu, p = c - j * ppu; u.pm = 64 + (j >> 2); u.pn = j & 3; u.k0 = p * PK; u.nt = PK; return true; }
        return false;
    }
    __device__ __forceinline__ void a_ready(const Unit&) const {}
    __device__ __forceinline__ void done(const Unit&) const {}
};

__device__ __forceinline__ unsigned cvt_pk_bf16(float lo, float hi) { unsigned r; asm volatile("v_cvt_pk_bf16_f32 %0, %1, %2" : "=v"(r) : "v"(lo), "v"(hi)); return r; }
typedef float f32x2 __attribute__((ext_vector_type(2)));
__device__ __forceinline__ f32x2 gelu_pk(f32x2 v) {
    const f32x2 av = __builtin_elementwise_abs(v), d = av * 0.2316418882f + 1.0f;
    f32x2 t; t.x = __builtin_amdgcn_rcpf(d.x); t.y = __builtin_amdgcn_rcpf(d.y);
    f32x2 q = t * 0.5307027145f + (-0.7265760135f); q = q * t + 0.7107068705f; q = q * t + (-0.142248368f); q = q * t + 0.127414796f; q = q * t;
    const f32x2 s = (v * v) * (-0.72134752044f);
    f32x2 e; e.x = __builtin_amdgcn_exp2f(s.x); e.y = __builtin_amdgcn_exp2f(s.y);
    const f32x2 m = v * (q * e), r = v - m;
    f32x2 o; o.x = v.x < 0.f ? m.x : r.x; o.y = v.y < 0.f ? m.y : r.y; return o;
}

template <int ACT  > struct EpiBf16 {
    static constexpr bool PERM = true, AFTER_DRAIN = false; static_assert(ACT == 0 || ACT == 1, "EpiBf16: ACT is 0 (none) or 1 (gelu_pk)");
    bf16_t* O; int ldc; const float* bias; int split_cols; size_t split_stride; float scale0;
    __device__ __forceinline__ void operator()(const f32x4 (&acc)[2][2][4][2], const Unit& u, int wr, int wc, int fr, int fq) const {
        const int row0 = u.pm * BM + wr * 64 + fr; int colt = u.pn * BM; bf16_t* base = O;
        float sc = 1.f; if (split_cols) { const int t = colt / split_cols; base += (size_t)t * split_stride; colt -= t * split_cols; if (t == 0) sc = scale0; }
        const int col0 = colt + wc * 32 + 8 * fq, bcol0 = u.pn * BM + wc * 32 + 8 * fq;
        f32x4 bv[2][2];
#pragma unroll
        for (int bj = 0; bj < 2; ++bj)
#pragma unroll
            for (int n = 0; n < 2; ++n) bv[bj][n] = bias ? *(const f32x4*)(bias + bcol0 + bj * HALF + 4 * n) : (f32x4){0.f, 0.f, 0.f, 0.f};
#pragma unroll
        for (int ai = 0; ai < 2; ++ai)
#pragma unroll
            for (int m = 0; m < 4; ++m) { bf16_t* rowp = base + (size_t)(row0 + ai * HALF + m * 16) * ldc + col0;
#pragma unroll
                for (int bj = 0; bj < 2; ++bj) { f32x4 v0 = acc[ai][bj][m][0] + bv[bj][0], v1 = acc[ai][bj][m][1] + bv[bj][1];
                    if (ACT == 1) { f32x2 a = gelu_pk((f32x2){v0[0], v0[1]}), b = gelu_pk((f32x2){v0[2], v0[3]}), c = gelu_pk((f32x2){v1[0], v1[1]}), d = gelu_pk((f32x2){v1[2], v1[3]});
                        v0 = (f32x4){a.x, a.y, b.x, b.y}; v1 = (f32x4){c.x, c.y, d.x, d.y}; }
                    v0 = v0 * sc; v1 = v1 * sc; u32x4 w; w.x = cvt_pk_bf16(v0[0], v0[1]); w.y = cvt_pk_bf16(v0[2], v0[3]); w.z = cvt_pk_bf16(v1[0], v1[1]); w.w = cvt_pk_bf16(v1[2], v1[3]);
                    *(u32x4*)(rowp + bj * HALF) = w; } }
    }
};
template <class Epi, class Sched, bool ALIGN_EPI = false, bool SP2 = false>
__device__ __forceinline__ void gemm_phase(PG8_LAS unsigned char* lds, const Gemm g, const Sched& S, const Epi& E) {
    int tid_ = threadIdx.x; asm volatile("" : "+v"(tid_));
    const int tid = tid_, wid = __builtin_amdgcn_readfirstlane(tid >> 6), lane = tid & 63, wr = wid >> 2, wc = wid & 3, fr = lane & 15, fq = lane >> 4;
    const int K = g.K;
    unsigned voffA[2], voffB[2];
#pragma unroll
    for (int i = 0; i < 2; ++i) { int R, C; stage_rc(tid * 16 + i * 8192, R, C); const int Rb = Epi::PERM ? ((R & ~31) + perm32(R & 31)) : R;
        voffA[i] = (unsigned)(R * K + C) * 2u; voffB[i] = (unsigned)(Rb * K + C) * 2u; }
    const size_t kstep = (size_t)(BK * 2);
    const size_t hstep = (size_t)HALF * K * 2;
    const size_t tstep = 2 * hstep;
    const unsigned ldsw = (unsigned)wid * 1024u;
    const int aoff = lds_byte(wr * 64 + fr, fq * 8), boff = lds_byte(wc * 32 + fr, fq * 8);
#define PG8_SA(b, h) (((b) * 2 + (h)) * HTB)
#define PG8_SB(b, h) ((4 + (b) * 2 + (h)) * HTB)
#define PG8_STAGE(bufoff, gbase, voff) do { _Pragma("unroll") for (int _i = 0; _i < 2; ++_i) \
        __builtin_amdgcn_global_load_lds((const unsigned*)((const char*)(gbase) + (voff)[_i]), (PG8_LAS unsigned*)(lds + (bufoff) + ldsw + _i * 8192), 16, 0, 0); } while (0)
#define PG8_LDA(dst, b, h) do { _Pragma("unroll") for (int m = 0; m < 4; ++m) _Pragma("unroll") for (int k = 0; k < 2; ++k) dst[m][k] = *(const PG8_LAS bf16x8*)(lds + PG8_SA(b, h) + aoff + m * 2048 + k * 1024); } while (0)
#define PG8_LDB(dst, b, h) do { _Pragma("unroll") for (int n = 0; n < 2; ++n) _Pragma("unroll") for (int k = 0; k < 2; ++k) dst[n][k] = *(const PG8_LAS bf16x8*)(lds + PG8_SB(b, h) + boff + n * 2048 + k * 1024); } while (0)
#define PG8_MMA(ai, bj, At, Bt) do { __builtin_amdgcn_s_setprio(1); _Pragma("unroll") for (int m = 0; m < 4; ++m) _Pragma("unroll") for (int n = 0; n < 2; ++n) _Pragma("unroll") for (int k = 0; k < 2; ++k) \
        acc[ai][bj][m][n] = __builtin_amdgcn_mfma_f32_16x16x32_bf16(Bt[n][k], At[m][k], acc[ai][bj][m][n], 0, 0, 0); __builtin_amdgcn_s_setprio(0); } while (0)
#define PG8_WAIT_V(n) asm volatile("s_waitcnt vmcnt(" #n ")" ::: "memory")
#define PG8_WAIT_L(n) asm volatile("s_waitcnt lgkmcnt(" #n ")" ::: "memory")
#define PG8_BAR __builtin_amdgcn_s_barrier()
#define PG8_SCHED __builtin_amdgcn_sched_barrier(0)
    Unit cur, nxt; int ui = 0;
    if (!S.next(0, cur)) return;
    f32x4 acc[2][2][4][2];
#pragma unroll
    for (int a = 0; a < 2; ++a)
#pragma unroll
        for (int b = 0; b < 2; ++b)
#pragma unroll
            for (int m = 0; m < 4; ++m)
#pragma unroll
                for (int n = 0; n < 2; ++n) acc[a][b][m][n] = (f32x4){0.f, 0.f, 0.f, 0.f};
    bf16x8 At[4][2], B0[2][2], B1[2][2];
    const char* cA = (const char*)g.A + (size_t)cur.pm * tstep + (size_t)cur.k0 * kstep; const char* cB = (const char*)g.Bt + (size_t)cur.pn * tstep + (size_t)cur.k0 * kstep;
    S.a_ready(cur);
    if constexpr (SP2) {
        PG8_STAGE(PG8_SB(0, 0), cB, voffB); PG8_STAGE(PG8_SB(0, 1), cB + hstep, voffB); PG8_STAGE(PG8_SA(0, 0), cA, voffA); PG8_STAGE(PG8_SA(0, 1), cA + hstep, voffA);
        if (wr == 1) PG8_BAR;
        PG8_WAIT_V(2); PG8_BAR;
        PG8_STAGE(PG8_SB(1, 0), cB + kstep, voffB); PG8_STAGE(PG8_SA(1, 0), cA + kstep, voffA); PG8_STAGE(PG8_SB(1, 1), cB + hstep + kstep, voffB);
        PG8_WAIT_V(6); PG8_BAR;
    } else {
        PG8_STAGE(PG8_SB(0, 0), cB, voffB); PG8_STAGE(PG8_SA(0, 0), cA, voffA); PG8_STAGE(PG8_SB(0, 1), cB + hstep, voffB); PG8_STAGE(PG8_SA(0, 1), cA + hstep, voffA);
        if (wr == 1) PG8_BAR;
        PG8_WAIT_V(4); PG8_BAR;
        PG8_STAGE(PG8_SB(1, 0), cB + kstep, voffB); PG8_STAGE(PG8_SA(1, 0), cA + kstep, voffA); PG8_STAGE(PG8_SB(1, 1), cB + hstep + kstep, voffB);
        PG8_WAIT_V(6); PG8_BAR;
    }
    for (;;) {
        const bool has_next = S.next(ui + 1, nxt);
        const char* nA = has_next ? (const char*)g.A + (size_t)nxt.pm * tstep + (size_t)nxt.k0 * kstep : cA; const char* nB = has_next ? (const char*)g.Bt + (size_t)nxt.pn * tstep + (size_t)nxt.k0 * kstep : cB;
        const int nt = cur.nt;
        for (int t = 0; t < nt; t += 2) {
            const bool last = (t == nt - 2);
            const char* a1 = cA + (size_t)(t + 1) * kstep;
            const char* a2 = last ? nA : cA + (size_t)(t + 2) * kstep; const char* b2 = last ? nB : cB + (size_t)(t + 2) * kstep;
            const char* a3 = a2 + kstep; const char* b3 = b2 + kstep;
            if (last && has_next) S.a_ready(nxt);
            if constexpr (SP2) {
            PG8_LDB(B0, 0, 0); PG8_LDB(B1, 0, 1); PG8_SCHED; PG8_LDA(At, 0, 0); PG8_STAGE(PG8_SA(1, 1), a1 + hstep, voffA);
            PG8_WAIT_V(8); PG8_WAIT_L(0); PG8_BAR; PG8_MMA(0, 0, At, B0); PG8_MMA(0, 1, At, B1); PG8_BAR; PG8_SCHED;
            PG8_LDA(At, 0, 1); PG8_STAGE(PG8_SB(0, 0), b2, voffB); PG8_STAGE(PG8_SB(0, 1), b2 + hstep, voffB); PG8_STAGE(PG8_SA(0, 0), a2, voffA);
            PG8_WAIT_V(8); PG8_WAIT_L(0); PG8_BAR; PG8_MMA(1, 0, At, B0); PG8_MMA(1, 1, At, B1); PG8_BAR; PG8_SCHED;
            PG8_LDB(B0, 1, 0); PG8_LDB(B1, 1, 1); PG8_SCHED; PG8_LDA(At, 1, 0); PG8_STAGE(PG8_SA(0, 1), a2 + hstep, voffA);
            PG8_WAIT_V(8); PG8_WAIT_L(0); PG8_BAR; PG8_MMA(0, 0, At, B0); PG8_MMA(0, 1, At, B1); PG8_BAR; PG8_SCHED;
            PG8_LDA(At, 1, 1); PG8_STAGE(PG8_SB(1, 0), b3, voffB); PG8_STAGE(PG8_SB(1, 1), b3 + hstep, voffB); PG8_STAGE(PG8_SA(1, 0), a3, voffA);
            PG8_WAIT_V(8); PG8_WAIT_L(0); PG8_BAR; PG8_MMA(1, 0, At, B0); PG8_MMA(1, 1, At, B1); PG8_BAR; PG8_SCHED;
            } else {
            PG8_LDB(B0, 0, 0); PG8_SCHED; PG8_LDA(At, 0, 0); PG8_STAGE(PG8_SA(1, 1), a1 + hstep, voffA);
            PG8_WAIT_L(8); PG8_BAR; PG8_WAIT_L(0); PG8_MMA(0, 0, At, B0); PG8_BAR; PG8_SCHED;
            PG8_LDB(B1, 0, 1); PG8_STAGE(PG8_SB(0, 0), b2, voffB);
            PG8_BAR; PG8_WAIT_L(0); PG8_MMA(0, 1, At, B1); PG8_BAR;
            PG8_LDA(At, 0, 1); PG8_STAGE(PG8_SA(0, 0), a2, voffA);
            PG8_BAR; PG8_WAIT_L(0); PG8_MMA(1, 0, At, B0); PG8_BAR; PG8_SCHED;
            PG8_STAGE(PG8_SB(0, 1), b2 + hstep, voffB);
            PG8_WAIT_V(6); PG8_BAR; PG8_MMA(1, 1, At, B1); PG8_BAR;
            PG8_LDB(B0, 1, 0); PG8_SCHED; PG8_LDA(At, 1, 0); PG8_STAGE(PG8_SA(0, 1), a2 + hstep, voffA);
            PG8_WAIT_L(8); PG8_BAR; PG8_WAIT_L(0); PG8_MMA(0, 0, At, B0); PG8_BAR; PG8_SCHED;
            PG8_LDB(B1, 1, 1); PG8_STAGE(PG8_SB(1, 0), b3, voffB);
            PG8_BAR; PG8_WAIT_L(0); PG8_MMA(0, 1, At, B1); PG8_BAR;
            PG8_LDA(At, 1, 1); PG8_STAGE(PG8_SA(1, 0), a3, voffA);
            PG8_BAR; PG8_WAIT_L(0); PG8_MMA(1, 0, At, B0); PG8_BAR; PG8_SCHED;
            PG8_STAGE(PG8_SB(1, 1), b3 + hstep, voffB);
            PG8_WAIT_V(6); PG8_BAR; PG8_MMA(1, 1, At, B1); PG8_BAR;
            }
        }
        if constexpr (ALIGN_EPI) { if (wr == 0) PG8_BAR; }
        if constexpr (!Epi::AFTER_DRAIN) { E(acc, cur, wr, wc, fr, fq); S.done(cur); }
        if (!has_next) break;
#pragma unroll
        for (int a = 0; a < 2; ++a)
#pragma unroll
            for (int b = 0; b < 2; ++b)
#pragma unroll
                for (int m = 0; m < 4; ++m)
#pragma unroll
                    for (int n = 0; n < 2; ++n) acc[a][b][m][n] = (f32x4){0.f, 0.f, 0.f, 0.f};
        cur = nxt; cA = nA; cB = nB; ++ui;
        if constexpr (ALIGN_EPI) { if (wr == 1) PG8_BAR; }
    }
    PG8_WAIT_V(0);
    if constexpr (!ALIGN_EPI) { if (wr == 0) PG8_BAR; }
    PG8_BAR;
    if constexpr (Epi::AFTER_DRAIN) { E.fused(acc, cur, wr, wc, fr, fq, lds, wid, lane); S.done(cur); }
#undef PG8_SA
#undef PG8_SB
#undef PG8_STAGE
#undef PG8_LDA
#undef PG8_LDB
#undef PG8_MMA
#undef PG8_WAIT_V
#undef PG8_WAIT_L
#undef PG8_BAR
#undef PG8_SCHED
}
}
#define PG8_SP2 true
#define PG8_ALIGN true

constexpr int D = 1024, TP = 2048, BP = 8, BS = 128, TS = 4;
constexpr int MP = BP * TP, MS = BS * TS, M = MP + MS;
constexpr int DFF = 2816, NWI = 2 * DFF, NIN = 3864, NINP = 4096, NMODC = 9216, NB = BP + BS;
constexpr int SBW = 1664, SFW = 396;
constexpr float LN_EPS = 1e-5f, RMS_EPS = 1e-6f;
constexpr float ALPHA = 1.41421356237f;
constexpr int C_RQ = 0, C_RK = 256, C_RV = 512, C_RG = 768, C_AQ = 1024, C_AK = 1152, C_AV = 1280, C_ALR = 1536, C_AG = 1552,
              C_HQ = 1808, C_HF = 2064, C_HI = 2320, C_HG = 2576, C_DQKV = 2832, C_DB = 3600, C_DA = 3604, C_DG = 3608;
constexpr int SB_RQ = 0, SB_RK = 256, SB_AQ = 512, SB_HQ = 640, SB_DQ = 896, SB_DK = 1152, SB_DV = 1408;
constexpr int SF_ADEC = 0, SF_HF = 128, SF_BETA = 384, SF_DDEC = 388, SF_QK = 392;
constexpr size_t O_Y = 0;
constexpr size_t O_PRET = (size_t)M * D;
constexpr size_t O_PGLA = O_PRET + 2ull * BP * 4 * 64 * 64;
constexpr size_t O_PHG = O_PGLA + 2ull * BP * 4 * 32 * 64;
constexpr size_t O_PGDN = O_PHG + 2ull * BP * 4 * 64 * 64;
constexpr size_t O_PCONV = O_PGDN + 2ull * BP * 4 * 64 * 64;
constexpr size_t O_SRET = O_PCONV + 2ull * BP * 3 * 768;
constexpr size_t O_SGLA = O_SRET + 2ull * BS * 4 * 64 * 64;
constexpr size_t O_SHG = O_SGLA + 2ull * BS * 4 * 32 * 64;
constexpr size_t O_SGDN = O_SHG + 2ull * BS * 4 * 64 * 64;
constexpr size_t O_SCONV = O_SGDN + 2ull * BS * 4 * 64 * 64;
constexpr size_t O_END = O_SCONV + 2ull * BS * 3 * 768;

constexpr size_t MiB = 1u << 20;
constexpr size_t WS_ROPE = 1 * MiB;
constexpr size_t WS_AC = 2 * MiB;
constexpr size_t WS_MOD = 3 * MiB;
constexpr size_t WS_STATS = 2 * MiB + 512 * 1024;
constexpr size_t WS_ID = 2 * MiB + 768 * 1024;
constexpr size_t WS_W = 13 * MiB;
constexpr size_t W_WI1 = 0, W_WO1 = 11 * MiB, W_WI2 = W_WO1 + 5 * MiB + MiB / 2, W_WO2 = W_WI2 + 11 * MiB, W_WIN = W_WO2 + 5 * MiB + MiB / 2, W_WOUT = W_WIN + 8 * MiB, W_LAYER = 43 * MiB;
constexpr size_t WS_H = WS_W + 2 * W_LAYER;
constexpr size_t WS_BIG = WS_H + 33 * MiB;
constexpr size_t WS_SB = WS_BIG + 132 * MiB;
constexpr size_t WS_SF = WS_SB + 54 * MiB;
constexpr size_t WS_END = WS_SF + 26 * MiB;
static_assert((size_t)M * SBW * 2 <= 54 * MiB && (size_t)M * SFW * 4 <= 26 * MiB && (size_t)M * 4096 * 2 <= 132 * MiB && (size_t)M * D * 2 <= 33 * MiB, "ws map");

constexpr int LDS_BYTES = 147456;
constexpr int NWAVES = 8;

#define GAS __attribute__((address_space(1)))
#define LAS __attribute__((address_space(3)))
typedef unsigned short bf16;
typedef unsigned v4u __attribute__((ext_vector_type(4)));
typedef unsigned v2u __attribute__((ext_vector_type(2)));
typedef float f32x4 __attribute__((ext_vector_type(4)));
typedef float f32x2 __attribute__((ext_vector_type(2)));
#define LDS_WAIT() asm volatile("s_waitcnt lgkmcnt(0)" ::: "memory")

__device__ __forceinline__ float bf2f(unsigned b) { return __uint_as_float(b << 16); }
__device__ __forceinline__ float bflo(unsigned w) { return __uint_as_float(w << 16); }
__device__ __forceinline__ float bfhi(unsigned w) { return __uint_as_float(w & 0xffff0000u); }
__device__ __forceinline__ unsigned pk2(float lo, float hi) { return pg8::cvt_pk_bf16(lo, hi); }
__device__ __forceinline__ float sigmoidf_(float x) { return __builtin_amdgcn_rcpf(1.0f + __expf(-x)); }
__device__ __forceinline__ float siluf_(float x) { return x * __builtin_amdgcn_rcpf(1.0f + __expf(-x)); }
__device__ __forceinline__ float wave_sum(float v) {
#pragma unroll
    for (int o = 1; o < 64; o <<= 1) v += __shfl_xor(v, o);
    return v;
}
template <int CTRL> __device__ __forceinline__ float dppmov(float v) { return __int_as_float(__builtin_amdgcn_update_dpp(0, __float_as_int(v), CTRL, 0xf, 0xf, true)); }
__device__ __forceinline__ float quad_sum(float v) { v += dppmov<0xB1>(v); v += dppmov<0x4E>(v); return v; }
__device__ __forceinline__ float row8_sum(float v) { v += dppmov<0xB1>(v); v += dppmov<0x4E>(v); v += dppmov<0x141>(v); return v; }
__device__ __forceinline__ float row16_sum(float v) { v += dppmov<0xB1>(v); v += dppmov<0x4E>(v); v += dppmov<0x141>(v); v += dppmov<0x140>(v); return v; }

struct Args { const float* in[28]; float* out; unsigned char* ws; };

struct Ctx {
    int tid, lane, wave, gw, NGW;
    LAS unsigned char* lds;
    float* out; unsigned char* ws;
};
template <class T> __device__ __forceinline__ T* fresh_ptr(T* p) {
    unsigned lo = (unsigned)(uintptr_t)p, hi = (unsigned)((uintptr_t)p >> 32);
    asm volatile("" : "+v"(lo), "+v"(hi));
    lo = __builtin_amdgcn_readfirstlane(lo); hi = __builtin_amdgcn_readfirstlane(hi);
    return (T*)(__attribute__((address_space(1))) T*)(((uintptr_t)hi << 32) | (uintptr_t)lo);
}
__device__ __forceinline__ Ctx make_ctx(const Args& args, LAS unsigned char* lds) {
    Ctx C; int t = threadIdx.x; asm volatile("" : "+v"(t));
    C.tid = t; C.lane = t & 63; C.wave = __builtin_amdgcn_readfirstlane(t >> 6);
    C.gw = (int)blockIdx.x * NWAVES + C.wave; C.NGW = (int)gridDim.x * NWAVES;
    float* op = fresh_ptr(args.out); unsigned char* wp = fresh_ptr(args.ws);
    C.lds = lds; C.out = op; C.ws = wp; return C;
}
__device__ __forceinline__ int batch_of_row(int r) { return r < MP ? (r >> 11) : BP + ((r - MP) >> 2); }


typedef GAS unsigned gu32;
#define RLX_AGENT __ATOMIC_RELAXED, __HIP_MEMORY_SCOPE_AGENT
#define XB_TMO      128
#define XB_XCNT(j)  (256  + 64 * (j))
#define XB_XSUB(j)  (1280 + 64 * (j))
#define XB_XGEN(j)  (2304 + 64 * (j))
#define XB_TOP      3328
#define XB_TOPGEN   3392
#define XCD_BAR_WORDS 3456
#define XB_SPIN_CAP (1u << 18)

__device__ __forceinline__ unsigned xb_ld(unsigned* p)              { return __hip_atomic_load(p, __ATOMIC_RELAXED, __HIP_MEMORY_SCOPE_AGENT); }
__device__ __forceinline__ unsigned xb_add(unsigned* p, unsigned v) { return __hip_atomic_fetch_add(p, v, __ATOMIC_RELAXED, __HIP_MEMORY_SCOPE_AGENT); }
__device__ __forceinline__ unsigned xb_xcc_id() { return (unsigned)__builtin_amdgcn_s_getreg((3 << 11) | 20) & 0xFu; }
#define XB_SPIN(cond, bar) do { unsigned _sp = 0; while (cond) { __builtin_amdgcn_s_sleep(1); \
    if ((++_sp & 255u) == 0u) { if (xb_ld(&(bar)[XB_TMO])) break; if (_sp > XB_SPIN_CAP) { atomicAdd(&(bar)[XB_TMO], 1u); break; } } } } while (0)

struct XcdBarrier {
    unsigned* bar; unsigned x;
    volatile LAS unsigned* st;
};

__device__ __forceinline__ XcdBarrier xcd_barrier_post(unsigned* bar, volatile LAS unsigned* st) {
    XcdBarrier b; b.bar = bar; b.x = xb_xcc_id(); b.st = st;
    if (threadIdx.x == 0) (void)xb_add(&bar[XB_XCNT(b.x)], 1u);
    return b;
}
__device__ __forceinline__ void xcd_barrier_complete(unsigned* bar, unsigned x, unsigned& nloc, unsigned& nx) {
    const unsigned G = gridDim.x * gridDim.y * gridDim.z;
    unsigned sum, cnt, mine, sp = 0u;
    for (;;) {
        sum = 0u; cnt = 0u; mine = 0u;
#pragma unroll
        for (unsigned j = 0; j < 16; ++j) { const unsigned c = xb_ld(&bar[XB_XCNT(j)]); sum += c; cnt += (c > 0u) ? 1u : 0u; mine = (j == x) ? c : mine; }
        if (sum == G) break;
        __builtin_amdgcn_s_sleep(1);
        if ((++sp & 255u) == 0u) { if (xb_ld(&bar[XB_TMO])) break; if (sp > XB_SPIN_CAP) { atomicAdd(&bar[XB_TMO], 1u); break; } }
    }
    nloc = mine > 0u ? mine : 1u; nx = cnt > 0u ? cnt : 1u;
}

__device__ __forceinline__ void xcd_barrier(const XcdBarrier& b) {
    asm volatile("s_waitcnt vmcnt(0)" ::: "memory");
    __syncthreads();
    if (threadIdx.x == 0) {
        unsigned* bar = b.bar;
        __builtin_amdgcn_s_waitcnt(0);
        unsigned nloc = b.st[0], nx = b.st[1];
        if (nloc == 0u) { xcd_barrier_complete(bar, b.x, nloc, nx); b.st[0] = nloc; b.st[1] = nx; }
        const unsigned old = xb_add(&bar[XB_XSUB(b.x)], 1u);
        const unsigned gen = old / nloc;
        if (old + 1u == (gen + 1u) * nloc) {
            __builtin_amdgcn_fence(__ATOMIC_RELEASE, "agent");
            asm volatile("s_waitcnt vmcnt(0)" ::: "memory");
            const unsigned og = xb_add(&bar[XB_TOP], 1u);
            const unsigned tg = og / nx;
            if (og + 1u == (tg + 1u) * nx) xb_add(&bar[XB_TOPGEN], 1u);
            else XB_SPIN(xb_ld(&bar[XB_TOPGEN]) == tg, bar);
            __builtin_amdgcn_fence(__ATOMIC_ACQUIRE, "agent");
            xb_add(&bar[XB_XGEN(b.x)], 1u);
            asm volatile("s_waitcnt vmcnt(0)" ::: "memory");
        } else {
            XB_SPIN(xb_ld(&bar[XB_XGEN(b.x)]) == gen, bar);
            __builtin_amdgcn_fence(__ATOMIC_ACQUIRE, "agent");
            asm volatile("s_waitcnt vmcnt(0)" ::: "memory");
        }
    }
    __syncthreads();
}

constexpr int MISC_OFF = LDS_BYTES - 256;
__device__ __forceinline__ void grid_bar(const Args& args, LAS unsigned char* lds) {
    XcdBarrier b; b.bar = (unsigned*)fresh_ptr(args.ws); b.x = xb_xcc_id(); b.st = (volatile LAS unsigned*)(lds + MISC_OFF);
    xcd_barrier(b);
}

__device__ __forceinline__ float wave_sum2(float v) { v = row16_sum(v); v += __shfl_xor(v, 16); v += __shfl_xor(v, 32); return v; }

namespace pg8 {
struct EpiSwiglu {
    static constexpr bool PERM = true, AFTER_DRAIN = false;
    bf16_t* O; int ldc;
    __device__ __forceinline__ void operator()(const f32x4 (&acc)[2][2][4][2], const Unit& u, int wr, int wc, int fr, int fq) const {
        const int row0 = u.pm * BM + wr * 64 + fr, col0 = u.pn * 128 + wc * 32 + 8 * fq;
#pragma unroll
        for (int ai = 0; ai < 2; ++ai)
#pragma unroll
            for (int m = 0; m < 4; ++m) {
                bf16_t* rowp = O + (size_t)(row0 + ai * HALF + m * 16) * ldc + col0;
                float h[8];
#pragma unroll
                for (int n = 0; n < 2; ++n)
#pragma unroll
                    for (int j = 0; j < 4; ++j) {
                        const float a = acc[ai][0][m][n][j], b = acc[ai][1][m][n][j];
                        const float e = __builtin_amdgcn_exp2f(-1.44269504f * a);
                        h[n * 4 + j] = a * __builtin_amdgcn_rcpf(1.0f + e) * b;
                    }
                u32x4 w; w.x = cvt_pk_bf16(h[0], h[1]); w.y = cvt_pk_bf16(h[2], h[3]); w.z = cvt_pk_bf16(h[4], h[5]); w.w = cvt_pk_bf16(h[6], h[7]);
                *(u32x4*)rowp = w;
            }
    }
};
struct EpiPlain {
    static constexpr bool PERM = true, AFTER_DRAIN = false;
    bf16_t* O; int ldc;
    __device__ __forceinline__ void operator()(const f32x4 (&acc)[2][2][4][2], const Unit& u, int wr, int wc, int fr, int fq) const {
        const int row0 = u.pm * BM + wr * 64 + fr, col0 = u.pn * BM + wc * 32 + 8 * fq;
#pragma unroll
        for (int ai = 0; ai < 2; ++ai)
#pragma unroll
            for (int m = 0; m < 4; ++m) {
                bf16_t* rowp = O + (size_t)(row0 + ai * HALF + m * 16) * ldc + col0;
#pragma unroll
                for (int bj = 0; bj < 2; ++bj) { const f32x4 v0 = acc[ai][bj][m][0], v1 = acc[ai][bj][m][1];
                    u32x4 w; w.x = cvt_pk_bf16(v0[0], v0[1]); w.y = cvt_pk_bf16(v0[2], v0[3]); w.z = cvt_pk_bf16(v1[0], v1[1]); w.w = cvt_pk_bf16(v1[2], v1[3]);
                    *(u32x4*)(rowp + bj * HALF) = w; }
            }
    }
};
struct EpiRes {
    static constexpr bool PERM = false, AFTER_DRAIN = false;
    float* X; const float* Xr; float* PART; const float* gate; const float* stats; const float* lg; const float* lb; float scale; int ntf;
    __device__ __forceinline__ void operator()(const f32x4 (&acc)[2][2][4][2], const Unit& u, int wr, int wc, int fr, int fq) const {
        const int col0 = u.pn * BM + wc * 32 + 4 * fq;
        if (u.nt == ntf) {
            const float* gp = gate + (size_t)(u.pm >> 3) * 9216 + col0;
            f32x4 gs[2][2], g4[2][2], b4[2][2];
#pragma unroll
            for (int bj = 0; bj < 2; ++bj)
#pragma unroll
                for (int n = 0; n < 2; ++n) { const int cc = bj * HALF + n * 16;
                    gs[bj][n] = *(const f32x4*)(gp + cc) * scale + scale; g4[bj][n] = *(const f32x4*)(lg + col0 + cc); b4[bj][n] = *(const f32x4*)(lb + col0 + cc) * 1.41421356237f; }
#pragma unroll
            for (int ai = 0; ai < 2; ++ai)
#pragma unroll
                for (int m = 0; m < 4; ++m) {
                    const int r = u.pm * BM + ai * HALF + wr * 64 + m * 16 + fr;
                    const f32x2 st = *(const f32x2*)(stats + 2 * (size_t)r); const float mean = st.x, rs = st.y * 1.41421356237f;
                    const float* yr = Xr + (size_t)r * 1024 + col0; float* xo = X + (size_t)r * 1024 + col0;
                    f32x4 y[2][2];
#pragma unroll
                    for (int bj = 0; bj < 2; ++bj)
#pragma unroll
                        for (int n = 0; n < 2; ++n) y[bj][n] = *(const f32x4*)(yr + bj * HALF + n * 16);
#pragma unroll
                    for (int bj = 0; bj < 2; ++bj)
#pragma unroll
                        for (int n = 0; n < 2; ++n)
                            *(f32x4*)(xo + bj * HALF + n * 16) = gs[bj][n] * acc[ai][bj][m][n] + ((y[bj][n] - mean) * rs * g4[bj][n] + b4[bj][n]);
                    asm volatile("" ::: "memory");
                }
            return;
        }
        float* pbase = PART + (size_t)(u.k0 / SplitOrder::PK) * (512 * 1024);
#pragma unroll
        for (int ai = 0; ai < 2; ++ai)
#pragma unroll
            for (int m = 0; m < 4; ++m) {
                const int r = u.pm * BM + ai * HALF + wr * 64 + m * 16 + fr - 16384;
                const float* gp = gate + (size_t)(8 + (r >> 2)) * 9216 + col0;
                float* xo = pbase + (size_t)r * 1024 + col0;
#pragma unroll
                for (int bj = 0; bj < 2; ++bj)
#pragma unroll
                    for (int n = 0; n < 2; ++n) { const int cc = bj * HALF + n * 16;
                        *(f32x4*)(xo + cc) = (*(const f32x4*)(gp + cc) * scale + scale) * acc[ai][bj][m][n]; }
                asm volatile("" ::: "memory");
            }
    }
};
struct EpiMod {
    static constexpr bool PERM = false, AFTER_DRAIN = false;
    float* MODp; const float* ada_b;
    __device__ __forceinline__ void operator()(const f32x4 (&acc)[2][2][4][2], const Unit& u, int wr, int wc, int fr, int fq) const {
        const int col0 = u.pn * BM + wc * 32 + 4 * fq;
        const int l = (u.pn * BM) / 9216;
#pragma unroll
        for (int ai = 0; ai < 2; ++ai)
#pragma unroll
            for (int m = 0; m < 4; ++m) {
                const int r = u.pm * BM + ai * HALF + wr * 64 + m * 16 + fr;
                if (r < 136) {
#pragma unroll
                    for (int bj = 0; bj < 2; ++bj)
#pragma unroll
                        for (int n = 0; n < 2; ++n) {
                            const int c = col0 + bj * HALF + n * 16;
                            const f32x4 o = acc[ai][bj][m][n] + *(const f32x4*)(ada_b + c);
                            *(f32x4*)(MODp + (size_t)(l * 136 + r) * 9216 + (c - l * 9216)) = o;
                        }
                }
            }
    }
};
}

__device__ __forceinline__ void transpose_item(const float* W, int K, int N, bf16* WT, int dest_row0, LAS float* scr, int k0, int n0, int lane) {
    const int nn = n0 + (lane & 31); const bool ok = nn < N;
    float tv[32];
#pragma unroll
    for (int i = 0; i < 32; ++i) { const int kk = 2 * i + (lane >> 5); tv[i] = ok ? W[(size_t)(k0 + kk) * N + nn] : 0.f; }
#pragma unroll
    for (int i = 0; i < 32; ++i) { const int kk = 2 * i + (lane >> 5); scr[kk * 33 + (lane & 31)] = tv[i]; }
    LDS_WAIT();
    const int c = lane & 7;
#pragma unroll
    for (int j = 0; j < 4; ++j) { const int n = (lane >> 3) + 8 * j; const LAS float* s = scr + (8 * c) * 33 + n;
        v4u o; o.x = pk2(s[0 * 33], s[1 * 33]); o.y = pk2(s[2 * 33], s[3 * 33]); o.z = pk2(s[4 * 33], s[5 * 33]); o.w = pk2(s[6 * 33], s[7 * 33]);
        *(v4u*)(WT + (size_t)(dest_row0 + n) * K + k0 + 8 * c) = o; }
    LDS_WAIT();
}

constexpr int I_WI = 16 * 176, I_WO = 44 * 32, I_WIN = 16 * 121, I_WOUT = 16 * 32, I_ADA = 16 * 288;
constexpr int I_MAIN = 2 * I_WI + 2 * I_WO + I_WIN + I_WOUT, I_LAYER = I_MAIN + I_ADA;
__device__ __forceinline__ void convert_item(const Args& args, unsigned char* ws, int l, int r, LAS float* scr, int lane) {
    unsigned char* wl = ws + WS_W + (size_t)l * W_LAYER;
    if (r < 2 * (I_WI + I_WO)) {
        const int f = r / (I_WI + I_WO); r -= f * (I_WI + I_WO);
        if (r < I_WI) {
            const int kb = r / 176, nb = r % 176, n0 = nb * 32;
            const int half = n0 / DFF, j = n0 - half * DFF, t = j >> 7, jj = j & 127;
            transpose_item((f ? args.in[15] : args.in[13]) + (size_t)l * D * NWI, D, NWI, (bf16*)(wl + (f ? W_WI2 : W_WI1)), 256 * t + 128 * half + jj, scr, kb * 64, n0, lane);
        } else { r -= I_WI;
            const int kb = r / 32, nb = r % 32;
            transpose_item((f ? args.in[16] : args.in[14]) + (size_t)l * DFF * D, DFF, D, (bf16*)(wl + (f ? W_WO2 : W_WO1)), nb * 32, scr, kb * 64, nb * 32, lane);
        }
        return;
    }
    r -= 2 * (I_WI + I_WO);
    if (r < I_WIN) { const int kb = r / 121, nb = r % 121;
        transpose_item(args.in[17] + (size_t)l * D * NIN, D, NIN, (bf16*)(wl + W_WIN), nb * 32, scr, kb * 64, nb * 32, lane); return; }
    r -= I_WIN;
    if (r < I_WOUT) { const int kb = r / 32, nb = r % 32;
        transpose_item(args.in[27] + (size_t)l * D * D, D, D, (bf16*)(wl + W_WOUT), nb * 32, scr, kb * 64, nb * 32, lane); return; }
    r -= I_WOUT;
    { const int kb = r / 288, nb = r % 288;
        transpose_item(args.in[9] + (size_t)l * D * NMODC, D, NMODC, (bf16*)(ws + WS_BIG), l * NMODC + nb * 32, scr, kb * 64, nb * 32, lane); }
}

__device__ __forceinline__ void p0_prologue(const Args& args, LAS unsigned char* lds_) {
    const Ctx C = make_ctx(args, lds_);
    LAS float* scr = (LAS float*)(C.lds + C.wave * 16384);
    for (int it = C.gw; it < 2 * I_ADA; it += C.NGW) convert_item(args, C.ws, it / I_ADA, I_MAIN + it % I_ADA, scr, C.lane);
    const int gt = C.gw * 64 + C.lane, NGT = C.NGW * 64;
    for (int i = gt; i < 2 * 224 * 128; i += NGT) { const int l = i / (224 * 128), rr = (i / 128) % 224, ch = i & 127;
        *(v4u*)(C.ws + WS_W + (size_t)l * W_LAYER + W_WIN + ((size_t)(3872 + rr) * 1024 + ch * 8) * 2) = (v4u){0u, 0u, 0u, 0u}; }
    for (int i = gt; i < 2048; i += NGT) ((float*)(C.ws + WS_ID))[i] = i < 1024 ? 1.0f : 0.f;
    for (int i = gt; i < 256 * 256; i += NGT) { const int row = i >> 8, c4 = (i & 255) * 4;
        v2u o = (v2u){0u, 0u};
        if (row < NB) { const float* src = row < BP ? args.in[7] + (size_t)row * D : args.in[8] + (size_t)(row - BP) * D; const f32x4 v = *(const f32x4*)(src + c4);
            o.x = pk2(siluf_(v.x), siluf_(v.y)); o.y = pk2(siluf_(v.z), siluf_(v.w)); }
        *(v2u*)(C.ws + WS_AC + ((size_t)row * D + c4) * 2) = o; }
    for (int i = gt; i < 2052 * 32; i += NGT) { const int p = i >> 5, j = i & 31; const double pos = p < 2048 ? (double)p : (double)(16384 + (p - 2048));
        double inv = 1.0; for (int q = 0; q < j; ++q) inv *= 0.7498942093324559;
        const double ang = pos * inv; const double n = rint(ang * 0.15915494309189535);
        const float rr = (float)((ang - n * 6.283185307179586) - n * 2.4492935982947064e-16);
        ((f32x2*)(C.ws + WS_ROPE))[i] = (f32x2){__cosf(rr), __sinf(rr)}; }
}

__device__ __forceinline__ void p1_convert(const Args& args, LAS unsigned char* lds_) {
    const Ctx C = make_ctx(args, lds_);
    if ((int)blockIdx.x < 72) return;
    LAS float* scr = (LAS float*)(C.lds + C.wave * 16384);
    constexpr int I_F0 = I_WI + I_WO, I_P0 = I_F0 + I_WIN;
    for (int it = ((int)blockIdx.x - 72) * NWAVES + C.wave; it < I_P0; it += 184 * NWAVES) {
        if (it < I_F0) convert_item(args, C.ws, 0, it, scr, C.lane);
        else convert_item(args, C.ws, 0, 2 * I_F0 + (it - I_F0), scr, C.lane);
    }
}

__device__ __forceinline__ void p2_modulate0(const Args& args, LAS unsigned char* lds_) {
    const Ctx C = make_ctx(args, lds_);
    const float* MOD = (const float*)(C.ws + WS_MOD); bf16* H = (bf16*)(C.ws + WS_H);
    auto rowp = [&](int r) { return r < MP ? args.in[0] + (size_t)r * D : args.in[1] + (size_t)(r - MP) * D; };
    f32x4 nx[4], nsh[4], nsc[4];
    auto ld = [&](int r) { const float* xr = rowp(r); const float* modr = MOD + (size_t)batch_of_row(r) * NMODC;
#pragma unroll
        for (int j = 0; j < 4; ++j) { const int c = (C.lane + 64 * j) * 4; nx[j] = *(const f32x4*)(xr + c); nsh[j] = *(const f32x4*)(modr + c); nsc[j] = *(const f32x4*)(modr + 1024 + c); } };
    if (C.gw < M) ld(C.gw);
#pragma unroll 1
    for (int r = C.gw; r < M; r += C.NGW) {
        f32x4 v[4], sh[4], sc[4];
#pragma unroll
        for (int j = 0; j < 4; ++j) { v[j] = nx[j]; sh[j] = nsh[j]; sc[j] = nsc[j]; }
        if (r + C.NGW < M) ld(r + C.NGW);
        if (C.lane == 0) *(f32x2*)((float*)(C.ws + WS_STATS) + 2 * (size_t)r) = (f32x2){0.f, 1.0f};
#pragma unroll
        for (int j = 0; j < 4; ++j) { const int c = (C.lane + 64 * j) * 4;
            const f32x4 h = v[j] * (sc[j] + 1.0f) + sh[j];
            if (r >= MP) *(f32x4*)(C.out + (size_t)r * D + c) = v[j] * ALPHA;
            *(v2u*)(H + (size_t)r * D + c) = (v2u){pk2(h.x, h.y), pk2(h.z, h.w)}; }
    }
}

__device__ __forceinline__ void ln_phase(const Args& args, LAS unsigned char* lds_, int l, int which, bool write_h, int hl, int shc, int npart, float xscale, bool write_x) {
    const Ctx C = make_ctx(args, lds_);
    const float* MOD = (const float*)(C.ws + WS_MOD); bf16* H = (bf16*)(C.ws + WS_H);
    const float* g = args.in[11] + (size_t)(l * 3 + which) * D; const float* b = args.in[12] + (size_t)(l * 3 + which) * D;
    f32x4 nv[4], gg[4], bb[4];
#pragma unroll
    for (int j = 0; j < 4; ++j) { gg[j] = *(const f32x4*)(g + (C.lane + 64 * j) * 4); bb[j] = *(const f32x4*)(b + (C.lane + 64 * j) * 4); }
    f32x4 nw[4];
    if (C.gw < M) {
#pragma unroll
        for (int j = 0; j < 4; ++j) nv[j] = *(const f32x4*)(C.out + (size_t)C.gw * D + (C.lane + 64 * j) * 4); }
    if (C.gw + C.NGW < M) {
#pragma unroll
        for (int j = 0; j < 4; ++j) nw[j] = *(const f32x4*)(C.out + (size_t)(C.gw + C.NGW) * D + (C.lane + 64 * j) * 4); }
#pragma unroll 1
    for (int r = C.gw; r < M; r += C.NGW) {
        float* xr = C.out + (size_t)r * D;
        f32x4 v[4]; float s = 0.f;
        const float* modr = MOD + (size_t)(hl * NB + batch_of_row(r)) * NMODC + shc * 1024;
        f32x4 msh[4], msc[4];
        if (write_h) {
#pragma unroll
            for (int j = 0; j < 4; ++j) { msh[j] = *(const f32x4*)(modr + (C.lane + 64 * j) * 4); msc[j] = *(const f32x4*)(modr + 1024 + (C.lane + 64 * j) * 4); } }
#pragma unroll
        for (int j = 0; j < 4; ++j) { v[j] = nv[j]; nv[j] = nw[j]; }
        if (r + 2 * C.NGW < M) {
#pragma unroll
            for (int j = 0; j < 4; ++j) nw[j] = *(const f32x4*)(xr + (size_t)(2 * C.NGW) * D + (C.lane + 64 * j) * 4); }
        if (r >= MP) { const float* pp = (const float*)(C.ws + WS_SB) + (size_t)(r - MP) * D;
#pragma unroll 1
            for (int p = 0; p < npart; p += 4, pp += 4 * 512 * 1024) {
                f32x4 t[4][4];
#pragma unroll
                for (int q = 0; q < 4; ++q) { const float* pq = pp + (size_t)(p + q < npart ? q : 0) * (512 * 1024);
#pragma unroll
                    for (int j = 0; j < 4; ++j) t[q][j] = *(const f32x4*)(pq + (C.lane + 64 * j) * 4); }
#pragma unroll
                for (int q = 0; q < 4; ++q) if (p + q < npart) {
#pragma unroll
                    for (int j = 0; j < 4; ++j) v[j] += t[q][j]; } } }
#pragma unroll
        for (int j = 0; j < 4; ++j) s += (v[j].x + v[j].y) + (v[j].z + v[j].w);
        const float mean = wave_sum2(s) * (1.f / D); float s2 = 0.f;
#pragma unroll
        for (int j = 0; j < 4; ++j) { v[j] = v[j] - mean; s2 += (v[j].x * v[j].x + v[j].y * v[j].y) + (v[j].z * v[j].z + v[j].w * v[j].w); }
        const float rstd = rsqrtf(wave_sum2(s2) * (1.f / D) + LN_EPS);
        if (C.lane == 0) *(f32x2*)((float*)(C.ws + WS_STATS) + 2 * (size_t)r) = (f32x2){mean, rstd};
#pragma unroll
        for (int j = 0; j < 4; ++j) { const int c = (C.lane + 64 * j) * 4;
            const f32x4 xn = v[j] * rstd * gg[j] + bb[j];
            if (write_x || r >= MP) *(f32x4*)(xr + c) = xn * xscale;
            if (write_h) { const f32x4 sh = msh[j], sc = msc[j]; const f32x4 h = xn * (sc + 1.0f) + sh;
                *(v2u*)(H + (size_t)r * D + c) = (v2u){pk2(h.x, h.y), pk2(h.z, h.w)}; }
        }
    }
}

struct PrepRaw { v2u rq, rqp, rk, rkp, hf, hq, dq, dk, dv; unsigned aq; unsigned short db, da; v4u alr0, alr1; f32x4 cs0, cs1; };
__device__ __forceinline__ void prep_load(PrepRaw& x, const bf16* P, int lane, const f32x2* rope_row) {
    const int c = lane * 4;
    const f32x4* cp = (const f32x4*)(rope_row + (c & 31)); x.cs0 = cp[0]; x.cs1 = cp[1];
    x.rq = *(const v2u*)(P + C_RQ + c); x.rqp = *(const v2u*)(P + C_RQ + (c ^ 32)); x.rk = *(const v2u*)(P + C_RK + c); x.rkp = *(const v2u*)(P + C_RK + (c ^ 32));
    x.alr0 = *(const v4u*)(P + C_ALR); x.alr1 = *(const v4u*)(P + C_ALR + 8);
    x.aq = *(const unsigned*)(P + C_AQ + lane * 2);
    x.hf = *(const v2u*)(P + C_HF + c); x.hq = *(const v2u*)(P + C_HQ + c);
    x.dq = *(const v2u*)(P + C_DQKV + c); x.dk = *(const v2u*)(P + C_DQKV + 256 + c); x.dv = *(const v2u*)(P + C_DQKV + 512 + c);
    x.db = P[C_DB + (lane & 3)]; x.da = P[C_DA + (lane & 3)];
}
__device__ __forceinline__ void unpack4(const v2u w, float (&o)[4]) { o[0] = bflo(w.x); o[1] = bfhi(w.x); o[2] = bflo(w.y); o[3] = bfhi(w.y); }

__device__ __forceinline__ void prep_phase(const Args& args, LAS unsigned char* lds_, int l) {
    const Ctx C = make_ctx(args, lds_);
    const bf16* PROJ = (const bf16*)(C.ws + WS_BIG); bf16* SB = (bf16*)(C.ws + WS_SB); float* SF = (float*)(C.ws + WS_SF);
    const f32x2* ROPE = (const f32x2*)(C.ws + WS_ROPE);
    const int lane = C.lane, c4 = lane * 4;
    const float* wg = args.in[18] + (size_t)l * 16 * 128; const float* bg = args.in[19] + (size_t)l * 128;
    const float* cw = args.in[21] + (size_t)l * 4 * 768;
    LAS float* lwg = (LAS float*)C.lds; LAS float* lcw = lwg + 16 * 128;
    for (int i = C.tid; i < 16 * 128; i += NWAVES * 64) lwg[i] = wg[i];
    for (int i = C.tid; i < 4 * 768; i += NWAVES * 64) lcw[i] = cw[i];
    __syncthreads();
    constexpr int CH = 9;
    const int r0 = C.gw * CH, r1 = min(r0 + CH, M);
    if (r0 >= M) return;
    float lbv[4];
#pragma unroll
    for (int i = 0; i < 4; ++i) { lbv[i] = 0.f; if (l == 1) lbv[i] = 1.0f / (1.0f + expf(args.in[20][c4 + i] - args.in[20][256 + c4 + i])); }
    const float a_neg = -expf(args.in[22][l * 4 + (lane & 3)]), dtb = args.in[23][l * 4 + (lane & 3)];
    const float bg0 = bg[lane * 2], bg1 = bg[lane * 2 + 1];
    float w1[3][4], w2[3][4], w3[3][4];
    auto load_window = [&](int r) {
        const bool isp = r < MP; const int rs = r - MP; const int b = isp ? (r >> 11) : (rs >> 2), t = isp ? (r & 2047) : (rs & 3);
        const float* cst = args.in[6] + ((size_t)(l * BS + b) * 3) * 768;
#pragma unroll
        for (int g = 0; g < 3; ++g) { const int ch = g * 256 + c4; const bf16* Pc = PROJ + (size_t)r * NINP + C_DQKV + ch;
            if (t >= 1) unpack4(*(const v2u*)(Pc - 1 * NINP), w1[g]); else { const f32x4 z = isp ? (f32x4){0.f, 0.f, 0.f, 0.f} : *(const f32x4*)(cst + 2 * 768 + ch); w1[g][0] = z.x; w1[g][1] = z.y; w1[g][2] = z.z; w1[g][3] = z.w; }
            if (t >= 2) unpack4(*(const v2u*)(Pc - 2 * NINP), w2[g]); else { const f32x4 z = isp ? (f32x4){0.f, 0.f, 0.f, 0.f} : *(const f32x4*)(cst + (1 + t) * 768 + ch); w2[g][0] = z.x; w2[g][1] = z.y; w2[g][2] = z.z; w2[g][3] = z.w; }
            if (t >= 3) unpack4(*(const v2u*)(Pc - 3 * NINP), w3[g]); else { const f32x4 z = isp ? (f32x4){0.f, 0.f, 0.f, 0.f} : *(const f32x4*)(cst + t * 768 + ch); w3[g][0] = z.x; w3[g][1] = z.y; w3[g][2] = z.z; w3[g][3] = z.w; } }
    };
    auto rope_of = [&](int r) { return ROPE + (size_t)(r < MP ? (r & 2047) : 2048 + ((r - MP) & 3)) * 32; };
    PrepRaw A; prep_load(A, PROJ + (size_t)r0 * NINP, lane, rope_of(r0));
    load_window(r0);
    const bool hi = (c4 & 32) != 0;
#pragma unroll 1
    for (int r = r0; r < r1; ++r) {
        PrepRaw B = A;
        if (r + 1 < r1) prep_load(B, PROJ + (size_t)(r + 1) * NINP, lane, rope_of(r + 1));
        int zo = 0; asm volatile("" : "+v"(zo));
        const bool isp = r < MP; const int rs = r - MP;
        const int b = isp ? (r >> 11) : (rs >> 2), t = isp ? (r & 2047) : (rs & 3);
        bf16* sb = SB + (size_t)r * SBW; float* sf = SF + (size_t)r * SFW;
        { float q[4], qp[4], k[4], kp[4], qo[4], ko[4]; unpack4(A.rq, q); unpack4(A.rqp, qp); unpack4(A.rk, k); unpack4(A.rkp, kp);
          const float cs[8] = {A.cs0.x, A.cs0.y, A.cs0.z, A.cs0.w, A.cs1.x, A.cs1.y, A.cs1.z, A.cs1.w};
#pragma unroll
          for (int e = 0; e < 4; ++e) { const float co = cs[2 * e], si = cs[2 * e + 1];
              qo[e] = hi ? (qp[e] * si + q[e] * co) : (q[e] * co - qp[e] * si);
              ko[e] = (hi ? (kp[e] * si + k[e] * co) : (k[e] * co - kp[e] * si)) * 0.125f; }
          *(v2u*)(sb + SB_RQ + c4) = (v2u){pk2(qo[0], qo[1]), pk2(qo[2], qo[3])};
          *(v2u*)(sb + SB_RK + c4) = (v2u){pk2(ko[0], ko[1]), pk2(ko[2], ko[3])}; }
        { const unsigned aw[8] = {A.alr0.x, A.alr0.y, A.alr0.z, A.alr0.w, A.alr1.x, A.alr1.y, A.alr1.z, A.alr1.w};
          float x0 = bg0, x1 = bg1;
#pragma unroll
          for (int i = 0; i < 8; ++i) { const float a0 = bflo(aw[i]), a1 = bfhi(aw[i]);
              const f32x2 wa = *(const LAS f32x2*)(lwg + (2 * i) * 128 + lane * 2 + zo), wb = *(const LAS f32x2*)(lwg + (2 * i + 1) * 128 + lane * 2 + zo);
              x0 += a0 * wa.x + a1 * wb.x; x1 += a0 * wa.y + a1 * wb.y; }
          const float sp0 = fmaxf(-x0, 0.f) + __logf(1.0f + __expf(-fabsf(x0))), sp1 = fmaxf(-x1, 0.f) + __logf(1.0f + __expf(-fabsf(x1)));
          *(f32x2*)(sf + SF_ADEC + lane * 2) = (f32x2){__expf(-sp0 * (1.0f / 16.0f)), __expf(-sp1 * (1.0f / 16.0f))};
          *(unsigned*)(sb + SB_AQ + lane * 2) = pk2(bflo(A.aq) * 0.17677669529663687f, bfhi(A.aq) * 0.17677669529663687f); }
        { float zf[4], zq[4], fo[4], qo[4]; unpack4(A.hf, zf); unpack4(A.hq, zq);
#pragma unroll
          for (int e = 0; e < 4; ++e) { fo[e] = lbv[e] + (1.0f - lbv[e]) * sigmoidf_(zf[e]); qo[e] = siluf_(zq[e]) * 0.125f; }
          *(f32x4*)(sf + SF_HF + c4) = (f32x4){fo[0], fo[1], fo[2], fo[3]};
          *(v2u*)(sb + SB_HQ + c4) = (v2u){pk2(qo[0], qo[1]), pk2(qo[2], qo[3])}; }
        { float* cso = isp ? C.out + O_PCONV + ((size_t)(l * BP + b) * 3) * 768 : C.out + O_SCONV + ((size_t)(l * BS + b) * 3) * 768;
          const int so = isp ? t - (TP - 3) : t - 1;
          float uu[3][4];
#pragma unroll
          for (int g = 0; g < 3; ++g) { float x0[4]; unpack4(g == 0 ? A.dq : g == 1 ? A.dk : A.dv, x0);
              const LAS float* cwc = lcw + g * 256 + c4 + zo;
              const f32x4 k0 = *(const LAS f32x4*)(cwc), k1 = *(const LAS f32x4*)(cwc + 768), k2 = *(const LAS f32x4*)(cwc + 2 * 768), k3 = *(const LAS f32x4*)(cwc + 3 * 768);
#pragma unroll
              for (int e = 0; e < 4; ++e) { uu[g][e] = siluf_(x0[e] * k3[e] + w1[g][e] * k2[e] + w2[g][e] * k1[e] + w3[g][e] * k0[e]);
                  w3[g][e] = w2[g][e]; w2[g][e] = w1[g][e]; w1[g][e] = x0[e]; }
              if (so >= 0) *(f32x4*)(cso + so * 768 + g * 256 + c4) = (f32x4){x0[0], x0[1], x0[2], x0[3]}; }
          const float qn = row16_sum(uu[0][0] * uu[0][0] + uu[0][1] * uu[0][1] + uu[0][2] * uu[0][2] + uu[0][3] * uu[0][3]);
          const float kn = row16_sum(uu[1][0] * uu[1][0] + uu[1][1] * uu[1][1] + uu[1][2] * uu[1][2] + uu[1][3] * uu[1][3]);
          const float qs = rsqrtf(qn + RMS_EPS) * 0.125f, ks = rsqrtf(kn + RMS_EPS);
          const unsigned q01 = pk2(uu[0][0] * qs, uu[0][1] * qs), q23 = pk2(uu[0][2] * qs, uu[0][3] * qs), k01 = pk2(uu[1][0] * ks, uu[1][1] * ks), k23 = pk2(uu[1][2] * ks, uu[1][3] * ks);
          *(v2u*)(sb + SB_DQ + c4) = (v2u){q01, q23}; *(v2u*)(sb + SB_DK + c4) = (v2u){k01, k23};
          *(v2u*)(sb + SB_DV + c4) = (v2u){pk2(uu[2][0], uu[2][1]), pk2(uu[2][2], uu[2][3])};
          const float qk = row16_sum(bflo(q01) * bflo(k01) + bfhi(q01) * bfhi(k01) + bflo(q23) * bflo(k23) + bfhi(q23) * bfhi(k23));
          if ((lane & 15) == 0) sf[SF_QK + (lane >> 4)] = qk;
          if (lane < 4) { sf[SF_BETA + lane] = sigmoidf_(bf2f(A.db));
              const float xx = bf2f(A.da) + dtb; const float sp = fmaxf(xx, 0.f) + __logf(1.0f + __expf(-fabsf(xx)));
              sf[SF_DDEC + lane] = __expf(a_neg * sp); } }
        A = B;
        if (r + 1 < r1) { const int rn = r + 1; const bool ns = rn < MP ? ((rn & 2047) == 0) : (((rn - MP) & 3) == 0); if (ns) load_window(rn); }
    }
}

template <int KIND, int DH, int R> struct Raw { unsigned q[DH / 2]; unsigned k[DH / 2]; unsigned v[(R + 1) / 2]; float f[DH]; float be, de; };

template <int KIND, int DH, int R>
__device__ __forceinline__ void load_tok(Raw<KIND, DH, R>& x, const bf16* qp, const bf16* kp, const bf16* vp, const float* fp) {
    if constexpr (DH == 4) { const v2u w = *(const v2u*)qp; x.q[0] = w.x; x.q[1] = w.y; } else { x.q[0] = *(const unsigned*)qp; }
    if constexpr (KIND != 2) { if constexpr (DH == 4) { const v2u w = *(const v2u*)kp; x.k[0] = w.x; x.k[1] = w.y; } else { x.k[0] = *(const unsigned*)kp; } }
    if constexpr (R == 1) x.v[0] = *vp; else if constexpr (R == 2) x.v[0] = *(const unsigned*)vp; else { const v2u w = *(const v2u*)vp; x.v[0] = w.x; x.v[1] = w.y; }
    if constexpr (KIND == 1) { const f32x2 w = *(const f32x2*)fp; x.f[0] = w.x; x.f[1] = w.y; }
    if constexpr (KIND == 2) { const f32x4 w = *(const f32x4*)fp; x.f[0] = w.x; x.f[1] = w.y; x.f[2] = w.z; x.f[3] = w.w; }
    if constexpr (KIND == 3) { x.be = fp[0]; x.de = fp[4]; }
}

template <int KIND, int DH, int R>
__device__ __forceinline__ void scan_task(const Ctx& C, int row0, int T, int h, int slice, const float* sin, float* sout) {
    const bf16* PROJ = (const bf16*)(C.ws + WS_BIG); const bf16* SB = (const bf16*)(C.ws + WS_SB); const float* SF = (const float*)(C.ws + WS_SF);
    bf16* H = (bf16*)(C.ws + WS_H);
    const int lane = C.lane, dl = lane & 15, rw = lane >> 4;
    const int d0 = dl * DH, v0 = slice * (4 * R) + rw * R;
    constexpr int DK = 16 * DH;
    const bf16 *qp, *kp, *vp; const float* fp; int ks, vs;
    const bf16* sbr = SB + (size_t)row0 * SBW; const bf16* pr = PROJ + (size_t)row0 * NINP; const float* sfr = SF + (size_t)row0 * SFW;
    if constexpr (KIND == 0) { qp = sbr + SB_RQ + h * 64 + d0; kp = sbr + SB_RK + h * 64 + d0; ks = SBW; vp = pr + C_RV + h * 64 + v0; vs = NINP; fp = sfr; }
    if constexpr (KIND == 1) { qp = sbr + SB_AQ + h * 32 + d0; kp = pr + C_AK + h * 32 + d0; ks = NINP; vp = pr + C_AV + h * 64 + v0; vs = NINP; fp = sfr + SF_ADEC + h * 32 + d0; }
    if constexpr (KIND == 2) { qp = sbr + SB_HQ + h * 64 + d0; kp = sbr; ks = SBW; vp = pr + C_HI + h * 64 + v0; vs = NINP; fp = sfr + SF_HF + h * 64 + d0; }
    if constexpr (KIND == 3) { qp = sbr + SB_DQ + h * 64 + d0; kp = sbr + SB_DK + h * 64 + d0; ks = SBW; vp = sbr + SB_DV + h * 64 + v0; vs = SBW; fp = sfr + SF_BETA + h; }
    bf16* op = H + (size_t)row0 * D + KIND * 256 + h * 64 + v0;
    const float rdec = 1.0f - exp2f(-5.0f - (float)h);

    float S[DH][R];
#pragma unroll
    for (int dh = 0; dh < DH; ++dh)
#pragma unroll
        for (int vv = 0; vv < R; ++vv) S[dh][vv] = sin ? sin[(size_t)(d0 + dh) * 64 + v0 + vv] : 0.f;

    typedef Raw<KIND, DH, R> RawT;
    RawT A[4];
#pragma unroll
    for (int u = 0; u < 4; ++u) load_tok<KIND, DH, R>(A[u], qp + (size_t)u * SBW, kp + (size_t)u * ks, vp + (size_t)u * vs, fp + (size_t)u * SFW);
    for (int t0 = 0; t0 < T; t0 += 4) {
        RawT B[4];
        const bool more = t0 + 4 < T;
#pragma unroll
        for (int u = 0; u < 4; ++u) { B[u] = A[u]; }
        if (more) {
#pragma unroll
            for (int u = 0; u < 4; ++u) load_tok<KIND, DH, R>(B[u], qp + (size_t)(t0 + 4 + u) * SBW, kp + (size_t)(t0 + 4 + u) * ks, vp + (size_t)(t0 + 4 + u) * vs, fp + (size_t)(t0 + 4 + u) * SFW);
        }
#pragma unroll
        for (int u = 0; u < 4; ++u) {
            const RawT& x = A[u];
            float q[DH], k[DH], v[R];
            q[0] = bflo(x.q[0]); q[1] = bfhi(x.q[0]); if constexpr (DH == 4) { q[2] = bflo(x.q[1]); q[3] = bfhi(x.q[1]); }
            if constexpr (KIND != 2) { k[0] = bflo(x.k[0]); k[1] = bfhi(x.k[0]); if constexpr (DH == 4) { k[2] = bflo(x.k[1]); k[3] = bfhi(x.k[1]); } }
            if constexpr (R == 1) v[0] = bflo(x.v[0]);
            if constexpr (R >= 2) { v[0] = bflo(x.v[0]); v[1] = bfhi(x.v[0]); }
            if constexpr (R == 4) { v[2] = bflo(x.v[1]); v[3] = bfhi(x.v[1]); }
            float o[R];
            if constexpr (KIND == 3) {
                float ks_[R];
#pragma unroll
                for (int vv = 0; vv < R; ++vv) { float p = 0.f;
#pragma unroll
                    for (int dh = 0; dh < DH; ++dh) { S[dh][vv] *= x.de; p += k[dh] * S[dh][vv]; }
                    ks_[vv] = row16_sum(p); }
#pragma unroll
                for (int vv = 0; vv < R; ++vv) { const float uu = x.be * (v[vv] - ks_[vv]); float p = 0.f;
#pragma unroll
                    for (int dh = 0; dh < DH; ++dh) { S[dh][vv] += k[dh] * uu; p += q[dh] * S[dh][vv]; }
                    o[vv] = row16_sum(p); }
            } else {
#pragma unroll
                for (int dh = 0; dh < DH; ++dh) {
                    float dec, kk;
                    if constexpr (KIND == 0) { dec = rdec; kk = k[dh]; }
                    if constexpr (KIND == 1) { dec = x.f[dh]; kk = k[dh]; }
                    if constexpr (KIND == 2) { dec = x.f[dh]; kk = 1.0f - x.f[dh]; }
#pragma unroll
                    for (int vv = 0; vv < R; ++vv) S[dh][vv] = dec * S[dh][vv] + kk * v[vv];
                }
#pragma unroll
                for (int vv = 0; vv < R; ++vv) { float p = 0.f;
#pragma unroll
                    for (int dh = 0; dh < DH; ++dh) p += q[dh] * S[dh][vv];
                    o[vv] = row16_sum(p); }
            }
            if (dl == 0) {
                bf16* o_ = op + (size_t)(t0 + u) * D;
                if constexpr (R == 1) *o_ = (bf16)(pk2(o[0], 0.f) & 0xffffu);
                if constexpr (R == 2) *(unsigned*)o_ = pk2(o[0], o[1]);
                if constexpr (R == 4) *(v2u*)o_ = (v2u){pk2(o[0], o[1]), pk2(o[2], o[3])};
            }
        }
#pragma unroll
        for (int u = 0; u < 4; ++u) A[u] = B[u];
    }
#pragma unroll
    for (int dh = 0; dh < DH; ++dh)
#pragma unroll
        for (int vv = 0; vv < R; ++vv) sout[(size_t)(d0 + dh) * 64 + v0 + vv] = S[dh][vv];
    (void)DK;
}

template <int KIND, int DH, int R>
__device__ __forceinline__ void scan_long(const Ctx& C, LAS float* wl, int row0, int T, int h, int slice, float* sout) {
    constexpr int CT = 16, LR = 8, DK = LR * DH, NV = (64 / LR) * R, UNR = 8;
    constexpr bool HASK = true, GK = (KIND != 2), HASF = (KIND == 1 || KIND == 2), HASB = (KIND == 3);
    constexpr int OQ = 0, OK_ = OQ + CT * DK, OF = OK_ + (HASK ? CT * DK : 0), OV = OF + (HASF ? CT * DK : 0), OB = OV + CT * NV, BUF = OB + (HASB ? CT * 4 : 0);
    const bf16* PROJ = (const bf16*)(C.ws + WS_BIG); const bf16* SB = (const bf16*)(C.ws + WS_SB); const float* SF = (const float*)(C.ws + WS_SF);
    bf16* H = (bf16*)(C.ws + WS_H);
    const int lane = C.lane, dl = lane & (LR - 1), rw = lane / LR;
    const int d0 = dl * DH;
    const int stok = lane >> 2, spart = lane & 3;
    const GAS bf16 *qg, *kg, *vg; const GAS float *fg, *bg; int ks, vs;
    {
        const GAS bf16* sbr = (const GAS bf16*)(SB + (size_t)row0 * SBW); const GAS bf16* pr = (const GAS bf16*)(PROJ + (size_t)row0 * NINP); const GAS float* sfr = (const GAS float*)(SF + (size_t)row0 * SFW);
        const int vcol = slice * NV;
        if constexpr (KIND == 0) { qg = sbr + SB_RQ + h * 64; kg = sbr + SB_RK + h * 64; ks = SBW; vg = pr + C_RV + h * 64 + vcol; vs = NINP; fg = sfr; bg = sfr; }
        if constexpr (KIND == 1) { qg = sbr + SB_AQ + h * 32; kg = pr + C_AK + h * 32; ks = NINP; vg = pr + C_AV + h * 64 + vcol; vs = NINP; fg = sfr + SF_ADEC + h * 32; bg = sfr; }
        if constexpr (KIND == 2) { qg = sbr + SB_HQ + h * 64; kg = sbr; ks = SBW; vg = pr + C_HI + h * 64 + vcol; vs = NINP; fg = sfr + SF_HF + h * 64; bg = sfr; }
        if constexpr (KIND == 3) { qg = sbr + SB_DQ + h * 64; kg = sbr + SB_DK + h * 64; ks = SBW; vg = sbr + SB_DV + h * 64 + vcol; vs = SBW; fg = sfr; bg = sfr + SF_BETA + h; }
    }
    constexpr int QP = DK / 4;
    qg += (size_t)stok * SBW + spart * QP; kg += (size_t)stok * ks + spart * QP; fg += (size_t)stok * SFW + spart * QP;
    vg += (size_t)(lane & 15) * vs; bg += (size_t)(lane & 15) * SFW;
    GAS bf16* op = (GAS bf16*)(H + (size_t)row0 * D + KIND * 256 + h * 64 + slice * NV + rw * R);
    const float rdec = 1.0f - exp2f(-5.0f - (float)h);

    static_assert(R == 1, "scan_long: one column per lane row");
    f32x2 S2[DH / 2];
#pragma unroll
    for (int i = 0; i < DH / 2; ++i) S2[i] = (f32x2){0.f, 0.f};

    struct SR { v4u rq[QP / 8], rk[QP / 8]; f32x4 rf[QP / 4]; unsigned rv[NV / 2]; float rb0, rb1, rb2; };
    SR s0; s0.rb0 = s0.rb1 = s0.rb2 = 0.f;
    auto stage_load = [&](SR& sr, int c) {
        const size_t t = (size_t)c * CT;
#pragma unroll
        for (int i = 0; i < QP / 8; ++i) { sr.rq[i] = *(const GAS v4u*)(qg + t * SBW + i * 8); if constexpr (GK) sr.rk[i] = *(const GAS v4u*)(kg + t * ks + i * 8); }
        if constexpr (HASF) {
#pragma unroll
            for (int i = 0; i < QP / 4; ++i) sr.rf[i] = *(const GAS f32x4*)(fg + t * SFW + i * 4); }
        if (lane < 16) {
            if constexpr (NV == 4) { const v2u w = *(const GAS v2u*)(vg + t * vs); sr.rv[0] = w.x; sr.rv[1] = w.y; }
            if constexpr (NV == 8) { const v4u w = *(const GAS v4u*)(vg + t * vs); sr.rv[0] = w.x; sr.rv[1] = w.y; sr.rv[2] = w.z; sr.rv[3] = w.w; }
            if constexpr (NV == 16) { const v4u w = *(const GAS v4u*)(vg + t * vs), w2 = *(const GAS v4u*)(vg + t * vs + 8); sr.rv[0] = w.x; sr.rv[1] = w.y; sr.rv[2] = w.z; sr.rv[3] = w.w; sr.rv[4] = w2.x; sr.rv[5] = w2.y; sr.rv[6] = w2.z; sr.rv[7] = w2.w; }
            if constexpr (HASB) { sr.rb0 = bg[t * SFW]; sr.rb1 = bg[t * SFW + 4]; sr.rb2 = bg[t * SFW + 8]; }
        }
    };
    auto stage_write = [&](SR& sr, int b) {
        LAS float* base = wl + b * BUF;
#pragma unroll
        for (int i = 0; i < QP / 8; ++i) {
            LAS float* qd = base + OQ + stok * DK + spart * QP + i * 8;
            *(LAS f32x4*)qd = (f32x4){bflo(sr.rq[i].x), bfhi(sr.rq[i].x), bflo(sr.rq[i].y), bfhi(sr.rq[i].y)}; *(LAS f32x4*)(qd + 4) = (f32x4){bflo(sr.rq[i].z), bfhi(sr.rq[i].z), bflo(sr.rq[i].w), bfhi(sr.rq[i].w)};
            if constexpr (GK) { LAS float* kd = base + OK_ + stok * DK + spart * QP + i * 8;
                *(LAS f32x4*)kd = (f32x4){bflo(sr.rk[i].x), bfhi(sr.rk[i].x), bflo(sr.rk[i].y), bfhi(sr.rk[i].y)}; *(LAS f32x4*)(kd + 4) = (f32x4){bflo(sr.rk[i].z), bfhi(sr.rk[i].z), bflo(sr.rk[i].w), bfhi(sr.rk[i].w)}; }
        }
        if constexpr (HASF) {
#pragma unroll
            for (int i = 0; i < QP / 4; ++i) { *(LAS f32x4*)(base + OF + stok * DK + spart * QP + i * 4) = sr.rf[i];
                if constexpr (KIND == 2) *(LAS f32x4*)(base + OK_ + stok * DK + spart * QP + i * 4) = 1.0f - sr.rf[i]; } }
        if (lane < 16) {
#pragma unroll
            for (int i = 0; i < NV / 2; ++i) { base[OV + lane * NV + 2 * i] = bflo(sr.rv[i]); base[OV + lane * NV + 2 * i + 1] = bfhi(sr.rv[i]); }
            if constexpr (HASB) *(LAS f32x4*)(base + OB + lane * 4) = (f32x4){sr.rb0, sr.rb1, sr.rb2, 0.f};
        }
    };
    static_assert(2 * BUF * 4 <= 26624, "per-wave LDS");
    const int nch = T / CT;
    struct Opnd { f32x2 q2[DH / 2], k2[DH / 2], f2[DH / 2]; float v; f32x4 bd; };
    auto ldop = [&](Opnd& x, const LAS float* bq, const LAS float* bv, const LAS float* bb, int uu) {
#pragma unroll
        for (int i = 0; i < DH / 4; ++i) { const f32x4 w = *(const LAS f32x4*)(bq + OQ + uu * DK + 4 * i); x.q2[2 * i] = (f32x2){w.x, w.y}; x.q2[2 * i + 1] = (f32x2){w.z, w.w}; }
#pragma unroll
        for (int i = 0; i < DH / 4; ++i) { const f32x4 w = *(const LAS f32x4*)(bq + OK_ + uu * DK + 4 * i); x.k2[2 * i] = (f32x2){w.x, w.y}; x.k2[2 * i + 1] = (f32x2){w.z, w.w}; }
        if constexpr (HASF) {
#pragma unroll
            for (int i = 0; i < DH / 4; ++i) { const f32x4 w = *(const LAS f32x4*)(bq + OF + uu * DK + 4 * i); x.f2[2 * i] = (f32x2){w.x, w.y}; x.f2[2 * i + 1] = (f32x2){w.z, w.w}; } }
        x.v = bv[uu * NV];
        if constexpr (HASB) x.bd = *(const LAS f32x4*)(bb + uu * 4);
    };
    auto compute = [&](int c, const LAS float* base) {
#pragma unroll 1
        for (int ub = 0; ub < CT; ub += UNR) {
        float okeep[R];
#pragma unroll
        for (int vv = 0; vv < R; ++vv) okeep[vv] = 0.f;
        Opnd X; X.bd = (f32x4){0.f, 0.f, 0.f, 0.f};
#pragma unroll
        for (int i = 0; i < DH / 2; ++i) X.f2[i] = (f32x2){0.f, 0.f};
        const LAS float* bq = base + ub * DK + d0; const LAS float* bv = base + OV + ub * NV + rw; const LAS float* bb = base + OB + ub * 4;
        ldop(X, bq, bv, bb, 0);
#pragma unroll
        for (int uu_ = 0; uu_ < UNR; ++uu_) { const int u = ub + uu_;
            Opnd Y = X;
            if (uu_ + 1 < UNR) ldop(Y, bq, bv, bb, uu_ + 1);
            f32x2 (&q2)[DH / 2] = X.q2; f32x2 (&k2)[DH / 2] = X.k2; f32x2 (&f2)[DH / 2] = X.f2; const float vv_ = X.v; const f32x4 bd = X.bd;
            float o[1];
            if constexpr (KIND == 3) {
                f32x2 a = k2[0] * S2[0], bq_ = q2[0] * S2[0];
#pragma unroll
                for (int i = 1; i < DH / 2; ++i) { a = __builtin_elementwise_fma(k2[i], S2[i], a); bq_ = __builtin_elementwise_fma(q2[i], S2[i], bq_); }
                const float ks_ = row8_sum(a.x + a.y) * bd.y, qs_ = row8_sum(bq_.x + bq_.y) * bd.y;
                const float uu = bd.x * (vv_ - ks_);
                o[0] = __builtin_fmaf(bd.z, uu, qs_);
                const f32x2 de2 = (f32x2){bd.y, bd.y}, uu2 = (f32x2){uu, uu};
#pragma unroll
                for (int i = 0; i < DH / 2; ++i) S2[i] = __builtin_elementwise_fma(S2[i], de2, k2[i] * uu2);
            } else {
                const f32x2 v2 = (f32x2){vv_, vv_};
#pragma unroll
                for (int i = 0; i < DH / 2; ++i) {
                    f32x2 dec2;
                    if constexpr (KIND == 0) dec2 = (f32x2){rdec, rdec}; else dec2 = f2[i];
                    S2[i] = __builtin_elementwise_fma(S2[i], dec2, k2[i] * v2);
                }
            }
            if constexpr (KIND != 3)
            { f32x2 a = q2[0] * S2[0];
#pragma unroll
              for (int i = 1; i < DH / 2; ++i) a = __builtin_elementwise_fma(q2[i], S2[i], a);
              o[0] = row8_sum(a.x + a.y); }
#pragma unroll
            for (int vv = 0; vv < R; ++vv) okeep[vv] = (dl == uu_) ? o[vv] : okeep[vv];
            X = Y;
        }
        {
            GAS bf16* o_ = op + (size_t)(c * CT + ub + dl) * D;
            if constexpr (R == 1) *o_ = (bf16)(pk2(okeep[0], 0.f) & 0xffffu);
            if constexpr (R == 2) *(GAS unsigned*)o_ = pk2(okeep[0], okeep[1]);
            if constexpr (R == 4) *(GAS v2u*)o_ = (v2u){pk2(okeep[0], okeep[1]), pk2(okeep[2], okeep[3])};
        }
        }
    };
    stage_load(s0, 0); stage_write(s0, 0);
#pragma unroll 1
    for (int c = 0; c < nch; c += 2) {
        stage_load(s0, min(c + 1, nch - 1));
        compute(c, wl);
        stage_write(s0, 1);
        stage_load(s0, min(c + 2, nch - 1));
        compute(c + 1, wl + BUF);
        stage_write(s0, 0);
    }
    const int v0 = slice * NV + rw * R;
#pragma unroll
    for (int i = 0; i < DH / 2; ++i) { sout[(size_t)(d0 + 2 * i) * 64 + v0] = S2[i].x; sout[(size_t)(d0 + 2 * i + 1) * 64 + v0] = S2[i].y; }
}

__device__ __forceinline__ void scan_phase(const Args& args, LAS unsigned char* lds_, int l, int mode = 0) {
    const Ctx C = make_ctx(args, lds_);
    constexpr int NLONG = 1024, NSHORT = BS * 144;
    const int slot = C.wave * 256 + (int)blockIdx.x;
    const int nidle = C.NGW - NLONG - 256;
    for (int it = 0;; ++it) {
        int kind, b, h, slice, row0, T; bool isp;
        if (slot < NLONG) { if (it > 0 || mode == 2) break; isp = true; T = TP;
            const int kk_ = slot >> 8, i = slot & 255; kind = kk_ == 0 ? 3 : (kk_ == 1 ? 0 : (kk_ == 2 ? 2 : 1));
            { const int stream = (i & 7) | ((i >> 6) << 3); slice = (i >> 3) & 7; b = stream >> 2; h = stream & 3; }
            row0 = b * TP;
        } else { if (C.wave < 5) break;
            const int st = (slot - NLONG - 256) + it * nidle; if (st >= NSHORT || mode == 1) break; isp = false; T = TS;
            b = st / 144; int i = st - b * 144;
            if (i < 64) { kind = 3; h = i >> 4; slice = i & 15; }
            else if (i < 96) { i -= 64; kind = 0; h = i >> 3; slice = i & 7; }
            else if (i < 128) { i -= 96; kind = 2; h = i >> 3; slice = i & 7; }
            else { i -= 128; kind = 1; h = i >> 2; slice = i & 3; }
            row0 = MP + b * TS;
        }
        const int nbat = isp ? BP : BS;
        const size_t sidx = (size_t)((l * nbat + b) * 4 + h);
        if (isp) {
            LAS float* wl = (LAS float*)(C.lds + C.wave * 26624);
            if (kind == 0) scan_long<0, 8, 1>(C, wl, row0, T, h, slice, C.out + O_PRET + sidx * 4096);
            else if (kind == 1) scan_long<1, 4, 1>(C, wl, row0, T, h, slice, C.out + O_PGLA + sidx * 2048);
            else if (kind == 2) scan_long<2, 8, 1>(C, wl, row0, T, h, slice, C.out + O_PHG + sidx * 4096);
            else scan_long<3, 8, 1>(C, wl, row0, T, h, slice, C.out + O_PGDN + sidx * 4096);
        } else {
            if (kind == 0) { scan_task<0, 4, 2>(C, row0, T, h, slice, args.in[2] + sidx * 4096, C.out + O_SRET + sidx * 4096); }
            else if (kind == 1) { scan_task<1, 2, 4>(C, row0, T, h, slice, args.in[3] + sidx * 2048, C.out + O_SGLA + sidx * 2048); }
            else if (kind == 2) { scan_task<2, 4, 2>(C, row0, T, h, slice, args.in[4] + sidx * 4096, C.out + O_SHG + sidx * 4096); }
            else { scan_task<3, 4, 1>(C, row0, T, h, slice, args.in[5] + sidx * 4096, C.out + O_SGDN + sidx * 4096); }
        }
    }
    if (l == 0 && C.wave >= 5 && mode != 1) {
        LAS float* scr = (LAS float*)(C.lds + 4 * 26624 + (C.wave - 5) * 8704);
        constexpr int I_F0 = I_WI + I_WO, I_L0B = I_F0 + I_WOUT;
        for (int it = (C.wave - 5) * 256 + (int)blockIdx.x; it < I_L0B + I_MAIN; it += 768) {
            if (it < I_F0) convert_item(args, C.ws, 0, I_F0 + it, scr, C.lane);
            else if (it < I_L0B) convert_item(args, C.ws, 0, 2 * I_F0 + I_WIN + (it - I_F0), scr, C.lane);
            else convert_item(args, C.ws, 1, it - I_L0B, scr, C.lane);
        }
    }
}

__device__ __forceinline__ void post_phase(const Args& args, LAS unsigned char* lds_, int l) {
    const Ctx C = make_ctx(args, lds_);
    const bf16* PROJ = (const bf16*)(C.ws + WS_BIG); bf16* H = (bf16*)(C.ws + WS_H);
    const int lane = C.lane, mixer = lane >> 4, cc = (lane & 15) * 16;
    const int gbase = mixer == 0 ? C_RG : mixer == 1 ? C_AG : mixer == 2 ? C_HG : C_DG;
    const float* nw = mixer == 1 ? args.in[24] + l * 64 : mixer == 2 ? args.in[25] + l * 64 : args.in[26] + l * 64;
    float w[16];
#pragma unroll
    for (int i = 0; i < 16; ++i) w[i] = mixer == 0 ? 1.0f : nw[(cc + i) & 63];
    v4u na0, na1, ng0, ng1;
    if (C.gw < M) { const bf16* hp = H + (size_t)C.gw * D + lane * 16; const bf16* gp = PROJ + (size_t)C.gw * NINP + gbase + cc;
        na0 = *(const v4u*)hp; na1 = *(const v4u*)(hp + 8); ng0 = *(const v4u*)gp; ng1 = *(const v4u*)(gp + 8); }
#pragma unroll 1
    for (int r = C.gw; r < M; r += C.NGW) {
        bf16* hp = H + (size_t)r * D + lane * 16; const bf16* gp = PROJ + (size_t)r * NINP + gbase + cc;
        const v4u a0 = na0, a1 = na1, g0 = ng0, g1 = ng1;
        if (r + C.NGW < M) { const bf16* hn = hp + (size_t)C.NGW * D; const bf16* gn = gp + (size_t)C.NGW * NINP;
            na0 = *(const v4u*)hn; na1 = *(const v4u*)(hn + 8); ng0 = *(const v4u*)gn; ng1 = *(const v4u*)(gn + 8); }
        float y[16], g[16];
        const unsigned aw[8] = {a0.x, a0.y, a0.z, a0.w, a1.x, a1.y, a1.z, a1.w}, gw_[8] = {g0.x, g0.y, g0.z, g0.w, g1.x, g1.y, g1.z, g1.w};
        float ss = 0.f;
#pragma unroll
        for (int i = 0; i < 8; ++i) { y[2 * i] = bflo(aw[i]); y[2 * i + 1] = bfhi(aw[i]); g[2 * i] = bflo(gw_[i]); g[2 * i + 1] = bfhi(gw_[i]); ss += y[2 * i] * y[2 * i] + y[2 * i + 1] * y[2 * i + 1]; }
        ss = quad_sum(ss);
        const float rs = rsqrtf(ss * (1.0f / 64.0f) + RMS_EPS);
        unsigned ow[8];
#pragma unroll
        for (int i = 0; i < 8; ++i) ow[i] = pk2(y[2 * i] * rs * w[2 * i] * siluf_(g[2 * i]), y[2 * i + 1] * rs * w[2 * i + 1] * siluf_(g[2 * i + 1]));
        *(v4u*)hp = (v4u){ow[0], ow[1], ow[2], ow[3]}; *(v4u*)(hp + 8) = (v4u){ow[4], ow[5], ow[6], ow[7]};
    }
}

__global__ void __launch_bounds__(NWAVES * 64, 2) mega_fwd(Args args) {
    extern __shared__ __attribute__((aligned(16))) unsigned char lds[];
    cg::grid_group grid = cg::this_grid();
    LAS unsigned char* const LDSP = (LAS unsigned char*)lds;
    const int G = (int)gridDim.x, bx = (int)blockIdx.x;
    if (threadIdx.x < 64) ((LAS unsigned*)(LDSP + MISC_OFF))[threadIdx.x] = 0u;
    __syncthreads();
    (void)xcd_barrier_post((unsigned*)args.ws, (volatile LAS unsigned*)(LDSP + MISC_OFF));
#define FRESH() float* out_ = fresh_ptr(args.out); unsigned char* ws = fresh_ptr(args.ws); \
    float* MOD = (float*)(ws + WS_MOD); bf16* H = (bf16*)(ws + WS_H); bf16* BIG = (bf16*)(ws + WS_BIG); (void)MOD; (void)H; (void)BIG; (void)out_;

    p0_prologue(args, LDSP);
    if (args.ws == nullptr) grid.sync();
    grid_bar(args, LDSP);
    {
        FRESH();
        pg8::Gemm g{(const bf16*)(ws + WS_AC), BIG, 256, 2 * NMODC, D}; pg8::StaticOrder S; S.init(256, 2 * NMODC, G, bx, D);
        pg8::EpiMod E{MOD, args.in[10]};
        pg8::gemm_phase<pg8::EpiMod, pg8::StaticOrder, PG8_ALIGN, PG8_SP2>(LDSP, g, S, E);
    }
    p1_convert(args, LDSP);
    grid_bar(args, LDSP);
    p2_modulate0(args, LDSP);
    grid_bar(args, LDSP);
#pragma unroll 1
    for (int l = 0; l < 2; ++l) {
#pragma unroll 1
        for (int f = 0; f < 2; ++f) {
            if (f == 1) {
                {
                    FRESH();
                    pg8::Gemm g{H, (const bf16*)(ws + WS_W + (size_t)l * W_LAYER + W_WIN), M, NINP, D}; pg8::StaticOrder S; S.init(M, NINP, G, bx, D);
                    pg8::EpiPlain E{BIG, NINP};
                    pg8::gemm_phase<pg8::EpiPlain, pg8::StaticOrder, PG8_ALIGN, PG8_SP2>(LDSP, g, S, E);
                }
                grid_bar(args, LDSP);
                prep_phase(args, LDSP, l);
                grid_bar(args, LDSP);
                scan_phase(args, LDSP, l);
#ifdef PROBE_SCANMODE
                grid_bar(args, LDSP); scan_phase(args, LDSP, l, PROBE_SCANMODE);
#endif
                grid_bar(args, LDSP);
                post_phase(args, LDSP, l);
                grid_bar(args, LDSP);
                {
                    FRESH();
                    pg8::Gemm g{H, (const bf16*)(ws + WS_W + (size_t)l * W_LAYER + W_WOUT), M, D, D}; pg8::SplitOrder S; S.init(D, G, bx);
                    pg8::EpiRes E{out_, out_, (float*)(ws + WS_SB), MOD + (size_t)l * NB * NMODC + 5 * 1024, (const float*)(ws + WS_STATS), args.in[11] + (size_t)(l * 3) * D, args.in[12] + (size_t)(l * 3) * D, 1.0f, D / 64};
                    pg8::gemm_phase<pg8::EpiRes, pg8::SplitOrder, PG8_ALIGN, PG8_SP2>(LDSP, g, S, E);
                }
                grid_bar(args, LDSP);
                ln_phase(args, LDSP, l, 1, true, l, 6, 4, ALPHA, false);
                grid_bar(args, LDSP);
            }
            {
                FRESH();
                pg8::Gemm g{H, (const bf16*)(ws + WS_W + (size_t)l * W_LAYER + (f ? W_WI2 : W_WI1)), M, NWI, D}; pg8::StaticOrder S; S.init(M, NWI, G, bx, D);
                pg8::EpiSwiglu E{BIG, DFF};
                pg8::gemm_phase<pg8::EpiSwiglu, pg8::StaticOrder, PG8_ALIGN, PG8_SP2>(LDSP, g, S, E);
            }
            grid_bar(args, LDSP);
            {
                FRESH();
                pg8::Gemm g{BIG, (const bf16*)(ws + WS_W + (size_t)l * W_LAYER + (f ? W_WO2 : W_WO1)), M, D, DFF}; pg8::SplitOrder S; S.init(DFF, G, bx);
                const bool first = (l == 0 && f == 0); const int pinst = f ? l * 3 + 1 : l * 3 - 1;
                pg8::EpiRes E{out_, first ? args.in[0] : out_, (float*)(ws + WS_SB), MOD + (size_t)l * NB * NMODC + (f ? 8 : 2) * 1024, (const float*)(ws + WS_STATS),
                              first ? (const float*)(ws + WS_ID) : args.in[11] + (size_t)pinst * D, first ? (const float*)(ws + WS_ID) + 1024 : args.in[12] + (size_t)pinst * D, 0.5f, DFF / 64};
                pg8::gemm_phase<pg8::EpiRes, pg8::SplitOrder, PG8_ALIGN, PG8_SP2>(LDSP, g, S, E);
            }
            grid_bar(args, LDSP);
            if (f == 0) ln_phase(args, LDSP, l, 0, true, l, 3, 11, ALPHA, false);
            else ln_phase(args, LDSP, l, 2, l == 0, 1, 0, 11, l == 0 ? ALPHA : 1.0f, l == 1);
            if (!(l == 1 && f == 1)) grid_bar(args, LDSP);
        }
    }
}

extern "C" void kernel_launch(void* const* d_in, const int* in_sizes, int n_in, void* d_out, int out_size, void* d_ws, size_t ws_size, hipStream_t stream) {
    static int grid = 0;
    if (grid == 0) {
        if (n_in != 28 || (size_t)out_size != O_END || ws_size < WS_END) { fprintf(stderr, "kernel_launch: unexpected sizes n_in %d out %d ws %zu (need %zu)\n", n_in, out_size, ws_size, (size_t)WS_END); grid = -1; return; }
        int dev = 0, cus = 0, per_cu = 0;
        hipGetDevice(&dev); hipDeviceGetAttribute(&cus, hipDeviceAttributeMultiprocessorCount, dev);
        hipFuncSetAttribute((const void*)mega_fwd, hipFuncAttributeMaxDynamicSharedMemorySize, LDS_BYTES);
        hipOccupancyMaxActiveBlocksPerMultiprocessor(&per_cu, (const void*)mega_fwd, NWAVES * 64, LDS_BYTES);
        (void)hipGetLastError();
        if (per_cu < 1 || cus < 256) { fprintf(stderr, "kernel_launch: occupancy %d cus %d\n", per_cu, cus); grid = -1; return; }
        grid = 256;
    }
    if (grid < 0) return;
    if (hipMemsetAsync(d_ws, 0, 65536, stream) != hipSuccess) { fprintf(stderr, "memset failed\n"); return; }
    Args a{};
    for (int i = 0; i < 28; ++i) a.in[i] = (const float*)d_in[i];
    a.out = (float*)d_out; a.ws = (unsigned char*)d_ws;
    void* kargs[] = {&a};
    hipError_t e = hipLaunchCooperativeKernel((const void*)mega_fwd, dim3(grid), dim3(NWAVES * 64), kargs, LDS_BYTES, stream);
    if (e != hipSuccess) fprintf(stderr, "cooperative launch failed: %s\n", hipGetErrorString(e));
}
```

```cpp
#include <hip/hip_runtime.h>
#include <hip/hip_cooperative_groups.h>
#include <cstdio>
#include <cstdint>
namespace cg = cooperative_groups;
namespace pg8 {
#define PG8_LAS __attribute__((address_space(3)))
typedef unsigned short bf16_t;
typedef short bf16x8 __attribute__((ext_vector_type(8)));
typedef float f32x4 __attribute__((ext_vector_type(4)));
typedef unsigned u32x4 __attribute__((ext_vector_type(4)));
constexpr int BM = 256, BK = 64, HALF = 128, HTB = HALF * BK * 2  , STAGE_BYTES = 8 * HTB, NXCD = 8, WGM = 8;

__host__ __device__ __forceinline__ int lds_byte(int r, int c) { const int st = (r >> 4) * 2 + (c >> 5), rr = r & 15, cc = c & 31, ob = rr * 64 + cc * 2; return st * 1024 + (ob ^ (((ob >> 9) & 1) << 5)); }
__host__ __device__ __forceinline__ void stage_rc(int b, int& R, int& C) { const int st = b / 1024, sb = b % 1024, swz = sb ^ (((sb >> 9) & 1) << 5); R = (st >> 1) * 16 + swz / 64; C = (st & 1) * 32 + (swz % 64) / 2; }
__host__ __device__ __forceinline__ int perm32(int rho) { const int n = rho >> 4, i = rho & 15; return 8 * (i >> 2) + 4 * n + (i & 3); }

struct Unit { int pm, pn, k0, nt; };
struct Gemm { const bf16_t* A; const bf16_t* Bt; int M, N, K; };

struct StaticOrder {
    int nM, nN, nwg, G, c, ntf;
    __host__ __device__ void init(int M, int N, int G_, int c_, int K_ = 1024) { nM = M / BM; nN = N / BM; nwg = nM * nN; G = G_; c = c_; ntf = K_ / BK; }
    __host__ __device__ bool next(int i, Unit& u) const {
        const long L = (long)i * G + c; if (L >= nwg) return false;
        int wgid = (int)L; { const int q = nwg / NXCD, r = nwg % NXCD, xcd = wgid % NXCD, off = wgid / NXCD; wgid = (xcd < r ? xcd * (q + 1) : r * (q + 1) + (xcd - r) * q) + off; }
        const int nig = WGM * nN, gid = wgid / nig, fm = gid * WGM, gsz = (nM - fm) < WGM ? (nM - fm) : WGM;
        u.pm = fm + ((wgid % nig) % gsz); u.pn = (wgid % nig) / gsz; u.k0 = 0; u.nt = ntf; return true;
    }
    __device__ __forceinline__ void a_ready(const Unit&) const {}
    __device__ __forceinline__ void done(const Unit&) const {}
};

struct SplitOrder {
    StaticOrder base; int ppu, c;
    static constexpr int PK = 4;
    __host__ __device__ void init(int K_, int G_, int c_) { base.init(16384, 1024, G_, c_, K_); ppu = (K_ / BK) / PK; c = c_; }
    __host__ __device__ bool next(int i, Unit& u) const {
        if (i == 0) return base.next(0, u);
        if (i == 1 && c < 8 * ppu) { const int j = c / ppu, p = c - j * ppu; u.pm = 64 + (j >> 2); u.pn = j & 3; u.k0 = p * PK; u.nt = PK; return true; }
        return false;
    }
    __device__ __forceinline__ void a_ready(const Unit&) const {}
    __device__ __forceinline__ void done(const Unit&) const {}
};

__device__ __forceinline__ unsigned cvt_pk_bf16(float lo, float hi) { unsigned r; asm volatile("v_cvt_pk_bf16_f32 %0, %1, %2" : "=v"(r) : "v"(lo), "v"(hi)); return r; }
typedef float f32x2 __attribute__((ext_vector_type(2)));
__device__ __forceinline__ f32x2 gelu_pk(f32x2 v) {
    const f32x2 av = __builtin_elementwise_abs(v), d = av * 0.2316418882f + 1.0f;
    f32x2 t; t.x = __builtin_amdgcn_rcpf(d.x); t.y = __builtin_amdgcn_rcpf(d.y);
    f32x2 q = t * 0.5307027145f + (-0.7265760135f); q = q * t + 0.7107068705f; q = q * t + (-0.142248368f); q = q * t + 0.127414796f; q = q * t;
    const f32x2 s = (v * v) * (-0.72134752044f);
    f32x2 e; e.x = __builtin_amdgcn_exp2f(s.x); e.y = __builtin_amdgcn_exp2f(s.y);
    const f32x2 m = v * (q * e), r = v - m;
    f32x2 o; o.x = v.x < 0.f ? m.x : r.x; o.y = v.y < 0.f ? m.y : r.y; return o;
}

template <int ACT  > struct EpiBf16 {
    static constexpr bool PERM = true, AFTER_DRAIN = false; static_assert(ACT == 0 || ACT == 1, "EpiBf16: ACT is 0 (none) or 1 (gelu_pk)");
    bf16_t* O; int ldc; const float* bias; int split_cols; size_t split_stride; float scale0;
    __device__ __forceinline__ void operator()(const f32x4 (&acc)[2][2][4][2], const Unit& u, int wr, int wc, int fr, int fq) const {
        const int row0 = u.pm * BM + wr * 64 + fr; int colt = u.pn * BM; bf16_t* base = O;
        float sc = 1.f; if (split_cols) { const int t = colt / split_cols; base += (size_t)t * split_stride; colt -= t * split_cols; if (t == 0) sc = scale0; }
        const int col0 = colt + wc * 32 + 8 * fq, bcol0 = u.pn * BM + wc * 32 + 8 * fq;
        f32x4 bv[2][2];
#pragma unroll
        for (int bj = 0; bj < 2; ++bj)
#pragma unroll
            for (int n = 0; n < 2; ++n) bv[bj][n] = bias ? *(const f32x4*)(bias + bcol0 + bj * HALF + 4 * n) : (f32x4){0.f, 0.f, 0.f, 0.f};
#pragma unroll
        for (int ai = 0; ai < 2; ++ai)
#pragma unroll
            for (int m = 0; m < 4; ++m) { bf16_t* rowp = base + (size_t)(row0 + ai * HALF + m * 16) * ldc + col0;
#pragma unroll
                for (int bj = 0; bj < 2; ++bj) { f32x4 v0 = acc[ai][bj][m][0] + bv[bj][0], v1 = acc[ai][bj][m][1] + bv[bj][1];
                    if (ACT == 1) { f32x2 a = gelu_pk((f32x2){v0[0], v0[1]}), b = gelu_pk((f32x2){v0[2], v0[3]}), c = gelu_pk((f32x2){v1[0], v1[1]}), d = gelu_pk((f32x2){v1[2], v1[3]});
                        v0 = (f32x4){a.x, a.y, b.x, b.y}; v1 = (f32x4){c.x, c.y, d.x, d.y}; }
                    v0 = v0 * sc; v1 = v1 * sc; u32x4 w; w.x = cvt_pk_bf16(v0[0], v0[1]); w.y = cvt_pk_bf16(v0[2], v0[3]); w.z = cvt_pk_bf16(v1[0], v1[1]); w.w = cvt_pk_bf16(v1[2], v1[3]);
                    *(u32x4*)(rowp + bj * HALF) = w; } }
    }
};
template <class Epi, class Sched, bool ALIGN_EPI = false, bool SP2 = false>
__device__ __forceinline__ void gemm_phase(PG8_LAS unsigned char* lds, const Gemm g, const Sched& S, const Epi& E) {
    int tid_ = threadIdx.x; asm volatile("" : "+v"(tid_));
    const int tid = tid_, wid = __builtin_amdgcn_readfirstlane(tid >> 6), lane = tid & 63, wr = wid >> 2, wc = wid & 3, fr = lane & 15, fq = lane >> 4;
    const int K = g.K;
    unsigned voffA[2], voffB[2];
#pragma unroll
    for (int i = 0; i < 2; ++i) { int R, C; stage_rc(tid * 16 + i * 8192, R, C); const int Rb = Epi::PERM ? ((R & ~31) + perm32(R & 31)) : R;
        voffA[i] = (unsigned)(R * K + C) * 2u; voffB[i] = (unsigned)(Rb * K + C) * 2u; }
    const size_t kstep = (size_t)(BK * 2);
    const size_t hstep = (size_t)HALF * K * 2;
    const size_t tstep = 2 * hstep;
    const unsigned ldsw = (unsigned)wid * 1024u;
    const int aoff = lds_byte(wr * 64 + fr, fq * 8), boff = lds_byte(wc * 32 + fr, fq * 8);
#define PG8_SA(b, h) (((b) * 2 + (h)) * HTB)
#define PG8_SB(b, h) ((4 + (b) * 2 + (h)) * HTB)
#define PG8_STAGE(bufoff, gbase, voff) do { _Pragma("unroll") for (int _i = 0; _i < 2; ++_i) \
        __builtin_amdgcn_global_load_lds((const unsigned*)((const char*)(gbase) + (voff)[_i]), (PG8_LAS unsigned*)(lds + (bufoff) + ldsw + _i * 8192), 16, 0, 0); } while (0)
#define PG8_LDA(dst, b, h) do { _Pragma("unroll") for (int m = 0; m < 4; ++m) _Pragma("unroll") for (int k = 0; k < 2; ++k) dst[m][k] = *(const PG8_LAS bf16x8*)(lds + PG8_SA(b, h) + aoff + m * 2048 + k * 1024); } while (0)
#define PG8_LDB(dst, b, h) do { _Pragma("unroll") for (int n = 0; n < 2; ++n) _Pragma("unroll") for (int k = 0; k < 2; ++k) dst[n][k] = *(const PG8_LAS bf16x8*)(lds + PG8_SB(b, h) + boff + n * 2048 + k * 1024); } while (0)
#define PG8_MMA(ai, bj, At, Bt) do { __builtin_amdgcn_s_setprio(1); _Pragma("unroll") for (int m = 0; m < 4; ++m) _Pragma("unroll") for (int n = 0; n < 2; ++n) _Pragma("unroll") for (int k = 0; k < 2; ++k) \
        acc[ai][bj][m][n] = __builtin_amdgcn_mfma_f32_16x16x32_bf16(Bt[n][k], At[m][k], acc[ai][bj][m][n], 0, 0, 0); __builtin_amdgcn_s_setprio(0); } while (0)
#define PG8_WAIT_V(n) asm volatile("s_waitcnt vmcnt(" #n ")" ::: "memory")
#define PG8_WAIT_L(n) asm volatile("s_waitcnt lgkmcnt(" #n ")" ::: "memory")
#define PG8_BAR __builtin_amdgcn_s_barrier()
#define PG8_SCHED __builtin_amdgcn_sched_barrier(0)
    Unit cur, nxt; int ui = 0;
    if (!S.next(0, cur)) return;
    f32x4 acc[2][2][4][2];
#pragma unroll
    for (int a = 0; a < 2; ++a)
#pragma unroll
        for (int b = 0; b < 2; ++b)
#pragma unroll
            for (int m = 0; m < 4; ++m)
#pragma unroll
                for (int n = 0; n < 2; ++n) acc[a][b][m][n] = (f32x4){0.f, 0.f, 0.f, 0.f};
    bf16x8 At[4][2], B0[2][2], B1[2][2];
    const char* cA = (const char*)g.A + (size_t)cur.pm * tstep + (size_t)cur.k0 * kstep; const char* cB = (const char*)g.Bt + (size_t)cur.pn * tstep + (size_t)cur.k0 * kstep;
    S.a_ready(cur);
    if constexpr (SP2) {
        PG8_STAGE(PG8_SB(0, 0), cB, voffB); PG8_STAGE(PG8_SB(0, 1), cB + hstep, voffB); PG8_STAGE(PG8_SA(0, 0), cA, voffA); PG8_STAGE(PG8_SA(0, 1), cA + hstep, voffA);
        if (wr == 1) PG8_BAR;
        PG8_WAIT_V(2); PG8_BAR;
        PG8_STAGE(PG8_SB(1, 0), cB + kstep, voffB); PG8_STAGE(PG8_SA(1, 0), cA + kstep, voffA); PG8_STAGE(PG8_SB(1, 1), cB + hstep + kstep, voffB);
        PG8_WAIT_V(6); PG8_BAR;
    } else {
        PG8_STAGE(PG8_SB(0, 0), cB, voffB); PG8_STAGE(PG8_SA(0, 0), cA, voffA); PG8_STAGE(PG8_SB(0, 1), cB + hstep, voffB); PG8_STAGE(PG8_SA(0, 1), cA + hstep, voffA);
        if (wr == 1) PG8_BAR;
        PG8_WAIT_V(4); PG8_BAR;
        PG8_STAGE(PG8_SB(1, 0), cB + kstep, voffB); PG8_STAGE(PG8_SA(1, 0), cA + kstep, voffA); PG8_STAGE(PG8_SB(1, 1), cB + hstep + kstep, voffB);
        PG8_WAIT_V(6); PG8_BAR;
    }
    for (;;) {
        const bool has_next = S.next(ui + 1, nxt);
        const char* nA = has_next ? (const char*)g.A + (size_t)nxt.pm * tstep + (size_t)nxt.k0 * kstep : cA; const char* nB = has_next ? (const char*)g.Bt + (size_t)nxt.pn * tstep + (size_t)nxt.k0 * kstep : cB;
        const int nt = cur.nt;
        for (int t = 0; t < nt; t += 2) {
            const bool last = (t == nt - 2);
            const char* a1 = cA + (size_t)(t + 1) * kstep;
            const char* a2 = last ? nA : cA + (size_t)(t + 2) * kstep; const char* b2 = last ? nB : cB + (size_t)(t + 2) * kstep;
            const char* a3 = a2 + kstep; const char* b3 = b2 + kstep;
            if (last && has_next) S.a_ready(nxt);
            if constexpr (SP2) {
            PG8_LDB(B0, 0, 0); PG8_LDB(B1, 0, 1); PG8_SCHED; PG8_LDA(At, 0, 0); PG8_STAGE(PG8_SA(1, 1), a1 + hstep, voffA);
            PG8_WAIT_V(8); PG8_WAIT_L(0); PG8_BAR; PG8_MMA(0, 0, At, B0); PG8_MMA(0, 1, At, B1); PG8_BAR; PG8_SCHED;
            PG8_LDA(At, 0, 1); PG8_STAGE(PG8_SB(0, 0), b2, voffB); PG8_STAGE(PG8_SB(0, 1), b2 + hstep, voffB); PG8_STAGE(PG8_SA(0, 0), a2, voffA);
            PG8_WAIT_V(8); PG8_WAIT_L(0); PG8_BAR; PG8_MMA(1, 0, At, B0); PG8_MMA(1, 1, At, B1); PG8_BAR; PG8_SCHED;
            PG8_LDB(B0, 1, 0); PG8_LDB(B1, 1, 1); PG8_SCHED; PG8_LDA(At, 1, 0); PG8_STAGE(PG8_SA(0, 1), a2 + hstep, voffA);
            PG8_WAIT_V(8); PG8_WAIT_L(0); PG8_BAR; PG8_MMA(0, 0, At, B0); PG8_MMA(0, 1, At, B1); PG8_BAR; PG8_SCHED;
            PG8_LDA(At, 1, 1); PG8_STAGE(PG8_SB(1, 0), b3, voffB); PG8_STAGE(PG8_SB(1, 1), b3 + hstep, voffB); PG8_STAGE(PG8_SA(1, 0), a3, voffA);
            PG8_WAIT_V(8); PG8_WAIT_L(0); PG8_BAR; PG8_MMA(1, 0, At, B0); PG8_MMA(1, 1, At, B1); PG8_BAR; PG8_SCHED;
            } else {
            PG8_LDB(B0, 0, 0); PG8_SCHED; PG8_LDA(At, 0, 0); PG8_STAGE(PG8_SA(1, 1), a1 + hstep, voffA);
            PG8_WAIT_L(8); PG8_BAR; PG8_WAIT_L(0); PG8_MMA(0, 0, At, B0); PG8_BAR; PG8_SCHED;
            PG8_LDB(B1, 0, 1); PG8_STAGE(PG8_SB(0, 0), b2, voffB);
            PG8_BAR; PG8_WAIT_L(0); PG8_MMA(0, 1, At, B1); PG8_BAR;
            PG8_LDA(At, 0, 1); PG8_STAGE(PG8_SA(0, 0), a2, voffA);
            PG8_BAR; PG8_WAIT_L(0); PG8_MMA(1, 0, At, B0); PG8_BAR; PG8_SCHED;
            PG8_STAGE(PG8_SB(0, 1), b2 + hstep, voffB);
            PG8_WAIT_V(6); PG8_BAR; PG8_MMA(1, 1, At, B1); PG8_BAR;
            PG8_LDB(B0, 1, 0); PG8_SCHED; PG8_LDA(At, 1, 0); PG8_STAGE(PG8_SA(0, 1), a2 + hstep, voffA);
            PG8_WAIT_L(8); PG8_BAR; PG8_WAIT_L(0); PG8_MMA(0, 0, At, B0); PG8_BAR; PG8_SCHED;
            PG8_LDB(B1, 1, 1); PG8_STAGE(PG8_SB(1, 0), b3, voffB);
            PG8_BAR; PG8_WAIT_L(0); PG8_MMA(0, 1, At, B1); PG8_BAR;
            PG8_LDA(At, 1, 1); PG8_STAGE(PG8_SA(1, 0), a3, voffA);
            PG8_BAR; PG8_WAIT_L(0); PG8_MMA(1, 0, At, B0); PG8_BAR; PG8_SCHED;
            PG8_STAGE(PG8_SB(1, 1), b3 + hstep, voffB);
            PG8_WAIT_V(6); PG8_BAR; PG8_MMA(1, 1, At, B1); PG8_BAR;
            }
        }
        if constexpr (ALIGN_EPI) { if (wr == 0) PG8_BAR; }
        if constexpr (!Epi::AFTER_DRAIN) { E(acc, cur, wr, wc, fr, fq); S.done(cur); }
        if (!has_next) break;
#pragma unroll
        for (int a = 0; a < 2; ++a)
#pragma unroll
            for (int b = 0; b < 2; ++b)
#pragma unroll
                for (int m = 0; m < 4; ++m)
#pragma unroll
                    for (int n = 0; n < 2; ++n) acc[a][b][m][n] = (f32x4){0.f, 0.f, 0.f, 0.f};
        cur = nxt; cA = nA; cB = nB; ++ui;
        if constexpr (ALIGN_EPI) { if (wr == 1) PG8_BAR; }
    }
    PG8_WAIT_V(0);
    if constexpr (!ALIGN_EPI) { if (wr == 0) PG8_BAR; }
    PG8_BAR;
    if constexpr (Epi::AFTER_DRAIN) { E.fused(acc, cur, wr, wc, fr, fq, lds, wid, lane); S.done(cur); }
#undef PG8_SA
#undef PG8_SB
#undef PG8_STAGE
#undef PG8_LDA
#undef PG8_LDB
#undef PG8_MMA
#undef PG8_WAIT_V
#undef PG8_WAIT_L
#undef PG8_BAR
#undef PG8_SCHED
}
}
#define PG8_SP2 true
#define PG8_ALIGN true

constexpr int D = 1024, TP = 2048, BP = 8, BS = 128, TS = 4;
constexpr int MP = BP * TP, MS = BS * TS, M = MP + MS;
constexpr int DFF = 2816, NWI = 2 * DFF, NIN = 3864, NINP = 4096, NMODC = 9216, NB = BP + BS;
constexpr int SBW = 1664, SFW = 396;
constexpr float LN_EPS = 1e-5f, RMS_EPS = 1e-6f;
constexpr float ALPHA = 1.41421356237f;
constexpr int C_RQ = 0, C_RK = 256, C_RV = 512, C_RG = 768, C_AQ = 1024, C_AK = 1152, C_AV = 1280, C_ALR = 1536, C_AG = 1552,
              C_HQ = 1808, C_HF = 2064, C_HI = 2320, C_HG = 2576, C_DQKV = 2832, C_DB = 3600, C_DA = 3604, C_DG = 3608;
constexpr int SB_RQ = 0, SB_RK = 256, SB_AQ = 512, SB_HQ = 640, SB_DQ = 896, SB_DK = 1152, SB_DV = 1408;
constexpr int SF_ADEC = 0, SF_HF = 128, SF_BETA = 384, SF_DDEC = 388, SF_QK = 392;
constexpr size_t O_Y = 0;
constexpr size_t O_PRET = (size_t)M * D;
constexpr size_t O_PGLA = O_PRET + 2ull * BP * 4 * 64 * 64;
constexpr size_t O_PHG = O_PGLA + 2ull * BP * 4 * 32 * 64;
constexpr size_t O_PGDN = O_PHG + 2ull * BP * 4 * 64 * 64;
constexpr size_t O_PCONV = O_PGDN + 2ull * BP * 4 * 64 * 64;
constexpr size_t O_SRET = O_PCONV + 2ull * BP * 3 * 768;
constexpr size_t O_SGLA = O_SRET + 2ull * BS * 4 * 64 * 64;
constexpr size_t O_SHG = O_SGLA + 2ull * BS * 4 * 32 * 64;
constexpr size_t O_SGDN = O_SHG + 2ull * BS * 4 * 64 * 64;
constexpr size_t O_SCONV = O_SGDN + 2ull * BS * 4 * 64 * 64;
constexpr size_t O_END = O_SCONV + 2ull * BS * 3 * 768;

constexpr size_t MiB = 1u << 20;
constexpr size_t WS_ROPE = 1 * MiB;
constexpr size_t WS_AC = 2 * MiB;
constexpr size_t WS_MOD = 3 * MiB;
constexpr size_t WS_STATS = 2 * MiB + 512 * 1024;
constexpr size_t WS_ID = 2 * MiB + 768 * 1024;
constexpr size_t WS_W = 13 * MiB;
constexpr size_t W_WI1 = 0, W_WO1 = 11 * MiB, W_WI2 = W_WO1 + 5 * MiB + MiB / 2, W_WO2 = W_WI2 + 11 * MiB, W_WIN = W_WO2 + 5 * MiB + MiB / 2, W_WOUT = W_WIN + 8 * MiB, W_LAYER = 43 * MiB;
constexpr size_t WS_H = WS_W + 2 * W_LAYER;
constexpr size_t WS_BIG = WS_H + 33 * MiB;
constexpr size_t WS_SB = WS_BIG + 132 * MiB;
constexpr size_t WS_SF = WS_SB + 54 * MiB;
constexpr size_t WS_END = WS_SF + 26 * MiB;
static_assert((size_t)M * SBW * 2 <= 54 * MiB && (size_t)M * SFW * 4 <= 26 * MiB && (size_t)M * 4096 * 2 <= 132 * MiB && (size_t)M * D * 2 <= 33 * MiB, "ws map");

constexpr int LDS_BYTES = 147456;
constexpr int NWAVES = 8;

#define GAS __attribute__((address_space(1)))
#define LAS __attribute__((address_space(3)))
typedef unsigned short bf16;
typedef unsigned v4u __attribute__((ext_vector_type(4)));
typedef unsigned v2u __attribute__((ext_vector_type(2)));
typedef float f32x4 __attribute__((ext_vector_type(4)));
typedef float f32x2 __attribute__((ext_vector_type(2)));
#define LDS_WAIT() asm volatile("s_waitcnt lgkmcnt(0)" ::: "memory")

__device__ __forceinline__ float bf2f(unsigned b) { return __uint_as_float(b << 16); }
__device__ __forceinline__ float bflo(unsigned w) { return __uint_as_float(w << 16); }
__device__ __forceinline__ float bfhi(unsigned w) { return __uint_as_float(w & 0xffff0000u); }
__device__ __forceinline__ unsigned pk2(float lo, float hi) { return pg8::cvt_pk_bf16(lo, hi); }
__device__ __forceinline__ float sigmoidf_(float x) { return __builtin_amdgcn_rcpf(1.0f + __expf(-x)); }
__device__ __forceinline__ float siluf_(float x) { return x * __builtin_amdgcn_rcpf(1.0f + __expf(-x)); }
__device__ __forceinline__ float wave_sum(float v) {
#pragma unroll
    for (int o = 1; o < 64; o <<= 1) v += __shfl_xor(v, o);
    return v;
}
template <int CTRL> __device__ __forceinline__ float dppmov(float v) { return __int_as_float(__builtin_amdgcn_update_dpp(0, __float_as_int(v), CTRL, 0xf, 0xf, true)); }
__device__ __forceinline__ float quad_sum(float v) { v += dppmov<0xB1>(v); v += dppmov<0x4E>(v); return v; }
__device__ __forceinline__ float row8_sum(float v) { v += dppmov<0xB1>(v); v += dppmov<0x4E>(v); v += dppmov<0x141>(v); return v; }
__device__ __forceinline__ float row16_sum(float v) { v += dppmov<0xB1>(v); v += dppmov<0x4E>(v); v += dppmov<0x141>(v); v += dppmov<0x140>(v); return v; }

struct Args { const float* in[28]; float* out; unsigned char* ws; };

struct Ctx {
    int tid, lane, wave, gw, NGW;
    LAS unsigned char* lds;
    float* out; unsigned char* ws;
};
template <class T> __device__ __forceinline__ T* fresh_ptr(T* p) {
    unsigned lo = (unsigned)(uintptr_t)p, hi = (unsigned)((uintptr_t)p >> 32);
    asm volatile("" : "+v"(lo), "+v"(hi));
    lo = __builtin_amdgcn_readfirstlane(lo); hi = __builtin_amdgcn_readfirstlane(hi);
    return (T*)(__attribute__((address_space(1))) T*)(((uintptr_t)hi << 32) | (uintptr_t)lo);
}
__device__ __forceinline__ Ctx make_ctx(const Args& args, LAS unsigned char* lds) {
    Ctx C; int t = threadIdx.x; asm volatile("" : "+v"(t));
    C.tid = t; C.lane = t & 63; C.wave = __builtin_amdgcn_readfirstlane(t >> 6);
    C.gw = (int)blockIdx.x * NWAVES + C.wave; C.NGW = (int)gridDim.x * NWAVES;
    float* op = fresh_ptr(args.out); unsigned char* wp = fresh_ptr(args.ws);
    C.lds = lds; C.out = op; C.ws = wp; return C;
}
__device__ __forceinline__ int batch_of_row(int r) { return r < MP ? (r >> 11) : BP + ((r - MP) >> 2); }


typedef GAS unsigned gu32;
#define RLX_AGENT __ATOMIC_RELAXED, __HIP_MEMORY_SCOPE_AGENT
#define XB_TMO      128
#define XB_XCNT(j)  (256  + 64 * (j))
#define XB_XSUB(j)  (1280 + 64 * (j))
#define XB_XGEN(j)  (2304 + 64 * (j))
#define XB_TOP      3328
#define XB_TOPGEN   3392
#define XCD_BAR_WORDS 3456
#define XB_SPIN_CAP (1u << 18)

__device__ __forceinline__ unsigned xb_ld(unsigned* p)              { return __hip_atomic_load(p, __ATOMIC_RELAXED, __HIP_MEMORY_SCOPE_AGENT); }
__device__ __forceinline__ unsigned xb_add(unsigned* p, unsigned v) { return __hip_atomic_fetch_add(p, v, __ATOMIC_RELAXED, __HIP_MEMORY_SCOPE_AGENT); }
__device__ __forceinline__ unsigned xb_xcc_id() { return (unsigned)__builtin_amdgcn_s_getreg((3 << 11) | 20) & 0xFu; }
#define XB_SPIN(cond, bar) do { unsigned _sp = 0; while (cond) { __builtin_amdgcn_s_sleep(1); \
    if ((++_sp & 255u) == 0u) { if (xb_ld(&(bar)[XB_TMO])) break; if (_sp > XB_SPIN_CAP) { atomicAdd(&(bar)[XB_TMO], 1u); break; } } } } while (0)

struct XcdBarrier {
    unsigned* bar; unsigned x;
    volatile LAS unsigned* st;
};

__device__ __forceinline__ XcdBarrier xcd_barrier_post(unsigned* bar, volatile LAS unsigned* st) {
    XcdBarrier b; b.bar = bar; b.x = xb_xcc_id(); b.st = st;
    if (threadIdx.x == 0) (void)xb_add(&bar[XB_XCNT(b.x)], 1u);
    return b;
}
__device__ __forceinline__ void xcd_barrier_complete(unsigned* bar, unsigned x, unsigned& nloc, unsigned& nx) {
    const unsigned G = gridDim.x * gridDim.y * gridDim.z;
    unsigned sum, cnt, mine, sp = 0u;
    for (;;) {
        sum = 0u; cnt = 0u; mine = 0u;
#pragma unroll
        for (unsigned j = 0; j < 16; ++j) { const unsigned c = xb_ld(&bar[XB_XCNT(j)]); sum += c; cnt += (c > 0u) ? 1u : 0u; mine = (j == x) ? c : mine; }
        if (sum == G) break;
        __builtin_amdgcn_s_sleep(1);
        if ((++sp & 255u) == 0u) { if (xb_ld(&bar[XB_TMO])) break; if (sp > XB_SPIN_CAP) { atomicAdd(&bar[XB_TMO], 1u); break; } }
    }
    nloc = mine > 0u ? mine : 1u; nx = cnt > 0u ? cnt : 1u;
}

__device__ __forceinline__ void xcd_barrier(const XcdBarrier& b) {
    asm volatile("s_waitcnt vmcnt(0)" ::: "memory");
    __syncthreads();
    if (threadIdx.x == 0) {
        unsigned* bar = b.bar;
        __builtin_amdgcn_s_waitcnt(0);
        unsigned nloc = b.st[0], nx = b.st[1];
        if (nloc == 0u) { xcd_barrier_complete(bar, b.x, nloc, nx); b.st[0] = nloc; b.st[1] = nx; }
        const unsigned old = xb_add(&bar[XB_XSUB(b.x)], 1u);
        const unsigned gen = old / nloc;
        if (old + 1u == (gen + 1u) * nloc) {
            __builtin_amdgcn_fence(__ATOMIC_RELEASE, "agent");
            asm volatile("s_waitcnt vmcnt(0)" ::: "memory");
            const unsigned og = xb_add(&bar[XB_TOP], 1u);
            const unsigned tg = og / nx;
            if (og + 1u == (tg + 1u) * nx) xb_add(&bar[XB_TOPGEN], 1u);
            else XB_SPIN(xb_ld(&bar[XB_TOPGEN]) == tg, bar);
            __builtin_amdgcn_fence(__ATOMIC_ACQUIRE, "agent");
            xb_add(&bar[XB_XGEN(b.x)], 1u);
            asm volatile("s_waitcnt vmcnt(0)" ::: "memory");
        } else {
            XB_SPIN(xb_ld(&bar[XB_XGEN(b.x)]) == gen, bar);
            __builtin_amdgcn_fence(__ATOMIC_ACQUIRE, "agent");
            asm volatile("s_waitcnt vmcnt(0)" ::: "memory");
        }
    }
    __syncthreads();
}

constexpr int MISC_OFF = LDS_BYTES - 256;
__device__ __forceinline__ void grid_bar(const Args& args, LAS unsigned char* lds) {
    XcdBarrier b; b.bar = (unsigned*)fresh_ptr(args.ws); b.x = xb_xcc_id(); b.st = (volatile LAS unsigned*)(lds + MISC_OFF);
    xcd_barrier(b);
}

__device__ __forceinline__ float wave_sum2(float v) { v = row16_sum(v); v += __shfl_xor(v, 16); v += __shfl_xor(v, 32); return v; }

namespace pg8 {
struct EpiSwiglu {
    static constexpr bool PERM = true, AFTER_DRAIN = false;
    bf16_t* O; int ldc;
    __device__ __forceinline__ void operator()(const f32x4 (&acc)[2][2][4][2], const Unit& u, int wr, int wc, int fr, int fq) const {
        const int row0 = u.pm * BM + wr * 64 + fr, col0 = u.pn * 128 + wc * 32 + 8 * fq;
#pragma unroll
        for (int ai = 0; ai < 2; ++ai)
#pragma unroll
            for (int m = 0; m < 4; ++m) {
                bf16_t* rowp = O + (size_t)(row0 + ai * HALF + m * 16) * ldc + col0;
                float h[8];
#pragma unroll
                for (int n = 0; n < 2; ++n)
#pragma unroll
                    for (int j = 0; j < 4; ++j) {
                        const float a = acc[ai][0][m][n][j], b = acc[ai][1][m][n][j];
                        const float e = __builtin_amdgcn_exp2f(-1.44269504f * a);
                        h[n * 4 + j] = a * __builtin_amdgcn_rcpf(1.0f + e) * b;
                    }
                u32x4 w; w.x = cvt_pk_bf16(h[0], h[1]); w.y = cvt_pk_bf16(h[2], h[3]); w.z = cvt_pk_bf16(h[4], h[5]); w.w = cvt_pk_bf16(h[6], h[7]);
                *(u32x4*)rowp = w;
            }
    }
};
struct EpiPlain {
    static constexpr bool PERM = true, AFTER_DRAIN = false;
    bf16_t* O; int ldc;
    __device__ __forceinline__ void operator()(const f32x4 (&acc)[2][2][4][2], const Unit& u, int wr, int wc, int fr, int fq) const {
        const int row0 = u.pm * BM + wr * 64 + fr, col0 = u.pn * BM + wc * 32 + 8 * fq;
#pragma unroll
        for (int ai = 0; ai < 2; ++ai)
#pragma unroll
            for (int m = 0; m < 4; ++m) {
                bf16_t* rowp = O + (size_t)(row0 + ai * HALF + m * 16) * ldc + col0;
#pragma unroll
                for (int bj = 0; bj < 2; ++bj) { const f32x4 v0 = acc[ai][bj][m][0], v1 = acc[ai][bj][m][1];
                    u32x4 w; w.x = cvt_pk_bf16(v0[0], v0[1]); w.y = cvt_pk_bf16(v0[2], v0[3]); w.z = cvt_pk_bf16(v1[0], v1[1]); w.w = cvt_pk_bf16(v1[2], v1[3]);
                    *(u32x4*)(rowp + bj * HALF) = w; }
            }
    }
};
struct EpiRes {
    static constexpr bool PERM = false, AFTER_DRAIN = false;
    float* X; const float* Xr; float* PART; const float* gate; const float* stats; const float* lg; const float* lb; float scale; int ntf;
    __device__ __forceinline__ void operator()(const f32x4 (&acc)[2][2][4][2], const Unit& u, int wr, int wc, int fr, int fq) const {
        const int col0 = u.pn * BM + wc * 32 + 4 * fq;
        if (u.nt == ntf) {
            const float* gp = gate + (size_t)(u.pm >> 3) * 9216 + col0;
            f32x4 gs[2][2], g4[2][2], b4[2][2];
#pragma unroll
            for (int bj = 0; bj < 2; ++bj)
#pragma unroll
                for (int n = 0; n < 2; ++n) { const int cc = bj * HALF + n * 16;
                    gs[bj][n] = *(const f32x4*)(gp + cc) * scale + scale; g4[bj][n] = *(const f32x4*)(lg + col0 + cc); b4[bj][n] = *(const f32x4*)(lb + col0 + cc) * 1.41421356237f; }
#pragma unroll
            for (int ai = 0; ai < 2; ++ai)
#pragma unroll
                for (int m = 0; m < 4; ++m) {
                    const int r = u.pm * BM + ai * HALF + wr * 64 + m * 16 + fr;
                    const f32x2 st = *(const f32x2*)(stats + 2 * (size_t)r); const float mean = st.x, rs = st.y * 1.41421356237f;
                    const float* yr = Xr + (size_t)r * 1024 + col0; float* xo = X + (size_t)r * 1024 + col0;
                    f32x4 y[2][2];
#pragma unroll
                    for (int bj = 0; bj < 2; ++bj)
#pragma unroll
                        for (int n = 0; n < 2; ++n) y[bj][n] = *(const f32x4*)(yr + bj * HALF + n * 16);
#pragma unroll
                    for (int bj = 0; bj < 2; ++bj)
#pragma unroll
                        for (int n = 0; n < 2; ++n)
                            *(f32x4*)(xo + bj * HALF + n * 16) = gs[bj][n] * acc[ai][bj][m][n] + ((y[bj][n] - mean) * rs * g4[bj][n] + b4[bj][n]);
                    asm volatile("" ::: "memory");
                }
            return;
        }
        float* pbase = PART + (size_t)(u.k0 / SplitOrder::PK) * (512 * 1024);
#pragma unroll
        for (int ai = 0; ai < 2; ++ai)
#pragma unroll
            for (int m = 0; m < 4; ++m) {
                const int r = u.pm * BM + ai * HALF + wr * 64 + m * 16 + fr - 16384;
                const float* gp = gate + (size_t)(8 + (r >> 2)) * 9216 + col0;
                float* xo = pbase + (size_t)r * 1024 + col0;
#pragma unroll
                for (int bj = 0; bj < 2; ++bj)
#pragma unroll
                    for (int n = 0; n < 2; ++n) { const int cc = bj * HALF + n * 16;
                        *(f32x4*)(xo + cc) = (*(const f32x4*)(gp + cc) * scale + scale) * acc[ai][bj][m][n]; }
                asm volatile("" ::: "memory");
            }
    }
};
struct EpiMod {
    static constexpr bool PERM = false, AFTER_DRAIN = false;
    float* MODp; const float* ada_b;
    __device__ __forceinline__ void operator()(const f32x4 (&acc)[2][2][4][2], const Unit& u, int wr, int wc, int fr, int fq) const {
        const int col0 = u.pn * BM + wc * 32 + 4 * fq;
        const int l = (u.pn * BM) / 9216;
#pragma unroll
        for (int ai = 0; ai < 2; ++ai)
#pragma unroll
            for (int m = 0; m < 4; ++m) {
                const int r = u.pm * BM + ai * HALF + wr * 64 + m * 16 + fr;
                if (r < 136) {
#pragma unroll
                    for (int bj = 0; bj < 2; ++bj)
#pragma unroll
                        for (int n = 0; n < 2; ++n) {
                            const int c = col0 + bj * HALF + n * 16;
                            const f32x4 o = acc[ai][bj][m][n] + *(const f32x4*)(ada_b + c);
                            *(f32x4*)(MODp + (size_t)(l * 136 + r) * 9216 + (c - l * 9216)) = o;
                        }
                }
            }
    }
};
}

__device__ __forceinline__ void transpose_item(const float* W, int K, int N, bf16* WT, int dest_row0, LAS float* scr, int k0, int n0, int lane) {
    const int nn = n0 + (lane & 31); const bool ok = nn < N;
    float tv[32];
#pragma unroll
    for (int i = 0; i < 32; ++i) { const int kk = 2 * i + (lane >> 5); tv[i] = ok ? W[(size_t)(k0 + kk) * N + nn] : 0.f; }
#pragma unroll
    for (int i = 0; i < 32; ++i) { const int kk = 2 * i + (lane >> 5); scr[kk * 33 + (lane & 31)] = tv[i]; }
    LDS_WAIT();
    const int c = lane & 7;
#pragma unroll
    for (int j = 0; j < 4; ++j) { const int n = (lane >> 3) + 8 * j; const LAS float* s = scr + (8 * c) * 33 + n;
        v4u o; o.x = pk2(s[0 * 33], s[1 * 33]); o.y = pk2(s[2 * 33], s[3 * 33]); o.z = pk2(s[4 * 33], s[5 * 33]); o.w = pk2(s[6 * 33], s[7 * 33]);
        *(v4u*)(WT + (size_t)(dest_row0 + n) * K + k0 + 8 * c) = o; }
    LDS_WAIT();
}

constexpr int I_WI = 16 * 176, I_WO = 44 * 32, I_WIN = 16 * 121, I_WOUT = 16 * 32, I_ADA = 16 * 288;
constexpr int I_MAIN = 2 * I_WI + 2 * I_WO + I_WIN + I_WOUT, I_LAYER = I_MAIN + I_ADA;
__device__ __forceinline__ void convert_item(const Args& args, unsigned char* ws, int l, int r, LAS float* scr, int lane) {
    unsigned char* wl = ws + WS_W + (size_t)l * W_LAYER;
    if (r < 2 * (I_WI + I_WO)) {
        const int f = r / (I_WI + I_WO); r -= f * (I_WI + I_WO);
        if (r < I_WI) {
            const int kb = r / 176, nb = r % 176, n0 = nb * 32;
            const int half = n0 / DFF, j = n0 - half * DFF, t = j >> 7, jj = j & 127;
            transpose_item((f ? args.in[15] : args.in[13]) + (size_t)l * D * NWI, D, NWI, (bf16*)(wl + (f ? W_WI2 : W_WI1)), 256 * t + 128 * half + jj, scr, kb * 64, n0, lane);
        } else { r -= I_WI;
            const int kb = r / 32, nb = r % 32;
            transpose_item((f ? args.in[16] : args.in[14]) + (size_t)l * DFF * D, DFF, D, (bf16*)(wl + (f ? W_WO2 : W_WO1)), nb * 32, scr, kb * 64, nb * 32, lane);
        }
        return;
    }
    r -= 2 * (I_WI + I_WO);
    if (r < I_WIN) { const int kb = r / 121, nb = r % 121;
        transpose_item(args.in[17] + (size_t)l * D * NIN, D, NIN, (bf16*)(wl + W_WIN), nb * 32, scr, kb * 64, nb * 32, lane); return; }
    r -= I_WIN;
    if (r < I_WOUT) { const int kb = r / 32, nb = r % 32;
        transpose_item(args.in[27] + (size_t)l * D * D, D, D, (bf16*)(wl + W_WOUT), nb * 32, scr, kb * 64, nb * 32, lane); return; }
    r -= I_WOUT;
    { const int kb = r / 288, nb = r % 288;
        transpose_item(args.in[9] + (size_t)l * D * NMODC, D, NMODC, (bf16*)(ws + WS_BIG), l * NMODC + nb * 32, scr, kb * 64, nb * 32, lane); }
}

__device__ __forceinline__ void p0_prologue(const Args& args, LAS unsigned char* lds_) {
    const Ctx C = make_ctx(args, lds_);
    LAS float* scr = (LAS float*)(C.lds + C.wave * 16384);
    for (int it = C.gw; it < 2 * I_ADA; it += C.NGW) convert_item(args, C.ws, it / I_ADA, I_MAIN + it % I_ADA, scr, C.lane);
    const int gt = C.gw * 64 + C.lane, NGT = C.NGW * 64;
    for (int i = gt; i < 2 * 224 * 128; i += NGT) { const int l = i / (224 * 128), rr = (i / 128) % 224, ch = i & 127;
        *(v4u*)(C.ws + WS_W + (size_t)l * W_LAYER + W_WIN + ((size_t)(3872 + rr) * 1024 + ch * 8) * 2) = (v4u){0u, 0u, 0u, 0u}; }
    for (int i = gt; i < 2048; i += NGT) ((float*)(C.ws + WS_ID))[i] = i < 1024 ? 1.0f : 0.f;
    for (int i = gt; i < 256 * 256; i += NGT) { const int row = i >> 8, c4 = (i & 255) * 4;
        v2u o = (v2u){0u, 0u};
        if (row < NB) { const float* src = row < BP ? args.in[7] + (size_t)row * D : args.in[8] + (size_t)(row - BP) * D; const f32x4 v = *(const f32x4*)(src + c4);
            o.x = pk2(siluf_(v.x), siluf_(v.y)); o.y = pk2(siluf_(v.z), siluf_(v.w)); }
        *(v2u*)(C.ws + WS_AC + ((size_t)row * D + c4) * 2) = o; }
    for (int i = gt; i < 2052 * 32; i += NGT) { const int p = i >> 5, j = i & 31; const double pos = p < 2048 ? (double)p : (double)(16384 + (p - 2048));
        double inv = 1.0; for (int q = 0; q < j; ++q) inv *= 0.7498942093324559;
        const double ang = pos * inv; const double n = rint(ang * 0.15915494309189535);
        const float rr = (float)((ang - n * 6.283185307179586) - n * 2.4492935982947064e-16);
        ((f32x2*)(C.ws + WS_ROPE))[i] = (f32x2){__cosf(rr), __sinf(rr)}; }
}

__device__ __forceinline__ void p1_convert(const Args& args, LAS unsigned char* lds_) {
    const Ctx C = make_ctx(args, lds_);
    if ((int)blockIdx.x < 72) return;
    LAS float* scr = (LAS float*)(C.lds + C.wave * 16384);
    constexpr int I_F0 = I_WI + I_WO, I_P0 = I_F0 + I_WIN;
    for (int it = ((int)blockIdx.x - 72) * NWAVES + C.wave; it < I_P0; it += 184 * NWAVES) {
        if (it < I_F0) convert_item(args, C.ws, 0, it, scr, C.lane);
        else convert_item(args, C.ws, 0, 2 * I_F0 + (it - I_F0), scr, C.lane);
    }
}

__device__ __forceinline__ void p2_modulate0(const Args& args, LAS unsigned char* lds_) {
    const Ctx C = make_ctx(args, lds_);
    const float* MOD = (const float*)(C.ws + WS_MOD); bf16* H = (bf16*)(C.ws + WS_H);
    auto rowp = [&](int r) { return r < MP ? args.in[0] + (size_t)r * D : args.in[1] + (size_t)(r - MP) * D; };
    f32x4 nx[4], nsh[4], nsc[4];
    auto ld = [&](int r) { const float* xr = rowp(r); const float* modr = MOD + (size_t)batch_of_row(r) * NMODC;
#pragma unroll
        for (int j = 0; j < 4; ++j) { const int c = (C.lane + 64 * j) * 4; nx[j] = *(const f32x4*)(xr + c); nsh[j] = *(const f32x4*)(modr + c); nsc[j] = *(const f32x4*)(modr + 1024 + c); } };
    if (C.gw < M) ld(C.gw);
#pragma unroll 1
    for (int r = C.gw; r < M; r += C.NGW) {
        f32x4 v[4], sh[4], sc[4];
#pragma unroll
        for (int j = 0; j < 4; ++j) { v[j] = nx[j]; sh[j] = nsh[j]; sc[j] = nsc[j]; }
        if (r + C.NGW < M) ld(r + C.NGW);
        if (C.lane == 0) *(f32x2*)((float*)(C.ws + WS_STATS) + 2 * (size_t)r) = (f32x2){0.f, 1.0f};
#pragma unroll
        for (int j = 0; j < 4; ++j) { const int c = (C.lane + 64 * j) * 4;
            const f32x4 h = v[j] * (sc[j] + 1.0f) + sh[j];
            if (r >= MP) *(f32x4*)(C.out + (size_t)r * D + c) = v[j] * ALPHA;
            *(v2u*)(H + (size_t)r * D + c) = (v2u){pk2(h.x, h.y), pk2(h.z, h.w)}; }
    }
}

__device__ __forceinline__ void ln_phase(const Args& args, LAS unsigned char* lds_, int l, int which, bool write_h, int hl, int shc, int npart, float xscale, bool write_x) {
    const Ctx C = make_ctx(args, lds_);
    const float* MOD = (const float*)(C.ws + WS_MOD); bf16* H = (bf16*)(C.ws + WS_H);
    const float* g = args.in[11] + (size_t)(l * 3 + which) * D; const float* b = args.in[12] + (size_t)(l * 3 + which) * D;
    f32x4 nv[4], gg[4], bb[4];
#pragma unroll
    for (int j = 0; j < 4; ++j) { gg[j] = *(const f32x4*)(g + (C.lane + 64 * j) * 4); bb[j] = *(const f32x4*)(b + (C.lane + 64 * j) * 4); }
    f32x4 nw[4];
    if (C.gw < M) {
#pragma unroll
        for (int j = 0; j < 4; ++j) nv[j] = *(const f32x4*)(C.out + (size_t)C.gw * D + (C.lane + 64 * j) * 4); }
    if (C.gw + C.NGW < M) {
#pragma unroll
        for (int j = 0; j < 4; ++j) nw[j] = *(const f32x4*)(C.out + (size_t)(C.gw + C.NGW) * D + (C.lane + 64 * j) * 4); }
#pragma unroll 1
    for (int r = C.gw; r < M; r += C.NGW) {
        float* xr = C.out + (size_t)r * D;
        f32x4 v[4]; float s = 0.f;
        const float* modr = MOD + (size_t)(hl * NB + batch_of_row(r)) * NMODC + shc * 1024;
        f32x4 msh[4], msc[4];
        if (write_h) {
#pragma unroll
            for (int j = 0; j < 4; ++j) { msh[j] = *(const f32x4*)(modr + (C.lane + 64 * j) * 4); msc[j] = *(const f32x4*)(modr + 1024 + (C.lane + 64 * j) * 4); } }
#pragma unroll
        for (int j = 0; j < 4; ++j) { v[j] = nv[j]; nv[j] = nw[j]; }
        if (r + 2 * C.NGW < M) {
#pragma unroll
            for (int j = 0; j < 4; ++j) nw[j] = *(const f32x4*)(xr + (size_t)(2 * C.NGW) * D + (C.lane + 64 * j) * 4); }
        if (r >= MP) { const float* pp = (const float*)(C.ws + WS_SB) + (size_t)(r - MP) * D;
#pragma unroll 1
            for (int p = 0; p < npart; p += 4, pp += 4 * 512 * 1024) {
                f32x4 t[4][4];
#pragma unroll
                for (int q = 0; q < 4; ++q) { const float* pq = pp + (size_t)(p + q < npart ? q : 0) * (512 * 1024);
#pragma unroll
                    for (int j = 0; j < 4; ++j) t[q][j] = *(const f32x4*)(pq + (C.lane + 64 * j) * 4); }
#pragma unroll
                for (int q = 0; q < 4; ++q) if (p + q < npart) {
#pragma unroll
                    for (int j = 0; j < 4; ++j) v[j] += t[q][j]; } } }
#pragma unroll
        for (int j = 0; j < 4; ++j) s += (v[j].x + v[j].y) + (v[j].z + v[j].w);
        const float mean = wave_sum2(s) * (1.f / D); float s2 = 0.f;
#pragma unroll
        for (int j = 0; j < 4; ++j) { v[j] = v[j] - mean; s2 += (v[j].x * v[j].x + v[j].y * v[j].y) + (v[j].z * v[j].z + v[j].w * v[j].w); }
        const float rstd = rsqrtf(wave_sum2(s2) * (1.f / D) + LN_EPS);
        if (C.lane == 0) *(f32x2*)((float*)(C.ws + WS_STATS) + 2 * (size_t)r) = (f32x2){mean, rstd};
#pragma unroll
        for (int j = 0; j < 4; ++j) { const int c = (C.lane + 64 * j) * 4;
            const f32x4 xn = v[j] * rstd * gg[j] + bb[j];
            if (write_x || r >= MP) *(f32x4*)(xr + c) = xn * xscale;
            if (write_h) { const f32x4 sh = msh[j], sc = msc[j]; const f32x4 h = xn * (sc + 1.0f) + sh;
                *(v2u*)(H + (size_t)r * D + c) = (v2u){pk2(h.x, h.y), pk2(h.z, h.w)}; }
        }
    }
}

struct PrepRaw { v2u rq, rqp, rk, rkp, hf, hq, dq, dk, dv; unsigned aq; unsigned short db, da; v4u alr0, alr1; f32x4 cs0, cs1; };
__device__ __forceinline__ void prep_load(PrepRaw& x, const bf16* P, int lane, const f32x2* rope_row) {
    const int c = lane * 4;
    const f32x4* cp = (const f32x4*)(rope_row + (c & 31)); x.cs0 = cp[0]; x.cs1 = cp[1];
    x.rq = *(const v2u*)(P + C_RQ + c); x.rqp = *(const v2u*)(P + C_RQ + (c ^ 32)); x.rk = *(const v2u*)(P + C_RK + c); x.rkp = *(const v2u*)(P + C_RK + (c ^ 32));
    x.alr0 = *(const v4u*)(P + C_ALR); x.alr1 = *(const v4u*)(P + C_ALR + 8);
    x.aq = *(const unsigned*)(P + C_AQ + lane * 2);
    x.hf = *(const v2u*)(P + C_HF + c); x.hq = *(const v2u*)(P + C_HQ + c);
    x.dq = *(const v2u*)(P + C_DQKV + c); x.dk = *(const v2u*)(P + C_DQKV + 256 + c); x.dv = *(const v2u*)(P + C_DQKV + 512 + c);
    x.db = P[C_DB + (lane & 3)]; x.da = P[C_DA + (lane & 3)];
}
__device__ __forceinline__ void unpack4(const v2u w, float (&o)[4]) { o[0] = bflo(w.x); o[1] = bfhi(w.x); o[2] = bflo(w.y); o[3] = bfhi(w.y); }

__device__ __forceinline__ void prep_phase(const Args& args, LAS unsigned char* lds_, int l) {
    const Ctx C = make_ctx(args, lds_);
    const bf16* PROJ = (const bf16*)(C.ws + WS_BIG); bf16* SB = (bf16*)(C.ws + WS_SB); float* SF = (float*)(C.ws + WS_SF);
    const f32x2* ROPE = (const f32x2*)(C.ws + WS_ROPE);
    const int lane = C.lane, c4 = lane * 4;
    const float* wg = args.in[18] + (size_t)l * 16 * 128; const float* bg = args.in[19] + (size_t)l * 128;
    const float* cw = args.in[21] + (size_t)l * 4 * 768;
    LAS float* lwg = (LAS float*)C.lds; LAS float* lcw = lwg + 16 * 128;
    for (int i = C.tid; i < 16 * 128; i += NWAVES * 64) lwg[i] = wg[i];
    for (int i = C.tid; i < 4 * 768; i += NWAVES * 64) lcw[i] = cw[i];
    __syncthreads();
    constexpr int CH = 9;
    const int r0 = C.gw * CH, r1 = min(r0 + CH, M);
    if (r0 >= M) return;
    float lbv[4];
#pragma unroll
    for (int i = 0; i < 4; ++i) { lbv[i] = 0.f; if (l == 1) lbv[i] = 1.0f / (1.0f + expf(args.in[20][c4 + i] - args.in[20][256 + c4 + i])); }
    const float a_neg = -expf(args.in[22][l * 4 + (lane & 3)]), dtb = args.in[23][l * 4 + (lane & 3)];
    const float bg0 = bg[lane * 2], bg1 = bg[lane * 2 + 1];
    float w1[3][4], w2[3][4], w3[3][4];
    auto load_window = [&](int r) {
        const bool isp = r < MP; const int rs = r - MP; const int b = isp ? (r >> 11) : (rs >> 2), t = isp ? (r & 2047) : (rs & 3);
        const float* cst = args.in[6] + ((size_t)(l * BS + b) * 3) * 768;
#pragma unroll
        for (int g = 0; g < 3; ++g) { const int ch = g * 256 + c4; const bf16* Pc = PROJ + (size_t)r * NINP + C_DQKV + ch;
            if (t >= 1) unpack4(*(const v2u*)(Pc - 1 * NINP), w1[g]); else { const f32x4 z = isp ? (f32x4){0.f, 0.f, 0.f, 0.f} : *(const f32x4*)(cst + 2 * 768 + ch); w1[g][0] = z.x; w1[g][1] = z.y; w1[g][2] = z.z; w1[g][3] = z.w; }
            if (t >= 2) unpack4(*(const v2u*)(Pc - 2 * NINP), w2[g]); else { const f32x4 z = isp ? (f32x4){0.f, 0.f, 0.f, 0.f} : *(const f32x4*)(cst + (1 + t) * 768 + ch); w2[g][0] = z.x; w2[g][1] = z.y; w2[g][2] = z.z; w2[g][3] = z.w; }
            if (t >= 3) unpack4(*(const v2u*)(Pc - 3 * NINP), w3[g]); else { const f32x4 z = isp ? (f32x4){0.f, 0.f, 0.f, 0.f} : *(const f32x4*)(cst + t * 768 + ch); w3[g][0] = z.x; w3[g][1] = z.y; w3[g][2] = z.z; w3[g][3] = z.w; } }
    };
    auto rope_of = [&](int r) { return ROPE + (size_t)(r < MP ? (r & 2047) : 2048 + ((r - MP) & 3)) * 32; };
    PrepRaw A; prep_load(A, PROJ + (size_t)r0 * NINP, lane, rope_of(r0));
    load_window(r0);
    const bool hi = (c4 & 32) != 0;
#pragma unroll 1
    for (int r = r0; r < r1; ++r) {
        PrepRaw B = A;
        if (r + 1 < r1) prep_load(B, PROJ + (size_t)(r + 1) * NINP, lane, rope_of(r + 1));
        int zo = 0; asm volatile("" : "+v"(zo));
        const bool isp = r < MP; const int rs = r - MP;
        const int b = isp ? (r >> 11) : (rs >> 2), t = isp ? (r & 2047) : (rs & 3);
        bf16* sb = SB + (size_t)r * SBW; float* sf = SF + (size_t)r * SFW;
        { float q[4], qp[4], k[4], kp[4], qo[4], ko[4]; unpack4(A.rq, q); unpack4(A.rqp, qp); unpack4(A.rk, k); unpack4(A.rkp, kp);
          const float cs[8] = {A.cs0.x, A.cs0.y, A.cs0.z, A.cs0.w, A.cs1.x, A.cs1.y, A.cs1.z, A.cs1.w};
#pragma unroll
          for (int e = 0; e < 4; ++e) { const float co = cs[2 * e], si = cs[2 * e + 1];
              qo[e] = hi ? (qp[e] * si + q[e] * co) : (q[e] * co - qp[e] * si);
              ko[e] = (hi ? (kp[e] * si + k[e] * co) : (k[e] * co - kp[e] * si)) * 0.125f; }
          *(v2u*)(sb + SB_RQ + c4) = (v2u){pk2(qo[0], qo[1]), pk2(qo[2], qo[3])};
          *(v2u*)(sb + SB_RK + c4) = (v2u){pk2(ko[0], ko[1]), pk2(ko[2], ko[3])}; }
        { const unsigned aw[8] = {A.alr0.x, A.alr0.y, A.alr0.z, A.alr0.w, A.alr1.x, A.alr1.y, A.alr1.z, A.alr1.w};
          float x0 = bg0, x1 = bg1;
#pragma unroll
          for (int i = 0; i < 8; ++i) { const float a0 = bflo(aw[i]), a1 = bfhi(aw[i]);
              const f32x2 wa = *(const LAS f32x2*)(lwg + (2 * i) * 128 + lane * 2 + zo), wb = *(const LAS f32x2*)(lwg + (2 * i + 1) * 128 + lane * 2 + zo);
              x0 += a0 * wa.x + a1 * wb.x; x1 += a0 * wa.y + a1 * wb.y; }
          const float sp0 = fmaxf(-x0, 0.f) + __logf(1.0f + __expf(-fabsf(x0))), sp1 = fmaxf(-x1, 0.f) + __logf(1.0f + __expf(-fabsf(x1)));
          *(f32x2*)(sf + SF_ADEC + lane * 2) = (f32x2){__expf(-sp0 * (1.0f / 16.0f)), __expf(-sp1 * (1.0f / 16.0f))};
          *(unsigned*)(sb + SB_AQ + lane * 2) = pk2(bflo(A.aq) * 0.17677669529663687f, bfhi(A.aq) * 0.17677669529663687f); }
        { float zf[4], zq[4], fo[4], qo[4]; unpack4(A.hf, zf); unpack4(A.hq, zq);
#pragma unroll
          for (int e = 0; e < 4; ++e) { fo[e] = lbv[e] + (1.0f - lbv[e]) * sigmoidf_(zf[e]); qo[e] = siluf_(zq[e]) * 0.125f; }
          *(f32x4*)(sf + SF_HF + c4) = (f32x4){fo[0], fo[1], fo[2], fo[3]};
          *(v2u*)(sb + SB_HQ + c4) = (v2u){pk2(qo[0], qo[1]), pk2(qo[2], qo[3])}; }
        { float* cso = isp ? C.out + O_PCONV + ((size_t)(l * BP + b) * 3) * 768 : C.out + O_SCONV + ((size_t)(l * BS + b) * 3) * 768;
          const int so = isp ? t - (TP - 3) : t - 1;
          float uu[3][4];
#pragma unroll
          for (int g = 0; g < 3; ++g) { float x0[4]; unpack4(g == 0 ? A.dq : g == 1 ? A.dk : A.dv, x0);
              const LAS float* cwc = lcw + g * 256 + c4 + zo;
              const f32x4 k0 = *(const LAS f32x4*)(cwc), k1 = *(const LAS f32x4*)(cwc + 768), k2 = *(const LAS f32x4*)(cwc + 2 * 768), k3 = *(const LAS f32x4*)(cwc + 3 * 768);
#pragma unroll
              for (int e = 0; e < 4; ++e) { uu[g][e] = siluf_(x0[e] * k3[e] + w1[g][e] * k2[e] + w2[g][e] * k1[e] + w3[g][e] * k0[e]);
                  w3[g][e] = w2[g][e]; w2[g][e] = w1[g][e]; w1[g][e] = x0[e]; }
              if (so >= 0) *(f32x4*)(cso + so * 768 + g * 256 + c4) = (f32x4){x0[0], x0[1], x0[2], x0[3]}; }
          const float qn = row16_sum(uu[0][0] * uu[0][0] + uu[0][1] * uu[0][1] + uu[0][2] * uu[0][2] + uu[0][3] * uu[0][3]);
          const float kn = row16_sum(uu[1][0] * uu[1][0] + uu[1][1] * uu[1][1] + uu[1][2] * uu[1][2] + uu[1][3] * uu[1][3]);
          const float qs = rsqrtf(qn + RMS_EPS) * 0.125f, ks = rsqrtf(kn + RMS_EPS);
          const unsigned q01 = pk2(uu[0][0] * qs, uu[0][1] * qs), q23 = pk2(uu[0][2] * qs, uu[0][3] * qs), k01 = pk2(uu[1][0] * ks, uu[1][1] * ks), k23 = pk2(uu[1][2] * ks, uu[1][3] * ks);
          *(v2u*)(sb + SB_DQ + c4) = (v2u){q01, q23}; *(v2u*)(sb + SB_DK + c4) = (v2u){k01, k23};
          *(v2u*)(sb + SB_DV + c4) = (v2u){pk2(uu[2][0], uu[2][1]), pk2(uu[2][2], uu[2][3])};
          const float qk = row16_sum(bflo(q01) * bflo(k01) + bfhi(q01) * bfhi(k01) + bflo(q23) * bflo(k23) + bfhi(q23) * bfhi(k23));
          if ((lane & 15) == 0) sf[SF_QK + (lane >> 4)] = qk;
          if (lane < 4) { sf[SF_BETA + lane] = sigmoidf_(bf2f(A.db));
              const float xx = bf2f(A.da) + dtb; const float sp = fmaxf(xx, 0.f) + __logf(1.0f + __expf(-fabsf(xx)));
              sf[SF_DDEC + lane] = __expf(a_neg * sp); } }
        A = B;
        if (r + 1 < r1) { const int rn = r + 1; const bool ns = rn < MP ? ((rn & 2047) == 0) : (((rn - MP) & 3) == 0); if (ns) load_window(rn); }
    }
}

template <int KIND, int DH, int R> struct Raw { unsigned q[DH / 2]; unsigned k[DH / 2]; unsigned v[(R + 1) / 2]; float f[DH]; float be, de; };

template <int KIND, int DH, int R>
__device__ __forceinline__ void load_tok(Raw<KIND, DH, R>& x, const bf16* qp, const bf16* kp, const bf16* vp, const float* fp) {
    if constexpr (DH == 4) { const v2u w = *(const v2u*)qp; x.q[0] = w.x; x.q[1] = w.y; } else { x.q[0] = *(const unsigned*)qp; }
    if constexpr (KIND != 2) { if constexpr (DH == 4) { const v2u w = *(const v2u*)kp; x.k[0] = w.x; x.k[1] = w.y; } else { x.k[0] = *(const unsigned*)kp; } }
    if constexpr (R == 1) x.v[0] = *vp; else if constexpr (R == 2) x.v[0] = *(const unsigned*)vp; else { const v2u w = *(const v2u*)vp; x.v[0] = w.x; x.v[1] = w.y; }
    if constexpr (KIND == 1) { const f32x2 w = *(const f32x2*)fp; x.f[0] = w.x; x.f[1] = w.y; }
    if constexpr (KIND == 2) { const f32x4 w = *(const f32x4*)fp; x.f[0] = w.x; x.f[1] = w.y; x.f[2] = w.z; x.f[3] = w.w; }
    if constexpr (KIND == 3) { x.be = fp[0]; x.de = fp[4]; }
}

template <int KIND, int DH, int R>
__device__ __forceinline__ void scan_task(const Ctx& C, int row0, int T, int h, int slice, const float* sin, float* sout) {
    const bf16* PROJ = (const bf16*)(C.ws + WS_BIG); const bf16* SB = (const bf16*)(C.ws + WS_SB); const float* SF = (const float*)(C.ws + WS_SF);
    bf16* H = (bf16*)(C.ws + WS_H);
    const int lane = C.lane, dl = lane & 15, rw = lane >> 4;
    const int d0 = dl * DH, v0 = slice * (4 * R) + rw * R;
    constexpr int DK = 16 * DH;
    const bf16 *qp, *kp, *vp; const float* fp; int ks, vs;
    const bf16* sbr = SB + (size_t)row0 * SBW; const bf16* pr = PROJ + (size_t)row0 * NINP; const float* sfr = SF + (size_t)row0 * SFW;
    if constexpr (KIND == 0) { qp = sbr + SB_RQ + h * 64 + d0; kp = sbr + SB_RK + h * 64 + d0; ks = SBW; vp = pr + C_RV + h * 64 + v0; vs = NINP; fp = sfr; }
    if constexpr (KIND == 1) { qp = sbr + SB_AQ + h * 32 + d0; kp = pr + C_AK + h * 32 + d0; ks = NINP; vp = pr + C_AV + h * 64 + v0; vs = NINP; fp = sfr + SF_ADEC + h * 32 + d0; }
    if constexpr (KIND == 2) { qp = sbr + SB_HQ + h * 64 + d0; kp = sbr; ks = SBW; vp = pr + C_HI + h * 64 + v0; vs = NINP; fp = sfr + SF_HF + h * 64 + d0; }
    if constexpr (KIND == 3) { qp = sbr + SB_DQ + h * 64 + d0; kp = sbr + SB_DK + h * 64 + d0; ks = SBW; vp = sbr + SB_DV + h * 64 + v0; vs = SBW; fp = sfr + SF_BETA + h; }
    bf16* op = H + (size_t)row0 * D + KIND * 256 + h * 64 + v0;
    const float rdec = 1.0f - exp2f(-5.0f - (float)h);

    float S[DH][R];
#pragma unroll
    for (int dh = 0; dh < DH; ++dh)
#pragma unroll
        for (int vv = 0; vv < R; ++vv) S[dh][vv] = sin ? sin[(size_t)(d0 + dh) * 64 + v0 + vv] : 0.f;

    typedef Raw<KIND, DH, R> RawT;
    RawT A[4];
#pragma unroll
    for (int u = 0; u < 4; ++u) load_tok<KIND, DH, R>(A[u], qp + (size_t)u * SBW, kp + (size_t)u * ks, vp + (size_t)u * vs, fp + (size_t)u * SFW);
    for (int t0 = 0; t0 < T; t0 += 4) {
        RawT B[4];
        const bool more = t0 + 4 < T;
#pragma unroll
        for (int u = 0; u < 4; ++u) { B[u] = A[u]; }
        if (more) {
#pragma unroll
            for (int u = 0; u < 4; ++u) load_tok<KIND, DH, R>(B[u], qp + (size_t)(t0 + 4 + u) * SBW, kp + (size_t)(t0 + 4 + u) * ks, vp + (size_t)(t0 + 4 + u) * vs, fp + (size_t)(t0 + 4 + u) * SFW);
        }
#pragma unroll
        for (int u = 0; u < 4; ++u) {
            const RawT& x = A[u];
            float q[DH], k[DH], v[R];
            q[0] = bflo(x.q[0]); q[1] = bfhi(x.q[0]); if constexpr (DH == 4) { q[2] = bflo(x.q[1]); q[3] = bfhi(x.q[1]); }
            if constexpr (KIND != 2) { k[0] = bflo(x.k[0]); k[1] = bfhi(x.k[0]); if constexpr (DH == 4) { k[2] = bflo(x.k[1]); k[3] = bfhi(x.k[1]); } }
            if constexpr (R == 1) v[0] = bflo(x.v[0]);
            if constexpr (R >= 2) { v[0] = bflo(x.v[0]); v[1] = bfhi(x.v[0]); }
            if constexpr (R == 4) { v[2] = bflo(x.v[1]); v[3] = bfhi(x.v[1]); }
            float o[R];
            if constexpr (KIND == 3) {
                float ks_[R];
#pragma unroll
                for (int vv = 0; vv < R; ++vv) { float p = 0.f;
#pragma unroll
                    for (int dh = 0; dh < DH; ++dh) { S[dh][vv] *= x.de; p += k[dh] * S[dh][vv]; }
                    ks_[vv] = row16_sum(p); }
#pragma unroll
                for (int vv = 0; vv < R; ++vv) { const float uu = x.be * (v[vv] - ks_[vv]); float p = 0.f;
#pragma unroll
                    for (int dh = 0; dh < DH; ++dh) { S[dh][vv] += k[dh] * uu; p += q[dh] * S[dh][vv]; }
                    o[vv] = row16_sum(p); }
            } else {
#pragma unroll
                for (int dh = 0; dh < DH; ++dh) {
                    float dec, kk;
                    if constexpr (KIND == 0) { dec = rdec; kk = k[dh]; }
                    if constexpr (KIND == 1) { dec = x.f[dh]; kk = k[dh]; }
                    if constexpr (KIND == 2) { dec = x.f[dh]; kk = 1.0f - x.f[dh]; }
#pragma unroll
                    for (int vv = 0; vv < R; ++vv) S[dh][vv] = dec * S[dh][vv] + kk * v[vv];
                }
#pragma unroll
                for (int vv = 0; vv < R; ++vv) { float p = 0.f;
#pragma unroll
                    for (int dh = 0; dh < DH; ++dh) p += q[dh] * S[dh][vv];
                    o[vv] = row16_sum(p); }
            }
            if (dl == 0) {
                bf16* o_ = op + (size_t)(t0 + u) * D;
                if constexpr (R == 1) *o_ = (bf16)(pk2(o[0], 0.f) & 0xffffu);
                if constexpr (R == 2) *(unsigned*)o_ = pk2(o[0], o[1]);
                if constexpr (R == 4) *(v2u*)o_ = (v2u){pk2(o[0], o[1]), pk2(o[2], o[3])};
            }
        }
#pragma unroll
        for (int u = 0; u < 4; ++u) A[u] = B[u];
    }
#pragma unroll
    for (int dh = 0; dh < DH; ++dh)
#pragma unroll
        for (int vv = 0; vv < R; ++vv) sout[(size_t)(d0 + dh) * 64 + v0 + vv] = S[dh][vv];
    (void)DK;
}

template <int KIND, int DH, int R>
__device__ __forceinline__ void scan_long(const Ctx& C, LAS float* wl, int row0, int T, int h, int slice, float* sout) {
    constexpr int CT = 16, LR = 8, DK = LR * DH, NV = (64 / LR) * R, UNR = 8;
    constexpr bool HASK = true, GK = (KIND != 2), HASF = (KIND == 1 || KIND == 2), HASB = (KIND == 3);
    constexpr int DKP = DK + 4;
    constexpr int OQ = 0, OK_ = OQ + CT * DKP, OF = OK_ + (HASK ? CT * DKP : 0), OV = OF + (HASF ? CT * DKP : 0), OB = OV + CT * NV, BUF = OB + (HASB ? CT * 4 : 0);
    const bf16* PROJ = (const bf16*)(C.ws + WS_BIG); const bf16* SB = (const bf16*)(C.ws + WS_SB); const float* SF = (const float*)(C.ws + WS_SF);
    bf16* H = (bf16*)(C.ws + WS_H);
    const int lane = C.lane, dl = lane & (LR - 1), rw = lane / LR;
    const int d0 = dl * DH;
    const int stok = lane >> 2, spart = lane & 3;
    const GAS bf16 *qg, *kg, *vg; const GAS float *fg, *bg; int ks, vs;
    {
        const GAS bf16* sbr = (const GAS bf16*)(SB + (size_t)row0 * SBW); const GAS bf16* pr = (const GAS bf16*)(PROJ + (size_t)row0 * NINP); const GAS float* sfr = (const GAS float*)(SF + (size_t)row0 * SFW);
        const int vcol = slice * NV;
        if constexpr (KIND == 0) { qg = sbr + SB_RQ + h * 64; kg = sbr + SB_RK + h * 64; ks = SBW; vg = pr + C_RV + h * 64 + vcol; vs = NINP; fg = sfr; bg = sfr; }
        if constexpr (KIND == 1) { qg = sbr + SB_AQ + h * 32; kg = pr + C_AK + h * 32; ks = NINP; vg = pr + C_AV + h * 64 + vcol; vs = NINP; fg = sfr + SF_ADEC + h * 32; bg = sfr; }
        if constexpr (KIND == 2) { qg = sbr + SB_HQ + h * 64; kg = sbr; ks = SBW; vg = pr + C_HI + h * 64 + vcol; vs = NINP; fg = sfr + SF_HF + h * 64; bg = sfr; }
        if constexpr (KIND == 3) { qg = sbr + SB_DQ + h * 64; kg = sbr + SB_DK + h * 64; ks = SBW; vg = sbr + SB_DV + h * 64 + vcol; vs = SBW; fg = sfr; bg = sfr + SF_BETA + h; }
    }
    constexpr int QP = DK / 4;
    qg += (size_t)stok * SBW + spart * QP; kg += (size_t)stok * ks + spart * QP; fg += (size_t)stok * SFW + spart * QP;
    vg += (size_t)(lane & 15) * vs; bg += (size_t)(lane & 15) * SFW;
    GAS bf16* op = (GAS bf16*)(H + (size_t)row0 * D + KIND * 256 + h * 64 + slice * NV + rw * R);
    const float rdec = 1.0f - exp2f(-5.0f - (float)h);

    static_assert(R == 1, "scan_long: one column per lane row");
    f32x2 S2[DH / 2];
#pragma unroll
    for (int i = 0; i < DH / 2; ++i) S2[i] = (f32x2){0.f, 0.f};

    struct SR { v4u rq[QP / 8], rk[QP / 8]; f32x4 rf[QP / 4]; unsigned rv[NV / 2]; float rb0, rb1, rb2; };
    SR s0; s0.rb0 = s0.rb1 = s0.rb2 = 0.f;
    auto stage_load = [&](SR& sr, int c) {
        const size_t t = (size_t)c * CT;
#pragma unroll
        for (int i = 0; i < QP / 8; ++i) { sr.rq[i] = *(const GAS v4u*)(qg + t * SBW + i * 8); if constexpr (GK) sr.rk[i] = *(const GAS v4u*)(kg + t * ks + i * 8); }
        if constexpr (HASF) {
#pragma unroll
            for (int i = 0; i < QP / 4; ++i) sr.rf[i] = *(const GAS f32x4*)(fg + t * SFW + i * 4); }
        if (lane < 16) {
            if constexpr (NV == 4) { const v2u w = *(const GAS v2u*)(vg + t * vs); sr.rv[0] = w.x; sr.rv[1] = w.y; }
            if constexpr (NV == 8) { const v4u w = *(const GAS v4u*)(vg + t * vs); sr.rv[0] = w.x; sr.rv[1] = w.y; sr.rv[2] = w.z; sr.rv[3] = w.w; }
            if constexpr (NV == 16) { const v4u w = *(const GAS v4u*)(vg + t * vs), w2 = *(const GAS v4u*)(vg + t * vs + 8); sr.rv[0] = w.x; sr.rv[1] = w.y; sr.rv[2] = w.z; sr.rv[3] = w.w; sr.rv[4] = w2.x; sr.rv[5] = w2.y; sr.rv[6] = w2.z; sr.rv[7] = w2.w; }
            if constexpr (HASB) { sr.rb0 = bg[t * SFW]; sr.rb1 = bg[t * SFW + 4]; sr.rb2 = bg[t * SFW + 8]; }
        }
    };
    auto stage_write = [&](SR& sr, int b) {
        LAS float* base = wl + b * BUF;
#pragma unroll
        for (int i = 0; i < QP / 8; ++i) {
            LAS float* qd = base + OQ + stok * DKP + spart * QP + i * 8;
            *(LAS f32x4*)qd = (f32x4){bflo(sr.rq[i].x), bfhi(sr.rq[i].x), bflo(sr.rq[i].y), bfhi(sr.rq[i].y)}; *(LAS f32x4*)(qd + 4) = (f32x4){bflo(sr.rq[i].z), bfhi(sr.rq[i].z), bflo(sr.rq[i].w), bfhi(sr.rq[i].w)};
            if constexpr (GK) { LAS float* kd = base + OK_ + stok * DKP + spart * QP + i * 8;
                *(LAS f32x4*)kd = (f32x4){bflo(sr.rk[i].x), bfhi(sr.rk[i].x), bflo(sr.rk[i].y), bfhi(sr.rk[i].y)}; *(LAS f32x4*)(kd + 4) = (f32x4){bflo(sr.rk[i].z), bfhi(sr.rk[i].z), bflo(sr.rk[i].w), bfhi(sr.rk[i].w)}; }
        }
        if constexpr (HASF) {
#pragma unroll
            for (int i = 0; i < QP / 4; ++i) { *(LAS f32x4*)(base + OF + stok * DKP + spart * QP + i * 4) = sr.rf[i];
                if constexpr (KIND == 2) *(LAS f32x4*)(base + OK_ + stok * DKP + spart * QP + i * 4) = 1.0f - sr.rf[i]; } }
        if (lane < 16) {
#pragma unroll
            for (int i = 0; i < NV / 2; ++i) { base[OV + lane * NV + 2 * i] = bflo(sr.rv[i]); base[OV + lane * NV + 2 * i + 1] = bfhi(sr.rv[i]); }
            if constexpr (HASB) *(LAS f32x4*)(base + OB + lane * 4) = (f32x4){sr.rb0, sr.rb1, sr.rb2, 0.f};
        }
    };
    static_assert(2 * BUF * 4 <= 27648, "per-wave LDS");
    const int nch = T / CT;
    struct Opnd { f32x2 q2[DH / 2], k2[DH / 2], f2[DH / 2]; float v; f32x4 bd; };
    auto ldop = [&](Opnd& x, const LAS float* bq, const LAS float* bv, const LAS float* bb, int uu) {
#pragma unroll
        for (int i = 0; i < DH / 4; ++i) { const f32x4 w = *(const LAS f32x4*)(bq + OQ + uu * DKP + 4 * i); x.q2[2 * i] = (f32x2){w.x, w.y}; x.q2[2 * i + 1] = (f32x2){w.z, w.w}; }
#pragma unroll
        for (int i = 0; i < DH / 4; ++i) { const f32x4 w = *(const LAS f32x4*)(bq + OK_ + uu * DKP + 4 * i); x.k2[2 * i] = (f32x2){w.x, w.y}; x.k2[2 * i + 1] = (f32x2){w.z, w.w}; }
        if constexpr (HASF) {
#pragma unroll
            for (int i = 0; i < DH / 4; ++i) { const f32x4 w = *(const LAS f32x4*)(bq + OF + uu * DKP + 4 * i); x.f2[2 * i] = (f32x2){w.x, w.y}; x.f2[2 * i + 1] = (f32x2){w.z, w.w}; } }
        x.v = bv[uu * NV];
        if constexpr (HASB) x.bd = *(const LAS f32x4*)(bb + uu * 4);
    };
    auto compute = [&](int c, const LAS float* base) {
#pragma unroll 1
        for (int ub = 0; ub < CT; ub += UNR) {
        float okeep[R];
#pragma unroll
        for (int vv = 0; vv < R; ++vv) okeep[vv] = 0.f;
        Opnd X; X.bd = (f32x4){0.f, 0.f, 0.f, 0.f};
#pragma unroll
        for (int i = 0; i < DH / 2; ++i) X.f2[i] = (f32x2){0.f, 0.f};
        const LAS float* bq = base + ub * DKP + d0; const LAS float* bv = base + OV + ub * NV + rw; const LAS float* bb = base + OB + ub * 4;
        ldop(X, bq, bv, bb, 0);
#pragma unroll
        for (int uu_ = 0; uu_ < UNR; ++uu_) { const int u = ub + uu_;
            Opnd Y = X;
            if (uu_ + 1 < UNR) ldop(Y, bq, bv, bb, uu_ + 1);
            f32x2 (&q2)[DH / 2] = X.q2; f32x2 (&k2)[DH / 2] = X.k2; f32x2 (&f2)[DH / 2] = X.f2; const float vv_ = X.v; const f32x4 bd = X.bd;
            float o[1];
            if constexpr (KIND == 3) {
                f32x2 a = k2[0] * S2[0], bq_ = q2[0] * S2[0];
#pragma unroll
                for (int i = 1; i < DH / 2; ++i) { a = __builtin_elementwise_fma(k2[i], S2[i], a); bq_ = __builtin_elementwise_fma(q2[i], S2[i], bq_); }
                const float ks_ = row8_sum(a.x + a.y) * bd.y, qs_ = row8_sum(bq_.x + bq_.y) * bd.y;
                const float uu = bd.x * (vv_ - ks_);
                o[0] = __builtin_fmaf(bd.z, uu, qs_);
                const f32x2 de2 = (f32x2){bd.y, bd.y}, uu2 = (f32x2){uu, uu};
#pragma unroll
                for (int i = 0; i < DH / 2; ++i) S2[i] = __builtin_elementwise_fma(S2[i], de2, k2[i] * uu2);
            } else {
                const f32x2 v2 = (f32x2){vv_, vv_};
#pragma unroll
                for (int i = 0; i < DH / 2; ++i) {
                    f32x2 dec2;
                    if constexpr (KIND == 0) dec2 = (f32x2){rdec, rdec}; else dec2 = f2[i];
                    S2[i] = __builtin_elementwise_fma(S2[i], dec2, k2[i] * v2);
                }
            }
            if constexpr (KIND != 3)
            { f32x2 a = q2[0] * S2[0];
#pragma unroll
              for (int i = 1; i < DH / 2; ++i) a = __builtin_elementwise_fma(q2[i], S2[i], a);
              o[0] = row8_sum(a.x + a.y); }
#pragma unroll
            for (int vv = 0; vv < R; ++vv) okeep[vv] = (dl == uu_) ? o[vv] : okeep[vv];
            X = Y;
        }
        {
            GAS bf16* o_ = op + (size_t)(c * CT + ub + dl) * D;
            if constexpr (R == 1) *o_ = (bf16)(pk2(okeep[0], 0.f) & 0xffffu);
            if constexpr (R == 2) *(GAS unsigned*)o_ = pk2(okeep[0], okeep[1]);
            if constexpr (R == 4) *(GAS v2u*)o_ = (v2u){pk2(okeep[0], okeep[1]), pk2(okeep[2], okeep[3])};
        }
        }
    };
    stage_load(s0, 0); stage_write(s0, 0);
#pragma unroll 1
    for (int c = 0; c < nch; c += 2) {
        stage_load(s0, min(c + 1, nch - 1));
        compute(c, wl);
        stage_write(s0, 1);
        stage_load(s0, min(c + 2, nch - 1));
        compute(c + 1, wl + BUF);
        stage_write(s0, 0);
    }
    const int v0 = slice * NV + rw * R;
#pragma unroll
    for (int i = 0; i < DH / 2; ++i) { sout[(size_t)(d0 + 2 * i) * 64 + v0] = S2[i].x; sout[(size_t)(d0 + 2 * i + 1) * 64 + v0] = S2[i].y; }
}

__device__ __forceinline__ void scan_phase(const Args& args, LAS unsigned char* lds_, int l, int mode = 0) {
    const Ctx C = make_ctx(args, lds_);
    constexpr int NLONG = 1024, NSHORT = BS * 144;
    const int slot = C.wave * 256 + (int)blockIdx.x;
    const int nidle = C.NGW - NLONG - 256;
    for (int it = 0;; ++it) {
        int kind, b, h, slice, row0, T; bool isp;
        if (slot < NLONG) { if (it > 0 || mode == 2) break; isp = true; T = TP;
            const int kk_ = slot >> 8, i = slot & 255; kind = kk_ == 0 ? 3 : (kk_ == 1 ? 0 : (kk_ == 2 ? 2 : 1));
            { const int stream = (i & 7) | ((i >> 6) << 3); slice = (i >> 3) & 7; b = stream >> 2; h = stream & 3; }
            row0 = b * TP;
        } else { if (C.wave < 5) break;
            const int st = (slot - NLONG - 256) + it * nidle; if (st >= NSHORT || mode == 1) break; isp = false; T = TS;
            b = st / 144; int i = st - b * 144;
            if (i < 64) { kind = 3; h = i >> 4; slice = i & 15; }
            else if (i < 96) { i -= 64; kind = 0; h = i >> 3; slice = i & 7; }
            else if (i < 128) { i -= 96; kind = 2; h = i >> 3; slice = i & 7; }
            else { i -= 128; kind = 1; h = i >> 2; slice = i & 3; }
            row0 = MP + b * TS;
        }
        const int nbat = isp ? BP : BS;
        const size_t sidx = (size_t)((l * nbat + b) * 4 + h);
        if (isp) {
            LAS float* wl = (LAS float*)(C.lds + C.wave * 27648);
            if (kind == 0) scan_long<0, 8, 1>(C, wl, row0, T, h, slice, C.out + O_PRET + sidx * 4096);
            else if (kind == 1) scan_long<1, 4, 1>(C, wl, row0, T, h, slice, C.out + O_PGLA + sidx * 2048);
            else if (kind == 2) scan_long<2, 8, 1>(C, wl, row0, T, h, slice, C.out + O_PHG + sidx * 4096);
            else scan_long<3, 8, 1>(C, wl, row0, T, h, slice, C.out + O_PGDN + sidx * 4096);
        } else {
            if (kind == 0) { scan_task<0, 4, 2>(C, row0, T, h, slice, args.in[2] + sidx * 4096, C.out + O_SRET + sidx * 4096); }
            else if (kind == 1) { scan_task<1, 2, 4>(C, row0, T, h, slice, args.in[3] + sidx * 2048, C.out + O_SGLA + sidx * 2048); }
            else if (kind == 2) { scan_task<2, 4, 2>(C, row0, T, h, slice, args.in[4] + sidx * 4096, C.out + O_SHG + sidx * 4096); }
            else { scan_task<3, 4, 1>(C, row0, T, h, slice, args.in[5] + sidx * 4096, C.out + O_SGDN + sidx * 4096); }
        }
    }
    if (l == 0 && C.wave >= 5 && mode != 1) {
        LAS float* scr = (LAS float*)(C.lds + 4 * 27648 + (C.wave - 5) * 8704);
        constexpr int I_F0 = I_WI + I_WO, I_L0B = I_F0 + I_WOUT;
        for (int it = (C.wave - 5) * 256 + (int)blockIdx.x; it < I_L0B + I_MAIN; it += 768) {
            if (it < I_F0) convert_item(args, C.ws, 0, I_F0 + it, scr, C.lane);
            else if (it < I_L0B) convert_item(args, C.ws, 0, 2 * I_F0 + I_WIN + (it - I_F0), scr, C.lane);
            else convert_item(args, C.ws, 1, it - I_L0B, scr, C.lane);
        }
    }
}

__device__ __forceinline__ void post_phase(const Args& args, LAS unsigned char* lds_, int l) {
    const Ctx C = make_ctx(args, lds_);
    const bf16* PROJ = (const bf16*)(C.ws + WS_BIG); bf16* H = (bf16*)(C.ws + WS_H);
    const int lane = C.lane, mixer = lane >> 4, cc = (lane & 15) * 16;
    const int gbase = mixer == 0 ? C_RG : mixer == 1 ? C_AG : mixer == 2 ? C_HG : C_DG;
    const float* nw = mixer == 1 ? args.in[24] + l * 64 : mixer == 2 ? args.in[25] + l * 64 : args.in[26] + l * 64;
    float w[16];
#pragma unroll
    for (int i = 0; i < 16; ++i) w[i] = mixer == 0 ? 1.0f : nw[(cc + i) & 63];
    v4u na0, na1, ng0, ng1;
    if (C.gw < M) { const bf16* hp = H + (size_t)C.gw * D + lane * 16; const bf16* gp = PROJ + (size_t)C.gw * NINP + gbase + cc;
        na0 = *(const v4u*)hp; na1 = *(const v4u*)(hp + 8); ng0 = *(const v4u*)gp; ng1 = *(const v4u*)(gp + 8); }
#pragma unroll 1
    for (int r = C.gw; r < M; r += C.NGW) {
        bf16* hp = H + (size_t)r * D + lane * 16; const bf16* gp = PROJ + (size_t)r * NINP + gbase + cc;
        const v4u a0 = na0, a1 = na1, g0 = ng0, g1 = ng1;
        if (r + C.NGW < M) { const bf16* hn = hp + (size_t)C.NGW * D; const bf16* gn = gp + (size_t)C.NGW * NINP;
            na0 = *(const v4u*)hn; na1 = *(const v4u*)(hn + 8); ng0 = *(const v4u*)gn; ng1 = *(const v4u*)(gn + 8); }
        float y[16], g[16];
        const unsigned aw[8] = {a0.x, a0.y, a0.z, a0.w, a1.x, a1.y, a1.z, a1.w}, gw_[8] = {g0.x, g0.y, g0.z, g0.w, g1.x, g1.y, g1.z, g1.w};
        float ss = 0.f;
#pragma unroll
        for (int i = 0; i < 8; ++i) { y[2 * i] = bflo(aw[i]); y[2 * i + 1] = bfhi(aw[i]); g[2 * i] = bflo(gw_[i]); g[2 * i + 1] = bfhi(gw_[i]); ss += y[2 * i] * y[2 * i] + y[2 * i + 1] * y[2 * i + 1]; }
        ss = quad_sum(ss);
        const float rs = rsqrtf(ss * (1.0f / 64.0f) + RMS_EPS);
        unsigned ow[8];
#pragma unroll
        for (int i = 0; i < 8; ++i) ow[i] = pk2(y[2 * i] * rs * w[2 * i] * siluf_(g[2 * i]), y[2 * i + 1] * rs * w[2 * i + 1] * siluf_(g[2 * i + 1]));
        *(v4u*)hp = (v4u){ow[0], ow[1], ow[2], ow[3]}; *(v4u*)(hp + 8) = (v4u){ow[4], ow[5], ow[6], ow[7]};
    }
}

__global__ void __launch_bounds__(NWAVES * 64, 2) mega_fwd(Args args) {
    extern __shared__ __attribute__((aligned(16))) unsigned char lds[];
    cg::grid_group grid = cg::this_grid();
    LAS unsigned char* const LDSP = (LAS unsigned char*)lds;
    const int G = (int)gridDim.x, bx = (int)blockIdx.x;
    if (threadIdx.x < 64) ((LAS unsigned*)(LDSP + MISC_OFF))[threadIdx.x] = 0u;
    __syncthreads();
    (void)xcd_barrier_post((unsigned*)args.ws, (volatile LAS unsigned*)(LDSP + MISC_OFF));
#define FRESH() float* out_ = fresh_ptr(args.out); unsigned char* ws = fresh_ptr(args.ws); \
    float* MOD = (float*)(ws + WS_MOD); bf16* H = (bf16*)(ws + WS_H); bf16* BIG = (bf16*)(ws + WS_BIG); (void)MOD; (void)H; (void)BIG; (void)out_;

    p0_prologue(args, LDSP);
    if (args.ws == nullptr) grid.sync();
    grid_bar(args, LDSP);
    {
        FRESH();
        pg8::Gemm g{(const bf16*)(ws + WS_AC), BIG, 256, 2 * NMODC, D}; pg8::StaticOrder S; S.init(256, 2 * NMODC, G, bx, D);
        pg8::EpiMod E{MOD, args.in[10]};
        pg8::gemm_phase<pg8::EpiMod, pg8::StaticOrder, PG8_ALIGN, PG8_SP2>(LDSP, g, S, E);
    }
    p1_convert(args, LDSP);
    grid_bar(args, LDSP);
    p2_modulate0(args, LDSP);
    grid_bar(args, LDSP);
#pragma unroll 1
    for (int l = 0; l < 2; ++l) {
#pragma unroll 1
        for (int f = 0; f < 2; ++f) {
            if (f == 1) {
                {
                    FRESH();
                    pg8::Gemm g{H, (const bf16*)(ws + WS_W + (size_t)l * W_LAYER + W_WIN), M, NINP, D}; pg8::StaticOrder S; S.init(M, NINP, G, bx, D);
                    pg8::EpiPlain E{BIG, NINP};
                    pg8::gemm_phase<pg8::EpiPlain, pg8::StaticOrder, PG8_ALIGN, PG8_SP2>(LDSP, g, S, E);
                }
                grid_bar(args, LDSP);
                prep_phase(args, LDSP, l);
                grid_bar(args, LDSP);
                scan_phase(args, LDSP, l);
#ifdef PROBE_SCANMODE
                grid_bar(args, LDSP); scan_phase(args, LDSP, l, PROBE_SCANMODE);
#endif
                grid_bar(args, LDSP);
                post_phase(args, LDSP, l);
                grid_bar(args, LDSP);
                {
                    FRESH();
                    pg8::Gemm g{H, (const bf16*)(ws + WS_W + (size_t)l * W_LAYER + W_WOUT), M, D, D}; pg8::SplitOrder S; S.init(D, G, bx);
                    pg8::EpiRes E{out_, out_, (float*)(ws + WS_SB), MOD + (size_t)l * NB * NMODC + 5 * 1024, (const float*)(ws + WS_STATS), args.in[11] + (size_t)(l * 3) * D, args.in[12] + (size_t)(l * 3) * D, 1.0f, D / 64};
                    pg8::gemm_phase<pg8::EpiRes, pg8::SplitOrder, PG8_ALIGN, PG8_SP2>(LDSP, g, S, E);
                }
                grid_bar(args, LDSP);
                ln_phase(args, LDSP, l, 1, true, l, 6, 4, ALPHA, false);
                grid_bar(args, LDSP);
            }
            {
                FRESH();
                pg8::Gemm g{H, (const bf16*)(ws + WS_W + (size_t)l * W_LAYER + (f ? W_WI2 : W_WI1)), M, NWI, D}; pg8::StaticOrder S; S.init(M, NWI, G, bx, D);
                pg8::EpiSwiglu E{BIG, DFF};
                pg8::gemm_phase<pg8::EpiSwiglu, pg8::StaticOrder, PG8_ALIGN, PG8_SP2>(LDSP, g, S, E);
            }
            grid_bar(args, LDSP);
            {
                FRESH();
                pg8::Gemm g{BIG, (const bf16*)(ws + WS_W + (size_t)l * W_LAYER + (f ? W_WO2 : W_WO1)), M, D, DFF}; pg8::SplitOrder S; S.init(DFF, G, bx);
                const bool first = (l == 0 && f == 0); const int pinst = f ? l * 3 + 1 : l * 3 - 1;
                pg8::EpiRes E{out_, first ? args.in[0] : out_, (float*)(ws + WS_SB), MOD + (size_t)l * NB * NMODC + (f ? 8 : 2) * 1024, (const float*)(ws + WS_STATS),
                              first ? (const float*)(ws + WS_ID) : args.in[11] + (size_t)pinst * D, first ? (const float*)(ws + WS_ID) + 1024 : args.in[12] + (size_t)pinst * D, 0.5f, DFF / 64};
                pg8::gemm_phase<pg8::EpiRes, pg8::SplitOrder, PG8_ALIGN, PG8_SP2>(LDSP, g, S, E);
            }
            grid_bar(args, LDSP);
            if (f == 0) ln_phase(args, LDSP, l, 0, true, l, 3, 11, ALPHA, false);
            else ln_phase(args, LDSP, l, 2, l == 0, 1, 0, 11, l == 0 ? ALPHA : 1.0f, l == 1);
            if (!(l == 1 && f == 1)) grid_bar(args, LDSP);
        }
    }
}

extern "C" void kernel_launch(void* const* d_in, const int* in_sizes, int n_in, void* d_out, int out_size, void* d_ws, size_t ws_size, hipStream_t stream) {
    static int grid = 0;
    if (grid == 0) {
        if (n_in != 28 || (size_t)out_size != O_END || ws_size < WS_END) { fprintf(stderr, "kernel_launch: unexpected sizes n_in %d out %d ws %zu (need %zu)\n", n_in, out_size, ws_size, (size_t)WS_END); grid = -1; return; }
        int dev = 0, cus = 0, per_cu = 0;
        hipGetDevice(&dev); hipDeviceGetAttribute(&cus, hipDeviceAttributeMultiprocessorCount, dev);
        hipFuncSetAttribute((const void*)mega_fwd, hipFuncAttributeMaxDynamicSharedMemorySize, LDS_BYTES);
        hipOccupancyMaxActiveBlocksPerMultiprocessor(&per_cu, (const void*)mega_fwd, NWAVES * 64, LDS_BYTES);
        (void)hipGetLastError();
        if (per_cu < 1 || cus < 256) { fprintf(stderr, "kernel_launch: occupancy %d cus %d\n", per_cu, cus); grid = -1; return; }
        grid = 256;
    }
    if (grid < 0) return;
    if (hipMemsetAsync(d_ws, 0, 65536, stream) != hipSuccess) { fprintf(stderr, "memset failed\n"); return; }
    Args a{};
    for (int i = 0; i < 28; ++i) a.in[i] = (const float*)d_in[i];
    a.out = (float*)d_out; a.ws = (unsigned char*)d_ws;
    void* kargs[] = {&a};
    hipError_t e = hipLaunchCooperativeKernel((const void*)mega_fwd, dim3(grid), dim3(NWAVES * 64), kargs, LDS_BYTES, stream);
    if (e != hipSuccess) fprintf(stderr, "cooperative launch failed: %s\n", hipGetErrorString(e));
}
```
